# Optimizing an MI355X kernel written in HIP

```python
import jax, jax.numpy as jnp
from jax import lax
import numpy as np

D_MODEL = 1024
BATCH = 4
SEQ = 8192
DEPTH = 1

N_META = 16
HEAD_DIM = 64
SB_HEADS = D_MODEL // (2 * HEAD_DIM)
RW_HEADS = D_MODEL // (2 * HEAD_DIM)
SB_WIDTH = SB_HEADS * HEAD_DIM
RW_WIDTH = RW_HEADS * HEAD_DIM
DECAY_LORA = 64
AAA_LORA = 64
GATE_LORA = 128
RW_SHIFT_WIDTH = 3 * RW_WIDTH + DECAY_LORA + AAA_LORA + GATE_LORA
P_IN = 3 * SB_WIDTH + RW_SHIFT_WIDTH + 2 * D_MODEL
D_FF = -(-8 * D_MODEL // (3 * 256)) * 256
Q_BLOCK = 128
RMS_EPS = 1e-6
GN_EPS = 64e-5

kernel_name = 'hybrid_stickbreak_rwkv7_block'


def rms_norm(x, g):
    xf = x.astype(jnp.float32)
    y = xf * lax.rsqrt(jnp.mean(xf * xf, axis=-1, keepdims=True) + RMS_EPS)
    return (y * g.astype(jnp.float32)).astype(x.dtype)


def token_shift(p, mu):
    prev = jnp.pad(p, ((0, 0), (1, 0), (0, 0)))[:, :-1]
    return p + mu * (prev - p)


def sb_block(q_blk, q_pos, k, v):
    T = k.shape[2]
    z = jnp.einsum('bhqd,bhsd->bhqs', q_blk, k).astype(jnp.float32) * (HEAD_DIM ** -0.5)
    visible = jnp.arange(T)[None, :] < q_pos[:, None]
    neg_log_1m_beta = jnp.where(visible, jax.nn.softplus(z), 0.0)
    between = lax.cumsum(neg_log_1m_beta, axis=3, reverse=True) - neg_log_1m_beta
    weights = jnp.where(visible, jnp.exp(jax.nn.log_sigmoid(z) - between), 0.0)
    return jnp.einsum('bhqs,bhsd->bhqd', weights.astype(v.dtype), v)


def stick_breaking_attention(q, k, v):
    B, T, _ = q.shape
    S = T - N_META
    nb = S // Q_BLOCK
    to_heads = lambda t: t.reshape(B, T, SB_HEADS, HEAD_DIM).transpose(0, 2, 1, 3)
    q, k, v = to_heads(q), to_heads(k), to_heads(v)
    lead = sb_block(q[:, :, :N_META], jnp.arange(N_META), k, v)
    qb = q[:, :, N_META:].reshape(B, SB_HEADS, nb, Q_BLOCK, HEAD_DIM).transpose(2, 0, 1, 3, 4)
    starts = N_META + Q_BLOCK * jnp.arange(nb)
    body = lambda args: sb_block(args[0], args[1] + jnp.arange(Q_BLOCK), k, v)
    out = lax.map(body, (qb, starts))
    out = out.transpose(1, 2, 0, 3, 4).reshape(B, SB_HEADS, S, HEAD_DIM)
    o = jnp.concatenate([lead, out], axis=2)
    return o.transpose(0, 2, 1, 3).reshape(B, T, SB_WIDTH)


def rwkv7_scan(r, decay, k, v, kk, a):
    B, T, H, N = r.shape

    def step(S, inp):
        r_t, w_t, k_t, v_t, kk_t, a_t = inp
        sa = jnp.einsum('bhvk,bhk->bhv', S, -kk_t)
        S = (S * w_t[:, :, None, :] + sa[..., None] * (kk_t * a_t)[:, :, None, :]
             + v_t[..., None] * k_t[:, :, None, :])
        y = jnp.einsum('bhvk,bhk->bhv', S, r_t)
        return S, y

    xs = tuple(jnp.moveaxis(t, 1, 0) for t in (r, decay, k, v, kk, a))
    S0 = jnp.zeros((B, H, N, N), jnp.float32)
    _, ys = lax.scan(step, S0, xs)
    return jnp.moveaxis(ys, 0, 1)


def rwkv7_time_mix(r, k, v, xw, xa, xg, decay_up, decay_base, aaa_up, aaa_base, gate_up,
                   k_k, k_a, r_k, ln_gain, ln_bias):
    B, T, _ = r.shape
    f32 = jnp.float32
    heads = lambda t: t.astype(f32).reshape(B, T, RW_HEADS, HEAD_DIM)
    w_log = -jax.nn.softplus(-(decay_base + jnp.tanh(xw) @ decay_up)) - 0.5
    decay = jnp.exp(-jnp.exp(w_log.astype(f32)))
    a = jax.nn.sigmoid(aaa_base + xa @ aaa_up)
    g = jax.nn.sigmoid(xg) @ gate_up
    kk = heads(k * k_k)
    kk = kk / jnp.maximum(jnp.sqrt(jnp.sum(kk * kk, axis=-1, keepdims=True)), 1e-12)
    k = k * (1.0 + (a - 1.0) * k_a)
    rh, kh, vh, ah = heads(r), heads(k), heads(v), heads(a)
    y = rwkv7_scan(rh, heads(decay), kh, vh, kk, ah)
    mu = jnp.mean(y, axis=-1, keepdims=True)
    var = jnp.mean(jnp.square(y - mu), axis=-1, keepdims=True)
    y = ((y - mu) * lax.rsqrt(var + GN_EPS)).reshape(B, T, RW_WIDTH)
    y = y * ln_gain.astype(f32) + ln_bias.astype(f32)
    bonus = jnp.sum(rh * kh * r_k.astype(f32), axis=-1, keepdims=True) * vh
    y = (y + bonus.reshape(B, T, RW_WIDTH)) * g.astype(f32)
    return y.astype(r.dtype)


def setup_inputs(seed: int = 0) -> dict:
    key = jax.random.key(seed)
    ks = jax.random.split(key, 26)
    nrm = lambda k, shape, s: jax.random.normal(k, shape, jnp.float32) * s
    L = DEPTH
    return {
        'x': nrm(ks[0], (BATCH, SEQ, D_MODEL), 1.0),
        'meta_tokens': nrm(ks[1], (N_META, D_MODEL), 1.0),
        'norm_mix_pre': 1.0 + nrm(ks[2], (L, D_MODEL), 0.05),
        'norm_mix_post': 1.0 + nrm(ks[3], (L, D_MODEL), 0.05),
        'w_in': nrm(ks[4], (L, D_MODEL, P_IN), D_MODEL ** -0.5),
        'rw_shift_mu': jax.random.uniform(ks[5], (L, RW_SHIFT_WIDTH), jnp.float32),
        'rw_decay_up': nrm(ks[6], (L, DECAY_LORA, RW_WIDTH), 0.5 * DECAY_LORA ** -0.5),
        'rw_decay_base': jax.random.uniform(ks[7], (L, RW_WIDTH), jnp.float32, -6.0, -1.0),
        'rw_aaa_up': nrm(ks[8], (L, AAA_LORA, RW_WIDTH), AAA_LORA ** -0.5),
        'rw_aaa_base': nrm(ks[9], (L, RW_WIDTH), 0.1),
        'rw_gate_up': nrm(ks[10], (L, GATE_LORA, RW_WIDTH), GATE_LORA ** -0.5),
        'rw_k_k': 0.85 + nrm(ks[11], (L, RW_WIDTH), 0.1),
        'rw_k_a': 1.0 + nrm(ks[12], (L, RW_WIDTH), 0.1),
        'rw_r_k': nrm(ks[13], (L, RW_HEADS, HEAD_DIM), 0.1),
        'rw_ln_gain': 1.0 + nrm(ks[14], (L, RW_WIDTH), 0.05),
        'rw_ln_bias': nrm(ks[15], (L, RW_WIDTH), 0.02),
        'w_branch_sb': nrm(ks[16], (L, SB_WIDTH, D_MODEL), SB_WIDTH ** -0.5),
        'w_branch_rw': nrm(ks[17], (L, RW_WIDTH, D_MODEL), RW_WIDTH ** -0.5),
        'w_out': nrm(ks[18], (L, D_MODEL, D_MODEL), D_MODEL ** -0.5),
        'norm_ffn_pre': 1.0 + nrm(ks[19], (L, D_MODEL), 0.05),
        'norm_ffn_post': 1.0 + nrm(ks[20], (L, D_MODEL), 0.05),
        'w_ffn_gate': nrm(ks[21], (L, D_MODEL, D_FF), D_MODEL ** -0.5),
        'w_ffn_up': nrm(ks[22], (L, D_MODEL, D_FF), D_MODEL ** -0.5),
        'w_ffn_down': nrm(ks[23], (L, D_FF, D_MODEL), D_FF ** -0.5),
    }


def reference(x, meta_tokens, norm_mix_pre, norm_mix_post, w_in, rw_shift_mu, rw_decay_up,
              rw_decay_base, rw_aaa_up, rw_aaa_base, rw_gate_up, rw_k_k, rw_k_a, rw_r_k,
              rw_ln_gain, rw_ln_bias, w_branch_sb, w_branch_rw, w_out, norm_ffn_pre,
              norm_ffn_post, w_ffn_gate, w_ffn_up, w_ffn_down):
    B = x.shape[0]
    meta = jnp.broadcast_to(meta_tokens[None].astype(x.dtype), (B, N_META, D_MODEL))
    h = jnp.concatenate([meta, x], axis=1)
    cut = [3 * SB_WIDTH, 3 * SB_WIDTH + RW_SHIFT_WIDTH, 3 * SB_WIDTH + RW_SHIFT_WIDTH + D_MODEL]
    rw_cut = [RW_WIDTH, 2 * RW_WIDTH, 3 * RW_WIDTH, 3 * RW_WIDTH + DECAY_LORA,
              3 * RW_WIDTH + DECAY_LORA + AAA_LORA]
    for l in range(DEPTH):
        u = rms_norm(h, norm_mix_pre[l]) @ w_in[l]
        u_sb, u_rw, gate_sb, gate_rw = jnp.split(u, cut, axis=-1)
        sq, sk, sv = jnp.split(u_sb, 3, axis=-1)
        o_sb = stick_breaking_attention(sq, sk, sv)
        u_rw = token_shift(u_rw, rw_shift_mu[l])
        rr, rk, rv, rxw, rxa, rxg = jnp.split(u_rw, rw_cut, axis=-1)
        o_rw = rwkv7_time_mix(rr, rk, rv, rxw, rxa, rxg, rw_decay_up[l], rw_decay_base[l],
                              rw_aaa_up[l], rw_aaa_base[l], rw_gate_up[l], rw_k_k[l], rw_k_a[l],
                              rw_r_k[l], rw_ln_gain[l], rw_ln_bias[l])
        merged = (jax.nn.sigmoid(gate_sb) * (o_sb @ w_branch_sb[l])
                  + jax.nn.sigmoid(gate_rw) * (o_rw @ w_branch_rw[l]))
        h = h + rms_norm(merged @ w_out[l], norm_mix_post[l])
        f = rms_norm(h, norm_ffn_pre[l])
        f = (jax.nn.silu(f @ w_ffn_gate[l]) * (f @ w_ffn_up[l])) @ w_ffn_down[l]
        h = h + rms_norm(f, norm_ffn_post[l])
    return h[:, N_META:]
```

```cpp
#include <hip/hip_runtime.h>
#include <hip/hip_cooperative_groups.h>
#include <cstdio>
#include <cstdint>
namespace cg = cooperative_groups;

#ifndef MULTI_LAUNCH
#define MULTI_LAUNCH 1
#endif

typedef unsigned short bf16_t;
typedef short bf16x8 __attribute__((ext_vector_type(8)));
typedef float f32x4 __attribute__((ext_vector_type(4)));
typedef float f32x2 __attribute__((ext_vector_type(2)));
typedef unsigned u32x2 __attribute__((ext_vector_type(2)));
typedef unsigned u32x4 __attribute__((ext_vector_type(4)));
typedef _Float16 h16x2 __attribute__((ext_vector_type(2)));
typedef _Float16 h16x4 __attribute__((ext_vector_type(4)));
typedef _Float16 h16x8 __attribute__((ext_vector_type(8)));

constexpr int D = 1024, NB = 4, SEQ = 8192, NMETA = 16, T = SEQ + NMETA, TP = 8320, MP = NB * TP, MS = NB * SEQ;
constexpr int PIN = 5376, DFF = 2816, NH = 8, RWS = 1792;
constexpr float RMS_EPS = 1e-6f, GN_EPS = 64e-5f;

constexpr size_t WS_CTL = 0;
constexpr size_t WS_WIN = 4096;
constexpr size_t WS_WSB = WS_WIN + (size_t)PIN * D * 2;
constexpr size_t WS_WRW = WS_WSB + (size_t)D * 512 * 2;
constexpr size_t WS_WOUT = WS_WRW + (size_t)D * 512 * 2;
constexpr size_t WS_WGU = WS_WOUT + (size_t)D * D * 2;
constexpr size_t WS_WD = WS_WGU + (size_t)2 * DFF * D * 2;
constexpr size_t WS_WL = WS_WD + (size_t)D * DFF * 2;
constexpr size_t R_QKV = WS_WL + (size_t)512 * 256 * 2;
constexpr size_t QKV_ONE = (size_t)MP * 512 * 2;
constexpr size_t R_URW = R_QKV + 3 * QKV_ONE;
constexpr size_t R_SI = R_URW + (size_t)MP * RWS * 2;
constexpr size_t SI_ONE = (size_t)MP * 512 * 2;
constexpr size_t R_G = R_SI + 6 * SI_ONE;
constexpr size_t WS_END = R_G + SI_ONE;
constexpr size_t O_A0 = R_SI;
constexpr size_t O_Y = R_URW;
constexpr size_t O_OSB = R_URW + (size_t)MP * 512 * 4;
constexpr size_t O_ORW = R_QKV;
constexpr size_t O_T1 = R_SI;
constexpr size_t O_M = R_SI + (size_t)MS * D * 4;
constexpr size_t O_P = R_QKV;
constexpr size_t O_F = R_SI;
constexpr size_t O_ACT = R_QKV;
constexpr size_t O_DN = R_SI + (size_t)MS * D * 2;
static_assert(O_OSB + (size_t)MS * 512 * 2 <= R_SI, "overlay");
static_assert(O_M + (size_t)MS * D * 2 <= WS_END, "overlay");
static_assert(O_ACT + (size_t)MS * DFF * 2 <= R_SI, "overlay");
static_assert(O_DN + (size_t)MS * D * 4 <= WS_END, "overlay");
static_assert(WS_END <= (size_t)512 * 1024 * 1024, "workspace");

constexpr int LDS_BYTES = 131072;

struct Params { const float* in[24]; float* out; unsigned char* ws; };

extern __shared__ __attribute__((aligned(16))) unsigned char smem[];

__device__ __forceinline__ unsigned pk_bf16(float lo, float hi) { unsigned r; asm volatile("v_cvt_pk_bf16_f32 %0, %1, %2" : "=v"(r) : "v"(lo), "v"(hi)); return r; }
__device__ __forceinline__ float bf2f(unsigned short v) { return __uint_as_float((unsigned)v << 16); }
__device__ __forceinline__ float sigmoidf_(float x) { return 1.0f / (1.0f + __expf(-x)); }
__device__ __forceinline__ float softplusf_(float x) { return fmaxf(x, 0.f) + __logf(1.0f + __expf(-fabsf(x))); }
template <int CTRL> __device__ __forceinline__ float dppf(float x) { return __builtin_bit_cast(float, __builtin_amdgcn_mov_dpp(__builtin_bit_cast(int, x), CTRL, 0xf, 0xf, true)); }
__device__ __forceinline__ float reduce16(float v) {
    v += dppf<0xB1>(v); v += dppf<0x4E>(v); v += dppf<0x141>(v); v += dppf<0x140>(v); return v;
}
__device__ __forceinline__ float wave_sum(float v) {
#pragma unroll
    for (int o = 1; o < 64; o <<= 1) v += __shfl_xor(v, o);
    return v;
}

#define LAS __attribute__((address_space(3)))
constexpr int BM = 256, BK = 64, HALF = 128, HTB = HALF * BK * 2, NXCD = 8, WGM = 8;
__device__ __forceinline__ int lds_byte(int r, int c) { const int st = (r >> 4) * 2 + (c >> 5), rr = r & 15, cc = c & 31, ob = rr * 64 + cc * 2; return st * 1024 + (ob ^ (((ob >> 9) & 1) << 5)); }
__device__ __forceinline__ void stage_rc(int b, int& R, int& C) { const int st = b / 1024, sb = b % 1024, swz = sb ^ (((sb >> 9) & 1) << 5); R = (st >> 1) * 16 + swz / 64; C = (st & 1) * 32 + (swz % 64) / 2; }
struct Unit { int pm, pn; };
struct Sched {
    int nM, nN, nwg, G, c;
    __device__ __forceinline__ bool next(int i, Unit& u) const {
        const long L = (long)i * G + c; if (L >= nwg) return false;
        int wgid = (int)L; { const int q = nwg / NXCD, r = nwg % NXCD, xcd = wgid % NXCD, off = wgid / NXCD; wgid = (xcd < r ? xcd * (q + 1) : r * (q + 1) + (xcd - r) * q) + off; }
        const int nig = WGM * nN, gid = wgid / nig, fm = gid * WGM, gsz = (nM - fm) < WGM ? (nM - fm) : WGM;
        u.pm = fm + ((wgid % nig) % gsz); u.pn = (wgid % nig) / gsz; return true;
    }
};

template <class Epi>
__device__ __forceinline__ void gemm_phase(const bf16_t* __restrict__ Ag, const bf16_t* __restrict__ Btg, const int K, const int nM, const int nN, const Epi& E) {
    LAS unsigned char* lds = (LAS unsigned char*)smem;
    const int tid = threadIdx.x, wid = __builtin_amdgcn_readfirstlane(tid >> 6), lane = tid & 63, wr = wid >> 2, wc = wid & 3, fr = lane & 15, fq = lane >> 4;
    const int nt = K / BK;
    Sched S; S.nM = nM; S.nN = nN; S.nwg = nM * nN; S.G = gridDim.x; S.c = blockIdx.x;
    unsigned voffA[2], voffB[2];
#pragma unroll
    for (int i = 0; i < 2; ++i) { int R, C; stage_rc(tid * 16 + i * 8192, R, C); voffA[i] = (unsigned)(R * K + C) * 2u; voffB[i] = voffA[i]; }
    const size_t kstep = (size_t)(BK * 2);
    const size_t hstep = (size_t)HALF * K * 2;
    const size_t tstep = 2 * hstep;
    const unsigned ldsw = (unsigned)wid * 1024u;
    const int aoff = lds_byte(wr * 64 + fr, fq * 8), boff = lds_byte(wc * 32 + fr, fq * 8);
#define PG8_SA(b, h) (((b) * 2 + (h)) * HTB)
#define PG8_SB(b, h) ((4 + (b) * 2 + (h)) * HTB)
#define PG8_STAGE(bufoff, gbase, voff) do { _Pragma("unroll") for (int _i = 0; _i < 2; ++_i) \
        __builtin_amdgcn_global_load_lds((const unsigned*)((const char*)(gbase) + (voff)[_i]), (LAS unsigned*)(lds + (bufoff) + ldsw + _i * 8192), 16, 0, 0); } while (0)
#define PG8_LDA(dst, b, h) do { _Pragma("unroll") for (int m = 0; m < 4; ++m) _Pragma("unroll") for (int k = 0; k < 2; ++k) dst[m][k] = *(const LAS bf16x8*)(lds + PG8_SA(b, h) + aoff + m * 2048 + k * 1024); } while (0)
#define PG8_LDB(dst, b, h) do { _Pragma("unroll") for (int n = 0; n < 2; ++n) _Pragma("unroll") for (int k = 0; k < 2; ++k) dst[n][k] = *(const LAS bf16x8*)(lds + PG8_SB(b, h) + boff + n * 2048 + k * 1024); } while (0)
#define PG8_MMA(ai, bj, At, Bt) do { __builtin_amdgcn_s_setprio(1); _Pragma("unroll") for (int m = 0; m < 4; ++m) _Pragma("unroll") for (int n = 0; n < 2; ++n) _Pragma("unroll") for (int k = 0; k < 2; ++k) \
        acc[ai][bj][m][n] = __builtin_amdgcn_mfma_f32_16x16x32_bf16(Bt[n][k], At[m][k], acc[ai][bj][m][n], 0, 0, 0); __builtin_amdgcn_s_setprio(0); } while (0)
#define PG8_WAIT_V(n) asm volatile("s_waitcnt vmcnt(" #n ")" ::: "memory")
#define PG8_WAIT_L(n) asm volatile("s_waitcnt lgkmcnt(" #n ")" ::: "memory")
#define PG8_BAR __builtin_amdgcn_s_barrier()
#define PG8_SCHED __builtin_amdgcn_sched_barrier(0)
    Unit cur, nxt; int ui = 0;
    __syncthreads();
    if (!S.next(0, cur)) return;
    f32x4 acc[2][2][4][2];
#pragma unroll
    for (int a = 0; a < 2; ++a)
#pragma unroll
        for (int b = 0; b < 2; ++b)
#pragma unroll
            for (int m = 0; m < 4; ++m)
#pragma unroll
                for (int n = 0; n < 2; ++n) acc[a][b][m][n] = (f32x4){0.f, 0.f, 0.f, 0.f};
    bf16x8 At[4][2], B0[2][2], B1[2][2];
    const char* cA = (const char*)Ag + (size_t)cur.pm * tstep; const char* cB = (const char*)Btg + (size_t)cur.pn * tstep;
    PG8_STAGE(PG8_SB(0, 0), cB, voffB); PG8_STAGE(PG8_SA(0, 0), cA, voffA); PG8_STAGE(PG8_SB(0, 1), cB + hstep, voffB); PG8_STAGE(PG8_SA(0, 1), cA + hstep, voffA);
    if (wr == 1) PG8_BAR;
    PG8_WAIT_V(4); PG8_BAR;
    PG8_STAGE(PG8_SB(1, 0), cB + kstep, voffB); PG8_STAGE(PG8_SA(1, 0), cA + kstep, voffA); PG8_STAGE(PG8_SB(1, 1), cB + hstep + kstep, voffB);
    PG8_WAIT_V(6); PG8_BAR;
    for (;;) {
        const bool has_next = S.next(ui + 1, nxt);
        const char* nA = has_next ? (const char*)Ag + (size_t)nxt.pm * tstep : cA; const char* nB = has_next ? (const char*)Btg + (size_t)nxt.pn * tstep : cB;
        for (int t = 0; t < nt; t += 2) {
            const bool last = (t == nt - 2);
            const char* a1 = cA + (size_t)(t + 1) * kstep;
            const char* a2 = last ? nA : cA + (size_t)(t + 2) * kstep; const char* b2 = last ? nB : cB + (size_t)(t + 2) * kstep;
            const char* a3 = a2 + kstep; const char* b3 = b2 + kstep;
            PG8_LDB(B0, 0, 0); PG8_SCHED; PG8_LDA(At, 0, 0); PG8_STAGE(PG8_SA(1, 1), a1 + hstep, voffA);
            PG8_WAIT_L(8); PG8_BAR; PG8_WAIT_L(0); PG8_MMA(0, 0, At, B0); PG8_BAR; PG8_SCHED;
            PG8_LDB(B1, 0, 1); PG8_STAGE(PG8_SB(0, 0), b2, voffB);
            PG8_BAR; PG8_WAIT_L(0); PG8_MMA(0, 1, At, B1); PG8_BAR;
            PG8_LDA(At, 0, 1); PG8_STAGE(PG8_SA(0, 0), a2, voffA);
            PG8_BAR; PG8_WAIT_L(0); PG8_MMA(1, 0, At, B0); PG8_BAR; PG8_SCHED;
            PG8_STAGE(PG8_SB(0, 1), b2 + hstep, voffB);
            PG8_WAIT_V(6); PG8_BAR; PG8_MMA(1, 1, At, B1); PG8_BAR;
            PG8_LDB(B0, 1, 0); PG8_SCHED; PG8_LDA(At, 1, 0); PG8_STAGE(PG8_SA(0, 1), a2 + hstep, voffA);
            PG8_WAIT_L(8); PG8_BAR; PG8_WAIT_L(0); PG8_MMA(0, 0, At, B0); PG8_BAR; PG8_SCHED;
            PG8_LDB(B1, 1, 1); PG8_STAGE(PG8_SB(1, 0), b3, voffB);
            PG8_BAR; PG8_WAIT_L(0); PG8_MMA(0, 1, At, B1); PG8_BAR;
            PG8_LDA(At, 1, 1); PG8_STAGE(PG8_SA(1, 0), a3, voffA);
            PG8_BAR; PG8_WAIT_L(0); PG8_MMA(1, 0, At, B0); PG8_BAR; PG8_SCHED;
            PG8_STAGE(PG8_SB(1, 1), b3 + hstep, voffB);
            PG8_WAIT_V(6); PG8_BAR; PG8_MMA(1, 1, At, B1); PG8_BAR;
        }
        {
            const int brow = cur.pm * BM, bcol = cur.pn * BM;
#pragma unroll
            for (int ai = 0; ai < 2; ++ai)
#pragma unroll
                for (int m = 0; m < 4; ++m) {
#pragma unroll
                    for (int bj = 0; bj < 2; ++bj)
                        E(brow + ai * HALF + wr * 64 + m * 16 + fr, bcol + bj * HALF + wc * 32, fq, acc[ai][bj][m][0], acc[ai][bj][m][1]);
                    asm volatile("" ::: "memory");
                }
        }
        if (!has_next) break;
#pragma unroll
        for (int a = 0; a < 2; ++a)
#pragma unroll
            for (int b = 0; b < 2; ++b)
#pragma unroll
                for (int m = 0; m < 4; ++m)
#pragma unroll
                    for (int n = 0; n < 2; ++n) acc[a][b][m][n] = (f32x4){0.f, 0.f, 0.f, 0.f};
        cur = nxt; cA = nA; cB = nB; ++ui;
    }
    PG8_WAIT_V(0);
    if (wr == 0) PG8_BAR;
    PG8_BAR;
#undef PG8_SA
#undef PG8_SB
#undef PG8_STAGE
#undef PG8_LDA
#undef PG8_LDB
#undef PG8_MMA
#undef PG8_WAIT_V
#undef PG8_WAIT_L
#undef PG8_BAR
#undef PG8_SCHED
}

struct EpiInProj {
    bf16_t* qkv; _Float16* urw; bf16_t* gates;
    __device__ __forceinline__ void one(int row, int col, const f32x4& v) const {
        if (col < 1536) {
            const int which = col >> 9, hc = col & 511, h = hc >> 6, d = hc & 63, b = row / TP, t = row - b * TP;
            const float s = which == 0 ? 0.125f : 1.0f;
            u32x2 w; w.x = pk_bf16(v[0] * s, v[1] * s); w.y = pk_bf16(v[2] * s, v[3] * s);
            *(u32x2*)(qkv + (size_t)which * (QKV_ONE / 2) + ((size_t)(b * NH + h) * TP + t) * 64 + d) = w;
        } else if (col < 3328) {
            h16x4 o; o[0] = (_Float16)v[0]; o[1] = (_Float16)v[1]; o[2] = (_Float16)v[2]; o[3] = (_Float16)v[3];
            *(h16x4*)(urw + (size_t)row * RWS + (col - 1536)) = o;
        } else {
            const int b = row / TP, t = row - b * TP;
            if (t >= NMETA && t < T) {
                u32x2 w; w.x = pk_bf16(sigmoidf_(v[0]), sigmoidf_(v[1])); w.y = pk_bf16(sigmoidf_(v[2]), sigmoidf_(v[3]));
                *(u32x2*)(gates + (size_t)(b * SEQ + t - NMETA) * 2048 + (col - 3328)) = w;
            }
        }
    }
    __device__ __forceinline__ void operator()(int row, int col32, int fq, const f32x4& v0, const f32x4& v1) const { one(row, col32 + 4 * fq, v0); one(row, col32 + 16 + 4 * fq, v1); }
};
struct EpiBranch1 {
    float* t1; const bf16_t* gates;
    __device__ __forceinline__ void one(int row, int col, const f32x4& v) const {
        const u32x2 g = *(const u32x2*)(gates + (size_t)row * 2048 + col);
        f32x4 o; o[0] = v[0] * __uint_as_float(g.x << 16); o[1] = v[1] * __uint_as_float(g.x & 0xffff0000u); o[2] = v[2] * __uint_as_float(g.y << 16); o[3] = v[3] * __uint_as_float(g.y & 0xffff0000u);
        *(f32x4*)(t1 + (size_t)row * D + col) = o;
    }
    __device__ __forceinline__ void operator()(int row, int col32, int fq, const f32x4& v0, const f32x4& v1) const { one(row, col32 + 4 * fq, v0); one(row, col32 + 16 + 4 * fq, v1); }
};
struct EpiBranch2 {
    const float* t1; const bf16_t* gates; bf16_t* m;
    __device__ __forceinline__ void one(int row, int col, const f32x4& v) const {
        const u32x2 g = *(const u32x2*)(gates + (size_t)row * 2048 + 1024 + col);
        const f32x4 a = *(const f32x4*)(t1 + (size_t)row * D + col);
        f32x4 o; o[0] = a[0] + v[0] * __uint_as_float(g.x << 16); o[1] = a[1] + v[1] * __uint_as_float(g.x & 0xffff0000u); o[2] = a[2] + v[2] * __uint_as_float(g.y << 16); o[3] = a[3] + v[3] * __uint_as_float(g.y & 0xffff0000u);
        u32x2 w; w.x = pk_bf16(o[0], o[1]); w.y = pk_bf16(o[2], o[3]);
        *(u32x2*)(m + (size_t)row * D + col) = w;
    }
    __device__ __forceinline__ void operator()(int row, int col32, int fq, const f32x4& v0, const f32x4& v1) const { one(row, col32 + 4 * fq, v0); one(row, col32 + 16 + 4 * fq, v1); }
};
struct EpiF32 {
    float* o;
    __device__ __forceinline__ void operator()(int row, int col32, int fq, const f32x4& v0, const f32x4& v1) const {
        *(f32x4*)(o + (size_t)row * D + col32 + 4 * fq) = v0; *(f32x4*)(o + (size_t)row * D + col32 + 16 + 4 * fq) = v1;
    }
};
struct EpiGU {
    bf16_t* act;
    __device__ __forceinline__ void operator()(int row, int col32, int fq, const f32x4& v0, const f32x4& v1) const {
        float o[4];
#pragma unroll
        for (int j = 0; j < 4; ++j) o[j] = v0[j] * sigmoidf_(v0[j]) * v1[j];
        u32x2 w; w.x = pk_bf16(o[0], o[1]); w.y = pk_bf16(o[2], o[3]);
        *(u32x2*)(act + (size_t)row * DFF + (col32 >> 5) * 16 + 4 * fq) = w;
    }
};

__device__ __forceinline__ void transpose_tile(const float* __restrict__ src, int K, int N, bf16_t* __restrict__ dst, int ldd, int koff, int mode, int tile) {
    float* scr = (float*)smem;
    const int ntn = N / 64, kb = tile / ntn, nb = tile % ntn, k0 = kb * 64, n0 = nb * 64, tid = threadIdx.x;
#pragma unroll
    for (int i = 0; i < 8; ++i) { const int kk = (tid >> 6) + 8 * i; scr[kk * 65 + (tid & 63)] = src[(size_t)(k0 + kk) * N + n0 + (tid & 63)]; }
    __syncthreads();
    const int n = tid >> 3, kc = (tid & 7) * 8;
    u32x4 o;
    o.x = pk_bf16(scr[(kc + 0) * 65 + n], scr[(kc + 1) * 65 + n]); o.y = pk_bf16(scr[(kc + 2) * 65 + n], scr[(kc + 3) * 65 + n]);
    o.z = pk_bf16(scr[(kc + 4) * 65 + n], scr[(kc + 5) * 65 + n]); o.w = pk_bf16(scr[(kc + 6) * 65 + n], scr[(kc + 7) * 65 + n]);
    const int f = n0 + n;
    const int drow = mode == 0 ? f : ((f >> 4) * 32 + (mode == 2 ? 16 : 0) + (f & 15));
    *(u32x4*)(dst + (size_t)drow * ldd + koff + k0 + kc) = o;
    __syncthreads();
}

__device__ __forceinline__ void phase0(const Params& p) {
    unsigned char* ws = p.ws;
    if (blockIdx.x == 0 && threadIdx.x < 64) ((unsigned*)(ws + WS_CTL))[threadIdx.x] = 0u;
    constexpr int J0 = 16 * 84, J1 = 8 * 16, J3 = 16 * 16, J4 = 16 * 44, J6 = 44 * 16, J7 = 8, J9 = 16;
    constexpr int NT = J0 + 2 * J1 + J3 + 2 * J4 + J6 + 2 * J7 + J9;
    constexpr int NR = MP / 8;
    for (int it = blockIdx.x; it < NT + NR; it += gridDim.x) {
        if (it < NT) {
            int r = it;
            if (r < J0) { transpose_tile(p.in[4], D, PIN, (bf16_t*)(ws + WS_WIN), D, 0, 0, r); continue; } r -= J0;
            if (r < J1) { transpose_tile(p.in[16], 512, D, (bf16_t*)(ws + WS_WSB), 512, 0, 0, r); continue; } r -= J1;
            if (r < J1) { transpose_tile(p.in[17], 512, D, (bf16_t*)(ws + WS_WRW), 512, 0, 0, r); continue; } r -= J1;
            if (r < J3) { transpose_tile(p.in[18], D, D, (bf16_t*)(ws + WS_WOUT), D, 0, 0, r); continue; } r -= J3;
            if (r < J4) { transpose_tile(p.in[21], D, DFF, (bf16_t*)(ws + WS_WGU), D, 0, 1, r); continue; } r -= J4;
            if (r < J4) { transpose_tile(p.in[22], D, DFF, (bf16_t*)(ws + WS_WGU), D, 0, 2, r); continue; } r -= J4;
            if (r < J6) { transpose_tile(p.in[23], DFF, D, (bf16_t*)(ws + WS_WD), DFF, 0, 0, r); continue; } r -= J6;
            if (r < J7) { transpose_tile(p.in[6], 64, 512, (bf16_t*)(ws + WS_WL), 256, 0, 0, r); continue; } r -= J7;
            if (r < J7) { transpose_tile(p.in[8], 64, 512, (bf16_t*)(ws + WS_WL), 256, 64, 0, r); continue; } r -= J7;
            transpose_tile(p.in[10], 128, 512, (bf16_t*)(ws + WS_WL), 256, 128, 0, r);
        } else {
            const int row = (it - NT) * 8 + (threadIdx.x >> 6), lane = threadIdx.x & 63;
            const int b = row / TP, t = row - b * TP;
            bf16_t* orow = (bf16_t*)(ws + O_A0) + (size_t)row * D;
            if (t >= T) {
#pragma unroll
                for (int j = 0; j < 4; ++j) *(u32x2*)(orow + 4 * lane + 256 * j) = (u32x2){0u, 0u};
            } else {
                const float* src = t < NMETA ? p.in[1] + (size_t)t * D : p.in[0] + ((size_t)b * SEQ + (t - NMETA)) * D;
                f32x4 v[4]; float ss = 0.f;
#pragma unroll
                for (int j = 0; j < 4; ++j) { v[j] = *(const f32x4*)(src + 4 * lane + 256 * j); ss += (v[j][0] * v[j][0] + v[j][1] * v[j][1]) + (v[j][2] * v[j][2] + v[j][3] * v[j][3]); }
                const float rs = rsqrtf(wave_sum(ss) * (1.0f / D) + RMS_EPS);
#pragma unroll
                for (int j = 0; j < 4; ++j) {
                    const f32x4 g = *(const f32x4*)(p.in[2] + 4 * lane + 256 * j);
                    u32x2 w; w.x = pk_bf16(v[j][0] * rs * g[0], v[j][1] * rs * g[1]); w.y = pk_bf16(v[j][2] * rs * g[2], v[j][3] * rs * g[3]);
                    *(u32x2*)(orow + 4 * lane + 256 * j) = w;
                }
            }
        }
    }
}

__device__ __forceinline__ void phase1(const Params& p) {
    unsigned char* ws = p.ws;
    EpiInProj epi{(bf16_t*)(ws + R_QKV), (_Float16*)(ws + R_URW), (bf16_t*)p.out};
    gemm_phase((const bf16_t*)(ws + O_A0), (const bf16_t*)(ws + WS_WIN), D, MP / BM, PIN / BM, epi);
}

constexpr int SI_R = 0, SI_W = 1, SI_K = 2, SI_V = 3, SI_KK = 4, SI_B = 5;
constexpr int ALD = 264;
__device__ __forceinline__ void phase2_tile(const Params& p, int tile) {
    unsigned char* ws = p.ws;
    const int tid = threadIdx.x, wave = tid >> 6, lane = tid & 63, fr = lane & 15, fq = lane >> 4;
    const int row0 = tile * 64;
    const _Float16* urw = (const _Float16*)(ws + R_URW);
    const float* mu = p.in[5];
    bf16_t* Al = (bf16_t*)smem;
    __syncthreads();
    {
        const int tk = tid >> 3, cgp = (tid & 7) * 32, row = row0 + tk, t = row % TP;
        const _Float16* cur = urw + (size_t)row * RWS + 1536 + cgp;
        const int kind = cgp < 64 ? 0 : (cgp < 128 ? 1 : 2);
#pragma unroll
        for (int q = 0; q < 4; ++q) {
            const h16x8 c = *(const h16x8*)(cur + q * 8);
            h16x8 pv = c;
            if (t > 0) pv = *(const h16x8*)(cur - RWS + q * 8);
            float o[8];
#pragma unroll
            for (int e = 0; e < 8; ++e) {
                const float cf = (float)c[e], pf = t > 0 ? (float)pv[e] : 0.f;
                const float xs = cf + mu[1536 + cgp + q * 8 + e] * (pf - cf);
                float val;
                if (kind == 0) { const float ex = __expf(2.f * xs); val = 1.f - 2.f / (ex + 1.f); }
                else if (kind == 1) val = xs;
                else val = sigmoidf_(xs);
                o[e] = val;
            }
            u32x4 w; w.x = pk_bf16(o[0], o[1]); w.y = pk_bf16(o[2], o[3]); w.z = pk_bf16(o[4], o[5]); w.w = pk_bf16(o[6], o[7]);
            *(u32x4*)(Al + tk * ALD + cgp + q * 8) = w;
        }
    }
    __syncthreads();
    const int h = wave;
    const bf16_t* WL = (const bf16_t*)(ws + WS_WL);
    _Float16* SI = (_Float16*)(ws + R_SI);
    bf16_t* G = (bf16_t*)(ws + R_G);
    constexpr size_t SIE = (size_t)MP * 512;
#pragma unroll 1
    for (int m = 0; m < 4; ++m) {
        f32x4 acc[4];
        auto lora = [&](int kbeg, int ksteps) {
#pragma unroll
            for (int n = 0; n < 4; ++n) acc[n] = (f32x4){0.f, 0.f, 0.f, 0.f};
#pragma unroll 1
            for (int ks = 0; ks < ksteps; ++ks) {
                const bf16x8 af = *(const bf16x8*)(Al + (m * 16 + fr) * ALD + kbeg + ks * 32 + fq * 8);
#pragma unroll
                for (int n = 0; n < 4; ++n) {
                    const bf16x8 wf = *(const bf16x8*)(WL + (size_t)(h * 64 + n * 16 + fr) * 256 + kbeg + ks * 32 + fq * 8);
                    acc[n] = __builtin_amdgcn_mfma_f32_16x16x32_bf16(wf, af, acc[n], 0, 0, 0);
                }
            }
        };
        const int row = row0 + m * 16 + fr, b = row / TP, t = row - b * TP;
        const size_t base = ((size_t)(b * NH + h) * TP + t) * 64;
        const _Float16* ur = urw + (size_t)row * RWS;
        lora(0, 2);
#pragma unroll
        for (int n = 0; n < 4; ++n) {
            const int c = n * 16 + fq * 4;
            const f32x4 db = *(const f32x4*)(p.in[7] + h * 64 + c);
            h16x4 o;
#pragma unroll
            for (int j = 0; j < 4; ++j) {
                const float wl = -softplusf_(-(db[j] + acc[n][j])) - 0.5f;
                const float e = __expf(wl);
                o[j] = (_Float16)(1.0f - __expf(-e));
            }
            *(h16x4*)(SI + SI_W * SIE + base + c) = o;
        }
        lora(64, 2);
        {
            float kv[4][4], av[4][4], kkr[4][4]; float ss = 0.f;
#pragma unroll
            for (int n = 0; n < 4; ++n) {
                const int c = n * 16 + fq * 4, c512 = h * 64 + c;
                const h16x4 kc = *(const h16x4*)(ur + 512 + c512), rc = *(const h16x4*)(ur + c512), vc = *(const h16x4*)(ur + 1024 + c512);
                h16x4 kp = kc, rp = rc, vp = vc;
                if (t > 0) { kp = *(const h16x4*)(ur - RWS + 512 + c512); rp = *(const h16x4*)(ur - RWS + c512); vp = *(const h16x4*)(ur - RWS + 1024 + c512); }
                const f32x4 muk = *(const f32x4*)(mu + 512 + c512), mur = *(const f32x4*)(mu + c512), muv = *(const f32x4*)(mu + 1024 + c512);
                const f32x4 ab = *(const f32x4*)(p.in[9] + c512), kkw = *(const f32x4*)(p.in[11] + c512);
                h16x4 ro, vo;
#pragma unroll
                for (int j = 0; j < 4; ++j) {
                    const float kcf = (float)kc[j], kpf = t > 0 ? (float)kp[j] : 0.f;
                    const float rcf = (float)rc[j], rpf = t > 0 ? (float)rp[j] : 0.f;
                    const float vcf = (float)vc[j], vpf = t > 0 ? (float)vp[j] : 0.f;
                    kv[n][j] = kcf + muk[j] * (kpf - kcf);
                    ro[j] = (_Float16)(rcf + mur[j] * (rpf - rcf));
                    vo[j] = (_Float16)(vcf + muv[j] * (vpf - vcf));
                    av[n][j] = sigmoidf_(ab[j] + acc[n][j]);
                    kkr[n][j] = kv[n][j] * kkw[j];
                    ss += kkr[n][j] * kkr[n][j];
                }
                *(h16x4*)(SI + SI_R * SIE + base + c) = ro;
                *(h16x4*)(SI + SI_V * SIE + base + c) = vo;
            }
            ss += __shfl_xor(ss, 16); ss += __shfl_xor(ss, 32);
            const float inv = 1.0f / fmaxf(sqrtf(ss), 1e-12f);
#pragma unroll
            for (int n = 0; n < 4; ++n) {
                const int c = n * 16 + fq * 4, c512 = h * 64 + c;
                const f32x4 ka = *(const f32x4*)(p.in[12] + c512);
                h16x4 ko, kko, bo;
#pragma unroll
                for (int j = 0; j < 4; ++j) {
                    const float kk = kkr[n][j] * inv;
                    ko[j] = (_Float16)(kv[n][j] * (1.0f + (av[n][j] - 1.0f) * ka[j]));
                    kko[j] = (_Float16)kk;
                    bo[j] = (_Float16)(kk * av[n][j]);
                }
                *(h16x4*)(SI + SI_K * SIE + base + c) = ko;
                *(h16x4*)(SI + SI_KK * SIE + base + c) = kko;
                *(h16x4*)(SI + SI_B * SIE + base + c) = bo;
            }
        }
        lora(128, 4);
#pragma unroll
        for (int n = 0; n < 4; ++n) {
            u32x2 w; w.x = pk_bf16(acc[n][0], acc[n][1]); w.y = pk_bf16(acc[n][2], acc[n][3]);
            *(u32x2*)(G + base + n * 16 + fq * 4) = w;
        }
    }
}
__device__ __forceinline__ void phase2_kmax(const Params& p, int item) {
    unsigned char* ws = p.ws;
    const int bh = item / 17, ch = item % 17, tid = threadIdx.x;
    const int t = ch * 512 + tid;
    float ss = 0.f;
    if (t < T) {
        const bf16_t* kr = (const bf16_t*)(ws + R_QKV) + QKV_ONE / 2 + ((size_t)bh * TP + t) * 64;
#pragma unroll
        for (int q = 0; q < 8; ++q) {
            const u32x4 v = *(const u32x4*)(kr + q * 8);
#pragma unroll
            for (int e = 0; e < 4; ++e) { const float lo = __uint_as_float(v[e] << 16), hi = __uint_as_float(v[e] & 0xffff0000u); ss += lo * lo + hi * hi; }
        }
    }
#pragma unroll
    for (int o = 1; o < 64; o <<= 1) ss = fmaxf(ss, __shfl_xor(ss, o));
    if ((tid & 63) == 0) atomicMax((unsigned*)(ws + WS_CTL) + 16 + bh, __float_as_uint(ss));
}
__device__ __forceinline__ void phase2(const Params& p) {
    constexpr int NTILE = MP / 64, NK = 32 * 17;
    for (int it = blockIdx.x; it < NTILE + NK; it += gridDim.x) {
        if (it < NTILE) phase2_tile(p, it); else phase2_kmax(p, it - NTILE);
    }
}

constexpr int SC_TC = 32, SC_NC = (T + SC_TC - 1) / SC_TC;
constexpr int SC_BUF = (5 * SC_TC * 64 + SC_TC * 16) * 4;
constexpr int SC_YOFF = 2 * SC_BUF, SC_YBUF = SC_TC * 16 * 4;
__device__ __forceinline__ void scan_unit(const Params& p, int unit) {
    unsigned char* ws = p.ws;
    const int bh = unit >> 2, vr0 = (unit & 3) * 16, tid = threadIdx.x, wave = tid >> 6, lane = tid & 63;
    const _Float16* SI = (const _Float16*)(ws + R_SI);
    constexpr size_t SIE = (size_t)MP * 512;
    float* Y = (float*)(ws + O_Y);
    const size_t hb = (size_t)bh * TP * 64;
    __syncthreads();
    if (wave >= 4) {
        const int i = tid - 256;
        const int arrs[5] = {SI_R, SI_W, SI_K, SI_KK, SI_B};
        u32x4 rg[5]; unsigned rv;
        auto issue = [&](int c) {
            const size_t off = hb + (size_t)c * SC_TC * 64;
#pragma unroll
            for (int a = 0; a < 5; ++a) rg[a] = *(const u32x4*)(SI + arrs[a] * SIE + off + i * 8);
            rv = *(const unsigned*)(SI + SI_V * SIE + off + (i >> 3) * 64 + vr0 + (i & 7) * 2);
        };
        auto commit = [&](int bufi) {
            float* buf = (float*)(smem + bufi * SC_BUF);
#pragma unroll
            for (int a = 0; a < 5; ++a) {
                const h16x8 hv = __builtin_bit_cast(h16x8, rg[a]);
                f32x4 lo, hi;
#pragma unroll
                for (int e = 0; e < 4; ++e) { lo[e] = (float)hv[e]; hi[e] = (float)hv[4 + e]; }
                if (a == 1) { lo = 1.0f - lo; hi = 1.0f - hi; }
                *(f32x4*)(buf + a * (SC_TC * 64) + i * 8) = lo; *(f32x4*)(buf + a * (SC_TC * 64) + i * 8 + 4) = hi;
            }
            const h16x2 v2 = __builtin_bit_cast(h16x2, rv);
            f32x2 vf; vf[0] = (float)v2[0]; vf[1] = (float)v2[1];
            *(f32x2*)(buf + 5 * (SC_TC * 64) + (i >> 3) * 16 + (i & 7) * 2) = vf;
        };
        auto yout = [&](int c) {
            const float* yb = (const float*)(smem + SC_YOFF + (c & 1) * SC_YBUF);
            const f32x2 v = *(const f32x2*)(yb + (i >> 3) * 16 + (i & 7) * 2);
            *(f32x2*)(Y + hb + (size_t)(c * SC_TC + (i >> 3)) * 64 + vr0 + (i & 7) * 2) = v;
        };
        issue(0); commit(0); issue(1);
        __syncthreads();
        for (int c = 0; c < SC_NC; ++c) {
            if (c > 0) yout(c - 1);
            if (c + 1 < SC_NC) commit((c + 1) & 1);
            if (c + 2 < SC_NC) issue(c + 2);
            __syncthreads();
        }
        yout(SC_NC - 1);
    } else {
        const int rl = wave * 4 + (lane >> 4), sub = lane & 15;
        f32x4 S = {0.f, 0.f, 0.f, 0.f};
        __syncthreads();
        for (int c = 0; c < SC_NC; ++c) {
            const float* buf = (const float*)(smem + (c & 1) * SC_BUF);
            float* yb = (float*)(smem + SC_YOFF + (c & 1) * SC_YBUF);
#pragma unroll 4
            for (int s = 0; s < SC_TC; ++s) {
                const f32x4 r4 = *(const f32x4*)(buf + 0 * (SC_TC * 64) + s * 64 + sub * 4);
                const f32x4 w4 = *(const f32x4*)(buf + 1 * (SC_TC * 64) + s * 64 + sub * 4);
                const f32x4 k4 = *(const f32x4*)(buf + 2 * (SC_TC * 64) + s * 64 + sub * 4);
                const f32x4 kk4 = *(const f32x4*)(buf + 3 * (SC_TC * 64) + s * 64 + sub * 4);
                const f32x4 b4 = *(const f32x4*)(buf + 4 * (SC_TC * 64) + s * 64 + sub * 4);
                const float vv = buf[5 * (SC_TC * 64) + s * 16 + rl];
                float d = (S[0] * kk4[0] + S[1] * kk4[1]) + (S[2] * kk4[2] + S[3] * kk4[3]);
                d = reduce16(d);
                const f32x4 tmp = S * w4 + vv * k4;
                S = tmp - d * b4;
                float y = (S[0] * r4[0] + S[1] * r4[1]) + (S[2] * r4[2] + S[3] * r4[3]);
                y = reduce16(y);
                if (sub == 0) yb[s * 16 + rl] = y;
            }
            __syncthreads();
        }
    }
}

constexpr int KLD = 72;
__device__ __forceinline__ void attn_unit(const Params& p, int unit) {
    unsigned char* ws = p.ws;
    const int qt = unit % 65, bh = unit / 65, b = bh >> 3, h = bh & 7;
    const int tid = threadIdx.x, wave = tid >> 6, lane = tid & 63, fr = lane & 15, fq = lane >> 4;
    const bf16_t* Q = (const bf16_t*)(ws + R_QKV) + (size_t)bh * TP * 64;
    const bf16_t* Kg = Q + QKV_ONE / 2;
    const bf16_t* Vg = Q + QKV_ONE;
    bf16_t* Ks = (bf16_t*)smem;
    bf16_t* Vt = Ks + 64 * KLD;
    volatile int* flags = (volatile int*)(smem + 2 * 64 * KLD * 2);
    const int t0 = qt * 128, tq = t0 + wave * 16 + fr;
    bf16x8 qf[2];
    qf[0] = *(const bf16x8*)(Q + (size_t)tq * 64 + fq * 8);
    qf[1] = *(const bf16x8*)(Q + (size_t)tq * 64 + 32 + fq * 8);
    float qs = 0.f;
#pragma unroll
    for (int s = 0; s < 2; ++s)
#pragma unroll
        for (int e = 0; e < 8; ++e) { const float f = bf2f((unsigned short)qf[s][e]); qs += f * f; }
    qs += __shfl_xor(qs, 16); qs += __shfl_xor(qs, 32);
    const float kmax = sqrtf(__uint_as_float(((const unsigned*)(ws + WS_CTL))[16 + bh]));
    const float zb = sqrtf(qs) * kmax * 1.0001f + 88.0f;
    float Arow = 0.f;
    f32x4 O[4];
#pragma unroll
    for (int nd = 0; nd < 4; ++nd) O[nd] = (f32x4){0.f, 0.f, 0.f, 0.f};
    for (int kb = qt * 2 + 1; kb >= 0; --kb) {
        const bool done = __all(Arow > zb);
        if (lane == 0) flags[wave] = done ? 1 : 0;
        __syncthreads();
        int alld = 1;
#pragma unroll
        for (int w = 0; w < 8; ++w) alld &= flags[w];
        if (alld) break;
        {
            const int key = tid >> 3, dc = (tid & 7) * 8;
            const u32x4 kvv = *(const u32x4*)(Kg + (size_t)(kb * 64 + key) * 64 + dc);
            const u32x4 vvv = *(const u32x4*)(Vg + (size_t)(kb * 64 + key) * 64 + dc);
            *(u32x4*)(Ks + key * KLD + dc) = kvv;
#pragma unroll
            for (int e = 0; e < 4; ++e) { Vt[(dc + 2 * e) * KLD + key] = (bf16_t)(vvv[e] & 0xffffu); Vt[(dc + 2 * e + 1) * KLD + key] = (bf16_t)(vvv[e] >> 16); }
        }
        __syncthreads();
        f32x4 z[4];
#pragma unroll
        for (int n = 0; n < 4; ++n) {
            z[n] = (f32x4){0.f, 0.f, 0.f, 0.f};
#pragma unroll
            for (int s = 0; s < 2; ++s) {
                const bf16x8 kf = *(const bf16x8*)(Ks + (n * 16 + fr) * KLD + s * 32 + fq * 8);
                z[n] = __builtin_amdgcn_mfma_f32_16x16x32_bf16(kf, qf[s], z[n], 0, 0, 0);
            }
        }
        float sp[4][4], lt[4], ex[4], sg[4];
#pragma unroll
        for (int n = 0; n < 4; ++n) {
#pragma unroll
            for (int j = 0; j < 4; ++j) { const int s = kb * 64 + n * 16 + fq * 4 + j; sp[n][j] = s < tq ? softplusf_(z[n][j]) : 0.f; }
            sp[n][2] += sp[n][3]; sp[n][1] += sp[n][2]; sp[n][0] += sp[n][1];
            lt[n] = sp[n][0];
            const float a = __shfl_xor(lt[n], 16), pr = lt[n] + a, c = __shfl_xor(pr, 32);
            ex[n] = fq == 3 ? 0.f : (fq == 2 ? a : (fq == 1 ? c : a + c));
            sg[n] = pr + c;
        }
        float nsuf[4]; nsuf[3] = 0.f; nsuf[2] = sg[3]; nsuf[1] = nsuf[2] + sg[2]; nsuf[0] = nsuf[1] + sg[1];
        float wgt[4][4];
#pragma unroll
        for (int n = 0; n < 4; ++n)
#pragma unroll
            for (int j = 0; j < 4; ++j) {
                const int s = kb * 64 + n * 16 + fq * 4 + j;
                const float C = Arow + nsuf[n] + ex[n] + sp[n][j];
                wgt[n][j] = s < tq ? __expf(z[n][j] - C) : 0.f;
            }
        Arow += nsuf[0] + sg[0];
#pragma unroll
        for (int ks = 0; ks < 2; ++ks) {
            u32x4 pw; pw.x = pk_bf16(wgt[2 * ks][0], wgt[2 * ks][1]); pw.y = pk_bf16(wgt[2 * ks][2], wgt[2 * ks][3]);
            pw.z = pk_bf16(wgt[2 * ks + 1][0], wgt[2 * ks + 1][1]); pw.w = pk_bf16(wgt[2 * ks + 1][2], wgt[2 * ks + 1][3]);
            const bf16x8 pf = __builtin_bit_cast(bf16x8, pw);
#pragma unroll
            for (int nd = 0; nd < 4; ++nd) {
                u32x4 vw;
                const u32x2 v0 = *(const u32x2*)(Vt + (nd * 16 + fr) * KLD + (2 * ks) * 16 + fq * 4);
                const u32x2 v1 = *(const u32x2*)(Vt + (nd * 16 + fr) * KLD + (2 * ks + 1) * 16 + fq * 4);
                vw.x = v0.x; vw.y = v0.y; vw.z = v1.x; vw.w = v1.y;
                O[nd] = __builtin_amdgcn_mfma_f32_16x16x32_bf16(pf, __builtin_bit_cast(bf16x8, vw), O[nd], 0, 0, 0);
            }
        }
    }
    __syncthreads();
    bf16_t* osb = (bf16_t*)(ws + O_OSB);
#pragma unroll
    for (int j = 0; j < 4; ++j) {
        const int t = t0 + wave * 16 + fq * 4 + j;
        if (t >= NMETA && t < T) {
#pragma unroll
            for (int nd = 0; nd < 4; ++nd) osb[(size_t)(b * SEQ + t - NMETA) * 512 + h * 64 + nd * 16 + fr] = (bf16_t)(pk_bf16(O[nd][j], 0.f) & 0xffffu);
        }
    }
}

constexpr int N_SCAN = 128, N_ATTN = 32 * 65;
__device__ __forceinline__ void phase3(const Params& p) {
    unsigned* ctr = (unsigned*)(p.ws + WS_CTL);
    volatile int* slot = (volatile int*)(smem + LDS_BYTES - 16);
    for (;;) {
        __syncthreads();
        if (threadIdx.x == 0) *slot = (int)atomicAdd(ctr, 1u);
        __syncthreads();
        const int u = *slot;
        if (u >= N_SCAN + N_ATTN) break;
        if (u < N_SCAN) scan_unit(p, u); else attn_unit(p, u - N_SCAN);
    }
}

__device__ __forceinline__ void phase3c(const Params& p) {
    unsigned char* ws = p.ws;
    const _Float16* SI = (const _Float16*)(ws + R_SI);
    constexpr size_t SIE = (size_t)MP * 512;
    const float* Y = (const float*)(ws + O_Y);
    const bf16_t* G = (const bf16_t*)(ws + R_G);
    bf16_t* orw = (bf16_t*)(ws + O_ORW);
    const int tid = threadIdx.x, sub = tid & 15;
    for (int it = blockIdx.x; it < 32 * 256; it += gridDim.x) {
        const int bh = it >> 8, ch = it & 255, b = bh >> 3, h = bh & 7;
        const int t = NMETA + ch * 32 + (tid >> 4);
        const size_t base = ((size_t)bh * TP + t) * 64 + sub * 4;
        const f32x4 y = *(const f32x4*)(Y + base);
        const float mean = reduce16((y[0] + y[1]) + (y[2] + y[3])) * (1.0f / 64.0f);
        const f32x4 dy = y - mean;
        const float var = reduce16((dy[0] * dy[0] + dy[1] * dy[1]) + (dy[2] * dy[2] + dy[3] * dy[3])) * (1.0f / 64.0f);
        const float rs = rsqrtf(var + GN_EPS);
        const int c = h * 64 + sub * 4;
        const f32x4 gain = *(const f32x4*)(p.in[14] + c), bias = *(const f32x4*)(p.in[15] + c), rk = *(const f32x4*)(p.in[13] + c);
        const h16x4 r4 = *(const h16x4*)(SI + SI_R * SIE + base), k4 = *(const h16x4*)(SI + SI_K * SIE + base), v4 = *(const h16x4*)(SI + SI_V * SIE + base);
        float bs = 0.f;
#pragma unroll
        for (int j = 0; j < 4; ++j) bs += (float)r4[j] * (float)k4[j] * rk[j];
        bs = reduce16(bs);
        const u32x2 g2 = *(const u32x2*)(G + base);
        const float gg[4] = {__uint_as_float(g2.x << 16), __uint_as_float(g2.x & 0xffff0000u), __uint_as_float(g2.y << 16), __uint_as_float(g2.y & 0xffff0000u)};
        float o[4];
#pragma unroll
        for (int j = 0; j < 4; ++j) o[j] = (dy[j] * rs * gain[j] + bias[j] + bs * (float)v4[j]) * gg[j];
        u32x2 w; w.x = pk_bf16(o[0], o[1]); w.y = pk_bf16(o[2], o[3]);
        *(u32x2*)(orw + (size_t)(b * SEQ + t - NMETA) * 512 + c) = w;
    }
}

__device__ __forceinline__ void phase4(const Params& p) {
    unsigned char* ws = p.ws;
    EpiBranch1 e1{(float*)(ws + O_T1), (const bf16_t*)p.out};
    EpiBranch2 e2{(const float*)(ws + O_T1), (const bf16_t*)p.out, (bf16_t*)(ws + O_M)};
    gemm_phase((const bf16_t*)(ws + O_OSB), (const bf16_t*)(ws + WS_WSB), 512, MS / BM, D / BM, e1);
    gemm_phase((const bf16_t*)(ws + O_ORW), (const bf16_t*)(ws + WS_WRW), 512, MS / BM, D / BM, e2);
}
__device__ __forceinline__ void phase5(const Params& p) {
    unsigned char* ws = p.ws;
    EpiF32 e{(float*)(ws + O_P)};
    gemm_phase((const bf16_t*)(ws + O_M), (const bf16_t*)(ws + WS_WOUT), D, MS / BM, D / BM, e);
}
__device__ __forceinline__ void phase6(const Params& p) {
    unsigned char* ws = p.ws;
    const int lane = threadIdx.x & 63;
    for (int it = blockIdx.x; it < MS / 8; it += gridDim.x) {
        const int row = it * 8 + (threadIdx.x >> 6);
        const float* pr = (const float*)(ws + O_P) + (size_t)row * D;
        const float* xr = p.in[0] + (size_t)row * D;
        f32x4 v[4]; float ss = 0.f;
#pragma unroll
        for (int j = 0; j < 4; ++j) { v[j] = *(const f32x4*)(pr + 4 * lane + 256 * j); ss += (v[j][0] * v[j][0] + v[j][1] * v[j][1]) + (v[j][2] * v[j][2] + v[j][3] * v[j][3]); }
        const float rs = rsqrtf(wave_sum(ss) * (1.0f / D) + RMS_EPS);
        float s2 = 0.f;
#pragma unroll
        for (int j = 0; j < 4; ++j) {
            const f32x4 g = *(const f32x4*)(p.in[3] + 4 * lane + 256 * j), x = *(const f32x4*)(xr + 4 * lane + 256 * j);
            v[j] = x + v[j] * rs * g;
            *(f32x4*)(p.out + (size_t)row * D + 4 * lane + 256 * j) = v[j];
            s2 += (v[j][0] * v[j][0] + v[j][1] * v[j][1]) + (v[j][2] * v[j][2] + v[j][3] * v[j][3]);
        }
        const float rs2 = rsqrtf(wave_sum(s2) * (1.0f / D) + RMS_EPS);
        bf16_t* fr_ = (bf16_t*)(ws + O_F) + (size_t)row * D;
#pragma unroll
        for (int j = 0; j < 4; ++j) {
            const f32x4 g = *(const f32x4*)(p.in[19] + 4 * lane + 256 * j);
            u32x2 w; w.x = pk_bf16(v[j][0] * rs2 * g[0], v[j][1] * rs2 * g[1]); w.y = pk_bf16(v[j][2] * rs2 * g[2], v[j][3] * rs2 * g[3]);
            *(u32x2*)(fr_ + 4 * lane + 256 * j) = w;
        }
    }
}
__device__ __forceinline__ void phase7(const Params& p) {
    unsigned char* ws = p.ws;
    EpiGU e{(bf16_t*)(ws + O_ACT)};
    gemm_phase((const bf16_t*)(ws + O_F), (const bf16_t*)(ws + WS_WGU), D, MS / BM, 2 * DFF / BM, e);
}
__device__ __forceinline__ void phase8(const Params& p) {
    unsigned char* ws = p.ws;
    EpiF32 e{(float*)(ws + O_DN)};
    gemm_phase((const bf16_t*)(ws + O_ACT), (const bf16_t*)(ws + WS_WD), DFF, MS / BM, D / BM, e);
}
__device__ __forceinline__ void phase9(const Params& p) {
    unsigned char* ws = p.ws;
    const int lane = threadIdx.x & 63;
    for (int it = blockIdx.x; it < MS / 8; it += gridDim.x) {
        const int row = it * 8 + (threadIdx.x >> 6);
        const float* dr = (const float*)(ws + O_DN) + (size_t)row * D;
        f32x4 v[4]; float ss = 0.f;
#pragma unroll
        for (int j = 0; j < 4; ++j) { v[j] = *(const f32x4*)(dr + 4 * lane + 256 * j); ss += (v[j][0] * v[j][0] + v[j][1] * v[j][1]) + (v[j][2] * v[j][2] + v[j][3] * v[j][3]); }
        const float rs = rsqrtf(wave_sum(ss) * (1.0f / D) + RMS_EPS);
#pragma unroll
        for (int j = 0; j < 4; ++j) {
            const f32x4 g = *(const f32x4*)(p.in[20] + 4 * lane + 256 * j);
            float* o = p.out + (size_t)row * D + 4 * lane + 256 * j;
            const f32x4 h1 = *(const f32x4*)o;
            *(f32x4*)o = h1 + v[j] * rs * g;
        }
    }
}

constexpr int N_PHASES = 11;
__device__ __forceinline__ void run_phase(const Params& p, int ph) {
    switch (ph) {
        case 0: phase0(p); break;
        case 1: phase1(p); break;
        case 2: phase2(p); break;
        case 3: phase3(p); break;
        case 4: phase3c(p); break;
        case 5: phase4(p); break;
        case 6: phase5(p); break;
        case 7: phase6(p); break;
        case 8: phase7(p); break;
        case 9: phase8(p); break;
        default: phase9(p); break;
    }
}

#if MULTI_LAUNCH
template <int PH> __global__ void __launch_bounds__(512) fwd_phase(Params p) { run_phase(p, PH); }
#else
__global__ void __launch_bounds__(512) fwd_mega(Params p) {
    cg::grid_group grid = cg::this_grid();
    for (int ph = 0; ph < N_PHASES; ++ph) {
        if (ph) grid.sync();
        run_phase(p, ph);
    }
}
#endif

extern "C" void kernel_launch(void* const* d_in, const int* in_sizes, int n_in, void* d_out, int out_size, void* d_ws, size_t ws_size, hipStream_t stream) {
    static int grid = 0;
    if (grid == 0) {
        if (n_in != 24 || out_size != MS * D || ws_size < WS_END) { fprintf(stderr, "kernel_launch: unexpected shapes (n_in %d out %d ws %zu need %zu)\n", n_in, out_size, ws_size, (size_t)WS_END); grid = -1; return; }
        int dev = 0, cus = 0, per_cu = 0;
        (void)hipGetDevice(&dev);
        (void)hipDeviceGetAttribute(&cus, hipDeviceAttributeMultiprocessorCount, dev);
#if MULTI_LAUNCH
        per_cu = 1;
#else
        (void)hipFuncSetAttribute((const void*)fwd_mega, hipFuncAttributeMaxDynamicSharedMemorySize, LDS_BYTES);
        (void)hipOccupancyMaxActiveBlocksPerMultiprocessor(&per_cu, (const void*)fwd_mega, 512, LDS_BYTES);
        if (per_cu < 1) { fprintf(stderr, "kernel_launch: occupancy query says %d blocks per CU\n", per_cu); per_cu = 1; }
        if (per_cu > 1) per_cu = 1;
#endif
        grid = cus * per_cu;
    }
    if (grid < 0) return;
    Params p{};
    for (int i = 0; i < 24; ++i) p.in[i] = (const float*)d_in[i];
    p.out = (float*)d_out; p.ws = (unsigned char*)d_ws;
#if MULTI_LAUNCH
#define LP(PH) do { (void)hipFuncSetAttribute((const void*)fwd_phase<PH>, hipFuncAttributeMaxDynamicSharedMemorySize, LDS_BYTES); hipLaunchKernelGGL(fwd_phase<PH>, dim3(grid), dim3(512), LDS_BYTES, stream, p); } while (0)
    LP(0); LP(1); LP(2); LP(3); LP(4); LP(5); LP(6); LP(7); LP(8); LP(9); LP(10);
#undef LP
#else
    void* args[] = {&p};
    hipError_t e = hipLaunchCooperativeKernel((const void*)fwd_mega, dim3(grid), dim3(512), args, LDS_BYTES, stream);
    if (e != hipSuccess) fprintf(stderr, "cooperative launch failed: %s (grid %d)\n", hipGetErrorString(e), grid);
#endif
}
```

```cpp
#include <hip/hip_runtime.h>
#include <hip/hip_cooperative_groups.h>
#include <cstdio>
#include <cstdint>
namespace cg = cooperative_groups;

#ifndef MULTI_LAUNCH
#define MULTI_LAUNCH 0
#endif

typedef unsigned short bf16_t;
typedef short bf16x8 __attribute__((ext_vector_type(8)));
typedef float f32x4 __attribute__((ext_vector_type(4)));
typedef float f32x2 __attribute__((ext_vector_type(2)));
typedef unsigned u32x2 __attribute__((ext_vector_type(2)));
typedef unsigned u32x4 __attribute__((ext_vector_type(4)));
typedef _Float16 h16x2 __attribute__((ext_vector_type(2)));
typedef _Float16 h16x4 __attribute__((ext_vector_type(4)));
typedef _Float16 h16x8 __attribute__((ext_vector_type(8)));

constexpr int D = 1024, NB = 4, SEQ = 8192, NMETA = 16, T = SEQ + NMETA, TP = 8320, MP = NB * TP, MS = NB * SEQ;
constexpr int PIN = 5376, DFF = 2816, NH = 8, RWS = 1792;
constexpr float RMS_EPS = 1e-6f, GN_EPS = 64e-5f;

constexpr size_t WS_CTL = 0;
constexpr size_t WS_WIN = 4096;
constexpr size_t WS_WSB = WS_WIN + (size_t)PIN * D * 2;
constexpr size_t WS_WRW = WS_WSB + (size_t)D * 512 * 2;
constexpr size_t WS_WOUT = WS_WRW + (size_t)D * 512 * 2;
constexpr size_t WS_WGU = WS_WOUT + (size_t)D * D * 2;
constexpr size_t WS_WD = WS_WGU + (size_t)2 * DFF * D * 2;
constexpr size_t WS_WL = WS_WD + (size_t)D * DFF * 2;
constexpr size_t R_QKV = WS_WL + (size_t)512 * 256 * 2;
constexpr size_t QKV_ONE = (size_t)MP * 512 * 2;
constexpr size_t R_URW = R_QKV + 3 * QKV_ONE;
constexpr size_t R_SI = R_URW + (size_t)MP * RWS * 2;
constexpr size_t SI_ONE = (size_t)MP * 512 * 2;
constexpr size_t R_G = R_SI + 6 * SI_ONE;
constexpr size_t WS_END = R_G + SI_ONE;
constexpr size_t O_A0 = R_SI;
constexpr size_t O_Y = R_URW;
constexpr size_t O_OSB = R_URW + (size_t)MP * 512 * 4;
constexpr size_t O_ORW = R_QKV;
constexpr size_t O_T1 = R_SI;
constexpr size_t O_M = R_SI + (size_t)MS * D * 4;
constexpr size_t O_P = R_QKV;
constexpr size_t O_F = R_SI;
constexpr size_t O_ACT = R_QKV;
constexpr size_t O_DN = R_SI + (size_t)MS * D * 2;
static_assert(O_OSB + (size_t)MS * 512 * 2 <= R_SI, "overlay");
static_assert(O_M + (size_t)MS * D * 2 <= WS_END, "overlay");
static_assert(O_ACT + (size_t)MS * DFF * 2 <= R_SI, "overlay");
static_assert(O_DN + (size_t)MS * D * 4 <= WS_END, "overlay");
static_assert(WS_END <= (size_t)512 * 1024 * 1024, "workspace");

constexpr int LDS_BYTES = 131072;

struct Params { const float* in[24]; float* out; unsigned char* ws; };

extern __shared__ __attribute__((aligned(16))) unsigned char smem[];

__device__ __forceinline__ unsigned pk_bf16(float lo, float hi) { unsigned r; asm volatile("v_cvt_pk_bf16_f32 %0, %1, %2" : "=v"(r) : "v"(lo), "v"(hi)); return r; }
__device__ __forceinline__ float bf2f(unsigned short v) { return __uint_as_float((unsigned)v << 16); }
__device__ __forceinline__ float sigmoidf_(float x) { return 1.0f / (1.0f + __expf(-x)); }
__device__ __forceinline__ float softplusf_(float x) { return fmaxf(x, 0.f) + __logf(1.0f + __expf(-fabsf(x))); }
template <int CTRL> __device__ __forceinline__ float dppf(float x) { return __builtin_bit_cast(float, __builtin_amdgcn_mov_dpp(__builtin_bit_cast(int, x), CTRL, 0xf, 0xf, true)); }
__device__ __forceinline__ float reduce16(float v) {
    v += dppf<0xB1>(v); v += dppf<0x4E>(v); v += dppf<0x141>(v); v += dppf<0x140>(v); return v;
}
__device__ __forceinline__ float wave_sum(float v) {
#pragma unroll
    for (int o = 1; o < 64; o <<= 1) v += __shfl_xor(v, o);
    return v;
}

#define LAS __attribute__((address_space(3)))
constexpr int BM = 256, BK = 64, HALF = 128, HTB = HALF * BK * 2, NXCD = 8, WGM = 8;
__device__ __forceinline__ int lds_byte(int r, int c) { const int st = (r >> 4) * 2 + (c >> 5), rr = r & 15, cc = c & 31, ob = rr * 64 + cc * 2; return st * 1024 + (ob ^ (((ob >> 9) & 1) << 5)); }
__device__ __forceinline__ void stage_rc(int b, int& R, int& C) { const int st = b / 1024, sb = b % 1024, swz = sb ^ (((sb >> 9) & 1) << 5); R = (st >> 1) * 16 + swz / 64; C = (st & 1) * 32 + (swz % 64) / 2; }
struct Unit { int pm, pn; };
struct Sched {
    int nM, nN, nwg, G, c;
    __device__ __forceinline__ bool next(int i, Unit& u) const {
        const long L = (long)i * G + c; if (L >= nwg) return false;
        int wgid = (int)L; { const int q = nwg / NXCD, r = nwg % NXCD, xcd = wgid % NXCD, off = wgid / NXCD; wgid = (xcd < r ? xcd * (q + 1) : r * (q + 1) + (xcd - r) * q) + off; }
        const int nig = WGM * nN, gid = wgid / nig, fm = gid * WGM, gsz = (nM - fm) < WGM ? (nM - fm) : WGM;
        u.pm = fm + ((wgid % nig) % gsz); u.pn = (wgid % nig) / gsz; return true;
    }
};

template <class Epi>
__device__ __forceinline__ void gemm_phase(const bf16_t* __restrict__ Ag, const bf16_t* __restrict__ Btg, const int K, const int nM, const int nN, const Epi& E) {
    LAS unsigned char* lds = (LAS unsigned char*)smem;
    const int tid = threadIdx.x, wid = __builtin_amdgcn_readfirstlane(tid >> 6), lane = tid & 63, wr = wid >> 2, wc = wid & 3, fr = lane & 15, fq = lane >> 4;
    const int nt = K / BK;
    Sched S; S.nM = nM; S.nN = nN; S.nwg = nM * nN; S.G = gridDim.x; S.c = blockIdx.x;
    unsigned voffA[2], voffB[2];
#pragma unroll
    for (int i = 0; i < 2; ++i) { int R, C; stage_rc(tid * 16 + i * 8192, R, C); voffA[i] = (unsigned)(R * K + C) * 2u; voffB[i] = voffA[i]; }
    const size_t kstep = (size_t)(BK * 2);
    const size_t hstep = (size_t)HALF * K * 2;
    const size_t tstep = 2 * hstep;
    const unsigned ldsw = (unsigned)wid * 1024u;
    const int aoff = lds_byte(wr * 64 + fr, fq * 8), boff = lds_byte(wc * 32 + fr, fq * 8);
#define PG8_SA(b, h) (((b) * 2 + (h)) * HTB)
#define PG8_SB(b, h) ((4 + (b) * 2 + (h)) * HTB)
#define PG8_STAGE(bufoff, gbase, voff) do { _Pragma("unroll") for (int _i = 0; _i < 2; ++_i) \
        __builtin_amdgcn_global_load_lds((const unsigned*)((const char*)(gbase) + (voff)[_i]), (LAS unsigned*)(lds + (bufoff) + ldsw + _i * 8192), 16, 0, 0); } while (0)
#define PG8_LDA(dst, b, h) do { _Pragma("unroll") for (int m = 0; m < 4; ++m) _Pragma("unroll") for (int k = 0; k < 2; ++k) dst[m][k] = *(const LAS bf16x8*)(lds + PG8_SA(b, h) + aoff + m * 2048 + k * 1024); } while (0)
#define PG8_LDB(dst, b, h) do { _Pragma("unroll") for (int n = 0; n < 2; ++n) _Pragma("unroll") for (int k = 0; k < 2; ++k) dst[n][k] = *(const LAS bf16x8*)(lds + PG8_SB(b, h) + boff + n * 2048 + k * 1024); } while (0)
#define PG8_MMA(ai, bj, At, Bt) do { __builtin_amdgcn_s_setprio(1); _Pragma("unroll") for (int m = 0; m < 4; ++m) _Pragma("unroll") for (int n = 0; n < 2; ++n) _Pragma("unroll") for (int k = 0; k < 2; ++k) \
        acc[ai][bj][m][n] = __builtin_amdgcn_mfma_f32_16x16x32_bf16(Bt[n][k], At[m][k], acc[ai][bj][m][n], 0, 0, 0); __builtin_amdgcn_s_setprio(0); } while (0)
#define PG8_WAIT_V(n) asm volatile("s_waitcnt vmcnt(" #n ")" ::: "memory")
#define PG8_WAIT_L(n) asm volatile("s_waitcnt lgkmcnt(" #n ")" ::: "memory")
#define PG8_BAR __builtin_amdgcn_s_barrier()
#define PG8_SCHED __builtin_amdgcn_sched_barrier(0)
    Unit cur, nxt; int ui = 0;
    __syncthreads();
    if (!S.next(0, cur)) return;
    f32x4 acc[2][2][4][2];
#pragma unroll
    for (int a = 0; a < 2; ++a)
#pragma unroll
        for (int b = 0; b < 2; ++b)
#pragma unroll
            for (int m = 0; m < 4; ++m)
#pragma unroll
                for (int n = 0; n < 2; ++n) acc[a][b][m][n] = (f32x4){0.f, 0.f, 0.f, 0.f};
    bf16x8 At[4][2], B0[2][2], B1[2][2];
    const char* cA = (const char*)Ag + (size_t)cur.pm * tstep; const char* cB = (const char*)Btg + (size_t)cur.pn * tstep;
    PG8_STAGE(PG8_SB(0, 0), cB, voffB); PG8_STAGE(PG8_SA(0, 0), cA, voffA); PG8_STAGE(PG8_SB(0, 1), cB + hstep, voffB); PG8_STAGE(PG8_SA(0, 1), cA + hstep, voffA);
    if (wr == 1) PG8_BAR;
    PG8_WAIT_V(4); PG8_BAR;
    PG8_STAGE(PG8_SB(1, 0), cB + kstep, voffB); PG8_STAGE(PG8_SA(1, 0), cA + kstep, voffA); PG8_STAGE(PG8_SB(1, 1), cB + hstep + kstep, voffB);
    PG8_WAIT_V(6); PG8_BAR;
    for (;;) {
        const bool has_next = S.next(ui + 1, nxt);
        const char* nA = has_next ? (const char*)Ag + (size_t)nxt.pm * tstep : cA; const char* nB = has_next ? (const char*)Btg + (size_t)nxt.pn * tstep : cB;
        for (int t = 0; t < nt; t += 2) {
            const bool last = (t == nt - 2);
            const char* a1 = cA + (size_t)(t + 1) * kstep;
            const char* a2 = last ? nA : cA + (size_t)(t + 2) * kstep; const char* b2 = last ? nB : cB + (size_t)(t + 2) * kstep;
            const char* a3 = a2 + kstep; const char* b3 = b2 + kstep;
            PG8_LDB(B0, 0, 0); PG8_SCHED; PG8_LDA(At, 0, 0); PG8_STAGE(PG8_SA(1, 1), a1 + hstep, voffA);
            PG8_WAIT_L(8); PG8_BAR; PG8_WAIT_L(0); PG8_MMA(0, 0, At, B0); PG8_BAR; PG8_SCHED;
            PG8_LDB(B1, 0, 1); PG8_STAGE(PG8_SB(0, 0), b2, voffB);
            PG8_BAR; PG8_WAIT_L(0); PG8_MMA(0, 1, At, B1); PG8_BAR;
            PG8_LDA(At, 0, 1); PG8_STAGE(PG8_SA(0, 0), a2, voffA);
            PG8_BAR; PG8_WAIT_L(0); PG8_MMA(1, 0, At, B0); PG8_BAR; PG8_SCHED;
            PG8_STAGE(PG8_SB(0, 1), b2 + hstep, voffB);
            PG8_WAIT_V(6); PG8_BAR; PG8_MMA(1, 1, At, B1); PG8_BAR;
            PG8_LDB(B0, 1, 0); PG8_SCHED; PG8_LDA(At, 1, 0); PG8_STAGE(PG8_SA(0, 1), a2 + hstep, voffA);
            PG8_WAIT_L(8); PG8_BAR; PG8_WAIT_L(0); PG8_MMA(0, 0, At, B0); PG8_BAR; PG8_SCHED;
            PG8_LDB(B1, 1, 1); PG8_STAGE(PG8_SB(1, 0), b3, voffB);
            PG8_BAR; PG8_WAIT_L(0); PG8_MMA(0, 1, At, B1); PG8_BAR;
            PG8_LDA(At, 1, 1); PG8_STAGE(PG8_SA(1, 0), a3, voffA);
            PG8_BAR; PG8_WAIT_L(0); PG8_MMA(1, 0, At, B0); PG8_BAR; PG8_SCHED;
            PG8_STAGE(PG8_SB(1, 1), b3 + hstep, voffB);
            PG8_WAIT_V(6); PG8_BAR; PG8_MMA(1, 1, At, B1); PG8_BAR;
        }
        {
            const int brow = cur.pm * BM, bcol = cur.pn * BM;
#pragma unroll
            for (int ai = 0; ai < 2; ++ai)
#pragma unroll
                for (int m = 0; m < 4; ++m) {
#pragma unroll
                    for (int bj = 0; bj < 2; ++bj)
                        E(brow + ai * HALF + wr * 64 + m * 16 + fr, bcol + bj * HALF + wc * 32, fq, acc[ai][bj][m][0], acc[ai][bj][m][1]);
                    asm volatile("" ::: "memory");
                }
        }
        if (!has_next) break;
#pragma unroll
        for (int a = 0; a < 2; ++a)
#pragma unroll
            for (int b = 0; b < 2; ++b)
#pragma unroll
                for (int m = 0; m < 4; ++m)
#pragma unroll
                    for (int n = 0; n < 2; ++n) acc[a][b][m][n] = (f32x4){0.f, 0.f, 0.f, 0.f};
        cur = nxt; cA = nA; cB = nB; ++ui;
    }
    PG8_WAIT_V(0);
    if (wr == 0) PG8_BAR;
    PG8_BAR;
#undef PG8_SA
#undef PG8_SB
#undef PG8_STAGE
#undef PG8_LDA
#undef PG8_LDB
#undef PG8_MMA
#undef PG8_WAIT_V
#undef PG8_WAIT_L
#undef PG8_BAR
#undef PG8_SCHED
}

struct EpiInProj {
    bf16_t* qkv; _Float16* urw; bf16_t* gates;
    __device__ __forceinline__ void one(int row, int col, const f32x4& v) const {
        if (col < 1536) {
            const int which = col >> 9, hc = col & 511, h = hc >> 6, d = hc & 63, b = row / TP, t = row - b * TP;
            const float s = which == 0 ? 0.125f : 1.0f;
            u32x2 w; w.x = pk_bf16(v[0] * s, v[1] * s); w.y = pk_bf16(v[2] * s, v[3] * s);
            *(u32x2*)(qkv + (size_t)which * (QKV_ONE / 2) + ((size_t)(b * NH + h) * TP + t) * 64 + d) = w;
        } else if (col < 3328) {
            h16x4 o; o[0] = (_Float16)v[0]; o[1] = (_Float16)v[1]; o[2] = (_Float16)v[2]; o[3] = (_Float16)v[3];
            *(h16x4*)(urw + (size_t)row * RWS + (col - 1536)) = o;
        } else {
            const int b = row / TP, t = row - b * TP;
            if (t >= NMETA && t < T) {
                u32x2 w; w.x = pk_bf16(sigmoidf_(v[0]), sigmoidf_(v[1])); w.y = pk_bf16(sigmoidf_(v[2]), sigmoidf_(v[3]));
                *(u32x2*)(gates + (size_t)(b * SEQ + t - NMETA) * 2048 + (col - 3328)) = w;
            }
        }
    }
    __device__ __forceinline__ void operator()(int row, int col32, int fq, const f32x4& v0, const f32x4& v1) const { one(row, col32 + 4 * fq, v0); one(row, col32 + 16 + 4 * fq, v1); }
};
struct EpiBranch1 {
    float* t1; const bf16_t* gates;
    __device__ __forceinline__ void one(int row, int col, const f32x4& v) const {
        const u32x2 g = *(const u32x2*)(gates + (size_t)row * 2048 + col);
        f32x4 o; o[0] = v[0] * __uint_as_float(g.x << 16); o[1] = v[1] * __uint_as_float(g.x & 0xffff0000u); o[2] = v[2] * __uint_as_float(g.y << 16); o[3] = v[3] * __uint_as_float(g.y & 0xffff0000u);
        *(f32x4*)(t1 + (size_t)row * D + col) = o;
    }
    __device__ __forceinline__ void operator()(int row, int col32, int fq, const f32x4& v0, const f32x4& v1) const { one(row, col32 + 4 * fq, v0); one(row, col32 + 16 + 4 * fq, v1); }
};
struct EpiBranch2 {
    const float* t1; const bf16_t* gates; bf16_t* m;
    __device__ __forceinline__ void one(int row, int col, const f32x4& v) const {
        const u32x2 g = *(const u32x2*)(gates + (size_t)row * 2048 + 1024 + col);
        const f32x4 a = *(const f32x4*)(t1 + (size_t)row * D + col);
        f32x4 o; o[0] = a[0] + v[0] * __uint_as_float(g.x << 16); o[1] = a[1] + v[1] * __uint_as_float(g.x & 0xffff0000u); o[2] = a[2] + v[2] * __uint_as_float(g.y << 16); o[3] = a[3] + v[3] * __uint_as_float(g.y & 0xffff0000u);
        u32x2 w; w.x = pk_bf16(o[0], o[1]); w.y = pk_bf16(o[2], o[3]);
        *(u32x2*)(m + (size_t)row * D + col) = w;
    }
    __device__ __forceinline__ void operator()(int row, int col32, int fq, const f32x4& v0, const f32x4& v1) const { one(row, col32 + 4 * fq, v0); one(row, col32 + 16 + 4 * fq, v1); }
};
struct EpiF32 {
    float* o;
    __device__ __forceinline__ void operator()(int row, int col32, int fq, const f32x4& v0, const f32x4& v1) const {
        *(f32x4*)(o + (size_t)row * D + col32 + 4 * fq) = v0; *(f32x4*)(o + (size_t)row * D + col32 + 16 + 4 * fq) = v1;
    }
};
struct EpiGU {
    bf16_t* act;
    __device__ __forceinline__ void operator()(int row, int col32, int fq, const f32x4& v0, const f32x4& v1) const {
        float o[4];
#pragma unroll
        for (int j = 0; j < 4; ++j) o[j] = v0[j] * sigmoidf_(v0[j]) * v1[j];
        u32x2 w; w.x = pk_bf16(o[0], o[1]); w.y = pk_bf16(o[2], o[3]);
        *(u32x2*)(act + (size_t)row * DFF + (col32 >> 5) * 16 + 4 * fq) = w;
    }
};

__device__ __forceinline__ void transpose_tile(const float* __restrict__ src, int K, int N, bf16_t* __restrict__ dst, int ldd, int koff, int mode, int tile) {
    float* scr = (float*)smem;
    const int ntn = N / 64, kb = tile / ntn, nb = tile % ntn, k0 = kb * 64, n0 = nb * 64, tid = threadIdx.x;
#pragma unroll
    for (int i = 0; i < 8; ++i) { const int kk = (tid >> 6) + 8 * i; scr[kk * 65 + (tid & 63)] = src[(size_t)(k0 + kk) * N + n0 + (tid & 63)]; }
    __syncthreads();
    const int n = tid >> 3, kc = (tid & 7) * 8;
    u32x4 o;
    o.x = pk_bf16(scr[(kc + 0) * 65 + n], scr[(kc + 1) * 65 + n]); o.y = pk_bf16(scr[(kc + 2) * 65 + n], scr[(kc + 3) * 65 + n]);
    o.z = pk_bf16(scr[(kc + 4) * 65 + n], scr[(kc + 5) * 65 + n]); o.w = pk_bf16(scr[(kc + 6) * 65 + n], scr[(kc + 7) * 65 + n]);
    const int f = n0 + n;
    const int drow = mode == 0 ? f : ((f >> 4) * 32 + (mode == 2 ? 16 : 0) + (f & 15));
    *(u32x4*)(dst + (size_t)drow * ldd + koff + k0 + kc) = o;
    __syncthreads();
}

__device__ __forceinline__ void phase0(const Params& p) {
    unsigned char* ws = p.ws;
    if (blockIdx.x == 0 && threadIdx.x < 64) ((unsigned*)(ws + WS_CTL))[threadIdx.x] = 0u;
    constexpr int J0 = 16 * 84, J1 = 8 * 16, J3 = 16 * 16, J4 = 16 * 44, J6 = 44 * 16, J7 = 8, J9 = 16;
    constexpr int NT = J0 + 2 * J1 + J3 + 2 * J4 + J6 + 2 * J7 + J9;
    constexpr int NR = MP / 8;
    for (int it = blockIdx.x; it < NT + NR; it += gridDim.x) {
        if (it < NT) {
            int r = it;
            if (r < J0) { transpose_tile(p.in[4], D, PIN, (bf16_t*)(ws + WS_WIN), D, 0, 0, r); continue; } r -= J0;
            if (r < J1) { transpose_tile(p.in[16], 512, D, (bf16_t*)(ws + WS_WSB), 512, 0, 0, r); continue; } r -= J1;
            if (r < J1) { transpose_tile(p.in[17], 512, D, (bf16_t*)(ws + WS_WRW), 512, 0, 0, r); continue; } r -= J1;
            if (r < J3) { transpose_tile(p.in[18], D, D, (bf16_t*)(ws + WS_WOUT), D, 0, 0, r); continue; } r -= J3;
            if (r < J4) { transpose_tile(p.in[21], D, DFF, (bf16_t*)(ws + WS_WGU), D, 0, 1, r); continue; } r -= J4;
            if (r < J4) { transpose_tile(p.in[22], D, DFF, (bf16_t*)(ws + WS_WGU), D, 0, 2, r); continue; } r -= J4;
            if (r < J6) { transpose_tile(p.in[23], DFF, D, (bf16_t*)(ws + WS_WD), DFF, 0, 0, r); continue; } r -= J6;
            if (r < J7) { transpose_tile(p.in[6], 64, 512, (bf16_t*)(ws + WS_WL), 256, 0, 0, r); continue; } r -= J7;
            if (r < J7) { transpose_tile(p.in[8], 64, 512, (bf16_t*)(ws + WS_WL), 256, 64, 0, r); continue; } r -= J7;
            transpose_tile(p.in[10], 128, 512, (bf16_t*)(ws + WS_WL), 256, 128, 0, r);
        } else {
            const int row = (it - NT) * 8 + (threadIdx.x >> 6), lane = threadIdx.x & 63;
            const int b = row / TP, t = row - b * TP;
            bf16_t* orow = (bf16_t*)(ws + O_A0) + (size_t)row * D;
            if (t >= T) {
#pragma unroll
                for (int j = 0; j < 4; ++j) *(u32x2*)(orow + 4 * lane + 256 * j) = (u32x2){0u, 0u};
            } else {
                const float* src = t < NMETA ? p.in[1] + (size_t)t * D : p.in[0] + ((size_t)b * SEQ + (t - NMETA)) * D;
                f32x4 v[4]; float ss = 0.f;
#pragma unroll
                for (int j = 0; j < 4; ++j) { v[j] = *(const f32x4*)(src + 4 * lane + 256 * j); ss += (v[j][0] * v[j][0] + v[j][1] * v[j][1]) + (v[j][2] * v[j][2] + v[j][3] * v[j][3]); }
                const float rs = rsqrtf(wave_sum(ss) * (1.0f / D) + RMS_EPS);
#pragma unroll
                for (int j = 0; j < 4; ++j) {
                    const f32x4 g = *(const f32x4*)(p.in[2] + 4 * lane + 256 * j);
                    u32x2 w; w.x = pk_bf16(v[j][0] * rs * g[0], v[j][1] * rs * g[1]); w.y = pk_bf16(v[j][2] * rs * g[2], v[j][3] * rs * g[3]);
                    *(u32x2*)(orow + 4 * lane + 256 * j) = w;
                }
            }
        }
    }
}

__device__ __forceinline__ void phase1(const Params& p) {
    unsigned char* ws = p.ws;
    EpiInProj epi{(bf16_t*)(ws + R_QKV), (_Float16*)(ws + R_URW), (bf16_t*)p.out};
    gemm_phase((const bf16_t*)(ws + O_A0), (const bf16_t*)(ws + WS_WIN), D, MP / BM, PIN / BM, epi);
}

constexpr int SI_R = 0, SI_W = 1, SI_K = 2, SI_V = 3, SI_KK = 4, SI_B = 5;
constexpr int ALD = 264;
__device__ __forceinline__ void phase2_tile(const Params& p, int tile) {
    unsigned char* ws = p.ws;
    const int tid = threadIdx.x, wave = tid >> 6, lane = tid & 63, fr = lane & 15, fq = lane >> 4;
    const int row0 = tile * 64;
    const _Float16* urw = (const _Float16*)(ws + R_URW);
    const float* mu = p.in[5];
    bf16_t* Al = (bf16_t*)smem;
    __syncthreads();
    {
        const int tk = tid >> 3, cgp = (tid & 7) * 32, row = row0 + tk, t = row % TP;
        const _Float16* cur = urw + (size_t)row * RWS + 1536 + cgp;
        const int kind = cgp < 64 ? 0 : (cgp < 128 ? 1 : 2);
#pragma unroll
        for (int q = 0; q < 4; ++q) {
            const h16x8 c = *(const h16x8*)(cur + q * 8);
            h16x8 pv = c;
            if (t > 0) pv = *(const h16x8*)(cur - RWS + q * 8);
            float o[8];
#pragma unroll
            for (int e = 0; e < 8; ++e) {
                const float cf = (float)c[e], pf = t > 0 ? (float)pv[e] : 0.f;
                const float xs = cf + mu[1536 + cgp + q * 8 + e] * (pf - cf);
                float val;
                if (kind == 0) { const float ex = __expf(2.f * xs); val = 1.f - 2.f / (ex + 1.f); }
                else if (kind == 1) val = xs;
                else val = sigmoidf_(xs);
                o[e] = val;
            }
            u32x4 w; w.x = pk_bf16(o[0], o[1]); w.y = pk_bf16(o[2], o[3]); w.z = pk_bf16(o[4], o[5]); w.w = pk_bf16(o[6], o[7]);
            *(u32x4*)(Al + tk * ALD + cgp + q * 8) = w;
        }
    }
    __syncthreads();
    const int h = wave;
    const bf16_t* WL = (const bf16_t*)(ws + WS_WL);
    _Float16* SI = (_Float16*)(ws + R_SI);
    bf16_t* G = (bf16_t*)(ws + R_G);
    constexpr size_t SIE = (size_t)MP * 512;
#pragma unroll 1
    for (int m = 0; m < 4; ++m) {
        f32x4 acc[4];
        auto lora = [&](int kbeg, int ksteps) {
#pragma unroll
            for (int n = 0; n < 4; ++n) acc[n] = (f32x4){0.f, 0.f, 0.f, 0.f};
#pragma unroll 1
            for (int ks = 0; ks < ksteps; ++ks) {
                const bf16x8 af = *(const bf16x8*)(Al + (m * 16 + fr) * ALD + kbeg + ks * 32 + fq * 8);
#pragma unroll
                for (int n = 0; n < 4; ++n) {
                    const bf16x8 wf = *(const bf16x8*)(WL + (size_t)(h * 64 + n * 16 + fr) * 256 + kbeg + ks * 32 + fq * 8);
                    acc[n] = __builtin_amdgcn_mfma_f32_16x16x32_bf16(wf, af, acc[n], 0, 0, 0);
                }
            }
        };
        const int row = row0 + m * 16 + fr, b = row / TP, t = row - b * TP;
        const size_t base = ((size_t)(b * NH + h) * TP + t) * 64;
        const _Float16* ur = urw + (size_t)row * RWS;
        lora(0, 2);
#pragma unroll
        for (int n = 0; n < 4; ++n) {
            const int c = n * 16 + fq * 4;
            const f32x4 db = *(const f32x4*)(p.in[7] + h * 64 + c);
            h16x4 o;
#pragma unroll
            for (int j = 0; j < 4; ++j) {
                const float wl = -softplusf_(-(db[j] + acc[n][j])) - 0.5f;
                const float e = __expf(wl);
                o[j] = (_Float16)(1.0f - __expf(-e));
            }
            *(h16x4*)(SI + SI_W * SIE + base + c) = o;
        }
        lora(64, 2);
        {
            float kv[4][4], av[4][4], kkr[4][4]; float ss = 0.f;
#pragma unroll
            for (int n = 0; n < 4; ++n) {
                const int c = n * 16 + fq * 4, c512 = h * 64 + c;
                const h16x4 kc = *(const h16x4*)(ur + 512 + c512), rc = *(const h16x4*)(ur + c512), vc = *(const h16x4*)(ur + 1024 + c512);
                h16x4 kp = kc, rp = rc, vp = vc;
                if (t > 0) { kp = *(const h16x4*)(ur - RWS + 512 + c512); rp = *(const h16x4*)(ur - RWS + c512); vp = *(const h16x4*)(ur - RWS + 1024 + c512); }
                const f32x4 muk = *(const f32x4*)(mu + 512 + c512), mur = *(const f32x4*)(mu + c512), muv = *(const f32x4*)(mu + 1024 + c512);
                const f32x4 ab = *(const f32x4*)(p.in[9] + c512), kkw = *(const f32x4*)(p.in[11] + c512);
                h16x4 ro, vo;
#pragma unroll
                for (int j = 0; j < 4; ++j) {
                    const float kcf = (float)kc[j], kpf = t > 0 ? (float)kp[j] : 0.f;
                    const float rcf = (float)rc[j], rpf = t > 0 ? (float)rp[j] : 0.f;
                    const float vcf = (float)vc[j], vpf = t > 0 ? (float)vp[j] : 0.f;
                    kv[n][j] = kcf + muk[j] * (kpf - kcf);
                    ro[j] = (_Float16)(rcf + mur[j] * (rpf - rcf));
                    vo[j] = (_Float16)(vcf + muv[j] * (vpf - vcf));
                    av[n][j] = sigmoidf_(ab[j] + acc[n][j]);
                    kkr[n][j] = kv[n][j] * kkw[j];
                    ss += kkr[n][j] * kkr[n][j];
                }
                *(h16x4*)(SI + SI_R * SIE + base + c) = ro;
                *(h16x4*)(SI + SI_V * SIE + base + c) = vo;
            }
            ss += __shfl_xor(ss, 16); ss += __shfl_xor(ss, 32);
            const float inv = 1.0f / fmaxf(sqrtf(ss), 1e-12f);
#pragma unroll
            for (int n = 0; n < 4; ++n) {
                const int c = n * 16 + fq * 4, c512 = h * 64 + c;
                const f32x4 ka = *(const f32x4*)(p.in[12] + c512);
                h16x4 ko, kko, bo;
#pragma unroll
                for (int j = 0; j < 4; ++j) {
                    const float kk = kkr[n][j] * inv;
                    ko[j] = (_Float16)(kv[n][j] * (1.0f + (av[n][j] - 1.0f) * ka[j]));
                    kko[j] = (_Float16)kk;
                    bo[j] = (_Float16)(kk * av[n][j]);
                }
                *(h16x4*)(SI + SI_K * SIE + base + c) = ko;
                *(h16x4*)(SI + SI_KK * SIE + base + c) = kko;
                *(h16x4*)(SI + SI_B * SIE + base + c) = bo;
            }
        }
        lora(128, 4);
#pragma unroll
        for (int n = 0; n < 4; ++n) {
            u32x2 w; w.x = pk_bf16(acc[n][0], acc[n][1]); w.y = pk_bf16(acc[n][2], acc[n][3]);
            *(u32x2*)(G + base + n * 16 + fq * 4) = w;
        }
    }
}
__device__ __forceinline__ void phase2_kmax(const Params& p, int item) {
    unsigned char* ws = p.ws;
    const int bh = item / 17, ch = item % 17, tid = threadIdx.x;
    const int t = ch * 512 + tid;
    float ss = 0.f;
    if (t < T) {
        const bf16_t* kr = (const bf16_t*)(ws + R_QKV) + QKV_ONE / 2 + ((size_t)bh * TP + t) * 64;
#pragma unroll
        for (int q = 0; q < 8; ++q) {
            const u32x4 v = *(const u32x4*)(kr + q * 8);
#pragma unroll
            for (int e = 0; e < 4; ++e) { const float lo = __uint_as_float(v[e] << 16), hi = __uint_as_float(v[e] & 0xffff0000u); ss += lo * lo + hi * hi; }
        }
    }
#pragma unroll
    for (int o = 1; o < 64; o <<= 1) ss = fmaxf(ss, __shfl_xor(ss, o));
    if ((tid & 63) == 0) atomicMax((unsigned*)(ws + WS_CTL) + 16 + bh, __float_as_uint(ss));
}
__device__ __forceinline__ void phase2(const Params& p) {
    constexpr int NTILE = MP / 64, NK = 32 * 17;
    for (int it = blockIdx.x; it < NTILE + NK; it += gridDim.x) {
        if (it < NTILE) phase2_tile(p, it); else phase2_kmax(p, it - NTILE);
    }
}

constexpr int SC_TC = 32, SC_NC = (T + SC_TC - 1) / SC_TC;
constexpr int SC_BUF = (5 * SC_TC * 64 + SC_TC * 16) * 4;
constexpr int SC_YOFF = 2 * SC_BUF, SC_YBUF = SC_TC * 16 * 4;
__device__ __forceinline__ void scan_unit(const Params& p, int unit) {
    unsigned char* ws = p.ws;
    const int bh = unit >> 2, vr0 = (unit & 3) * 16, tid = threadIdx.x, wave = tid >> 6, lane = tid & 63;
    const _Float16* SI = (const _Float16*)(ws + R_SI);
    constexpr size_t SIE = (size_t)MP * 512;
    float* Y = (float*)(ws + O_Y);
    const size_t hb = (size_t)bh * TP * 64;
    __syncthreads();
    if (wave >= 4) {
        const int i = tid - 256;
        const int arrs[5] = {SI_R, SI_W, SI_K, SI_KK, SI_B};
        u32x4 rg[5]; unsigned rv;
        auto issue = [&](int c) {
            const size_t off = hb + (size_t)c * SC_TC * 64;
#pragma unroll
            for (int a = 0; a < 5; ++a) rg[a] = *(const u32x4*)(SI + arrs[a] * SIE + off + i * 8);
            rv = *(const unsigned*)(SI + SI_V * SIE + off + (i >> 3) * 64 + vr0 + (i & 7) * 2);
        };
        auto commit = [&](int bufi) {
            float* buf = (float*)(smem + bufi * SC_BUF);
#pragma unroll
            for (int a = 0; a < 5; ++a) {
                const h16x8 hv = __builtin_bit_cast(h16x8, rg[a]);
                f32x4 lo, hi;
#pragma unroll
                for (int e = 0; e < 4; ++e) { lo[e] = (float)hv[e]; hi[e] = (float)hv[4 + e]; }
                if (a == 1) { lo = 1.0f - lo; hi = 1.0f - hi; }
                *(f32x4*)(buf + a * (SC_TC * 64) + i * 8) = lo; *(f32x4*)(buf + a * (SC_TC * 64) + i * 8 + 4) = hi;
            }
            const h16x2 v2 = __builtin_bit_cast(h16x2, rv);
            f32x2 vf; vf[0] = (float)v2[0]; vf[1] = (float)v2[1];
            *(f32x2*)(buf + 5 * (SC_TC * 64) + (i >> 3) * 16 + (i & 7) * 2) = vf;
        };
        auto yout = [&](int c) {
            const float* yb = (const float*)(smem + SC_YOFF + (c & 1) * SC_YBUF);
            const f32x2 v = *(const f32x2*)(yb + (i >> 3) * 16 + (i & 7) * 2);
            *(f32x2*)(Y + hb + (size_t)(c * SC_TC + (i >> 3)) * 64 + vr0 + (i & 7) * 2) = v;
        };
        issue(0); commit(0); issue(1);
        __syncthreads();
        for (int c = 0; c < SC_NC; ++c) {
            if (c > 0) yout(c - 1);
            if (c + 1 < SC_NC) commit((c + 1) & 1);
            if (c + 2 < SC_NC) issue(c + 2);
            __syncthreads();
        }
        yout(SC_NC - 1);
    } else {
        const int rl = wave * 4 + (lane >> 4), sub = lane & 15;
        f32x4 S = {0.f, 0.f, 0.f, 0.f};
        __syncthreads();
        for (int c = 0; c < SC_NC; ++c) {
            const float* buf = (const float*)(smem + (c & 1) * SC_BUF);
            float* yb = (float*)(smem + SC_YOFF + (c & 1) * SC_YBUF);
#pragma unroll 4
            for (int s = 0; s < SC_TC; ++s) {
                const f32x4 r4 = *(const f32x4*)(buf + 0 * (SC_TC * 64) + s * 64 + sub * 4);
                const f32x4 w4 = *(const f32x4*)(buf + 1 * (SC_TC * 64) + s * 64 + sub * 4);
                const f32x4 k4 = *(const f32x4*)(buf + 2 * (SC_TC * 64) + s * 64 + sub * 4);
                const f32x4 kk4 = *(const f32x4*)(buf + 3 * (SC_TC * 64) + s * 64 + sub * 4);
                const f32x4 b4 = *(const f32x4*)(buf + 4 * (SC_TC * 64) + s * 64 + sub * 4);
                const float vv = buf[5 * (SC_TC * 64) + s * 16 + rl];
                float d = (S[0] * kk4[0] + S[1] * kk4[1]) + (S[2] * kk4[2] + S[3] * kk4[3]);
                d = reduce16(d);
                const f32x4 tmp = S * w4 + vv * k4;
                S = tmp - d * b4;
                float y = (S[0] * r4[0] + S[1] * r4[1]) + (S[2] * r4[2] + S[3] * r4[3]);
                y = reduce16(y);
                if (sub == 0) yb[s * 16 + rl] = y;
            }
            __syncthreads();
        }
    }
}

constexpr int KLD = 72;
__device__ __forceinline__ void attn_unit(const Params& p, int unit) {
    unsigned char* ws = p.ws;
    const int qt = unit % 65, bh = unit / 65, b = bh >> 3, h = bh & 7;
    const int tid = threadIdx.x, wave = tid >> 6, lane = tid & 63, fr = lane & 15, fq = lane >> 4;
    const bf16_t* Q = (const bf16_t*)(ws + R_QKV) + (size_t)bh * TP * 64;
    const bf16_t* Kg = Q + QKV_ONE / 2;
    const bf16_t* Vg = Q + QKV_ONE;
    bf16_t* Ks = (bf16_t*)smem;
    bf16_t* Vt = Ks + 64 * KLD;
    volatile int* flags = (volatile int*)(smem + 2 * 64 * KLD * 2);
    const int t0 = qt * 128, tq = t0 + wave * 16 + fr;
    bf16x8 qf[2];
    qf[0] = *(const bf16x8*)(Q + (size_t)tq * 64 + fq * 8);
    qf[1] = *(const bf16x8*)(Q + (size_t)tq * 64 + 32 + fq * 8);
    float qs = 0.f;
#pragma unroll
    for (int s = 0; s < 2; ++s)
#pragma unroll
        for (int e = 0; e < 8; ++e) { const float f = bf2f((unsigned short)qf[s][e]); qs += f * f; }
    qs += __shfl_xor(qs, 16); qs += __shfl_xor(qs, 32);
    const float kmax = sqrtf(__uint_as_float(((const unsigned*)(ws + WS_CTL))[16 + bh]));
    const float zb = sqrtf(qs) * kmax * 1.0001f + 88.0f;
    float Arow = 0.f;
    f32x4 O[4];
#pragma unroll
    for (int nd = 0; nd < 4; ++nd) O[nd] = (f32x4){0.f, 0.f, 0.f, 0.f};
    for (int kb = qt * 2 + 1; kb >= 0; --kb) {
        const bool done = __all(Arow > zb);
        if (lane == 0) flags[wave] = done ? 1 : 0;
        __syncthreads();
        int alld = 1;
#pragma unroll
        for (int w = 0; w < 8; ++w) alld &= flags[w];
        if (alld) break;
        {
            const int key = tid >> 3, dc = (tid & 7) * 8;
            const u32x4 kvv = *(const u32x4*)(Kg + (size_t)(kb * 64 + key) * 64 + dc);
            const u32x4 vvv = *(const u32x4*)(Vg + (size_t)(kb * 64 + key) * 64 + dc);
            *(u32x4*)(Ks + key * KLD + dc) = kvv;
#pragma unroll
            for (int e = 0; e < 4; ++e) { Vt[(dc + 2 * e) * KLD + key] = (bf16_t)(vvv[e] & 0xffffu); Vt[(dc + 2 * e + 1) * KLD + key] = (bf16_t)(vvv[e] >> 16); }
        }
        __syncthreads();
        f32x4 z[4];
#pragma unroll
        for (int n = 0; n < 4; ++n) {
            z[n] = (f32x4){0.f, 0.f, 0.f, 0.f};
#pragma unroll
            for (int s = 0; s < 2; ++s) {
                const bf16x8 kf = *(const bf16x8*)(Ks + (n * 16 + fr) * KLD + s * 32 + fq * 8);
                z[n] = __builtin_amdgcn_mfma_f32_16x16x32_bf16(kf, qf[s], z[n], 0, 0, 0);
            }
        }
        float sp[4][4], lt[4], ex[4], sg[4];
#pragma unroll
        for (int n = 0; n < 4; ++n) {
#pragma unroll
            for (int j = 0; j < 4; ++j) { const int s = kb * 64 + n * 16 + fq * 4 + j; sp[n][j] = s < tq ? softplusf_(z[n][j]) : 0.f; }
            sp[n][2] += sp[n][3]; sp[n][1] += sp[n][2]; sp[n][0] += sp[n][1];
            lt[n] = sp[n][0];
            const float a = __shfl_xor(lt[n], 16), pr = lt[n] + a, c = __shfl_xor(pr, 32);
            ex[n] = fq == 3 ? 0.f : (fq == 2 ? a : (fq == 1 ? c : a + c));
            sg[n] = pr + c;
        }
        float nsuf[4]; nsuf[3] = 0.f; nsuf[2] = sg[3]; nsuf[1] = nsuf[2] + sg[2]; nsuf[0] = nsuf[1] + sg[1];
        float wgt[4][4];
#pragma unroll
        for (int n = 0; n < 4; ++n)
#pragma unroll
            for (int j = 0; j < 4; ++j) {
                const int s = kb * 64 + n * 16 + fq * 4 + j;
                const float C = Arow + nsuf[n] + ex[n] + sp[n][j];
                wgt[n][j] = s < tq ? __expf(z[n][j] - C) : 0.f;
            }
        Arow += nsuf[0] + sg[0];
#pragma unroll
        for (int ks = 0; ks < 2; ++ks) {
            u32x4 pw; pw.x = pk_bf16(wgt[2 * ks][0], wgt[2 * ks][1]); pw.y = pk_bf16(wgt[2 * ks][2], wgt[2 * ks][3]);
            pw.z = pk_bf16(wgt[2 * ks + 1][0], wgt[2 * ks + 1][1]); pw.w = pk_bf16(wgt[2 * ks + 1][2], wgt[2 * ks + 1][3]);
            const bf16x8 pf = __builtin_bit_cast(bf16x8, pw);
#pragma unroll
            for (int nd = 0; nd < 4; ++nd) {
                u32x4 vw;
                const u32x2 v0 = *(const u32x2*)(Vt + (nd * 16 + fr) * KLD + (2 * ks) * 16 + fq * 4);
                const u32x2 v1 = *(const u32x2*)(Vt + (nd * 16 + fr) * KLD + (2 * ks + 1) * 16 + fq * 4);
                vw.x = v0.x; vw.y = v0.y; vw.z = v1.x; vw.w = v1.y;
                O[nd] = __builtin_amdgcn_mfma_f32_16x16x32_bf16(pf, __builtin_bit_cast(bf16x8, vw), O[nd], 0, 0, 0);
            }
        }
    }
    __syncthreads();
    bf16_t* osb = (bf16_t*)(ws + O_OSB);
#pragma unroll
    for (int j = 0; j < 4; ++j) {
        const int t = t0 + wave * 16 + fq * 4 + j;
        if (t >= NMETA && t < T) {
#pragma unroll
            for (int nd = 0; nd < 4; ++nd) osb[(size_t)(b * SEQ + t - NMETA) * 512 + h * 64 + nd * 16 + fr] = (bf16_t)(pk_bf16(O[nd][j], 0.f) & 0xffffu);
        }
    }
}

constexpr int N_SCAN = 128, N_ATTN = 32 * 65;
__device__ __forceinline__ void phase3(const Params& p) {
    unsigned* ctr = (unsigned*)(p.ws + WS_CTL);
    volatile int* slot = (volatile int*)(smem + LDS_BYTES - 16);
    for (;;) {
        __syncthreads();
        if (threadIdx.x == 0) *slot = (int)atomicAdd(ctr, 1u);
        __syncthreads();
        const int u = *slot;
        if (u >= N_SCAN + N_ATTN) break;
        if (u < N_SCAN) scan_unit(p, u); else attn_unit(p, u - N_SCAN);
    }
}

__device__ __forceinline__ void phase3c(const Params& p) {
    unsigned char* ws = p.ws;
    const _Float16* SI = (const _Float16*)(ws + R_SI);
    constexpr size_t SIE = (size_t)MP * 512;
    const float* Y = (const float*)(ws + O_Y);
    const bf16_t* G = (const bf16_t*)(ws + R_G);
    bf16_t* orw = (bf16_t*)(ws + O_ORW);
    const int tid = threadIdx.x, sub = tid & 15;
    for (int it = blockIdx.x; it < 32 * 256; it += gridDim.x) {
        const int bh = it >> 8, ch = it & 255, b = bh >> 3, h = bh & 7;
        const int t = NMETA + ch * 32 + (tid >> 4);
        const size_t base = ((size_t)bh * TP + t) * 64 + sub * 4;
        const f32x4 y = *(const f32x4*)(Y + base);
        const float mean = reduce16((y[0] + y[1]) + (y[2] + y[3])) * (1.0f / 64.0f);
        const f32x4 dy = y - mean;
        const float var = reduce16((dy[0] * dy[0] + dy[1] * dy[1]) + (dy[2] * dy[2] + dy[3] * dy[3])) * (1.0f / 64.0f);
        const float rs = rsqrtf(var + GN_EPS);
        const int c = h * 64 + sub * 4;
        const f32x4 gain = *(const f32x4*)(p.in[14] + c), bias = *(const f32x4*)(p.in[15] + c), rk = *(const f32x4*)(p.in[13] + c);
        const h16x4 r4 = *(const h16x4*)(SI + SI_R * SIE + base), k4 = *(const h16x4*)(SI + SI_K * SIE + base), v4 = *(const h16x4*)(SI + SI_V * SIE + base);
        float bs = 0.f;
#pragma unroll
        for (int j = 0; j < 4; ++j) bs += (float)r4[j] * (float)k4[j] * rk[j];
        bs = reduce16(bs);
        const u32x2 g2 = *(const u32x2*)(G + base);
        const float gg[4] = {__uint_as_float(g2.x << 16), __uint_as_float(g2.x & 0xffff0000u), __uint_as_float(g2.y << 16), __uint_as_float(g2.y & 0xffff0000u)};
        float o[4];
#pragma unroll
        for (int j = 0; j < 4; ++j) o[j] = (dy[j] * rs * gain[j] + bias[j] + bs * (float)v4[j]) * gg[j];
        u32x2 w; w.x = pk_bf16(o[0], o[1]); w.y = pk_bf16(o[2], o[3]);
        *(u32x2*)(orw + (size_t)(b * SEQ + t - NMETA) * 512 + c) = w;
    }
}

__device__ __forceinline__ void phase4(const Params& p) {
    unsigned char* ws = p.ws;
    EpiBranch1 e1{(float*)(ws + O_T1), (const bf16_t*)p.out};
    EpiBranch2 e2{(const float*)(ws + O_T1), (const bf16_t*)p.out, (bf16_t*)(ws + O_M)};
    gemm_phase((const bf16_t*)(ws + O_OSB), (const bf16_t*)(ws + WS_WSB), 512, MS / BM, D / BM, e1);
    gemm_phase((const bf16_t*)(ws + O_ORW), (const bf16_t*)(ws + WS_WRW), 512, MS / BM, D / BM, e2);
}
__device__ __forceinline__ void phase5(const Params& p) {
    unsigned char* ws = p.ws;
    EpiF32 e{(float*)(ws + O_P)};
    gemm_phase((const bf16_t*)(ws + O_M), (const bf16_t*)(ws + WS_WOUT), D, MS / BM, D / BM, e);
}
__device__ __forceinline__ void phase6(const Params& p) {
    unsigned char* ws = p.ws;
    const int lane = threadIdx.x & 63;
    for (int it = blockIdx.x; it < MS / 8; it += gridDim.x) {
        const int row = it * 8 + (threadIdx.x >> 6);
        const float* pr = (const float*)(ws + O_P) + (size_t)row * D;
        const float* xr = p.in[0] + (size_t)row * D;
        f32x4 v[4]; float ss = 0.f;
#pragma unroll
        for (int j = 0; j < 4; ++j) { v[j] = *(const f32x4*)(pr + 4 * lane + 256 * j); ss += (v[j][0] * v[j][0] + v[j][1] * v[j][1]) + (v[j][2] * v[j][2] + v[j][3] * v[j][3]); }
        const float rs = rsqrtf(wave_sum(ss) * (1.0f / D) + RMS_EPS);
        float s2 = 0.f;
#pragma unroll
        for (int j = 0; j < 4; ++j) {
            const f32x4 g = *(const f32x4*)(p.in[3] + 4 * lane + 256 * j), x = *(const f32x4*)(xr + 4 * lane + 256 * j);
            v[j] = x + v[j] * rs * g;
            *(f32x4*)(p.out + (size_t)row * D + 4 * lane + 256 * j) = v[j];
            s2 += (v[j][0] * v[j][0] + v[j][1] * v[j][1]) + (v[j][2] * v[j][2] + v[j][3] * v[j][3]);
        }
        const float rs2 = rsqrtf(wave_sum(s2) * (1.0f / D) + RMS_EPS);
        bf16_t* fr_ = (bf16_t*)(ws + O_F) + (size_t)row * D;
#pragma unroll
        for (int j = 0; j < 4; ++j) {
            const f32x4 g = *(const f32x4*)(p.in[19] + 4 * lane + 256 * j);
            u32x2 w; w.x = pk_bf16(v[j][0] * rs2 * g[0], v[j][1] * rs2 * g[1]); w.y = pk_bf16(v[j][2] * rs2 * g[2], v[j][3] * rs2 * g[3]);
            *(u32x2*)(fr_ + 4 * lane + 256 * j) = w;
        }
    }
}
__device__ __forceinline__ void phase7(const Params& p) {
    unsigned char* ws = p.ws;
    EpiGU e{(bf16_t*)(ws + O_ACT)};
    gemm_phase((const bf16_t*)(ws + O_F), (const bf16_t*)(ws + WS_WGU), D, MS / BM, 2 * DFF / BM, e);
}
__device__ __forceinline__ void phase8(const Params& p) {
    unsigned char* ws = p.ws;
    EpiF32 e{(float*)(ws + O_DN)};
    gemm_phase((const bf16_t*)(ws + O_ACT), (const bf16_t*)(ws + WS_WD), DFF, MS / BM, D / BM, e);
}
__device__ __forceinline__ void phase9(const Params& p) {
    unsigned char* ws = p.ws;
    const int lane = threadIdx.x & 63;
    for (int it = blockIdx.x; it < MS / 8; it += gridDim.x) {
        const int row = it * 8 + (threadIdx.x >> 6);
        const float* dr = (const float*)(ws + O_DN) + (size_t)row * D;
        f32x4 v[4]; float ss = 0.f;
#pragma unroll
        for (int j = 0; j < 4; ++j) { v[j] = *(const f32x4*)(dr + 4 * lane + 256 * j); ss += (v[j][0] * v[j][0] + v[j][1] * v[j][1]) + (v[j][2] * v[j][2] + v[j][3] * v[j][3]); }
        const float rs = rsqrtf(wave_sum(ss) * (1.0f / D) + RMS_EPS);
#pragma unroll
        for (int j = 0; j < 4; ++j) {
            const f32x4 g = *(const f32x4*)(p.in[20] + 4 * lane + 256 * j);
            float* o = p.out + (size_t)row * D + 4 * lane + 256 * j;
            const f32x4 h1 = *(const f32x4*)o;
            *(f32x4*)o = h1 + v[j] * rs * g;
        }
    }
}

constexpr int N_PHASES = 11;
__device__ __forceinline__ void run_phase(const Params& p, int ph) {
    switch (ph) {
        case 0: phase0(p); break;
        case 1: phase1(p); break;
        case 2: phase2(p); break;
        case 3: phase3(p); break;
        case 4: phase3c(p); break;
        case 5: phase4(p); break;
        case 6: phase5(p); break;
        case 7: phase6(p); break;
        case 8: phase7(p); break;
        case 9: phase8(p); break;
        default: phase9(p); break;
    }
}

#if MULTI_LAUNCH
template <int PH> __global__ void __launch_bounds__(512) fwd_phase(Params p) { run_phase(p, PH); }
#else
__global__ void __launch_bounds__(512) fwd_mega(Params p) {
    cg::grid_group grid = cg::this_grid();
    phase0(p); grid.sync(); phase1(p); grid.sync(); phase2(p); grid.sync(); phase3(p); grid.sync(); phase3c(p); grid.sync();
    phase4(p); grid.sync(); phase5(p); grid.sync(); phase6(p); grid.sync(); phase7(p); grid.sync(); phase8(p); grid.sync(); phase9(p);
}
#endif

extern "C" void kernel_launch(void* const* d_in, const int* in_sizes, int n_in, void* d_out, int out_size, void* d_ws, size_t ws_size, hipStream_t stream) {
    static int grid = 0;
    if (grid == 0) {
        if (n_in != 24 || out_size != MS * D || ws_size < WS_END) { fprintf(stderr, "kernel_launch: unexpected shapes (n_in %d out %d ws %zu need %zu)\n", n_in, out_size, ws_size, (size_t)WS_END); grid = -1; return; }
        int dev = 0, cus = 0, per_cu = 0;
        (void)hipGetDevice(&dev);
        (void)hipDeviceGetAttribute(&cus, hipDeviceAttributeMultiprocessorCount, dev);
#if MULTI_LAUNCH
        per_cu = 1;
#else
        (void)hipFuncSetAttribute((const void*)fwd_mega, hipFuncAttributeMaxDynamicSharedMemorySize, LDS_BYTES);
        (void)hipOccupancyMaxActiveBlocksPerMultiprocessor(&per_cu, (const void*)fwd_mega, 512, LDS_BYTES);
        if (per_cu < 1) { fprintf(stderr, "kernel_launch: occupancy query says %d blocks per CU\n", per_cu); per_cu = 1; }
        if (per_cu > 1) per_cu = 1;
#endif
        grid = cus * per_cu;
    }
    if (grid < 0) return;
    Params p{};
    for (int i = 0; i < 24; ++i) p.in[i] = (const float*)d_in[i];
    p.out = (float*)d_out; p.ws = (unsigned char*)d_ws;
#if MULTI_LAUNCH
#define LP(PH) do { (void)hipFuncSetAttribute((const void*)fwd_phase<PH>, hipFuncAttributeMaxDynamicSharedMemorySize, LDS_BYTES); hipLaunchKernelGGL(fwd_phase<PH>, dim3(grid), dim3(512), LDS_BYTES, stream, p); } while (0)
    LP(0); LP(1); LP(2); LP(3); LP(4); LP(5); LP(6); LP(7); LP(8); LP(9); LP(10);
#undef LP
#else
    void* args[] = {&p};
    hipError_t e = hipLaunchCooperativeKernel((const void*)fwd_mega, dim3(grid), dim3(512), args, LDS_BYTES, stream);
    if (e != hipSuccess) fprintf(stderr, "cooperative launch failed: %s (grid %d)\n", hipGetErrorString(e), grid);
#endif
}
```

```cpp
#include <hip/hip_runtime.h>
#include <hip/hip_cooperative_groups.h>
#include <cstdio>
#include <cstdint>
#include <type_traits>
namespace cg = cooperative_groups;

#ifndef MULTI_LAUNCH
#define MULTI_LAUNCH 0
#endif

typedef unsigned short bf16_t;
typedef short bf16x8 __attribute__((ext_vector_type(8)));
typedef float f32x4 __attribute__((ext_vector_type(4)));
typedef float f32x2 __attribute__((ext_vector_type(2)));
typedef unsigned u32x2 __attribute__((ext_vector_type(2)));
typedef unsigned u32x4 __attribute__((ext_vector_type(4)));
typedef _Float16 h16x2 __attribute__((ext_vector_type(2)));
typedef _Float16 h16x4 __attribute__((ext_vector_type(4)));
typedef _Float16 h16x8 __attribute__((ext_vector_type(8)));

constexpr int D = 1024, NB = 4, SEQ = 8192, NMETA = 16, T = SEQ + NMETA, TP = 8320, MP = NB * TP, MS = NB * SEQ;
constexpr int PIN = 5376, DFF = 2816, NH = 8, RWS = 1792;
constexpr float RMS_EPS = 1e-6f, GN_EPS = 64e-5f;

constexpr size_t WS_CTL = 0;
constexpr size_t WS_WIN = 4096;
constexpr size_t WS_WSB = WS_WIN + (size_t)PIN * D * 2;
constexpr size_t WS_WRW = WS_WSB + (size_t)D * 512 * 2;
constexpr size_t WS_WOUT = WS_WRW + (size_t)D * 512 * 2;
constexpr size_t WS_WGU = WS_WOUT + (size_t)D * D * 2;
constexpr size_t WS_WD = WS_WGU + (size_t)2 * DFF * D * 2;
constexpr size_t WS_WL = WS_WD + (size_t)D * DFF * 2;
constexpr size_t R_QKV = WS_WL + (size_t)512 * 256 * 2;
constexpr size_t QKV_ONE = (size_t)MP * 512 * 2;
constexpr size_t R_URW = R_QKV + 3 * QKV_ONE;
constexpr size_t R_SI = R_URW + (size_t)MP * RWS * 2;
constexpr size_t SI_ONE = (size_t)MP * 512 * 2;
constexpr size_t R_G = R_SI + 6 * SI_ONE;
constexpr size_t WS_END = R_G + SI_ONE;
constexpr size_t O_A0 = R_SI;
constexpr size_t O_Y = R_URW;
constexpr size_t O_OSB = R_URW + (size_t)MP * 512 * 4;
constexpr size_t O_ORW = R_QKV;
constexpr size_t O_T1 = R_SI;
constexpr size_t O_M = R_SI + (size_t)MS * D * 4;
constexpr size_t O_P = R_QKV;
constexpr size_t O_F = R_SI;
constexpr size_t O_ACT = R_QKV;
constexpr size_t O_DN = R_SI + (size_t)MS * D * 2;
static_assert(O_OSB + (size_t)MS * 512 * 2 <= R_SI, "overlay");
static_assert(O_M + (size_t)MS * D * 2 <= WS_END, "overlay");
static_assert(O_ACT + (size_t)MS * DFF * 2 <= R_SI, "overlay");
static_assert(O_DN + (size_t)MS * D * 4 <= WS_END, "overlay");
static_assert(WS_END <= (size_t)512 * 1024 * 1024, "workspace");

constexpr int LDS_BYTES = 131072;

struct Params { const float* in[24]; float* out; unsigned char* ws; };

extern __shared__ __attribute__((aligned(16))) unsigned char smem[];

typedef __bf16 b16x2 __attribute__((ext_vector_type(2)));
__device__ __forceinline__ unsigned pk_bf16(float lo, float hi) { const f32x2 v = {lo, hi}; return __builtin_bit_cast(unsigned, __builtin_convertvector(v, b16x2)); }
__device__ __forceinline__ float bf2f(unsigned short v) { return __uint_as_float((unsigned)v << 16); }
__device__ __forceinline__ float sigmoidf_(float x) { return __builtin_amdgcn_rcpf(1.0f + __expf(-x)); }
__device__ __forceinline__ float softplusf_(float x) { return fmaxf(x, 0.f) + __logf(1.0f + __expf(-fabsf(x))); }
template <int CTRL> __device__ __forceinline__ float dppf(float x) { return __builtin_bit_cast(float, __builtin_amdgcn_mov_dpp(__builtin_bit_cast(int, x), CTRL, 0xf, 0xf, true)); }
__device__ __forceinline__ float reduce16(float v) {
    v += dppf<0xB1>(v); v += dppf<0x4E>(v); v += dppf<0x141>(v); v += dppf<0x140>(v); return v;
}
__device__ __forceinline__ float wave_sum(float v) {
#pragma unroll
    for (int o = 1; o < 64; o <<= 1) v += __shfl_xor(v, o);
    return v;
}

#define LAS __attribute__((address_space(3)))
constexpr int BM = 256, BK = 64, HALF = 128, HTB = HALF * BK * 2, NXCD = 8, WGM = 8;
__device__ __forceinline__ int lds_byte(int r, int c) { const int st = (r >> 4) * 2 + (c >> 5), rr = r & 15, cc = c & 31, ob = rr * 64 + cc * 2; return st * 1024 + (ob ^ (((ob >> 9) & 1) << 5)); }
__device__ __forceinline__ void stage_rc(int b, int& R, int& C) { const int st = b / 1024, sb = b % 1024, swz = sb ^ (((sb >> 9) & 1) << 5); R = (st >> 1) * 16 + swz / 64; C = (st & 1) * 32 + (swz % 64) / 2; }
struct Unit { int pm, pn; };
struct Sched {
    int nM, nN, nwg, G, c;
    __device__ __forceinline__ bool next(int i, Unit& u) const {
        const long L = (long)i * G + c; if (L >= nwg) return false;
        int wgid = (int)L; { const int q = nwg / NXCD, r = nwg % NXCD, xcd = wgid % NXCD, off = wgid / NXCD; wgid = (xcd < r ? xcd * (q + 1) : r * (q + 1) + (xcd - r) * q) + off; }
        const int nig = WGM * nN, gid = wgid / nig, fm = gid * WGM, gsz = (nM - fm) < WGM ? (nM - fm) : WGM;
        u.pm = fm + ((wgid % nig) % gsz); u.pn = (wgid % nig) / gsz; return true;
    }
};

template <class Epi>
__device__ __forceinline__ void gemm_phase(const bf16_t* __restrict__ Ag, const bf16_t* __restrict__ Btg, const int K, const int nM, const int nN, const Epi& E) {
    LAS unsigned char* lds = (LAS unsigned char*)smem;
    const int tid = threadIdx.x, wid = __builtin_amdgcn_readfirstlane(tid >> 6), lane = tid & 63, wr = wid >> 2, wc = wid & 3, fr = lane & 15, fq = lane >> 4;
    const int nt = K / BK;
    Sched S; S.nM = nM; S.nN = nN; S.nwg = nM * nN; S.G = gridDim.x; S.c = blockIdx.x;
    unsigned voffA[2], voffB[2];
#pragma unroll
    for (int i = 0; i < 2; ++i) { int R, C; stage_rc(tid * 16 + i * 8192, R, C); voffA[i] = (unsigned)(R * K + C) * 2u; voffB[i] = voffA[i]; }
    const size_t kstep = (size_t)(BK * 2);
    const size_t hstep = (size_t)HALF * K * 2;
    const size_t tstep = 2 * hstep;
    const unsigned ldsw = (unsigned)wid * 1024u;
    const int aoff = lds_byte(wr * 64 + fr, fq * 8), boff = lds_byte(wc * 32 + fr, fq * 8);
#define PG8_SA(b, h) (((b) * 2 + (h)) * HTB)
#define PG8_SB(b, h) ((4 + (b) * 2 + (h)) * HTB)
#define PG8_STAGE(bufoff, gbase, voff) do { _Pragma("unroll") for (int _i = 0; _i < 2; ++_i) \
        __builtin_amdgcn_global_load_lds((const unsigned*)((const char*)(gbase) + (voff)[_i]), (LAS unsigned*)(lds + (bufoff) + ldsw + _i * 8192), 16, 0, 0); } while (0)
#define PG8_LDA(dst, b, h) do { _Pragma("unroll") for (int m = 0; m < 4; ++m) _Pragma("unroll") for (int k = 0; k < 2; ++k) dst[m][k] = *(const LAS bf16x8*)(lds + PG8_SA(b, h) + aoff + m * 2048 + k * 1024); } while (0)
#define PG8_LDB(dst, b, h) do { _Pragma("unroll") for (int n = 0; n < 2; ++n) _Pragma("unroll") for (int k = 0; k < 2; ++k) dst[n][k] = *(const LAS bf16x8*)(lds + PG8_SB(b, h) + boff + n * 2048 + k * 1024); } while (0)
#define PG8_MMA(ai, bj, At, Bt) do { __builtin_amdgcn_s_setprio(1); _Pragma("unroll") for (int m = 0; m < 4; ++m) _Pragma("unroll") for (int n = 0; n < 2; ++n) _Pragma("unroll") for (int k = 0; k < 2; ++k) \
        acc[ai][bj][m][n] = __builtin_amdgcn_mfma_f32_16x16x32_bf16(Bt[n][k], At[m][k], acc[ai][bj][m][n], 0, 0, 0); __builtin_amdgcn_s_setprio(0); } while (0)
#define PG8_WAIT_V(n) asm volatile("s_waitcnt vmcnt(" #n ")" ::: "memory")
#define PG8_WAIT_L(n) asm volatile("s_waitcnt lgkmcnt(" #n ")" ::: "memory")
#define PG8_BAR __builtin_amdgcn_s_barrier()
#define PG8_SCHED __builtin_amdgcn_sched_barrier(0)
    Unit cur, nxt; int ui = 0;
    __syncthreads();
    if (!S.next(0, cur)) return;
    f32x4 acc[2][2][4][2];
#pragma unroll
    for (int a = 0; a < 2; ++a)
#pragma unroll
        for (int b = 0; b < 2; ++b)
#pragma unroll
            for (int m = 0; m < 4; ++m)
#pragma unroll
                for (int n = 0; n < 2; ++n) acc[a][b][m][n] = (f32x4){0.f, 0.f, 0.f, 0.f};
    bf16x8 At[4][2], B0[2][2], B1[2][2];
    const char* cA = (const char*)Ag + (size_t)cur.pm * tstep; const char* cB = (const char*)Btg + (size_t)cur.pn * tstep;
    PG8_STAGE(PG8_SB(0, 0), cB, voffB); PG8_STAGE(PG8_SA(0, 0), cA, voffA); PG8_STAGE(PG8_SB(0, 1), cB + hstep, voffB); PG8_STAGE(PG8_SA(0, 1), cA + hstep, voffA);
    if (wr == 1) PG8_BAR;
    PG8_WAIT_V(4); PG8_BAR;
    PG8_STAGE(PG8_SB(1, 0), cB + kstep, voffB); PG8_STAGE(PG8_SA(1, 0), cA + kstep, voffA); PG8_STAGE(PG8_SB(1, 1), cB + hstep + kstep, voffB);
    PG8_WAIT_V(6); PG8_BAR;
    for (;;) {
        const bool has_next = S.next(ui + 1, nxt);
        const char* nA = has_next ? (const char*)Ag + (size_t)nxt.pm * tstep : cA; const char* nB = has_next ? (const char*)Btg + (size_t)nxt.pn * tstep : cB;
        for (int t = 0; t < nt; t += 2) {
            const bool last = (t == nt - 2);
            const char* a1 = cA + (size_t)(t + 1) * kstep;
            const char* a2 = last ? nA : cA + (size_t)(t + 2) * kstep; const char* b2 = last ? nB : cB + (size_t)(t + 2) * kstep;
            const char* a3 = a2 + kstep; const char* b3 = b2 + kstep;
            PG8_LDB(B0, 0, 0); PG8_SCHED; PG8_LDA(At, 0, 0); PG8_STAGE(PG8_SA(1, 1), a1 + hstep, voffA);
            PG8_WAIT_L(8); PG8_BAR; PG8_WAIT_L(0); PG8_MMA(0, 0, At, B0); PG8_BAR; PG8_SCHED;
            PG8_LDB(B1, 0, 1); PG8_STAGE(PG8_SB(0, 0), b2, voffB);
            PG8_BAR; PG8_WAIT_L(0); PG8_MMA(0, 1, At, B1); PG8_BAR;
            PG8_LDA(At, 0, 1); PG8_STAGE(PG8_SA(0, 0), a2, voffA);
            PG8_BAR; PG8_WAIT_L(0); PG8_MMA(1, 0, At, B0); PG8_BAR; PG8_SCHED;
            PG8_STAGE(PG8_SB(0, 1), b2 + hstep, voffB);
            PG8_WAIT_V(6); PG8_BAR; PG8_MMA(1, 1, At, B1); PG8_BAR;
            PG8_LDB(B0, 1, 0); PG8_SCHED; PG8_LDA(At, 1, 0); PG8_STAGE(PG8_SA(0, 1), a2 + hstep, voffA);
            PG8_WAIT_L(8); PG8_BAR; PG8_WAIT_L(0); PG8_MMA(0, 0, At, B0); PG8_BAR; PG8_SCHED;
            PG8_LDB(B1, 1, 1); PG8_STAGE(PG8_SB(1, 0), b3, voffB);
            PG8_BAR; PG8_WAIT_L(0); PG8_MMA(0, 1, At, B1); PG8_BAR;
            PG8_LDA(At, 1, 1); PG8_STAGE(PG8_SA(1, 0), a3, voffA);
            PG8_BAR; PG8_WAIT_L(0); PG8_MMA(1, 0, At, B0); PG8_BAR; PG8_SCHED;
            PG8_STAGE(PG8_SB(1, 1), b3 + hstep, voffB);
            PG8_WAIT_V(6); PG8_BAR; PG8_MMA(1, 1, At, B1); PG8_BAR;
        }
        {
            const int brow = cur.pm * BM, bcol = cur.pn * BM;
#pragma unroll
            for (int ai = 0; ai < 2; ++ai)
#pragma unroll
                for (int m = 0; m < 4; ++m) {
#pragma unroll
                    for (int bj = 0; bj < 2; ++bj)
                        E(brow + ai * HALF + wr * 64 + m * 16 + fr, bcol + bj * HALF + wc * 32, fq, acc[ai][bj][m][0], acc[ai][bj][m][1]);
                    asm volatile("" ::: "memory");
                }
        }
        if (!has_next) break;
#pragma unroll
        for (int a = 0; a < 2; ++a)
#pragma unroll
            for (int b = 0; b < 2; ++b)
#pragma unroll
                for (int m = 0; m < 4; ++m)
#pragma unroll
                    for (int n = 0; n < 2; ++n) acc[a][b][m][n] = (f32x4){0.f, 0.f, 0.f, 0.f};
        cur = nxt; cA = nA; cB = nB; ++ui;
    }
    PG8_WAIT_V(0);
    if (wr == 0) PG8_BAR;
    PG8_BAR;
#undef PG8_SA
#undef PG8_SB
#undef PG8_STAGE
#undef PG8_LDA
#undef PG8_LDB
#undef PG8_MMA
#undef PG8_WAIT_V
#undef PG8_WAIT_L
#undef PG8_BAR
#undef PG8_SCHED
}

struct EpiInProj {
    bf16_t* qkv; _Float16* urw; bf16_t* gates;
    __device__ __forceinline__ void one(int row, int col, const f32x4& v) const {
        if (col < 1536) {
            const int which = col >> 9, hc = col & 511, h = hc >> 6, d = hc & 63, b = row / TP, t = row - b * TP;
            const float s = which == 0 ? 0.125f : 1.0f;
            u32x2 w; w.x = pk_bf16(v[0] * s, v[1] * s); w.y = pk_bf16(v[2] * s, v[3] * s);
            *(u32x2*)(qkv + (size_t)which * (QKV_ONE / 2) + ((size_t)(b * NH + h) * TP + t) * 64 + d) = w;
        } else if (col < 3328) {
            h16x4 o; o[0] = (_Float16)v[0]; o[1] = (_Float16)v[1]; o[2] = (_Float16)v[2]; o[3] = (_Float16)v[3];
            *(h16x4*)(urw + (size_t)row * RWS + (col - 1536)) = o;
        } else {
            const int b = row / TP, t = row - b * TP;
            if (t >= NMETA && t < T) {
                u32x2 w; w.x = pk_bf16(sigmoidf_(v[0]), sigmoidf_(v[1])); w.y = pk_bf16(sigmoidf_(v[2]), sigmoidf_(v[3]));
                *(u32x2*)(gates + (size_t)(b * SEQ + t - NMETA) * 2048 + (col - 3328)) = w;
            }
        }
    }
    __device__ __forceinline__ void operator()(int row, int col32, int fq, const f32x4& v0, const f32x4& v1) const {
        if (col32 >= 1536 && col32 < 3072) {
            const int c = col32 - 1536, pos = (c & ~63) + fq * 16 + ((c & 63) >> 4) * 4;
            h16x8 o;
#pragma unroll
            for (int j = 0; j < 4; ++j) { o[j] = (_Float16)v0[j]; o[4 + j] = (_Float16)v1[j]; }
            *(h16x8*)(urw + (size_t)row * RWS + pos) = o;
        } else { one(row, col32 + 4 * fq, v0); one(row, col32 + 16 + 4 * fq, v1); }
    }
};
struct EpiBranch1 {
    float* t1; const bf16_t* gates;
    __device__ __forceinline__ void one(int row, int col, const f32x4& v) const {
        const u32x2 g = *(const u32x2*)(gates + (size_t)row * 2048 + col);
        f32x4 o; o[0] = v[0] * __uint_as_float(g.x << 16); o[1] = v[1] * __uint_as_float(g.x & 0xffff0000u); o[2] = v[2] * __uint_as_float(g.y << 16); o[3] = v[3] * __uint_as_float(g.y & 0xffff0000u);
        *(f32x4*)(t1 + (size_t)row * D + col) = o;
    }
    __device__ __forceinline__ void operator()(int row, int col32, int fq, const f32x4& v0, const f32x4& v1) const { one(row, col32 + 4 * fq, v0); one(row, col32 + 16 + 4 * fq, v1); }
};
struct EpiBranch2 {
    const float* t1; const bf16_t* gates; bf16_t* m;
    __device__ __forceinline__ void one(int row, int col, const f32x4& v) const {
        const u32x2 g = *(const u32x2*)(gates + (size_t)row * 2048 + 1024 + col);
        const f32x4 a = *(const f32x4*)(t1 + (size_t)row * D + col);
        f32x4 o; o[0] = a[0] + v[0] * __uint_as_float(g.x << 16); o[1] = a[1] + v[1] * __uint_as_float(g.x & 0xffff0000u); o[2] = a[2] + v[2] * __uint_as_float(g.y << 16); o[3] = a[3] + v[3] * __uint_as_float(g.y & 0xffff0000u);
        u32x2 w; w.x = pk_bf16(o[0], o[1]); w.y = pk_bf16(o[2], o[3]);
        *(u32x2*)(m + (size_t)row * D + col) = w;
    }
    __device__ __forceinline__ void operator()(int row, int col32, int fq, const f32x4& v0, const f32x4& v1) const { one(row, col32 + 4 * fq, v0); one(row, col32 + 16 + 4 * fq, v1); }
};
struct EpiF32 {
    float* o;
    __device__ __forceinline__ void operator()(int row, int col32, int fq, const f32x4& v0, const f32x4& v1) const {
        *(f32x4*)(o + (size_t)row * D + col32 + 4 * fq) = v0; *(f32x4*)(o + (size_t)row * D + col32 + 16 + 4 * fq) = v1;
    }
};
struct EpiGU {
    bf16_t* act;
    __device__ __forceinline__ void operator()(int row, int col32, int fq, const f32x4& v0, const f32x4& v1) const {
        float o[4];
#pragma unroll
        for (int j = 0; j < 4; ++j) o[j] = v0[j] * sigmoidf_(v0[j]) * v1[j];
        u32x2 w; w.x = pk_bf16(o[0], o[1]); w.y = pk_bf16(o[2], o[3]);
        *(u32x2*)(act + (size_t)row * DFF + (col32 >> 5) * 16 + 4 * fq) = w;
    }
};

__device__ __forceinline__ void transpose_tile(const float* __restrict__ src, int K, int N, bf16_t* __restrict__ dst, int ldd, int koff, int mode, int tile) {
    float* scr = (float*)smem;
    const int ntn = N / 128, kb = tile / ntn, nb = tile % ntn, k0 = kb * 64, n0 = nb * 128, tid = threadIdx.x;
    f32x4 v[4];
#pragma unroll
    for (int i = 0; i < 4; ++i) { const int idx = tid + 512 * i, kk = idx >> 5, n4 = idx & 31; v[i] = *(const f32x4*)(src + (size_t)(k0 + kk) * N + n0 + n4 * 4); }
#pragma unroll
    for (int i = 0; i < 4; ++i) { const int idx = tid + 512 * i, kk = idx >> 5, n4 = idx & 31;
#pragma unroll
        for (int c = 0; c < 4; ++c) scr[kk * 129 + n4 * 4 + c] = v[i][c]; }
    __syncthreads();
#pragma unroll
    for (int i = 0; i < 2; ++i) {
        const int o = tid + 512 * i, n = o >> 3, kc = (o & 7) * 8;
        u32x4 w;
        w.x = pk_bf16(scr[(kc + 0) * 129 + n], scr[(kc + 1) * 129 + n]); w.y = pk_bf16(scr[(kc + 2) * 129 + n], scr[(kc + 3) * 129 + n]);
        w.z = pk_bf16(scr[(kc + 4) * 129 + n], scr[(kc + 5) * 129 + n]); w.w = pk_bf16(scr[(kc + 6) * 129 + n], scr[(kc + 7) * 129 + n]);
        const int f = n0 + n;
        const int drow = mode == 0 ? f : ((f >> 4) * 32 + (mode == 2 ? 16 : 0) + (f & 15));
        *(u32x4*)(dst + (size_t)drow * ldd + koff + k0 + kc) = w;
    }
    __syncthreads();
}

__device__ __forceinline__ void phase0(const Params& p) {
    unsigned char* ws = p.ws;
    if (blockIdx.x == 0 && threadIdx.x < 64) ((unsigned*)(ws + WS_CTL))[threadIdx.x] = 0u;
    constexpr int J0 = 16 * 42, J1 = 8 * 8, J3 = 16 * 8, J4 = 16 * 22, J6 = 44 * 8, J7 = 4, J9 = 8;
    constexpr int NT = J0 + 2 * J1 + J3 + 2 * J4 + J6 + 2 * J7 + J9;
    constexpr int NR = MP / 32;
    for (int it = blockIdx.x; it < NT + NR; it += gridDim.x) {
        if (it >= NR) {
            int r = it - NR;
            if (r < J0) { transpose_tile(p.in[4], D, PIN, (bf16_t*)(ws + WS_WIN), D, 0, 0, r); continue; } r -= J0;
            if (r < J1) { transpose_tile(p.in[16], 512, D, (bf16_t*)(ws + WS_WSB), 512, 0, 0, r); continue; } r -= J1;
            if (r < J1) { transpose_tile(p.in[17], 512, D, (bf16_t*)(ws + WS_WRW), 512, 0, 0, r); continue; } r -= J1;
            if (r < J3) { transpose_tile(p.in[18], D, D, (bf16_t*)(ws + WS_WOUT), D, 0, 0, r); continue; } r -= J3;
            if (r < J4) { transpose_tile(p.in[21], D, DFF, (bf16_t*)(ws + WS_WGU), D, 0, 1, r); continue; } r -= J4;
            if (r < J4) { transpose_tile(p.in[22], D, DFF, (bf16_t*)(ws + WS_WGU), D, 0, 2, r); continue; } r -= J4;
            if (r < J6) { transpose_tile(p.in[23], DFF, D, (bf16_t*)(ws + WS_WD), DFF, 0, 0, r); continue; } r -= J6;
            if (r < J7) { transpose_tile(p.in[6], 64, 512, (bf16_t*)(ws + WS_WL), 256, 0, 0, r); continue; } r -= J7;
            if (r < J7) { transpose_tile(p.in[8], 64, 512, (bf16_t*)(ws + WS_WL), 256, 64, 0, r); continue; } r -= J7;
            transpose_tile(p.in[10], 128, 512, (bf16_t*)(ws + WS_WL), 256, 128, 0, r);
        } else {
            const int lane = threadIdx.x & 63, row0 = it * 32 + (threadIdx.x >> 6) * 4;
            f32x4 v[4][4];
#pragma unroll
            for (int r = 0; r < 4; ++r) {
                const int row = row0 + r, b = row / TP, t = row - b * TP;
                const float* src = t < NMETA ? p.in[1] + (size_t)t * D : p.in[0] + ((size_t)b * SEQ + (t < T ? t - NMETA : 0)) * D;
#pragma unroll
                for (int j = 0; j < 4; ++j) v[r][j] = *(const f32x4*)(src + 4 * lane + 256 * j);
            }
            f32x4 g[4];
#pragma unroll
            for (int j = 0; j < 4; ++j) g[j] = *(const f32x4*)(p.in[2] + 4 * lane + 256 * j);
#pragma unroll
            for (int r = 0; r < 4; ++r) {
                const int row = row0 + r, b = row / TP, t = row - b * TP;
                float ss = 0.f;
#pragma unroll
                for (int j = 0; j < 4; ++j) ss += (v[r][j][0] * v[r][j][0] + v[r][j][1] * v[r][j][1]) + (v[r][j][2] * v[r][j][2] + v[r][j][3] * v[r][j][3]);
                const float rs = t < T ? rsqrtf(wave_sum(ss) * (1.0f / D) + RMS_EPS) : 0.f;
                bf16_t* orow = (bf16_t*)(ws + O_A0) + (size_t)row * D;
#pragma unroll
                for (int j = 0; j < 4; ++j) {
                    u32x2 w; w.x = pk_bf16(v[r][j][0] * rs * g[j][0], v[r][j][1] * rs * g[j][1]); w.y = pk_bf16(v[r][j][2] * rs * g[j][2], v[r][j][3] * rs * g[j][3]);
                    *(u32x2*)(orow + 4 * lane + 256 * j) = w;
                }
            }
        }
    }
}

__device__ __forceinline__ void phase1(const Params& p) {
    unsigned char* ws = p.ws;
    EpiInProj epi{(bf16_t*)(ws + R_QKV), (_Float16*)(ws + R_URW), (bf16_t*)p.out};
    gemm_phase((const bf16_t*)(ws + O_A0), (const bf16_t*)(ws + WS_WIN), D, MP / BM, PIN / BM, epi);
}

constexpr int SI_R = 0, SI_W = 1, SI_K = 2, SI_V = 3, SI_KK = 4, SI_B = 5;
constexpr int ALD = 264;
constexpr int P2_WLS = 64 * ALD * 2;
constexpr int P2_MU = P2_WLS;
constexpr int P2_AL = P2_MU + 1024;
__device__ __forceinline__ void phase2_main(const Params& p) {
    unsigned char* ws = p.ws;
    const int tid = threadIdx.x, wave = tid >> 6, lane = tid & 63, fr = lane & 15, fq = lane >> 4;
    const int h = blockIdx.x & 7, nslot = (gridDim.x >> 3) * 8, slot = (blockIdx.x >> 3) * 8 + wave;
    const _Float16* urw = (const _Float16*)(ws + R_URW);
    const float* mu = p.in[5];
    bf16_t* WLs = (bf16_t*)smem;
    float* mus = (float*)(smem + P2_MU);
    bf16_t* Al = (bf16_t*)(smem + P2_AL) + wave * (16 * ALD);
    __syncthreads();
    {
        const bf16_t* WL = (const bf16_t*)(ws + WS_WL) + (size_t)h * 64 * 256;
#pragma unroll
        for (int i = 0; i < 4; ++i) { const int idx = tid + 512 * i, row = idx >> 5, c16 = idx & 31; *(u32x4*)(WLs + row * ALD + c16 * 8) = *(const u32x4*)(WL + row * 256 + c16 * 8); }
        if (tid < 256) mus[tid] = mu[1536 + tid];
    }
    __syncthreads();
    if (blockIdx.x >= nslot) return;
    _Float16* SI = (_Float16*)(ws + R_SI);
    bf16_t* G = (bf16_t*)(ws + R_G);
    constexpr size_t SIE = (size_t)MP * 512;
#pragma unroll 1
    for (int g = slot; g < NB * 514; g += nslot) {
        const int ub = g / 514, ui = g - ub * 514, row0 = ub * TP + ui * 16;
        {
            const int half = lane >> 5, pc = (lane & 31) * 8;
            const float sA = pc < 64 ? 2.f : 1.f, sC = pc < 64 ? -1.f : 0.f;
            const bool lin = pc >= 64 && pc < 128;
            const f32x4 mA = *(const f32x4*)(mu + 1536 + pc), mB = *(const f32x4*)(mu + 1536 + pc + 4);
            h16x8 c[8], pv[8];
#pragma unroll
            for (int q = 0; q < 8; ++q) {
                const int rowa = row0 + 2 * q + half, ta = rowa % TP;
                const _Float16* cur = urw + (size_t)rowa * RWS + 1536 + pc;
                c[q] = *(const h16x8*)cur;
                pv[q] = *(const h16x8*)(ta > 0 ? cur - RWS : cur);
            }
#pragma unroll
            for (int q = 0; q < 8; ++q) {
                const int ta = (row0 + 2 * q + half) % TP;
                float o[8];
#pragma unroll
                for (int e = 0; e < 8; ++e) {
                    const float cf = (float)c[q][e], pf = ta > 0 ? (float)pv[q][e] : 0.f;
                    const float xs = cf + (e < 4 ? mA[e & 3] : mB[e & 3]) * (pf - cf);
                    const float sg = __builtin_amdgcn_rcpf(1.0f + __expf(-sA * xs));
                    o[e] = lin ? xs : sA * sg + sC;
                }
                u32x4 w; w.x = pk_bf16(o[0], o[1]); w.y = pk_bf16(o[2], o[3]); w.z = pk_bf16(o[4], o[5]); w.w = pk_bf16(o[6], o[7]);
                *(u32x4*)(Al + (2 * q + half) * ALD + pc) = w;
            }
        }
        asm volatile("s_waitcnt lgkmcnt(0)" ::: "memory");
        __builtin_amdgcn_wave_barrier();
        f32x4 acc[4];
        auto lora = [&](auto kbeg_c, auto ksteps_c) {
            constexpr int kbeg = decltype(kbeg_c)::value, ksteps = decltype(ksteps_c)::value;
#pragma unroll
            for (int n = 0; n < 4; ++n) acc[n] = (f32x4){0.f, 0.f, 0.f, 0.f};
#pragma unroll
            for (int ks = 0; ks < ksteps; ++ks) {
                const bf16x8 af = *(const bf16x8*)(Al + fr * ALD + kbeg + ks * 32 + fq * 8);
#pragma unroll
                for (int n = 0; n < 4; ++n) {
                    const bf16x8 wf = *(const bf16x8*)(WLs + (n * 16 + fr) * ALD + kbeg + ks * 32 + fq * 8);
                    acc[n] = __builtin_amdgcn_mfma_f32_16x16x32_bf16(wf, af, acc[n], 0, 0, 0);
                }
            }
        };
        const int row = row0 + fr, b = row / TP, t = row - b * TP;
        const size_t base = ((size_t)(b * NH + h) * TP + t) * 64;
        const _Float16* ur = urw + (size_t)row * RWS;
        const size_t pb = base + fq * 16;
        lora(std::integral_constant<int, 0>{}, std::integral_constant<int, 2>{});
        {
            h16x8 wo[2];
#pragma unroll
            for (int n = 0; n < 4; ++n) {
                const f32x4 db = *(const f32x4*)(p.in[7] + h * 64 + n * 16 + fq * 4);
#pragma unroll
                for (int j = 0; j < 4; ++j) {
                    const float wl = -softplusf_(-(db[j] + acc[n][j])) - 0.5f;
                    const float e = __expf(wl);
                    wo[n >> 1][(n & 1) * 4 + j] = (_Float16)(1.0f - __expf(-e));
                }
            }
            *(h16x8*)(SI + SI_W * SIE + pb) = wo[0]; *(h16x8*)(SI + SI_W * SIE + pb + 8) = wo[1];
        }
        lora(std::integral_constant<int, 64>{}, std::integral_constant<int, 2>{});
        {
            const _Float16* up = ur + h * 64 + fq * 16;
            const _Float16* upp = t > 0 ? up - RWS : up;
            h16x8 kc[2], rc[2], vc[2], kp[2], rp[2], vp[2];
#pragma unroll
            for (int i = 0; i < 2; ++i) {
                rc[i] = *(const h16x8*)(up + i * 8); kc[i] = *(const h16x8*)(up + 512 + i * 8); vc[i] = *(const h16x8*)(up + 1024 + i * 8);
                rp[i] = *(const h16x8*)(upp + i * 8); kp[i] = *(const h16x8*)(upp + 512 + i * 8); vp[i] = *(const h16x8*)(upp + 1024 + i * 8);
            }
            float kv[4][4], av[4][4], kkr[4][4]; float ss = 0.f;
            h16x8 ro[2];
#pragma unroll
            for (int n = 0; n < 4; ++n) {
                const int c = n * 16 + fq * 4, c512 = h * 64 + c;
                const f32x4 muk = *(const f32x4*)(mu + 512 + c512), mur = *(const f32x4*)(mu + c512), muv = *(const f32x4*)(mu + 1024 + c512);
                const f32x4 ab = *(const f32x4*)(p.in[9] + c512), kkw = *(const f32x4*)(p.in[11] + c512);
                h16x4 vo;
#pragma unroll
                for (int j = 0; j < 4; ++j) {
                    const int i = n >> 1, e = (n & 1) * 4 + j;
                    const float kcf = (float)kc[i][e], kpf = t > 0 ? (float)kp[i][e] : 0.f;
                    const float rcf = (float)rc[i][e], rpf = t > 0 ? (float)rp[i][e] : 0.f;
                    const float vcf = (float)vc[i][e], vpf = t > 0 ? (float)vp[i][e] : 0.f;
                    kv[n][j] = kcf + muk[j] * (kpf - kcf);
                    ro[i][e] = (_Float16)(rcf + mur[j] * (rpf - rcf));
                    vo[j] = (_Float16)(vcf + muv[j] * (vpf - vcf));
                    av[n][j] = sigmoidf_(ab[j] + acc[n][j]);
                    kkr[n][j] = kv[n][j] * kkw[j];
                    ss += kkr[n][j] * kkr[n][j];
                }
                *(h16x4*)(SI + SI_V * SIE + base + c) = vo;
            }
            *(h16x8*)(SI + SI_R * SIE + pb) = ro[0]; *(h16x8*)(SI + SI_R * SIE + pb + 8) = ro[1];
            ss += __shfl_xor(ss, 16); ss += __shfl_xor(ss, 32);
            const float inv = fminf(__builtin_amdgcn_rsqf(ss), 1e12f);
            h16x8 ko[2], kko[2], bo[2];
#pragma unroll
            for (int n = 0; n < 4; ++n) {
                const f32x4 ka = *(const f32x4*)(p.in[12] + h * 64 + n * 16 + fq * 4);
#pragma unroll
                for (int j = 0; j < 4; ++j) {
                    const int i = n >> 1, e = (n & 1) * 4 + j;
                    const float kk = kkr[n][j] * inv;
                    ko[i][e] = (_Float16)(kv[n][j] * (1.0f + (av[n][j] - 1.0f) * ka[j]));
                    kko[i][e] = (_Float16)kk;
                    bo[i][e] = (_Float16)(kk * av[n][j]);
                }
            }
#pragma unroll
            for (int i = 0; i < 2; ++i) {
                *(h16x8*)(SI + SI_K * SIE + pb + i * 8) = ko[i]; *(h16x8*)(SI + SI_KK * SIE + pb + i * 8) = kko[i]; *(h16x8*)(SI + SI_B * SIE + pb + i * 8) = bo[i];
            }
        }
        lora(std::integral_constant<int, 128>{}, std::integral_constant<int, 4>{});
        {
            u32x4 g0, g1;
            g0.x = pk_bf16(acc[0][0], acc[0][1]); g0.y = pk_bf16(acc[0][2], acc[0][3]); g0.z = pk_bf16(acc[1][0], acc[1][1]); g0.w = pk_bf16(acc[1][2], acc[1][3]);
            g1.x = pk_bf16(acc[2][0], acc[2][1]); g1.y = pk_bf16(acc[2][2], acc[2][3]); g1.z = pk_bf16(acc[3][0], acc[3][1]); g1.w = pk_bf16(acc[3][2], acc[3][3]);
            *(u32x4*)(G + pb) = g0; *(u32x4*)(G + pb + 8) = g1;
        }
        asm volatile("s_waitcnt lgkmcnt(0)" ::: "memory");
        __builtin_amdgcn_wave_barrier();
    }
}
__device__ __forceinline__ void phase2_kmax(const Params& p, int item) {
    unsigned char* ws = p.ws;
    const int bh = item >> 2, qr = item & 3, tid = threadIdx.x;
    float* red = (float*)(smem + P2_AL + 8 * 16 * ALD * 2);
    float ss = 0.f;
    for (int t = qr * 2052 + tid; t < (qr + 1) * 2052; t += 512) {
        const bf16_t* kr = (const bf16_t*)(ws + R_QKV) + QKV_ONE / 2 + ((size_t)bh * TP + t) * 64;
        float s1 = 0.f;
#pragma unroll
        for (int q = 0; q < 8; ++q) {
            const u32x4 v = *(const u32x4*)(kr + q * 8);
#pragma unroll
            for (int e = 0; e < 4; ++e) { const float lo = __uint_as_float(v[e] << 16), hi = __uint_as_float(v[e] & 0xffff0000u); s1 += lo * lo + hi * hi; }
        }
        ss = fmaxf(ss, s1);
    }
#pragma unroll
    for (int o = 1; o < 64; o <<= 1) ss = fmaxf(ss, __shfl_xor(ss, o));
    __syncthreads();
    if ((tid & 63) == 0) red[tid >> 6] = ss;
    __syncthreads();
    if (tid == 0) {
        float m = red[0];
#pragma unroll
        for (int w = 1; w < 8; ++w) m = fmaxf(m, red[w]);
        ((float*)(ws + WS_CTL))[16 + item] = m;
    }
}
__device__ __forceinline__ void phase2(const Params& p) {
    phase2_main(p);
    for (int it = (int)gridDim.x - 1 - (int)blockIdx.x; it < 128; it += gridDim.x) phase2_kmax(p, it);
}

constexpr int SC_TC = 32, SC_NC = (T + SC_TC - 1) / SC_TC;
constexpr int SC_ARR = SC_TC * 64;
constexpr int SC_VOFF = 5 * SC_ARR, SC_COFF = SC_VOFF + SC_TC * 16;
constexpr int SC_BUF = (SC_COFF + SC_TC) * 4;
constexpr int SC_YOFF = 2 * SC_BUF, SC_YBUF = SC_TC * 16 * 4;
__device__ __forceinline__ float dot4(const f32x4& a, const f32x4& b) {
    f32x2 t = __builtin_shufflevector(a, a, 0, 1) * __builtin_shufflevector(b, b, 0, 1);
    t = __builtin_shufflevector(a, a, 2, 3) * __builtin_shufflevector(b, b, 2, 3) + t;
    return t[0] + t[1];
}
__device__ __forceinline__ void reduce16x2(float& a, float& b) {
    a += dppf<0xB1>(a); b += dppf<0xB1>(b); a += dppf<0x4E>(a); b += dppf<0x4E>(b);
    a += dppf<0x141>(a); b += dppf<0x141>(b); a += dppf<0x140>(a); b += dppf<0x140>(b);
}
__device__ __forceinline__ void scan_unit(const Params& p, int unit) {
    unsigned char* ws = p.ws;
    const int bh = unit >> 2, vr0 = (unit & 3) * 16, tid = threadIdx.x, wave = tid >> 6, lane = tid & 63;
    const _Float16* SI = (const _Float16*)(ws + R_SI);
    constexpr size_t SIE = (size_t)MP * 512;
    float* Y = (float*)(ws + O_Y);
    const size_t hb = (size_t)bh * TP * 64;
    __syncthreads();
    if (wave >= 4) {
        const int i = tid - 256, ip = i >= 8 ? i - 8 : i;
        const int arrs[5] = {SI_R, SI_W, SI_K, SI_KK, SI_B};
        u32x4 rg[5], rp[3]; unsigned rv;
        auto issue = [&](int c) {
            const size_t off = hb + (size_t)c * SC_TC * 64;
#pragma unroll
            for (int a = 0; a < 5; ++a) rg[a] = *(const u32x4*)(SI + arrs[a] * SIE + off + i * 8);
            rp[0] = *(const u32x4*)(SI + SI_W * SIE + off + ip * 8);
            rp[1] = *(const u32x4*)(SI + SI_K * SIE + off + ip * 8);
            rp[2] = *(const u32x4*)(SI + SI_B * SIE + off + ip * 8);
            rv = *(const unsigned*)(SI + SI_V * SIE + off + (i >> 3) * 64 + vr0 + (i & 7) * 2);
        };
        auto commit = [&](int bufi) {
            float* buf = (float*)(smem + bufi * SC_BUF);
            float f[5][8];
#pragma unroll
            for (int a = 0; a < 5; ++a) {
                const h16x8 hv = __builtin_bit_cast(h16x8, rg[a]);
#pragma unroll
                for (int e = 0; e < 8; ++e) f[a][e] = (float)hv[e];
            }
            const bool odd = (i >> 3) & 1;
            float ckk = 0.f, cbk = 0.f;
            {
                const h16x8 pw = __builtin_bit_cast(h16x8, rp[0]), pk = __builtin_bit_cast(h16x8, rp[1]), pb = __builtin_bit_cast(h16x8, rp[2]);
#pragma unroll
                for (int e = 0; e < 8; ++e) {
                    const float kk2 = f[3][e];
                    ckk += (float)pk[e] * kk2; cbk += (float)pb[e] * kk2;
                    if (odd) f[3][e] = (1.0f - (float)pw[e]) * kk2;
                }
            }
            ckk += dppf<0xB1>(ckk); cbk += dppf<0xB1>(cbk); ckk += dppf<0x4E>(ckk); cbk += dppf<0x4E>(cbk); ckk += dppf<0x141>(ckk); cbk += dppf<0x141>(cbk);
#pragma unroll
            for (int a = 0; a < 5; ++a) {
                f32x4 lo, hi;
#pragma unroll
                for (int e = 0; e < 4; ++e) { lo[e] = f[a][e]; hi[e] = f[a][4 + e]; }
                if (a == 1) { lo = 1.0f - lo; hi = 1.0f - hi; }
                if (a == 4) { lo = -lo; hi = -hi; }
                *(f32x4*)(buf + a * SC_ARR + i * 8) = lo; *(f32x4*)(buf + a * SC_ARR + i * 8 + 4) = hi;
            }
            const h16x2 v2 = __builtin_bit_cast(h16x2, rv);
            f32x2 vf; vf[0] = (float)v2[0]; vf[1] = (float)v2[1];
            *(f32x2*)(buf + SC_VOFF + (i >> 3) * 16 + (i & 7) * 2) = vf;
            if (odd && (i & 7) == 0) { f32x2 cf; cf[0] = ckk; cf[1] = cbk; *(f32x2*)(buf + SC_COFF + (i >> 4) * 2) = cf; }
        };
        auto yout = [&](int c) {
            const float* yb = (const float*)(smem + SC_YOFF + (c & 1) * SC_YBUF);
            const f32x2 v = *(const f32x2*)(yb + (i >> 3) * 16 + (i & 7) * 2);
            *(f32x2*)(Y + hb + (size_t)(c * SC_TC + (i >> 3)) * 64 + vr0 + (i & 7) * 2) = v;
        };
        issue(0); commit(0); issue(1);
        __syncthreads();
        for (int c = 0; c < SC_NC; ++c) {
            if (c > 0) yout(c - 1);
            if (c + 1 < SC_NC) commit((c + 1) & 1);
            if (c + 2 < SC_NC) issue(c + 2);
            __syncthreads();
        }
        yout(SC_NC - 1);
    } else {
        const int rl = wave * 4 + (lane >> 4), sub = lane & 15;
        f32x4 S = {0.f, 0.f, 0.f, 0.f};
        __syncthreads();
        for (int c = 0; c < SC_NC; ++c) {
            const float* buf = (const float*)(smem + (c & 1) * SC_BUF);
            float* yb = (float*)(smem + SC_YOFF + (c & 1) * SC_YBUF);
            const float* bp = buf + sub * 4;
#define SC_LD(arr, s) (*(const f32x4*)(bp + (arr) * SC_ARR + (s) * 64))
            f32x4 r1 = SC_LD(0, 0), w1 = SC_LD(1, 0), k1 = SC_LD(2, 0), q1 = SC_LD(3, 0), n1 = SC_LD(4, 0);
            f32x4 r2 = SC_LD(0, 1), w2 = SC_LD(1, 1), k2 = SC_LD(2, 1), g2 = SC_LD(3, 1), n2 = SC_LD(4, 1);
            float v1 = buf[SC_VOFF + rl], v2 = buf[SC_VOFF + 16 + rl];
            f32x2 cf = *(const f32x2*)(buf + SC_COFF);
#pragma unroll 4
            for (int pr = 0; pr < SC_TC / 2; ++pr) {
                const int sn = 2 * pr + 2;
                const f32x4 r1n = SC_LD(0, sn), w1n = SC_LD(1, sn), k1n = SC_LD(2, sn), q1n = SC_LD(3, sn), n1n = SC_LD(4, sn);
                const f32x4 r2n = SC_LD(0, sn + 1), w2n = SC_LD(1, sn + 1), k2n = SC_LD(2, sn + 1), g2n = SC_LD(3, sn + 1), n2n = SC_LD(4, sn + 1);
                const float v1n = buf[SC_VOFF + sn * 16 + rl], v2n = buf[SC_VOFF + (sn + 1) * 16 + rl];
                const f32x2 cfn = *(const f32x2*)(buf + SC_COFF + (pr + 1) * 2);
                __builtin_amdgcn_sched_barrier(0);
                float d1 = dot4(S, q1), e2 = dot4(S, g2);
                const f32x4 t1 = S * w1 + v1 * k1;
                reduce16x2(d1, e2);
                const float d2 = e2 + v1 * cf[0] - d1 * cf[1];
                const f32x4 S1 = t1 + d1 * n1;
                const f32x4 S2 = (S1 * w2 + v2 * k2) + d2 * n2;
                float y1 = dot4(S1, r1), y2 = dot4(S2, r2);
                reduce16x2(y1, y2);
                yb[(2 * pr) * 16 + rl] = y1; yb[(2 * pr + 1) * 16 + rl] = y2;
                S = S2;
                r1 = r1n; w1 = w1n; k1 = k1n; q1 = q1n; n1 = n1n; r2 = r2n; w2 = w2n; k2 = k2n; g2 = g2n; n2 = n2n; v1 = v1n; v2 = v2n; cf = cfn;
            }
#undef SC_LD
            __syncthreads();
        }
    }
}

constexpr int KLD = 72;
__device__ __forceinline__ void attn_unit(const Params& p, int unit) {
    unsigned char* ws = p.ws;
    const int qt = unit % 65, bh = unit / 65, b = bh >> 3, h = bh & 7;
    const int tid = threadIdx.x, wave = tid >> 6, lane = tid & 63, fr = lane & 15, fq = lane >> 4;
    const bf16_t* Q = (const bf16_t*)(ws + R_QKV) + (size_t)bh * TP * 64;
    const bf16_t* Kg = Q + QKV_ONE / 2;
    const bf16_t* Vg = Q + QKV_ONE;
    bf16_t* Ks = (bf16_t*)smem;
    bf16_t* Vt = Ks + 64 * KLD;
    volatile int* flags = (volatile int*)(smem + 2 * 64 * KLD * 2);
    const int t0 = qt * 128, tq = t0 + wave * 16 + fr;
    bf16x8 qf[2];
    qf[0] = *(const bf16x8*)(Q + (size_t)tq * 64 + fq * 8);
    qf[1] = *(const bf16x8*)(Q + (size_t)tq * 64 + 32 + fq * 8);
    float qs = 0.f;
#pragma unroll
    for (int s = 0; s < 2; ++s)
#pragma unroll
        for (int e = 0; e < 8; ++e) { const float f = bf2f((unsigned short)qf[s][e]); qs += f * f; }
    qs += __shfl_xor(qs, 16); qs += __shfl_xor(qs, 32);
    const f32x4 km4 = *(const f32x4*)((const float*)(ws + WS_CTL) + 16 + bh * 4);
    const float kmax = sqrtf(fmaxf(fmaxf(km4[0], km4[1]), fmaxf(km4[2], km4[3])));
    const float zb = sqrtf(qs) * kmax * 1.0001f + 88.0f;
    float Arow = 0.f;
    f32x4 O[4];
#pragma unroll
    for (int nd = 0; nd < 4; ++nd) O[nd] = (f32x4){0.f, 0.f, 0.f, 0.f};
    for (int kb = qt * 2 + 1; kb >= 0; --kb) {
        const bool done = __all(Arow > zb);
        if (lane == 0) flags[wave] = done ? 1 : 0;
        __syncthreads();
        int alld = 1;
#pragma unroll
        for (int w = 0; w < 8; ++w) alld &= flags[w];
        if (alld) break;
        {
            const int key = tid >> 3, dc = (tid & 7) * 8;
            const u32x4 kvv = *(const u32x4*)(Kg + (size_t)(kb * 64 + key) * 64 + dc);
            const u32x4 vvv = *(const u32x4*)(Vg + (size_t)(kb * 64 + key) * 64 + dc);
            *(u32x4*)(Ks + key * KLD + dc) = kvv;
#pragma unroll
            for (int e = 0; e < 4; ++e) { Vt[(dc + 2 * e) * KLD + key] = (bf16_t)(vvv[e] & 0xffffu); Vt[(dc + 2 * e + 1) * KLD + key] = (bf16_t)(vvv[e] >> 16); }
        }
        __syncthreads();
        f32x4 z[4];
#pragma unroll
        for (int n = 0; n < 4; ++n) {
            z[n] = (f32x4){0.f, 0.f, 0.f, 0.f};
#pragma unroll
            for (int s = 0; s < 2; ++s) {
                const bf16x8 kf = *(const bf16x8*)(Ks + (n * 16 + fr) * KLD + s * 32 + fq * 8);
                z[n] = __builtin_amdgcn_mfma_f32_16x16x32_bf16(kf, qf[s], z[n], 0, 0, 0);
            }
        }
        float sp[4][4], lt[4], ex[4], sg[4];
#pragma unroll
        for (int n = 0; n < 4; ++n) {
#pragma unroll
            for (int j = 0; j < 4; ++j) { const int s = kb * 64 + n * 16 + fq * 4 + j; sp[n][j] = s < tq ? softplusf_(z[n][j]) : 0.f; }
            sp[n][2] += sp[n][3]; sp[n][1] += sp[n][2]; sp[n][0] += sp[n][1];
            lt[n] = sp[n][0];
            const float a = __shfl_xor(lt[n], 16), pr = lt[n] + a, c = __shfl_xor(pr, 32);
            ex[n] = fq == 3 ? 0.f : (fq == 2 ? a : (fq == 1 ? c : a + c));
            sg[n] = pr + c;
        }
        float nsuf[4]; nsuf[3] = 0.f; nsuf[2] = sg[3]; nsuf[1] = nsuf[2] + sg[2]; nsuf[0] = nsuf[1] + sg[1];
        float wgt[4][4];
#pragma unroll
        for (int n = 0; n < 4; ++n)
#pragma unroll
            for (int j = 0; j < 4; ++j) {
                const int s = kb * 64 + n * 16 + fq * 4 + j;
                const float C = Arow + nsuf[n] + ex[n] + sp[n][j];
                wgt[n][j] = s < tq ? __expf(z[n][j] - C) : 0.f;
            }
        Arow += nsuf[0] + sg[0];
#pragma unroll
        for (int ks = 0; ks < 2; ++ks) {
            u32x4 pw; pw.x = pk_bf16(wgt[2 * ks][0], wgt[2 * ks][1]); pw.y = pk_bf16(wgt[2 * ks][2], wgt[2 * ks][3]);
            pw.z = pk_bf16(wgt[2 * ks + 1][0], wgt[2 * ks + 1][1]); pw.w = pk_bf16(wgt[2 * ks + 1][2], wgt[2 * ks + 1][3]);
            const bf16x8 pf = __builtin_bit_cast(bf16x8, pw);
#pragma unroll
            for (int nd = 0; nd < 4; ++nd) {
                u32x4 vw;
                const u32x2 v0 = *(const u32x2*)(Vt + (nd * 16 + fr) * KLD + (2 * ks) * 16 + fq * 4);
                const u32x2 v1 = *(const u32x2*)(Vt + (nd * 16 + fr) * KLD + (2 * ks + 1) * 16 + fq * 4);
                vw.x = v0.x; vw.y = v0.y; vw.z = v1.x; vw.w = v1.y;
                O[nd] = __builtin_amdgcn_mfma_f32_16x16x32_bf16(pf, __builtin_bit_cast(bf16x8, vw), O[nd], 0, 0, 0);
            }
        }
    }
    __syncthreads();
    bf16_t* osb = (bf16_t*)(ws + O_OSB);
#pragma unroll
    for (int j = 0; j < 4; ++j) {
        const int t = t0 + wave * 16 + fq * 4 + j;
        if (t >= NMETA && t < T) {
#pragma unroll
            for (int nd = 0; nd < 4; ++nd) osb[(size_t)(b * SEQ + t - NMETA) * 512 + h * 64 + nd * 16 + fr] = (bf16_t)(pk_bf16(O[nd][j], 0.f) & 0xffffu);
        }
    }
}

constexpr int N_SCAN = 128, N_ATTN = 32 * 65;
__device__ __forceinline__ void phase3(const Params& p, int cw = 0, int first = 0, int last = N_SCAN + N_ATTN) {
    unsigned* ctr = (unsigned*)(p.ws + WS_CTL) + cw;
    volatile int* slot = (volatile int*)(smem + LDS_BYTES - 16);
    for (;;) {
        __syncthreads();
        if (threadIdx.x == 0) *slot = (int)atomicAdd(ctr, 1u);
        __syncthreads();
        const int u = *slot + first;
        if (u >= last) break;
        if (u < N_SCAN) scan_unit(p, u); else attn_unit(p, u - N_SCAN);
    }
}

__device__ __forceinline__ void phase3c(const Params& p) {
    unsigned char* ws = p.ws;
    const _Float16* SI = (const _Float16*)(ws + R_SI);
    constexpr size_t SIE = (size_t)MP * 512;
    const float* Y = (const float*)(ws + O_Y);
    const bf16_t* G = (const bf16_t*)(ws + R_G);
    bf16_t* orw = (bf16_t*)(ws + O_ORW);
    const int tid = threadIdx.x, sub = tid & 15;
    for (int it = blockIdx.x; it < 32 * 256; it += gridDim.x) {
        const int bh = it >> 8, ch = it & 255, b = bh >> 3, h = bh & 7;
        const int t = NMETA + ch * 32 + (tid >> 4);
        const size_t base = ((size_t)bh * TP + t) * 64 + sub * 4;
        const f32x4 y = *(const f32x4*)(Y + base);
        const float mean = reduce16((y[0] + y[1]) + (y[2] + y[3])) * (1.0f / 64.0f);
        const f32x4 dy = y - mean;
        const float var = reduce16((dy[0] * dy[0] + dy[1] * dy[1]) + (dy[2] * dy[2] + dy[3] * dy[3])) * (1.0f / 64.0f);
        const float rs = rsqrtf(var + GN_EPS);
        const int c = h * 64 + sub * 4;
        const f32x4 gain = *(const f32x4*)(p.in[14] + c), bias = *(const f32x4*)(p.in[15] + c), rk = *(const f32x4*)(p.in[13] + c);
        const size_t pbase = ((size_t)bh * TP + t) * 64 + (sub & 3) * 16 + (sub >> 2) * 4;
        const h16x4 r4 = *(const h16x4*)(SI + SI_R * SIE + pbase), k4 = *(const h16x4*)(SI + SI_K * SIE + pbase), v4 = *(const h16x4*)(SI + SI_V * SIE + base);
        float bs = 0.f;
#pragma unroll
        for (int j = 0; j < 4; ++j) bs += (float)r4[j] * (float)k4[j] * rk[j];
        bs = reduce16(bs);
        const u32x2 g2 = *(const u32x2*)(G + pbase);
        const float gg[4] = {__uint_as_float(g2.x << 16), __uint_as_float(g2.x & 0xffff0000u), __uint_as_float(g2.y << 16), __uint_as_float(g2.y & 0xffff0000u)};
        float o[4];
#pragma unroll
        for (int j = 0; j < 4; ++j) o[j] = (dy[j] * rs * gain[j] + bias[j] + bs * (float)v4[j]) * gg[j];
        u32x2 w; w.x = pk_bf16(o[0], o[1]); w.y = pk_bf16(o[2], o[3]);
        *(u32x2*)(orw + (size_t)(b * SEQ + t - NMETA) * 512 + c) = w;
    }
}

__device__ __forceinline__ void phase4(const Params& p) {
    unsigned char* ws = p.ws;
    EpiBranch1 e1{(float*)(ws + O_T1), (const bf16_t*)p.out};
    EpiBranch2 e2{(const float*)(ws + O_T1), (const bf16_t*)p.out, (bf16_t*)(ws + O_M)};
    gemm_phase((const bf16_t*)(ws + O_OSB), (const bf16_t*)(ws + WS_WSB), 512, MS / BM, D / BM, e1);
    gemm_phase((const bf16_t*)(ws + O_ORW), (const bf16_t*)(ws + WS_WRW), 512, MS / BM, D / BM, e2);
}
__device__ __forceinline__ void phase5(const Params& p) {
    unsigned char* ws = p.ws;
    EpiF32 e{(float*)(ws + O_P)};
    gemm_phase((const bf16_t*)(ws + O_M), (const bf16_t*)(ws + WS_WOUT), D, MS / BM, D / BM, e);
}
__device__ __forceinline__ void phase6(const Params& p) {
    unsigned char* ws = p.ws;
    const int lane = threadIdx.x & 63;
    for (int it = blockIdx.x; it < MS / 8; it += gridDim.x) {
        const int row = it * 8 + (threadIdx.x >> 6);
        const float* pr = (const float*)(ws + O_P) + (size_t)row * D;
        const float* xr = p.in[0] + (size_t)row * D;
        f32x4 v[4]; float ss = 0.f;
#pragma unroll
        for (int j = 0; j < 4; ++j) { v[j] = *(const f32x4*)(pr + 4 * lane + 256 * j); ss += (v[j][0] * v[j][0] + v[j][1] * v[j][1]) + (v[j][2] * v[j][2] + v[j][3] * v[j][3]); }
        const float rs = rsqrtf(wave_sum(ss) * (1.0f / D) + RMS_EPS);
        float s2 = 0.f;
#pragma unroll
        for (int j = 0; j < 4; ++j) {
            const f32x4 g = *(const f32x4*)(p.in[3] + 4 * lane + 256 * j), x = *(const f32x4*)(xr + 4 * lane + 256 * j);
            v[j] = x + v[j] * rs * g;
            *(f32x4*)(p.out + (size_t)row * D + 4 * lane + 256 * j) = v[j];
            s2 += (v[j][0] * v[j][0] + v[j][1] * v[j][1]) + (v[j][2] * v[j][2] + v[j][3] * v[j][3]);
        }
        const float rs2 = rsqrtf(wave_sum(s2) * (1.0f / D) + RMS_EPS);
        bf16_t* fr_ = (bf16_t*)(ws + O_F) + (size_t)row * D;
#pragma unroll
        for (int j = 0; j < 4; ++j) {
            const f32x4 g = *(const f32x4*)(p.in[19] + 4 * lane + 256 * j);
            u32x2 w; w.x = pk_bf16(v[j][0] * rs2 * g[0], v[j][1] * rs2 * g[1]); w.y = pk_bf16(v[j][2] * rs2 * g[2], v[j][3] * rs2 * g[3]);
            *(u32x2*)(fr_ + 4 * lane + 256 * j) = w;
        }
    }
}
__device__ __forceinline__ void phase7(const Params& p) {
    unsigned char* ws = p.ws;
    EpiGU e{(bf16_t*)(ws + O_ACT)};
    gemm_phase((const bf16_t*)(ws + O_F), (const bf16_t*)(ws + WS_WGU), D, MS / BM, 2 * DFF / BM, e);
}
__device__ __forceinline__ void phase8(const Params& p) {
    unsigned char* ws = p.ws;
    EpiF32 e{(float*)(ws + O_DN)};
    gemm_phase((const bf16_t*)(ws + O_ACT), (const bf16_t*)(ws + WS_WD), DFF, MS / BM, D / BM, e);
}
__device__ __forceinline__ void phase9(const Params& p) {
    unsigned char* ws = p.ws;
    const int lane = threadIdx.x & 63;
    for (int it = blockIdx.x; it < MS / 8; it += gridDim.x) {
        const int row = it * 8 + (threadIdx.x >> 6);
        const float* dr = (const float*)(ws + O_DN) + (size_t)row * D;
        f32x4 v[4]; float ss = 0.f;
#pragma unroll
        for (int j = 0; j < 4; ++j) { v[j] = *(const f32x4*)(dr + 4 * lane + 256 * j); ss += (v[j][0] * v[j][0] + v[j][1] * v[j][1]) + (v[j][2] * v[j][2] + v[j][3] * v[j][3]); }
        const float rs = rsqrtf(wave_sum(ss) * (1.0f / D) + RMS_EPS);
#pragma unroll
        for (int j = 0; j < 4; ++j) {
            const f32x4 g = *(const f32x4*)(p.in[20] + 4 * lane + 256 * j);
            float* o = p.out + (size_t)row * D + 4 * lane + 256 * j;
            const f32x4 h1 = *(const f32x4*)o;
            *(f32x4*)o = h1 + v[j] * rs * g;
        }
    }
}

constexpr int N_PHASES = 11;
__device__ __forceinline__ void run_phase(const Params& p, int ph) {
    switch (ph) {
        case 0: phase0(p); break;
        case 1: phase1(p); break;
        case 2: phase2(p); break;
        case 3: phase3(p); break;
        case 4: phase3c(p); break;
        case 5: phase4(p); break;
        case 6: phase5(p); break;
        case 7: phase6(p); break;
        case 8: phase7(p); break;
        case 9: phase8(p); break;
        default: phase9(p); break;
    }
}

#if MULTI_LAUNCH
template <int PH> __global__ void __launch_bounds__(512) fwd_phase(Params p) { run_phase(p, PH); }
#else
__global__ void __launch_bounds__(512) fwd_mega(Params p) {
    cg::grid_group grid = cg::this_grid();
    phase0(p); grid.sync(); phase1(p); grid.sync(); phase2(p); grid.sync(); phase3(p); grid.sync(); phase3c(p); grid.sync();
    phase4(p); grid.sync(); phase5(p); grid.sync(); phase6(p); grid.sync(); phase7(p); grid.sync(); phase8(p); grid.sync(); phase9(p);
}
#endif

extern "C" void kernel_launch(void* const* d_in, const int* in_sizes, int n_in, void* d_out, int out_size, void* d_ws, size_t ws_size, hipStream_t stream) {
    static int grid = 0;
    if (grid == 0) {
        if (n_in != 24 || out_size != MS * D || ws_size < WS_END) { fprintf(stderr, "kernel_launch: unexpected shapes (n_in %d out %d ws %zu need %zu)\n", n_in, out_size, ws_size, (size_t)WS_END); grid = -1; return; }
        int dev = 0, cus = 0, per_cu = 0;
        (void)hipGetDevice(&dev);
        (void)hipDeviceGetAttribute(&cus, hipDeviceAttributeMultiprocessorCount, dev);
#if MULTI_LAUNCH
        per_cu = 1;
#else
        (void)hipFuncSetAttribute((const void*)fwd_mega, hipFuncAttributeMaxDynamicSharedMemorySize, LDS_BYTES);
        (void)hipOccupancyMaxActiveBlocksPerMultiprocessor(&per_cu, (const void*)fwd_mega, 512, LDS_BYTES);
        if (per_cu < 1) { fprintf(stderr, "kernel_launch: occupancy query says %d blocks per CU\n", per_cu); per_cu = 1; }
        if (per_cu > 1) per_cu = 1;
#endif
        grid = cus * per_cu;
    }
    if (grid < 0) return;
    Params p{};
    for (int i = 0; i < 24; ++i) p.in[i] = (const float*)d_in[i];
    p.out = (float*)d_out; p.ws = (unsigned char*)d_ws;
#if MULTI_LAUNCH
#define LP(PH) do { (void)hipFuncSetAttribute((const void*)fwd_phase<PH>, hipFuncAttributeMaxDynamicSharedMemorySize, LDS_BYTES); hipLaunchKernelGGL(fwd_phase<PH>, dim3(grid), dim3(512), LDS_BYTES, stream, p); } while (0)
    LP(0); LP(1); LP(2); LP(3); LP(4); LP(5); LP(6); LP(7); LP(8); LP(9); LP(10);
#undef LP
#else
    void* args[] = {&p};
    hipError_t e = hipLaunchCooperativeKernel((const void*)fwd_mega, dim3(grid), dim3(512), args, LDS_BYTES, stream);
    if (e != hipSuccess) fprintf(stderr, "cooperative launch failed: %s (grid %d)\n", hipGetErrorString(e), grid);
#endif
}
```

```cpp
#include <hip/hip_runtime.h>
#include <hip/hip_cooperative_groups.h>
#include <cstdio>
#include <cstdint>
#include <type_traits>
namespace cg = cooperative_groups;

#ifndef MULTI_LAUNCH
#define MULTI_LAUNCH 0
#endif

typedef unsigned short bf16_t;
typedef short bf16x8 __attribute__((ext_vector_type(8)));
typedef float f32x4 __attribute__((ext_vector_type(4)));
typedef float f32x2 __attribute__((ext_vector_type(2)));
typedef unsigned u32x2 __attribute__((ext_vector_type(2)));
typedef unsigned u32x4 __attribute__((ext_vector_type(4)));
typedef _Float16 h16x2 __attribute__((ext_vector_type(2)));
typedef _Float16 h16x4 __attribute__((ext_vector_type(4)));
typedef _Float16 h16x8 __attribute__((ext_vector_type(8)));

constexpr int D = 1024, NB = 4, SEQ = 8192, NMETA = 16, T = SEQ + NMETA, TP = 8320, MP = NB * TP, MS = NB * SEQ;
constexpr int PIN = 5376, DFF = 2816, NH = 8, RWS = 1792;
constexpr float RMS_EPS = 1e-6f, GN_EPS = 64e-5f;

constexpr size_t WS_CTL = 0;
constexpr size_t WS_BAR = 4096;
constexpr size_t WS_CTL_BYTES = 32768;
constexpr size_t WS_WIN = WS_CTL_BYTES;
constexpr size_t WS_WSB = WS_WIN + (size_t)PIN * D * 2;
constexpr size_t WS_WRW = WS_WSB + (size_t)D * 512 * 2;
constexpr size_t WS_WOUT = WS_WRW + (size_t)D * 512 * 2;
constexpr size_t WS_WGU = WS_WOUT + (size_t)D * D * 2;
constexpr size_t WS_WD = WS_WGU + (size_t)2 * DFF * D * 2;
constexpr size_t WS_WL = WS_WD + (size_t)D * DFF * 2;
constexpr size_t R_QKV = WS_WL + (size_t)512 * 256 * 2;
constexpr size_t QKV_ONE = (size_t)MP * 512 * 2;
constexpr size_t R_URW = R_QKV + 3 * QKV_ONE;
constexpr size_t R_SI = R_URW + (size_t)MP * RWS * 2;
constexpr size_t SI_ONE = (size_t)MP * 512 * 2;
constexpr size_t R_G = R_SI + 6 * SI_ONE;
constexpr size_t WS_END = R_G + SI_ONE;
constexpr size_t O_A0 = R_SI;
constexpr size_t O_Y = R_URW;
constexpr size_t O_OSB = R_URW + (size_t)MP * 512 * 4;
constexpr size_t O_ORW = R_QKV;
constexpr size_t O_T1 = R_SI;
constexpr size_t O_M = R_SI + (size_t)MS * D * 4;
constexpr size_t O_P = R_QKV;
constexpr size_t O_F = R_SI;
constexpr size_t O_ACT = R_QKV;
constexpr size_t O_DN = R_SI + (size_t)MS * D * 2;
static_assert(O_OSB + (size_t)MS * 512 * 2 <= R_SI, "overlay");
static_assert(O_M + (size_t)MS * D * 2 <= WS_END, "overlay");
static_assert(O_ACT + (size_t)MS * DFF * 2 <= R_SI, "overlay");
static_assert(O_DN + (size_t)MS * D * 4 <= WS_END, "overlay");
static_assert(WS_END <= (size_t)512 * 1024 * 1024, "workspace");

constexpr int LDS_BYTES = 131072 + 64;

struct Params { const float* in[24]; float* out; unsigned char* ws; };

extern __shared__ __attribute__((aligned(16))) unsigned char smem[];

typedef __bf16 b16x2 __attribute__((ext_vector_type(2)));
__device__ __forceinline__ unsigned pk_bf16(float lo, float hi) { const f32x2 v = {lo, hi}; return __builtin_bit_cast(unsigned, __builtin_convertvector(v, b16x2)); }
__device__ __forceinline__ float bf2f(unsigned short v) { return __uint_as_float((unsigned)v << 16); }
__device__ __forceinline__ float sigmoidf_(float x) { return __builtin_amdgcn_rcpf(1.0f + __expf(-x)); }
__device__ __forceinline__ float softplusf_(float x) { return fmaxf(x, 0.f) + __logf(1.0f + __expf(-fabsf(x))); }
template <int CTRL> __device__ __forceinline__ float dppf(float x) { return __builtin_bit_cast(float, __builtin_amdgcn_mov_dpp(__builtin_bit_cast(int, x), CTRL, 0xf, 0xf, true)); }
__device__ __forceinline__ float reduce16(float v) {
    v += dppf<0xB1>(v); v += dppf<0x4E>(v); v += dppf<0x141>(v); v += dppf<0x140>(v); return v;
}
__device__ __forceinline__ float wave_sum(float v) {
#pragma unroll
    for (int o = 1; o < 64; o <<= 1) v += __shfl_xor(v, o);
    return v;
}

#define LAS __attribute__((address_space(3)))
#define XB_TMO      128
#define XB_XCNT(j)  (256  + 64 * (j))
#define XB_XSUB(j)  (1280 + 64 * (j))
#define XB_XGEN(j)  (2304 + 64 * (j))
#define XB_TOP      3328
#define XB_TOPGEN   3392
#define XCD_BAR_WORDS 3456
#define XB_SPIN_CAP (1u << 18)
__device__ __forceinline__ unsigned xb_ld(unsigned* p)              { return __hip_atomic_load(p, __ATOMIC_RELAXED, __HIP_MEMORY_SCOPE_AGENT); }
__device__ __forceinline__ unsigned xb_add(unsigned* p, unsigned v) { return __hip_atomic_fetch_add(p, v, __ATOMIC_RELAXED, __HIP_MEMORY_SCOPE_AGENT); }
__device__ __forceinline__ unsigned xb_xcc_id() { return (unsigned)__builtin_amdgcn_s_getreg((3 << 11) | 20) & 0xFu; }
#define XB_SPIN(cond, bar) do { unsigned _sp = 0; while (cond) { __builtin_amdgcn_s_sleep(1); \
    if ((++_sp & 255u) == 0u) { if (xb_ld(&(bar)[XB_TMO])) break; if (_sp > XB_SPIN_CAP) { atomicAdd(&(bar)[XB_TMO], 1u); break; } } } } while (0)
struct XcdBarrier { unsigned* bar; unsigned x; volatile LAS unsigned* st; };
__device__ __forceinline__ XcdBarrier xcd_barrier_post(unsigned* bar, volatile LAS unsigned* st) {
    XcdBarrier b; b.bar = bar; b.x = xb_xcc_id(); b.st = st;
    if (threadIdx.x == 0) (void)xb_add(&bar[XB_XCNT(b.x)], 1u);
    return b;
}
__device__ __forceinline__ void xcd_barrier_complete(unsigned* bar, unsigned x, unsigned& nloc, unsigned& nx) {
    const unsigned G = gridDim.x * gridDim.y * gridDim.z;
    unsigned sum, cnt, mine, sp = 0u;
    for (;;) {
        sum = 0u; cnt = 0u; mine = 0u;
#pragma unroll
        for (unsigned j = 0; j < 16; ++j) { const unsigned c = xb_ld(&bar[XB_XCNT(j)]); sum += c; cnt += (c > 0u) ? 1u : 0u; mine = (j == x) ? c : mine; }
        if (sum == G) break;
        __builtin_amdgcn_s_sleep(1);
        if ((++sp & 255u) == 0u) { if (xb_ld(&bar[XB_TMO])) break; if (sp > XB_SPIN_CAP) { atomicAdd(&bar[XB_TMO], 1u); break; } }
    }
    nloc = mine > 0u ? mine : 1u; nx = cnt > 0u ? cnt : 1u;
}
__device__ __forceinline__ void xcd_barrier(const XcdBarrier& b) {
    asm volatile("s_waitcnt vmcnt(0)" ::: "memory");
    __syncthreads();
    if (threadIdx.x == 0) {
        unsigned* bar = b.bar;
        __builtin_amdgcn_s_waitcnt(0);
        unsigned nloc = b.st[0], nx = b.st[1];
        if (nloc == 0u) { xcd_barrier_complete(bar, b.x, nloc, nx); b.st[0] = nloc; b.st[1] = nx; }
        const unsigned old = xb_add(&bar[XB_XSUB(b.x)], 1u);
        const unsigned gen = old / nloc;
        if (old + 1u == (gen + 1u) * nloc) {
            __builtin_amdgcn_fence(__ATOMIC_RELEASE, "agent");
            asm volatile("s_waitcnt vmcnt(0)" ::: "memory");
            const unsigned og = xb_add(&bar[XB_TOP], 1u);
            const unsigned tg = og / nx;
            if (og + 1u == (tg + 1u) * nx) xb_add(&bar[XB_TOPGEN], 1u);
            else XB_SPIN(xb_ld(&bar[XB_TOPGEN]) == tg, bar);
            __builtin_amdgcn_fence(__ATOMIC_ACQUIRE, "agent");
            xb_add(&bar[XB_XGEN(b.x)], 1u);
            asm volatile("s_waitcnt vmcnt(0)" ::: "memory");
        } else {
            XB_SPIN(xb_ld(&bar[XB_XGEN(b.x)]) == gen, bar);
            __builtin_amdgcn_fence(__ATOMIC_ACQUIRE, "agent");
            asm volatile("s_waitcnt vmcnt(0)" ::: "memory");
        }
    }
    __syncthreads();
}

constexpr int BM = 256, BK = 64, HALF = 128, HTB = HALF * BK * 2, NXCD = 8, WGM = 8;
__device__ __forceinline__ int lds_byte(int r, int c) { const int st = (r >> 4) * 2 + (c >> 5), rr = r & 15, cc = c & 31, ob = rr * 64 + cc * 2; return st * 1024 + (ob ^ (((ob >> 9) & 1) << 5)); }
__device__ __forceinline__ void stage_rc(int b, int& R, int& C) { const int st = b / 1024, sb = b % 1024, swz = sb ^ (((sb >> 9) & 1) << 5); R = (st >> 1) * 16 + swz / 64; C = (st & 1) * 32 + (swz % 64) / 2; }
struct Unit { int pm, pn; };
struct Sched {
    int nM, nN, nwg, G, c;
    __device__ __forceinline__ bool next(int i, Unit& u) const {
        const long L = (long)i * G + c; if (L >= nwg) return false;
        int wgid = (int)L; { const int q = nwg / NXCD, r = nwg % NXCD, xcd = wgid % NXCD, off = wgid / NXCD; wgid = (xcd < r ? xcd * (q + 1) : r * (q + 1) + (xcd - r) * q) + off; }
        const int nig = WGM * nN, gid = wgid / nig, fm = gid * WGM, gsz = (nM - fm) < WGM ? (nM - fm) : WGM;
        u.pm = fm + ((wgid % nig) % gsz); u.pn = (wgid % nig) / gsz; return true;
    }
};

template <class Epi>
__device__ __forceinline__ void gemm_phase(const bf16_t* __restrict__ Ag, const bf16_t* __restrict__ Btg, const int K, const int nM, const int nN, const Epi& E) {
    LAS unsigned char* lds = (LAS unsigned char*)smem;
    const int tid = threadIdx.x, wid = __builtin_amdgcn_readfirstlane(tid >> 6), lane = tid & 63, wr = wid >> 2, wc = wid & 3, fr = lane & 15, fq = lane >> 4;
    const int nt = K / BK;
    Sched S; S.nM = nM; S.nN = nN; S.nwg = nM * nN; S.G = gridDim.x; S.c = blockIdx.x;
    unsigned voffA[2], voffB[2];
#pragma unroll
    for (int i = 0; i < 2; ++i) { int R, C; stage_rc(tid * 16 + i * 8192, R, C); voffA[i] = (unsigned)(R * K + C) * 2u; voffB[i] = voffA[i]; }
    const size_t kstep = (size_t)(BK * 2);
    const size_t hstep = (size_t)HALF * K * 2;
    const size_t tstep = 2 * hstep;
    const unsigned ldsw = (unsigned)wid * 1024u;
    const int aoff = lds_byte(wr * 64 + fr, fq * 8), boff = lds_byte(wc * 32 + fr, fq * 8);
#define PG8_SA(b, h) (((b) * 2 + (h)) * HTB)
#define PG8_SB(b, h) ((4 + (b) * 2 + (h)) * HTB)
#define PG8_STAGE(bufoff, gbase, voff) do { _Pragma("unroll") for (int _i = 0; _i < 2; ++_i) \
        __builtin_amdgcn_global_load_lds((const unsigned*)((const char*)(gbase) + (voff)[_i]), (LAS unsigned*)(lds + (bufoff) + ldsw + _i * 8192), 16, 0, 0); } while (0)
#define PG8_LDA(dst, b, h) do { _Pragma("unroll") for (int m = 0; m < 4; ++m) _Pragma("unroll") for (int k = 0; k < 2; ++k) dst[m][k] = *(const LAS bf16x8*)(lds + PG8_SA(b, h) + aoff + m * 2048 + k * 1024); } while (0)
#define PG8_LDB(dst, b, h) do { _Pragma("unroll") for (int n = 0; n < 2; ++n) _Pragma("unroll") for (int k = 0; k < 2; ++k) dst[n][k] = *(const LAS bf16x8*)(lds + PG8_SB(b, h) + boff + n * 2048 + k * 1024); } while (0)
#define PG8_MMA(ai, bj, At, Bt) do { __builtin_amdgcn_s_setprio(1); _Pragma("unroll") for (int m = 0; m < 4; ++m) _Pragma("unroll") for (int n = 0; n < 2; ++n) _Pragma("unroll") for (int k = 0; k < 2; ++k) \
        acc[ai][bj][m][n] = __builtin_amdgcn_mfma_f32_16x16x32_bf16(Bt[n][k], At[m][k], acc[ai][bj][m][n], 0, 0, 0); __builtin_amdgcn_s_setprio(0); } while (0)
#define PG8_WAIT_V(n) asm volatile("s_waitcnt vmcnt(" #n ")" ::: "memory")
#define PG8_WAIT_L(n) asm volatile("s_waitcnt lgkmcnt(" #n ")" ::: "memory")
#define PG8_BAR __builtin_amdgcn_s_barrier()
#define PG8_SCHED __builtin_amdgcn_sched_barrier(0)
    Unit cur, nxt; int ui = 0;
    __syncthreads();
    if (!S.next(0, cur)) return;
    f32x4 acc[2][2][4][2];
#pragma unroll
    for (int a = 0; a < 2; ++a)
#pragma unroll
        for (int b = 0; b < 2; ++b)
#pragma unroll
            for (int m = 0; m < 4; ++m)
#pragma unroll
                for (int n = 0; n < 2; ++n) acc[a][b][m][n] = (f32x4){0.f, 0.f, 0.f, 0.f};
    bf16x8 At[4][2], B0[2][2], B1[2][2];
    const char* cA = (const char*)Ag + (size_t)cur.pm * tstep; const char* cB = (const char*)Btg + (size_t)cur.pn * tstep;
    PG8_STAGE(PG8_SB(0, 0), cB, voffB); PG8_STAGE(PG8_SA(0, 0), cA, voffA); PG8_STAGE(PG8_SB(0, 1), cB + hstep, voffB); PG8_STAGE(PG8_SA(0, 1), cA + hstep, voffA);
    if (wr == 1) PG8_BAR;
    PG8_WAIT_V(4); PG8_BAR;
    PG8_STAGE(PG8_SB(1, 0), cB + kstep, voffB); PG8_STAGE(PG8_SA(1, 0), cA + kstep, voffA); PG8_STAGE(PG8_SB(1, 1), cB + hstep + kstep, voffB);
    PG8_WAIT_V(6); PG8_BAR;
    for (;;) {
        const bool has_next = S.next(ui + 1, nxt);
        const char* nA = has_next ? (const char*)Ag + (size_t)nxt.pm * tstep : cA; const char* nB = has_next ? (const char*)Btg + (size_t)nxt.pn * tstep : cB;
        for (int t = 0; t < nt; t += 2) {
            const bool last = (t == nt - 2);
            const char* a1 = cA + (size_t)(t + 1) * kstep;
            const char* a2 = last ? nA : cA + (size_t)(t + 2) * kstep; const char* b2 = last ? nB : cB + (size_t)(t + 2) * kstep;
            const char* a3 = a2 + kstep; const char* b3 = b2 + kstep;
            PG8_LDB(B0, 0, 0); PG8_SCHED; PG8_LDA(At, 0, 0); PG8_STAGE(PG8_SA(1, 1), a1 + hstep, voffA);
            PG8_WAIT_L(8); PG8_BAR; PG8_WAIT_L(0); PG8_MMA(0, 0, At, B0); PG8_BAR; PG8_SCHED;
            PG8_LDB(B1, 0, 1); PG8_STAGE(PG8_SB(0, 0), b2, voffB);
            PG8_BAR; PG8_WAIT_L(0); PG8_MMA(0, 1, At, B1); PG8_BAR;
            PG8_LDA(At, 0, 1); PG8_STAGE(PG8_SA(0, 0), a2, voffA);
            PG8_BAR; PG8_WAIT_L(0); PG8_MMA(1, 0, At, B0); PG8_BAR; PG8_SCHED;
            PG8_STAGE(PG8_SB(0, 1), b2 + hstep, voffB);
            PG8_WAIT_V(6); PG8_BAR; PG8_MMA(1, 1, At, B1); PG8_BAR;
            PG8_LDB(B0, 1, 0); PG8_SCHED; PG8_LDA(At, 1, 0); PG8_STAGE(PG8_SA(0, 1), a2 + hstep, voffA);
            PG8_WAIT_L(8); PG8_BAR; PG8_WAIT_L(0); PG8_MMA(0, 0, At, B0); PG8_BAR; PG8_SCHED;
            PG8_LDB(B1, 1, 1); PG8_STAGE(PG8_SB(1, 0), b3, voffB);
            PG8_BAR; PG8_WAIT_L(0); PG8_MMA(0, 1, At, B1); PG8_BAR;
            PG8_LDA(At, 1, 1); PG8_STAGE(PG8_SA(1, 0), a3, voffA);
            PG8_BAR; PG8_WAIT_L(0); PG8_MMA(1, 0, At, B0); PG8_BAR; PG8_SCHED;
            PG8_STAGE(PG8_SB(1, 1), b3 + hstep, voffB);
            PG8_WAIT_V(6); PG8_BAR; PG8_MMA(1, 1, At, B1); PG8_BAR;
        }
        {
            const int brow = cur.pm * BM, bcol = cur.pn * BM;
#pragma unroll
            for (int ai = 0; ai < 2; ++ai)
#pragma unroll
                for (int m = 0; m < 4; ++m) {
#pragma unroll
                    for (int bj = 0; bj < 2; ++bj)
                        E(brow + ai * HALF + wr * 64 + m * 16 + fr, bcol + bj * HALF + wc * 32, fq, acc[ai][bj][m][0], acc[ai][bj][m][1]);
                    asm volatile("" ::: "memory");
                }
        }
        if (!has_next) break;
#pragma unroll
        for (int a = 0; a < 2; ++a)
#pragma unroll
            for (int b = 0; b < 2; ++b)
#pragma unroll
                for (int m = 0; m < 4; ++m)
#pragma unroll
                    for (int n = 0; n < 2; ++n) acc[a][b][m][n] = (f32x4){0.f, 0.f, 0.f, 0.f};
        cur = nxt; cA = nA; cB = nB; ++ui;
    }
    PG8_WAIT_V(0);
    if (wr == 0) PG8_BAR;
    PG8_BAR;
#undef PG8_SA
#undef PG8_SB
#undef PG8_STAGE
#undef PG8_LDA
#undef PG8_LDB
#undef PG8_MMA
#undef PG8_WAIT_V
#undef PG8_WAIT_L
#undef PG8_BAR
#undef PG8_SCHED
}

struct EpiInProj {
    bf16_t* qkv; _Float16* urw; bf16_t* gates;
    __device__ __forceinline__ void one(int row, int col, const f32x4& v) const {
        if (col < 1536) {
            const int which = col >> 9, hc = col & 511, h = hc >> 6, d = hc & 63, b = row / TP, t = row - b * TP;
            const float s = which == 0 ? 0.125f : 1.0f;
            u32x2 w; w.x = pk_bf16(v[0] * s, v[1] * s); w.y = pk_bf16(v[2] * s, v[3] * s);
            *(u32x2*)(qkv + (size_t)which * (QKV_ONE / 2) + ((size_t)(b * NH + h) * TP + t) * 64 + d) = w;
        } else if (col < 3328) {
            h16x4 o; o[0] = (_Float16)v[0]; o[1] = (_Float16)v[1]; o[2] = (_Float16)v[2]; o[3] = (_Float16)v[3];
            *(h16x4*)(urw + (size_t)row * RWS + (col - 1536)) = o;
        } else {
            const int b = row / TP, t = row - b * TP;
            if (t >= NMETA && t < T) {
                u32x2 w; w.x = pk_bf16(sigmoidf_(v[0]), sigmoidf_(v[1])); w.y = pk_bf16(sigmoidf_(v[2]), sigmoidf_(v[3]));
                *(u32x2*)(gates + (size_t)(b * SEQ + t - NMETA) * 2048 + (col - 3328)) = w;
            }
        }
    }
    __device__ __forceinline__ void operator()(int row, int col32, int fq, const f32x4& v0, const f32x4& v1) const {
        if (col32 >= 1536 && col32 < 3072) {
            const int c = col32 - 1536, pos = (c & ~63) + fq * 16 + ((c & 63) >> 4) * 4;
            h16x8 o;
#pragma unroll
            for (int j = 0; j < 4; ++j) { o[j] = (_Float16)v0[j]; o[4 + j] = (_Float16)v1[j]; }
            *(h16x8*)(urw + (size_t)row * RWS + pos) = o;
        } else { one(row, col32 + 4 * fq, v0); one(row, col32 + 16 + 4 * fq, v1); }
    }
};
struct EpiBranch1 {
    float* t1; const bf16_t* gates;
    __device__ __forceinline__ void one(int row, int col, const f32x4& v) const {
        const u32x2 g = *(const u32x2*)(gates + (size_t)row * 2048 + col);
        f32x4 o; o[0] = v[0] * __uint_as_float(g.x << 16); o[1] = v[1] * __uint_as_float(g.x & 0xffff0000u); o[2] = v[2] * __uint_as_float(g.y << 16); o[3] = v[3] * __uint_as_float(g.y & 0xffff0000u);
        *(f32x4*)(t1 + (size_t)row * D + col) = o;
    }
    __device__ __forceinline__ void operator()(int row, int col32, int fq, const f32x4& v0, const f32x4& v1) const { one(row, col32 + 4 * fq, v0); one(row, col32 + 16 + 4 * fq, v1); }
};
struct EpiBranch2 {
    const float* t1; const bf16_t* gates; bf16_t* m;
    __device__ __forceinline__ void one(int row, int col, const f32x4& v) const {
        const u32x2 g = *(const u32x2*)(gates + (size_t)row * 2048 + 1024 + col);
        const f32x4 a = *(const f32x4*)(t1 + (size_t)row * D + col);
        f32x4 o; o[0] = a[0] + v[0] * __uint_as_float(g.x << 16); o[1] = a[1] + v[1] * __uint_as_float(g.x & 0xffff0000u); o[2] = a[2] + v[2] * __uint_as_float(g.y << 16); o[3] = a[3] + v[3] * __uint_as_float(g.y & 0xffff0000u);
        u32x2 w; w.x = pk_bf16(o[0], o[1]); w.y = pk_bf16(o[2], o[3]);
        *(u32x2*)(m + (size_t)row * D + col) = w;
    }
    __device__ __forceinline__ void operator()(int row, int col32, int fq, const f32x4& v0, const f32x4& v1) const { one(row, col32 + 4 * fq, v0); one(row, col32 + 16 + 4 * fq, v1); }
};
struct EpiF32 {
    float* o;
    __device__ __forceinline__ void operator()(int row, int col32, int fq, const f32x4& v0, const f32x4& v1) const {
        *(f32x4*)(o + (size_t)row * D + col32 + 4 * fq) = v0; *(f32x4*)(o + (size_t)row * D + col32 + 16 + 4 * fq) = v1;
    }
};
struct EpiGU {
    bf16_t* act;
    __device__ __forceinline__ void operator()(int row, int col32, int fq, const f32x4& v0, const f32x4& v1) const {
        float o[4];
#pragma unroll
        for (int j = 0; j < 4; ++j) o[j] = v0[j] * sigmoidf_(v0[j]) * v1[j];
        u32x2 w; w.x = pk_bf16(o[0], o[1]); w.y = pk_bf16(o[2], o[3]);
        *(u32x2*)(act + (size_t)row * DFF + (col32 >> 5) * 16 + 4 * fq) = w;
    }
};

__device__ __forceinline__ void transpose_tile(const float* __restrict__ src, int K, int N, bf16_t* __restrict__ dst, int ldd, int koff, int mode, int tile) {
    float* scr = (float*)smem;
    const int ntn = N / 128, kb = tile / ntn, nb = tile % ntn, k0 = kb * 64, n0 = nb * 128, tid = threadIdx.x;
    f32x4 v[4];
#pragma unroll
    for (int i = 0; i < 4; ++i) { const int idx = tid + 512 * i, kk = idx >> 5, n4 = idx & 31; v[i] = *(const f32x4*)(src + (size_t)(k0 + kk) * N + n0 + n4 * 4); }
#pragma unroll
    for (int i = 0; i < 4; ++i) { const int idx = tid + 512 * i, kk = idx >> 5, n4 = idx & 31;
#pragma unroll
        for (int c = 0; c < 4; ++c) scr[kk * 129 + n4 * 4 + c] = v[i][c]; }
    __syncthreads();
#pragma unroll
    for (int i = 0; i < 2; ++i) {
        const int o = tid + 512 * i, n = o >> 3, kc = (o & 7) * 8;
        u32x4 w;
        w.x = pk_bf16(scr[(kc + 0) * 129 + n], scr[(kc + 1) * 129 + n]); w.y = pk_bf16(scr[(kc + 2) * 129 + n], scr[(kc + 3) * 129 + n]);
        w.z = pk_bf16(scr[(kc + 4) * 129 + n], scr[(kc + 5) * 129 + n]); w.w = pk_bf16(scr[(kc + 6) * 129 + n], scr[(kc + 7) * 129 + n]);
        const int f = n0 + n;
        const int drow = mode == 0 ? f : ((f >> 4) * 32 + (mode == 2 ? 16 : 0) + (f & 15));
        *(u32x4*)(dst + (size_t)drow * ldd + koff + k0 + kc) = w;
    }
    __syncthreads();
}

__device__ __forceinline__ void phase0(const Params& p) {
    unsigned char* ws = p.ws;
    if (blockIdx.x == 0 && threadIdx.x < 64) ((unsigned*)(ws + WS_CTL))[threadIdx.x] = 0u;
    constexpr int J0 = 16 * 42, J1 = 8 * 8, J3 = 16 * 8, J4 = 16 * 22, J6 = 44 * 8, J7 = 4, J9 = 8;
    constexpr int NT = J0 + 2 * J1 + J3 + 2 * J4 + J6 + 2 * J7 + J9;
    constexpr int NR = MP / 32;
    for (int it = blockIdx.x; it < NT + NR; it += gridDim.x) {
        if (it >= NR) {
            int r = it - NR;
            if (r < J0) { transpose_tile(p.in[4], D, PIN, (bf16_t*)(ws + WS_WIN), D, 0, 0, r); continue; } r -= J0;
            if (r < J1) { transpose_tile(p.in[16], 512, D, (bf16_t*)(ws + WS_WSB), 512, 0, 0, r); continue; } r -= J1;
            if (r < J1) { transpose_tile(p.in[17], 512, D, (bf16_t*)(ws + WS_WRW), 512, 0, 0, r); continue; } r -= J1;
            if (r < J3) { transpose_tile(p.in[18], D, D, (bf16_t*)(ws + WS_WOUT), D, 0, 0, r); continue; } r -= J3;
            if (r < J4) { transpose_tile(p.in[21], D, DFF, (bf16_t*)(ws + WS_WGU), D, 0, 1, r); continue; } r -= J4;
            if (r < J4) { transpose_tile(p.in[22], D, DFF, (bf16_t*)(ws + WS_WGU), D, 0, 2, r); continue; } r -= J4;
            if (r < J6) { transpose_tile(p.in[23], DFF, D, (bf16_t*)(ws + WS_WD), DFF, 0, 0, r); continue; } r -= J6;
            if (r < J7) { transpose_tile(p.in[6], 64, 512, (bf16_t*)(ws + WS_WL), 256, 0, 0, r); continue; } r -= J7;
            if (r < J7) { transpose_tile(p.in[8], 64, 512, (bf16_t*)(ws + WS_WL), 256, 64, 0, r); continue; } r -= J7;
            transpose_tile(p.in[10], 128, 512, (bf16_t*)(ws + WS_WL), 256, 128, 0, r);
        } else {
            const int lane = threadIdx.x & 63, row0 = it * 32 + (threadIdx.x >> 6) * 4;
            f32x4 v[4][4];
#pragma unroll
            for (int r = 0; r < 4; ++r) {
                const int row = row0 + r, b = row / TP, t = row - b * TP;
                const float* src = t < NMETA ? p.in[1] + (size_t)t * D : p.in[0] + ((size_t)b * SEQ + (t < T ? t - NMETA : 0)) * D;
#pragma unroll
                for (int j = 0; j < 4; ++j) v[r][j] = *(const f32x4*)(src + 4 * lane + 256 * j);
            }
            f32x4 g[4];
#pragma unroll
            for (int j = 0; j < 4; ++j) g[j] = *(const f32x4*)(p.in[2] + 4 * lane + 256 * j);
#pragma unroll
            for (int r = 0; r < 4; ++r) {
                const int row = row0 + r, b = row / TP, t = row - b * TP;
                float ss = 0.f;
#pragma unroll
                for (int j = 0; j < 4; ++j) ss += (v[r][j][0] * v[r][j][0] + v[r][j][1] * v[r][j][1]) + (v[r][j][2] * v[r][j][2] + v[r][j][3] * v[r][j][3]);
                const float rs = t < T ? rsqrtf(wave_sum(ss) * (1.0f / D) + RMS_EPS) : 0.f;
                bf16_t* orow = (bf16_t*)(ws + O_A0) + (size_t)row * D;
#pragma unroll
                for (int j = 0; j < 4; ++j) {
                    u32x2 w; w.x = pk_bf16(v[r][j][0] * rs * g[j][0], v[r][j][1] * rs * g[j][1]); w.y = pk_bf16(v[r][j][2] * rs * g[j][2], v[r][j][3] * rs * g[j][3]);
                    *(u32x2*)(orow + 4 * lane + 256 * j) = w;
                }
            }
        }
    }
}

__device__ __forceinline__ void phase1(const Params& p) {
    unsigned char* ws = p.ws;
    EpiInProj epi{(bf16_t*)(ws + R_QKV), (_Float16*)(ws + R_URW), (bf16_t*)p.out};
    gemm_phase((const bf16_t*)(ws + O_A0), (const bf16_t*)(ws + WS_WIN), D, MP / BM, PIN / BM, epi);
}

constexpr int SI_R = 0, SI_W = 1, SI_K = 2, SI_V = 3, SI_KK = 4, SI_B = 5;
constexpr int ALD = 264;
constexpr int P2_WLS = 64 * ALD * 2;
constexpr int P2_MU = P2_WLS;
constexpr int P2_AL = P2_MU + 1024;
__device__ __forceinline__ void phase2_main(const Params& p) {
    unsigned char* ws = p.ws;
    const int tid = threadIdx.x, wave = tid >> 6, lane = tid & 63, fr = lane & 15, fq = lane >> 4;
    const int h = blockIdx.x & 7, nslot = (gridDim.x >> 3) * 8, slot = (blockIdx.x >> 3) * 8 + wave;
    const _Float16* urw = (const _Float16*)(ws + R_URW);
    const float* mu = p.in[5];
    bf16_t* WLs = (bf16_t*)smem;
    float* mus = (float*)(smem + P2_MU);
    bf16_t* Al = (bf16_t*)(smem + P2_AL) + wave * (16 * ALD);
    __syncthreads();
    {
        const bf16_t* WL = (const bf16_t*)(ws + WS_WL) + (size_t)h * 64 * 256;
#pragma unroll
        for (int i = 0; i < 4; ++i) { const int idx = tid + 512 * i, row = idx >> 5, c16 = idx & 31; *(u32x4*)(WLs + row * ALD + c16 * 8) = *(const u32x4*)(WL + row * 256 + c16 * 8); }
        if (tid < 256) mus[tid] = mu[1536 + tid];
    }
    __syncthreads();
    if (blockIdx.x >= nslot) return;
    _Float16* SI = (_Float16*)(ws + R_SI);
    bf16_t* G = (bf16_t*)(ws + R_G);
    constexpr size_t SIE = (size_t)MP * 512;
#pragma unroll 1
    for (int g = slot; g < NB * 514; g += nslot) {
        const int ub = g / 514, ui = g - ub * 514, row0 = ub * TP + ui * 16;
        {
            const int half = lane >> 5, pc = (lane & 31) * 8;
            const float sA = pc < 64 ? 2.f : 1.f, sC = pc < 64 ? -1.f : 0.f;
            const bool lin = pc >= 64 && pc < 128;
            const f32x4 mA = *(const f32x4*)(mu + 1536 + pc), mB = *(const f32x4*)(mu + 1536 + pc + 4);
            h16x8 c[8], pv[8];
#pragma unroll
            for (int q = 0; q < 8; ++q) {
                const int rowa = row0 + 2 * q + half, ta = rowa % TP;
                const _Float16* cur = urw + (size_t)rowa * RWS + 1536 + pc;
                c[q] = *(const h16x8*)cur;
                pv[q] = *(const h16x8*)(ta > 0 ? cur - RWS : cur);
            }
#pragma unroll
            for (int q = 0; q < 8; ++q) {
                const int ta = (row0 + 2 * q + half) % TP;
                float o[8];
#pragma unroll
                for (int e = 0; e < 8; ++e) {
                    const float cf = (float)c[q][e], pf = ta > 0 ? (float)pv[q][e] : 0.f;
                    const float xs = cf + (e < 4 ? mA[e & 3] : mB[e & 3]) * (pf - cf);
                    const float sg = __builtin_amdgcn_rcpf(1.0f + __expf(-sA * xs));
                    o[e] = lin ? xs : sA * sg + sC;
                }
                u32x4 w; w.x = pk_bf16(o[0], o[1]); w.y = pk_bf16(o[2], o[3]); w.z = pk_bf16(o[4], o[5]); w.w = pk_bf16(o[6], o[7]);
                *(u32x4*)(Al + (2 * q + half) * ALD + pc) = w;
            }
        }
        asm volatile("s_waitcnt lgkmcnt(0)" ::: "memory");
        __builtin_amdgcn_wave_barrier();
        f32x4 acc[4];
        auto lora = [&](auto kbeg_c, auto ksteps_c) {
            constexpr int kbeg = decltype(kbeg_c)::value, ksteps = decltype(ksteps_c)::value;
#pragma unroll
            for (int n = 0; n < 4; ++n) acc[n] = (f32x4){0.f, 0.f, 0.f, 0.f};
#pragma unroll
            for (int ks = 0; ks < ksteps; ++ks) {
                const bf16x8 af = *(const bf16x8*)(Al + fr * ALD + kbeg + ks * 32 + fq * 8);
#pragma unroll
                for (int n = 0; n < 4; ++n) {
                    const bf16x8 wf = *(const bf16x8*)(WLs + (n * 16 + fr) * ALD + kbeg + ks * 32 + fq * 8);
                    acc[n] = __builtin_amdgcn_mfma_f32_16x16x32_bf16(wf, af, acc[n], 0, 0, 0);
                }
            }
        };
        const int row = row0 + fr, b = row / TP, t = row - b * TP;
        const size_t base = ((size_t)(b * NH + h) * TP + t) * 64;
        const _Float16* ur = urw + (size_t)row * RWS;
        const size_t pb = base + fq * 16;
        lora(std::integral_constant<int, 0>{}, std::integral_constant<int, 2>{});
        {
            h16x8 wo[2];
#pragma unroll
            for (int n = 0; n < 4; ++n) {
                const f32x4 db = *(const f32x4*)(p.in[7] + h * 64 + n * 16 + fq * 4);
#pragma unroll
                for (int j = 0; j < 4; ++j) {
                    const float wl = -softplusf_(-(db[j] + acc[n][j])) - 0.5f;
                    const float e = __expf(wl);
                    wo[n >> 1][(n & 1) * 4 + j] = (_Float16)(1.0f - __expf(-e));
                }
            }
            *(h16x8*)(SI + SI_W * SIE + pb) = wo[0]; *(h16x8*)(SI + SI_W * SIE + pb + 8) = wo[1];
        }
        lora(std::integral_constant<int, 64>{}, std::integral_constant<int, 2>{});
        {
            const _Float16* up = ur + h * 64 + fq * 16;
            const _Float16* upp = t > 0 ? up - RWS : up;
            h16x8 kc[2], rc[2], vc[2], kp[2], rp[2], vp[2];
#pragma unroll
            for (int i = 0; i < 2; ++i) {
                rc[i] = *(const h16x8*)(up + i * 8); kc[i] = *(const h16x8*)(up + 512 + i * 8); vc[i] = *(const h16x8*)(up + 1024 + i * 8);
                rp[i] = *(const h16x8*)(upp + i * 8); kp[i] = *(const h16x8*)(upp + 512 + i * 8); vp[i] = *(const h16x8*)(upp + 1024 + i * 8);
            }
            float kv[4][4], av[4][4], kkr[4][4]; float ss = 0.f;
            h16x8 ro[2];
#pragma unroll
            for (int n = 0; n < 4; ++n) {
                const int c = n * 16 + fq * 4, c512 = h * 64 + c;
                const f32x4 muk = *(const f32x4*)(mu + 512 + c512), mur = *(const f32x4*)(mu + c512), muv = *(const f32x4*)(mu + 1024 + c512);
                const f32x4 ab = *(const f32x4*)(p.in[9] + c512), kkw = *(const f32x4*)(p.in[11] + c512);
                h16x4 vo;
#pragma unroll
                for (int j = 0; j < 4; ++j) {
                    const int i = n >> 1, e = (n & 1) * 4 + j;
                    const float kcf = (float)kc[i][e], kpf = t > 0 ? (float)kp[i][e] : 0.f;
                    const float rcf = (float)rc[i][e], rpf = t > 0 ? (float)rp[i][e] : 0.f;
                    const float vcf = (float)vc[i][e], vpf = t > 0 ? (float)vp[i][e] : 0.f;
                    kv[n][j] = kcf + muk[j] * (kpf - kcf);
                    ro[i][e] = (_Float16)(rcf + mur[j] * (rpf - rcf));
                    vo[j] = (_Float16)(vcf + muv[j] * (vpf - vcf));
                    av[n][j] = sigmoidf_(ab[j] + acc[n][j]);
                    kkr[n][j] = kv[n][j] * kkw[j];
                    ss += kkr[n][j] * kkr[n][j];
                }
                *(h16x4*)(SI + SI_V * SIE + base + c) = vo;
            }
            *(h16x8*)(SI + SI_R * SIE + pb) = ro[0]; *(h16x8*)(SI + SI_R * SIE + pb + 8) = ro[1];
            ss += __shfl_xor(ss, 16); ss += __shfl_xor(ss, 32);
            const float inv = fminf(__builtin_amdgcn_rsqf(ss), 1e12f);
            h16x8 ko[2], kko[2], bo[2];
#pragma unroll
            for (int n = 0; n < 4; ++n) {
                const f32x4 ka = *(const f32x4*)(p.in[12] + h * 64 + n * 16 + fq * 4);
#pragma unroll
                for (int j = 0; j < 4; ++j) {
                    const int i = n >> 1, e = (n & 1) * 4 + j;
                    const float kk = kkr[n][j] * inv;
                    ko[i][e] = (_Float16)(kv[n][j] * (1.0f + (av[n][j] - 1.0f) * ka[j]));
                    kko[i][e] = (_Float16)kk;
                    bo[i][e] = (_Float16)(kk * av[n][j]);
                }
            }
#pragma unroll
            for (int i = 0; i < 2; ++i) {
                *(h16x8*)(SI + SI_K * SIE + pb + i * 8) = ko[i]; *(h16x8*)(SI + SI_KK * SIE + pb + i * 8) = kko[i]; *(h16x8*)(SI + SI_B * SIE + pb + i * 8) = bo[i];
            }
        }
        lora(std::integral_constant<int, 128>{}, std::integral_constant<int, 4>{});
        {
            u32x4 g0, g1;
            g0.x = pk_bf16(acc[0][0], acc[0][1]); g0.y = pk_bf16(acc[0][2], acc[0][3]); g0.z = pk_bf16(acc[1][0], acc[1][1]); g0.w = pk_bf16(acc[1][2], acc[1][3]);
            g1.x = pk_bf16(acc[2][0], acc[2][1]); g1.y = pk_bf16(acc[2][2], acc[2][3]); g1.z = pk_bf16(acc[3][0], acc[3][1]); g1.w = pk_bf16(acc[3][2], acc[3][3]);
            *(u32x4*)(G + pb) = g0; *(u32x4*)(G + pb + 8) = g1;
        }
        asm volatile("s_waitcnt lgkmcnt(0)" ::: "memory");
        __builtin_amdgcn_wave_barrier();
    }
}
__device__ __forceinline__ void phase2_kmax(const Params& p, int item) {
    unsigned char* ws = p.ws;
    const int bh = item >> 2, qr = item & 3, tid = threadIdx.x;
    float* red = (float*)(smem + P2_AL + 8 * 16 * ALD * 2);
    float ss = 0.f;
    for (int t = qr * 2052 + tid; t < (qr + 1) * 2052; t += 512) {
        const bf16_t* kr = (const bf16_t*)(ws + R_QKV) + QKV_ONE / 2 + ((size_t)bh * TP + t) * 64;
        float s1 = 0.f;
#pragma unroll
        for (int q = 0; q < 8; ++q) {
            const u32x4 v = *(const u32x4*)(kr + q * 8);
#pragma unroll
            for (int e = 0; e < 4; ++e) { const float lo = __uint_as_float(v[e] << 16), hi = __uint_as_float(v[e] & 0xffff0000u); s1 += lo * lo + hi * hi; }
        }
        ss = fmaxf(ss, s1);
    }
#pragma unroll
    for (int o = 1; o < 64; o <<= 1) ss = fmaxf(ss, __shfl_xor(ss, o));
    __syncthreads();
    if ((tid & 63) == 0) red[tid >> 6] = ss;
    __syncthreads();
    if (tid == 0) {
        float m = red[0];
#pragma unroll
        for (int w = 1; w < 8; ++w) m = fmaxf(m, red[w]);
        ((float*)(ws + WS_CTL))[16 + item] = m;
    }
}
__device__ __forceinline__ void phase2(const Params& p) {
    phase2_main(p);
    for (int it = (int)gridDim.x - 1 - (int)blockIdx.x; it < 128; it += gridDim.x) phase2_kmax(p, it);
}

constexpr int SC_TC = 32, SC_NC = (T + SC_TC - 1) / SC_TC;
constexpr int SC_ARR = SC_TC * 64;
constexpr int SC_VOFF = 5 * SC_ARR, SC_COFF = SC_VOFF + SC_TC * 16;
constexpr int SC_BUF = (SC_COFF + SC_TC) * 4;
constexpr int SC_YOFF = 2 * SC_BUF, SC_YBUF = SC_TC * 16 * 4;
__device__ __forceinline__ float dot4(const f32x4& a, const f32x4& b) {
    f32x2 t = __builtin_shufflevector(a, a, 0, 1) * __builtin_shufflevector(b, b, 0, 1);
    t = __builtin_shufflevector(a, a, 2, 3) * __builtin_shufflevector(b, b, 2, 3) + t;
    return t[0] + t[1];
}
__device__ __forceinline__ void reduce16x2(float& a, float& b) {
    a += dppf<0xB1>(a); b += dppf<0xB1>(b); a += dppf<0x4E>(a); b += dppf<0x4E>(b);
    a += dppf<0x141>(a); b += dppf<0x141>(b); a += dppf<0x140>(a); b += dppf<0x140>(b);
}
__device__ __forceinline__ void scan_unit(const Params& p, int unit) {
    unsigned char* ws = p.ws;
    const int bh = unit >> 2, vr0 = (unit & 3) * 16, tid = threadIdx.x, wave = tid >> 6, lane = tid & 63;
    const _Float16* SI = (const _Float16*)(ws + R_SI);
    constexpr size_t SIE = (size_t)MP * 512;
    float* Y = (float*)(ws + O_Y);
    const size_t hb = (size_t)bh * TP * 64;
    __syncthreads();
    if (wave >= 4) {
        const int i = tid - 256, ip = i >= 8 ? i - 8 : i;
        const int arrs[5] = {SI_R, SI_W, SI_K, SI_KK, SI_B};
        u32x4 rg[5], rp[3]; unsigned rv;
        auto issue = [&](int c) {
            const size_t off = hb + (size_t)c * SC_TC * 64;
#pragma unroll
            for (int a = 0; a < 5; ++a) rg[a] = *(const u32x4*)(SI + arrs[a] * SIE + off + i * 8);
            rp[0] = *(const u32x4*)(SI + SI_W * SIE + off + ip * 8);
            rp[1] = *(const u32x4*)(SI + SI_K * SIE + off + ip * 8);
            rp[2] = *(const u32x4*)(SI + SI_B * SIE + off + ip * 8);
            rv = *(const unsigned*)(SI + SI_V * SIE + off + (i >> 3) * 64 + vr0 + (i & 7) * 2);
        };
        auto commit = [&](int bufi) {
            float* buf = (float*)(smem + bufi * SC_BUF);
            float f[5][8];
#pragma unroll
            for (int a = 0; a < 5; ++a) {
                const h16x8 hv = __builtin_bit_cast(h16x8, rg[a]);
#pragma unroll
                for (int e = 0; e < 8; ++e) f[a][e] = (float)hv[e];
            }
            const bool odd = (i >> 3) & 1;
            float ckk = 0.f, cbk = 0.f;
            {
                const h16x8 pw = __builtin_bit_cast(h16x8, rp[0]), pk = __builtin_bit_cast(h16x8, rp[1]), pb = __builtin_bit_cast(h16x8, rp[2]);
#pragma unroll
                for (int e = 0; e < 8; ++e) {
                    const float kk2 = f[3][e];
                    ckk += (float)pk[e] * kk2; cbk += (float)pb[e] * kk2;
                    if (odd) f[3][e] = (1.0f - (float)pw[e]) * kk2;
                }
            }
            ckk += dppf<0xB1>(ckk); cbk += dppf<0xB1>(cbk); ckk += dppf<0x4E>(ckk); cbk += dppf<0x4E>(cbk); ckk += dppf<0x141>(ckk); cbk += dppf<0x141>(cbk);
#pragma unroll
            for (int a = 0; a < 5; ++a) {
                f32x4 lo, hi;
#pragma unroll
                for (int e = 0; e < 4; ++e) { lo[e] = f[a][e]; hi[e] = f[a][4 + e]; }
                if (a == 1) { lo = 1.0f - lo; hi = 1.0f - hi; }
                if (a == 4) { lo = -lo; hi = -hi; }
                *(f32x4*)(buf + a * SC_ARR + i * 8) = lo; *(f32x4*)(buf + a * SC_ARR + i * 8 + 4) = hi;
            }
            const h16x2 v2 = __builtin_bit_cast(h16x2, rv);
            f32x2 vf; vf[0] = (float)v2[0]; vf[1] = (float)v2[1];
            *(f32x2*)(buf + SC_VOFF + (i >> 3) * 16 + (i & 7) * 2) = vf;
            if (odd && (i & 7) == 0) { f32x2 cf; cf[0] = ckk; cf[1] = cbk; *(f32x2*)(buf + SC_COFF + (i >> 4) * 2) = cf; }
        };
        auto yout = [&](int c) {
            const float* yb = (const float*)(smem + SC_YOFF + (c & 1) * SC_YBUF);
            const f32x2 v = *(const f32x2*)(yb + (i >> 3) * 16 + (i & 7) * 2);
            *(f32x2*)(Y + hb + (size_t)(c * SC_TC + (i >> 3)) * 64 + vr0 + (i & 7) * 2) = v;
        };
        issue(0); commit(0); issue(1);
        __syncthreads();
        for (int c = 0; c < SC_NC; ++c) {
            if (c > 0) yout(c - 1);
            if (c + 1 < SC_NC) commit((c + 1) & 1);
            if (c + 2 < SC_NC) issue(c + 2);
            __syncthreads();
        }
        yout(SC_NC - 1);
    } else {
        const int rl = wave * 4 + (lane >> 4), sub = lane & 15;
        f32x4 S = {0.f, 0.f, 0.f, 0.f};
        __syncthreads();
        for (int c = 0; c < SC_NC; ++c) {
            const float* buf = (const float*)(smem + (c & 1) * SC_BUF);
            float* yb = (float*)(smem + SC_YOFF + (c & 1) * SC_YBUF);
            const float* bp = buf + sub * 4;
#define SC_LD(arr, s) (*(const f32x4*)(bp + (arr) * SC_ARR + (s) * 64))
            f32x4 r1 = SC_LD(0, 0), w1 = SC_LD(1, 0), k1 = SC_LD(2, 0), q1 = SC_LD(3, 0), n1 = SC_LD(4, 0);
            f32x4 r2 = SC_LD(0, 1), w2 = SC_LD(1, 1), k2 = SC_LD(2, 1), g2 = SC_LD(3, 1), n2 = SC_LD(4, 1);
            float v1 = buf[SC_VOFF + rl], v2 = buf[SC_VOFF + 16 + rl];
            f32x2 cf = *(const f32x2*)(buf + SC_COFF);
#pragma unroll
            for (int pr = 0; pr < SC_TC / 2; ++pr) {
                const int sn = 2 * pr + 2;
                const f32x4 r1n = SC_LD(0, sn), w1n = SC_LD(1, sn), k1n = SC_LD(2, sn), q1n = SC_LD(3, sn), n1n = SC_LD(4, sn);
                const f32x4 r2n = SC_LD(0, sn + 1), w2n = SC_LD(1, sn + 1), k2n = SC_LD(2, sn + 1), g2n = SC_LD(3, sn + 1), n2n = SC_LD(4, sn + 1);
                const float v1n = buf[SC_VOFF + sn * 16 + rl], v2n = buf[SC_VOFF + (sn + 1) * 16 + rl];
                const f32x2 cfn = *(const f32x2*)(buf + SC_COFF + (pr + 1) * 2);
                __builtin_amdgcn_sched_barrier(0);
                float d1 = dot4(S, q1), e2 = dot4(S, g2);
                const f32x4 t1 = S * w1 + v1 * k1;
                reduce16x2(d1, e2);
                const float d2 = e2 + v1 * cf[0] - d1 * cf[1];
                const f32x4 S1 = t1 + d1 * n1;
                const f32x4 S2 = (S1 * w2 + v2 * k2) + d2 * n2;
                float y1 = dot4(S1, r1), y2 = dot4(S2, r2);
                reduce16x2(y1, y2);
                yb[(2 * pr) * 16 + rl] = y1; yb[(2 * pr + 1) * 16 + rl] = y2;
                S = S2;
                r1 = r1n; w1 = w1n; k1 = k1n; q1 = q1n; n1 = n1n; r2 = r2n; w2 = w2n; k2 = k2n; g2 = g2n; n2 = n2n; v1 = v1n; v2 = v2n; cf = cfn;
            }
#undef SC_LD
            __syncthreads();
        }
    }
}

constexpr int KLD = 72;
__device__ __forceinline__ void attn_unit(const Params& p, int unit) {
    unsigned char* ws = p.ws;
    const int qt = unit % 65, bh = unit / 65, b = bh >> 3, h = bh & 7;
    const int tid = threadIdx.x, wave = tid >> 6, lane = tid & 63, fr = lane & 15, fq = lane >> 4;
    const bf16_t* Q = (const bf16_t*)(ws + R_QKV) + (size_t)bh * TP * 64;
    const bf16_t* Kg = Q + QKV_ONE / 2;
    const bf16_t* Vg = Q + QKV_ONE;
    bf16_t* Ks = (bf16_t*)smem;
    bf16_t* Vt = Ks + 64 * KLD;
    volatile int* flags = (volatile int*)(smem + 2 * 64 * KLD * 2);
    const int t0 = qt * 128, tq = t0 + wave * 16 + fr;
    bf16x8 qf[2];
    qf[0] = *(const bf16x8*)(Q + (size_t)tq * 64 + fq * 8);
    qf[1] = *(const bf16x8*)(Q + (size_t)tq * 64 + 32 + fq * 8);
    float qs = 0.f;
#pragma unroll
    for (int s = 0; s < 2; ++s)
#pragma unroll
        for (int e = 0; e < 8; ++e) { const float f = bf2f((unsigned short)qf[s][e]); qs += f * f; }
    qs += __shfl_xor(qs, 16); qs += __shfl_xor(qs, 32);
    const f32x4 km4 = *(const f32x4*)((const float*)(ws + WS_CTL) + 16 + bh * 4);
    const float kmax = sqrtf(fmaxf(fmaxf(km4[0], km4[1]), fmaxf(km4[2], km4[3])));
    const float zb = sqrtf(qs) * kmax * 1.0001f + 88.0f;
    float Arow = 0.f;
    f32x4 O[4];
#pragma unroll
    for (int nd = 0; nd < 4; ++nd) O[nd] = (f32x4){0.f, 0.f, 0.f, 0.f};
    for (int kb = qt * 2 + 1; kb >= 0; --kb) {
        const bool done = __all(Arow > zb);
        if (lane == 0) flags[wave] = done ? 1 : 0;
        __syncthreads();
        int alld = 1;
#pragma unroll
        for (int w = 0; w < 8; ++w) alld &= flags[w];
        if (alld) break;
        {
            const int key = tid >> 3, dc = (tid & 7) * 8;
            const u32x4 kvv = *(const u32x4*)(Kg + (size_t)(kb * 64 + key) * 64 + dc);
            const u32x4 vvv = *(const u32x4*)(Vg + (size_t)(kb * 64 + key) * 64 + dc);
            *(u32x4*)(Ks + key * KLD + dc) = kvv;
#pragma unroll
            for (int e = 0; e < 4; ++e) { Vt[(dc + 2 * e) * KLD + key] = (bf16_t)(vvv[e] & 0xffffu); Vt[(dc + 2 * e + 1) * KLD + key] = (bf16_t)(vvv[e] >> 16); }
        }
        __syncthreads();
        f32x4 z[4];
#pragma unroll
        for (int n = 0; n < 4; ++n) {
            z[n] = (f32x4){0.f, 0.f, 0.f, 0.f};
#pragma unroll
            for (int s = 0; s < 2; ++s) {
                const bf16x8 kf = *(const bf16x8*)(Ks + (n * 16 + fr) * KLD + s * 32 + fq * 8);
                z[n] = __builtin_amdgcn_mfma_f32_16x16x32_bf16(kf, qf[s], z[n], 0, 0, 0);
            }
        }
        float sp[4][4], lt[4], ex[4], sg[4];
#pragma unroll
        for (int n = 0; n < 4; ++n) {
#pragma unroll
            for (int j = 0; j < 4; ++j) { const int s = kb * 64 + n * 16 + fq * 4 + j; sp[n][j] = s < tq ? softplusf_(z[n][j]) : 0.f; }
            sp[n][2] += sp[n][3]; sp[n][1] += sp[n][2]; sp[n][0] += sp[n][1];
            lt[n] = sp[n][0];
            const float a = __shfl_xor(lt[n], 16), pr = lt[n] + a, c = __shfl_xor(pr, 32);
            ex[n] = fq == 3 ? 0.f : (fq == 2 ? a : (fq == 1 ? c : a + c));
            sg[n] = pr + c;
        }
        float nsuf[4]; nsuf[3] = 0.f; nsuf[2] = sg[3]; nsuf[1] = nsuf[2] + sg[2]; nsuf[0] = nsuf[1] + sg[1];
        float wgt[4][4];
#pragma unroll
        for (int n = 0; n < 4; ++n)
#pragma unroll
            for (int j = 0; j < 4; ++j) {
                const int s = kb * 64 + n * 16 + fq * 4 + j;
                const float C = Arow + nsuf[n] + ex[n] + sp[n][j];
                wgt[n][j] = s < tq ? __expf(z[n][j] - C) : 0.f;
            }
        Arow += nsuf[0] + sg[0];
#pragma unroll
        for (int ks = 0; ks < 2; ++ks) {
            u32x4 pw; pw.x = pk_bf16(wgt[2 * ks][0], wgt[2 * ks][1]); pw.y = pk_bf16(wgt[2 * ks][2], wgt[2 * ks][3]);
            pw.z = pk_bf16(wgt[2 * ks + 1][0], wgt[2 * ks + 1][1]); pw.w = pk_bf16(wgt[2 * ks + 1][2], wgt[2 * ks + 1][3]);
            const bf16x8 pf = __builtin_bit_cast(bf16x8, pw);
#pragma unroll
            for (int nd = 0; nd < 4; ++nd) {
                u32x4 vw;
                const u32x2 v0 = *(const u32x2*)(Vt + (nd * 16 + fr) * KLD + (2 * ks) * 16 + fq * 4);
                const u32x2 v1 = *(const u32x2*)(Vt + (nd * 16 + fr) * KLD + (2 * ks + 1) * 16 + fq * 4);
                vw.x = v0.x; vw.y = v0.y; vw.z = v1.x; vw.w = v1.y;
                O[nd] = __builtin_amdgcn_mfma_f32_16x16x32_bf16(pf, __builtin_bit_cast(bf16x8, vw), O[nd], 0, 0, 0);
            }
        }
    }
    __syncthreads();
    bf16_t* osb = (bf16_t*)(ws + O_OSB);
#pragma unroll
    for (int j = 0; j < 4; ++j) {
        const int t = t0 + wave * 16 + fq * 4 + j;
        if (t >= NMETA && t < T) {
#pragma unroll
            for (int nd = 0; nd < 4; ++nd) osb[(size_t)(b * SEQ + t - NMETA) * 512 + h * 64 + nd * 16 + fr] = (bf16_t)(pk_bf16(O[nd][j], 0.f) & 0xffffu);
        }
    }
}

constexpr int N_SCAN = 128, N_ATTN = 32 * 65;
__device__ __forceinline__ void phase3(const Params& p, int cw = 0, int first = 0, int last = N_SCAN + N_ATTN) {
    unsigned* ctr = (unsigned*)(p.ws + WS_CTL) + cw;
    volatile int* slot = (volatile int*)(smem + 131072 - 16);
    for (;;) {
        __syncthreads();
        if (threadIdx.x == 0) *slot = (int)atomicAdd(ctr, 1u);
        __syncthreads();
        const int u = *slot + first;
        if (u >= last) break;
        if (u < N_SCAN) scan_unit(p, u); else attn_unit(p, u - N_SCAN);
    }
}

__device__ __forceinline__ void phase3c(const Params& p) {
    unsigned char* ws = p.ws;
    const _Float16* SI = (const _Float16*)(ws + R_SI);
    constexpr size_t SIE = (size_t)MP * 512;
    const float* Y = (const float*)(ws + O_Y);
    const bf16_t* G = (const bf16_t*)(ws + R_G);
    bf16_t* orw = (bf16_t*)(ws + O_ORW);
    const int tid = threadIdx.x, sub = tid & 15;
    constexpr int U = 4;
    for (int it = blockIdx.x; it < 32 * 64; it += gridDim.x) {
        const int bh = it >> 6, c4 = it & 63, b = bh >> 3, h = bh & 7;
        const int c = h * 64 + sub * 4;
        const f32x4 gain = *(const f32x4*)(p.in[14] + c), bias = *(const f32x4*)(p.in[15] + c), rk = *(const f32x4*)(p.in[13] + c);
        f32x4 y[U]; h16x4 r4[U], k4[U], v4[U]; u32x2 g2[U];
#pragma unroll
        for (int u = 0; u < U; ++u) {
            const int t = NMETA + (c4 * U + u) * 32 + (tid >> 4);
            const size_t base = ((size_t)bh * TP + t) * 64 + sub * 4;
            const size_t pbase = ((size_t)bh * TP + t) * 64 + (sub & 3) * 16 + (sub >> 2) * 4;
            y[u] = *(const f32x4*)(Y + base);
            r4[u] = *(const h16x4*)(SI + SI_R * SIE + pbase); k4[u] = *(const h16x4*)(SI + SI_K * SIE + pbase); v4[u] = *(const h16x4*)(SI + SI_V * SIE + base);
            g2[u] = *(const u32x2*)(G + pbase);
        }
#pragma unroll
        for (int u = 0; u < U; ++u) {
            const int t = NMETA + (c4 * U + u) * 32 + (tid >> 4);
            const float mean = reduce16((y[u][0] + y[u][1]) + (y[u][2] + y[u][3])) * (1.0f / 64.0f);
            const f32x4 dy = y[u] - mean;
            const float var = reduce16((dy[0] * dy[0] + dy[1] * dy[1]) + (dy[2] * dy[2] + dy[3] * dy[3])) * (1.0f / 64.0f);
            const float rs = rsqrtf(var + GN_EPS);
            float bs = 0.f;
#pragma unroll
            for (int j = 0; j < 4; ++j) bs += (float)r4[u][j] * (float)k4[u][j] * rk[j];
            bs = reduce16(bs);
            const float gg[4] = {__uint_as_float(g2[u].x << 16), __uint_as_float(g2[u].x & 0xffff0000u), __uint_as_float(g2[u].y << 16), __uint_as_float(g2[u].y & 0xffff0000u)};
            float o[4];
#pragma unroll
            for (int j = 0; j < 4; ++j) o[j] = (dy[j] * rs * gain[j] + bias[j] + bs * (float)v4[u][j]) * gg[j];
            u32x2 w; w.x = pk_bf16(o[0], o[1]); w.y = pk_bf16(o[2], o[3]);
            *(u32x2*)(orw + (size_t)(b * SEQ + t - NMETA) * 512 + c) = w;
        }
    }
}

__device__ __forceinline__ void phase4(const Params& p) {
    unsigned char* ws = p.ws;
    EpiBranch1 e1{(float*)(ws + O_T1), (const bf16_t*)p.out};
    EpiBranch2 e2{(const float*)(ws + O_T1), (const bf16_t*)p.out, (bf16_t*)(ws + O_M)};
    gemm_phase((const bf16_t*)(ws + O_OSB), (const bf16_t*)(ws + WS_WSB), 512, MS / BM, D / BM, e1);
    gemm_phase((const bf16_t*)(ws + O_ORW), (const bf16_t*)(ws + WS_WRW), 512, MS / BM, D / BM, e2);
}
__device__ __forceinline__ void phase5(const Params& p) {
    unsigned char* ws = p.ws;
    EpiF32 e{(float*)(ws + O_P)};
    gemm_phase((const bf16_t*)(ws + O_M), (const bf16_t*)(ws + WS_WOUT), D, MS / BM, D / BM, e);
}
__device__ __forceinline__ void phase6(const Params& p) {
    unsigned char* ws = p.ws;
    const int lane = threadIdx.x & 63;
    f32x4 g1[4], g2[4];
#pragma unroll
    for (int j = 0; j < 4; ++j) { g1[j] = *(const f32x4*)(p.in[3] + 4 * lane + 256 * j); g2[j] = *(const f32x4*)(p.in[19] + 4 * lane + 256 * j); }
    for (int it = blockIdx.x; it < MS / 16; it += gridDim.x) {
        const int row0 = it * 16 + (threadIdx.x >> 6) * 2;
        f32x4 v[2][4], x[2][4];
#pragma unroll
        for (int r = 0; r < 2; ++r)
#pragma unroll
            for (int j = 0; j < 4; ++j) {
                v[r][j] = *(const f32x4*)((const float*)(ws + O_P) + (size_t)(row0 + r) * D + 4 * lane + 256 * j);
                x[r][j] = *(const f32x4*)(p.in[0] + (size_t)(row0 + r) * D + 4 * lane + 256 * j);
            }
#pragma unroll
        for (int r = 0; r < 2; ++r) {
            const int row = row0 + r;
            float ss = 0.f;
#pragma unroll
            for (int j = 0; j < 4; ++j) ss += (v[r][j][0] * v[r][j][0] + v[r][j][1] * v[r][j][1]) + (v[r][j][2] * v[r][j][2] + v[r][j][3] * v[r][j][3]);
            const float rs = rsqrtf(wave_sum(ss) * (1.0f / D) + RMS_EPS);
            float s2 = 0.f;
#pragma unroll
            for (int j = 0; j < 4; ++j) {
                v[r][j] = x[r][j] + v[r][j] * rs * g1[j];
                *(f32x4*)(p.out + (size_t)row * D + 4 * lane + 256 * j) = v[r][j];
                s2 += (v[r][j][0] * v[r][j][0] + v[r][j][1] * v[r][j][1]) + (v[r][j][2] * v[r][j][2] + v[r][j][3] * v[r][j][3]);
            }
            const float rs2 = rsqrtf(wave_sum(s2) * (1.0f / D) + RMS_EPS);
            bf16_t* fr_ = (bf16_t*)(ws + O_F) + (size_t)row * D;
#pragma unroll
            for (int j = 0; j < 4; ++j) {
                u32x2 w; w.x = pk_bf16(v[r][j][0] * rs2 * g2[j][0], v[r][j][1] * rs2 * g2[j][1]); w.y = pk_bf16(v[r][j][2] * rs2 * g2[j][2], v[r][j][3] * rs2 * g2[j][3]);
                *(u32x2*)(fr_ + 4 * lane + 256 * j) = w;
            }
        }
    }
}
__device__ __forceinline__ void phase7(const Params& p) {
    unsigned char* ws = p.ws;
    EpiGU e{(bf16_t*)(ws + O_ACT)};
    gemm_phase((const bf16_t*)(ws + O_F), (const bf16_t*)(ws + WS_WGU), D, MS / BM, 2 * DFF / BM, e);
}
__device__ __forceinline__ void phase8(const Params& p) {
    unsigned char* ws = p.ws;
    EpiF32 e{(float*)(ws + O_DN)};
    gemm_phase((const bf16_t*)(ws + O_ACT), (const bf16_t*)(ws + WS_WD), DFF, MS / BM, D / BM, e);
}
__device__ __forceinline__ void phase9(const Params& p) {
    unsigned char* ws = p.ws;
    const int lane = threadIdx.x & 63;
    f32x4 g[4];
#pragma unroll
    for (int j = 0; j < 4; ++j) g[j] = *(const f32x4*)(p.in[20] + 4 * lane + 256 * j);
    for (int it = blockIdx.x; it < MS / 16; it += gridDim.x) {
        const int row0 = it * 16 + (threadIdx.x >> 6) * 2;
        f32x4 v[2][4], h1[2][4];
#pragma unroll
        for (int r = 0; r < 2; ++r)
#pragma unroll
            for (int j = 0; j < 4; ++j) {
                v[r][j] = *(const f32x4*)((const float*)(ws + O_DN) + (size_t)(row0 + r) * D + 4 * lane + 256 * j);
                h1[r][j] = *(const f32x4*)(p.out + (size_t)(row0 + r) * D + 4 * lane + 256 * j);
            }
#pragma unroll
        for (int r = 0; r < 2; ++r) {
            float ss = 0.f;
#pragma unroll
            for (int j = 0; j < 4; ++j) ss += (v[r][j][0] * v[r][j][0] + v[r][j][1] * v[r][j][1]) + (v[r][j][2] * v[r][j][2] + v[r][j][3] * v[r][j][3]);
            const float rs = rsqrtf(wave_sum(ss) * (1.0f / D) + RMS_EPS);
#pragma unroll
            for (int j = 0; j < 4; ++j) *(f32x4*)(p.out + (size_t)(row0 + r) * D + 4 * lane + 256 * j) = h1[r][j] + v[r][j] * rs * g[j];
        }
    }
}

constexpr int N_PHASES = 11;
__device__ __forceinline__ void run_phase(const Params& p, int ph) {
    switch (ph) {
        case 0: phase0(p); break;
        case 1: phase1(p); break;
        case 2: phase2(p); break;
        case 3: phase3(p); break;
        case 4: phase3c(p); break;
        case 5: phase4(p); break;
        case 6: phase5(p); break;
        case 7: phase6(p); break;
        case 8: phase7(p); break;
        case 9: phase8(p); break;
        default: phase9(p); break;
    }
}

#if MULTI_LAUNCH
template <int PH> __global__ void __launch_bounds__(512) fwd_phase(Params p) { run_phase(p, PH); }
#else
__global__ void __launch_bounds__(512) fwd_mega(Params p) {
    cg::grid_group grid = cg::this_grid();
    volatile LAS unsigned* st = (volatile LAS unsigned*)(smem + 131072);
    if (threadIdx.x == 0) { st[0] = 0u; st[1] = 0u; }
    __syncthreads();
    const XcdBarrier xb = xcd_barrier_post((unsigned*)(p.ws + WS_BAR), st);
    phase0(p); grid.sync(); phase1(p); xcd_barrier(xb); phase2(p); xcd_barrier(xb); phase3(p); xcd_barrier(xb); phase3c(p); xcd_barrier(xb);
    phase4(p); xcd_barrier(xb); phase5(p); xcd_barrier(xb); phase6(p); xcd_barrier(xb); phase7(p); xcd_barrier(xb); phase8(p); xcd_barrier(xb); phase9(p);
}
#endif

extern "C" void kernel_launch(void* const* d_in, const int* in_sizes, int n_in, void* d_out, int out_size, void* d_ws, size_t ws_size, hipStream_t stream) {
    static int grid = 0;
    if (grid == 0) {
        if (n_in != 24 || out_size != MS * D || ws_size < WS_END) { fprintf(stderr, "kernel_launch: unexpected shapes (n_in %d out %d ws %zu need %zu)\n", n_in, out_size, ws_size, (size_t)WS_END); grid = -1; return; }
        int dev = 0, cus = 0, per_cu = 0;
        (void)hipGetDevice(&dev);
        (void)hipDeviceGetAttribute(&cus, hipDeviceAttributeMultiprocessorCount, dev);
#if MULTI_LAUNCH
        per_cu = 1;
#else
        (void)hipFuncSetAttribute((const void*)fwd_mega, hipFuncAttributeMaxDynamicSharedMemorySize, LDS_BYTES);
        (void)hipOccupancyMaxActiveBlocksPerMultiprocessor(&per_cu, (const void*)fwd_mega, 512, LDS_BYTES);
        if (per_cu < 1) { fprintf(stderr, "kernel_launch: occupancy query says %d blocks per CU\n", per_cu); per_cu = 1; }
        if (per_cu > 1) per_cu = 1;
#endif
        grid = cus * per_cu;
    }
    if (grid < 0) return;
    Params p{};
    for (int i = 0; i < 24; ++i) p.in[i] = (const float*)d_in[i];
    p.out = (float*)d_out; p.ws = (unsigned char*)d_ws;
#if MULTI_LAUNCH
#define LP(PH) do { (void)hipFuncSetAttribute((const void*)fwd_phase<PH>, hipFuncAttributeMaxDynamicSharedMemorySize, LDS_BYTES); hipLaunchKernelGGL(fwd_phase<PH>, dim3(grid), dim3(512), LDS_BYTES, stream, p); } while (0)
    LP(0); LP(1); LP(2); LP(3); LP(4); LP(5); LP(6); LP(7); LP(8); LP(9); LP(10);
#undef LP
#else
    if (hipMemsetAsync(d_ws, 0, WS_CTL_BYTES, stream) != hipSuccess) { fprintf(stderr, "kernel_launch: hipMemsetAsync of the control words failed\n"); return; }
    void* args[] = {&p};
    hipError_t e = hipLaunchCooperativeKernel((const void*)fwd_mega, dim3(grid), dim3(512), args, LDS_BYTES, stream);
    if (e != hipSuccess) fprintf(stderr, "cooperative launch failed: %s (grid %d)\n", hipGetErrorString(e), grid);
#endif
}
```

```cpp
#include <hip/hip_runtime.h>
#include <hip/hip_cooperative_groups.h>
#include <cstdio>
#include <cstdint>
#include <type_traits>
namespace cg = cooperative_groups;

#ifndef MULTI_LAUNCH
#define MULTI_LAUNCH 0
#endif

typedef unsigned short bf16_t;
typedef short bf16x8 __attribute__((ext_vector_type(8)));
typedef float f32x4 __attribute__((ext_vector_type(4)));
typedef float f32x2 __attribute__((ext_vector_type(2)));
typedef unsigned u32x2 __attribute__((ext_vector_type(2)));
typedef unsigned u32x4 __attribute__((ext_vector_type(4)));
typedef _Float16 h16x2 __attribute__((ext_vector_type(2)));
typedef _Float16 h16x4 __attribute__((ext_vector_type(4)));
typedef _Float16 h16x8 __attribute__((ext_vector_type(8)));

constexpr int D = 1024, NB = 4, SEQ = 8192, NMETA = 16, T = SEQ + NMETA, TP = 8320, MP = NB * TP, MS = NB * SEQ;
constexpr int PIN = 5376, DFF = 2816, NH = 8, RWS = 1792;
constexpr float RMS_EPS = 1e-6f, GN_EPS = 64e-5f;

constexpr size_t WS_CTL = 0;
constexpr size_t WS_BAR = 4096;
constexpr size_t WS_CTL_BYTES = 32768;
constexpr size_t WS_WIN = WS_CTL_BYTES;
constexpr size_t WS_WSB = WS_WIN + (size_t)PIN * D * 2;
constexpr size_t WS_WRW = WS_WSB + (size_t)D * 512 * 2;
constexpr size_t WS_WOUT = WS_WRW + (size_t)D * 512 * 2;
constexpr size_t WS_WGU = WS_WOUT + (size_t)D * D * 2;
constexpr size_t WS_WD = WS_WGU + (size_t)2 * DFF * D * 2;
constexpr size_t WS_WL = WS_WD + (size_t)D * DFF * 2;
constexpr size_t R_QKV = WS_WL + (size_t)512 * 256 * 2;
constexpr size_t QKV_ONE = (size_t)MP * 512 * 2;
constexpr size_t R_URW = R_QKV + 3 * QKV_ONE;
constexpr size_t R_SI = R_URW + (size_t)MP * RWS * 2;
constexpr size_t SI_ONE = (size_t)MP * 512 * 2;
constexpr size_t R_G = R_SI + 6 * SI_ONE;
constexpr size_t WS_END = R_G + SI_ONE;
constexpr size_t O_A0 = R_SI;
constexpr size_t O_Y = R_URW;
constexpr size_t O_OSB = R_URW + (size_t)MP * 512 * 4;
constexpr size_t O_ORW = R_QKV;
constexpr size_t O_T1 = R_SI;
constexpr size_t O_M = R_SI + (size_t)MS * D * 4;
constexpr size_t O_P = R_QKV;
constexpr size_t O_F = R_SI;
constexpr size_t O_ACT = R_QKV;
constexpr size_t O_DN = R_SI + (size_t)MS * D * 2;
static_assert(O_OSB + (size_t)MS * 512 * 2 <= R_SI, "overlay");
static_assert(O_M + (size_t)MS * D * 2 <= WS_END, "overlay");
static_assert(O_ACT + (size_t)MS * DFF * 2 <= R_SI, "overlay");
static_assert(O_DN + (size_t)MS * D * 4 <= WS_END, "overlay");
static_assert(WS_END <= (size_t)512 * 1024 * 1024, "workspace");

constexpr int LDS_BYTES = 131072 + 64;

struct Params { const float* in[24]; float* out; unsigned char* ws; };

extern __shared__ __attribute__((aligned(16))) unsigned char smem[];

typedef __bf16 b16x2 __attribute__((ext_vector_type(2)));
__device__ __forceinline__ unsigned pk_bf16(float lo, float hi) { const f32x2 v = {lo, hi}; return __builtin_bit_cast(unsigned, __builtin_convertvector(v, b16x2)); }
__device__ __forceinline__ float bf2f(unsigned short v) { return __uint_as_float((unsigned)v << 16); }
__device__ __forceinline__ float sigmoidf_(float x) { return __builtin_amdgcn_rcpf(1.0f + __expf(-x)); }
__device__ __forceinline__ float softplusf_(float x) { return fmaxf(x, 0.f) + __logf(1.0f + __expf(-fabsf(x))); }
template <int CTRL> __device__ __forceinline__ float dppf(float x) { return __builtin_bit_cast(float, __builtin_amdgcn_mov_dpp(__builtin_bit_cast(int, x), CTRL, 0xf, 0xf, true)); }
__device__ __forceinline__ float reduce16(float v) {
    v += dppf<0xB1>(v); v += dppf<0x4E>(v); v += dppf<0x141>(v); v += dppf<0x140>(v); return v;
}
__device__ __forceinline__ float wave_sum(float v) {
#pragma unroll
    for (int o = 1; o < 64; o <<= 1) v += __shfl_xor(v, o);
    return v;
}

#define LAS __attribute__((address_space(3)))
#define XB_TMO      128
#define XB_XCNT(j)  (256  + 64 * (j))
#define XB_XSUB(j)  (1280 + 64 * (j))
#define XB_XGEN(j)  (2304 + 64 * (j))
#define XB_TOP      3328
#define XB_TOPGEN   3392
#define XCD_BAR_WORDS 3456
#define XB_SPIN_CAP (1u << 18)
__device__ __forceinline__ unsigned xb_ld(unsigned* p)              { return __hip_atomic_load(p, __ATOMIC_RELAXED, __HIP_MEMORY_SCOPE_AGENT); }
__device__ __forceinline__ unsigned xb_add(unsigned* p, unsigned v) { return __hip_atomic_fetch_add(p, v, __ATOMIC_RELAXED, __HIP_MEMORY_SCOPE_AGENT); }
__device__ __forceinline__ unsigned xb_xcc_id() { return (unsigned)__builtin_amdgcn_s_getreg((3 << 11) | 20) & 0xFu; }
#define XB_SPIN(cond, bar) do { unsigned _sp = 0; while (cond) { __builtin_amdgcn_s_sleep(1); \
    if ((++_sp & 255u) == 0u) { if (xb_ld(&(bar)[XB_TMO])) break; if (_sp > XB_SPIN_CAP) { atomicAdd(&(bar)[XB_TMO], 1u); break; } } } } while (0)
struct XcdBarrier { unsigned* bar; unsigned x; volatile LAS unsigned* st; };
__device__ __forceinline__ XcdBarrier xcd_barrier_post(unsigned* bar, volatile LAS unsigned* st) {
    XcdBarrier b; b.bar = bar; b.x = xb_xcc_id(); b.st = st;
    if (threadIdx.x == 0) (void)xb_add(&bar[XB_XCNT(b.x)], 1u);
    return b;
}
__device__ __forceinline__ void xcd_barrier_complete(unsigned* bar, unsigned x, unsigned& nloc, unsigned& nx) {
    const unsigned G = gridDim.x * gridDim.y * gridDim.z;
    unsigned sum, cnt, mine, sp = 0u;
    for (;;) {
        sum = 0u; cnt = 0u; mine = 0u;
#pragma unroll
        for (unsigned j = 0; j < 16; ++j) { const unsigned c = xb_ld(&bar[XB_XCNT(j)]); sum += c; cnt += (c > 0u) ? 1u : 0u; mine = (j == x) ? c : mine; }
        if (sum == G) break;
        __builtin_amdgcn_s_sleep(1);
        if ((++sp & 255u) == 0u) { if (xb_ld(&bar[XB_TMO])) break; if (sp > XB_SPIN_CAP) { atomicAdd(&bar[XB_TMO], 1u); break; } }
    }
    nloc = mine > 0u ? mine : 1u; nx = cnt > 0u ? cnt : 1u;
}
__device__ __forceinline__ void xcd_barrier(const XcdBarrier& b) {
    asm volatile("s_waitcnt vmcnt(0)" ::: "memory");
    __syncthreads();
    if (threadIdx.x == 0) {
        unsigned* bar = b.bar;
        __builtin_amdgcn_s_waitcnt(0);
        unsigned nloc = b.st[0], nx = b.st[1];
        if (nloc == 0u) { xcd_barrier_complete(bar, b.x, nloc, nx); b.st[0] = nloc; b.st[1] = nx; }
        const unsigned old = xb_add(&bar[XB_XSUB(b.x)], 1u);
        const unsigned gen = old / nloc;
        if (old + 1u == (gen + 1u) * nloc) {
            __builtin_amdgcn_fence(__ATOMIC_RELEASE, "agent");
            asm volatile("s_waitcnt vmcnt(0)" ::: "memory");
            const unsigned og = xb_add(&bar[XB_TOP], 1u);
            const unsigned tg = og / nx;
            if (og + 1u == (tg + 1u) * nx) xb_add(&bar[XB_TOPGEN], 1u);
            else XB_SPIN(xb_ld(&bar[XB_TOPGEN]) == tg, bar);
            __builtin_amdgcn_fence(__ATOMIC_ACQUIRE, "agent");
            xb_add(&bar[XB_XGEN(b.x)], 1u);
            asm volatile("s_waitcnt vmcnt(0)" ::: "memory");
        } else {
            XB_SPIN(xb_ld(&bar[XB_XGEN(b.x)]) == gen, bar);
            __builtin_amdgcn_fence(__ATOMIC_ACQUIRE, "agent");
            asm volatile("s_waitcnt vmcnt(0)" ::: "memory");
        }
    }
    __syncthreads();
}

constexpr int BM = 256, BK = 64, HALF = 128, HTB = HALF * BK * 2, NXCD = 8, WGM = 8;
__device__ __forceinline__ int lds_byte(int r, int c) { const int st = (r >> 4) * 2 + (c >> 5), rr = r & 15, cc = c & 31, ob = rr * 64 + cc * 2; return st * 1024 + (ob ^ (((ob >> 9) & 1) << 5)); }
__device__ __forceinline__ void stage_rc(int b, int& R, int& C) { const int st = b / 1024, sb = b % 1024, swz = sb ^ (((sb >> 9) & 1) << 5); R = (st >> 1) * 16 + swz / 64; C = (st & 1) * 32 + (swz % 64) / 2; }
struct Unit { int pm, pn; };
struct Sched {
    int nM, nN, nwg, G, c;
    __device__ __forceinline__ bool next(int i, Unit& u) const {
        const long L = (long)i * G + c; if (L >= nwg) return false;
        int wgid = (int)L; { const int q = nwg / NXCD, r = nwg % NXCD, xcd = wgid % NXCD, off = wgid / NXCD; wgid = (xcd < r ? xcd * (q + 1) : r * (q + 1) + (xcd - r) * q) + off; }
        const int nig = WGM * nN, gid = wgid / nig, fm = gid * WGM, gsz = (nM - fm) < WGM ? (nM - fm) : WGM;
        u.pm = fm + ((wgid % nig) % gsz); u.pn = (wgid % nig) / gsz; return true;
    }
};

template <class Epi>
__device__ __forceinline__ void gemm_phase(const bf16_t* __restrict__ Ag, const bf16_t* __restrict__ Btg, const int K, const int nM, const int nN, const Epi& E) {
    LAS unsigned char* lds = (LAS unsigned char*)smem;
    const int tid = threadIdx.x, wid = __builtin_amdgcn_readfirstlane(tid >> 6), lane = tid & 63, wr = wid >> 2, wc = wid & 3, fr = lane & 15, fq = lane >> 4;
    const int nt = K / BK;
    Sched S; S.nM = nM; S.nN = nN; S.nwg = nM * nN; S.G = gridDim.x; S.c = blockIdx.x;
    unsigned voffA[2], voffB[2];
#pragma unroll
    for (int i = 0; i < 2; ++i) { int R, C; stage_rc(tid * 16 + i * 8192, R, C); voffA[i] = (unsigned)(R * K + C) * 2u; voffB[i] = voffA[i]; }
    const size_t kstep = (size_t)(BK * 2);
    const size_t hstep = (size_t)HALF * K * 2;
    const size_t tstep = 2 * hstep;
    const unsigned ldsw = (unsigned)wid * 1024u;
    const int aoff = lds_byte(wr * 64 + fr, fq * 8), boff = lds_byte(wc * 32 + fr, fq * 8);
#define PG8_SA(b, h) (((b) * 2 + (h)) * HTB)
#define PG8_SB(b, h) ((4 + (b) * 2 + (h)) * HTB)
#define PG8_STAGE(bufoff, gbase, voff) do { _Pragma("unroll") for (int _i = 0; _i < 2; ++_i) \
        __builtin_amdgcn_global_load_lds((const unsigned*)((const char*)(gbase) + (voff)[_i]), (LAS unsigned*)(lds + (bufoff) + ldsw + _i * 8192), 16, 0, 0); } while (0)
#define PG8_LDA(dst, b, h) do { _Pragma("unroll") for (int m = 0; m < 4; ++m) _Pragma("unroll") for (int k = 0; k < 2; ++k) dst[m][k] = *(const LAS bf16x8*)(lds + PG8_SA(b, h) + aoff + m * 2048 + k * 1024); } while (0)
#define PG8_LDB(dst, b, h) do { _Pragma("unroll") for (int n = 0; n < 2; ++n) _Pragma("unroll") for (int k = 0; k < 2; ++k) dst[n][k] = *(const LAS bf16x8*)(lds + PG8_SB(b, h) + boff + n * 2048 + k * 1024); } while (0)
#define PG8_MMA(ai, bj, At, Bt) do { __builtin_amdgcn_s_setprio(1); _Pragma("unroll") for (int m = 0; m < 4; ++m) _Pragma("unroll") for (int n = 0; n < 2; ++n) _Pragma("unroll") for (int k = 0; k < 2; ++k) \
        acc[ai][bj][m][n] = __builtin_amdgcn_mfma_f32_16x16x32_bf16(Bt[n][k], At[m][k], acc[ai][bj][m][n], 0, 0, 0); __builtin_amdgcn_s_setprio(0); } while (0)
#define PG8_WAIT_V(n) asm volatile("s_waitcnt vmcnt(" #n ")" ::: "memory")
#define PG8_WAIT_L(n) asm volatile("s_waitcnt lgkmcnt(" #n ")" ::: "memory")
#define PG8_BAR __builtin_amdgcn_s_barrier()
#define PG8_SCHED __builtin_amdgcn_sched_barrier(0)
    Unit cur, nxt; int ui = 0;
    __syncthreads();
    if (!S.next(0, cur)) return;
    f32x4 acc[2][2][4][2];
#pragma unroll
    for (int a = 0; a < 2; ++a)
#pragma unroll
        for (int b = 0; b < 2; ++b)
#pragma unroll
            for (int m = 0; m < 4; ++m)
#pragma unroll
                for (int n = 0; n < 2; ++n) acc[a][b][m][n] = (f32x4){0.f, 0.f, 0.f, 0.f};
    bf16x8 At[4][2], B0[2][2], B1[2][2];
    const char* cA = (const char*)Ag + (size_t)cur.pm * tstep; const char* cB = (const char*)Btg + (size_t)cur.pn * tstep;
    PG8_STAGE(PG8_SB(0, 0), cB, voffB); PG8_STAGE(PG8_SA(0, 0), cA, voffA); PG8_STAGE(PG8_SB(0, 1), cB + hstep, voffB); PG8_STAGE(PG8_SA(0, 1), cA + hstep, voffA);
    if (wr == 1) PG8_BAR;
    PG8_WAIT_V(4); PG8_BAR;
    PG8_STAGE(PG8_SB(1, 0), cB + kstep, voffB); PG8_STAGE(PG8_SA(1, 0), cA + kstep, voffA); PG8_STAGE(PG8_SB(1, 1), cB + hstep + kstep, voffB);
    PG8_WAIT_V(6); PG8_BAR;
    for (;;) {
        const bool has_next = S.next(ui + 1, nxt);
        const char* nA = has_next ? (const char*)Ag + (size_t)nxt.pm * tstep : cA; const char* nB = has_next ? (const char*)Btg + (size_t)nxt.pn * tstep : cB;
        for (int t = 0; t < nt; t += 2) {
            const bool last = (t == nt - 2);
            const char* a1 = cA + (size_t)(t + 1) * kstep;
            const char* a2 = last ? nA : cA + (size_t)(t + 2) * kstep; const char* b2 = last ? nB : cB + (size_t)(t + 2) * kstep;
            const char* a3 = a2 + kstep; const char* b3 = b2 + kstep;
            PG8_LDB(B0, 0, 0); PG8_SCHED; PG8_LDA(At, 0, 0); PG8_STAGE(PG8_SA(1, 1), a1 + hstep, voffA);
            PG8_WAIT_L(8); PG8_BAR; PG8_WAIT_L(0); PG8_MMA(0, 0, At, B0); PG8_BAR; PG8_SCHED;
            PG8_LDB(B1, 0, 1); PG8_STAGE(PG8_SB(0, 0), b2, voffB);
            PG8_BAR; PG8_WAIT_L(0); PG8_MMA(0, 1, At, B1); PG8_BAR;
            PG8_LDA(At, 0, 1); PG8_STAGE(PG8_SA(0, 0), a2, voffA);
            PG8_BAR; PG8_WAIT_L(0); PG8_MMA(1, 0, At, B0); PG8_BAR; PG8_SCHED;
            PG8_STAGE(PG8_SB(0, 1), b2 + hstep, voffB);
            PG8_WAIT_V(6); PG8_BAR; PG8_MMA(1, 1, At, B1); PG8_BAR;
            PG8_LDB(B0, 1, 0); PG8_SCHED; PG8_LDA(At, 1, 0); PG8_STAGE(PG8_SA(0, 1), a2 + hstep, voffA);
            PG8_WAIT_L(8); PG8_BAR; PG8_WAIT_L(0); PG8_MMA(0, 0, At, B0); PG8_BAR; PG8_SCHED;
            PG8_LDB(B1, 1, 1); PG8_STAGE(PG8_SB(1, 0), b3, voffB);
            PG8_BAR; PG8_WAIT_L(0); PG8_MMA(0, 1, At, B1); PG8_BAR;
            PG8_LDA(At, 1, 1); PG8_STAGE(PG8_SA(1, 0), a3, voffA);
            PG8_BAR; PG8_WAIT_L(0); PG8_MMA(1, 0, At, B0); PG8_BAR; PG8_SCHED;
            PG8_STAGE(PG8_SB(1, 1), b3 + hstep, voffB);
            PG8_WAIT_V(6); PG8_BAR; PG8_MMA(1, 1, At, B1); PG8_BAR;
        }
        {
            const int brow = cur.pm * BM, bcol = cur.pn * BM;
#pragma unroll
            for (int ai = 0; ai < 2; ++ai)
#pragma unroll
                for (int m = 0; m < 4; ++m) {
#pragma unroll
                    for (int bj = 0; bj < 2; ++bj)
                        E(brow + ai * HALF + wr * 64 + m * 16 + fr, bcol + bj * HALF + wc * 32, fq, acc[ai][bj][m][0], acc[ai][bj][m][1]);
                    asm volatile("" ::: "memory");
                }
        }
        if (!has_next) break;
#pragma unroll
        for (int a = 0; a < 2; ++a)
#pragma unroll
            for (int b = 0; b < 2; ++b)
#pragma unroll
                for (int m = 0; m < 4; ++m)
#pragma unroll
                    for (int n = 0; n < 2; ++n) acc[a][b][m][n] = (f32x4){0.f, 0.f, 0.f, 0.f};
        cur = nxt; cA = nA; cB = nB; ++ui;
    }
    PG8_WAIT_V(0);
    if (wr == 0) PG8_BAR;
    PG8_BAR;
#undef PG8_SA
#undef PG8_SB
#undef PG8_STAGE
#undef PG8_LDA
#undef PG8_LDB
#undef PG8_MMA
#undef PG8_WAIT_V
#undef PG8_WAIT_L
#undef PG8_BAR
#undef PG8_SCHED
}

struct EpiInProj {
    bf16_t* qkv; _Float16* urw; bf16_t* gates;
    __device__ __forceinline__ void one(int row, int col, const f32x4& v) const {
        if (col < 1536) {
            const int which = col >> 9, hc = col & 511, h = hc >> 6, d = hc & 63, b = row / TP, t = row - b * TP;
            const float s = which == 0 ? 0.125f : 1.0f;
            u32x2 w; w.x = pk_bf16(v[0] * s, v[1] * s); w.y = pk_bf16(v[2] * s, v[3] * s);
            *(u32x2*)(qkv + (size_t)which * (QKV_ONE / 2) + ((size_t)(b * NH + h) * TP + t) * 64 + d) = w;
        } else if (col < 3328) {
            h16x4 o; o[0] = (_Float16)v[0]; o[1] = (_Float16)v[1]; o[2] = (_Float16)v[2]; o[3] = (_Float16)v[3];
            *(h16x4*)(urw + (size_t)row * RWS + (col - 1536)) = o;
        } else {
            const int b = row / TP, t = row - b * TP;
            if (t >= NMETA && t < T) {
                u32x2 w; w.x = pk_bf16(sigmoidf_(v[0]), sigmoidf_(v[1])); w.y = pk_bf16(sigmoidf_(v[2]), sigmoidf_(v[3]));
                *(u32x2*)(gates + (size_t)(b * SEQ + t - NMETA) * 2048 + (col - 3328)) = w;
            }
        }
    }
    __device__ __forceinline__ void operator()(int row, int col32, int fq, const f32x4& v0, const f32x4& v1) const {
        if (col32 >= 1536 && col32 < 3072) {
            const int c = col32 - 1536, pos = (c & ~63) + fq * 16 + ((c & 63) >> 4) * 4;
            h16x8 o;
#pragma unroll
            for (int j = 0; j < 4; ++j) { o[j] = (_Float16)v0[j]; o[4 + j] = (_Float16)v1[j]; }
            *(h16x8*)(urw + (size_t)row * RWS + pos) = o;
        } else { one(row, col32 + 4 * fq, v0); one(row, col32 + 16 + 4 * fq, v1); }
    }
};
struct EpiBranch1 {
    float* t1; const bf16_t* gates;
    __device__ __forceinline__ void one(int row, int col, const f32x4& v) const {
        const u32x2 g = *(const u32x2*)(gates + (size_t)row * 2048 + col);
        f32x4 o; o[0] = v[0] * __uint_as_float(g.x << 16); o[1] = v[1] * __uint_as_float(g.x & 0xffff0000u); o[2] = v[2] * __uint_as_float(g.y << 16); o[3] = v[3] * __uint_as_float(g.y & 0xffff0000u);
        *(f32x4*)(t1 + (size_t)row * D + col) = o;
    }
    __device__ __forceinline__ void operator()(int row, int col32, int fq, const f32x4& v0, const f32x4& v1) const { one(row, col32 + 4 * fq, v0); one(row, col32 + 16 + 4 * fq, v1); }
};
struct EpiBranch2 {
    const float* t1; const bf16_t* gates; bf16_t* m;
    __device__ __forceinline__ void one(int row, int col, const f32x4& v) const {
        const u32x2 g = *(const u32x2*)(gates + (size_t)row * 2048 + 1024 + col);
        const f32x4 a = *(const f32x4*)(t1 + (size_t)row * D + col);
        f32x4 o; o[0] = a[0] + v[0] * __uint_as_float(g.x << 16); o[1] = a[1] + v[1] * __uint_as_float(g.x & 0xffff0000u); o[2] = a[2] + v[2] * __uint_as_float(g.y << 16); o[3] = a[3] + v[3] * __uint_as_float(g.y & 0xffff0000u);
        u32x2 w; w.x = pk_bf16(o[0], o[1]); w.y = pk_bf16(o[2], o[3]);
        *(u32x2*)(m + (size_t)row * D + col) = w;
    }
    __device__ __forceinline__ void operator()(int row, int col32, int fq, const f32x4& v0, const f32x4& v1) const { one(row, col32 + 4 * fq, v0); one(row, col32 + 16 + 4 * fq, v1); }
};
struct EpiF32 {
    float* o;
    __device__ __forceinline__ void operator()(int row, int col32, int fq, const f32x4& v0, const f32x4& v1) const {
        *(f32x4*)(o + (size_t)row * D + col32 + 4 * fq) = v0; *(f32x4*)(o + (size_t)row * D + col32 + 16 + 4 * fq) = v1;
    }
};
struct EpiGU {
    bf16_t* act;
    __device__ __forceinline__ void operator()(int row, int col32, int fq, const f32x4& v0, const f32x4& v1) const {
        float o[4];
#pragma unroll
        for (int j = 0; j < 4; ++j) o[j] = v0[j] * sigmoidf_(v0[j]) * v1[j];
        u32x2 w; w.x = pk_bf16(o[0], o[1]); w.y = pk_bf16(o[2], o[3]);
        *(u32x2*)(act + (size_t)row * DFF + (col32 >> 5) * 16 + 4 * fq) = w;
    }
};

__device__ __forceinline__ void transpose_tile(const float* __restrict__ src, int K, int N, bf16_t* __restrict__ dst, int ldd, int koff, int mode, int tile) {
    float* scr = (float*)smem;
    const int ntn = N / 128, kb = tile / ntn, nb = tile % ntn, k0 = kb * 64, n0 = nb * 128, tid = threadIdx.x;
    f32x4 v[4];
#pragma unroll
    for (int i = 0; i < 4; ++i) { const int idx = tid + 512 * i, kk = idx >> 5, n4 = idx & 31; v[i] = *(const f32x4*)(src + (size_t)(k0 + kk) * N + n0 + n4 * 4); }
#pragma unroll
    for (int i = 0; i < 4; ++i) { const int idx = tid + 512 * i, kk = idx >> 5, n4 = idx & 31;
#pragma unroll
        for (int c = 0; c < 4; ++c) scr[kk * 129 + n4 * 4 + c] = v[i][c]; }
    __syncthreads();
#pragma unroll
    for (int i = 0; i < 2; ++i) {
        const int o = tid + 512 * i, n = o >> 3, kc = (o & 7) * 8;
        u32x4 w;
        w.x = pk_bf16(scr[(kc + 0) * 129 + n], scr[(kc + 1) * 129 + n]); w.y = pk_bf16(scr[(kc + 2) * 129 + n], scr[(kc + 3) * 129 + n]);
        w.z = pk_bf16(scr[(kc + 4) * 129 + n], scr[(kc + 5) * 129 + n]); w.w = pk_bf16(scr[(kc + 6) * 129 + n], scr[(kc + 7) * 129 + n]);
        const int f = n0 + n;
        const int drow = mode == 0 ? f : ((f >> 4) * 32 + (mode == 2 ? 16 : 0) + (f & 15));
        *(u32x4*)(dst + (size_t)drow * ldd + koff + k0 + kc) = w;
    }
    __syncthreads();
}

__device__ __forceinline__ void phase0(const Params& p) {
    unsigned char* ws = p.ws;
    if (blockIdx.x == 0 && threadIdx.x < 64) ((unsigned*)(ws + WS_CTL))[threadIdx.x] = 0u;
    constexpr int J0 = 16 * 42, J1 = 8 * 8, J3 = 16 * 8, J4 = 16 * 22, J6 = 44 * 8, J7 = 4, J9 = 8;
    constexpr int NT = J0 + 2 * J1 + J3 + 2 * J4 + J6 + 2 * J7 + J9;
    constexpr int NR = MP / 32;
    for (int it = blockIdx.x; it < NT + NR; it += gridDim.x) {
        if (it >= NR) {
            int r = it - NR;
            if (r < J0) { transpose_tile(p.in[4], D, PIN, (bf16_t*)(ws + WS_WIN), D, 0, 0, r); continue; } r -= J0;
            if (r < J1) { transpose_tile(p.in[16], 512, D, (bf16_t*)(ws + WS_WSB), 512, 0, 0, r); continue; } r -= J1;
            if (r < J1) { transpose_tile(p.in[17], 512, D, (bf16_t*)(ws + WS_WRW), 512, 0, 0, r); continue; } r -= J1;
            if (r < J3) { transpose_tile(p.in[18], D, D, (bf16_t*)(ws + WS_WOUT), D, 0, 0, r); continue; } r -= J3;
            if (r < J4) { transpose_tile(p.in[21], D, DFF, (bf16_t*)(ws + WS_WGU), D, 0, 1, r); continue; } r -= J4;
            if (r < J4) { transpose_tile(p.in[22], D, DFF, (bf16_t*)(ws + WS_WGU), D, 0, 2, r); continue; } r -= J4;
            if (r < J6) { transpose_tile(p.in[23], DFF, D, (bf16_t*)(ws + WS_WD), DFF, 0, 0, r); continue; } r -= J6;
            if (r < J7) { transpose_tile(p.in[6], 64, 512, (bf16_t*)(ws + WS_WL), 256, 0, 0, r); continue; } r -= J7;
            if (r < J7) { transpose_tile(p.in[8], 64, 512, (bf16_t*)(ws + WS_WL), 256, 64, 0, r); continue; } r -= J7;
            transpose_tile(p.in[10], 128, 512, (bf16_t*)(ws + WS_WL), 256, 128, 0, r);
        } else {
            const int lane = threadIdx.x & 63, row0 = it * 32 + (threadIdx.x >> 6) * 4;
            f32x4 v[4][4];
#pragma unroll
            for (int r = 0; r < 4; ++r) {
                const int row = row0 + r, b = row / TP, t = row - b * TP;
                const float* src = t < NMETA ? p.in[1] + (size_t)t * D : p.in[0] + ((size_t)b * SEQ + (t < T ? t - NMETA : 0)) * D;
#pragma unroll
                for (int j = 0; j < 4; ++j) v[r][j] = *(const f32x4*)(src + 4 * lane + 256 * j);
            }
            f32x4 g[4];
#pragma unroll
            for (int j = 0; j < 4; ++j) g[j] = *(const f32x4*)(p.in[2] + 4 * lane + 256 * j);
#pragma unroll
            for (int r = 0; r < 4; ++r) {
                const int row = row0 + r, b = row / TP, t = row - b * TP;
                float ss = 0.f;
#pragma unroll
                for (int j = 0; j < 4; ++j) ss += (v[r][j][0] * v[r][j][0] + v[r][j][1] * v[r][j][1]) + (v[r][j][2] * v[r][j][2] + v[r][j][3] * v[r][j][3]);
                const float rs = t < T ? rsqrtf(wave_sum(ss) * (1.0f / D) + RMS_EPS) : 0.f;
                bf16_t* orow = (bf16_t*)(ws + O_A0) + (size_t)row * D;
#pragma unroll
                for (int j = 0; j < 4; ++j) {
                    u32x2 w; w.x = pk_bf16(v[r][j][0] * rs * g[j][0], v[r][j][1] * rs * g[j][1]); w.y = pk_bf16(v[r][j][2] * rs * g[j][2], v[r][j][3] * rs * g[j][3]);
                    *(u32x2*)(orow + 4 * lane + 256 * j) = w;
                }
            }
        }
    }
}

__device__ __forceinline__ void phase1(const Params& p) {
    unsigned char* ws = p.ws;
    EpiInProj epi{(bf16_t*)(ws + R_QKV), (_Float16*)(ws + R_URW), (bf16_t*)p.out};
    gemm_phase((const bf16_t*)(ws + O_A0), (const bf16_t*)(ws + WS_WIN), D, MP / BM, PIN / BM, epi);
}

constexpr int SI_R = 0, SI_W = 1, SI_K = 2, SI_V = 3, SI_KK = 4, SI_B = 5;
constexpr int ALD = 264;
constexpr int P2_WLS = 64 * ALD * 2;
constexpr int P2_MU = P2_WLS;
constexpr int P2_AL = P2_MU + 1024;
__device__ __forceinline__ void phase2_main(const Params& p) {
    unsigned char* ws = p.ws;
    const int tid = threadIdx.x, wave = tid >> 6, lane = tid & 63, fr = lane & 15, fq = lane >> 4;
    const int h = blockIdx.x & 7, nslot = (gridDim.x >> 3) * 8, slot = (blockIdx.x >> 3) * 8 + wave;
    const _Float16* urw = (const _Float16*)(ws + R_URW);
    const float* mu = p.in[5];
    bf16_t* WLs = (bf16_t*)smem;
    float* mus = (float*)(smem + P2_MU);
    bf16_t* Al = (bf16_t*)(smem + P2_AL) + wave * (16 * ALD);
    __syncthreads();
    {
        const bf16_t* WL = (const bf16_t*)(ws + WS_WL) + (size_t)h * 64 * 256;
#pragma unroll
        for (int i = 0; i < 4; ++i) { const int idx = tid + 512 * i, row = idx >> 5, c16 = idx & 31; *(u32x4*)(WLs + row * ALD + c16 * 8) = *(const u32x4*)(WL + row * 256 + c16 * 8); }
        if (tid < 256) mus[tid] = mu[1536 + tid];
    }
    __syncthreads();
    if (blockIdx.x >= nslot) return;
    _Float16* SI = (_Float16*)(ws + R_SI);
    bf16_t* G = (bf16_t*)(ws + R_G);
    constexpr size_t SIE = (size_t)MP * 512;
#pragma unroll 1
    for (int g = slot; g < NB * 514; g += nslot) {
        const int ub = g / 514, ui = g - ub * 514, row0 = ub * TP + ui * 16;
        {
            const int half = lane >> 5, pc = (lane & 31) * 8;
            const float sA = pc < 64 ? 2.f : 1.f, sC = pc < 64 ? -1.f : 0.f;
            const bool lin = pc >= 64 && pc < 128;
            const f32x4 mA = *(const f32x4*)(mu + 1536 + pc), mB = *(const f32x4*)(mu + 1536 + pc + 4);
            h16x8 c[8], pv[8];
#pragma unroll
            for (int q = 0; q < 8; ++q) {
                const int rowa = row0 + 2 * q + half, ta = rowa % TP;
                const _Float16* cur = urw + (size_t)rowa * RWS + 1536 + pc;
                c[q] = *(const h16x8*)cur;
                pv[q] = *(const h16x8*)(ta > 0 ? cur - RWS : cur);
            }
#pragma unroll
            for (int q = 0; q < 8; ++q) {
                const int ta = (row0 + 2 * q + half) % TP;
                float o[8];
#pragma unroll
                for (int e = 0; e < 8; ++e) {
                    const float cf = (float)c[q][e], pf = ta > 0 ? (float)pv[q][e] : 0.f;
                    const float xs = cf + (e < 4 ? mA[e & 3] : mB[e & 3]) * (pf - cf);
                    const float sg = __builtin_amdgcn_rcpf(1.0f + __expf(-sA * xs));
                    o[e] = lin ? xs : sA * sg + sC;
                }
                u32x4 w; w.x = pk_bf16(o[0], o[1]); w.y = pk_bf16(o[2], o[3]); w.z = pk_bf16(o[4], o[5]); w.w = pk_bf16(o[6], o[7]);
                *(u32x4*)(Al + (2 * q + half) * ALD + pc) = w;
            }
        }
        asm volatile("s_waitcnt lgkmcnt(0)" ::: "memory");
        __builtin_amdgcn_wave_barrier();
        f32x4 acc[4];
        auto lora = [&](auto kbeg_c, auto ksteps_c) {
            constexpr int kbeg = decltype(kbeg_c)::value, ksteps = decltype(ksteps_c)::value;
#pragma unroll
            for (int n = 0; n < 4; ++n) acc[n] = (f32x4){0.f, 0.f, 0.f, 0.f};
#pragma unroll
            for (int ks = 0; ks < ksteps; ++ks) {
                const bf16x8 af = *(const bf16x8*)(Al + fr * ALD + kbeg + ks * 32 + fq * 8);
#pragma unroll
                for (int n = 0; n < 4; ++n) {
                    const bf16x8 wf = *(const bf16x8*)(WLs + (n * 16 + fr) * ALD + kbeg + ks * 32 + fq * 8);
                    acc[n] = __builtin_amdgcn_mfma_f32_16x16x32_bf16(wf, af, acc[n], 0, 0, 0);
                }
            }
        };
        const int row = row0 + fr, b = row / TP, t = row - b * TP;
        const size_t base = ((size_t)(b * NH + h) * TP + t) * 64;
        const _Float16* ur = urw + (size_t)row * RWS;
        const size_t pb = base + fq * 16;
        lora(std::integral_constant<int, 0>{}, std::integral_constant<int, 2>{});
        {
            h16x8 wo[2];
#pragma unroll
            for (int n = 0; n < 4; ++n) {
                const f32x4 db = *(const f32x4*)(p.in[7] + h * 64 + n * 16 + fq * 4);
#pragma unroll
                for (int j = 0; j < 4; ++j) {
                    const float wl = -softplusf_(-(db[j] + acc[n][j])) - 0.5f;
                    const float e = __expf(wl);
                    wo[n >> 1][(n & 1) * 4 + j] = (_Float16)(1.0f - __expf(-e));
                }
            }
            *(h16x8*)(SI + SI_W * SIE + pb) = wo[0]; *(h16x8*)(SI + SI_W * SIE + pb + 8) = wo[1];
        }
        lora(std::integral_constant<int, 64>{}, std::integral_constant<int, 2>{});
        {
            const _Float16* up = ur + h * 64 + fq * 16;
            const _Float16* upp = t > 0 ? up - RWS : up;
            h16x8 kc[2], rc[2], vc[2], kp[2], rp[2], vp[2];
#pragma unroll
            for (int i = 0; i < 2; ++i) {
                rc[i] = *(const h16x8*)(up + i * 8); kc[i] = *(const h16x8*)(up + 512 + i * 8); vc[i] = *(const h16x8*)(up + 1024 + i * 8);
                rp[i] = *(const h16x8*)(upp + i * 8); kp[i] = *(const h16x8*)(upp + 512 + i * 8); vp[i] = *(const h16x8*)(upp + 1024 + i * 8);
            }
            float kv[4][4], av[4][4], kkr[4][4]; float ss = 0.f;
            h16x8 ro[2];
#pragma unroll
            for (int n = 0; n < 4; ++n) {
                const int c = n * 16 + fq * 4, c512 = h * 64 + c;
                const f32x4 muk = *(const f32x4*)(mu + 512 + c512), mur = *(const f32x4*)(mu + c512), muv = *(const f32x4*)(mu + 1024 + c512);
                const f32x4 ab = *(const f32x4*)(p.in[9] + c512), kkw = *(const f32x4*)(p.in[11] + c512);
                h16x4 vo;
#pragma unroll
                for (int j = 0; j < 4; ++j) {
                    const int i = n >> 1, e = (n & 1) * 4 + j;
                    const float kcf = (float)kc[i][e], kpf = t > 0 ? (float)kp[i][e] : 0.f;
                    const float rcf = (float)rc[i][e], rpf = t > 0 ? (float)rp[i][e] : 0.f;
                    const float vcf = (float)vc[i][e], vpf = t > 0 ? (float)vp[i][e] : 0.f;
                    kv[n][j] = kcf + muk[j] * (kpf - kcf);
                    ro[i][e] = (_Float16)(rcf + mur[j] * (rpf - rcf));
                    vo[j] = (_Float16)(vcf + muv[j] * (vpf - vcf));
                    av[n][j] = sigmoidf_(ab[j] + acc[n][j]);
                    kkr[n][j] = kv[n][j] * kkw[j];
                    ss += kkr[n][j] * kkr[n][j];
                }
                *(h16x4*)(SI + SI_V * SIE + base + c) = vo;
            }
            *(h16x8*)(SI + SI_R * SIE + pb) = ro[0]; *(h16x8*)(SI + SI_R * SIE + pb + 8) = ro[1];
            ss += __shfl_xor(ss, 16); ss += __shfl_xor(ss, 32);
            const float inv = fminf(__builtin_amdgcn_rsqf(ss), 1e12f);
            h16x8 ko[2], kko[2], bo[2];
#pragma unroll
            for (int n = 0; n < 4; ++n) {
                const f32x4 ka = *(const f32x4*)(p.in[12] + h * 64 + n * 16 + fq * 4);
#pragma unroll
                for (int j = 0; j < 4; ++j) {
                    const int i = n >> 1, e = (n & 1) * 4 + j;
                    const float kk = kkr[n][j] * inv;
                    ko[i][e] = (_Float16)(kv[n][j] * (1.0f + (av[n][j] - 1.0f) * ka[j]));
                    kko[i][e] = (_Float16)kk;
                    bo[i][e] = (_Float16)(kk * av[n][j]);
                }
            }
#pragma unroll
            for (int i = 0; i < 2; ++i) {
                *(h16x8*)(SI + SI_K * SIE + pb + i * 8) = ko[i]; *(h16x8*)(SI + SI_KK * SIE + pb + i * 8) = kko[i]; *(h16x8*)(SI + SI_B * SIE + pb + i * 8) = bo[i];
            }
        }
        lora(std::integral_constant<int, 128>{}, std::integral_constant<int, 4>{});
        {
            u32x4 g0, g1;
            g0.x = pk_bf16(acc[0][0], acc[0][1]); g0.y = pk_bf16(acc[0][2], acc[0][3]); g0.z = pk_bf16(acc[1][0], acc[1][1]); g0.w = pk_bf16(acc[1][2], acc[1][3]);
            g1.x = pk_bf16(acc[2][0], acc[2][1]); g1.y = pk_bf16(acc[2][2], acc[2][3]); g1.z = pk_bf16(acc[3][0], acc[3][1]); g1.w = pk_bf16(acc[3][2], acc[3][3]);
            *(u32x4*)(G + pb) = g0; *(u32x4*)(G + pb + 8) = g1;
        }
        asm volatile("s_waitcnt lgkmcnt(0)" ::: "memory");
        __builtin_amdgcn_wave_barrier();
    }
}
__device__ __forceinline__ void phase2_kmax(const Params& p, int item) {
    unsigned char* ws = p.ws;
    const int bh = item >> 2, qr = item & 3, tid = threadIdx.x;
    float* red = (float*)(smem + P2_AL + 8 * 16 * ALD * 2);
    float ss = 0.f;
    for (int t = qr * 2052 + tid; t < (qr + 1) * 2052; t += 512) {
        const bf16_t* kr = (const bf16_t*)(ws + R_QKV) + QKV_ONE / 2 + ((size_t)bh * TP + t) * 64;
        float s1 = 0.f;
#pragma unroll
        for (int q = 0; q < 8; ++q) {
            const u32x4 v = *(const u32x4*)(kr + q * 8);
#pragma unroll
            for (int e = 0; e < 4; ++e) { const float lo = __uint_as_float(v[e] << 16), hi = __uint_as_float(v[e] & 0xffff0000u); s1 += lo * lo + hi * hi; }
        }
        ss = fmaxf(ss, s1);
    }
#pragma unroll
    for (int o = 1; o < 64; o <<= 1) ss = fmaxf(ss, __shfl_xor(ss, o));
    __syncthreads();
    if ((tid & 63) == 0) red[tid >> 6] = ss;
    __syncthreads();
    if (tid == 0) {
        float m = red[0];
#pragma unroll
        for (int w = 1; w < 8; ++w) m = fmaxf(m, red[w]);
        ((float*)(ws + WS_CTL))[16 + item] = m;
    }
}
__device__ __forceinline__ void phase2(const Params& p) {
    phase2_main(p);
    for (int it = (int)gridDim.x - 1 - (int)blockIdx.x; it < 128; it += gridDim.x) phase2_kmax(p, it);
}

constexpr int SC_TC = 32, SC_NC = (T + SC_TC - 1) / SC_TC;
constexpr int SC_ARR = SC_TC * 64;
constexpr int SC_VOFF = 5 * SC_ARR, SC_COFF = SC_VOFF + SC_TC * 16;
constexpr int SC_BUF = (SC_COFF + SC_TC) * 4;
constexpr int SC_YOFF = 2 * SC_BUF, SC_YBUF = SC_TC * 16 * 4;
__device__ __forceinline__ float dot4(const f32x4& a, const f32x4& b) {
    f32x2 t = __builtin_shufflevector(a, a, 0, 1) * __builtin_shufflevector(b, b, 0, 1);
    t = __builtin_shufflevector(a, a, 2, 3) * __builtin_shufflevector(b, b, 2, 3) + t;
    return t[0] + t[1];
}
__device__ __forceinline__ void reduce16x2(float& a, float& b) {
    a += dppf<0xB1>(a); b += dppf<0xB1>(b); a += dppf<0x4E>(a); b += dppf<0x4E>(b);
    a += dppf<0x141>(a); b += dppf<0x141>(b); a += dppf<0x140>(a); b += dppf<0x140>(b);
}
__device__ __forceinline__ void scan_unit(const Params& p, int unit) {
    unsigned char* ws = p.ws;
    const int bh = unit >> 2, vr0 = (unit & 3) * 16, tid = threadIdx.x, wave = tid >> 6, lane = tid & 63;
    const _Float16* SI = (const _Float16*)(ws + R_SI);
    constexpr size_t SIE = (size_t)MP * 512;
    float* Y = (float*)(ws + O_Y);
    const size_t hb = (size_t)bh * TP * 64;
    __syncthreads();
    if (wave >= 4) {
        const int i = tid - 256, ip = i >= 8 ? i - 8 : i;
        const int arrs[5] = {SI_R, SI_W, SI_K, SI_KK, SI_B};
        u32x4 rg[5], rp[3]; unsigned rv;
        auto issue = [&](int c) {
            const size_t off = hb + (size_t)c * SC_TC * 64;
#pragma unroll
            for (int a = 0; a < 5; ++a) rg[a] = *(const u32x4*)(SI + arrs[a] * SIE + off + i * 8);
            rp[0] = *(const u32x4*)(SI + SI_W * SIE + off + ip * 8);
            rp[1] = *(const u32x4*)(SI + SI_K * SIE + off + ip * 8);
            rp[2] = *(const u32x4*)(SI + SI_B * SIE + off + ip * 8);
            rv = *(const unsigned*)(SI + SI_V * SIE + off + (i >> 3) * 64 + vr0 + (i & 7) * 2);
        };
        auto commit = [&](int bufi) {
            float* buf = (float*)(smem + bufi * SC_BUF);
            float f[5][8];
#pragma unroll
            for (int a = 0; a < 5; ++a) {
                const h16x8 hv = __builtin_bit_cast(h16x8, rg[a]);
#pragma unroll
                for (int e = 0; e < 8; ++e) f[a][e] = (float)hv[e];
            }
            const bool odd = (i >> 3) & 1;
            float ckk = 0.f, cbk = 0.f;
            {
                const h16x8 pw = __builtin_bit_cast(h16x8, rp[0]), pk = __builtin_bit_cast(h16x8, rp[1]), pb = __builtin_bit_cast(h16x8, rp[2]);
#pragma unroll
                for (int e = 0; e < 8; ++e) {
                    const float kk2 = f[3][e];
                    ckk += (float)pk[e] * kk2; cbk += (float)pb[e] * kk2;
                    if (odd) f[3][e] = (1.0f - (float)pw[e]) * kk2;
                }
            }
            ckk += dppf<0xB1>(ckk); cbk += dppf<0xB1>(cbk); ckk += dppf<0x4E>(ckk); cbk += dppf<0x4E>(cbk); ckk += dppf<0x141>(ckk); cbk += dppf<0x141>(cbk);
#pragma unroll
            for (int a = 0; a < 5; ++a) {
                f32x4 lo, hi;
#pragma unroll
                for (int e = 0; e < 4; ++e) { lo[e] = f[a][e]; hi[e] = f[a][4 + e]; }
                if (a == 1) { lo = 1.0f - lo; hi = 1.0f - hi; }
                if (a == 4) { lo = -lo; hi = -hi; }
                *(f32x4*)(buf + a * SC_ARR + i * 8) = lo; *(f32x4*)(buf + a * SC_ARR + i * 8 + 4) = hi;
            }
            const h16x2 v2 = __builtin_bit_cast(h16x2, rv);
            f32x2 vf; vf[0] = (float)v2[0]; vf[1] = (float)v2[1];
            *(f32x2*)(buf + SC_VOFF + (i >> 3) * 16 + (i & 7) * 2) = vf;
            if (odd && (i & 7) == 0) { f32x2 cf; cf[0] = ckk; cf[1] = cbk; *(f32x2*)(buf + SC_COFF + (i >> 4) * 2) = cf; }
        };
        auto yout = [&](int c) {
            const float* yb = (const float*)(smem + SC_YOFF + (c & 1) * SC_YBUF);
            const f32x2 v = *(const f32x2*)(yb + (i >> 3) * 16 + (i & 7) * 2);
            *(f32x2*)(Y + hb + (size_t)(c * SC_TC + (i >> 3)) * 64 + vr0 + (i & 7) * 2) = v;
        };
        issue(0); commit(0); issue(1);
        __syncthreads();
        for (int c = 0; c < SC_NC; ++c) {
            if (c > 0) yout(c - 1);
            if (c + 1 < SC_NC) commit((c + 1) & 1);
            if (c + 2 < SC_NC) issue(c + 2);
            __syncthreads();
        }
        yout(SC_NC - 1);
    } else {
        const int rl = wave * 4 + (lane >> 4), sub = lane & 15;
        const bool odd_lane = lane & 1; const int yoff = (lane & 1) * 16 + rl;
        f32x4 S = {0.f, 0.f, 0.f, 0.f};
        __syncthreads();
        for (int c = 0; c < SC_NC; ++c) {
            const float* buf = (const float*)(smem + (c & 1) * SC_BUF);
            float* yb = (float*)(smem + SC_YOFF + (c & 1) * SC_YBUF);
            const float* bp = buf + sub * 4;
#define SC_LD(arr, s) (*(const f32x4*)(bp + (arr) * SC_ARR + (s) * 64))
            f32x4 r1 = SC_LD(0, 0), w1 = SC_LD(1, 0), k1 = SC_LD(2, 0), q1 = SC_LD(3, 0), n1 = SC_LD(4, 0);
            f32x4 r2 = SC_LD(0, 1), w2 = SC_LD(1, 1), k2 = SC_LD(2, 1), g2 = SC_LD(3, 1), n2 = SC_LD(4, 1);
            float v1 = buf[SC_VOFF + rl], v2 = buf[SC_VOFF + 16 + rl];
            f32x2 cf = *(const f32x2*)(buf + SC_COFF);
#pragma unroll
            for (int pr = 0; pr < SC_TC / 2; ++pr) {
                const int sn = 2 * pr + 2;
                const f32x4 r1n = SC_LD(0, sn), w1n = SC_LD(1, sn), k1n = SC_LD(2, sn), q1n = SC_LD(3, sn), n1n = SC_LD(4, sn);
                const f32x4 r2n = SC_LD(0, sn + 1), w2n = SC_LD(1, sn + 1), k2n = SC_LD(2, sn + 1), g2n = SC_LD(3, sn + 1), n2n = SC_LD(4, sn + 1);
                const float v1n = buf[SC_VOFF + sn * 16 + rl], v2n = buf[SC_VOFF + (sn + 1) * 16 + rl];
                const f32x2 cfn = *(const f32x2*)(buf + SC_COFF + (pr + 1) * 2);
                __builtin_amdgcn_sched_barrier(0);
                float d1 = dot4(S, q1), e2 = dot4(S, g2);
                const f32x4 t1 = S * w1 + v1 * k1;
                reduce16x2(d1, e2);
                const float d2 = e2 + v1 * cf[0] - d1 * cf[1];
                const f32x4 S1 = t1 + d1 * n1;
                const f32x4 S2 = (S1 * w2 + v2 * k2) + d2 * n2;
                float y1 = dot4(S1, r1), y2 = dot4(S2, r2);
                y1 += dppf<0xB1>(y1); y2 += dppf<0xB1>(y2);
                float yz = odd_lane ? y2 : y1;
                yz += dppf<0x122>(yz); yz += dppf<0x124>(yz); yz += dppf<0x128>(yz);
                yb[(2 * pr) * 16 + yoff] = yz;
                S = S2;
                r1 = r1n; w1 = w1n; k1 = k1n; q1 = q1n; n1 = n1n; r2 = r2n; w2 = w2n; k2 = k2n; g2 = g2n; n2 = n2n; v1 = v1n; v2 = v2n; cf = cfn;
            }
#undef SC_LD
            __syncthreads();
        }
    }
}

constexpr int KLD = 72;
__device__ __forceinline__ void attn_unit(const Params& p, int unit) {
    unsigned char* ws = p.ws;
    const int qt = unit % 65, bh = unit / 65, b = bh >> 3, h = bh & 7;
    const int tid = threadIdx.x, wave = tid >> 6, lane = tid & 63, fr = lane & 15, fq = lane >> 4;
    const bf16_t* Q = (const bf16_t*)(ws + R_QKV) + (size_t)bh * TP * 64;
    const bf16_t* Kg = Q + QKV_ONE / 2;
    const bf16_t* Vg = Q + QKV_ONE;
    bf16_t* Ks = (bf16_t*)smem;
    bf16_t* Vt = Ks + 64 * KLD;
    volatile int* flags = (volatile int*)(smem + 2 * 64 * KLD * 2);
    const int t0 = qt * 128, tq = t0 + wave * 16 + fr;
    bf16x8 qf[2];
    qf[0] = *(const bf16x8*)(Q + (size_t)tq * 64 + fq * 8);
    qf[1] = *(const bf16x8*)(Q + (size_t)tq * 64 + 32 + fq * 8);
    float qs = 0.f;
#pragma unroll
    for (int s = 0; s < 2; ++s)
#pragma unroll
        for (int e = 0; e < 8; ++e) { const float f = bf2f((unsigned short)qf[s][e]); qs += f * f; }
    qs += __shfl_xor(qs, 16); qs += __shfl_xor(qs, 32);
    const f32x4 km4 = *(const f32x4*)((const float*)(ws + WS_CTL) + 16 + bh * 4);
    const float kmax = sqrtf(fmaxf(fmaxf(km4[0], km4[1]), fmaxf(km4[2], km4[3])));
    const float zb = sqrtf(qs) * kmax * 1.0001f + 88.0f;
    float Arow = 0.f;
    f32x4 O[4];
#pragma unroll
    for (int nd = 0; nd < 4; ++nd) O[nd] = (f32x4){0.f, 0.f, 0.f, 0.f};
    for (int kb = qt * 2 + 1; kb >= 0; --kb) {
        const bool done = __all(Arow > zb);
        if (lane == 0) flags[wave] = done ? 1 : 0;
        __syncthreads();
        int alld = 1;
#pragma unroll
        for (int w = 0; w < 8; ++w) alld &= flags[w];
        if (alld) break;
        {
            const int key = tid >> 3, dc = (tid & 7) * 8;
            const u32x4 kvv = *(const u32x4*)(Kg + (size_t)(kb * 64 + key) * 64 + dc);
            const u32x4 vvv = *(const u32x4*)(Vg + (size_t)(kb * 64 + key) * 64 + dc);
            *(u32x4*)(Ks + key * KLD + dc) = kvv;
#pragma unroll
            for (int e = 0; e < 4; ++e) { Vt[(dc + 2 * e) * KLD + key] = (bf16_t)(vvv[e] & 0xffffu); Vt[(dc + 2 * e + 1) * KLD + key] = (bf16_t)(vvv[e] >> 16); }
        }
        __syncthreads();
        f32x4 z[4];
#pragma unroll
        for (int n = 0; n < 4; ++n) {
            z[n] = (f32x4){0.f, 0.f, 0.f, 0.f};
#pragma unroll
            for (int s = 0; s < 2; ++s) {
                const bf16x8 kf = *(const bf16x8*)(Ks + (n * 16 + fr) * KLD + s * 32 + fq * 8);
                z[n] = __builtin_amdgcn_mfma_f32_16x16x32_bf16(kf, qf[s], z[n], 0, 0, 0);
            }
        }
        float sp[4][4], lt[4], ex[4], sg[4];
#pragma unroll
        for (int n = 0; n < 4; ++n) {
#pragma unroll
            for (int j = 0; j < 4; ++j) { const int s = kb * 64 + n * 16 + fq * 4 + j; sp[n][j] = s < tq ? softplusf_(z[n][j]) : 0.f; }
            sp[n][2] += sp[n][3]; sp[n][1] += sp[n][2]; sp[n][0] += sp[n][1];
            lt[n] = sp[n][0];
            const float a = __shfl_xor(lt[n], 16), pr = lt[n] + a, c = __shfl_xor(pr, 32);
            ex[n] = fq == 3 ? 0.f : (fq == 2 ? a : (fq == 1 ? c : a + c));
            sg[n] = pr + c;
        }
        float nsuf[4]; nsuf[3] = 0.f; nsuf[2] = sg[3]; nsuf[1] = nsuf[2] + sg[2]; nsuf[0] = nsuf[1] + sg[1];
        float wgt[4][4];
#pragma unroll
        for (int n = 0; n < 4; ++n)
#pragma unroll
            for (int j = 0; j < 4; ++j) {
                const int s = kb * 64 + n * 16 + fq * 4 + j;
                const float C = Arow + nsuf[n] + ex[n] + sp[n][j];
                wgt[n][j] = s < tq ? __expf(z[n][j] - C) : 0.f;
            }
        Arow += nsuf[0] + sg[0];
#pragma unroll
        for (int ks = 0; ks < 2; ++ks) {
            u32x4 pw; pw.x = pk_bf16(wgt[2 * ks][0], wgt[2 * ks][1]); pw.y = pk_bf16(wgt[2 * ks][2], wgt[2 * ks][3]);
            pw.z = pk_bf16(wgt[2 * ks + 1][0], wgt[2 * ks + 1][1]); pw.w = pk_bf16(wgt[2 * ks + 1][2], wgt[2 * ks + 1][3]);
            const bf16x8 pf = __builtin_bit_cast(bf16x8, pw);
#pragma unroll
            for (int nd = 0; nd < 4; ++nd) {
                u32x4 vw;
                const u32x2 v0 = *(const u32x2*)(Vt + (nd * 16 + fr) * KLD + (2 * ks) * 16 + fq * 4);
                const u32x2 v1 = *(const u32x2*)(Vt + (nd * 16 + fr) * KLD + (2 * ks + 1) * 16 + fq * 4);
                vw.x = v0.x; vw.y = v0.y; vw.z = v1.x; vw.w = v1.y;
                O[nd] = __builtin_amdgcn_mfma_f32_16x16x32_bf16(pf, __builtin_bit_cast(bf16x8, vw), O[nd], 0, 0, 0);
            }
        }
    }
    __syncthreads();
    bf16_t* osb = (bf16_t*)(ws + O_OSB);
#pragma unroll
    for (int j = 0; j < 4; ++j) {
        const int t = t0 + wave * 16 + fq * 4 + j;
        if (t >= NMETA && t < T) {
#pragma unroll
            for (int nd = 0; nd < 4; ++nd) osb[(size_t)(b * SEQ + t - NMETA) * 512 + h * 64 + nd * 16 + fr] = (bf16_t)(pk_bf16(O[nd][j], 0.f) & 0xffffu);
        }
    }
}

constexpr int N_SCAN = 128, N_ATTN = 32 * 65;
__device__ __forceinline__ void phase3(const Params& p, int cw = 0, int first = 0, int last = N_SCAN + N_ATTN) {
    unsigned* ctr = (unsigned*)(p.ws + WS_CTL) + cw;
    volatile int* slot = (volatile int*)(smem + 131072 - 16);
    for (;;) {
        __syncthreads();
        if (threadIdx.x == 0) *slot = (int)atomicAdd(ctr, 1u);
        __syncthreads();
        const int u = *slot + first;
        if (u >= last) break;
        if (u < N_SCAN) scan_unit(p, u); else attn_unit(p, u - N_SCAN);
    }
}

__device__ __forceinline__ void phase3c(const Params& p) {
    unsigned char* ws = p.ws;
    const _Float16* SI = (const _Float16*)(ws + R_SI);
    constexpr size_t SIE = (size_t)MP * 512;
    const float* Y = (const float*)(ws + O_Y);
    const bf16_t* G = (const bf16_t*)(ws + R_G);
    bf16_t* orw = (bf16_t*)(ws + O_ORW);
    const int tid = threadIdx.x, sub = tid & 15;
    constexpr int U = 4;
    for (int it = blockIdx.x; it < 32 * 64; it += gridDim.x) {
        const int bh = it >> 6, c4 = it & 63, b = bh >> 3, h = bh & 7;
        const int c = h * 64 + sub * 4;
        const f32x4 gain = *(const f32x4*)(p.in[14] + c), bias = *(const f32x4*)(p.in[15] + c), rk = *(const f32x4*)(p.in[13] + c);
        f32x4 y[U]; h16x4 r4[U], k4[U], v4[U]; u32x2 g2[U];
#pragma unroll
        for (int u = 0; u < U; ++u) {
            const int t = NMETA + (c4 * U + u) * 32 + (tid >> 4);
            const size_t base = ((size_t)bh * TP + t) * 64 + sub * 4;
            const size_t pbase = ((size_t)bh * TP + t) * 64 + (sub & 3) * 16 + (sub >> 2) * 4;
            y[u] = *(const f32x4*)(Y + base);
            r4[u] = *(const h16x4*)(SI + SI_R * SIE + pbase); k4[u] = *(const h16x4*)(SI + SI_K * SIE + pbase); v4[u] = *(const h16x4*)(SI + SI_V * SIE + base);
            g2[u] = *(const u32x2*)(G + pbase);
        }
#pragma unroll
        for (int u = 0; u < U; ++u) {
            const int t = NMETA + (c4 * U + u) * 32 + (tid >> 4);
            const float mean = reduce16((y[u][0] + y[u][1]) + (y[u][2] + y[u][3])) * (1.0f / 64.0f);
            const f32x4 dy = y[u] - mean;
            const float var = reduce16((dy[0] * dy[0] + dy[1] * dy[1]) + (dy[2] * dy[2] + dy[3] * dy[3])) * (1.0f / 64.0f);
            const float rs = rsqrtf(var + GN_EPS);
            float bs = 0.f;
#pragma unroll
            for (int j = 0; j < 4; ++j) bs += (float)r4[u][j] * (float)k4[u][j] * rk[j];
            bs = reduce16(bs);
            const float gg[4] = {__uint_as_float(g2[u].x << 16), __uint_as_float(g2[u].x & 0xffff0000u), __uint_as_float(g2[u].y << 16), __uint_as_float(g2[u].y & 0xffff0000u)};
            float o[4];
#pragma unroll
            for (int j = 0; j < 4; ++j) o[j] = (dy[j] * rs * gain[j] + bias[j] + bs * (float)v4[u][j]) * gg[j];
            u32x2 w; w.x = pk_bf16(o[0], o[1]); w.y = pk_bf16(o[2], o[3]);
            *(u32x2*)(orw + (size_t)(b * SEQ + t - NMETA) * 512 + c) = w;
        }
    }
}

__device__ __forceinline__ void phase4(const Params& p) {
    unsigned char* ws = p.ws;
    EpiBranch1 e1{(float*)(ws + O_T1), (const bf16_t*)p.out};
    EpiBranch2 e2{(const float*)(ws + O_T1), (const bf16_t*)p.out, (bf16_t*)(ws + O_M)};
    gemm_phase((const bf16_t*)(ws + O_OSB), (const bf16_t*)(ws + WS_WSB), 512, MS / BM, D / BM, e1);
    gemm_phase((const bf16_t*)(ws + O_ORW), (const bf16_t*)(ws + WS_WRW), 512, MS / BM, D / BM, e2);
}
__device__ __forceinline__ void phase5(const Params& p) {
    unsigned char* ws = p.ws;
    EpiF32 e{(float*)(ws + O_P)};
    gemm_phase((const bf16_t*)(ws + O_M), (const bf16_t*)(ws + WS_WOUT), D, MS / BM, D / BM, e);
}
__device__ __forceinline__ void phase6(const Params& p) {
    unsigned char* ws = p.ws;
    const int lane = threadIdx.x & 63;
    f32x4 g1[4], g2[4];
#pragma unroll
    for (int j = 0; j < 4; ++j) { g1[j] = *(const f32x4*)(p.in[3] + 4 * lane + 256 * j); g2[j] = *(const f32x4*)(p.in[19] + 4 * lane + 256 * j); }
    for (int it = blockIdx.x; it < MS / 16; it += gridDim.x) {
        const int row0 = it * 16 + (threadIdx.x >> 6) * 2;
        f32x4 v[2][4], x[2][4];
#pragma unroll
        for (int r = 0; r < 2; ++r)
#pragma unroll
            for (int j = 0; j < 4; ++j) {
                v[r][j] = *(const f32x4*)((const float*)(ws + O_P) + (size_t)(row0 + r) * D + 4 * lane + 256 * j);
                x[r][j] = *(const f32x4*)(p.in[0] + (size_t)(row0 + r) * D + 4 * lane + 256 * j);
            }
#pragma unroll
        for (int r = 0; r < 2; ++r) {
            const int row = row0 + r;
            float ss = 0.f;
#pragma unroll
            for (int j = 0; j < 4; ++j) ss += (v[r][j][0] * v[r][j][0] + v[r][j][1] * v[r][j][1]) + (v[r][j][2] * v[r][j][2] + v[r][j][3] * v[r][j][3]);
            const float rs = rsqrtf(wave_sum(ss) * (1.0f / D) + RMS_EPS);
            float s2 = 0.f;
#pragma unroll
            for (int j = 0; j < 4; ++j) {
                v[r][j] = x[r][j] + v[r][j] * rs * g1[j];
                *(f32x4*)(p.out + (size_t)row * D + 4 * lane + 256 * j) = v[r][j];
                s2 += (v[r][j][0] * v[r][j][0] + v[r][j][1] * v[r][j][1]) + (v[r][j][2] * v[r][j][2] + v[r][j][3] * v[r][j][3]);
            }
            const float rs2 = rsqrtf(wave_sum(s2) * (1.0f / D) + RMS_EPS);
            bf16_t* fr_ = (bf16_t*)(ws + O_F) + (size_t)row * D;
#pragma unroll
            for (int j = 0; j < 4; ++j) {
                u32x2 w; w.x = pk_bf16(v[r][j][0] * rs2 * g2[j][0], v[r][j][1] * rs2 * g2[j][1]); w.y = pk_bf16(v[r][j][2] * rs2 * g2[j][2], v[r][j][3] * rs2 * g2[j][3]);
                *(u32x2*)(fr_ + 4 * lane + 256 * j) = w;
            }
        }
    }
}
__device__ __forceinline__ void phase7(const Params& p) {
    unsigned char* ws = p.ws;
    EpiGU e{(bf16_t*)(ws + O_ACT)};
    gemm_phase((const bf16_t*)(ws + O_F), (const bf16_t*)(ws + WS_WGU), D, MS / BM, 2 * DFF / BM, e);
}
__device__ __forceinline__ void phase8(const Params& p) {
    unsigned char* ws = p.ws;
    EpiF32 e{(float*)(ws + O_DN)};
    gemm_phase((const bf16_t*)(ws + O_ACT), (const bf16_t*)(ws + WS_WD), DFF, MS / BM, D / BM, e);
}
__device__ __forceinline__ void phase9(const Params& p) {
    unsigned char* ws = p.ws;
    const int lane = threadIdx.x & 63;
    f32x4 g[4];
#pragma unroll
    for (int j = 0; j < 4; ++j) g[j] = *(const f32x4*)(p.in[20] + 4 * lane + 256 * j);
    for (int it = blockIdx.x; it < MS / 16; it += gridDim.x) {
        const int row0 = it * 16 + (threadIdx.x >> 6) * 2;
        f32x4 v[2][4], h1[2][4];
#pragma unroll
        for (int r = 0; r < 2; ++r)
#pragma unroll
            for (int j = 0; j < 4; ++j) {
                v[r][j] = *(const f32x4*)((const float*)(ws + O_DN) + (size_t)(row0 + r) * D + 4 * lane + 256 * j);
                h1[r][j] = *(const f32x4*)(p.out + (size_t)(row0 + r) * D + 4 * lane + 256 * j);
            }
#pragma unroll
        for (int r = 0; r < 2; ++r) {
            float ss = 0.f;
#pragma unroll
            for (int j = 0; j < 4; ++j) ss += (v[r][j][0] * v[r][j][0] + v[r][j][1] * v[r][j][1]) + (v[r][j][2] * v[r][j][2] + v[r][j][3] * v[r][j][3]);
            const float rs = rsqrtf(wave_sum(ss) * (1.0f / D) + RMS_EPS);
#pragma unroll
            for (int j = 0; j < 4; ++j) *(f32x4*)(p.out + (size_t)(row0 + r) * D + 4 * lane + 256 * j) = h1[r][j] + v[r][j] * rs * g[j];
        }
    }
}

constexpr int N_PHASES = 11;
__device__ __forceinline__ void run_phase(const Params& p, int ph) {
    switch (ph) {
        case 0: phase0(p); break;
        case 1: phase1(p); break;
        case 2: phase2(p); break;
        case 3: phase3(p); break;
        case 4: phase3c(p); break;
        case 5: phase4(p); break;
        case 6: phase5(p); break;
        case 7: phase6(p); break;
        case 8: phase7(p); break;
        case 9: phase8(p); break;
        default: phase9(p); break;
    }
}

#if MULTI_LAUNCH
template <int PH> __global__ void __launch_bounds__(512) fwd_phase(Params p) { run_phase(p, PH); }
#else
__global__ void __launch_bounds__(512) fwd_mega(Params p) {
    cg::grid_group grid = cg::this_grid();
    volatile LAS unsigned* st = (volatile LAS unsigned*)(smem + 131072);
    if (threadIdx.x == 0) { st[0] = 0u; st[1] = 0u; }
    __syncthreads();
    const XcdBarrier xb = xcd_barrier_post((unsigned*)(p.ws + WS_BAR), st);
    if (p.out == nullptr) grid.sync();
    phase0(p); xcd_barrier(xb); phase1(p); xcd_barrier(xb); phase2(p); xcd_barrier(xb); phase3(p); xcd_barrier(xb); phase3c(p); xcd_barrier(xb);
    phase4(p); xcd_barrier(xb); phase5(p); xcd_barrier(xb); phase6(p); xcd_barrier(xb); phase7(p); xcd_barrier(xb); phase8(p); xcd_barrier(xb); phase9(p);
}
#endif

extern "C" void kernel_launch(void* const* d_in, const int* in_sizes, int n_in, void* d_out, int out_size, void* d_ws, size_t ws_size, hipStream_t stream) {
    static int grid = 0;
    if (grid == 0) {
        if (n_in != 24 || out_size != MS * D || ws_size < WS_END) { fprintf(stderr, "kernel_launch: unexpected shapes (n_in %d out %d ws %zu need %zu)\n", n_in, out_size, ws_size, (size_t)WS_END); grid = -1; return; }
        int dev = 0, cus = 0, per_cu = 0;
        (void)hipGetDevice(&dev);
        (void)hipDeviceGetAttribute(&cus, hipDeviceAttributeMultiprocessorCount, dev);
#if MULTI_LAUNCH
        per_cu = 1;
#else
        (void)hipFuncSetAttribute((const void*)fwd_mega, hipFuncAttributeMaxDynamicSharedMemorySize, LDS_BYTES);
        (void)hipOccupancyMaxActiveBlocksPerMultiprocessor(&per_cu, (const void*)fwd_mega, 512, LDS_BYTES);
        if (per_cu < 1) { fprintf(stderr, "kernel_launch: occupancy query says %d blocks per CU\n", per_cu); per_cu = 1; }
        if (per_cu > 1) per_cu = 1;
#endif
        grid = cus * per_cu;
    }
    if (grid < 0) return;
    Params p{};
    for (int i = 0; i < 24; ++i) p.in[i] = (const float*)d_in[i];
    p.out = (float*)d_out; p.ws = (unsigned char*)d_ws;
#if MULTI_LAUNCH
#define LP(PH) do { (void)hipFuncSetAttribute((const void*)fwd_phase<PH>, hipFuncAttributeMaxDynamicSharedMemorySize, LDS_BYTES); hipLaunchKernelGGL(fwd_phase<PH>, dim3(grid), dim3(512), LDS_BYTES, stream, p); } while (0)
    LP(0); LP(1); LP(2); LP(3); LP(4); LP(5); LP(6); LP(7); LP(8); LP(9); LP(10);
#undef LP
#else
    if (hipMemsetAsync(d_ws, 0, WS_CTL_BYTES, stream) != hipSuccess) { fprintf(stderr, "kernel_launch: hipMemsetAsync of the control words failed\n"); return; }
    void* args[] = {&p};
    hipError_t e = hipLaunchCooperativeKernel((const void*)fwd_mega, dim3(grid), dim3(512), args, LDS_BYTES, stream);
    if (e != hipSuccess) fprintf(stderr, "cooperative launch failed: %s (grid %d)\n", hipGetErrorString(e), grid);
#endif
}
```

```cpp
#include <hip/hip_runtime.h>
#include <hip/hip_cooperative_groups.h>
#include <cstdio>
#include <cstdint>
#include <type_traits>
namespace cg = cooperative_groups;

#ifndef MULTI_LAUNCH
#define MULTI_LAUNCH 0
#endif

typedef unsigned short bf16_t;
typedef short bf16x8 __attribute__((ext_vector_type(8)));
typedef float f32x4 __attribute__((ext_vector_type(4)));
typedef float f32x2 __attribute__((ext_vector_type(2)));
typedef unsigned u32x2 __attribute__((ext_vector_type(2)));
typedef unsigned u32x4 __attribute__((ext_vector_type(4)));
typedef _Float16 h16x2 __attribute__((ext_vector_type(2)));
typedef _Float16 h16x4 __attribute__((ext_vector_type(4)));
typedef _Float16 h16x8 __attribute__((ext_vector_type(8)));

constexpr int D = 1024, NB = 4, SEQ = 8192, NMETA = 16, T = SEQ + NMETA, TP = 8320, MP = NB * TP, MS = NB * SEQ;
constexpr int PIN = 5376, DFF = 2816, NH = 8, RWS = 1792;
constexpr float RMS_EPS = 1e-6f, GN_EPS = 64e-5f;

constexpr size_t WS_CTL = 0;
constexpr size_t WS_BAR = 4096;
constexpr size_t WS_CTL_BYTES = 32768;
constexpr size_t WS_WIN = WS_CTL_BYTES;
constexpr size_t WS_WSB = WS_WIN + (size_t)PIN * D * 2;
constexpr size_t WS_WRW = WS_WSB + (size_t)D * 512 * 2;
constexpr size_t WS_WOUT = WS_WRW + (size_t)D * 512 * 2;
constexpr size_t WS_WGU = WS_WOUT + (size_t)D * D * 2;
constexpr size_t WS_WD = WS_WGU + (size_t)2 * DFF * D * 2;
constexpr size_t WS_WL = WS_WD + (size_t)D * DFF * 2;
constexpr size_t R_QKV = WS_WL + (size_t)512 * 256 * 2;
constexpr size_t QKV_ONE = (size_t)MP * 512 * 2;
constexpr size_t R_URW = R_QKV + 3 * QKV_ONE;
constexpr size_t R_SI = R_URW + (size_t)MP * RWS * 2;
constexpr size_t SI_ONE = (size_t)MP * 512 * 2;
constexpr size_t R_G = R_SI + 6 * SI_ONE;
constexpr size_t WS_END = R_G + SI_ONE;
constexpr size_t O_A0 = R_SI;
constexpr size_t O_Y = R_URW;
constexpr size_t O_OSB = R_URW + (size_t)MP * 512 * 4;
constexpr size_t O_ORW = R_QKV;
constexpr size_t O_T1 = R_SI;
constexpr size_t O_M = R_SI + (size_t)MS * D * 4;
constexpr size_t O_P = R_QKV;
constexpr size_t O_F = R_SI;
constexpr size_t O_ACT = R_QKV;
constexpr size_t O_DN = R_SI + (size_t)MS * D * 2;
static_assert(O_OSB + (size_t)MS * 512 * 2 <= R_SI, "overlay");
static_assert(O_M + (size_t)MS * D * 2 <= WS_END, "overlay");
static_assert(O_ACT + (size_t)MS * DFF * 2 <= R_SI, "overlay");
static_assert(O_DN + (size_t)MS * D * 4 <= WS_END, "overlay");
static_assert(WS_END <= (size_t)512 * 1024 * 1024, "workspace");

constexpr int LDS_BYTES = 131072 + 64;

struct Params { const float* in[24]; float* out; unsigned char* ws; };

extern __shared__ __attribute__((aligned(16))) unsigned char smem[];

typedef __bf16 b16x2 __attribute__((ext_vector_type(2)));
__device__ __forceinline__ unsigned pk_bf16(float lo, float hi) { const f32x2 v = {lo, hi}; return __builtin_bit_cast(unsigned, __builtin_convertvector(v, b16x2)); }
__device__ __forceinline__ float bf2f(unsigned short v) { return __uint_as_float((unsigned)v << 16); }
__device__ __forceinline__ float sigmoidf_(float x) { return __builtin_amdgcn_rcpf(1.0f + __expf(-x)); }
__device__ __forceinline__ float softplusf_(float x) { return fmaxf(x, 0.f) + __logf(1.0f + __expf(-fabsf(x))); }
template <int CTRL> __device__ __forceinline__ float dppf(float x) { return __builtin_bit_cast(float, __builtin_amdgcn_mov_dpp(__builtin_bit_cast(int, x), CTRL, 0xf, 0xf, true)); }
__device__ __forceinline__ float reduce16(float v) {
    v += dppf<0xB1>(v); v += dppf<0x4E>(v); v += dppf<0x141>(v); v += dppf<0x140>(v); return v;
}
__device__ __forceinline__ float wave_sum(float v) {
#pragma unroll
    for (int o = 1; o < 64; o <<= 1) v += __shfl_xor(v, o);
    return v;
}

#define LAS __attribute__((address_space(3)))
#define XB_TMO      128
#define XB_XCNT(j)  (256  + 64 * (j))
#define XB_XSUB(j)  (1280 + 64 * (j))
#define XB_XGEN(j)  (2304 + 64 * (j))
#define XB_TOP      3328
#define XB_TOPGEN   3392
#define XCD_BAR_WORDS 3456
#define XB_SPIN_CAP (1u << 18)
__device__ __forceinline__ unsigned xb_ld(unsigned* p)              { return __hip_atomic_load(p, __ATOMIC_RELAXED, __HIP_MEMORY_SCOPE_AGENT); }
__device__ __forceinline__ unsigned xb_add(unsigned* p, unsigned v) { return __hip_atomic_fetch_add(p, v, __ATOMIC_RELAXED, __HIP_MEMORY_SCOPE_AGENT); }
__device__ __forceinline__ unsigned xb_xcc_id() { return (unsigned)__builtin_amdgcn_s_getreg((3 << 11) | 20) & 0xFu; }
#define XB_SPIN(cond, bar) do { unsigned _sp = 0; while (cond) { __builtin_amdgcn_s_sleep(1); \
    if ((++_sp & 255u) == 0u) { if (xb_ld(&(bar)[XB_TMO])) break; if (_sp > XB_SPIN_CAP) { atomicAdd(&(bar)[XB_TMO], 1u); break; } } } } while (0)
struct XcdBarrier { unsigned* bar; unsigned x; volatile LAS unsigned* st; };
__device__ __forceinline__ XcdBarrier xcd_barrier_post(unsigned* bar, volatile LAS unsigned* st) {
    XcdBarrier b; b.bar = bar; b.x = xb_xcc_id(); b.st = st;
    if (threadIdx.x == 0) (void)xb_add(&bar[XB_XCNT(b.x)], 1u);
    return b;
}
__device__ __forceinline__ void xcd_barrier_complete(unsigned* bar, unsigned x, unsigned& nloc, unsigned& nx) {
    const unsigned G = gridDim.x * gridDim.y * gridDim.z;
    unsigned sum, cnt, mine, sp = 0u;
    for (;;) {
        sum = 0u; cnt = 0u; mine = 0u;
#pragma unroll
        for (unsigned j = 0; j < 16; ++j) { const unsigned c = xb_ld(&bar[XB_XCNT(j)]); sum += c; cnt += (c > 0u) ? 1u : 0u; mine = (j == x) ? c : mine; }
        if (sum == G) break;
        __builtin_amdgcn_s_sleep(1);
        if ((++sp & 255u) == 0u) { if (xb_ld(&bar[XB_TMO])) break; if (sp > XB_SPIN_CAP) { atomicAdd(&bar[XB_TMO], 1u); break; } }
    }
    nloc = mine > 0u ? mine : 1u; nx = cnt > 0u ? cnt : 1u;
}
__device__ __forceinline__ void xcd_barrier(const XcdBarrier& b) {
    asm volatile("s_waitcnt vmcnt(0)" ::: "memory");
    __syncthreads();
    if (threadIdx.x == 0) {
        unsigned* bar = b.bar;
        __builtin_amdgcn_s_waitcnt(0);
        unsigned nloc = b.st[0], nx = b.st[1];
        if (nloc == 0u) { xcd_barrier_complete(bar, b.x, nloc, nx); b.st[0] = nloc; b.st[1] = nx; }
        const unsigned old = xb_add(&bar[XB_XSUB(b.x)], 1u);
        const unsigned gen = old / nloc;
        if (old + 1u == (gen + 1u) * nloc) {
            __builtin_amdgcn_fence(__ATOMIC_RELEASE, "agent");
            asm volatile("s_waitcnt vmcnt(0)" ::: "memory");
            const unsigned og = xb_add(&bar[XB_TOP], 1u);
            const unsigned tg = og / nx;
            if (og + 1u == (tg + 1u) * nx) xb_add(&bar[XB_TOPGEN], 1u);
            else XB_SPIN(xb_ld(&bar[XB_TOPGEN]) == tg, bar);
            __builtin_amdgcn_fence(__ATOMIC_ACQUIRE, "agent");
            xb_add(&bar[XB_XGEN(b.x)], 1u);
            asm volatile("s_waitcnt vmcnt(0)" ::: "memory");
        } else {
            XB_SPIN(xb_ld(&bar[XB_XGEN(b.x)]) == gen, bar);
            __builtin_amdgcn_fence(__ATOMIC_ACQUIRE, "agent");
            asm volatile("s_waitcnt vmcnt(0)" ::: "memory");
        }
    }
    __syncthreads();
}

constexpr int BM = 256, BK = 64, HALF = 128, HTB = HALF * BK * 2, NXCD = 8, WGM = 8;
__device__ __forceinline__ int lds_byte(int r, int c) { const int st = (r >> 4) * 2 + (c >> 5), rr = r & 15, cc = c & 31, ob = rr * 64 + cc * 2; return st * 1024 + (ob ^ (((ob >> 9) & 1) << 5)); }
__device__ __forceinline__ void stage_rc(int b, int& R, int& C) { const int st = b / 1024, sb = b % 1024, swz = sb ^ (((sb >> 9) & 1) << 5); R = (st >> 1) * 16 + swz / 64; C = (st & 1) * 32 + (swz % 64) / 2; }
struct Unit { int pm, pn; };
struct Sched {
    int nM, nN, nwg, G, c;
    __device__ __forceinline__ bool next(int i, Unit& u) const {
        const long L = (long)i * G + c; if (L >= nwg) return false;
        int wgid = (int)L; { const int q = nwg / NXCD, r = nwg % NXCD, xcd = wgid % NXCD, off = wgid / NXCD; wgid = (xcd < r ? xcd * (q + 1) : r * (q + 1) + (xcd - r) * q) + off; }
        const int nig = WGM * nN, gid = wgid / nig, fm = gid * WGM, gsz = (nM - fm) < WGM ? (nM - fm) : WGM;
        u.pm = fm + ((wgid % nig) % gsz); u.pn = (wgid % nig) / gsz; return true;
    }
};

template <class Epi>
__device__ __forceinline__ void gemm_phase(const bf16_t* __restrict__ Ag, const bf16_t* __restrict__ Btg, const int K, const int nM, const int nN, const Epi& E) {
    LAS unsigned char* lds = (LAS unsigned char*)smem;
    const int tid = threadIdx.x, wid = __builtin_amdgcn_readfirstlane(tid >> 6), lane = tid & 63, wr = wid >> 2, wc = wid & 3, fr = lane & 15, fq = lane >> 4;
    const int nt = K / BK;
    Sched S; S.nM = nM; S.nN = nN; S.nwg = nM * nN; S.G = gridDim.x; S.c = blockIdx.x;
    unsigned voffA[2], voffB[2];
#pragma unroll
    for (int i = 0; i < 2; ++i) { int R, C; stage_rc(tid * 16 + i * 8192, R, C); voffA[i] = (unsigned)(R * K + C) * 2u; voffB[i] = voffA[i]; }
    const size_t kstep = (size_t)(BK * 2);
    const size_t hstep = (size_t)HALF * K * 2;
    const size_t tstep = 2 * hstep;
    const unsigned ldsw = (unsigned)wid * 1024u;
    const int aoff = lds_byte(wr * 64 + fr, fq * 8), boff = lds_byte(wc * 32 + fr, fq * 8);
#define PG8_SA(b, h) (((b) * 2 + (h)) * HTB)
#define PG8_SB(b, h) ((4 + (b) * 2 + (h)) * HTB)
#define PG8_STAGE(bufoff, gbase, voff) do { _Pragma("unroll") for (int _i = 0; _i < 2; ++_i) \
        __builtin_amdgcn_global_load_lds((const unsigned*)((const char*)(gbase) + (voff)[_i]), (LAS unsigned*)(lds + (bufoff) + ldsw + _i * 8192), 16, 0, 0); } while (0)
#define PG8_LDA(dst, b, h) do { _Pragma("unroll") for (int m = 0; m < 4; ++m) _Pragma("unroll") for (int k = 0; k < 2; ++k) dst[m][k] = *(const LAS bf16x8*)(lds + PG8_SA(b, h) + aoff + m * 2048 + k * 1024); } while (0)
#define PG8_LDB(dst, b, h) do { _Pragma("unroll") for (int n = 0; n < 2; ++n) _Pragma("unroll") for (int k = 0; k < 2; ++k) dst[n][k] = *(const LAS bf16x8*)(lds + PG8_SB(b, h) + boff + n * 2048 + k * 1024); } while (0)
#define PG8_MMA(ai, bj, At, Bt) do { __builtin_amdgcn_s_setprio(1); _Pragma("unroll") for (int m = 0; m < 4; ++m) _Pragma("unroll") for (int n = 0; n < 2; ++n) _Pragma("unroll") for (int k = 0; k < 2; ++k) \
        acc[ai][bj][m][n] = __builtin_amdgcn_mfma_f32_16x16x32_bf16(Bt[n][k], At[m][k], acc[ai][bj][m][n], 0, 0, 0); __builtin_amdgcn_s_setprio(0); } while (0)
#define PG8_WAIT_V(n) asm volatile("s_waitcnt vmcnt(" #n ")" ::: "memory")
#define PG8_WAIT_L(n) asm volatile("s_waitcnt lgkmcnt(" #n ")" ::: "memory")
#define PG8_BAR __builtin_amdgcn_s_barrier()
#define PG8_SCHED __builtin_amdgcn_sched_barrier(0)
    Unit cur, nxt; int ui = 0;
    __syncthreads();
    if (!S.next(0, cur)) return;
    f32x4 acc[2][2][4][2];
#pragma unroll
    for (int a = 0; a < 2; ++a)
#pragma unroll
        for (int b = 0; b < 2; ++b)
#pragma unroll
            for (int m = 0; m < 4; ++m)
#pragma unroll
                for (int n = 0; n < 2; ++n) acc[a][b][m][n] = (f32x4){0.f, 0.f, 0.f, 0.f};
    bf16x8 At[4][2], B0[2][2], B1[2][2];
    const char* cA = (const char*)Ag + (size_t)cur.pm * tstep; const char* cB = (const char*)Btg + (size_t)cur.pn * tstep;
    PG8_STAGE(PG8_SB(0, 0), cB, voffB); PG8_STAGE(PG8_SA(0, 0), cA, voffA); PG8_STAGE(PG8_SB(0, 1), cB + hstep, voffB); PG8_STAGE(PG8_SA(0, 1), cA + hstep, voffA);
    if (wr == 1) PG8_BAR;
    PG8_WAIT_V(4); PG8_BAR;
    PG8_STAGE(PG8_SB(1, 0), cB + kstep, voffB); PG8_STAGE(PG8_SA(1, 0), cA + kstep, voffA); PG8_STAGE(PG8_SB(1, 1), cB + hstep + kstep, voffB);
    PG8_WAIT_V(6); PG8_BAR;
    for (;;) {
        const bool has_next = S.next(ui + 1, nxt);
        const char* nA = has_next ? (const char*)Ag + (size_t)nxt.pm * tstep : cA; const char* nB = has_next ? (const char*)Btg + (size_t)nxt.pn * tstep : cB;
        for (int t = 0; t < nt; t += 2) {
            const bool last = (t == nt - 2);
            const char* a1 = cA + (size_t)(t + 1) * kstep;
            const char* a2 = last ? nA : cA + (size_t)(t + 2) * kstep; const char* b2 = last ? nB : cB + (size_t)(t + 2) * kstep;
            const char* a3 = a2 + kstep; const char* b3 = b2 + kstep;
            PG8_LDB(B0, 0, 0); PG8_SCHED; PG8_LDA(At, 0, 0); PG8_STAGE(PG8_SA(1, 1), a1 + hstep, voffA);
            PG8_WAIT_L(8); PG8_BAR; PG8_WAIT_L(0); PG8_MMA(0, 0, At, B0); PG8_BAR; PG8_SCHED;
            PG8_LDB(B1, 0, 1); PG8_STAGE(PG8_SB(0, 0), b2, voffB);
            PG8_BAR; PG8_WAIT_L(0); PG8_MMA(0, 1, At, B1); PG8_BAR;
            PG8_LDA(At, 0, 1); PG8_STAGE(PG8_SA(0, 0), a2, voffA);
            PG8_BAR; PG8_WAIT_L(0); PG8_MMA(1, 0, At, B0); PG8_BAR; PG8_SCHED;
            PG8_STAGE(PG8_SB(0, 1), b2 + hstep, voffB);
            PG8_WAIT_V(6); PG8_BAR; PG8_MMA(1, 1, At, B1); PG8_BAR;
            PG8_LDB(B0, 1, 0); PG8_SCHED; PG8_LDA(At, 1, 0); PG8_STAGE(PG8_SA(0, 1), a2 + hstep, voffA);
            PG8_WAIT_L(8); PG8_BAR; PG8_WAIT_L(0); PG8_MMA(0, 0, At, B0); PG8_BAR; PG8_SCHED;
            PG8_LDB(B1, 1, 1); PG8_STAGE(PG8_SB(1, 0), b3, voffB);
            PG8_BAR; PG8_WAIT_L(0); PG8_MMA(0, 1, At, B1); PG8_BAR;
            PG8_LDA(At, 1, 1); PG8_STAGE(PG8_SA(1, 0), a3, voffA);
            PG8_BAR; PG8_WAIT_L(0); PG8_MMA(1, 0, At, B0); PG8_BAR; PG8_SCHED;
            PG8_STAGE(PG8_SB(1, 1), b3 + hstep, voffB);
            PG8_WAIT_V(6); PG8_BAR; PG8_MMA(1, 1, At, B1); PG8_BAR;
        }
        {
            const int brow = cur.pm * BM, bcol = cur.pn * BM;
#pragma unroll
            for (int ai = 0; ai < 2; ++ai)
#pragma unroll
                for (int m = 0; m < 4; ++m) {
#pragma unroll
                    for (int bj = 0; bj < 2; ++bj)
                        E(brow + ai * HALF + wr * 64 + m * 16 + fr, bcol + bj * HALF + wc * 32, fq, acc[ai][bj][m][0], acc[ai][bj][m][1]);
                    asm volatile("" ::: "memory");
                }
        }
        if (!has_next) break;
#pragma unroll
        for (int a = 0; a < 2; ++a)
#pragma unroll
            for (int b = 0; b < 2; ++b)
#pragma unroll
                for (int m = 0; m < 4; ++m)
#pragma unroll
                    for (int n = 0; n < 2; ++n) acc[a][b][m][n] = (f32x4){0.f, 0.f, 0.f, 0.f};
        cur = nxt; cA = nA; cB = nB; ++ui;
    }
    PG8_WAIT_V(0);
    if (wr == 0) PG8_BAR;
    PG8_BAR;
#undef PG8_SA
#undef PG8_SB
#undef PG8_STAGE
#undef PG8_LDA
#undef PG8_LDB
#undef PG8_MMA
#undef PG8_WAIT_V
#undef PG8_WAIT_L
#undef PG8_BAR
#undef PG8_SCHED
}

struct EpiInProj {
    bf16_t* qkv; _Float16* urw; bf16_t* gates;
    __device__ __forceinline__ void one(int row, int col, const f32x4& v) const {
        if (col < 1536) {
            const int which = col >> 9, hc = col & 511, h = hc >> 6, d = hc & 63, b = row / TP, t = row - b * TP;
            const float s = which == 0 ? 0.125f : 1.0f;
            u32x2 w; w.x = pk_bf16(v[0] * s, v[1] * s); w.y = pk_bf16(v[2] * s, v[3] * s);
            *(u32x2*)(qkv + (size_t)which * (QKV_ONE / 2) + ((size_t)(b * NH + h) * TP + t) * 64 + d) = w;
        } else if (col < 3328) {
            h16x4 o; o[0] = (_Float16)v[0]; o[1] = (_Float16)v[1]; o[2] = (_Float16)v[2]; o[3] = (_Float16)v[3];
            *(h16x4*)(urw + (size_t)row * RWS + (col - 1536)) = o;
        } else {
            const int b = row / TP, t = row - b * TP;
            if (t >= NMETA && t < T) {
                u32x2 w; w.x = pk_bf16(sigmoidf_(v[0]), sigmoidf_(v[1])); w.y = pk_bf16(sigmoidf_(v[2]), sigmoidf_(v[3]));
                *(u32x2*)(gates + (size_t)(b * SEQ + t - NMETA) * 2048 + (col - 3328)) = w;
            }
        }
    }
    __device__ __forceinline__ void operator()(int row, int col32, int fq, const f32x4& v0, const f32x4& v1) const {
        if (col32 >= 1536 && col32 < 3072) {
            const int c = col32 - 1536, pos = (c & ~63) + fq * 16 + ((c & 63) >> 4) * 4;
            h16x8 o;
#pragma unroll
            for (int j = 0; j < 4; ++j) { o[j] = (_Float16)v0[j]; o[4 + j] = (_Float16)v1[j]; }
            *(h16x8*)(urw + (size_t)row * RWS + pos) = o;
        } else { one(row, col32 + 4 * fq, v0); one(row, col32 + 16 + 4 * fq, v1); }
    }
};
struct EpiBranch1 {
    float* t1; const bf16_t* gates;
    __device__ __forceinline__ void one(int row, int col, const f32x4& v) const {
        const u32x2 g = *(const u32x2*)(gates + (size_t)row * 2048 + col);
        f32x4 o; o[0] = v[0] * __uint_as_float(g.x << 16); o[1] = v[1] * __uint_as_float(g.x & 0xffff0000u); o[2] = v[2] * __uint_as_float(g.y << 16); o[3] = v[3] * __uint_as_float(g.y & 0xffff0000u);
        *(f32x4*)(t1 + (size_t)row * D + col) = o;
    }
    __device__ __forceinline__ void operator()(int row, int col32, int fq, const f32x4& v0, const f32x4& v1) const { one(row, col32 + 4 * fq, v0); one(row, col32 + 16 + 4 * fq, v1); }
};
struct EpiBranch2 {
    const float* t1; const bf16_t* gates; bf16_t* m;
    __device__ __forceinline__ void one(int row, int col, const f32x4& v) const {
        const u32x2 g = *(const u32x2*)(gates + (size_t)row * 2048 + 1024 + col);
        const f32x4 a = *(const f32x4*)(t1 + (size_t)row * D + col);
        f32x4 o; o[0] = a[0] + v[0] * __uint_as_float(g.x << 16); o[1] = a[1] + v[1] * __uint_as_float(g.x & 0xffff0000u); o[2] = a[2] + v[2] * __uint_as_float(g.y << 16); o[3] = a[3] + v[3] * __uint_as_float(g.y & 0xffff0000u);
        u32x2 w; w.x = pk_bf16(o[0], o[1]); w.y = pk_bf16(o[2], o[3]);
        *(u32x2*)(m + (size_t)row * D + col) = w;
    }
    __device__ __forceinline__ void operator()(int row, int col32, int fq, const f32x4& v0, const f32x4& v1) const { one(row, col32 + 4 * fq, v0); one(row, col32 + 16 + 4 * fq, v1); }
};
struct EpiF32 {
    float* o;
    __device__ __forceinline__ void operator()(int row, int col32, int fq, const f32x4& v0, const f32x4& v1) const {
        *(f32x4*)(o + (size_t)row * D + col32 + 4 * fq) = v0; *(f32x4*)(o + (size_t)row * D + col32 + 16 + 4 * fq) = v1;
    }
};
struct EpiGU {
    bf16_t* act;
    __device__ __forceinline__ void operator()(int row, int col32, int fq, const f32x4& v0, const f32x4& v1) const {
        float o[4];
#pragma unroll
        for (int j = 0; j < 4; ++j) o[j] = v0[j] * sigmoidf_(v0[j]) * v1[j];
        u32x2 w; w.x = pk_bf16(o[0], o[1]); w.y = pk_bf16(o[2], o[3]);
        *(u32x2*)(act + (size_t)row * DFF + (col32 >> 5) * 16 + 4 * fq) = w;
    }
};

__device__ __forceinline__ void transpose_tile(const float* __restrict__ src, int K, int N, bf16_t* __restrict__ dst, int ldd, int koff, int mode, int tile) {
    float* scr = (float*)smem;
    const int ntn = N / 128, kb = tile / ntn, nb = tile % ntn, k0 = kb * 64, n0 = nb * 128, tid = threadIdx.x;
    f32x4 v[4];
#pragma unroll
    for (int i = 0; i < 4; ++i) { const int idx = tid + 512 * i, kk = idx >> 5, n4 = idx & 31; v[i] = *(const f32x4*)(src + (size_t)(k0 + kk) * N + n0 + n4 * 4); }
#pragma unroll
    for (int i = 0; i < 4; ++i) { const int idx = tid + 512 * i, kk = idx >> 5, n4 = idx & 31;
#pragma unroll
        for (int c = 0; c < 4; ++c) scr[kk * 129 + n4 * 4 + c] = v[i][c]; }
    __syncthreads();
#pragma unroll
    for (int i = 0; i < 2; ++i) {
        const int o = tid + 512 * i, n = o >> 3, kc = (o & 7) * 8;
        u32x4 w;
        w.x = pk_bf16(scr[(kc + 0) * 129 + n], scr[(kc + 1) * 129 + n]); w.y = pk_bf16(scr[(kc + 2) * 129 + n], scr[(kc + 3) * 129 + n]);
        w.z = pk_bf16(scr[(kc + 4) * 129 + n], scr[(kc + 5) * 129 + n]); w.w = pk_bf16(scr[(kc + 6) * 129 + n], scr[(kc + 7) * 129 + n]);
        const int f = n0 + n;
        const int drow = mode == 0 ? f : ((f >> 4) * 32 + (mode == 2 ? 16 : 0) + (f & 15));
        *(u32x4*)(dst + (size_t)drow * ldd + koff + k0 + kc) = w;
    }
    __syncthreads();
}

__device__ __forceinline__ void phase0(const Params& p) {
    unsigned char* ws = p.ws;
    if (blockIdx.x == 0 && threadIdx.x < 64) ((unsigned*)(ws + WS_CTL))[threadIdx.x] = 0u;
    constexpr int J0 = 16 * 42, J1 = 8 * 8, J3 = 16 * 8, J4 = 16 * 22, J6 = 44 * 8, J7 = 4, J9 = 8;
    constexpr int NT = J0 + 2 * J1 + J3 + 2 * J4 + J6 + 2 * J7 + J9;
    constexpr int NR = MP / 32;
    for (int it = blockIdx.x; it < NT + NR; it += gridDim.x) {
        if (it >= NR) {
            int r = it - NR;
            if (r < J0) { transpose_tile(p.in[4], D, PIN, (bf16_t*)(ws + WS_WIN), D, 0, 0, r); continue; } r -= J0;
            if (r < J1) { transpose_tile(p.in[16], 512, D, (bf16_t*)(ws + WS_WSB), 512, 0, 0, r); continue; } r -= J1;
            if (r < J1) { transpose_tile(p.in[17], 512, D, (bf16_t*)(ws + WS_WRW), 512, 0, 0, r); continue; } r -= J1;
            if (r < J3) { transpose_tile(p.in[18], D, D, (bf16_t*)(ws + WS_WOUT), D, 0, 0, r); continue; } r -= J3;
            if (r < J4) { transpose_tile(p.in[21], D, DFF, (bf16_t*)(ws + WS_WGU), D, 0, 1, r); continue; } r -= J4;
            if (r < J4) { transpose_tile(p.in[22], D, DFF, (bf16_t*)(ws + WS_WGU), D, 0, 2, r); continue; } r -= J4;
            if (r < J6) { transpose_tile(p.in[23], DFF, D, (bf16_t*)(ws + WS_WD), DFF, 0, 0, r); continue; } r -= J6;
            if (r < J7) { transpose_tile(p.in[6], 64, 512, (bf16_t*)(ws + WS_WL), 256, 0, 0, r); continue; } r -= J7;
            if (r < J7) { transpose_tile(p.in[8], 64, 512, (bf16_t*)(ws + WS_WL), 256, 64, 0, r); continue; } r -= J7;
            transpose_tile(p.in[10], 128, 512, (bf16_t*)(ws + WS_WL), 256, 128, 0, r);
        } else {
            const int lane = threadIdx.x & 63, row0 = it * 32 + (threadIdx.x >> 6) * 4;
            f32x4 v[4][4];
#pragma unroll
            for (int r = 0; r < 4; ++r) {
                const int row = row0 + r, b = row / TP, t = row - b * TP;
                const float* src = t < NMETA ? p.in[1] + (size_t)t * D : p.in[0] + ((size_t)b * SEQ + (t < T ? t - NMETA : 0)) * D;
#pragma unroll
                for (int j = 0; j < 4; ++j) v[r][j] = *(const f32x4*)(src + 4 * lane + 256 * j);
            }
            f32x4 g[4];
#pragma unroll
            for (int j = 0; j < 4; ++j) g[j] = *(const f32x4*)(p.in[2] + 4 * lane + 256 * j);
#pragma unroll
            for (int r = 0; r < 4; ++r) {
                const int row = row0 + r, b = row / TP, t = row - b * TP;
                float ss = 0.f;
#pragma unroll
                for (int j = 0; j < 4; ++j) ss += (v[r][j][0] * v[r][j][0] + v[r][j][1] * v[r][j][1]) + (v[r][j][2] * v[r][j][2] + v[r][j][3] * v[r][j][3]);
                const float rs = t < T ? rsqrtf(wave_sum(ss) * (1.0f / D) + RMS_EPS) : 0.f;
                bf16_t* orow = (bf16_t*)(ws + O_A0) + (size_t)row * D;
#pragma unroll
                for (int j = 0; j < 4; ++j) {
                    u32x2 w; w.x = pk_bf16(v[r][j][0] * rs * g[j][0], v[r][j][1] * rs * g[j][1]); w.y = pk_bf16(v[r][j][2] * rs * g[j][2], v[r][j][3] * rs * g[j][3]);
                    *(u32x2*)(orow + 4 * lane + 256 * j) = w;
                }
            }
        }
    }
}

__device__ __forceinline__ void phase1(const Params& p) {
    unsigned char* ws = p.ws;
    EpiInProj epi{(bf16_t*)(ws + R_QKV), (_Float16*)(ws + R_URW), (bf16_t*)p.out};
    gemm_phase((const bf16_t*)(ws + O_A0), (const bf16_t*)(ws + WS_WIN), D, MP / BM, PIN / BM, epi);
}

constexpr int SI_R = 0, SI_W = 1, SI_K = 2, SI_V = 3, SI_KK = 4, SI_B = 5;
constexpr int ALD = 264;
constexpr int P2_WLS = 64 * ALD * 2;
constexpr int P2_MU = P2_WLS;
constexpr int P2_AL = P2_MU + 1024;
__device__ __forceinline__ void phase2_main(const Params& p) {
    unsigned char* ws = p.ws;
    const int tid = threadIdx.x, wave = tid >> 6, lane = tid & 63, fr = lane & 15, fq = lane >> 4;
    const int h = blockIdx.x & 7, nslot = (gridDim.x >> 3) * 8, slot = (blockIdx.x >> 3) * 8 + wave;
    const _Float16* urw = (const _Float16*)(ws + R_URW);
    const float* mu = p.in[5];
    bf16_t* WLs = (bf16_t*)smem;
    float* mus = (float*)(smem + P2_MU);
    bf16_t* Al = (bf16_t*)(smem + P2_AL) + wave * (16 * ALD);
    __syncthreads();
    {
        const bf16_t* WL = (const bf16_t*)(ws + WS_WL) + (size_t)h * 64 * 256;
#pragma unroll
        for (int i = 0; i < 4; ++i) { const int idx = tid + 512 * i, row = idx >> 5, c16 = idx & 31; *(u32x4*)(WLs + row * ALD + c16 * 8) = *(const u32x4*)(WL + row * 256 + c16 * 8); }
        if (tid < 256) mus[tid] = mu[1536 + tid];
    }
    __syncthreads();
    if (blockIdx.x >= nslot) return;
    _Float16* SI = (_Float16*)(ws + R_SI);
    bf16_t* G = (bf16_t*)(ws + R_G);
    constexpr size_t SIE = (size_t)MP * 512;
#pragma unroll 1
    for (int g = slot; g < NB * 514; g += nslot) {
        const int ub = g / 514, ui = g - ub * 514, row0 = ub * TP + ui * 16;
        {
            const int half = lane >> 5, pc = (lane & 31) * 8;
            const float sA = pc < 64 ? 2.f : 1.f, sC = pc < 64 ? -1.f : 0.f;
            const bool lin = pc >= 64 && pc < 128;
            const f32x4 mA = *(const f32x4*)(mu + 1536 + pc), mB = *(const f32x4*)(mu + 1536 + pc + 4);
            h16x8 c[8], pv[8];
#pragma unroll
            for (int q = 0; q < 8; ++q) {
                const int rowa = row0 + 2 * q + half, ta = rowa % TP;
                const _Float16* cur = urw + (size_t)rowa * RWS + 1536 + pc;
                c[q] = *(const h16x8*)cur;
                pv[q] = *(const h16x8*)(ta > 0 ? cur - RWS : cur);
            }
#pragma unroll
            for (int q = 0; q < 8; ++q) {
                const int ta = (row0 + 2 * q + half) % TP;
                float o[8];
#pragma unroll
                for (int e = 0; e < 8; ++e) {
                    const float cf = (float)c[q][e], pf = ta > 0 ? (float)pv[q][e] : 0.f;
                    const float xs = cf + (e < 4 ? mA[e & 3] : mB[e & 3]) * (pf - cf);
                    const float sg = __builtin_amdgcn_rcpf(1.0f + __expf(-sA * xs));
                    o[e] = lin ? xs : sA * sg + sC;
                }
                u32x4 w; w.x = pk_bf16(o[0], o[1]); w.y = pk_bf16(o[2], o[3]); w.z = pk_bf16(o[4], o[5]); w.w = pk_bf16(o[6], o[7]);
                *(u32x4*)(Al + (2 * q + half) * ALD + pc) = w;
            }
        }
        asm volatile("s_waitcnt lgkmcnt(0)" ::: "memory");
        __builtin_amdgcn_wave_barrier();
        f32x4 acc[4];
        auto lora = [&](auto kbeg_c, auto ksteps_c) {
            constexpr int kbeg = decltype(kbeg_c)::value, ksteps = decltype(ksteps_c)::value;
#pragma unroll
            for (int n = 0; n < 4; ++n) acc[n] = (f32x4){0.f, 0.f, 0.f, 0.f};
#pragma unroll
            for (int ks = 0; ks < ksteps; ++ks) {
                const bf16x8 af = *(const bf16x8*)(Al + fr * ALD + kbeg + ks * 32 + fq * 8);
#pragma unroll
                for (int n = 0; n < 4; ++n) {
                    const bf16x8 wf = *(const bf16x8*)(WLs + (n * 16 + fr) * ALD + kbeg + ks * 32 + fq * 8);
                    acc[n] = __builtin_amdgcn_mfma_f32_16x16x32_bf16(wf, af, acc[n], 0, 0, 0);
                }
            }
        };
        const int row = row0 + fr, b = row / TP, t = row - b * TP;
        const size_t base = ((size_t)(b * NH + h) * TP + t) * 64;
        const _Float16* ur = urw + (size_t)row * RWS;
        const size_t pb = base + fq * 16;
        lora(std::integral_constant<int, 0>{}, std::integral_constant<int, 2>{});
        {
            h16x8 wo[2];
#pragma unroll
            for (int n = 0; n < 4; ++n) {
                const f32x4 db = *(const f32x4*)(p.in[7] + h * 64 + n * 16 + fq * 4);
#pragma unroll
                for (int j = 0; j < 4; ++j) {
                    const float wl = -softplusf_(-(db[j] + acc[n][j])) - 0.5f;
                    const float e = __expf(wl);
                    wo[n >> 1][(n & 1) * 4 + j] = (_Float16)(1.0f - __expf(-e));
                }
            }
            *(h16x8*)(SI + SI_W * SIE + pb) = wo[0]; *(h16x8*)(SI + SI_W * SIE + pb + 8) = wo[1];
        }
        lora(std::integral_constant<int, 64>{}, std::integral_constant<int, 2>{});
        {
            const _Float16* up = ur + h * 64 + fq * 16;
            const _Float16* upp = t > 0 ? up - RWS : up;
            h16x8 kc[2], rc[2], vc[2], kp[2], rp[2], vp[2];
#pragma unroll
            for (int i = 0; i < 2; ++i) {
                rc[i] = *(const h16x8*)(up + i * 8); kc[i] = *(const h16x8*)(up + 512 + i * 8); vc[i] = *(const h16x8*)(up + 1024 + i * 8);
                rp[i] = *(const h16x8*)(upp + i * 8); kp[i] = *(const h16x8*)(upp + 512 + i * 8); vp[i] = *(const h16x8*)(upp + 1024 + i * 8);
            }
            float kv[4][4], av[4][4], kkr[4][4]; float ss = 0.f;
            h16x8 ro[2];
#pragma unroll
            for (int n = 0; n < 4; ++n) {
                const int c = n * 16 + fq * 4, c512 = h * 64 + c;
                const f32x4 muk = *(const f32x4*)(mu + 512 + c512), mur = *(const f32x4*)(mu + c512), muv = *(const f32x4*)(mu + 1024 + c512);
                const f32x4 ab = *(const f32x4*)(p.in[9] + c512), kkw = *(const f32x4*)(p.in[11] + c512);
                h16x4 vo;
#pragma unroll
                for (int j = 0; j < 4; ++j) {
                    const int i = n >> 1, e = (n & 1) * 4 + j;
                    const float kcf = (float)kc[i][e], kpf = t > 0 ? (float)kp[i][e] : 0.f;
                    const float rcf = (float)rc[i][e], rpf = t > 0 ? (float)rp[i][e] : 0.f;
                    const float vcf = (float)vc[i][e], vpf = t > 0 ? (float)vp[i][e] : 0.f;
                    kv[n][j] = kcf + muk[j] * (kpf - kcf);
                    ro[i][e] = (_Float16)(rcf + mur[j] * (rpf - rcf));
                    vo[j] = (_Float16)(vcf + muv[j] * (vpf - vcf));
                    av[n][j] = sigmoidf_(ab[j] + acc[n][j]);
                    kkr[n][j] = kv[n][j] * kkw[j];
                    ss += kkr[n][j] * kkr[n][j];
                }
                *(h16x4*)(SI + SI_V * SIE + base + c) = vo;
            }
            *(h16x8*)(SI + SI_R * SIE + pb) = ro[0]; *(h16x8*)(SI + SI_R * SIE + pb + 8) = ro[1];
            ss += __shfl_xor(ss, 16); ss += __shfl_xor(ss, 32);
            const float inv = fminf(__builtin_amdgcn_rsqf(ss), 1e12f);
            h16x8 ko[2], kko[2], bo[2];
#pragma unroll
            for (int n = 0; n < 4; ++n) {
                const f32x4 ka = *(const f32x4*)(p.in[12] + h * 64 + n * 16 + fq * 4);
#pragma unroll
                for (int j = 0; j < 4; ++j) {
                    const int i = n >> 1, e = (n & 1) * 4 + j;
                    const float kk = kkr[n][j] * inv;
                    ko[i][e] = (_Float16)(kv[n][j] * (1.0f + (av[n][j] - 1.0f) * ka[j]));
                    kko[i][e] = (_Float16)kk;
                    bo[i][e] = (_Float16)(kk * av[n][j]);
                }
            }
#pragma unroll
            for (int i = 0; i < 2; ++i) {
                *(h16x8*)(SI + SI_K * SIE + pb + i * 8) = ko[i]; *(h16x8*)(SI + SI_KK * SIE + pb + i * 8) = kko[i]; *(h16x8*)(SI + SI_B * SIE + pb + i * 8) = bo[i];
            }
        }
        lora(std::integral_constant<int, 128>{}, std::integral_constant<int, 4>{});
        {
            u32x4 g0, g1;
            g0.x = pk_bf16(acc[0][0], acc[0][1]); g0.y = pk_bf16(acc[0][2], acc[0][3]); g0.z = pk_bf16(acc[1][0], acc[1][1]); g0.w = pk_bf16(acc[1][2], acc[1][3]);
            g1.x = pk_bf16(acc[2][0], acc[2][1]); g1.y = pk_bf16(acc[2][2], acc[2][3]); g1.z = pk_bf16(acc[3][0], acc[3][1]); g1.w = pk_bf16(acc[3][2], acc[3][3]);
            *(u32x4*)(G + pb) = g0; *(u32x4*)(G + pb + 8) = g1;
        }
        asm volatile("s_waitcnt lgkmcnt(0)" ::: "memory");
        __builtin_amdgcn_wave_barrier();
    }
}
__device__ __forceinline__ void phase2_kmax(const Params& p, int item) {
    unsigned char* ws = p.ws;
    const int bh = item >> 2, qr = item & 3, tid = threadIdx.x;
    float* red = (float*)(smem + P2_AL + 8 * 16 * ALD * 2);
    float ss = 0.f;
    for (int t = qr * 2052 + tid; t < (qr + 1) * 2052; t += 512) {
        const bf16_t* kr = (const bf16_t*)(ws + R_QKV) + QKV_ONE / 2 + ((size_t)bh * TP + t) * 64;
        float s1 = 0.f;
#pragma unroll
        for (int q = 0; q < 8; ++q) {
            const u32x4 v = *(const u32x4*)(kr + q * 8);
#pragma unroll
            for (int e = 0; e < 4; ++e) { const float lo = __uint_as_float(v[e] << 16), hi = __uint_as_float(v[e] & 0xffff0000u); s1 += lo * lo + hi * hi; }
        }
        ss = fmaxf(ss, s1);
    }
#pragma unroll
    for (int o = 1; o < 64; o <<= 1) ss = fmaxf(ss, __shfl_xor(ss, o));
    __syncthreads();
    if ((tid & 63) == 0) red[tid >> 6] = ss;
    __syncthreads();
    if (tid == 0) {
        float m = red[0];
#pragma unroll
        for (int w = 1; w < 8; ++w) m = fmaxf(m, red[w]);
        ((float*)(ws + WS_CTL))[16 + item] = m;
    }
}
__device__ __forceinline__ void phase2(const Params& p) {
    phase2_main(p);
    for (int it = (int)gridDim.x - 1 - (int)blockIdx.x; it < 128; it += gridDim.x) phase2_kmax(p, it);
}

constexpr int SC_TC = 32, SC_NC = (T + SC_TC - 1) / SC_TC;
constexpr int SC_ARR = SC_TC * 64;
constexpr int SC_VOFF = 5 * SC_ARR, SC_COFF = SC_VOFF + SC_TC * 16;
constexpr int SC_BUF = (SC_COFF + SC_TC) * 4;
constexpr int SC_YOFF = 2 * SC_BUF, SC_YBUF = SC_TC * 16 * 4;
__device__ __forceinline__ float dot4(const f32x4& a, const f32x4& b) {
    f32x2 t = __builtin_shufflevector(a, a, 0, 1) * __builtin_shufflevector(b, b, 0, 1);
    t = __builtin_shufflevector(a, a, 2, 3) * __builtin_shufflevector(b, b, 2, 3) + t;
    return t[0] + t[1];
}
__device__ __forceinline__ void reduce16x2(float& a, float& b) {
    a += dppf<0xB1>(a); b += dppf<0xB1>(b); a += dppf<0x4E>(a); b += dppf<0x4E>(b);
    a += dppf<0x141>(a); b += dppf<0x141>(b); a += dppf<0x140>(a); b += dppf<0x140>(b);
}
__device__ __forceinline__ void scan_unit(const Params& p, int unit) {
    unsigned char* ws = p.ws;
    const int bh = unit >> 2, vr0 = (unit & 3) * 16, tid = threadIdx.x, wave = tid >> 6, lane = tid & 63;
    const _Float16* SI = (const _Float16*)(ws + R_SI);
    constexpr size_t SIE = (size_t)MP * 512;
    float* Y = (float*)(ws + O_Y);
    const size_t hb = (size_t)bh * TP * 64;
    __syncthreads();
    if (wave >= 4) {
        const int i = tid - 256, ip = i >= 8 ? i - 8 : i;
        const int arrs[5] = {SI_R, SI_W, SI_K, SI_KK, SI_B};
        u32x4 rg[5], rp[3]; unsigned rv;
        auto issue = [&](int c) {
            const size_t off = hb + (size_t)c * SC_TC * 64;
#pragma unroll
            for (int a = 0; a < 5; ++a) rg[a] = *(const u32x4*)(SI + arrs[a] * SIE + off + i * 8);
            rp[0] = *(const u32x4*)(SI + SI_W * SIE + off + ip * 8);
            rp[1] = *(const u32x4*)(SI + SI_K * SIE + off + ip * 8);
            rp[2] = *(const u32x4*)(SI + SI_B * SIE + off + ip * 8);
            rv = *(const unsigned*)(SI + SI_V * SIE + off + (i >> 3) * 64 + vr0 + (i & 7) * 2);
        };
        auto commit = [&](int bufi) {
            float* buf = (float*)(smem + bufi * SC_BUF);
            float f[5][8];
#pragma unroll
            for (int a = 0; a < 5; ++a) {
                const h16x8 hv = __builtin_bit_cast(h16x8, rg[a]);
#pragma unroll
                for (int e = 0; e < 8; ++e) f[a][e] = (float)hv[e];
            }
            const bool odd = (i >> 3) & 1;
            float ckk = 0.f, cbk = 0.f;
            {
                const h16x8 pw = __builtin_bit_cast(h16x8, rp[0]), pk = __builtin_bit_cast(h16x8, rp[1]), pb = __builtin_bit_cast(h16x8, rp[2]);
#pragma unroll
                for (int e = 0; e < 8; ++e) {
                    const float kk2 = f[3][e];
                    ckk += (float)pk[e] * kk2; cbk += (float)pb[e] * kk2;
                    if (odd) f[3][e] = (1.0f - (float)pw[e]) * kk2;
                }
            }
            ckk += dppf<0xB1>(ckk); cbk += dppf<0xB1>(cbk); ckk += dppf<0x4E>(ckk); cbk += dppf<0x4E>(cbk); ckk += dppf<0x141>(ckk); cbk += dppf<0x141>(cbk);
#pragma unroll
            for (int a = 0; a < 5; ++a) {
                f32x4 lo, hi;
#pragma unroll
                for (int e = 0; e < 4; ++e) { lo[e] = f[a][e]; hi[e] = f[a][4 + e]; }
                if (a == 1) { lo = 1.0f - lo; hi = 1.0f - hi; }
                if (a == 4) { lo = -lo; hi = -hi; }
                *(f32x4*)(buf + a * SC_ARR + i * 8) = lo; *(f32x4*)(buf + a * SC_ARR + i * 8 + 4) = hi;
            }
            const h16x2 v2 = __builtin_bit_cast(h16x2, rv);
            f32x2 vf; vf[0] = (float)v2[0]; vf[1] = (float)v2[1];
            *(f32x2*)(buf + SC_VOFF + (i >> 3) * 16 + (i & 7) * 2) = vf;
            if (odd && (i & 7) == 0) { f32x2 cf; cf[0] = ckk; cf[1] = cbk; *(f32x2*)(buf + SC_COFF + (i >> 4) * 2) = cf; }
        };
        auto yout = [&](int c) {
            const float* yb = (const float*)(smem + SC_YOFF + (c & 1) * SC_YBUF);
            const f32x2 v = *(const f32x2*)(yb + (i >> 3) * 16 + (i & 7) * 2);
            *(f32x2*)(Y + hb + (size_t)(c * SC_TC + (i >> 3)) * 64 + vr0 + (i & 7) * 2) = v;
        };
        issue(0); commit(0); issue(1);
        __syncthreads();
        for (int c = 0; c < SC_NC; ++c) {
            if (c > 0) yout(c - 1);
            if (c + 1 < SC_NC) commit((c + 1) & 1);
            if (c + 2 < SC_NC) issue(c + 2);
            __syncthreads();
        }
        yout(SC_NC - 1);
    } else {
        const int rl = wave * 4 + (lane >> 4), sub = lane & 15;
        const bool odd_lane = lane & 1; const int yoff = (lane & 1) * 16 + rl;
        f32x4 S = {0.f, 0.f, 0.f, 0.f};
        __syncthreads();
        for (int c = 0; c < SC_NC; ++c) {
            const float* buf = (const float*)(smem + (c & 1) * SC_BUF);
            float* yb = (float*)(smem + SC_YOFF + (c & 1) * SC_YBUF);
            const float* bp = buf + sub * 4;
#define SC_LD(arr, s) (*(const f32x4*)(bp + (arr) * SC_ARR + (s) * 64))
            f32x4 r1 = SC_LD(0, 0), w1 = SC_LD(1, 0), k1 = SC_LD(2, 0), q1 = SC_LD(3, 0), n1 = SC_LD(4, 0);
            f32x4 r2 = SC_LD(0, 1), w2 = SC_LD(1, 1), k2 = SC_LD(2, 1), g2 = SC_LD(3, 1), n2 = SC_LD(4, 1);
            float v1 = buf[SC_VOFF + rl], v2 = buf[SC_VOFF + 16 + rl];
            f32x2 cf = *(const f32x2*)(buf + SC_COFF);
#pragma unroll
            for (int pr = 0; pr < SC_TC / 2; ++pr) {
                const int sn = 2 * pr + 2;
                const f32x4 r1n = SC_LD(0, sn), w1n = SC_LD(1, sn), k1n = SC_LD(2, sn), q1n = SC_LD(3, sn), n1n = SC_LD(4, sn);
                const f32x4 r2n = SC_LD(0, sn + 1), w2n = SC_LD(1, sn + 1), k2n = SC_LD(2, sn + 1), g2n = SC_LD(3, sn + 1), n2n = SC_LD(4, sn + 1);
                const float v1n = buf[SC_VOFF + sn * 16 + rl], v2n = buf[SC_VOFF + (sn + 1) * 16 + rl];
                const f32x2 cfn = *(const f32x2*)(buf + SC_COFF + (pr + 1) * 2);
                __builtin_amdgcn_sched_barrier(0x7);
                float d1 = dot4(S, q1), e2 = dot4(S, g2);
                const f32x4 t1 = S * w1 + v1 * k1;
                reduce16x2(d1, e2);
                const float d2 = e2 + v1 * cf[0] - d1 * cf[1];
                const f32x4 S1 = t1 + d1 * n1;
                const f32x4 S2 = (S1 * w2 + v2 * k2) + d2 * n2;
                float y1 = dot4(S1, r1), y2 = dot4(S2, r2);
                y1 += dppf<0xB1>(y1); y2 += dppf<0xB1>(y2);
                float yz = odd_lane ? y2 : y1;
                yz += dppf<0x122>(yz); yz += dppf<0x124>(yz); yz += dppf<0x128>(yz);
                yb[(2 * pr) * 16 + yoff] = yz;
                S = S2;
                r1 = r1n; w1 = w1n; k1 = k1n; q1 = q1n; n1 = n1n; r2 = r2n; w2 = w2n; k2 = k2n; g2 = g2n; n2 = n2n; v1 = v1n; v2 = v2n; cf = cfn;
            }
#undef SC_LD
            __syncthreads();
        }
    }
}

constexpr int KLD = 72;
__device__ __forceinline__ void attn_unit(const Params& p, int unit) {
    unsigned char* ws = p.ws;
    const int qt = unit % 65, bh = unit / 65, b = bh >> 3, h = bh & 7;
    const int tid = threadIdx.x, wave = tid >> 6, lane = tid & 63, fr = lane & 15, fq = lane >> 4;
    const bf16_t* Q = (const bf16_t*)(ws + R_QKV) + (size_t)bh * TP * 64;
    const bf16_t* Kg = Q + QKV_ONE / 2;
    const bf16_t* Vg = Q + QKV_ONE;
    bf16_t* Ks = (bf16_t*)smem;
    bf16_t* Vt = Ks + 64 * KLD;
    volatile int* flags = (volatile int*)(smem + 2 * 64 * KLD * 2);
    const int t0 = qt * 128, tq = t0 + wave * 16 + fr;
    bf16x8 qf[2];
    qf[0] = *(const bf16x8*)(Q + (size_t)tq * 64 + fq * 8);
    qf[1] = *(const bf16x8*)(Q + (size_t)tq * 64 + 32 + fq * 8);
    float qs = 0.f;
#pragma unroll
    for (int s = 0; s < 2; ++s)
#pragma unroll
        for (int e = 0; e < 8; ++e) { const float f = bf2f((unsigned short)qf[s][e]); qs += f * f; }
    qs += __shfl_xor(qs, 16); qs += __shfl_xor(qs, 32);
    const f32x4 km4 = *(const f32x4*)((const float*)(ws + WS_CTL) + 16 + bh * 4);
    const float kmax = sqrtf(fmaxf(fmaxf(km4[0], km4[1]), fmaxf(km4[2], km4[3])));
    const float zb = sqrtf(qs) * kmax * 1.0001f + 88.0f;
    float Arow = 0.f;
    f32x4 O[4];
#pragma unroll
    for (int nd = 0; nd < 4; ++nd) O[nd] = (f32x4){0.f, 0.f, 0.f, 0.f};
    for (int kb = qt * 2 + 1; kb >= 0; --kb) {
        const bool done = __all(Arow > zb);
        if (lane == 0) flags[wave] = done ? 1 : 0;
        __syncthreads();
        int alld = 1;
#pragma unroll
        for (int w = 0; w < 8; ++w) alld &= flags[w];
        if (alld) break;
        {
            const int key = tid >> 3, dc = (tid & 7) * 8;
            const u32x4 kvv = *(const u32x4*)(Kg + (size_t)(kb * 64 + key) * 64 + dc);
            const u32x4 vvv = *(const u32x4*)(Vg + (size_t)(kb * 64 + key) * 64 + dc);
            *(u32x4*)(Ks + key * KLD + dc) = kvv;
#pragma unroll
            for (int e = 0; e < 4; ++e) { Vt[(dc + 2 * e) * KLD + key] = (bf16_t)(vvv[e] & 0xffffu); Vt[(dc + 2 * e + 1) * KLD + key] = (bf16_t)(vvv[e] >> 16); }
        }
        __syncthreads();
        f32x4 z[4];
#pragma unroll
        for (int n = 0; n < 4; ++n) {
            z[n] = (f32x4){0.f, 0.f, 0.f, 0.f};
#pragma unroll
            for (int s = 0; s < 2; ++s) {
                const bf16x8 kf = *(const bf16x8*)(Ks + (n * 16 + fr) * KLD + s * 32 + fq * 8);
                z[n] = __builtin_amdgcn_mfma_f32_16x16x32_bf16(kf, qf[s], z[n], 0, 0, 0);
            }
        }
        float sp[4][4], lt[4], ex[4], sg[4];
#pragma unroll
        for (int n = 0; n < 4; ++n) {
#pragma unroll
            for (int j = 0; j < 4; ++j) { const int s = kb * 64 + n * 16 + fq * 4 + j; sp[n][j] = s < tq ? softplusf_(z[n][j]) : 0.f; }
            sp[n][2] += sp[n][3]; sp[n][1] += sp[n][2]; sp[n][0] += sp[n][1];
            lt[n] = sp[n][0];
            const float a = __shfl_xor(lt[n], 16), pr = lt[n] + a, c = __shfl_xor(pr, 32);
            ex[n] = fq == 3 ? 0.f : (fq == 2 ? a : (fq == 1 ? c : a + c));
            sg[n] = pr + c;
        }
        float nsuf[4]; nsuf[3] = 0.f; nsuf[2] = sg[3]; nsuf[1] = nsuf[2] + sg[2]; nsuf[0] = nsuf[1] + sg[1];
        float wgt[4][4];
#pragma unroll
        for (int n = 0; n < 4; ++n)
#pragma unroll
            for (int j = 0; j < 4; ++j) {
                const int s = kb * 64 + n * 16 + fq * 4 + j;
                const float C = Arow + nsuf[n] + ex[n] + sp[n][j];
                wgt[n][j] = s < tq ? __expf(z[n][j] - C) : 0.f;
            }
        Arow += nsuf[0] + sg[0];
#pragma unroll
        for (int ks = 0; ks < 2; ++ks) {
            u32x4 pw; pw.x = pk_bf16(wgt[2 * ks][0], wgt[2 * ks][1]); pw.y = pk_bf16(wgt[2 * ks][2], wgt[2 * ks][3]);
            pw.z = pk_bf16(wgt[2 * ks + 1][0], wgt[2 * ks + 1][1]); pw.w = pk_bf16(wgt[2 * ks + 1][2], wgt[2 * ks + 1][3]);
            const bf16x8 pf = __builtin_bit_cast(bf16x8, pw);
#pragma unroll
            for (int nd = 0; nd < 4; ++nd) {
                u32x4 vw;
                const u32x2 v0 = *(const u32x2*)(Vt + (nd * 16 + fr) * KLD + (2 * ks) * 16 + fq * 4);
                const u32x2 v1 = *(const u32x2*)(Vt + (nd * 16 + fr) * KLD + (2 * ks + 1) * 16 + fq * 4);
                vw.x = v0.x; vw.y = v0.y; vw.z = v1.x; vw.w = v1.y;
                O[nd] = __builtin_amdgcn_mfma_f32_16x16x32_bf16(pf, __builtin_bit_cast(bf16x8, vw), O[nd], 0, 0, 0);
            }
        }
    }
    __syncthreads();
    bf16_t* osb = (bf16_t*)(ws + O_OSB);
#pragma unroll
    for (int j = 0; j < 4; ++j) {
        const int t = t0 + wave * 16 + fq * 4 + j;
        if (t >= NMETA && t < T) {
#pragma unroll
            for (int nd = 0; nd < 4; ++nd) osb[(size_t)(b * SEQ + t - NMETA) * 512 + h * 64 + nd * 16 + fr] = (bf16_t)(pk_bf16(O[nd][j], 0.f) & 0xffffu);
        }
    }
}

constexpr int N_SCAN = 128, N_ATTN = 32 * 65;
__device__ __forceinline__ void phase3(const Params& p, int cw = 0, int first = 0, int last = N_SCAN + N_ATTN) {
    unsigned* ctr = (unsigned*)(p.ws + WS_CTL) + cw;
    volatile int* slot = (volatile int*)(smem + 131072 - 16);
    for (;;) {
        __syncthreads();
        if (threadIdx.x == 0) *slot = (int)atomicAdd(ctr, 1u);
        __syncthreads();
        const int u = *slot + first;
        if (u >= last) break;
        if (u < N_SCAN) scan_unit(p, u); else attn_unit(p, u - N_SCAN);
    }
}

__device__ __forceinline__ void phase3c(const Params& p) {
    unsigned char* ws = p.ws;
    const _Float16* SI = (const _Float16*)(ws + R_SI);
    constexpr size_t SIE = (size_t)MP * 512;
    const float* Y = (const float*)(ws + O_Y);
    const bf16_t* G = (const bf16_t*)(ws + R_G);
    bf16_t* orw = (bf16_t*)(ws + O_ORW);
    const int tid = threadIdx.x, sub = tid & 15;
    constexpr int U = 4;
    for (int it = blockIdx.x; it < 32 * 64; it += gridDim.x) {
        const int bh = it >> 6, c4 = it & 63, b = bh >> 3, h = bh & 7;
        const int c = h * 64 + sub * 4;
        const f32x4 gain = *(const f32x4*)(p.in[14] + c), bias = *(const f32x4*)(p.in[15] + c), rk = *(const f32x4*)(p.in[13] + c);
        f32x4 y[U]; h16x4 r4[U], k4[U], v4[U]; u32x2 g2[U];
#pragma unroll
        for (int u = 0; u < U; ++u) {
            const int t = NMETA + (c4 * U + u) * 32 + (tid >> 4);
            const size_t base = ((size_t)bh * TP + t) * 64 + sub * 4;
            const size_t pbase = ((size_t)bh * TP + t) * 64 + (sub & 3) * 16 + (sub >> 2) * 4;
            y[u] = *(const f32x4*)(Y + base);
            r4[u] = *(const h16x4*)(SI + SI_R * SIE + pbase); k4[u] = *(const h16x4*)(SI + SI_K * SIE + pbase); v4[u] = *(const h16x4*)(SI + SI_V * SIE + base);
            g2[u] = *(const u32x2*)(G + pbase);
        }
#pragma unroll
        for (int u = 0; u < U; ++u) {
            const int t = NMETA + (c4 * U + u) * 32 + (tid >> 4);
            const float mean = reduce16((y[u][0] + y[u][1]) + (y[u][2] + y[u][3])) * (1.0f / 64.0f);
            const f32x4 dy = y[u] - mean;
            const float var = reduce16((dy[0] * dy[0] + dy[1] * dy[1]) + (dy[2] * dy[2] + dy[3] * dy[3])) * (1.0f / 64.0f);
            const float rs = rsqrtf(var + GN_EPS);
            float bs = 0.f;
#pragma unroll
            for (int j = 0; j < 4; ++j) bs += (float)r4[u][j] * (float)k4[u][j] * rk[j];
            bs = reduce16(bs);
            const float gg[4] = {__uint_as_float(g2[u].x << 16), __uint_as_float(g2[u].x & 0xffff0000u), __uint_as_float(g2[u].y << 16), __uint_as_float(g2[u].y & 0xffff0000u)};
            float o[4];
#pragma unroll
            for (int j = 0; j < 4; ++j) o[j] = (dy[j] * rs * gain[j] + bias[j] + bs * (float)v4[u][j]) * gg[j];
            u32x2 w; w.x = pk_bf16(o[0], o[1]); w.y = pk_bf16(o[2], o[3]);
            *(u32x2*)(orw + (size_t)(b * SEQ + t - NMETA) * 512 + c) = w;
        }
    }
}

__device__ __forceinline__ void phase4(const Params& p) {
    unsigned char* ws = p.ws;
    EpiBranch1 e1{(float*)(ws + O_T1), (const bf16_t*)p.out};
    EpiBranch2 e2{(const float*)(ws + O_T1), (const bf16_t*)p.out, (bf16_t*)(ws + O_M)};
    gemm_phase((const bf16_t*)(ws + O_OSB), (const bf16_t*)(ws + WS_WSB), 512, MS / BM, D / BM, e1);
    gemm_phase((const bf16_t*)(ws + O_ORW), (const bf16_t*)(ws + WS_WRW), 512, MS / BM, D / BM, e2);
}
__device__ __forceinline__ void phase5(const Params& p) {
    unsigned char* ws = p.ws;
    EpiF32 e{(float*)(ws + O_P)};
    gemm_phase((const bf16_t*)(ws + O_M), (const bf16_t*)(ws + WS_WOUT), D, MS / BM, D / BM, e);
}
__device__ __forceinline__ void phase6(const Params& p) {
    unsigned char* ws = p.ws;
    const int lane = threadIdx.x & 63;
    f32x4 g1[4], g2[4];
#pragma unroll
    for (int j = 0; j < 4; ++j) { g1[j] = *(const f32x4*)(p.in[3] + 4 * lane + 256 * j); g2[j] = *(const f32x4*)(p.in[19] + 4 * lane + 256 * j); }
    for (int it = blockIdx.x; it < MS / 16; it += gridDim.x) {
        const int row0 = it * 16 + (threadIdx.x >> 6) * 2;
        f32x4 v[2][4], x[2][4];
#pragma unroll
        for (int r = 0; r < 2; ++r)
#pragma unroll
            for (int j = 0; j < 4; ++j) {
                v[r][j] = *(const f32x4*)((const float*)(ws + O_P) + (size_t)(row0 + r) * D + 4 * lane + 256 * j);
                x[r][j] = *(const f32x4*)(p.in[0] + (size_t)(row0 + r) * D + 4 * lane + 256 * j);
            }
#pragma unroll
        for (int r = 0; r < 2; ++r) {
            const int row = row0 + r;
            float ss = 0.f;
#pragma unroll
            for (int j = 0; j < 4; ++j) ss += (v[r][j][0] * v[r][j][0] + v[r][j][1] * v[r][j][1]) + (v[r][j][2] * v[r][j][2] + v[r][j][3] * v[r][j][3]);
            const float rs = rsqrtf(wave_sum(ss) * (1.0f / D) + RMS_EPS);
            float s2 = 0.f;
#pragma unroll
            for (int j = 0; j < 4; ++j) {
                v[r][j] = x[r][j] + v[r][j] * rs * g1[j];
                *(f32x4*)(p.out + (size_t)row * D + 4 * lane + 256 * j) = v[r][j];
                s2 += (v[r][j][0] * v[r][j][0] + v[r][j][1] * v[r][j][1]) + (v[r][j][2] * v[r][j][2] + v[r][j][3] * v[r][j][3]);
            }
            const float rs2 = rsqrtf(wave_sum(s2) * (1.0f / D) + RMS_EPS);
            bf16_t* fr_ = (bf16_t*)(ws + O_F) + (size_t)row * D;
#pragma unroll
            for (int j = 0; j < 4; ++j) {
                u32x2 w; w.x = pk_bf16(v[r][j][0] * rs2 * g2[j][0], v[r][j][1] * rs2 * g2[j][1]); w.y = pk_bf16(v[r][j][2] * rs2 * g2[j][2], v[r][j][3] * rs2 * g2[j][3]);
                *(u32x2*)(fr_ + 4 * lane + 256 * j) = w;
            }
        }
    }
}
__device__ __forceinline__ void phase7(const Params& p) {
    unsigned char* ws = p.ws;
    EpiGU e{(bf16_t*)(ws + O_ACT)};
    gemm_phase((const bf16_t*)(ws + O_F), (const bf16_t*)(ws + WS_WGU), D, MS / BM, 2 * DFF / BM, e);
}
__device__ __forceinline__ void phase8(const Params& p) {
    unsigned char* ws = p.ws;
    EpiF32 e{(float*)(ws + O_DN)};
    gemm_phase((const bf16_t*)(ws + O_ACT), (const bf16_t*)(ws + WS_WD), DFF, MS / BM, D / BM, e);
}
__device__ __forceinline__ void phase9(const Params& p) {
    unsigned char* ws = p.ws;
    const int lane = threadIdx.x & 63;
    f32x4 g[4];
#pragma unroll
    for (int j = 0; j < 4; ++j) g[j] = *(const f32x4*)(p.in[20] + 4 * lane + 256 * j);
    for (int it = blockIdx.x; it < MS / 16; it += gridDim.x) {
        const int row0 = it * 16 + (threadIdx.x >> 6) * 2;
        f32x4 v[2][4], h1[2][4];
#pragma unroll
        for (int r = 0; r < 2; ++r)
#pragma unroll
            for (int j = 0; j < 4; ++j) {
                v[r][j] = *(const f32x4*)((const float*)(ws + O_DN) + (size_t)(row0 + r) * D + 4 * lane + 256 * j);
                h1[r][j] = *(const f32x4*)(p.out + (size_t)(row0 + r) * D + 4 * lane + 256 * j);
            }
#pragma unroll
        for (int r = 0; r < 2; ++r) {
            float ss = 0.f;
#pragma unroll
            for (int j = 0; j < 4; ++j) ss += (v[r][j][0] * v[r][j][0] + v[r][j][1] * v[r][j][1]) + (v[r][j][2] * v[r][j][2] + v[r][j][3] * v[r][j][3]);
            const float rs = rsqrtf(wave_sum(ss) * (1.0f / D) + RMS_EPS);
#pragma unroll
            for (int j = 0; j < 4; ++j) *(f32x4*)(p.out + (size_t)(row0 + r) * D + 4 * lane + 256 * j) = h1[r][j] + v[r][j] * rs * g[j];
        }
    }
}

constexpr int N_PHASES = 11;
__device__ __forceinline__ void run_phase(const Params& p, int ph) {
    switch (ph) {
        case 0: phase0(p); break;
        case 1: phase1(p); break;
        case 2: phase2(p); break;
        case 3: phase3(p); break;
        case 4: phase3c(p); break;
        case 5: phase4(p); break;
        case 6: phase5(p); break;
        case 7: phase6(p); break;
        case 8: phase7(p); break;
        case 9: phase8(p); break;
        default: phase9(p); break;
    }
}

#if MULTI_LAUNCH
template <int PH> __global__ void __launch_bounds__(512) fwd_phase(Params p) { run_phase(p, PH); }
#else
__global__ void __launch_bounds__(512) fwd_mega(Params p) {
    cg::grid_group grid = cg::this_grid();
    volatile LAS unsigned* st = (volatile LAS unsigned*)(smem + 131072);
    if (threadIdx.x == 0) { st[0] = 0u; st[1] = 0u; }
    __syncthreads();
    const XcdBarrier xb = xcd_barrier_post((unsigned*)(p.ws + WS_BAR), st);
    if (p.out == nullptr) grid.sync();
    phase0(p); xcd_barrier(xb); phase1(p); xcd_barrier(xb); phase2(p); xcd_barrier(xb); phase3(p); xcd_barrier(xb); phase3c(p); xcd_barrier(xb);
    phase4(p); xcd_barrier(xb); phase5(p); xcd_barrier(xb); phase6(p); xcd_barrier(xb); phase7(p); xcd_barrier(xb); phase8(p); xcd_barrier(xb); phase9(p);
}
#endif

extern "C" void kernel_launch(void* const* d_in, const int* in_sizes, int n_in, void* d_out, int out_size, void* d_ws, size_t ws_size, hipStream_t stream) {
    static int grid = 0;
    if (grid == 0) {
        if (n_in != 24 || out_size != MS * D || ws_size < WS_END) { fprintf(stderr, "kernel_launch: unexpected shapes (n_in %d out %d ws %zu need %zu)\n", n_in, out_size, ws_size, (size_t)WS_END); grid = -1; return; }
        int dev = 0, cus = 0, per_cu = 0;
        (void)hipGetDevice(&dev);
        (void)hipDeviceGetAttribute(&cus, hipDeviceAttributeMultiprocessorCount, dev);
#if MULTI_LAUNCH
        per_cu = 1;
#else
        (void)hipFuncSetAttribute((const void*)fwd_mega, hipFuncAttributeMaxDynamicSharedMemorySize, LDS_BYTES);
        (void)hipOccupancyMaxActiveBlocksPerMultiprocessor(&per_cu, (const void*)fwd_mega, 512, LDS_BYTES);
        if (per_cu < 1) { fprintf(stderr, "kernel_launch: occupancy query says %d blocks per CU\n", per_cu); per_cu = 1; }
        if (per_cu > 1) per_cu = 1;
#endif
        grid = cus * per_cu;
    }
    if (grid < 0) return;
    Params p{};
    for (int i = 0; i < 24; ++i) p.in[i] = (const float*)d_in[i];
    p.out = (float*)d_out; p.ws = (unsigned char*)d_ws;
#if MULTI_LAUNCH
#define LP(PH) do { (void)hipFuncSetAttribute((const void*)fwd_phase<PH>, hipFuncAttributeMaxDynamicSharedMemorySize, LDS_BYTES); hipLaunchKernelGGL(fwd_phase<PH>, dim3(grid), dim3(512), LDS_BYTES, stream, p); } while (0)
    LP(0); LP(1); LP(2); LP(3); LP(4); LP(5); LP(6); LP(7); LP(8); LP(9); LP(10);
#undef LP
#else
    if (hipMemsetAsync(d_ws, 0, WS_CTL_BYTES, stream) != hipSuccess) { fprintf(stderr, "kernel_launch: hipMemsetAsync of the control words failed\n"); return; }
    void* args[] = {&p};
    hipError_t e = hipLaunchCooperativeKernel((const void*)fwd_mega, dim3(grid), dim3(512), args, LDS_BYTES, stream);
    if (e != hipSuccess) fprintf(stderr, "cooperative launch failed: %s (grid %d)\n", hipGetErrorString(e), grid);
#endif
}
```

```cpp
#include <hip/hip_runtime.h>
#include <hip/hip_cooperative_groups.h>
#include <cstdio>
#include <cstdint>
#include <type_traits>
namespace cg = cooperative_groups;

#ifndef MULTI_LAUNCH
#define MULTI_LAUNCH 0
#endif

typedef unsigned short bf16_t;
typedef short bf16x8 __attribute__((ext_vector_type(8)));
typedef float f32x4 __attribute__((ext_vector_type(4)));
typedef float f32x2 __attribute__((ext_vector_type(2)));
typedef unsigned u32x2 __attribute__((ext_vector_type(2)));
typedef unsigned u32x4 __attribute__((ext_vector_type(4)));
typedef _Float16 h16x2 __attribute__((ext_vector_type(2)));
typedef _Float16 h16x4 __attribute__((ext_vector_type(4)));
typedef _Float16 h16x8 __attribute__((ext_vector_type(8)));

constexpr int D = 1024, NB = 4, SEQ = 8192, NMETA = 16, T = SEQ + NMETA, TP = 8320, MP = NB * TP, MS = NB * SEQ;
constexpr int PIN = 5376, DFF = 2816, NH = 8, RWS = 1792;
constexpr float RMS_EPS = 1e-6f, GN_EPS = 64e-5f;

constexpr size_t WS_CTL = 0;
constexpr size_t WS_BAR = 4096;
constexpr size_t WS_CTL_BYTES = 32768;
constexpr size_t WS_WIN = WS_CTL_BYTES;
constexpr size_t WS_WSB = WS_WIN + (size_t)PIN * D * 2;
constexpr size_t WS_WRW = WS_WSB + (size_t)D * 512 * 2;
constexpr size_t WS_WOUT = WS_WRW + (size_t)D * 512 * 2;
constexpr size_t WS_WGU = WS_WOUT + (size_t)D * D * 2;
constexpr size_t WS_WD = WS_WGU + (size_t)2 * DFF * D * 2;
constexpr size_t WS_WL = WS_WD + (size_t)D * DFF * 2;
constexpr size_t R_A0 = WS_WL + (size_t)512 * 256 * 2;
constexpr size_t R_URW = R_A0 + (size_t)MP * D * 2;
constexpr size_t R_QKV = R_URW;
constexpr size_t QKV_ONE = (size_t)MP * 512 * 2;
constexpr size_t R_SI = R_URW + (size_t)MP * RWS * 2;
constexpr size_t SI_ONE = (size_t)MP * 512 * 2;
constexpr size_t R_G = R_SI + 6 * SI_ONE;
constexpr size_t R_TAIL = R_G + SI_ONE;
constexpr size_t O_Y = R_TAIL;
constexpr size_t O_OSB = R_TAIL + SI_ONE;
constexpr size_t WS_END = O_OSB + (size_t)MS * 512 * 2;
constexpr size_t O_A0 = R_A0;
constexpr size_t O_ORW = R_A0;
constexpr size_t O_T1 = R_SI;
constexpr size_t O_M = R_SI + (size_t)MS * D * 4;
constexpr size_t O_P = R_A0;
constexpr size_t O_F = R_SI;
constexpr size_t O_ACT = R_A0;
constexpr size_t O_DN = R_SI + (size_t)MS * D * 2;
static_assert(3 * QKV_ONE <= (size_t)MP * RWS * 2, "overlay");
static_assert(O_M + (size_t)MS * D * 2 <= R_TAIL, "overlay");
static_assert(O_ACT + (size_t)MS * DFF * 2 <= R_SI, "overlay");
static_assert(O_P + (size_t)MS * D * 4 <= R_SI, "overlay");
static_assert(O_DN + (size_t)MS * D * 4 <= R_TAIL, "overlay");
static_assert(WS_END <= (size_t)512 * 1024 * 1024, "workspace");

constexpr int LDS_BYTES = 131072 + 64;

struct Params { const float* in[24]; float* out; unsigned char* ws; };

extern __shared__ __attribute__((aligned(16))) unsigned char smem[];

typedef __bf16 b16x2 __attribute__((ext_vector_type(2)));
__device__ __forceinline__ unsigned pk_bf16(float lo, float hi) { const f32x2 v = {lo, hi}; return __builtin_bit_cast(unsigned, __builtin_convertvector(v, b16x2)); }
__device__ __forceinline__ float bf2f(unsigned short v) { return __uint_as_float((unsigned)v << 16); }
__device__ __forceinline__ float sigmoidf_(float x) { return __builtin_amdgcn_rcpf(1.0f + __expf(-x)); }
__device__ __forceinline__ float softplusf_(float x) { return fmaxf(x, 0.f) + __logf(1.0f + __expf(-fabsf(x))); }
template <int CTRL> __device__ __forceinline__ float dppf(float x) { return __builtin_bit_cast(float, __builtin_amdgcn_mov_dpp(__builtin_bit_cast(int, x), CTRL, 0xf, 0xf, true)); }
__device__ __forceinline__ float reduce16(float v) {
    v += dppf<0xB1>(v); v += dppf<0x4E>(v); v += dppf<0x141>(v); v += dppf<0x140>(v); return v;
}
__device__ __forceinline__ float wave_sum(float v) {
#pragma unroll
    for (int o = 1; o < 64; o <<= 1) v += __shfl_xor(v, o);
    return v;
}

#define LAS __attribute__((address_space(3)))
#define XB_TMO      128
#define XB_XCNT(j)  (256  + 64 * (j))
#define XB_XSUB(j)  (1280 + 64 * (j))
#define XB_XGEN(j)  (2304 + 64 * (j))
#define XB_TOP      3328
#define XB_TOPGEN   3392
#define XCD_BAR_WORDS 3456
#define XB_SPIN_CAP (1u << 18)
__device__ __forceinline__ unsigned xb_ld(unsigned* p)              { return __hip_atomic_load(p, __ATOMIC_RELAXED, __HIP_MEMORY_SCOPE_AGENT); }
__device__ __forceinline__ unsigned xb_add(unsigned* p, unsigned v) { return __hip_atomic_fetch_add(p, v, __ATOMIC_RELAXED, __HIP_MEMORY_SCOPE_AGENT); }
__device__ __forceinline__ unsigned xb_xcc_id() { return (unsigned)__builtin_amdgcn_s_getreg((3 << 11) | 20) & 0xFu; }
#define XB_SPIN(cond, bar) do { unsigned _sp = 0; while (cond) { __builtin_amdgcn_s_sleep(1); \
    if ((++_sp & 255u) == 0u) { if (xb_ld(&(bar)[XB_TMO])) break; if (_sp > XB_SPIN_CAP) { atomicAdd(&(bar)[XB_TMO], 1u); break; } } } } while (0)
struct XcdBarrier { unsigned* bar; unsigned x; volatile LAS unsigned* st; };
__device__ __forceinline__ XcdBarrier xcd_barrier_post(unsigned* bar, volatile LAS unsigned* st) {
    XcdBarrier b; b.bar = bar; b.x = xb_xcc_id(); b.st = st;
    if (threadIdx.x == 0) (void)xb_add(&bar[XB_XCNT(b.x)], 1u);
    return b;
}
__device__ __forceinline__ void xcd_barrier_complete(unsigned* bar, unsigned x, unsigned& nloc, unsigned& nx) {
    const unsigned G = gridDim.x * gridDim.y * gridDim.z;
    unsigned sum, cnt, mine, sp = 0u;
    for (;;) {
        sum = 0u; cnt = 0u; mine = 0u;
#pragma unroll
        for (unsigned j = 0; j < 16; ++j) { const unsigned c = xb_ld(&bar[XB_XCNT(j)]); sum += c; cnt += (c > 0u) ? 1u : 0u; mine = (j == x) ? c : mine; }
        if (sum == G) break;
        __builtin_amdgcn_s_sleep(1);
        if ((++sp & 255u) == 0u) { if (xb_ld(&bar[XB_TMO])) break; if (sp > XB_SPIN_CAP) { atomicAdd(&bar[XB_TMO], 1u); break; } }
    }
    nloc = mine > 0u ? mine : 1u; nx = cnt > 0u ? cnt : 1u;
}
__device__ __forceinline__ void xcd_barrier(const XcdBarrier& b) {
    asm volatile("s_waitcnt vmcnt(0)" ::: "memory");
    __syncthreads();
    if (threadIdx.x == 0) {
        unsigned* bar = b.bar;
        __builtin_amdgcn_s_waitcnt(0);
        unsigned nloc = b.st[0], nx = b.st[1];
        if (nloc == 0u) { xcd_barrier_complete(bar, b.x, nloc, nx); b.st[0] = nloc; b.st[1] = nx; }
        const unsigned old = xb_add(&bar[XB_XSUB(b.x)], 1u);
        const unsigned gen = old / nloc;
        if (old + 1u == (gen + 1u) * nloc) {
            __builtin_amdgcn_fence(__ATOMIC_RELEASE, "agent");
            asm volatile("s_waitcnt vmcnt(0)" ::: "memory");
            const unsigned og = xb_add(&bar[XB_TOP], 1u);
            const unsigned tg = og / nx;
            if (og + 1u == (tg + 1u) * nx) xb_add(&bar[XB_TOPGEN], 1u);
            else XB_SPIN(xb_ld(&bar[XB_TOPGEN]) == tg, bar);
            __builtin_amdgcn_fence(__ATOMIC_ACQUIRE, "agent");
            xb_add(&bar[XB_XGEN(b.x)], 1u);
            asm volatile("s_waitcnt vmcnt(0)" ::: "memory");
        } else {
            XB_SPIN(xb_ld(&bar[XB_XGEN(b.x)]) == gen, bar);
            __builtin_amdgcn_fence(__ATOMIC_ACQUIRE, "agent");
            asm volatile("s_waitcnt vmcnt(0)" ::: "memory");
        }
    }
    __syncthreads();
}

constexpr int BM = 256, BK = 64, HALF = 128, HTB = HALF * BK * 2, NXCD = 8, WGM = 8;
__device__ __forceinline__ int lds_byte(int r, int c) { const int st = (r >> 4) * 2 + (c >> 5), rr = r & 15, cc = c & 31, ob = rr * 64 + cc * 2; return st * 1024 + (ob ^ (((ob >> 9) & 1) << 5)); }
__device__ __forceinline__ void stage_rc(int b, int& R, int& C) { const int st = b / 1024, sb = b % 1024, swz = sb ^ (((sb >> 9) & 1) << 5); R = (st >> 1) * 16 + swz / 64; C = (st & 1) * 32 + (swz % 64) / 2; }
struct Unit { int pm, pn; };
struct Sched {
    int nM, nN, nwg, G, c;
    __device__ __forceinline__ bool next(int i, Unit& u) const {
        const long L = (long)i * G + c; if (L >= nwg) return false;
        int wgid = (int)L; { const int q = nwg / NXCD, r = nwg % NXCD, xcd = wgid % NXCD, off = wgid / NXCD; wgid = (xcd < r ? xcd * (q + 1) : r * (q + 1) + (xcd - r) * q) + off; }
        const int nig = WGM * nN, gid = wgid / nig, fm = gid * WGM, gsz = (nM - fm) < WGM ? (nM - fm) : WGM;
        u.pm = fm + ((wgid % nig) % gsz); u.pn = (wgid % nig) / gsz; return true;
    }
};

template <class Epi>
__device__ __forceinline__ void gemm_phase(const bf16_t* __restrict__ Ag, const bf16_t* __restrict__ Btg, const int K, const int nM, const int nN, const Epi& E,
                                           const int G = (int)gridDim.x, const int c = (int)blockIdx.x, const int pn_from = 1 << 30, const int pn_add = 0) {
    LAS unsigned char* lds = (LAS unsigned char*)smem;
    const int tid = threadIdx.x, wid = __builtin_amdgcn_readfirstlane(tid >> 6), lane = tid & 63, wr = wid >> 2, wc = wid & 3, fr = lane & 15, fq = lane >> 4;
    const int nt = K / BK;
    Sched S; S.nM = nM; S.nN = nN; S.nwg = nM * nN; S.G = G; S.c = c;
    unsigned voffA[2], voffB[2];
#pragma unroll
    for (int i = 0; i < 2; ++i) { int R, C; stage_rc(tid * 16 + i * 8192, R, C); voffA[i] = (unsigned)(R * K + C) * 2u; voffB[i] = voffA[i]; }
    const size_t kstep = (size_t)(BK * 2);
    const size_t hstep = (size_t)HALF * K * 2;
    const size_t tstep = 2 * hstep;
    const unsigned ldsw = (unsigned)wid * 1024u;
    const int aoff = lds_byte(wr * 64 + fr, fq * 8), boff = lds_byte(wc * 32 + fr, fq * 8);
#define PG8_SA(b, h) (((b) * 2 + (h)) * HTB)
#define PG8_SB(b, h) ((4 + (b) * 2 + (h)) * HTB)
#define PG8_STAGE(bufoff, gbase, voff) do { _Pragma("unroll") for (int _i = 0; _i < 2; ++_i) \
        __builtin_amdgcn_global_load_lds((const unsigned*)((const char*)(gbase) + (voff)[_i]), (LAS unsigned*)(lds + (bufoff) + ldsw + _i * 8192), 16, 0, 0); } while (0)
#define PG8_LDA(dst, b, h) do { _Pragma("unroll") for (int m = 0; m < 4; ++m) _Pragma("unroll") for (int k = 0; k < 2; ++k) dst[m][k] = *(const LAS bf16x8*)(lds + PG8_SA(b, h) + aoff + m * 2048 + k * 1024); } while (0)
#define PG8_LDB(dst, b, h) do { _Pragma("unroll") for (int n = 0; n < 2; ++n) _Pragma("unroll") for (int k = 0; k < 2; ++k) dst[n][k] = *(const LAS bf16x8*)(lds + PG8_SB(b, h) + boff + n * 2048 + k * 1024); } while (0)
#define PG8_MMA(ai, bj, At, Bt) do { __builtin_amdgcn_s_setprio(1); _Pragma("unroll") for (int m = 0; m < 4; ++m) _Pragma("unroll") for (int n = 0; n < 2; ++n) _Pragma("unroll") for (int k = 0; k < 2; ++k) \
        acc[ai][bj][m][n] = __builtin_amdgcn_mfma_f32_16x16x32_bf16(Bt[n][k], At[m][k], acc[ai][bj][m][n], 0, 0, 0); __builtin_amdgcn_s_setprio(0); } while (0)
#define PG8_WAIT_V(n) asm volatile("s_waitcnt vmcnt(" #n ")" ::: "memory")
#define PG8_WAIT_L(n) asm volatile("s_waitcnt lgkmcnt(" #n ")" ::: "memory")
#define PG8_BAR __builtin_amdgcn_s_barrier()
#define PG8_SCHED __builtin_amdgcn_sched_barrier(0)
    Unit cur, nxt; int ui = 0;
    __syncthreads();
    if (!S.next(0, cur)) return;
    if (cur.pn >= pn_from) cur.pn += pn_add;
    f32x4 acc[2][2][4][2];
#pragma unroll
    for (int a = 0; a < 2; ++a)
#pragma unroll
        for (int b = 0; b < 2; ++b)
#pragma unroll
            for (int m = 0; m < 4; ++m)
#pragma unroll
                for (int n = 0; n < 2; ++n) acc[a][b][m][n] = (f32x4){0.f, 0.f, 0.f, 0.f};
    bf16x8 At[4][2], B0[2][2], B1[2][2];
    const char* cA = (const char*)Ag + (size_t)cur.pm * tstep; const char* cB = (const char*)Btg + (size_t)cur.pn * tstep;
    PG8_STAGE(PG8_SB(0, 0), cB, voffB); PG8_STAGE(PG8_SA(0, 0), cA, voffA); PG8_STAGE(PG8_SB(0, 1), cB + hstep, voffB); PG8_STAGE(PG8_SA(0, 1), cA + hstep, voffA);
    if (wr == 1) PG8_BAR;
    PG8_WAIT_V(4); PG8_BAR;
    PG8_STAGE(PG8_SB(1, 0), cB + kstep, voffB); PG8_STAGE(PG8_SA(1, 0), cA + kstep, voffA); PG8_STAGE(PG8_SB(1, 1), cB + hstep + kstep, voffB);
    PG8_WAIT_V(6); PG8_BAR;
    for (;;) {
        const bool has_next = S.next(ui + 1, nxt);
        if (has_next && nxt.pn >= pn_from) nxt.pn += pn_add;
        const char* nA = has_next ? (const char*)Ag + (size_t)nxt.pm * tstep : cA; const char* nB = has_next ? (const char*)Btg + (size_t)nxt.pn * tstep : cB;
        for (int t = 0; t < nt; t += 2) {
            const bool last = (t == nt - 2);
            const char* a1 = cA + (size_t)(t + 1) * kstep;
            const char* a2 = last ? nA : cA + (size_t)(t + 2) * kstep; const char* b2 = last ? nB : cB + (size_t)(t + 2) * kstep;
            const char* a3 = a2 + kstep; const char* b3 = b2 + kstep;
            PG8_LDB(B0, 0, 0); PG8_SCHED; PG8_LDA(At, 0, 0); PG8_STAGE(PG8_SA(1, 1), a1 + hstep, voffA);
            PG8_WAIT_L(8); PG8_BAR; PG8_WAIT_L(0); PG8_MMA(0, 0, At, B0); PG8_BAR; PG8_SCHED;
            PG8_LDB(B1, 0, 1); PG8_STAGE(PG8_SB(0, 0), b2, voffB);
            PG8_BAR; PG8_WAIT_L(0); PG8_MMA(0, 1, At, B1); PG8_BAR;
            PG8_LDA(At, 0, 1); PG8_STAGE(PG8_SA(0, 0), a2, voffA);
            PG8_BAR; PG8_WAIT_L(0); PG8_MMA(1, 0, At, B0); PG8_BAR; PG8_SCHED;
            PG8_STAGE(PG8_SB(0, 1), b2 + hstep, voffB);
            PG8_WAIT_V(6); PG8_BAR; PG8_MMA(1, 1, At, B1); PG8_BAR;
            PG8_LDB(B0, 1, 0); PG8_SCHED; PG8_LDA(At, 1, 0); PG8_STAGE(PG8_SA(0, 1), a2 + hstep, voffA);
            PG8_WAIT_L(8); PG8_BAR; PG8_WAIT_L(0); PG8_MMA(0, 0, At, B0); PG8_BAR; PG8_SCHED;
            PG8_LDB(B1, 1, 1); PG8_STAGE(PG8_SB(1, 0), b3, voffB);
            PG8_BAR; PG8_WAIT_L(0); PG8_MMA(0, 1, At, B1); PG8_BAR;
            PG8_LDA(At, 1, 1); PG8_STAGE(PG8_SA(1, 0), a3, voffA);
            PG8_BAR; PG8_WAIT_L(0); PG8_MMA(1, 0, At, B0); PG8_BAR; PG8_SCHED;
            PG8_STAGE(PG8_SB(1, 1), b3 + hstep, voffB);
            PG8_WAIT_V(6); PG8_BAR; PG8_MMA(1, 1, At, B1); PG8_BAR;
        }
        {
            const int brow = cur.pm * BM, bcol = cur.pn * BM;
#pragma unroll
            for (int ai = 0; ai < 2; ++ai)
#pragma unroll
                for (int m = 0; m < 4; ++m) {
#pragma unroll
                    for (int bj = 0; bj < 2; ++bj)
                        E(brow + ai * HALF + wr * 64 + m * 16 + fr, bcol + bj * HALF + wc * 32, fq, acc[ai][bj][m][0], acc[ai][bj][m][1]);
                    asm volatile("" ::: "memory");
                }
        }
        if (!has_next) break;
#pragma unroll
        for (int a = 0; a < 2; ++a)
#pragma unroll
            for (int b = 0; b < 2; ++b)
#pragma unroll
                for (int m = 0; m < 4; ++m)
#pragma unroll
                    for (int n = 0; n < 2; ++n) acc[a][b][m][n] = (f32x4){0.f, 0.f, 0.f, 0.f};
        cur = nxt; cA = nA; cB = nB; ++ui;
    }
    PG8_WAIT_V(0);
    if (wr == 0) PG8_BAR;
    PG8_BAR;
#undef PG8_SA
#undef PG8_SB
#undef PG8_STAGE
#undef PG8_LDA
#undef PG8_LDB
#undef PG8_MMA
#undef PG8_WAIT_V
#undef PG8_WAIT_L
#undef PG8_BAR
#undef PG8_SCHED
}

struct EpiInProj {
    bf16_t* qkv; _Float16* urw; bf16_t* gates;
    __device__ __forceinline__ void one(int row, int col, const f32x4& v) const {
        if (col < 1536) {
            const int which = col >> 9, hc = col & 511, h = hc >> 6, d = hc & 63, b = row / TP, t = row - b * TP;
            const float s = which == 0 ? 0.125f : 1.0f;
            u32x2 w; w.x = pk_bf16(v[0] * s, v[1] * s); w.y = pk_bf16(v[2] * s, v[3] * s);
            *(u32x2*)(qkv + (size_t)which * (QKV_ONE / 2) + ((size_t)(b * NH + h) * TP + t) * 64 + d) = w;
        } else if (col < 3328) {
            h16x4 o; o[0] = (_Float16)v[0]; o[1] = (_Float16)v[1]; o[2] = (_Float16)v[2]; o[3] = (_Float16)v[3];
            *(h16x4*)(urw + (size_t)row * RWS + (col - 1536)) = o;
        } else {
            const int b = row / TP, t = row - b * TP;
            if (t >= NMETA && t < T) {
                u32x2 w; w.x = pk_bf16(sigmoidf_(v[0]), sigmoidf_(v[1])); w.y = pk_bf16(sigmoidf_(v[2]), sigmoidf_(v[3]));
                *(u32x2*)(gates + (size_t)(b * SEQ + t - NMETA) * 2048 + (col - 3328)) = w;
            }
        }
    }
    __device__ __forceinline__ void operator()(int row, int col32, int fq, const f32x4& v0, const f32x4& v1) const {
        if (col32 >= 1536 && col32 < 3072) {
            const int c = col32 - 1536, pos = (c & ~63) + fq * 16 + ((c & 63) >> 4) * 4;
            h16x8 o;
#pragma unroll
            for (int j = 0; j < 4; ++j) { o[j] = (_Float16)v0[j]; o[4 + j] = (_Float16)v1[j]; }
            *(h16x8*)(urw + (size_t)row * RWS + pos) = o;
        } else { one(row, col32 + 4 * fq, v0); one(row, col32 + 16 + 4 * fq, v1); }
    }
};
struct EpiBranch1 {
    float* t1; const bf16_t* gates;
    __device__ __forceinline__ void one(int row, int col, const f32x4& v) const {
        const u32x2 g = *(const u32x2*)(gates + (size_t)row * 2048 + col);
        f32x4 o; o[0] = v[0] * __uint_as_float(g.x << 16); o[1] = v[1] * __uint_as_float(g.x & 0xffff0000u); o[2] = v[2] * __uint_as_float(g.y << 16); o[3] = v[3] * __uint_as_float(g.y & 0xffff0000u);
        *(f32x4*)(t1 + (size_t)row * D + col) = o;
    }
    __device__ __forceinline__ void operator()(int row, int col32, int fq, const f32x4& v0, const f32x4& v1) const { one(row, col32 + 4 * fq, v0); one(row, col32 + 16 + 4 * fq, v1); }
};
struct EpiBranch2 {
    const float* t1; const bf16_t* gates; bf16_t* m;
    __device__ __forceinline__ void one(int row, int col, const f32x4& v) const {
        const u32x2 g = *(const u32x2*)(gates + (size_t)row * 2048 + 1024 + col);
        const f32x4 a = *(const f32x4*)(t1 + (size_t)row * D + col);
        f32x4 o; o[0] = a[0] + v[0] * __uint_as_float(g.x << 16); o[1] = a[1] + v[1] * __uint_as_float(g.x & 0xffff0000u); o[2] = a[2] + v[2] * __uint_as_float(g.y << 16); o[3] = a[3] + v[3] * __uint_as_float(g.y & 0xffff0000u);
        u32x2 w; w.x = pk_bf16(o[0], o[1]); w.y = pk_bf16(o[2], o[3]);
        *(u32x2*)(m + (size_t)row * D + col) = w;
    }
    __device__ __forceinline__ void operator()(int row, int col32, int fq, const f32x4& v0, const f32x4& v1) const { one(row, col32 + 4 * fq, v0); one(row, col32 + 16 + 4 * fq, v1); }
};
struct EpiF32 {
    float* o;
    __device__ __forceinline__ void operator()(int row, int col32, int fq, const f32x4& v0, const f32x4& v1) const {
        *(f32x4*)(o + (size_t)row * D + col32 + 4 * fq) = v0; *(f32x4*)(o + (size_t)row * D + col32 + 16 + 4 * fq) = v1;
    }
};
struct EpiGU {
    bf16_t* act;
    __device__ __forceinline__ void operator()(int row, int col32, int fq, const f32x4& v0, const f32x4& v1) const {
        float o[4];
#pragma unroll
        for (int j = 0; j < 4; ++j) o[j] = v0[j] * sigmoidf_(v0[j]) * v1[j];
        u32x2 w; w.x = pk_bf16(o[0], o[1]); w.y = pk_bf16(o[2], o[3]);
        *(u32x2*)(act + (size_t)row * DFF + (col32 >> 5) * 16 + 4 * fq) = w;
    }
};

__device__ __forceinline__ void transpose_tile(const float* __restrict__ src, int K, int N, bf16_t* __restrict__ dst, int ldd, int koff, int mode, int tile) {
    float* scr = (float*)smem;
    const int ntn = N / 128, kb = tile / ntn, nb = tile % ntn, k0 = kb * 64, n0 = nb * 128, tid = threadIdx.x;
    f32x4 v[4];
#pragma unroll
    for (int i = 0; i < 4; ++i) { const int idx = tid + 512 * i, kk = idx >> 5, n4 = idx & 31; v[i] = *(const f32x4*)(src + (size_t)(k0 + kk) * N + n0 + n4 * 4); }
#pragma unroll
    for (int i = 0; i < 4; ++i) { const int idx = tid + 512 * i, kk = idx >> 5, n4 = idx & 31;
#pragma unroll
        for (int c = 0; c < 4; ++c) scr[kk * 129 + n4 * 4 + c] = v[i][c]; }
    __syncthreads();
#pragma unroll
    for (int i = 0; i < 2; ++i) {
        const int o = tid + 512 * i, n = o >> 3, kc = (o & 7) * 8;
        u32x4 w;
        w.x = pk_bf16(scr[(kc + 0) * 129 + n], scr[(kc + 1) * 129 + n]); w.y = pk_bf16(scr[(kc + 2) * 129 + n], scr[(kc + 3) * 129 + n]);
        w.z = pk_bf16(scr[(kc + 4) * 129 + n], scr[(kc + 5) * 129 + n]); w.w = pk_bf16(scr[(kc + 6) * 129 + n], scr[(kc + 7) * 129 + n]);
        const int f = n0 + n;
        const int drow = mode == 0 ? f : ((f >> 4) * 32 + (mode == 2 ? 16 : 0) + (f & 15));
        *(u32x4*)(dst + (size_t)drow * ldd + koff + k0 + kc) = w;
    }
    __syncthreads();
}

__device__ __forceinline__ void phase0(const Params& p) {
    unsigned char* ws = p.ws;
    if (blockIdx.x == 0 && threadIdx.x < 64) ((unsigned*)(ws + WS_CTL))[threadIdx.x] = 0u;
    constexpr int J0 = 16 * 42, J1 = 8 * 8, J3 = 16 * 8, J4 = 16 * 22, J6 = 44 * 8, J7 = 4, J9 = 8;
    constexpr int NT = J0 + 2 * J1 + J3 + 2 * J4 + J6 + 2 * J7 + J9;
    constexpr int NR = MP / 32;
    for (int it = blockIdx.x; it < NT + NR; it += gridDim.x) {
        if (it >= NR) {
            int r = it - NR;
            if (r < J0) { transpose_tile(p.in[4], D, PIN, (bf16_t*)(ws + WS_WIN), D, 0, 0, r); continue; } r -= J0;
            if (r < J1) { transpose_tile(p.in[16], 512, D, (bf16_t*)(ws + WS_WSB), 512, 0, 0, r); continue; } r -= J1;
            if (r < J1) { transpose_tile(p.in[17], 512, D, (bf16_t*)(ws + WS_WRW), 512, 0, 0, r); continue; } r -= J1;
            if (r < J3) { transpose_tile(p.in[18], D, D, (bf16_t*)(ws + WS_WOUT), D, 0, 0, r); continue; } r -= J3;
            if (r < J4) { transpose_tile(p.in[21], D, DFF, (bf16_t*)(ws + WS_WGU), D, 0, 1, r); continue; } r -= J4;
            if (r < J4) { transpose_tile(p.in[22], D, DFF, (bf16_t*)(ws + WS_WGU), D, 0, 2, r); continue; } r -= J4;
            if (r < J6) { transpose_tile(p.in[23], DFF, D, (bf16_t*)(ws + WS_WD), DFF, 0, 0, r); continue; } r -= J6;
            if (r < J7) { transpose_tile(p.in[6], 64, 512, (bf16_t*)(ws + WS_WL), 256, 0, 0, r); continue; } r -= J7;
            if (r < J7) { transpose_tile(p.in[8], 64, 512, (bf16_t*)(ws + WS_WL), 256, 64, 0, r); continue; } r -= J7;
            transpose_tile(p.in[10], 128, 512, (bf16_t*)(ws + WS_WL), 256, 128, 0, r);
        } else {
            const int lane = threadIdx.x & 63, row0 = it * 32 + (threadIdx.x >> 6) * 4;
            f32x4 v[4][4];
#pragma unroll
            for (int r = 0; r < 4; ++r) {
                const int row = row0 + r, b = row / TP, t = row - b * TP;
                const float* src = t < NMETA ? p.in[1] + (size_t)t * D : p.in[0] + ((size_t)b * SEQ + (t < T ? t - NMETA : 0)) * D;
#pragma unroll
                for (int j = 0; j < 4; ++j) v[r][j] = *(const f32x4*)(src + 4 * lane + 256 * j);
            }
            f32x4 g[4];
#pragma unroll
            for (int j = 0; j < 4; ++j) g[j] = *(const f32x4*)(p.in[2] + 4 * lane + 256 * j);
#pragma unroll
            for (int r = 0; r < 4; ++r) {
                const int row = row0 + r, b = row / TP, t = row - b * TP;
                float ss = 0.f;
#pragma unroll
                for (int j = 0; j < 4; ++j) ss += (v[r][j][0] * v[r][j][0] + v[r][j][1] * v[r][j][1]) + (v[r][j][2] * v[r][j][2] + v[r][j][3] * v[r][j][3]);
                const float rs = t < T ? rsqrtf(wave_sum(ss) * (1.0f / D) + RMS_EPS) : 0.f;
                bf16_t* orow = (bf16_t*)(ws + O_A0) + (size_t)row * D;
#pragma unroll
                for (int j = 0; j < 4; ++j) {
                    u32x2 w; w.x = pk_bf16(v[r][j][0] * rs * g[j][0], v[r][j][1] * rs * g[j][1]); w.y = pk_bf16(v[r][j][2] * rs * g[j][2], v[r][j][3] * rs * g[j][3]);
                    *(u32x2*)(orow + 4 * lane + 256 * j) = w;
                }
            }
        }
    }
}

__device__ __forceinline__ void phase1(const Params& p) {
    unsigned char* ws = p.ws;
    EpiInProj epi{(bf16_t*)(ws + R_QKV), (_Float16*)(ws + R_URW), (bf16_t*)p.out};
    gemm_phase((const bf16_t*)(ws + O_A0), (const bf16_t*)(ws + WS_WIN), D, MP / BM, 7, epi, (int)gridDim.x, (int)blockIdx.x, 0, 6);
}

constexpr int SI_R = 0, SI_W = 1, SI_K = 2, SI_V = 3, SI_KK = 4, SI_B = 5;
constexpr int ALD = 264;
constexpr int P2_WLS = 64 * ALD * 2;
constexpr int P2_MU = P2_WLS;
constexpr int P2_AL = P2_MU + 1024;
__device__ __forceinline__ void phase2_main(const Params& p) {
    unsigned char* ws = p.ws;
    const int tid = threadIdx.x, wave = tid >> 6, lane = tid & 63, fr = lane & 15, fq = lane >> 4;
    const int h = blockIdx.x & 7, nslot = (gridDim.x >> 3) * 8, slot = (blockIdx.x >> 3) * 8 + wave;
    const _Float16* urw = (const _Float16*)(ws + R_URW);
    const float* mu = p.in[5];
    bf16_t* WLs = (bf16_t*)smem;
    float* mus = (float*)(smem + P2_MU);
    bf16_t* Al = (bf16_t*)(smem + P2_AL) + wave * (16 * ALD);
    __syncthreads();
    {
        const bf16_t* WL = (const bf16_t*)(ws + WS_WL) + (size_t)h * 64 * 256;
#pragma unroll
        for (int i = 0; i < 4; ++i) { const int idx = tid + 512 * i, row = idx >> 5, c16 = idx & 31; *(u32x4*)(WLs + row * ALD + c16 * 8) = *(const u32x4*)(WL + row * 256 + c16 * 8); }
        if (tid < 256) mus[tid] = mu[1536 + tid];
    }
    __syncthreads();
    if (blockIdx.x >= nslot) return;
    _Float16* SI = (_Float16*)(ws + R_SI);
    bf16_t* G = (bf16_t*)(ws + R_G);
    constexpr size_t SIE = (size_t)MP * 512;
#pragma unroll 1
    for (int g = slot; g < NB * 514; g += nslot) {
        const int ub = g / 514, ui = g - ub * 514, row0 = ub * TP + ui * 16;
        {
            const int half = lane >> 5, pc = (lane & 31) * 8;
            const float sA = pc < 64 ? 2.f : 1.f, sC = pc < 64 ? -1.f : 0.f;
            const bool lin = pc >= 64 && pc < 128;
            const f32x4 mA = *(const f32x4*)(mu + 1536 + pc), mB = *(const f32x4*)(mu + 1536 + pc + 4);
            h16x8 c[8], pv[8];
#pragma unroll
            for (int q = 0; q < 8; ++q) {
                const int rowa = row0 + 2 * q + half, ta = rowa % TP;
                const _Float16* cur = urw + (size_t)rowa * RWS + 1536 + pc;
                c[q] = *(const h16x8*)cur;
                pv[q] = *(const h16x8*)(ta > 0 ? cur - RWS : cur);
            }
#pragma unroll
            for (int q = 0; q < 8; ++q) {
                const int ta = (row0 + 2 * q + half) % TP;
                float o[8];
#pragma unroll
                for (int e = 0; e < 8; ++e) {
                    const float cf = (float)c[q][e], pf = ta > 0 ? (float)pv[q][e] : 0.f;
                    const float xs = cf + (e < 4 ? mA[e & 3] : mB[e & 3]) * (pf - cf);
                    const float sg = __builtin_amdgcn_rcpf(1.0f + __expf(-sA * xs));
                    o[e] = lin ? xs : sA * sg + sC;
                }
                u32x4 w; w.x = pk_bf16(o[0], o[1]); w.y = pk_bf16(o[2], o[3]); w.z = pk_bf16(o[4], o[5]); w.w = pk_bf16(o[6], o[7]);
                *(u32x4*)(Al + (2 * q + half) * ALD + pc) = w;
            }
        }
        asm volatile("s_waitcnt lgkmcnt(0)" ::: "memory");
        __builtin_amdgcn_wave_barrier();
        f32x4 acc[4];
        auto lora = [&](auto kbeg_c, auto ksteps_c) {
            constexpr int kbeg = decltype(kbeg_c)::value, ksteps = decltype(ksteps_c)::value;
#pragma unroll
            for (int n = 0; n < 4; ++n) acc[n] = (f32x4){0.f, 0.f, 0.f, 0.f};
#pragma unroll
            for (int ks = 0; ks < ksteps; ++ks) {
                const bf16x8 af = *(const bf16x8*)(Al + fr * ALD + kbeg + ks * 32 + fq * 8);
#pragma unroll
                for (int n = 0; n < 4; ++n) {
                    const bf16x8 wf = *(const bf16x8*)(WLs + (n * 16 + fr) * ALD + kbeg + ks * 32 + fq * 8);
                    acc[n] = __builtin_amdgcn_mfma_f32_16x16x32_bf16(wf, af, acc[n], 0, 0, 0);
                }
            }
        };
        const int row = row0 + fr, b = row / TP, t = row - b * TP;
        const size_t base = ((size_t)(b * NH + h) * TP + t) * 64;
        const _Float16* ur = urw + (size_t)row * RWS;
        const size_t pb = base + fq * 16;
        lora(std::integral_constant<int, 0>{}, std::integral_constant<int, 2>{});
        {
            h16x8 wo[2];
#pragma unroll
            for (int n = 0; n < 4; ++n) {
                const f32x4 db = *(const f32x4*)(p.in[7] + h * 64 + n * 16 + fq * 4);
#pragma unroll
                for (int j = 0; j < 4; ++j) {
                    const float wl = -softplusf_(-(db[j] + acc[n][j])) - 0.5f;
                    const float e = __expf(wl);
                    wo[n >> 1][(n & 1) * 4 + j] = (_Float16)(1.0f - __expf(-e));
                }
            }
            *(h16x8*)(SI + SI_W * SIE + pb) = wo[0]; *(h16x8*)(SI + SI_W * SIE + pb + 8) = wo[1];
        }
        lora(std::integral_constant<int, 64>{}, std::integral_constant<int, 2>{});
        {
            const _Float16* up = ur + h * 64 + fq * 16;
            const _Float16* upp = t > 0 ? up - RWS : up;
            h16x8 kc[2], rc[2], vc[2], kp[2], rp[2], vp[2];
#pragma unroll
            for (int i = 0; i < 2; ++i) {
                rc[i] = *(const h16x8*)(up + i * 8); kc[i] = *(const h16x8*)(up + 512 + i * 8); vc[i] = *(const h16x8*)(up + 1024 + i * 8);
                rp[i] = *(const h16x8*)(upp + i * 8); kp[i] = *(const h16x8*)(upp + 512 + i * 8); vp[i] = *(const h16x8*)(upp + 1024 + i * 8);
            }
            float kv[4][4], av[4][4], kkr[4][4]; float ss = 0.f;
            h16x8 ro[2];
#pragma unroll
            for (int n = 0; n < 4; ++n) {
                const int c = n * 16 + fq * 4, c512 = h * 64 + c;
                const f32x4 muk = *(const f32x4*)(mu + 512 + c512), mur = *(const f32x4*)(mu + c512), muv = *(const f32x4*)(mu + 1024 + c512);
                const f32x4 ab = *(const f32x4*)(p.in[9] + c512), kkw = *(const f32x4*)(p.in[11] + c512);
                h16x4 vo;
#pragma unroll
                for (int j = 0; j < 4; ++j) {
                    const int i = n >> 1, e = (n & 1) * 4 + j;
                    const float kcf = (float)kc[i][e], kpf = t > 0 ? (float)kp[i][e] : 0.f;
                    const float rcf = (float)rc[i][e], rpf = t > 0 ? (float)rp[i][e] : 0.f;
                    const float vcf = (float)vc[i][e], vpf = t > 0 ? (float)vp[i][e] : 0.f;
                    kv[n][j] = kcf + muk[j] * (kpf - kcf);
                    ro[i][e] = (_Float16)(rcf + mur[j] * (rpf - rcf));
                    vo[j] = (_Float16)(vcf + muv[j] * (vpf - vcf));
                    av[n][j] = sigmoidf_(ab[j] + acc[n][j]);
                    kkr[n][j] = kv[n][j] * kkw[j];
                    ss += kkr[n][j] * kkr[n][j];
                }
                *(h16x4*)(SI + SI_V * SIE + base + c) = vo;
            }
            *(h16x8*)(SI + SI_R * SIE + pb) = ro[0]; *(h16x8*)(SI + SI_R * SIE + pb + 8) = ro[1];
            ss += __shfl_xor(ss, 16); ss += __shfl_xor(ss, 32);
            const float inv = fminf(__builtin_amdgcn_rsqf(ss), 1e12f);
            h16x8 ko[2], kko[2], bo[2];
#pragma unroll
            for (int n = 0; n < 4; ++n) {
                const f32x4 ka = *(const f32x4*)(p.in[12] + h * 64 + n * 16 + fq * 4);
#pragma unroll
                for (int j = 0; j < 4; ++j) {
                    const int i = n >> 1, e = (n & 1) * 4 + j;
                    const float kk = kkr[n][j] * inv;
                    ko[i][e] = (_Float16)(kv[n][j] * (1.0f + (av[n][j] - 1.0f) * ka[j]));
                    kko[i][e] = (_Float16)kk;
                    bo[i][e] = (_Float16)(kk * av[n][j]);
                }
            }
#pragma unroll
            for (int i = 0; i < 2; ++i) {
                *(h16x8*)(SI + SI_K * SIE + pb + i * 8) = ko[i]; *(h16x8*)(SI + SI_KK * SIE + pb + i * 8) = kko[i]; *(h16x8*)(SI + SI_B * SIE + pb + i * 8) = bo[i];
            }
        }
        lora(std::integral_constant<int, 128>{}, std::integral_constant<int, 4>{});
        {
            u32x4 g0, g1;
            g0.x = pk_bf16(acc[0][0], acc[0][1]); g0.y = pk_bf16(acc[0][2], acc[0][3]); g0.z = pk_bf16(acc[1][0], acc[1][1]); g0.w = pk_bf16(acc[1][2], acc[1][3]);
            g1.x = pk_bf16(acc[2][0], acc[2][1]); g1.y = pk_bf16(acc[2][2], acc[2][3]); g1.z = pk_bf16(acc[3][0], acc[3][1]); g1.w = pk_bf16(acc[3][2], acc[3][3]);
            *(u32x4*)(G + pb) = g0; *(u32x4*)(G + pb + 8) = g1;
        }
        asm volatile("s_waitcnt lgkmcnt(0)" ::: "memory");
        __builtin_amdgcn_wave_barrier();
    }
}
__device__ __forceinline__ void phase2_kmax(const Params& p, int item) {
    unsigned char* ws = p.ws;
    const int bh = item >> 2, qr = item & 3, tid = threadIdx.x;
    float* red = (float*)(smem + P2_AL + 8 * 16 * ALD * 2);
    float ss = 0.f;
    for (int t = qr * 2052 + tid; t < (qr + 1) * 2052; t += 512) {
        const bf16_t* kr = (const bf16_t*)(ws + R_QKV) + QKV_ONE / 2 + ((size_t)bh * TP + t) * 64;
        float s1 = 0.f;
#pragma unroll
        for (int q = 0; q < 8; ++q) {
            const u32x4 v = *(const u32x4*)(kr + q * 8);
#pragma unroll
            for (int e = 0; e < 4; ++e) { const float lo = __uint_as_float(v[e] << 16), hi = __uint_as_float(v[e] & 0xffff0000u); s1 += lo * lo + hi * hi; }
        }
        ss = fmaxf(ss, s1);
    }
#pragma unroll
    for (int o = 1; o < 64; o <<= 1) ss = fmaxf(ss, __shfl_xor(ss, o));
    __syncthreads();
    if ((tid & 63) == 0) red[tid >> 6] = ss;
    __syncthreads();
    if (tid == 0) {
        float m = red[0];
#pragma unroll
        for (int w = 1; w < 8; ++w) m = fmaxf(m, red[w]);
        ((float*)(ws + WS_CTL))[16 + item] = m;
    }
}
__device__ __forceinline__ void phase2(const Params& p) {
    phase2_main(p);
}

constexpr int SC_TC = 32, SC_NC = (T + SC_TC - 1) / SC_TC;
constexpr int SC_ARR = SC_TC * 64;
constexpr int SC_VOFF = 5 * SC_ARR, SC_COFF = SC_VOFF + SC_TC * 16;
constexpr int SC_BUF = (SC_COFF + SC_TC) * 4;
constexpr int SC_YOFF = 2 * SC_BUF, SC_YBUF = SC_TC * 16 * 4;
__device__ __forceinline__ float dot4(const f32x4& a, const f32x4& b) {
    f32x2 t = __builtin_shufflevector(a, a, 0, 1) * __builtin_shufflevector(b, b, 0, 1);
    t = __builtin_shufflevector(a, a, 2, 3) * __builtin_shufflevector(b, b, 2, 3) + t;
    return t[0] + t[1];
}
__device__ __forceinline__ void reduce16x2(float& a, float& b) {
    a += dppf<0xB1>(a); b += dppf<0xB1>(b); a += dppf<0x4E>(a); b += dppf<0x4E>(b);
    a += dppf<0x141>(a); b += dppf<0x141>(b); a += dppf<0x140>(a); b += dppf<0x140>(b);
}
__device__ __forceinline__ void scan_unit(const Params& p, int unit) {
    unsigned char* ws = p.ws;
    const int bh = unit >> 2, vr0 = (unit & 3) * 16, tid = threadIdx.x, wave = tid >> 6, lane = tid & 63;
    const _Float16* SI = (const _Float16*)(ws + R_SI);
    constexpr size_t SIE = (size_t)MP * 512;
    bf16_t* Y = (bf16_t*)(ws + O_Y);
    const size_t hb = (size_t)bh * TP * 64;
    __syncthreads();
    if (wave >= 4) {
        const int i = tid - 256, ip = i >= 8 ? i - 8 : i;
        const int arrs[5] = {SI_R, SI_W, SI_K, SI_KK, SI_B};
        u32x4 rg[5], rp[3]; unsigned rv;
        auto issue = [&](int c) {
            const size_t off = hb + (size_t)c * SC_TC * 64;
#pragma unroll
            for (int a = 0; a < 5; ++a) rg[a] = *(const u32x4*)(SI + arrs[a] * SIE + off + i * 8);
            rp[0] = *(const u32x4*)(SI + SI_W * SIE + off + ip * 8);
            rp[1] = *(const u32x4*)(SI + SI_K * SIE + off + ip * 8);
            rp[2] = *(const u32x4*)(SI + SI_B * SIE + off + ip * 8);
            rv = *(const unsigned*)(SI + SI_V * SIE + off + (i >> 3) * 64 + vr0 + (i & 7) * 2);
        };
        auto commit = [&](int bufi) {
            float* buf = (float*)(smem + bufi * SC_BUF);
            float f[5][8];
#pragma unroll
            for (int a = 0; a < 5; ++a) {
                const h16x8 hv = __builtin_bit_cast(h16x8, rg[a]);
#pragma unroll
                for (int e = 0; e < 8; ++e) f[a][e] = (float)hv[e];
            }
            const bool odd = (i >> 3) & 1;
            float ckk = 0.f, cbk = 0.f;
            {
                const h16x8 pw = __builtin_bit_cast(h16x8, rp[0]), pk = __builtin_bit_cast(h16x8, rp[1]), pb = __builtin_bit_cast(h16x8, rp[2]);
#pragma unroll
                for (int e = 0; e < 8; ++e) {
                    const float kk2 = f[3][e];
                    ckk += (float)pk[e] * kk2; cbk += (float)pb[e] * kk2;
                    if (odd) f[3][e] = (1.0f - (float)pw[e]) * kk2;
                }
            }
            ckk += dppf<0xB1>(ckk); cbk += dppf<0xB1>(cbk); ckk += dppf<0x4E>(ckk); cbk += dppf<0x4E>(cbk); ckk += dppf<0x141>(ckk); cbk += dppf<0x141>(cbk);
#pragma unroll
            for (int a = 0; a < 5; ++a) {
                f32x4 lo, hi;
#pragma unroll
                for (int e = 0; e < 4; ++e) { lo[e] = f[a][e]; hi[e] = f[a][4 + e]; }
                if (a == 1) { lo = 1.0f - lo; hi = 1.0f - hi; }
                if (a == 4) { lo = -lo; hi = -hi; }
                *(f32x4*)(buf + a * SC_ARR + i * 8) = lo; *(f32x4*)(buf + a * SC_ARR + i * 8 + 4) = hi;
            }
            const h16x2 v2 = __builtin_bit_cast(h16x2, rv);
            f32x2 vf; vf[0] = (float)v2[0]; vf[1] = (float)v2[1];
            *(f32x2*)(buf + SC_VOFF + (i >> 3) * 16 + (i & 7) * 2) = vf;
            if (odd && (i & 7) == 0) { f32x2 cf; cf[0] = ckk; cf[1] = cbk; *(f32x2*)(buf + SC_COFF + (i >> 4) * 2) = cf; }
        };
        auto yout = [&](int c) {
            const float* yb = (const float*)(smem + SC_YOFF + (c & 1) * SC_YBUF);
            const f32x2 v = *(const f32x2*)(yb + (i >> 3) * 16 + (i & 7) * 2);
            *(unsigned*)(Y + hb + (size_t)(c * SC_TC + (i >> 3)) * 64 + vr0 + (i & 7) * 2) = pk_bf16(v[0], v[1]);
        };
        issue(0); commit(0); issue(1);
        __syncthreads();
        for (int c = 0; c < SC_NC; ++c) {
            if (c > 0) yout(c - 1);
            if (c + 1 < SC_NC) commit((c + 1) & 1);
            if (c + 2 < SC_NC) issue(c + 2);
            __syncthreads();
        }
        yout(SC_NC - 1);
    } else {
        const int rl = wave * 4 + (lane >> 4), sub = lane & 15;
        const bool odd_lane = lane & 1; const int yoff = (lane & 1) * 16 + rl;
        f32x4 S = {0.f, 0.f, 0.f, 0.f};
        __syncthreads();
        for (int c = 0; c < SC_NC; ++c) {
            const float* buf = (const float*)(smem + (c & 1) * SC_BUF);
            float* yb = (float*)(smem + SC_YOFF + (c & 1) * SC_YBUF);
            const float* bp = buf + sub * 4;
#define SC_LD(arr, s) (*(const f32x4*)(bp + (arr) * SC_ARR + (s) * 64))
            f32x4 r1 = SC_LD(0, 0), w1 = SC_LD(1, 0), k1 = SC_LD(2, 0), q1 = SC_LD(3, 0), n1 = SC_LD(4, 0);
            f32x4 r2 = SC_LD(0, 1), w2 = SC_LD(1, 1), k2 = SC_LD(2, 1), g2 = SC_LD(3, 1), n2 = SC_LD(4, 1);
            float v1 = buf[SC_VOFF + rl], v2 = buf[SC_VOFF + 16 + rl];
            f32x2 cf = *(const f32x2*)(buf + SC_COFF);
#pragma unroll
            for (int pr = 0; pr < SC_TC / 2; ++pr) {
                const int sn = 2 * pr + 2;
                const f32x4 r1n = SC_LD(0, sn), w1n = SC_LD(1, sn), k1n = SC_LD(2, sn), q1n = SC_LD(3, sn), n1n = SC_LD(4, sn);
                const f32x4 r2n = SC_LD(0, sn + 1), w2n = SC_LD(1, sn + 1), k2n = SC_LD(2, sn + 1), g2n = SC_LD(3, sn + 1), n2n = SC_LD(4, sn + 1);
                const float v1n = buf[SC_VOFF + sn * 16 + rl], v2n = buf[SC_VOFF + (sn + 1) * 16 + rl];
                const f32x2 cfn = *(const f32x2*)(buf + SC_COFF + (pr + 1) * 2);
                __builtin_amdgcn_sched_barrier(0x7);
                float d1 = dot4(S, q1), e2 = dot4(S, g2);
                const f32x4 t1 = S * w1 + v1 * k1;
                reduce16x2(d1, e2);
                const float d2 = e2 + v1 * cf[0] - d1 * cf[1];
                const f32x4 S1 = t1 + d1 * n1;
                const f32x4 S2 = (S1 * w2 + v2 * k2) + d2 * n2;
                float y1 = dot4(S1, r1), y2 = dot4(S2, r2);
                y1 += dppf<0xB1>(y1); y2 += dppf<0xB1>(y2);
                float yz = odd_lane ? y2 : y1;
                yz += dppf<0x122>(yz); yz += dppf<0x124>(yz); yz += dppf<0x128>(yz);
                yb[(2 * pr) * 16 + yoff] = yz;
                S = S2;
                r1 = r1n; w1 = w1n; k1 = k1n; q1 = q1n; n1 = n1n; r2 = r2n; w2 = w2n; k2 = k2n; g2 = g2n; n2 = n2n; v1 = v1n; v2 = v2n; cf = cfn;
            }
#undef SC_LD
            __syncthreads();
        }
    }
}

constexpr int KLD = 72;
__device__ __forceinline__ void attn_unit(const Params& p, int unit) {
    unsigned char* ws = p.ws;
    const int qt = unit % 65, bh = unit / 65, b = bh >> 3, h = bh & 7;
    const int tid = threadIdx.x, wave = tid >> 6, lane = tid & 63, fr = lane & 15, fq = lane >> 4;
    const bf16_t* Q = (const bf16_t*)(ws + R_QKV) + (size_t)bh * TP * 64;
    const bf16_t* Kg = Q + QKV_ONE / 2;
    const bf16_t* Vg = Q + QKV_ONE;
    bf16_t* Ks = (bf16_t*)smem;
    bf16_t* Vt = Ks + 64 * KLD;
    volatile int* flags = (volatile int*)(smem + 2 * 64 * KLD * 2);
    const int t0 = qt * 128, tq = t0 + wave * 16 + fr;
    bf16x8 qf[2];
    qf[0] = *(const bf16x8*)(Q + (size_t)tq * 64 + fq * 8);
    qf[1] = *(const bf16x8*)(Q + (size_t)tq * 64 + 32 + fq * 8);
    float qs = 0.f;
#pragma unroll
    for (int s = 0; s < 2; ++s)
#pragma unroll
        for (int e = 0; e < 8; ++e) { const float f = bf2f((unsigned short)qf[s][e]); qs += f * f; }
    qs += __shfl_xor(qs, 16); qs += __shfl_xor(qs, 32);
    const f32x4 km4 = *(const f32x4*)((const float*)(ws + WS_CTL) + 16 + bh * 4);
    const float kmax = sqrtf(fmaxf(fmaxf(km4[0], km4[1]), fmaxf(km4[2], km4[3])));
    const float zb = sqrtf(qs) * kmax * 1.0001f + 88.0f;
    float Arow = 0.f;
    f32x4 O[4];
#pragma unroll
    for (int nd = 0; nd < 4; ++nd) O[nd] = (f32x4){0.f, 0.f, 0.f, 0.f};
    for (int kb = qt * 2 + 1; kb >= 0; --kb) {
        const bool done = __all(Arow > zb);
        if (lane == 0) flags[wave] = done ? 1 : 0;
        __syncthreads();
        int alld = 1;
#pragma unroll
        for (int w = 0; w < 8; ++w) alld &= flags[w];
        if (alld) break;
        {
            const int key = tid >> 3, dc = (tid & 7) * 8;
            const u32x4 kvv = *(const u32x4*)(Kg + (size_t)(kb * 64 + key) * 64 + dc);
            const u32x4 vvv = *(const u32x4*)(Vg + (size_t)(kb * 64 + key) * 64 + dc);
            *(u32x4*)(Ks + key * KLD + dc) = kvv;
#pragma unroll
            for (int e = 0; e < 4; ++e) { Vt[(dc + 2 * e) * KLD + key] = (bf16_t)(vvv[e] & 0xffffu); Vt[(dc + 2 * e + 1) * KLD + key] = (bf16_t)(vvv[e] >> 16); }
        }
        __syncthreads();
        f32x4 z[4];
#pragma unroll
        for (int n = 0; n < 4; ++n) {
            z[n] = (f32x4){0.f, 0.f, 0.f, 0.f};
#pragma unroll
            for (int s = 0; s < 2; ++s) {
                const bf16x8 kf = *(const bf16x8*)(Ks + (n * 16 + fr) * KLD + s * 32 + fq * 8);
                z[n] = __builtin_amdgcn_mfma_f32_16x16x32_bf16(kf, qf[s], z[n], 0, 0, 0);
            }
        }
        float sp[4][4], lt[4], ex[4], sg[4];
#pragma unroll
        for (int n = 0; n < 4; ++n) {
#pragma unroll
            for (int j = 0; j < 4; ++j) { const int s = kb * 64 + n * 16 + fq * 4 + j; sp[n][j] = s < tq ? softplusf_(z[n][j]) : 0.f; }
            sp[n][2] += sp[n][3]; sp[n][1] += sp[n][2]; sp[n][0] += sp[n][1];
            lt[n] = sp[n][0];
            const float a = __shfl_xor(lt[n], 16), pr = lt[n] + a, c = __shfl_xor(pr, 32);
            ex[n] = fq == 3 ? 0.f : (fq == 2 ? a : (fq == 1 ? c : a + c));
            sg[n] = pr + c;
        }
        float nsuf[4]; nsuf[3] = 0.f; nsuf[2] = sg[3]; nsuf[1] = nsuf[2] + sg[2]; nsuf[0] = nsuf[1] + sg[1];
        float wgt[4][4];
#pragma unroll
        for (int n = 0; n < 4; ++n)
#pragma unroll
            for (int j = 0; j < 4; ++j) {
                const int s = kb * 64 + n * 16 + fq * 4 + j;
                const float C = Arow + nsuf[n] + ex[n] + sp[n][j];
                wgt[n][j] = s < tq ? __expf(z[n][j] - C) : 0.f;
            }
        Arow += nsuf[0] + sg[0];
#pragma unroll
        for (int ks = 0; ks < 2; ++ks) {
            u32x4 pw; pw.x = pk_bf16(wgt[2 * ks][0], wgt[2 * ks][1]); pw.y = pk_bf16(wgt[2 * ks][2], wgt[2 * ks][3]);
            pw.z = pk_bf16(wgt[2 * ks + 1][0], wgt[2 * ks + 1][1]); pw.w = pk_bf16(wgt[2 * ks + 1][2], wgt[2 * ks + 1][3]);
            const bf16x8 pf = __builtin_bit_cast(bf16x8, pw);
#pragma unroll
            for (int nd = 0; nd < 4; ++nd) {
                u32x4 vw;
                const u32x2 v0 = *(const u32x2*)(Vt + (nd * 16 + fr) * KLD + (2 * ks) * 16 + fq * 4);
                const u32x2 v1 = *(const u32x2*)(Vt + (nd * 16 + fr) * KLD + (2 * ks + 1) * 16 + fq * 4);
                vw.x = v0.x; vw.y = v0.y; vw.z = v1.x; vw.w = v1.y;
                O[nd] = __builtin_amdgcn_mfma_f32_16x16x32_bf16(pf, __builtin_bit_cast(bf16x8, vw), O[nd], 0, 0, 0);
            }
        }
    }
    __syncthreads();
    bf16_t* osb = (bf16_t*)(ws + O_OSB);
#pragma unroll
    for (int j = 0; j < 4; ++j) {
        const int t = t0 + wave * 16 + fq * 4 + j;
        if (t >= NMETA && t < T) {
#pragma unroll
            for (int nd = 0; nd < 4; ++nd) osb[(size_t)(b * SEQ + t - NMETA) * 512 + h * 64 + nd * 16 + fr] = (bf16_t)(pk_bf16(O[nd][j], 0.f) & 0xffffu);
        }
    }
}

constexpr int N_SCAN = 128, N_ATTN = 32 * 65;
__device__ __forceinline__ void sub_barrier(unsigned* ctr, unsigned target, bool arrive) {
    asm volatile("s_waitcnt vmcnt(0)" ::: "memory");
    __syncthreads();
    if (threadIdx.x == 0) {
        if (arrive) { __builtin_amdgcn_fence(__ATOMIC_RELEASE, "agent"); asm volatile("s_waitcnt vmcnt(0)" ::: "memory"); (void)xb_add(ctr, 1u); }
        unsigned sp = 0u;
        while (xb_ld(ctr) < target) { __builtin_amdgcn_s_sleep(2); if (++sp > (1u << 22)) break; }
        __builtin_amdgcn_fence(__ATOMIC_ACQUIRE, "agent");
        asm volatile("s_waitcnt vmcnt(0)" ::: "memory");
    }
    __syncthreads();
}
__device__ __forceinline__ void phase3(const Params& p) {
    unsigned char* ws = p.ws;
    unsigned* ctl = (unsigned*)(ws + WS_CTL);
    const int nother = (int)gridDim.x - N_SCAN;
    if ((int)blockIdx.x < N_SCAN) {
        scan_unit(p, blockIdx.x);
    } else {
        EpiInProj epi{(bf16_t*)(ws + R_QKV), (_Float16*)(ws + R_URW), (bf16_t*)p.out};
        gemm_phase((const bf16_t*)(ws + O_A0), (const bf16_t*)(ws + WS_WIN), D, MP / BM, 14, epi, nother, (int)blockIdx.x - N_SCAN, 6, 7);
        sub_barrier(ctl + 256, (unsigned)nother, true);
        for (int it = (int)blockIdx.x - N_SCAN; it < 128; it += nother) phase2_kmax(p, it);
        sub_barrier(ctl + 320, (unsigned)nother, true);
    }
    sub_barrier(ctl + 320, (unsigned)nother, false);
    volatile int* slot = (volatile int*)(smem + 131072 - 16);
    for (;;) {
        __syncthreads();
        if (threadIdx.x == 0) *slot = (int)atomicAdd(ctl, 1u);
        __syncthreads();
        const int u = *slot;
        if (u >= N_ATTN) break;
        attn_unit(p, u);
    }
}

__device__ __forceinline__ void phase3c(const Params& p) {
    unsigned char* ws = p.ws;
    const _Float16* SI = (const _Float16*)(ws + R_SI);
    constexpr size_t SIE = (size_t)MP * 512;
    const bf16_t* Y = (const bf16_t*)(ws + O_Y);
    const bf16_t* G = (const bf16_t*)(ws + R_G);
    bf16_t* orw = (bf16_t*)(ws + O_ORW);
    const int tid = threadIdx.x, sub = tid & 15;
    constexpr int U = 4;
    for (int it = blockIdx.x; it < 32 * 64; it += gridDim.x) {
        const int bh = it >> 6, c4 = it & 63, b = bh >> 3, h = bh & 7;
        const int c = h * 64 + sub * 4;
        const f32x4 gain = *(const f32x4*)(p.in[14] + c), bias = *(const f32x4*)(p.in[15] + c), rk = *(const f32x4*)(p.in[13] + c);
        u32x2 yb2[U]; f32x4 y[U]; h16x4 r4[U], k4[U], v4[U]; u32x2 g2[U];
#pragma unroll
        for (int u = 0; u < U; ++u) {
            const int t = NMETA + (c4 * U + u) * 32 + (tid >> 4);
            const size_t base = ((size_t)bh * TP + t) * 64 + sub * 4;
            const size_t pbase = ((size_t)bh * TP + t) * 64 + (sub & 3) * 16 + (sub >> 2) * 4;
            yb2[u] = *(const u32x2*)(Y + base);
            r4[u] = *(const h16x4*)(SI + SI_R * SIE + pbase); k4[u] = *(const h16x4*)(SI + SI_K * SIE + pbase); v4[u] = *(const h16x4*)(SI + SI_V * SIE + base);
            g2[u] = *(const u32x2*)(G + pbase);
        }
#pragma unroll
        for (int u = 0; u < U; ++u) {
            const int t = NMETA + (c4 * U + u) * 32 + (tid >> 4);
            y[u][0] = __uint_as_float(yb2[u].x << 16); y[u][1] = __uint_as_float(yb2[u].x & 0xffff0000u); y[u][2] = __uint_as_float(yb2[u].y << 16); y[u][3] = __uint_as_float(yb2[u].y & 0xffff0000u);
            const float mean = reduce16((y[u][0] + y[u][1]) + (y[u][2] + y[u][3])) * (1.0f / 64.0f);
            const f32x4 dy = y[u] - mean;
            const float var = reduce16((dy[0] * dy[0] + dy[1] * dy[1]) + (dy[2] * dy[2] + dy[3] * dy[3])) * (1.0f / 64.0f);
            const float rs = rsqrtf(var + GN_EPS);
            float bs = 0.f;
#pragma unroll
            for (int j = 0; j < 4; ++j) bs += (float)r4[u][j] * (float)k4[u][j] * rk[j];
            bs = reduce16(bs);
            const float gg[4] = {__uint_as_float(g2[u].x << 16), __uint_as_float(g2[u].x & 0xffff0000u), __uint_as_float(g2[u].y << 16), __uint_as_float(g2[u].y & 0xffff0000u)};
            float o[4];
#pragma unroll
            for (int j = 0; j < 4; ++j) o[j] = (dy[j] * rs * gain[j] + bias[j] + bs * (float)v4[u][j]) * gg[j];
            u32x2 w; w.x = pk_bf16(o[0], o[1]); w.y = pk_bf16(o[2], o[3]);
            *(u32x2*)(orw + (size_t)(b * SEQ + t - NMETA) * 512 + c) = w;
        }
    }
}

__device__ __forceinline__ void phase4(const Params& p) {
    unsigned char* ws = p.ws;
    EpiBranch1 e1{(float*)(ws + O_T1), (const bf16_t*)p.out};
    EpiBranch2 e2{(const float*)(ws + O_T1), (const bf16_t*)p.out, (bf16_t*)(ws + O_M)};
    gemm_phase((const bf16_t*)(ws + O_OSB), (const bf16_t*)(ws + WS_WSB), 512, MS / BM, D / BM, e1);
    gemm_phase((const bf16_t*)(ws + O_ORW), (const bf16_t*)(ws + WS_WRW), 512, MS / BM, D / BM, e2);
}
__device__ __forceinline__ void phase5(const Params& p) {
    unsigned char* ws = p.ws;
    EpiF32 e{(float*)(ws + O_P)};
    gemm_phase((const bf16_t*)(ws + O_M), (const bf16_t*)(ws + WS_WOUT), D, MS / BM, D / BM, e);
}
__device__ __forceinline__ void phase6(const Params& p) {
    unsigned char* ws = p.ws;
    const int lane = threadIdx.x & 63;
    f32x4 g1[4], g2[4];
#pragma unroll
    for (int j = 0; j < 4; ++j) { g1[j] = *(const f32x4*)(p.in[3] + 4 * lane + 256 * j); g2[j] = *(const f32x4*)(p.in[19] + 4 * lane + 256 * j); }
    for (int it = blockIdx.x; it < MS / 16; it += gridDim.x) {
        const int row0 = it * 16 + (threadIdx.x >> 6) * 2;
        f32x4 v[2][4], x[2][4];
#pragma unroll
        for (int r = 0; r < 2; ++r)
#pragma unroll
            for (int j = 0; j < 4; ++j) {
                v[r][j] = *(const f32x4*)((const float*)(ws + O_P) + (size_t)(row0 + r) * D + 4 * lane + 256 * j);
                x[r][j] = *(const f32x4*)(p.in[0] + (size_t)(row0 + r) * D + 4 * lane + 256 * j);
            }
#pragma unroll
        for (int r = 0; r < 2; ++r) {
            const int row = row0 + r;
            float ss = 0.f;
#pragma unroll
            for (int j = 0; j < 4; ++j) ss += (v[r][j][0] * v[r][j][0] + v[r][j][1] * v[r][j][1]) + (v[r][j][2] * v[r][j][2] + v[r][j][3] * v[r][j][3]);
            const float rs = rsqrtf(wave_sum(ss) * (1.0f / D) + RMS_EPS);
            float s2 = 0.f;
#pragma unroll
            for (int j = 0; j < 4; ++j) {
                v[r][j] = x[r][j] + v[r][j] * rs * g1[j];
                *(f32x4*)(p.out + (size_t)row * D + 4 * lane + 256 * j) = v[r][j];
                s2 += (v[r][j][0] * v[r][j][0] + v[r][j][1] * v[r][j][1]) + (v[r][j][2] * v[r][j][2] + v[r][j][3] * v[r][j][3]);
            }
            const float rs2 = rsqrtf(wave_sum(s2) * (1.0f / D) + RMS_EPS);
            bf16_t* fr_ = (bf16_t*)(ws + O_F) + (size_t)row * D;
#pragma unroll
            for (int j = 0; j < 4; ++j) {
                u32x2 w; w.x = pk_bf16(v[r][j][0] * rs2 * g2[j][0], v[r][j][1] * rs2 * g2[j][1]); w.y = pk_bf16(v[r][j][2] * rs2 * g2[j][2], v[r][j][3] * rs2 * g2[j][3]);
                *(u32x2*)(fr_ + 4 * lane + 256 * j) = w;
            }
        }
    }
}
__device__ __forceinline__ void phase7(const Params& p) {
    unsigned char* ws = p.ws;
    EpiGU e{(bf16_t*)(ws + O_ACT)};
    gemm_phase((const bf16_t*)(ws + O_F), (const bf16_t*)(ws + WS_WGU), D, MS / BM, 2 * DFF / BM, e);
}
__device__ __forceinline__ void phase8(const Params& p) {
    unsigned char* ws = p.ws;
    EpiF32 e{(float*)(ws + O_DN)};
    gemm_phase((const bf16_t*)(ws + O_ACT), (const bf16_t*)(ws + WS_WD), DFF, MS / BM, D / BM, e);
}
__device__ __forceinline__ void phase9(const Params& p) {
    unsigned char* ws = p.ws;
    const int lane = threadIdx.x & 63;
    f32x4 g[4];
#pragma unroll
    for (int j = 0; j < 4; ++j) g[j] = *(const f32x4*)(p.in[20] + 4 * lane + 256 * j);
    for (int it = blockIdx.x; it < MS / 16; it += gridDim.x) {
        const int row0 = it * 16 + (threadIdx.x >> 6) * 2;
        f32x4 v[2][4], h1[2][4];
#pragma unroll
        for (int r = 0; r < 2; ++r)
#pragma unroll
            for (int j = 0; j < 4; ++j) {
                v[r][j] = *(const f32x4*)((const float*)(ws + O_DN) + (size_t)(row0 + r) * D + 4 * lane + 256 * j);
                h1[r][j] = *(const f32x4*)(p.out + (size_t)(row0 + r) * D + 4 * lane + 256 * j);
            }
#pragma unroll
        for (int r = 0; r < 2; ++r) {
            float ss = 0.f;
#pragma unroll
            for (int j = 0; j < 4; ++j) ss += (v[r][j][0] * v[r][j][0] + v[r][j][1] * v[r][j][1]) + (v[r][j][2] * v[r][j][2] + v[r][j][3] * v[r][j][3]);
            const float rs = rsqrtf(wave_sum(ss) * (1.0f / D) + RMS_EPS);
#pragma unroll
            for (int j = 0; j < 4; ++j) *(f32x4*)(p.out + (size_t)(row0 + r) * D + 4 * lane + 256 * j) = h1[r][j] + v[r][j] * rs * g[j];
        }
    }
}

constexpr int N_PHASES = 11;
__device__ __forceinline__ void run_phase(const Params& p, int ph) {
    switch (ph) {
        case 0: phase0(p); break;
        case 1: phase1(p); break;
        case 2: phase2(p); break;
        case 3: phase3(p); break;
        case 4: phase3c(p); break;
        case 5: phase4(p); break;
        case 6: phase5(p); break;
        case 7: phase6(p); break;
        case 8: phase7(p); break;
        case 9: phase8(p); break;
        default: phase9(p); break;
    }
}

#if MULTI_LAUNCH
template <int PH> __global__ void __launch_bounds__(512) fwd_phase(Params p) { run_phase(p, PH); }
#else
__global__ void __launch_bounds__(512) fwd_mega(Params p) {
    cg::grid_group grid = cg::this_grid();
    volatile LAS unsigned* st = (volatile LAS unsigned*)(smem + 131072);
    if (threadIdx.x == 0) { st[0] = 0u; st[1] = 0u; }
    __syncthreads();
    const XcdBarrier xb = xcd_barrier_post((unsigned*)(p.ws + WS_BAR), st);
    if (p.out == nullptr) grid.sync();
    phase0(p); xcd_barrier(xb); phase1(p); xcd_barrier(xb); phase2(p); xcd_barrier(xb); phase3(p); xcd_barrier(xb); phase3c(p); xcd_barrier(xb);
    phase4(p); xcd_barrier(xb); phase5(p); xcd_barrier(xb); phase6(p); xcd_barrier(xb); phase7(p); xcd_barrier(xb); phase8(p); xcd_barrier(xb); phase9(p);
}
#endif

extern "C" void kernel_launch(void* const* d_in, const int* in_sizes, int n_in, void* d_out, int out_size, void* d_ws, size_t ws_size, hipStream_t stream) {
    static int grid = 0;
    if (grid == 0) {
        if (n_in != 24 || out_size != MS * D || ws_size < WS_END) { fprintf(stderr, "kernel_launch: unexpected shapes (n_in %d out %d ws %zu need %zu)\n", n_in, out_size, ws_size, (size_t)WS_END); grid = -1; return; }
        int dev = 0, cus = 0, per_cu = 0;
        (void)hipGetDevice(&dev);
        (void)hipDeviceGetAttribute(&cus, hipDeviceAttributeMultiprocessorCount, dev);
#if MULTI_LAUNCH
        per_cu = 1;
#else
        (void)hipFuncSetAttribute((const void*)fwd_mega, hipFuncAttributeMaxDynamicSharedMemorySize, LDS_BYTES);
        (void)hipOccupancyMaxActiveBlocksPerMultiprocessor(&per_cu, (const void*)fwd_mega, 512, LDS_BYTES);
        if (per_cu < 1) { fprintf(stderr, "kernel_launch: occupancy query says %d blocks per CU\n", per_cu); per_cu = 1; }
        if (per_cu > 1) per_cu = 1;
#endif
        grid = cus * per_cu;
        if (grid <= N_SCAN) { fprintf(stderr, "kernel_launch: grid %d too small (needs more than %d workgroups)\n", grid, N_SCAN); grid = -1; return; }
    }
    if (grid < 0) return;
    Params p{};
    for (int i = 0; i < 24; ++i) p.in[i] = (const float*)d_in[i];
    p.out = (float*)d_out; p.ws = (unsigned char*)d_ws;
#if MULTI_LAUNCH
#define LP(PH) do { (void)hipFuncSetAttribute((const void*)fwd_phase<PH>, hipFuncAttributeMaxDynamicSharedMemorySize, LDS_BYTES); hipLaunchKernelGGL(fwd_phase<PH>, dim3(grid), dim3(512), LDS_BYTES, stream, p); } while (0)
    LP(0); LP(1); LP(2); LP(3); LP(4); LP(5); LP(6); LP(7); LP(8); LP(9); LP(10);
#undef LP
#else
    if (hipMemsetAsync(d_ws, 0, WS_CTL_BYTES, stream) != hipSuccess) { fprintf(stderr, "kernel_launch: hipMemsetAsync of the control words failed\n"); return; }
    void* args[] = {&p};
    hipError_t e = hipLaunchCooperativeKernel((const void*)fwd_mega, dim3(grid), dim3(512), args, LDS_BYTES, stream);
    if (e != hipSuccess) fprintf(stderr, "cooperative launch failed: %s (grid %d)\n", hipGetErrorString(e), grid);
#endif
}
```

```cpp
#include <hip/hip_runtime.h>
#include <hip/hip_cooperative_groups.h>
#include <cstdio>
#include <cstdint>
#include <type_traits>
namespace cg = cooperative_groups;

#ifndef MULTI_LAUNCH
#define MULTI_LAUNCH 0
#endif

typedef unsigned short bf16_t;
typedef short bf16x8 __attribute__((ext_vector_type(8)));
typedef float f32x4 __attribute__((ext_vector_type(4)));
typedef float f32x2 __attribute__((ext_vector_type(2)));
typedef unsigned u32x2 __attribute__((ext_vector_type(2)));
typedef unsigned u32x4 __attribute__((ext_vector_type(4)));
typedef _Float16 h16x2 __attribute__((ext_vector_type(2)));
typedef _Float16 h16x4 __attribute__((ext_vector_type(4)));
typedef _Float16 h16x8 __attribute__((ext_vector_type(8)));

constexpr int D = 1024, NB = 4, SEQ = 8192, NMETA = 16, T = SEQ + NMETA, TP = 8320, MP = NB * TP, MS = NB * SEQ;
constexpr int PIN = 5376, DFF = 2816, NH = 8, RWS = 1792;
constexpr float RMS_EPS = 1e-6f, GN_EPS = 64e-5f;

constexpr size_t WS_CTL = 0;
constexpr size_t WS_BAR = 4096;
constexpr size_t WS_CTL_BYTES = 32768;
constexpr size_t WS_WIN = WS_CTL_BYTES;
constexpr size_t WS_WSB = WS_WIN + (size_t)PIN * D * 2;
constexpr size_t WS_WRW = WS_WSB + (size_t)D * 512 * 2;
constexpr size_t WS_WOUT = WS_WRW + (size_t)D * 512 * 2;
constexpr size_t WS_WGU = WS_WOUT + (size_t)D * D * 2;
constexpr size_t WS_WD = WS_WGU + (size_t)2 * DFF * D * 2;
constexpr size_t WS_WL = WS_WD + (size_t)D * DFF * 2;
constexpr size_t R_A0 = WS_WL + (size_t)512 * 256 * 2;
constexpr size_t R_URW = R_A0 + (size_t)MP * D * 2;
constexpr size_t R_QKV = R_URW;
constexpr size_t QKV_ONE = (size_t)MP * 512 * 2;
constexpr size_t R_SI = R_URW + (size_t)MP * RWS * 2;
constexpr size_t SI_ONE = (size_t)MP * 512 * 2;
constexpr size_t R_G = R_SI + 6 * SI_ONE;
constexpr size_t R_TAIL = R_G + SI_ONE;
constexpr size_t O_Y = R_TAIL;
constexpr size_t O_OSB = R_TAIL + SI_ONE;
constexpr size_t WS_END = O_OSB + (size_t)MS * 512 * 2;
constexpr size_t O_A0 = R_A0;
constexpr size_t O_ORW = R_A0;
constexpr size_t O_T1 = R_SI;
constexpr size_t O_M = R_SI + (size_t)MS * D * 4;
constexpr size_t O_P = R_A0;
constexpr size_t O_F = R_SI;
constexpr size_t O_ACT = R_A0;
constexpr size_t O_DN = R_SI + (size_t)MS * D * 2;
static_assert(3 * QKV_ONE <= (size_t)MP * RWS * 2, "overlay");
static_assert(O_M + (size_t)MS * D * 2 <= R_TAIL, "overlay");
static_assert(O_ACT + (size_t)MS * DFF * 2 <= R_SI, "overlay");
static_assert(O_P + (size_t)MS * D * 4 <= R_SI, "overlay");
static_assert(O_DN + (size_t)MS * D * 4 <= R_TAIL, "overlay");
static_assert(WS_END <= (size_t)512 * 1024 * 1024, "workspace");

constexpr int LDS_BYTES = 131072 + 64;

struct Params { const float* in[24]; float* out; unsigned char* ws; };

extern __shared__ __attribute__((aligned(16))) unsigned char smem[];

typedef __bf16 b16x2 __attribute__((ext_vector_type(2)));
__device__ __forceinline__ unsigned pk_bf16(float lo, float hi) { const f32x2 v = {lo, hi}; return __builtin_bit_cast(unsigned, __builtin_convertvector(v, b16x2)); }
__device__ __forceinline__ float bf2f(unsigned short v) { return __uint_as_float((unsigned)v << 16); }
__device__ __forceinline__ float sigmoidf_(float x) { return __builtin_amdgcn_rcpf(1.0f + __expf(-x)); }
__device__ __forceinline__ float softplusf_(float x) { return fmaxf(x, 0.f) + __logf(1.0f + __expf(-fabsf(x))); }
template <int CTRL> __device__ __forceinline__ float dppf(float x) { return __builtin_bit_cast(float, __builtin_amdgcn_mov_dpp(__builtin_bit_cast(int, x), CTRL, 0xf, 0xf, true)); }
__device__ __forceinline__ float reduce16(float v) {
    v += dppf<0xB1>(v); v += dppf<0x4E>(v); v += dppf<0x141>(v); v += dppf<0x140>(v); return v;
}
__device__ __forceinline__ float wave_sum(float v) {
#pragma unroll
    for (int o = 1; o < 64; o <<= 1) v += __shfl_xor(v, o);
    return v;
}

#define LAS __attribute__((address_space(3)))
#define XB_TMO      128
#define XB_XCNT(j)  (256  + 64 * (j))
#define XB_XSUB(j)  (1280 + 64 * (j))
#define XB_XGEN(j)  (2304 + 64 * (j))
#define XB_TOP      3328
#define XB_TOPGEN   3392
#define XCD_BAR_WORDS 3456
#define XB_SPIN_CAP (1u << 18)
__device__ __forceinline__ unsigned xb_ld(unsigned* p)              { return __hip_atomic_load(p, __ATOMIC_RELAXED, __HIP_MEMORY_SCOPE_AGENT); }
__device__ __forceinline__ unsigned xb_add(unsigned* p, unsigned v) { return __hip_atomic_fetch_add(p, v, __ATOMIC_RELAXED, __HIP_MEMORY_SCOPE_AGENT); }
__device__ __forceinline__ unsigned xb_xcc_id() { return (unsigned)__builtin_amdgcn_s_getreg((3 << 11) | 20) & 0xFu; }
#define XB_SPIN(cond, bar) do { unsigned _sp = 0; while (cond) { __builtin_amdgcn_s_sleep(1); \
    if ((++_sp & 255u) == 0u) { if (xb_ld(&(bar)[XB_TMO])) break; if (_sp > XB_SPIN_CAP) { atomicAdd(&(bar)[XB_TMO], 1u); break; } } } } while (0)
struct XcdBarrier { unsigned* bar; unsigned x; volatile LAS unsigned* st; };
__device__ __forceinline__ XcdBarrier xcd_barrier_post(unsigned* bar, volatile LAS unsigned* st) {
    XcdBarrier b; b.bar = bar; b.x = xb_xcc_id(); b.st = st;
    if (threadIdx.x == 0) (void)xb_add(&bar[XB_XCNT(b.x)], 1u);
    return b;
}
__device__ __forceinline__ void xcd_barrier_complete(unsigned* bar, unsigned x, unsigned& nloc, unsigned& nx) {
    const unsigned G = gridDim.x * gridDim.y * gridDim.z;
    unsigned sum, cnt, mine, sp = 0u;
    for (;;) {
        sum = 0u; cnt = 0u; mine = 0u;
#pragma unroll
        for (unsigned j = 0; j < 16; ++j) { const unsigned c = xb_ld(&bar[XB_XCNT(j)]); sum += c; cnt += (c > 0u) ? 1u : 0u; mine = (j == x) ? c : mine; }
        if (sum == G) break;
        __builtin_amdgcn_s_sleep(1);
        if ((++sp & 255u) == 0u) { if (xb_ld(&bar[XB_TMO])) break; if (sp > XB_SPIN_CAP) { atomicAdd(&bar[XB_TMO], 1u); break; } }
    }
    nloc = mine > 0u ? mine : 1u; nx = cnt > 0u ? cnt : 1u;
}
__device__ __forceinline__ void xcd_barrier(const XcdBarrier& b) {
    asm volatile("s_waitcnt vmcnt(0)" ::: "memory");
    __syncthreads();
    if (threadIdx.x == 0) {
        unsigned* bar = b.bar;
        __builtin_amdgcn_s_waitcnt(0);
        unsigned nloc = b.st[0], nx = b.st[1];
        if (nloc == 0u) { xcd_barrier_complete(bar, b.x, nloc, nx); b.st[0] = nloc; b.st[1] = nx; }
        const unsigned old = xb_add(&bar[XB_XSUB(b.x)], 1u);
        const unsigned gen = old / nloc;
        if (old + 1u == (gen + 1u) * nloc) {
            __builtin_amdgcn_fence(__ATOMIC_RELEASE, "agent");
            asm volatile("s_waitcnt vmcnt(0)" ::: "memory");
            const unsigned og = xb_add(&bar[XB_TOP], 1u);
            const unsigned tg = og / nx;
            if (og + 1u == (tg + 1u) * nx) xb_add(&bar[XB_TOPGEN], 1u);
            else XB_SPIN(xb_ld(&bar[XB_TOPGEN]) == tg, bar);
            __builtin_amdgcn_fence(__ATOMIC_ACQUIRE, "agent");
            xb_add(&bar[XB_XGEN(b.x)], 1u);
            asm volatile("s_waitcnt vmcnt(0)" ::: "memory");
        } else {
            XB_SPIN(xb_ld(&bar[XB_XGEN(b.x)]) == gen, bar);
            __builtin_amdgcn_fence(__ATOMIC_ACQUIRE, "agent");
            asm volatile("s_waitcnt vmcnt(0)" ::: "memory");
        }
    }
    __syncthreads();
}

constexpr int BM = 256, BK = 64, HALF = 128, HTB = HALF * BK * 2, NXCD = 8, WGM = 8;
__device__ __forceinline__ int lds_byte(int r, int c) { const int st = (r >> 4) * 2 + (c >> 5), rr = r & 15, cc = c & 31, ob = rr * 64 + cc * 2; return st * 1024 + (ob ^ (((ob >> 9) & 1) << 5)); }
__device__ __forceinline__ void stage_rc(int b, int& R, int& C) { const int st = b / 1024, sb = b % 1024, swz = sb ^ (((sb >> 9) & 1) << 5); R = (st >> 1) * 16 + swz / 64; C = (st & 1) * 32 + (swz % 64) / 2; }
struct Unit { int pm, pn; };
struct Sched {
    int nM, nN, nwg, G, c;
    __device__ __forceinline__ bool next(int i, Unit& u) const {
        const long L = (long)i * G + c; if (L >= nwg) return false;
        int wgid = (int)L; { const int q = nwg / NXCD, r = nwg % NXCD, xcd = wgid % NXCD, off = wgid / NXCD; wgid = (xcd < r ? xcd * (q + 1) : r * (q + 1) + (xcd - r) * q) + off; }
        const int nig = WGM * nN, gid = wgid / nig, fm = gid * WGM, gsz = (nM - fm) < WGM ? (nM - fm) : WGM;
        u.pm = fm + ((wgid % nig) % gsz); u.pn = (wgid % nig) / gsz; return true;
    }
};

template <class Epi>
__device__ __forceinline__ void gemm_phase(const bf16_t* __restrict__ Ag, const bf16_t* __restrict__ Btg, const int K, const int nM, const int nN, const Epi& E,
                                           const int G = (int)gridDim.x, const int c = (int)blockIdx.x, const int pn_from = 1 << 30, const int pn_add = 0) {
    LAS unsigned char* lds = (LAS unsigned char*)smem;
    const int tid = threadIdx.x, wid = __builtin_amdgcn_readfirstlane(tid >> 6), lane = tid & 63, wr = wid >> 2, wc = wid & 3, fr = lane & 15, fq = lane >> 4;
    const int nt = K / BK;
    Sched S; S.nM = nM; S.nN = nN; S.nwg = nM * nN; S.G = G; S.c = c;
    unsigned voffA[2], voffB[2];
#pragma unroll
    for (int i = 0; i < 2; ++i) { int R, C; stage_rc(tid * 16 + i * 8192, R, C); voffA[i] = (unsigned)(R * K + C) * 2u; voffB[i] = voffA[i]; }
    const size_t kstep = (size_t)(BK * 2);
    const size_t hstep = (size_t)HALF * K * 2;
    const size_t tstep = 2 * hstep;
    const unsigned ldsw = (unsigned)wid * 1024u;
    const int aoff = lds_byte(wr * 64 + fr, fq * 8), boff = lds_byte(wc * 32 + fr, fq * 8);
#define PG8_SA(b, h) (((b) * 2 + (h)) * HTB)
#define PG8_SB(b, h) ((4 + (b) * 2 + (h)) * HTB)
#define PG8_STAGE(bufoff, gbase, voff) do { _Pragma("unroll") for (int _i = 0; _i < 2; ++_i) \
        __builtin_amdgcn_global_load_lds((const unsigned*)((const char*)(gbase) + (voff)[_i]), (LAS unsigned*)(lds + (bufoff) + ldsw + _i * 8192), 16, 0, 0); } while (0)
#define PG8_LDA(dst, b, h) do { _Pragma("unroll") for (int m = 0; m < 4; ++m) _Pragma("unroll") for (int k = 0; k < 2; ++k) dst[m][k] = *(const LAS bf16x8*)(lds + PG8_SA(b, h) + aoff + m * 2048 + k * 1024); } while (0)
#define PG8_LDB(dst, b, h) do { _Pragma("unroll") for (int n = 0; n < 2; ++n) _Pragma("unroll") for (int k = 0; k < 2; ++k) dst[n][k] = *(const LAS bf16x8*)(lds + PG8_SB(b, h) + boff + n * 2048 + k * 1024); } while (0)
#define PG8_MMA(ai, bj, At, Bt) do { __builtin_amdgcn_s_setprio(1); _Pragma("unroll") for (int m = 0; m < 4; ++m) _Pragma("unroll") for (int n = 0; n < 2; ++n) _Pragma("unroll") for (int k = 0; k < 2; ++k) \
        acc[ai][bj][m][n] = __builtin_amdgcn_mfma_f32_16x16x32_bf16(Bt[n][k], At[m][k], acc[ai][bj][m][n], 0, 0, 0); __builtin_amdgcn_s_setprio(0); } while (0)
#define PG8_WAIT_V(n) asm volatile("s_waitcnt vmcnt(" #n ")" ::: "memory")
#define PG8_WAIT_L(n) asm volatile("s_waitcnt lgkmcnt(" #n ")" ::: "memory")
#define PG8_BAR __builtin_amdgcn_s_barrier()
#define PG8_SCHED __builtin_amdgcn_sched_barrier(0)
    Unit cur, nxt; int ui = 0;
    __syncthreads();
    if (!S.next(0, cur)) return;
    if (cur.pn >= pn_from) cur.pn += pn_add;
    f32x4 acc[2][2][4][2];
#pragma unroll
    for (int a = 0; a < 2; ++a)
#pragma unroll
        for (int b = 0; b < 2; ++b)
#pragma unroll
            for (int m = 0; m < 4; ++m)
#pragma unroll
                for (int n = 0; n < 2; ++n) acc[a][b][m][n] = (f32x4){0.f, 0.f, 0.f, 0.f};
    bf16x8 At[4][2], B0[2][2], B1[2][2];
    const char* cA = (const char*)Ag + (size_t)cur.pm * tstep; const char* cB = (const char*)Btg + (size_t)cur.pn * tstep;
    PG8_STAGE(PG8_SB(0, 0), cB, voffB); PG8_STAGE(PG8_SA(0, 0), cA, voffA); PG8_STAGE(PG8_SB(0, 1), cB + hstep, voffB); PG8_STAGE(PG8_SA(0, 1), cA + hstep, voffA);
    if (wr == 1) PG8_BAR;
    PG8_WAIT_V(4); PG8_BAR;
    PG8_STAGE(PG8_SB(1, 0), cB + kstep, voffB); PG8_STAGE(PG8_SA(1, 0), cA + kstep, voffA); PG8_STAGE(PG8_SB(1, 1), cB + hstep + kstep, voffB);
    PG8_WAIT_V(6); PG8_BAR;
    for (;;) {
        const bool has_next = S.next(ui + 1, nxt);
        if (has_next && nxt.pn >= pn_from) nxt.pn += pn_add;
        const char* nA = has_next ? (const char*)Ag + (size_t)nxt.pm * tstep : cA; const char* nB = has_next ? (const char*)Btg + (size_t)nxt.pn * tstep : cB;
        for (int t = 0; t < nt; t += 2) {
            const bool last = (t == nt - 2);
            const char* a1 = cA + (size_t)(t + 1) * kstep;
            const char* a2 = last ? nA : cA + (size_t)(t + 2) * kstep; const char* b2 = last ? nB : cB + (size_t)(t + 2) * kstep;
            const char* a3 = a2 + kstep; const char* b3 = b2 + kstep;
            PG8_LDB(B0, 0, 0); PG8_SCHED; PG8_LDA(At, 0, 0); PG8_STAGE(PG8_SA(1, 1), a1 + hstep, voffA);
            PG8_WAIT_L(8); PG8_BAR; PG8_WAIT_L(0); PG8_MMA(0, 0, At, B0); PG8_BAR; PG8_SCHED;
            PG8_LDB(B1, 0, 1); PG8_STAGE(PG8_SB(0, 0), b2, voffB);
            PG8_BAR; PG8_WAIT_L(0); PG8_MMA(0, 1, At, B1); PG8_BAR;
            PG8_LDA(At, 0, 1); PG8_STAGE(PG8_SA(0, 0), a2, voffA);
            PG8_BAR; PG8_WAIT_L(0); PG8_MMA(1, 0, At, B0); PG8_BAR; PG8_SCHED;
            PG8_STAGE(PG8_SB(0, 1), b2 + hstep, voffB);
            PG8_WAIT_V(6); PG8_BAR; PG8_MMA(1, 1, At, B1); PG8_BAR;
            PG8_LDB(B0, 1, 0); PG8_SCHED; PG8_LDA(At, 1, 0); PG8_STAGE(PG8_SA(0, 1), a2 + hstep, voffA);
            PG8_WAIT_L(8); PG8_BAR; PG8_WAIT_L(0); PG8_MMA(0, 0, At, B0); PG8_BAR; PG8_SCHED;
            PG8_LDB(B1, 1, 1); PG8_STAGE(PG8_SB(1, 0), b3, voffB);
            PG8_BAR; PG8_WAIT_L(0); PG8_MMA(0, 1, At, B1); PG8_BAR;
            PG8_LDA(At, 1, 1); PG8_STAGE(PG8_SA(1, 0), a3, voffA);
            PG8_BAR; PG8_WAIT_L(0); PG8_MMA(1, 0, At, B0); PG8_BAR; PG8_SCHED;
            PG8_STAGE(PG8_SB(1, 1), b3 + hstep, voffB);
            PG8_WAIT_V(6); PG8_BAR; PG8_MMA(1, 1, At, B1); PG8_BAR;
        }
        {
            const int brow = cur.pm * BM, bcol = cur.pn * BM;
#pragma unroll
            for (int ai = 0; ai < 2; ++ai)
#pragma unroll
                for (int m = 0; m < 4; ++m) {
#pragma unroll
                    for (int bj = 0; bj < 2; ++bj)
                        E(brow + ai * HALF + wr * 64 + m * 16 + fr, bcol + bj * HALF + wc * 32, fq, acc[ai][bj][m][0], acc[ai][bj][m][1]);
                    asm volatile("" ::: "memory");
                }
        }
        if (!has_next) break;
#pragma unroll
        for (int a = 0; a < 2; ++a)
#pragma unroll
            for (int b = 0; b < 2; ++b)
#pragma unroll
                for (int m = 0; m < 4; ++m)
#pragma unroll
                    for (int n = 0; n < 2; ++n) acc[a][b][m][n] = (f32x4){0.f, 0.f, 0.f, 0.f};
        cur = nxt; cA = nA; cB = nB; ++ui;
    }
    PG8_WAIT_V(0);
    if (wr == 0) PG8_BAR;
    PG8_BAR;
#undef PG8_SA
#undef PG8_SB
#undef PG8_STAGE
#undef PG8_LDA
#undef PG8_LDB
#undef PG8_MMA
#undef PG8_WAIT_V
#undef PG8_WAIT_L
#undef PG8_BAR
#undef PG8_SCHED
}

struct EpiInProj {
    bf16_t* qkv; _Float16* urw; bf16_t* gates;
    __device__ __forceinline__ void one(int row, int col, const f32x4& v) const {
        if (col < 1536) {
            const int which = col >> 9, hc = col & 511, h = hc >> 6, d = hc & 63, b = row / TP, t = row - b * TP;
            const float s = which == 0 ? 0.125f : 1.0f;
            u32x2 w; w.x = pk_bf16(v[0] * s, v[1] * s); w.y = pk_bf16(v[2] * s, v[3] * s);
            *(u32x2*)(qkv + (size_t)which * (QKV_ONE / 2) + ((size_t)(b * NH + h) * TP + t) * 64 + d) = w;
        } else if (col < 3328) {
            h16x4 o; o[0] = (_Float16)v[0]; o[1] = (_Float16)v[1]; o[2] = (_Float16)v[2]; o[3] = (_Float16)v[3];
            *(h16x4*)(urw + (size_t)row * RWS + (col - 1536)) = o;
        } else {
            const int b = row / TP, t = row - b * TP;
            if (t >= NMETA && t < T) {
                u32x2 w; w.x = pk_bf16(sigmoidf_(v[0]), sigmoidf_(v[1])); w.y = pk_bf16(sigmoidf_(v[2]), sigmoidf_(v[3]));
                *(u32x2*)(gates + (size_t)(b * SEQ + t - NMETA) * 2048 + (col - 3328)) = w;
            }
        }
    }
    __device__ __forceinline__ void operator()(int row, int col32, int fq, const f32x4& v0, const f32x4& v1) const {
        if (col32 >= 1536 && col32 < 3072) {
            const int c = col32 - 1536, pos = (c & ~63) + fq * 16 + ((c & 63) >> 4) * 4;
            h16x8 o;
#pragma unroll
            for (int j = 0; j < 4; ++j) { o[j] = (_Float16)v0[j]; o[4 + j] = (_Float16)v1[j]; }
            *(h16x8*)(urw + (size_t)row * RWS + pos) = o;
        } else { one(row, col32 + 4 * fq, v0); one(row, col32 + 16 + 4 * fq, v1); }
    }
};
struct EpiBranch1 {
    bf16_t* t1; const bf16_t* gates;
    __device__ __forceinline__ void one(int row, int col, const f32x4& v) const {
        const u32x2 g = *(const u32x2*)(gates + (size_t)row * 2048 + col);
        f32x4 o; o[0] = v[0] * __uint_as_float(g.x << 16); o[1] = v[1] * __uint_as_float(g.x & 0xffff0000u); o[2] = v[2] * __uint_as_float(g.y << 16); o[3] = v[3] * __uint_as_float(g.y & 0xffff0000u);
        u32x2 w; w.x = pk_bf16(o[0], o[1]); w.y = pk_bf16(o[2], o[3]);
        *(u32x2*)(t1 + (size_t)row * D + col) = w;
    }
    __device__ __forceinline__ void operator()(int row, int col32, int fq, const f32x4& v0, const f32x4& v1) const { one(row, col32 + 4 * fq, v0); one(row, col32 + 16 + 4 * fq, v1); }
};
struct EpiBranch2 {
    const bf16_t* t1; const bf16_t* gates; bf16_t* m;
    __device__ __forceinline__ void one(int row, int col, const f32x4& v) const {
        const u32x2 g = *(const u32x2*)(gates + (size_t)row * 2048 + 1024 + col);
        const u32x2 ta = *(const u32x2*)(t1 + (size_t)row * D + col);
        const f32x4 a = {__uint_as_float(ta.x << 16), __uint_as_float(ta.x & 0xffff0000u), __uint_as_float(ta.y << 16), __uint_as_float(ta.y & 0xffff0000u)};
        f32x4 o; o[0] = a[0] + v[0] * __uint_as_float(g.x << 16); o[1] = a[1] + v[1] * __uint_as_float(g.x & 0xffff0000u); o[2] = a[2] + v[2] * __uint_as_float(g.y << 16); o[3] = a[3] + v[3] * __uint_as_float(g.y & 0xffff0000u);
        u32x2 w; w.x = pk_bf16(o[0], o[1]); w.y = pk_bf16(o[2], o[3]);
        *(u32x2*)(m + (size_t)row * D + col) = w;
    }
    __device__ __forceinline__ void operator()(int row, int col32, int fq, const f32x4& v0, const f32x4& v1) const { one(row, col32 + 4 * fq, v0); one(row, col32 + 16 + 4 * fq, v1); }
};
struct EpiF32 {
    float* o;
    __device__ __forceinline__ void operator()(int row, int col32, int fq, const f32x4& v0, const f32x4& v1) const {
        *(f32x4*)(o + (size_t)row * D + col32 + 4 * fq) = v0; *(f32x4*)(o + (size_t)row * D + col32 + 16 + 4 * fq) = v1;
    }
};
struct EpiGU {
    bf16_t* act;
    __device__ __forceinline__ void operator()(int row, int col32, int fq, const f32x4& v0, const f32x4& v1) const {
        float o[4];
#pragma unroll
        for (int j = 0; j < 4; ++j) o[j] = v0[j] * sigmoidf_(v0[j]) * v1[j];
        u32x2 w; w.x = pk_bf16(o[0], o[1]); w.y = pk_bf16(o[2], o[3]);
        *(u32x2*)(act + (size_t)row * DFF + (col32 >> 5) * 16 + 4 * fq) = w;
    }
};

__device__ __forceinline__ void transpose_tile(const float* __restrict__ src, int K, int N, bf16_t* __restrict__ dst, int ldd, int koff, int mode, int tile) {
    float* scr = (float*)smem;
    const int ntn = N / 128, kb = tile / ntn, nb = tile % ntn, k0 = kb * 64, n0 = nb * 128, tid = threadIdx.x;
    f32x4 v[4];
#pragma unroll
    for (int i = 0; i < 4; ++i) { const int idx = tid + 512 * i, kk = idx >> 5, n4 = idx & 31; v[i] = *(const f32x4*)(src + (size_t)(k0 + kk) * N + n0 + n4 * 4); }
#pragma unroll
    for (int i = 0; i < 4; ++i) { const int idx = tid + 512 * i, kk = idx >> 5, n4 = idx & 31;
#pragma unroll
        for (int c = 0; c < 4; ++c) scr[kk * 129 + n4 * 4 + c] = v[i][c]; }
    __syncthreads();
#pragma unroll
    for (int i = 0; i < 2; ++i) {
        const int o = tid + 512 * i, n = o >> 3, kc = (o & 7) * 8;
        u32x4 w;
        w.x = pk_bf16(scr[(kc + 0) * 129 + n], scr[(kc + 1) * 129 + n]); w.y = pk_bf16(scr[(kc + 2) * 129 + n], scr[(kc + 3) * 129 + n]);
        w.z = pk_bf16(scr[(kc + 4) * 129 + n], scr[(kc + 5) * 129 + n]); w.w = pk_bf16(scr[(kc + 6) * 129 + n], scr[(kc + 7) * 129 + n]);
        const int f = n0 + n;
        const int drow = mode == 0 ? f : ((f >> 4) * 32 + (mode == 2 ? 16 : 0) + (f & 15));
        *(u32x4*)(dst + (size_t)drow * ldd + koff + k0 + kc) = w;
    }
    __syncthreads();
}

__device__ __forceinline__ void phase0(const Params& p) {
    unsigned char* ws = p.ws;
    if (blockIdx.x == 0 && threadIdx.x < 64) ((unsigned*)(ws + WS_CTL))[threadIdx.x] = 0u;
    constexpr int J0 = 16 * 42, J1 = 8 * 8, J3 = 16 * 8, J4 = 16 * 22, J6 = 44 * 8, J7 = 4, J9 = 8;
    constexpr int NT = J0 + 2 * J1 + J3 + 2 * J4 + J6 + 2 * J7 + J9;
    constexpr int NR = MP / 32;
    for (int it = blockIdx.x; it < NT + NR; it += gridDim.x) {
        if (it >= NR) {
            int r = it - NR;
            if (r < J0) { transpose_tile(p.in[4], D, PIN, (bf16_t*)(ws + WS_WIN), D, 0, 0, r); continue; } r -= J0;
            if (r < J1) { transpose_tile(p.in[16], 512, D, (bf16_t*)(ws + WS_WSB), 512, 0, 0, r); continue; } r -= J1;
            if (r < J1) { transpose_tile(p.in[17], 512, D, (bf16_t*)(ws + WS_WRW), 512, 0, 0, r); continue; } r -= J1;
            if (r < J3) { transpose_tile(p.in[18], D, D, (bf16_t*)(ws + WS_WOUT), D, 0, 0, r); continue; } r -= J3;
            if (r < J4) { transpose_tile(p.in[21], D, DFF, (bf16_t*)(ws + WS_WGU), D, 0, 1, r); continue; } r -= J4;
            if (r < J4) { transpose_tile(p.in[22], D, DFF, (bf16_t*)(ws + WS_WGU), D, 0, 2, r); continue; } r -= J4;
            if (r < J6) { transpose_tile(p.in[23], DFF, D, (bf16_t*)(ws + WS_WD), DFF, 0, 0, r); continue; } r -= J6;
            if (r < J7) { transpose_tile(p.in[6], 64, 512, (bf16_t*)(ws + WS_WL), 256, 0, 0, r); continue; } r -= J7;
            if (r < J7) { transpose_tile(p.in[8], 64, 512, (bf16_t*)(ws + WS_WL), 256, 64, 0, r); continue; } r -= J7;
            transpose_tile(p.in[10], 128, 512, (bf16_t*)(ws + WS_WL), 256, 128, 0, r);
        } else {
            const int lane = threadIdx.x & 63, row0 = it * 32 + (threadIdx.x >> 6) * 4;
            f32x4 v[4][4];
#pragma unroll
            for (int r = 0; r < 4; ++r) {
                const int row = row0 + r, b = row / TP, t = row - b * TP;
                const float* src = t < NMETA ? p.in[1] + (size_t)t * D : p.in[0] + ((size_t)b * SEQ + (t < T ? t - NMETA : 0)) * D;
#pragma unroll
                for (int j = 0; j < 4; ++j) v[r][j] = *(const f32x4*)(src + 4 * lane + 256 * j);
            }
            f32x4 g[4];
#pragma unroll
            for (int j = 0; j < 4; ++j) g[j] = *(const f32x4*)(p.in[2] + 4 * lane + 256 * j);
#pragma unroll
            for (int r = 0; r < 4; ++r) {
                const int row = row0 + r, b = row / TP, t = row - b * TP;
                float ss = 0.f;
#pragma unroll
                for (int j = 0; j < 4; ++j) ss += (v[r][j][0] * v[r][j][0] + v[r][j][1] * v[r][j][1]) + (v[r][j][2] * v[r][j][2] + v[r][j][3] * v[r][j][3]);
                const float rs = t < T ? rsqrtf(wave_sum(ss) * (1.0f / D) + RMS_EPS) : 0.f;
                bf16_t* orow = (bf16_t*)(ws + O_A0) + (size_t)row * D;
#pragma unroll
                for (int j = 0; j < 4; ++j) {
                    u32x2 w; w.x = pk_bf16(v[r][j][0] * rs * g[j][0], v[r][j][1] * rs * g[j][1]); w.y = pk_bf16(v[r][j][2] * rs * g[j][2], v[r][j][3] * rs * g[j][3]);
                    *(u32x2*)(orow + 4 * lane + 256 * j) = w;
                }
            }
        }
    }
}

__device__ __forceinline__ void phase1(const Params& p) {
    unsigned char* ws = p.ws;
    EpiInProj epi{(bf16_t*)(ws + R_QKV), (_Float16*)(ws + R_URW), (bf16_t*)p.out};
    gemm_phase((const bf16_t*)(ws + O_A0), (const bf16_t*)(ws + WS_WIN), D, MP / BM, 7, epi, (int)gridDim.x, (int)blockIdx.x, 0, 6);
}

constexpr int SI_R = 0, SI_W = 1, SI_K = 2, SI_V = 3, SI_KK = 4, SI_B = 5;
constexpr int ALD = 264;
constexpr int P2_WLS = 64 * ALD * 2;
constexpr int P2_MU = P2_WLS;
constexpr int P2_AL = P2_MU + 1024;
__device__ __forceinline__ void phase2_main(const Params& p) {
    unsigned char* ws = p.ws;
    const int tid = threadIdx.x, wave = tid >> 6, lane = tid & 63, fr = lane & 15, fq = lane >> 4;
    const int h = blockIdx.x & 7, nslot = (gridDim.x >> 3) * 8, slot = (blockIdx.x >> 3) * 8 + wave;
    const _Float16* urw = (const _Float16*)(ws + R_URW);
    const float* mu = p.in[5];
    bf16_t* WLs = (bf16_t*)smem;
    float* mus = (float*)(smem + P2_MU);
    bf16_t* Al = (bf16_t*)(smem + P2_AL) + wave * (16 * ALD);
    __syncthreads();
    {
        const bf16_t* WL = (const bf16_t*)(ws + WS_WL) + (size_t)h * 64 * 256;
#pragma unroll
        for (int i = 0; i < 4; ++i) { const int idx = tid + 512 * i, row = idx >> 5, c16 = idx & 31; *(u32x4*)(WLs + row * ALD + c16 * 8) = *(const u32x4*)(WL + row * 256 + c16 * 8); }
        if (tid < 256) mus[tid] = mu[1536 + tid];
    }
    __syncthreads();
    if (blockIdx.x >= nslot) return;
    _Float16* SI = (_Float16*)(ws + R_SI);
    bf16_t* G = (bf16_t*)(ws + R_G);
    constexpr size_t SIE = (size_t)MP * 512;
#pragma unroll 1
    for (int g = slot; g < NB * 514; g += nslot) {
        const int ub = g / 514, ui = g - ub * 514, row0 = ub * TP + ui * 16;
        {
            const int half = lane >> 5, pc = (lane & 31) * 8;
            const float sA = pc < 64 ? 2.f : 1.f, sC = pc < 64 ? -1.f : 0.f;
            const bool lin = pc >= 64 && pc < 128;
            const f32x4 mA = *(const f32x4*)(mu + 1536 + pc), mB = *(const f32x4*)(mu + 1536 + pc + 4);
            h16x8 c[8], pv[8];
#pragma unroll
            for (int q = 0; q < 8; ++q) {
                const int rowa = row0 + 2 * q + half, ta = rowa % TP;
                const _Float16* cur = urw + (size_t)rowa * RWS + 1536 + pc;
                c[q] = *(const h16x8*)cur;
                pv[q] = *(const h16x8*)(ta > 0 ? cur - RWS : cur);
            }
#pragma unroll
            for (int q = 0; q < 8; ++q) {
                const int ta = (row0 + 2 * q + half) % TP;
                float o[8];
#pragma unroll
                for (int e = 0; e < 8; ++e) {
                    const float cf = (float)c[q][e], pf = ta > 0 ? (float)pv[q][e] : 0.f;
                    const float xs = cf + (e < 4 ? mA[e & 3] : mB[e & 3]) * (pf - cf);
                    const float sg = __builtin_amdgcn_rcpf(1.0f + __expf(-sA * xs));
                    o[e] = lin ? xs : sA * sg + sC;
                }
                u32x4 w; w.x = pk_bf16(o[0], o[1]); w.y = pk_bf16(o[2], o[3]); w.z = pk_bf16(o[4], o[5]); w.w = pk_bf16(o[6], o[7]);
                *(u32x4*)(Al + (2 * q + half) * ALD + pc) = w;
            }
        }
        asm volatile("s_waitcnt lgkmcnt(0)" ::: "memory");
        __builtin_amdgcn_wave_barrier();
        f32x4 acc[4];
        auto lora = [&](auto kbeg_c, auto ksteps_c) {
            constexpr int kbeg = decltype(kbeg_c)::value, ksteps = decltype(ksteps_c)::value;
#pragma unroll
            for (int n = 0; n < 4; ++n) acc[n] = (f32x4){0.f, 0.f, 0.f, 0.f};
#pragma unroll
            for (int ks = 0; ks < ksteps; ++ks) {
                const bf16x8 af = *(const bf16x8*)(Al + fr * ALD + kbeg + ks * 32 + fq * 8);
#pragma unroll
                for (int n = 0; n < 4; ++n) {
                    const bf16x8 wf = *(const bf16x8*)(WLs + (n * 16 + fr) * ALD + kbeg + ks * 32 + fq * 8);
                    acc[n] = __builtin_amdgcn_mfma_f32_16x16x32_bf16(wf, af, acc[n], 0, 0, 0);
                }
            }
        };
        const int row = row0 + fr, b = row / TP, t = row - b * TP;
        const size_t base = ((size_t)(b * NH + h) * TP + t) * 64;
        const _Float16* ur = urw + (size_t)row * RWS;
        const size_t pb = base + fq * 16;
        lora(std::integral_constant<int, 0>{}, std::integral_constant<int, 2>{});
        {
            h16x8 wo[2];
#pragma unroll
            for (int n = 0; n < 4; ++n) {
                const f32x4 db = *(const f32x4*)(p.in[7] + h * 64 + n * 16 + fq * 4);
#pragma unroll
                for (int j = 0; j < 4; ++j) {
                    const float wl = -softplusf_(-(db[j] + acc[n][j])) - 0.5f;
                    const float e = __expf(wl);
                    wo[n >> 1][(n & 1) * 4 + j] = (_Float16)(1.0f - __expf(-e));
                }
            }
            *(h16x8*)(SI + SI_W * SIE + pb) = wo[0]; *(h16x8*)(SI + SI_W * SIE + pb + 8) = wo[1];
        }
        lora(std::integral_constant<int, 64>{}, std::integral_constant<int, 2>{});
        {
            const _Float16* up = ur + h * 64 + fq * 16;
            const _Float16* upp = t > 0 ? up - RWS : up;
            h16x8 kc[2], rc[2], vc[2], kp[2], rp[2], vp[2];
#pragma unroll
            for (int i = 0; i < 2; ++i) {
                rc[i] = *(const h16x8*)(up + i * 8); kc[i] = *(const h16x8*)(up + 512 + i * 8); vc[i] = *(const h16x8*)(up + 1024 + i * 8);
                rp[i] = *(const h16x8*)(upp + i * 8); kp[i] = *(const h16x8*)(upp + 512 + i * 8); vp[i] = *(const h16x8*)(upp + 1024 + i * 8);
            }
            float kv[4][4], av[4][4], kkr[4][4]; float ss = 0.f;
            h16x8 ro[2];
#pragma unroll
            for (int n = 0; n < 4; ++n) {
                const int c = n * 16 + fq * 4, c512 = h * 64 + c;
                const f32x4 muk = *(const f32x4*)(mu + 512 + c512), mur = *(const f32x4*)(mu + c512), muv = *(const f32x4*)(mu + 1024 + c512);
                const f32x4 ab = *(const f32x4*)(p.in[9] + c512), kkw = *(const f32x4*)(p.in[11] + c512);
                h16x4 vo;
#pragma unroll
                for (int j = 0; j < 4; ++j) {
                    const int i = n >> 1, e = (n & 1) * 4 + j;
                    const float kcf = (float)kc[i][e], kpf = t > 0 ? (float)kp[i][e] : 0.f;
                    const float rcf = (float)rc[i][e], rpf = t > 0 ? (float)rp[i][e] : 0.f;
                    const float vcf = (float)vc[i][e], vpf = t > 0 ? (float)vp[i][e] : 0.f;
                    kv[n][j] = kcf + muk[j] * (kpf - kcf);
                    ro[i][e] = (_Float16)(rcf + mur[j] * (rpf - rcf));
                    vo[j] = (_Float16)(vcf + muv[j] * (vpf - vcf));
                    av[n][j] = sigmoidf_(ab[j] + acc[n][j]);
                    kkr[n][j] = kv[n][j] * kkw[j];
                    ss += kkr[n][j] * kkr[n][j];
                }
                *(h16x4*)(SI + SI_V * SIE + base + c) = vo;
            }
            *(h16x8*)(SI + SI_R * SIE + pb) = ro[0]; *(h16x8*)(SI + SI_R * SIE + pb + 8) = ro[1];
            ss += __shfl_xor(ss, 16); ss += __shfl_xor(ss, 32);
            const float inv = fminf(__builtin_amdgcn_rsqf(ss), 1e12f);
            h16x8 ko[2], kko[2], bo[2];
#pragma unroll
            for (int n = 0; n < 4; ++n) {
                const f32x4 ka = *(const f32x4*)(p.in[12] + h * 64 + n * 16 + fq * 4);
#pragma unroll
                for (int j = 0; j < 4; ++j) {
                    const int i = n >> 1, e = (n & 1) * 4 + j;
                    const float kk = kkr[n][j] * inv;
                    ko[i][e] = (_Float16)(kv[n][j] * (1.0f + (av[n][j] - 1.0f) * ka[j]));
                    kko[i][e] = (_Float16)kk;
                    bo[i][e] = (_Float16)(kk * av[n][j]);
                }
            }
#pragma unroll
            for (int i = 0; i < 2; ++i) {
                *(h16x8*)(SI + SI_K * SIE + pb + i * 8) = ko[i]; *(h16x8*)(SI + SI_KK * SIE + pb + i * 8) = kko[i]; *(h16x8*)(SI + SI_B * SIE + pb + i * 8) = bo[i];
            }
        }
        lora(std::integral_constant<int, 128>{}, std::integral_constant<int, 4>{});
        {
            u32x4 g0, g1;
            g0.x = pk_bf16(acc[0][0], acc[0][1]); g0.y = pk_bf16(acc[0][2], acc[0][3]); g0.z = pk_bf16(acc[1][0], acc[1][1]); g0.w = pk_bf16(acc[1][2], acc[1][3]);
            g1.x = pk_bf16(acc[2][0], acc[2][1]); g1.y = pk_bf16(acc[2][2], acc[2][3]); g1.z = pk_bf16(acc[3][0], acc[3][1]); g1.w = pk_bf16(acc[3][2], acc[3][3]);
            *(u32x4*)(G + pb) = g0; *(u32x4*)(G + pb + 8) = g1;
        }
        asm volatile("s_waitcnt lgkmcnt(0)" ::: "memory");
        __builtin_amdgcn_wave_barrier();
    }
}
__device__ __forceinline__ void phase2_kmax(const Params& p, int item) {
    unsigned char* ws = p.ws;
    const int bh = item >> 2, qr = item & 3, tid = threadIdx.x;
    float* red = (float*)(smem + P2_AL + 8 * 16 * ALD * 2);
    float ss = 0.f;
    for (int t = qr * 2052 + tid; t < (qr + 1) * 2052; t += 512) {
        const bf16_t* kr = (const bf16_t*)(ws + R_QKV) + QKV_ONE / 2 + ((size_t)bh * TP + t) * 64;
        float s1 = 0.f;
#pragma unroll
        for (int q = 0; q < 8; ++q) {
            const u32x4 v = *(const u32x4*)(kr + q * 8);
#pragma unroll
            for (int e = 0; e < 4; ++e) { const float lo = __uint_as_float(v[e] << 16), hi = __uint_as_float(v[e] & 0xffff0000u); s1 += lo * lo + hi * hi; }
        }
        ss = fmaxf(ss, s1);
    }
#pragma unroll
    for (int o = 1; o < 64; o <<= 1) ss = fmaxf(ss, __shfl_xor(ss, o));
    __syncthreads();
    if ((tid & 63) == 0) red[tid >> 6] = ss;
    __syncthreads();
    if (tid == 0) {
        float m = red[0];
#pragma unroll
        for (int w = 1; w < 8; ++w) m = fmaxf(m, red[w]);
        ((float*)(ws + WS_CTL))[16 + item] = m;
    }
}
__device__ __forceinline__ void phase2(const Params& p) {
    phase2_main(p);
}

constexpr int SC_TC = 32, SC_NC = (T + SC_TC - 1) / SC_TC;
constexpr int SC_ARR = SC_TC * 64;
constexpr int SC_VOFF = 5 * SC_ARR, SC_COFF = SC_VOFF + SC_TC * 16;
constexpr int SC_BUF = (SC_COFF + SC_TC) * 4;
constexpr int SC_YOFF = 2 * SC_BUF, SC_YBUF = SC_TC * 16 * 4;
__device__ __forceinline__ float dot4(const f32x4& a, const f32x4& b) {
    f32x2 t = __builtin_shufflevector(a, a, 0, 1) * __builtin_shufflevector(b, b, 0, 1);
    t = __builtin_shufflevector(a, a, 2, 3) * __builtin_shufflevector(b, b, 2, 3) + t;
    return t[0] + t[1];
}
__device__ __forceinline__ void reduce16x2(float& a, float& b) {
    a += dppf<0xB1>(a); b += dppf<0xB1>(b); a += dppf<0x4E>(a); b += dppf<0x4E>(b);
    a += dppf<0x141>(a); b += dppf<0x141>(b); a += dppf<0x140>(a); b += dppf<0x140>(b);
}
__device__ __forceinline__ void scan_unit(const Params& p, int unit) {
    unsigned char* ws = p.ws;
    const int bh = unit >> 2, vr0 = (unit & 3) * 16, tid = threadIdx.x, wave = tid >> 6, lane = tid & 63;
    const _Float16* SI = (const _Float16*)(ws + R_SI);
    constexpr size_t SIE = (size_t)MP * 512;
    bf16_t* Y = (bf16_t*)(ws + O_Y);
    const size_t hb = (size_t)bh * TP * 64;
    __syncthreads();
    if (wave >= 4) {
        const int i = tid - 256, ip = i >= 8 ? i - 8 : i;
        const int arrs[5] = {SI_R, SI_W, SI_K, SI_KK, SI_B};
        u32x4 rg[5], rp[3]; unsigned rv;
        auto issue = [&](int c) {
            const size_t off = hb + (size_t)c * SC_TC * 64;
#pragma unroll
            for (int a = 0; a < 5; ++a) rg[a] = *(const u32x4*)(SI + arrs[a] * SIE + off + i * 8);
            rp[0] = *(const u32x4*)(SI + SI_W * SIE + off + ip * 8);
            rp[1] = *(const u32x4*)(SI + SI_K * SIE + off + ip * 8);
            rp[2] = *(const u32x4*)(SI + SI_B * SIE + off + ip * 8);
            rv = *(const unsigned*)(SI + SI_V * SIE + off + (i >> 3) * 64 + vr0 + (i & 7) * 2);
        };
        auto commit = [&](int bufi) {
            float* buf = (float*)(smem + bufi * SC_BUF);
            float f[5][8];
#pragma unroll
            for (int a = 0; a < 5; ++a) {
                const h16x8 hv = __builtin_bit_cast(h16x8, rg[a]);
#pragma unroll
                for (int e = 0; e < 8; ++e) f[a][e] = (float)hv[e];
            }
            const bool odd = (i >> 3) & 1;
            float ckk = 0.f, cbk = 0.f;
            {
                const h16x8 pw = __builtin_bit_cast(h16x8, rp[0]), pk = __builtin_bit_cast(h16x8, rp[1]), pb = __builtin_bit_cast(h16x8, rp[2]);
#pragma unroll
                for (int e = 0; e < 8; ++e) {
                    const float kk2 = f[3][e];
                    ckk += (float)pk[e] * kk2; cbk += (float)pb[e] * kk2;
                    if (odd) f[3][e] = (1.0f - (float)pw[e]) * kk2;
                }
            }
            ckk += dppf<0xB1>(ckk); cbk += dppf<0xB1>(cbk); ckk += dppf<0x4E>(ckk); cbk += dppf<0x4E>(cbk); ckk += dppf<0x141>(ckk); cbk += dppf<0x141>(cbk);
#pragma unroll
            for (int a = 0; a < 5; ++a) {
                f32x4 lo, hi;
#pragma unroll
                for (int e = 0; e < 4; ++e) { lo[e] = f[a][e]; hi[e] = f[a][4 + e]; }
                if (a == 1) { lo = 1.0f - lo; hi = 1.0f - hi; }
                if (a == 4) { lo = -lo; hi = -hi; }
                *(f32x4*)(buf + a * SC_ARR + i * 8) = lo; *(f32x4*)(buf + a * SC_ARR + i * 8 + 4) = hi;
            }
            const h16x2 v2 = __builtin_bit_cast(h16x2, rv);
            f32x2 vf; vf[0] = (float)v2[0]; vf[1] = (float)v2[1];
            *(f32x2*)(buf + SC_VOFF + (i >> 3) * 16 + (i & 7) * 2) = vf;
            if (odd && (i & 7) == 0) { f32x2 cf; cf[0] = ckk; cf[1] = cbk; *(f32x2*)(buf + SC_COFF + (i >> 4) * 2) = cf; }
        };
        auto yout = [&](int c) {
            const float* yb = (const float*)(smem + SC_YOFF + (c & 1) * SC_YBUF);
            const f32x2 v = *(const f32x2*)(yb + (i >> 3) * 16 + (i & 7) * 2);
            *(unsigned*)(Y + hb + (size_t)(c * SC_TC + (i >> 3)) * 64 + vr0 + (i & 7) * 2) = pk_bf16(v[0], v[1]);
        };
        issue(0); commit(0); issue(1);
        __syncthreads();
        for (int c = 0; c < SC_NC; ++c) {
            if (c > 0) yout(c - 1);
            if (c + 1 < SC_NC) commit((c + 1) & 1);
            if (c + 2 < SC_NC) issue(c + 2);
            __syncthreads();
        }
        yout(SC_NC - 1);
    } else {
        const int rl = wave * 4 + (lane >> 4), sub = lane & 15;
        const bool odd_lane = lane & 1; const int yoff = (lane & 1) * 16 + rl;
        f32x4 S = {0.f, 0.f, 0.f, 0.f};
        __syncthreads();
        for (int c = 0; c < SC_NC; ++c) {
            const float* buf = (const float*)(smem + (c & 1) * SC_BUF);
            float* yb = (float*)(smem + SC_YOFF + (c & 1) * SC_YBUF);
            const float* bp = buf + sub * 4;
#define SC_LD(arr, s) (*(const f32x4*)(bp + (arr) * SC_ARR + (s) * 64))
            f32x4 r1 = SC_LD(0, 0), w1 = SC_LD(1, 0), k1 = SC_LD(2, 0), q1 = SC_LD(3, 0), n1 = SC_LD(4, 0);
            f32x4 r2 = SC_LD(0, 1), w2 = SC_LD(1, 1), k2 = SC_LD(2, 1), g2 = SC_LD(3, 1), n2 = SC_LD(4, 1);
            float v1 = buf[SC_VOFF + rl], v2 = buf[SC_VOFF + 16 + rl];
            f32x2 cf = *(const f32x2*)(buf + SC_COFF);
#pragma unroll
            for (int pr = 0; pr < SC_TC / 2; ++pr) {
                const int sn = 2 * pr + 2;
                const f32x4 r1n = SC_LD(0, sn), w1n = SC_LD(1, sn), k1n = SC_LD(2, sn), q1n = SC_LD(3, sn), n1n = SC_LD(4, sn);
                const f32x4 r2n = SC_LD(0, sn + 1), w2n = SC_LD(1, sn + 1), k2n = SC_LD(2, sn + 1), g2n = SC_LD(3, sn + 1), n2n = SC_LD(4, sn + 1);
                const float v1n = buf[SC_VOFF + sn * 16 + rl], v2n = buf[SC_VOFF + (sn + 1) * 16 + rl];
                const f32x2 cfn = *(const f32x2*)(buf + SC_COFF + (pr + 1) * 2);
                __builtin_amdgcn_sched_barrier(0x7);
                float d1 = dot4(S, q1), e2 = dot4(S, g2);
                const f32x4 t1 = S * w1 + v1 * k1;
                reduce16x2(d1, e2);
                const float d2 = e2 + v1 * cf[0] - d1 * cf[1];
                const f32x4 S1 = t1 + d1 * n1;
                const f32x4 S2 = (S1 * w2 + v2 * k2) + d2 * n2;
                float y1 = dot4(S1, r1), y2 = dot4(S2, r2);
                y1 += dppf<0xB1>(y1); y2 += dppf<0xB1>(y2);
                float yz = odd_lane ? y2 : y1;
                yz += dppf<0x122>(yz); yz += dppf<0x124>(yz); yz += dppf<0x128>(yz);
                yb[(2 * pr) * 16 + yoff] = yz;
                S = S2;
                r1 = r1n; w1 = w1n; k1 = k1n; q1 = q1n; n1 = n1n; r2 = r2n; w2 = w2n; k2 = k2n; g2 = g2n; n2 = n2n; v1 = v1n; v2 = v2n; cf = cfn;
            }
#undef SC_LD
            __syncthreads();
        }
    }
}

constexpr int KLD = 72;
__device__ __forceinline__ void attn_unit(const Params& p, int unit) {
    unsigned char* ws = p.ws;
    const int qt = unit % 65, bh = unit / 65, b = bh >> 3, h = bh & 7;
    const int tid = threadIdx.x, wave = tid >> 6, lane = tid & 63, fr = lane & 15, fq = lane >> 4;
    const bf16_t* Q = (const bf16_t*)(ws + R_QKV) + (size_t)bh * TP * 64;
    const bf16_t* Kg = Q + QKV_ONE / 2;
    const bf16_t* Vg = Q + QKV_ONE;
    bf16_t* slots = (bf16_t*)smem;
    constexpr int SLOT = 2 * 64 * KLD;
    volatile int* flags = (volatile int*)(smem + 2 * SLOT * 2);
    const int t0 = qt * 128, tq = t0 + wave * 16 + fr;
    bf16x8 qf[2];
    qf[0] = *(const bf16x8*)(Q + (size_t)tq * 64 + fq * 8);
    qf[1] = *(const bf16x8*)(Q + (size_t)tq * 64 + 32 + fq * 8);
    float qs = 0.f;
#pragma unroll
    for (int s = 0; s < 2; ++s)
#pragma unroll
        for (int e = 0; e < 8; ++e) { const float f = bf2f((unsigned short)qf[s][e]); qs += f * f; }
    qs += __shfl_xor(qs, 16); qs += __shfl_xor(qs, 32);
    const f32x4 km4 = *(const f32x4*)((const float*)(ws + WS_CTL) + 16 + bh * 4);
    const float kmax = sqrtf(fmaxf(fmaxf(km4[0], km4[1]), fmaxf(km4[2], km4[3])));
    const float zb = sqrtf(qs) * kmax * 1.0001f + 88.0f;
    float Arow = 0.f;
    f32x4 O[4];
#pragma unroll
    for (int nd = 0; nd < 4; ++nd) O[nd] = (f32x4){0.f, 0.f, 0.f, 0.f};
    const int key = tid >> 3, dc = (tid & 7) * 8, half = wave >> 2;
    auto tile_store = [&](int blk, const u32x4& kv, const u32x4& vv) {
        bf16_t* Ks_ = slots + (blk & 1) * SLOT; bf16_t* Vt_ = Ks_ + 64 * KLD;
        *(u32x4*)(Ks_ + key * KLD + dc) = kv;
#pragma unroll
        for (int e = 0; e < 4; ++e) { Vt_[(dc + 2 * e) * KLD + key] = (bf16_t)(vv[e] & 0xffffu); Vt_[(dc + 2 * e + 1) * KLD + key] = (bf16_t)(vv[e] >> 16); }
    };
    const int ktop = qt * 2 + 1;
    {
        const u32x4 k0 = *(const u32x4*)(Kg + (size_t)(ktop * 64 + key) * 64 + dc), v0 = *(const u32x4*)(Vg + (size_t)(ktop * 64 + key) * 64 + dc);
        __syncthreads();
        tile_store(ktop, k0, v0);
    }
    u32x4 kvv = *(const u32x4*)(Kg + (size_t)((ktop - 1) * 64 + key) * 64 + dc);
    u32x4 vvv = *(const u32x4*)(Vg + (size_t)((ktop - 1) * 64 + key) * 64 + dc);
    for (int kt = ktop; kt >= 0; --kt) {
        const int kb = kt - 1 + half;
        const bool done = __all(Arow > zb) || kb < 0;
        if (lane == 0) flags[wave] = done ? 1 : 0;
        __syncthreads();
        int alld = 1;
#pragma unroll
        for (int w = 0; w < 8; ++w) alld &= flags[w];
        if (alld) break;
        if (kt >= 1) {
            tile_store(kt - 1, kvv, vvv);
            if (kt >= 2) {
                kvv = *(const u32x4*)(Kg + (size_t)((kt - 2) * 64 + key) * 64 + dc);
                vvv = *(const u32x4*)(Vg + (size_t)((kt - 2) * 64 + key) * 64 + dc);
            }
        }
        asm volatile("s_waitcnt lgkmcnt(0)" ::: "memory");
        __builtin_amdgcn_s_barrier();
        if (kb < 0) continue;
        const bf16_t* Ks = slots + (kb & 1) * SLOT; const bf16_t* Vt = Ks + 64 * KLD;
        f32x4 z[4];
#pragma unroll
        for (int n = 0; n < 4; ++n) {
            z[n] = (f32x4){0.f, 0.f, 0.f, 0.f};
#pragma unroll
            for (int s = 0; s < 2; ++s) {
                const bf16x8 kf = *(const bf16x8*)(Ks + (n * 16 + fr) * KLD + s * 32 + fq * 8);
                z[n] = __builtin_amdgcn_mfma_f32_16x16x32_bf16(kf, qf[s], z[n], 0, 0, 0);
            }
        }
        float sp[4][4], lt[4], ex[4], sg[4];
#pragma unroll
        for (int n = 0; n < 4; ++n) {
#pragma unroll
            for (int j = 0; j < 4; ++j) { const int s = kb * 64 + n * 16 + fq * 4 + j; sp[n][j] = s < tq ? softplusf_(z[n][j]) : 0.f; }
            sp[n][2] += sp[n][3]; sp[n][1] += sp[n][2]; sp[n][0] += sp[n][1];
            lt[n] = sp[n][0];
            const float a = __shfl_xor(lt[n], 16), pr = lt[n] + a, c = __shfl_xor(pr, 32);
            ex[n] = fq == 3 ? 0.f : (fq == 2 ? a : (fq == 1 ? c : a + c));
            sg[n] = pr + c;
        }
        float nsuf[4]; nsuf[3] = 0.f; nsuf[2] = sg[3]; nsuf[1] = nsuf[2] + sg[2]; nsuf[0] = nsuf[1] + sg[1];
        float wgt[4][4];
#pragma unroll
        for (int n = 0; n < 4; ++n)
#pragma unroll
            for (int j = 0; j < 4; ++j) {
                const int s = kb * 64 + n * 16 + fq * 4 + j;
                const float C = Arow + nsuf[n] + ex[n] + sp[n][j];
                wgt[n][j] = s < tq ? __expf(z[n][j] - C) : 0.f;
            }
        Arow += nsuf[0] + sg[0];
#pragma unroll
        for (int ks = 0; ks < 2; ++ks) {
            u32x4 pw; pw.x = pk_bf16(wgt[2 * ks][0], wgt[2 * ks][1]); pw.y = pk_bf16(wgt[2 * ks][2], wgt[2 * ks][3]);
            pw.z = pk_bf16(wgt[2 * ks + 1][0], wgt[2 * ks + 1][1]); pw.w = pk_bf16(wgt[2 * ks + 1][2], wgt[2 * ks + 1][3]);
            const bf16x8 pf = __builtin_bit_cast(bf16x8, pw);
#pragma unroll
            for (int nd = 0; nd < 4; ++nd) {
                u32x4 vw;
                const u32x2 v0 = *(const u32x2*)(Vt + (nd * 16 + fr) * KLD + (2 * ks) * 16 + fq * 4);
                const u32x2 v1 = *(const u32x2*)(Vt + (nd * 16 + fr) * KLD + (2 * ks + 1) * 16 + fq * 4);
                vw.x = v0.x; vw.y = v0.y; vw.z = v1.x; vw.w = v1.y;
                O[nd] = __builtin_amdgcn_mfma_f32_16x16x32_bf16(pf, __builtin_bit_cast(bf16x8, vw), O[nd], 0, 0, 0);
            }
        }
    }
    __syncthreads();
    bf16_t* osb = (bf16_t*)(ws + O_OSB);
#pragma unroll
    for (int j = 0; j < 4; ++j) {
        const int t = t0 + wave * 16 + fq * 4 + j;
        if (t >= NMETA && t < T) {
#pragma unroll
            for (int nd = 0; nd < 4; ++nd) osb[(size_t)(b * SEQ + t - NMETA) * 512 + h * 64 + nd * 16 + fr] = (bf16_t)(pk_bf16(O[nd][j], 0.f) & 0xffffu);
        }
    }
}

constexpr int N_SCAN = 128, N_ATTN = 32 * 65;
__device__ __forceinline__ void sub_barrier(unsigned* ctr, unsigned target, bool arrive) {
    asm volatile("s_waitcnt vmcnt(0)" ::: "memory");
    __syncthreads();
    if (threadIdx.x == 0) {
        if (arrive) { __builtin_amdgcn_fence(__ATOMIC_RELEASE, "agent"); asm volatile("s_waitcnt vmcnt(0)" ::: "memory"); (void)xb_add(ctr, 1u); }
        unsigned sp = 0u;
        while (xb_ld(ctr) < target) { __builtin_amdgcn_s_sleep(2); if (++sp > (1u << 22)) break; }
        __builtin_amdgcn_fence(__ATOMIC_ACQUIRE, "agent");
        asm volatile("s_waitcnt vmcnt(0)" ::: "memory");
    }
    __syncthreads();
}
__device__ __forceinline__ void phase3(const Params& p) {
    unsigned char* ws = p.ws;
    unsigned* ctl = (unsigned*)(ws + WS_CTL);
    const int nother = (int)gridDim.x - N_SCAN;
    if ((int)blockIdx.x < N_SCAN) {
        scan_unit(p, blockIdx.x);
    } else {
        EpiInProj epi{(bf16_t*)(ws + R_QKV), (_Float16*)(ws + R_URW), (bf16_t*)p.out};
        gemm_phase((const bf16_t*)(ws + O_A0), (const bf16_t*)(ws + WS_WIN), D, MP / BM, 14, epi, nother, (int)blockIdx.x - N_SCAN, 6, 7);
        sub_barrier(ctl + 256, (unsigned)nother, true);
        for (int it = (int)blockIdx.x - N_SCAN; it < 128; it += nother) phase2_kmax(p, it);
        sub_barrier(ctl + 320, (unsigned)nother, true);
    }
    sub_barrier(ctl + 320, (unsigned)nother, false);
    volatile int* slot = (volatile int*)(smem + 131072 - 16);
    for (;;) {
        __syncthreads();
        if (threadIdx.x == 0) *slot = (int)atomicAdd(ctl, 1u);
        __syncthreads();
        const int u = *slot;
        if (u >= N_ATTN) break;
        attn_unit(p, u);
    }
}

__device__ __forceinline__ void phase3c(const Params& p) {
    unsigned char* ws = p.ws;
    const _Float16* SI = (const _Float16*)(ws + R_SI);
    constexpr size_t SIE = (size_t)MP * 512;
    const bf16_t* Y = (const bf16_t*)(ws + O_Y);
    const bf16_t* G = (const bf16_t*)(ws + R_G);
    bf16_t* orw = (bf16_t*)(ws + O_ORW);
    const int tid = threadIdx.x, sub = tid & 15;
    constexpr int U = 4;
    for (int it = blockIdx.x; it < 32 * 64; it += gridDim.x) {
        const int bh = it >> 6, c4 = it & 63, b = bh >> 3, h = bh & 7;
        const int c = h * 64 + sub * 4;
        const f32x4 gain = *(const f32x4*)(p.in[14] + c), bias = *(const f32x4*)(p.in[15] + c), rk = *(const f32x4*)(p.in[13] + c);
        u32x2 yb2[U]; f32x4 y[U]; h16x4 r4[U], k4[U], v4[U]; u32x2 g2[U];
#pragma unroll
        for (int u = 0; u < U; ++u) {
            const int t = NMETA + (c4 * U + u) * 32 + (tid >> 4);
            const size_t base = ((size_t)bh * TP + t) * 64 + sub * 4;
            const size_t pbase = ((size_t)bh * TP + t) * 64 + (sub & 3) * 16 + (sub >> 2) * 4;
            yb2[u] = *(const u32x2*)(Y + base);
            r4[u] = *(const h16x4*)(SI + SI_R * SIE + pbase); k4[u] = *(const h16x4*)(SI + SI_K * SIE + pbase); v4[u] = *(const h16x4*)(SI + SI_V * SIE + base);
            g2[u] = *(const u32x2*)(G + pbase);
        }
#pragma unroll
        for (int u = 0; u < U; ++u) {
            const int t = NMETA + (c4 * U + u) * 32 + (tid >> 4);
            y[u][0] = __uint_as_float(yb2[u].x << 16); y[u][1] = __uint_as_float(yb2[u].x & 0xffff0000u); y[u][2] = __uint_as_float(yb2[u].y << 16); y[u][3] = __uint_as_float(yb2[u].y & 0xffff0000u);
            const float mean = reduce16((y[u][0] + y[u][1]) + (y[u][2] + y[u][3])) * (1.0f / 64.0f);
            const f32x4 dy = y[u] - mean;
            const float var = reduce16((dy[0] * dy[0] + dy[1] * dy[1]) + (dy[2] * dy[2] + dy[3] * dy[3])) * (1.0f / 64.0f);
            const float rs = rsqrtf(var + GN_EPS);
            float bs = 0.f;
#pragma unroll
            for (int j = 0; j < 4; ++j) bs += (float)r4[u][j] * (float)k4[u][j] * rk[j];
            bs = reduce16(bs);
            const float gg[4] = {__uint_as_float(g2[u].x << 16), __uint_as_float(g2[u].x & 0xffff0000u), __uint_as_float(g2[u].y << 16), __uint_as_float(g2[u].y & 0xffff0000u)};
            float o[4];
#pragma unroll
            for (int j = 0; j < 4; ++j) o[j] = (dy[j] * rs * gain[j] + bias[j] + bs * (float)v4[u][j]) * gg[j];
            u32x2 w; w.x = pk_bf16(o[0], o[1]); w.y = pk_bf16(o[2], o[3]);
            *(u32x2*)(orw + (size_t)(b * SEQ + t - NMETA) * 512 + c) = w;
        }
    }
}

__device__ __forceinline__ void phase4(const Params& p) {
    unsigned char* ws = p.ws;
    EpiBranch1 e1{(bf16_t*)(ws + O_T1), (const bf16_t*)p.out};
    EpiBranch2 e2{(const bf16_t*)(ws + O_T1), (const bf16_t*)p.out, (bf16_t*)(ws + O_M)};
    gemm_phase((const bf16_t*)(ws + O_OSB), (const bf16_t*)(ws + WS_WSB), 512, MS / BM, D / BM, e1);
    gemm_phase((const bf16_t*)(ws + O_ORW), (const bf16_t*)(ws + WS_WRW), 512, MS / BM, D / BM, e2);
}
__device__ __forceinline__ void phase5(const Params& p) {
    unsigned char* ws = p.ws;
    EpiF32 e{(float*)(ws + O_P)};
    gemm_phase((const bf16_t*)(ws + O_M), (const bf16_t*)(ws + WS_WOUT), D, MS / BM, D / BM, e);
}
__device__ __forceinline__ void phase6(const Params& p) {
    unsigned char* ws = p.ws;
    const int lane = threadIdx.x & 63;
    f32x4 g1[4], g2[4];
#pragma unroll
    for (int j = 0; j < 4; ++j) { g1[j] = *(const f32x4*)(p.in[3] + 4 * lane + 256 * j); g2[j] = *(const f32x4*)(p.in[19] + 4 * lane + 256 * j); }
    for (int it = blockIdx.x; it < MS / 16; it += gridDim.x) {
        const int row0 = it * 16 + (threadIdx.x >> 6) * 2;
        f32x4 v[2][4], x[2][4];
#pragma unroll
        for (int r = 0; r < 2; ++r)
#pragma unroll
            for (int j = 0; j < 4; ++j) {
                v[r][j] = *(const f32x4*)((const float*)(ws + O_P) + (size_t)(row0 + r) * D + 4 * lane + 256 * j);
                x[r][j] = *(const f32x4*)(p.in[0] + (size_t)(row0 + r) * D + 4 * lane + 256 * j);
            }
#pragma unroll
        for (int r = 0; r < 2; ++r) {
            const int row = row0 + r;
            float ss = 0.f;
#pragma unroll
            for (int j = 0; j < 4; ++j) ss += (v[r][j][0] * v[r][j][0] + v[r][j][1] * v[r][j][1]) + (v[r][j][2] * v[r][j][2] + v[r][j][3] * v[r][j][3]);
            const float rs = rsqrtf(wave_sum(ss) * (1.0f / D) + RMS_EPS);
            float s2 = 0.f;
#pragma unroll
            for (int j = 0; j < 4; ++j) {
                v[r][j] = x[r][j] + v[r][j] * rs * g1[j];
                *(f32x4*)(p.out + (size_t)row * D + 4 * lane + 256 * j) = v[r][j];
                s2 += (v[r][j][0] * v[r][j][0] + v[r][j][1] * v[r][j][1]) + (v[r][j][2] * v[r][j][2] + v[r][j][3] * v[r][j][3]);
            }
            const float rs2 = rsqrtf(wave_sum(s2) * (1.0f / D) + RMS_EPS);
            bf16_t* fr_ = (bf16_t*)(ws + O_F) + (size_t)row * D;
#pragma unroll
            for (int j = 0; j < 4; ++j) {
                u32x2 w; w.x = pk_bf16(v[r][j][0] * rs2 * g2[j][0], v[r][j][1] * rs2 * g2[j][1]); w.y = pk_bf16(v[r][j][2] * rs2 * g2[j][2], v[r][j][3] * rs2 * g2[j][3]);
                *(u32x2*)(fr_ + 4 * lane + 256 * j) = w;
            }
        }
    }
}
__device__ __forceinline__ void phase7(const Params& p) {
    unsigned char* ws = p.ws;
    EpiGU e{(bf16_t*)(ws + O_ACT)};
    gemm_phase((const bf16_t*)(ws + O_F), (const bf16_t*)(ws + WS_WGU), D, MS / BM, 2 * DFF / BM, e);
}
__device__ __forceinline__ void phase8(const Params& p) {
    unsigned char* ws = p.ws;
    EpiF32 e{(float*)(ws + O_DN)};
    gemm_phase((const bf16_t*)(ws + O_ACT), (const bf16_t*)(ws + WS_WD), DFF, MS / BM, D / BM, e);
}
__device__ __forceinline__ void phase9(const Params& p) {
    unsigned char* ws = p.ws;
    const int lane = threadIdx.x & 63;
    f32x4 g[4];
#pragma unroll
    for (int j = 0; j < 4; ++j) g[j] = *(const f32x4*)(p.in[20] + 4 * lane + 256 * j);
    for (int it = blockIdx.x; it < MS / 16; it += gridDim.x) {
        const int row0 = it * 16 + (threadIdx.x >> 6) * 2;
        f32x4 v[2][4], h1[2][4];
#pragma unroll
        for (int r = 0; r < 2; ++r)
#pragma unroll
            for (int j = 0; j < 4; ++j) {
                v[r][j] = *(const f32x4*)((const float*)(ws + O_DN) + (size_t)(row0 + r) * D + 4 * lane + 256 * j);
                h1[r][j] = *(const f32x4*)(p.out + (size_t)(row0 + r) * D + 4 * lane + 256 * j);
            }
#pragma unroll
        for (int r = 0; r < 2; ++r) {
            float ss = 0.f;
#pragma unroll
            for (int j = 0; j < 4; ++j) ss += (v[r][j][0] * v[r][j][0] + v[r][j][1] * v[r][j][1]) + (v[r][j][2] * v[r][j][2] + v[r][j][3] * v[r][j][3]);
            const float rs = rsqrtf(wave_sum(ss) * (1.0f / D) + RMS_EPS);
#pragma unroll
            for (int j = 0; j < 4; ++j) *(f32x4*)(p.out + (size_t)(row0 + r) * D + 4 * lane + 256 * j) = h1[r][j] + v[r][j] * rs * g[j];
        }
    }
}

constexpr int N_PHASES = 11;
__device__ __forceinline__ void run_phase(const Params& p, int ph) {
    switch (ph) {
        case 0: phase0(p); break;
        case 1: phase1(p); break;
        case 2: phase2(p); break;
        case 3: phase3(p); break;
        case 4: phase3c(p); break;
        case 5: phase4(p); break;
        case 6: phase5(p); break;
        case 7: phase6(p); break;
        case 8: phase7(p); break;
        case 9: phase8(p); break;
        default: phase9(p); break;
    }
}

#if MULTI_LAUNCH
template <int PH> __global__ void __launch_bounds__(512) fwd_phase(Params p) { run_phase(p, PH); }
#else
__global__ void __launch_bounds__(512) fwd_mega(Params p) {
    cg::grid_group grid = cg::this_grid();
    volatile LAS unsigned* st = (volatile LAS unsigned*)(smem + 131072);
    if (threadIdx.x == 0) { st[0] = 0u; st[1] = 0u; }
    __syncthreads();
    const XcdBarrier xb = xcd_barrier_post((unsigned*)(p.ws + WS_BAR), st);
    if (p.out == nullptr) grid.sync();
    phase0(p); xcd_barrier(xb); phase1(p); xcd_barrier(xb); phase2(p); xcd_barrier(xb); phase3(p); xcd_barrier(xb); phase3c(p); xcd_barrier(xb);
    phase4(p); xcd_barrier(xb); phase5(p); xcd_barrier(xb); phase6(p); xcd_barrier(xb); phase7(p); xcd_barrier(xb); phase8(p); xcd_barrier(xb); phase9(p);
}
#endif

extern "C" void kernel_launch(void* const* d_in, const int* in_sizes, int n_in, void* d_out, int out_size, void* d_ws, size_t ws_size, hipStream_t stream) {
    static int grid = 0;
    if (grid == 0) {
        if (n_in != 24 || out_size != MS * D || ws_size < WS_END) { fprintf(stderr, "kernel_launch: unexpected shapes (n_in %d out %d ws %zu need %zu)\n", n_in, out_size, ws_size, (size_t)WS_END); grid = -1; return; }
        int dev = 0, cus = 0, per_cu = 0;
        (void)hipGetDevice(&dev);
        (void)hipDeviceGetAttribute(&cus, hipDeviceAttributeMultiprocessorCount, dev);
#if MULTI_LAUNCH
        per_cu = 1;
#else
        (void)hipFuncSetAttribute((const void*)fwd_mega, hipFuncAttributeMaxDynamicSharedMemorySize, LDS_BYTES);
        (void)hipOccupancyMaxActiveBlocksPerMultiprocessor(&per_cu, (const void*)fwd_mega, 512, LDS_BYTES);
        if (per_cu < 1) { fprintf(stderr, "kernel_launch: occupancy query says %d blocks per CU\n", per_cu); per_cu = 1; }
        if (per_cu > 1) per_cu = 1;
#endif
        grid = cus * per_cu;
        if (grid <= N_SCAN) { fprintf(stderr, "kernel_launch: grid %d too small (needs more than %d workgroups)\n", grid, N_SCAN); grid = -1; return; }
    }
    if (grid < 0) return;
    Params p{};
    for (int i = 0; i < 24; ++i) p.in[i] = (const float*)d_in[i];
    p.out = (float*)d_out; p.ws = (unsigned char*)d_ws;
#if MULTI_LAUNCH
#define LP(PH) do { (void)hipFuncSetAttribute((const void*)fwd_phase<PH>, hipFuncAttributeMaxDynamicSharedMemorySize, LDS_BYTES); hipLaunchKernelGGL(fwd_phase<PH>, dim3(grid), dim3(512), LDS_BYTES, stream, p); } while (0)
    LP(0); LP(1); LP(2); LP(3); LP(4); LP(5); LP(6); LP(7); LP(8); LP(9); LP(10);
#undef LP
#else
    if (hipMemsetAsync(d_ws, 0, WS_CTL_BYTES, stream) != hipSuccess) { fprintf(stderr, "kernel_launch: hipMemsetAsync of the control words failed\n"); return; }
    void* args[] = {&p};
    hipError_t e = hipLaunchCooperativeKernel((const void*)fwd_mega, dim3(grid), dim3(512), args, LDS_BYTES, stream);
    if (e != hipSuccess) fprintf(stderr, "cooperative launch failed: %s (grid %d)\n", hipGetErrorString(e), grid);
#endif
}
```

```cpp
#include <hip/hip_runtime.h>
#include <hip/hip_cooperative_groups.h>
#include <cstdio>
#include <cstdint>
#include <type_traits>
namespace cg = cooperative_groups;

#ifndef MULTI_LAUNCH
#define MULTI_LAUNCH 0
#endif

typedef unsigned short bf16_t;
typedef short bf16x8 __attribute__((ext_vector_type(8)));
typedef float f32x4 __attribute__((ext_vector_type(4)));
typedef float f32x2 __attribute__((ext_vector_type(2)));
typedef unsigned u32x2 __attribute__((ext_vector_type(2)));
typedef unsigned u32x4 __attribute__((ext_vector_type(4)));
typedef _Float16 h16x2 __attribute__((ext_vector_type(2)));
typedef _Float16 h16x4 __attribute__((ext_vector_type(4)));
typedef _Float16 h16x8 __attribute__((ext_vector_type(8)));

constexpr int D = 1024, NB = 4, SEQ = 8192, NMETA = 16, T = SEQ + NMETA, TP = 8320, MP = NB * TP, MS = NB * SEQ;
constexpr int PIN = 5376, DFF = 2816, NH = 8, RWS = 1792;
constexpr float RMS_EPS = 1e-6f, GN_EPS = 64e-5f;

constexpr size_t WS_CTL = 0;
constexpr size_t WS_BAR = 4096;
constexpr size_t WS_CTL_BYTES = 32768;
constexpr size_t WS_WIN = WS_CTL_BYTES;
constexpr size_t WS_WSB = WS_WIN + (size_t)PIN * D * 2;
constexpr size_t WS_WRW = WS_WSB + (size_t)D * 512 * 2;
constexpr size_t WS_WOUT = WS_WRW + (size_t)D * 512 * 2;
constexpr size_t WS_WGU = WS_WOUT + (size_t)D * D * 2;
constexpr size_t WS_WD = WS_WGU + (size_t)2 * DFF * D * 2;
constexpr size_t WS_WL = WS_WD + (size_t)D * DFF * 2;
constexpr size_t R_A0 = WS_WL + (size_t)512 * 256 * 2;
constexpr size_t R_URW = R_A0 + (size_t)MP * D * 2;
constexpr size_t R_QKV = R_URW;
constexpr size_t QKV_ONE = (size_t)MP * 512 * 2;
constexpr size_t R_SI = R_URW + (size_t)MP * RWS * 2;
constexpr size_t SI_ONE = (size_t)MP * 512 * 2;
constexpr size_t R_G = R_SI + 6 * SI_ONE;
constexpr size_t R_TAIL = R_G + SI_ONE;
constexpr size_t O_Y = R_TAIL;
constexpr size_t O_OSB = R_TAIL + SI_ONE;
constexpr size_t WS_END = O_OSB + (size_t)MS * 512 * 2;
constexpr size_t O_A0 = R_A0;
constexpr size_t O_ORW = R_A0;
constexpr size_t O_T1 = R_SI;
constexpr size_t O_M = R_SI + (size_t)MS * D * 4;
constexpr size_t O_P = R_A0;
constexpr size_t O_F = R_SI;
constexpr size_t O_ACT = R_A0;
constexpr size_t O_DN = R_SI + (size_t)MS * D * 2;
static_assert(3 * QKV_ONE <= (size_t)MP * RWS * 2, "overlay");
static_assert(O_M + (size_t)MS * D * 2 <= R_TAIL, "overlay");
static_assert(O_ACT + (size_t)MS * DFF * 2 <= R_SI, "overlay");
static_assert(O_P + (size_t)MS * D * 4 <= R_SI, "overlay");
static_assert(O_DN + (size_t)MS * D * 4 <= R_TAIL, "overlay");
static_assert(WS_END <= (size_t)512 * 1024 * 1024, "workspace");

constexpr int LDS_BYTES = 131072 + 64;

struct Params { const float* in[24]; float* out; unsigned char* ws; };

extern __shared__ __attribute__((aligned(16))) unsigned char smem[];

typedef __bf16 b16x2 __attribute__((ext_vector_type(2)));
__device__ __forceinline__ unsigned pk_bf16(float lo, float hi) { const f32x2 v = {lo, hi}; return __builtin_bit_cast(unsigned, __builtin_convertvector(v, b16x2)); }
__device__ __forceinline__ float bf2f(unsigned short v) { return __uint_as_float((unsigned)v << 16); }
__device__ __forceinline__ float sigmoidf_(float x) { return __builtin_amdgcn_rcpf(1.0f + __expf(-x)); }
__device__ __forceinline__ float softplusf_(float x) { return fmaxf(x, 0.f) + __logf(1.0f + __expf(-fabsf(x))); }
template <int CTRL> __device__ __forceinline__ float dppf(float x) { return __builtin_bit_cast(float, __builtin_amdgcn_mov_dpp(__builtin_bit_cast(int, x), CTRL, 0xf, 0xf, true)); }
__device__ __forceinline__ float reduce16(float v) {
    v += dppf<0xB1>(v); v += dppf<0x4E>(v); v += dppf<0x141>(v); v += dppf<0x140>(v); return v;
}
__device__ __forceinline__ float wave_sum(float v) {
#pragma unroll
    for (int o = 1; o < 64; o <<= 1) v += __shfl_xor(v, o);
    return v;
}

#define LAS __attribute__((address_space(3)))
#define XB_TMO      128
#define XB_XCNT(j)  (256  + 64 * (j))
#define XB_XSUB(j)  (1280 + 64 * (j))
#define XB_XGEN(j)  (2304 + 64 * (j))
#define XB_TOP      3328
#define XB_TOPGEN   3392
#define XCD_BAR_WORDS 3456
#define XB_SPIN_CAP (1u << 18)
__device__ __forceinline__ unsigned xb_ld(unsigned* p)              { return __hip_atomic_load(p, __ATOMIC_RELAXED, __HIP_MEMORY_SCOPE_AGENT); }
__device__ __forceinline__ unsigned xb_add(unsigned* p, unsigned v) { return __hip_atomic_fetch_add(p, v, __ATOMIC_RELAXED, __HIP_MEMORY_SCOPE_AGENT); }
__device__ __forceinline__ unsigned xb_xcc_id() { return (unsigned)__builtin_amdgcn_s_getreg((3 << 11) | 20) & 0xFu; }
#define XB_SPIN(cond, bar) do { unsigned _sp = 0; while (cond) { __builtin_amdgcn_s_sleep(1); \
    if ((++_sp & 255u) == 0u) { if (xb_ld(&(bar)[XB_TMO])) break; if (_sp > XB_SPIN_CAP) { atomicAdd(&(bar)[XB_TMO], 1u); break; } } } } while (0)
struct XcdBarrier { unsigned* bar; unsigned x; volatile LAS unsigned* st; };
__device__ __forceinline__ XcdBarrier xcd_barrier_post(unsigned* bar, volatile LAS unsigned* st) {
    XcdBarrier b; b.bar = bar; b.x = xb_xcc_id(); b.st = st;
    if (threadIdx.x == 0) (void)xb_add(&bar[XB_XCNT(b.x)], 1u);
    return b;
}
__device__ __forceinline__ void xcd_barrier_complete(unsigned* bar, unsigned x, unsigned& nloc, unsigned& nx) {
    const unsigned G = gridDim.x * gridDim.y * gridDim.z;
    unsigned sum, cnt, mine, sp = 0u;
    for (;;) {
        sum = 0u; cnt = 0u; mine = 0u;
#pragma unroll
        for (unsigned j = 0; j < 16; ++j) { const unsigned c = xb_ld(&bar[XB_XCNT(j)]); sum += c; cnt += (c > 0u) ? 1u : 0u; mine = (j == x) ? c : mine; }
        if (sum == G) break;
        __builtin_amdgcn_s_sleep(1);
        if ((++sp & 255u) == 0u) { if (xb_ld(&bar[XB_TMO])) break; if (sp > XB_SPIN_CAP) { atomicAdd(&bar[XB_TMO], 1u); break; } }
    }
    nloc = mine > 0u ? mine : 1u; nx = cnt > 0u ? cnt : 1u;
}
__device__ __forceinline__ void xcd_barrier(const XcdBarrier& b) {
    asm volatile("s_waitcnt vmcnt(0)" ::: "memory");
    __syncthreads();
    if (threadIdx.x == 0) {
        unsigned* bar = b.bar;
        __builtin_amdgcn_s_waitcnt(0);
        unsigned nloc = b.st[0], nx = b.st[1];
        if (nloc == 0u) { xcd_barrier_complete(bar, b.x, nloc, nx); b.st[0] = nloc; b.st[1] = nx; }
        const unsigned old = xb_add(&bar[XB_XSUB(b.x)], 1u);
        const unsigned gen = old / nloc;
        if (old + 1u == (gen + 1u) * nloc) {
            __builtin_amdgcn_fence(__ATOMIC_RELEASE, "agent");
            asm volatile("s_waitcnt vmcnt(0)" ::: "memory");
            const unsigned og = xb_add(&bar[XB_TOP], 1u);
            const unsigned tg = og / nx;
            if (og + 1u == (tg + 1u) * nx) xb_add(&bar[XB_TOPGEN], 1u);
            else XB_SPIN(xb_ld(&bar[XB_TOPGEN]) == tg, bar);
            __builtin_amdgcn_fence(__ATOMIC_ACQUIRE, "agent");
            xb_add(&bar[XB_XGEN(b.x)], 1u);
            asm volatile("s_waitcnt vmcnt(0)" ::: "memory");
        } else {
            XB_SPIN(xb_ld(&bar[XB_XGEN(b.x)]) == gen, bar);
            __builtin_amdgcn_fence(__ATOMIC_ACQUIRE, "agent");
            asm volatile("s_waitcnt vmcnt(0)" ::: "memory");
        }
    }
    __syncthreads();
}

constexpr int BM = 256, BK = 64, HALF = 128, HTB = HALF * BK * 2, NXCD = 8, WGM = 8;
__device__ __forceinline__ int lds_byte(int r, int c) { const int st = (r >> 4) * 2 + (c >> 5), rr = r & 15, cc = c & 31, ob = rr * 64 + cc * 2; return st * 1024 + (ob ^ (((ob >> 9) & 1) << 5)); }
__device__ __forceinline__ void stage_rc(int b, int& R, int& C) { const int st = b / 1024, sb = b % 1024, swz = sb ^ (((sb >> 9) & 1) << 5); R = (st >> 1) * 16 + swz / 64; C = (st & 1) * 32 + (swz % 64) / 2; }
struct Unit { int pm, pn; };
struct Sched {
    int nM, nN, nwg, G, c;
    __device__ __forceinline__ bool next(int i, Unit& u) const {
        const long L = (long)i * G + c; if (L >= nwg) return false;
        int wgid = (int)L; { const int q = nwg / NXCD, r = nwg % NXCD, xcd = wgid % NXCD, off = wgid / NXCD; wgid = (xcd < r ? xcd * (q + 1) : r * (q + 1) + (xcd - r) * q) + off; }
        const int nig = WGM * nN, gid = wgid / nig, fm = gid * WGM, gsz = (nM - fm) < WGM ? (nM - fm) : WGM;
        u.pm = fm + ((wgid % nig) % gsz); u.pn = (wgid % nig) / gsz; return true;
    }
};

template <class Epi>
__device__ __forceinline__ void gemm_phase(const bf16_t* __restrict__ Ag, const bf16_t* __restrict__ Btg, const int K, const int nM, const int nN, const Epi& E,
                                           const int G = (int)gridDim.x, const int c = (int)blockIdx.x, const int pn_from = 1 << 30, const int pn_add = 0) {
    LAS unsigned char* lds = (LAS unsigned char*)smem;
    const int tid = threadIdx.x, wid = __builtin_amdgcn_readfirstlane(tid >> 6), lane = tid & 63, wr = wid >> 2, wc = wid & 3, fr = lane & 15, fq = lane >> 4;
    const int nt = K / BK;
    Sched S; S.nM = nM; S.nN = nN; S.nwg = nM * nN; S.G = G; S.c = c;
    unsigned voffA[2], voffB[2];
#pragma unroll
    for (int i = 0; i < 2; ++i) { int R, C; stage_rc(tid * 16 + i * 8192, R, C);
        const int Rb = Epi::PERM ? ((R & ~31) + 8 * ((R & 15) >> 2) + 4 * ((R & 31) >> 4) + (R & 3)) : R;
        voffA[i] = (unsigned)(R * K + C) * 2u; voffB[i] = (unsigned)(Rb * K + C) * 2u; }
    const size_t kstep = (size_t)(BK * 2);
    const size_t hstep = (size_t)HALF * K * 2;
    const size_t tstep = 2 * hstep;
    const unsigned ldsw = (unsigned)wid * 1024u;
    const int aoff = lds_byte(wr * 64 + fr, fq * 8), boff = lds_byte(wc * 32 + fr, fq * 8);
#define PG8_SA(b, h) (((b) * 2 + (h)) * HTB)
#define PG8_SB(b, h) ((4 + (b) * 2 + (h)) * HTB)
#define PG8_STAGE(bufoff, gbase, voff) do { _Pragma("unroll") for (int _i = 0; _i < 2; ++_i) \
        __builtin_amdgcn_global_load_lds((const unsigned*)((const char*)(gbase) + (voff)[_i]), (LAS unsigned*)(lds + (bufoff) + ldsw + _i * 8192), 16, 0, 0); } while (0)
#define PG8_LDA(dst, b, h) do { _Pragma("unroll") for (int m = 0; m < 4; ++m) _Pragma("unroll") for (int k = 0; k < 2; ++k) dst[m][k] = *(const LAS bf16x8*)(lds + PG8_SA(b, h) + aoff + m * 2048 + k * 1024); } while (0)
#define PG8_LDB(dst, b, h) do { _Pragma("unroll") for (int n = 0; n < 2; ++n) _Pragma("unroll") for (int k = 0; k < 2; ++k) dst[n][k] = *(const LAS bf16x8*)(lds + PG8_SB(b, h) + boff + n * 2048 + k * 1024); } while (0)
#define PG8_MMA(ai, bj, At, Bt) do { __builtin_amdgcn_s_setprio(1); _Pragma("unroll") for (int m = 0; m < 4; ++m) _Pragma("unroll") for (int n = 0; n < 2; ++n) _Pragma("unroll") for (int k = 0; k < 2; ++k) \
        acc[ai][bj][m][n] = __builtin_amdgcn_mfma_f32_16x16x32_bf16(Bt[n][k], At[m][k], acc[ai][bj][m][n], 0, 0, 0); __builtin_amdgcn_s_setprio(0); } while (0)
#define PG8_WAIT_V(n) asm volatile("s_waitcnt vmcnt(" #n ")" ::: "memory")
#define PG8_WAIT_L(n) asm volatile("s_waitcnt lgkmcnt(" #n ")" ::: "memory")
#define PG8_BAR __builtin_amdgcn_s_barrier()
#define PG8_SCHED __builtin_amdgcn_sched_barrier(0)
    Unit cur, nxt; int ui = 0;
    __syncthreads();
    if (!S.next(0, cur)) return;
    if (cur.pn >= pn_from) cur.pn += pn_add;
    f32x4 acc[2][2][4][2];
#pragma unroll
    for (int a = 0; a < 2; ++a)
#pragma unroll
        for (int b = 0; b < 2; ++b)
#pragma unroll
            for (int m = 0; m < 4; ++m)
#pragma unroll
                for (int n = 0; n < 2; ++n) acc[a][b][m][n] = (f32x4){0.f, 0.f, 0.f, 0.f};
    bf16x8 At[4][2], B0[2][2], B1[2][2];
    const char* cA = (const char*)Ag + (size_t)cur.pm * tstep; const char* cB = (const char*)Btg + (size_t)cur.pn * tstep;
    PG8_STAGE(PG8_SB(0, 0), cB, voffB); PG8_STAGE(PG8_SA(0, 0), cA, voffA); PG8_STAGE(PG8_SB(0, 1), cB + hstep, voffB); PG8_STAGE(PG8_SA(0, 1), cA + hstep, voffA);
    if (wr == 1) PG8_BAR;
    PG8_WAIT_V(4); PG8_BAR;
    PG8_STAGE(PG8_SB(1, 0), cB + kstep, voffB); PG8_STAGE(PG8_SA(1, 0), cA + kstep, voffA); PG8_STAGE(PG8_SB(1, 1), cB + hstep + kstep, voffB);
    PG8_WAIT_V(6); PG8_BAR;
    for (;;) {
        const bool has_next = S.next(ui + 1, nxt);
        if (has_next && nxt.pn >= pn_from) nxt.pn += pn_add;
        const char* nA = has_next ? (const char*)Ag + (size_t)nxt.pm * tstep : cA; const char* nB = has_next ? (const char*)Btg + (size_t)nxt.pn * tstep : cB;
        for (int t = 0; t < nt; t += 2) {
            const bool last = (t == nt - 2);
            const char* a1 = cA + (size_t)(t + 1) * kstep;
            const char* a2 = last ? nA : cA + (size_t)(t + 2) * kstep; const char* b2 = last ? nB : cB + (size_t)(t + 2) * kstep;
            const char* a3 = a2 + kstep; const char* b3 = b2 + kstep;
            PG8_LDB(B0, 0, 0); PG8_SCHED; PG8_LDA(At, 0, 0); PG8_STAGE(PG8_SA(1, 1), a1 + hstep, voffA);
            PG8_WAIT_L(8); PG8_BAR; PG8_WAIT_L(0); PG8_MMA(0, 0, At, B0); PG8_BAR; PG8_SCHED;
            PG8_LDB(B1, 0, 1); PG8_STAGE(PG8_SB(0, 0), b2, voffB);
            PG8_BAR; PG8_WAIT_L(0); PG8_MMA(0, 1, At, B1); PG8_BAR;
            PG8_LDA(At, 0, 1); PG8_STAGE(PG8_SA(0, 0), a2, voffA);
            PG8_BAR; PG8_WAIT_L(0); PG8_MMA(1, 0, At, B0); PG8_BAR; PG8_SCHED;
            PG8_STAGE(PG8_SB(0, 1), b2 + hstep, voffB);
            PG8_WAIT_V(6); PG8_BAR; PG8_MMA(1, 1, At, B1); PG8_BAR;
            PG8_LDB(B0, 1, 0); PG8_SCHED; PG8_LDA(At, 1, 0); PG8_STAGE(PG8_SA(0, 1), a2 + hstep, voffA);
            PG8_WAIT_L(8); PG8_BAR; PG8_WAIT_L(0); PG8_MMA(0, 0, At, B0); PG8_BAR; PG8_SCHED;
            PG8_LDB(B1, 1, 1); PG8_STAGE(PG8_SB(1, 0), b3, voffB);
            PG8_BAR; PG8_WAIT_L(0); PG8_MMA(0, 1, At, B1); PG8_BAR;
            PG8_LDA(At, 1, 1); PG8_STAGE(PG8_SA(1, 0), a3, voffA);
            PG8_BAR; PG8_WAIT_L(0); PG8_MMA(1, 0, At, B0); PG8_BAR; PG8_SCHED;
            PG8_STAGE(PG8_SB(1, 1), b3 + hstep, voffB);
            PG8_WAIT_V(6); PG8_BAR; PG8_MMA(1, 1, At, B1); PG8_BAR;
        }
        {
            const int brow = cur.pm * BM, bcol = cur.pn * BM;
#pragma unroll
            for (int ai = 0; ai < 2; ++ai)
#pragma unroll
                for (int m = 0; m < 4; ++m) {
                    E.row(brow + ai * HALF + wr * 64 + m * 16 + fr, bcol + wc * 32, fq, acc[ai][0][m][0], acc[ai][0][m][1], acc[ai][1][m][0], acc[ai][1][m][1]);
                    asm volatile("" ::: "memory");
                }
        }
        if (!has_next) break;
#pragma unroll
        for (int a = 0; a < 2; ++a)
#pragma unroll
            for (int b = 0; b < 2; ++b)
#pragma unroll
                for (int m = 0; m < 4; ++m)
#pragma unroll
                    for (int n = 0; n < 2; ++n) acc[a][b][m][n] = (f32x4){0.f, 0.f, 0.f, 0.f};
        cur = nxt; cA = nA; cB = nB; ++ui;
    }
    PG8_WAIT_V(0);
    if (wr == 0) PG8_BAR;
    PG8_BAR;
#undef PG8_SA
#undef PG8_SB
#undef PG8_STAGE
#undef PG8_LDA
#undef PG8_LDB
#undef PG8_MMA
#undef PG8_WAIT_V
#undef PG8_WAIT_L
#undef PG8_BAR
#undef PG8_SCHED
}

template <bool PERM_> struct EpiInProj {
    static constexpr bool PERM = PERM_;
    bf16_t* qkv; _Float16* urw; bf16_t* gates;
    __device__ __forceinline__ void one(int row, int col, const f32x4& v) const {
        if (col < 1536) {
            const int which = col >> 9, hc = col & 511, h = hc >> 6, d = hc & 63, b = row / TP, t = row - b * TP;
            const float s = which == 0 ? 0.125f : 1.0f;
            u32x2 w; w.x = pk_bf16(v[0] * s, v[1] * s); w.y = pk_bf16(v[2] * s, v[3] * s);
            *(u32x2*)(qkv + (size_t)which * (QKV_ONE / 2) + ((size_t)(b * NH + h) * TP + t) * 64 + d) = w;
        } else if (col < 3328) {
            h16x4 o; o[0] = (_Float16)v[0]; o[1] = (_Float16)v[1]; o[2] = (_Float16)v[2]; o[3] = (_Float16)v[3];
            *(h16x4*)(urw + (size_t)row * RWS + (col - 1536)) = o;
        } else {
            const int b = row / TP, t = row - b * TP;
            if (t >= NMETA && t < T) {
                u32x2 w; w.x = pk_bf16(sigmoidf_(v[0]), sigmoidf_(v[1])); w.y = pk_bf16(sigmoidf_(v[2]), sigmoidf_(v[3]));
                *(u32x2*)(gates + (size_t)(b * SEQ + t - NMETA) * 2048 + (col - 3328)) = w;
            }
        }
    }
    __device__ __forceinline__ void half(int row, int col32, int fq, const f32x4& v0, const f32x4& v1) const {
        if constexpr (PERM_) {
            const int col = col32 + 8 * fq, b = row / TP, t = row - b * TP;
            if (col < 1536) {
                const int which = col >> 9, hc = col & 511, h = hc >> 6, d = hc & 63;
                const float s = which == 0 ? 0.125f : 1.0f;
                u32x4 w; w.x = pk_bf16(v0[0] * s, v0[1] * s); w.y = pk_bf16(v0[2] * s, v0[3] * s); w.z = pk_bf16(v1[0] * s, v1[1] * s); w.w = pk_bf16(v1[2] * s, v1[3] * s);
                *(u32x4*)(qkv + (size_t)which * (QKV_ONE / 2) + ((size_t)(b * NH + h) * TP + t) * 64 + d) = w;
            } else if (t >= NMETA && t < T) {
                u32x4 w; w.x = pk_bf16(sigmoidf_(v0[0]), sigmoidf_(v0[1])); w.y = pk_bf16(sigmoidf_(v0[2]), sigmoidf_(v0[3]));
                w.z = pk_bf16(sigmoidf_(v1[0]), sigmoidf_(v1[1])); w.w = pk_bf16(sigmoidf_(v1[2]), sigmoidf_(v1[3]));
                *(u32x4*)(gates + (size_t)(b * SEQ + t - NMETA) * 2048 + (col - 3328)) = w;
            }
        } else {
            if (col32 >= 1536 && col32 < 3072) {
                const int c = col32 - 1536, pos = (c & ~63) + fq * 16 + ((c & 63) >> 4) * 4;
                h16x8 o;
#pragma unroll
                for (int j = 0; j < 4; ++j) { o[j] = (_Float16)v0[j]; o[4 + j] = (_Float16)v1[j]; }
                *(h16x8*)(urw + (size_t)row * RWS + pos) = o;
            } else { one(row, col32 + 4 * fq, v0); one(row, col32 + 16 + 4 * fq, v1); }
        }
    }
    __device__ __forceinline__ void row(int r, int col32, int fq, const f32x4& a00, const f32x4& a01, const f32x4& a10, const f32x4& a11) const { half(r, col32, fq, a00, a01); half(r, col32 + HALF, fq, a10, a11); }
};
__device__ __forceinline__ void bf8_to_f(const u32x4& g, float (&f)[8]) {
#pragma unroll
    for (int i = 0; i < 4; ++i) { f[2 * i] = __uint_as_float(g[i] << 16); f[2 * i + 1] = __uint_as_float(g[i] & 0xffff0000u); }
}
struct EpiBranch1 {
    static constexpr bool PERM = true;
    bf16_t* t1; const bf16_t* gates;
    __device__ __forceinline__ void half(int row, int col32, int fq, const f32x4& v0, const f32x4& v1) const {
        const int col = col32 + 8 * fq;
        float g[8]; bf8_to_f(*(const u32x4*)(gates + (size_t)row * 2048 + col), g);
        u32x4 w; w.x = pk_bf16(v0[0] * g[0], v0[1] * g[1]); w.y = pk_bf16(v0[2] * g[2], v0[3] * g[3]); w.z = pk_bf16(v1[0] * g[4], v1[1] * g[5]); w.w = pk_bf16(v1[2] * g[6], v1[3] * g[7]);
        *(u32x4*)(t1 + (size_t)row * D + col) = w;
    }
    __device__ __forceinline__ void row(int r, int col32, int fq, const f32x4& a00, const f32x4& a01, const f32x4& a10, const f32x4& a11) const { half(r, col32, fq, a00, a01); half(r, col32 + HALF, fq, a10, a11); }
};
struct EpiBranch2 {
    static constexpr bool PERM = true;
    const bf16_t* t1; const bf16_t* gates; bf16_t* m;
    __device__ __forceinline__ void half(int row, int col32, int fq, const f32x4& v0, const f32x4& v1) const {
        const int col = col32 + 8 * fq;
        float g[8], a[8]; bf8_to_f(*(const u32x4*)(gates + (size_t)row * 2048 + 1024 + col), g); bf8_to_f(*(const u32x4*)(t1 + (size_t)row * D + col), a);
        u32x4 w; w.x = pk_bf16(a[0] + v0[0] * g[0], a[1] + v0[1] * g[1]); w.y = pk_bf16(a[2] + v0[2] * g[2], a[3] + v0[3] * g[3]);
        w.z = pk_bf16(a[4] + v1[0] * g[4], a[5] + v1[1] * g[5]); w.w = pk_bf16(a[6] + v1[2] * g[6], a[7] + v1[3] * g[7]);
        *(u32x4*)(m + (size_t)row * D + col) = w;
    }
    __device__ __forceinline__ void row(int r, int col32, int fq, const f32x4& a00, const f32x4& a01, const f32x4& a10, const f32x4& a11) const { half(r, col32, fq, a00, a01); half(r, col32 + HALF, fq, a10, a11); }
};
struct EpiF32 {
    static constexpr bool PERM = true;
    float* o;
    __device__ __forceinline__ void row(int r, int col32, int fq, const f32x4& a00, const f32x4& a01, const f32x4& a10, const f32x4& a11) const {
        float* q = o + (size_t)r * D + col32 + 8 * fq;
        *(f32x4*)q = a00; *(f32x4*)(q + 4) = a01; *(f32x4*)(q + HALF) = a10; *(f32x4*)(q + HALF + 4) = a11;
    }
};
struct EpiGU {
    static constexpr bool PERM = true;
    bf16_t* act;
    __device__ __forceinline__ void row(int r, int col32, int fq, const f32x4& g0, const f32x4& g1, const f32x4& u0, const f32x4& u1) const {
        float o[8];
#pragma unroll
        for (int j = 0; j < 4; ++j) { o[j] = g0[j] * sigmoidf_(g0[j]) * u0[j]; o[4 + j] = g1[j] * sigmoidf_(g1[j]) * u1[j]; }
        u32x4 w; w.x = pk_bf16(o[0], o[1]); w.y = pk_bf16(o[2], o[3]); w.z = pk_bf16(o[4], o[5]); w.w = pk_bf16(o[6], o[7]);
        const int pn = col32 >> 8, cin = (col32 & 255) + 8 * fq;
        *(u32x4*)(act + (size_t)r * DFF + pn * 128 + cin) = w;
    }
};

__device__ __forceinline__ void transpose_tile(const float* __restrict__ src, int K, int N, bf16_t* __restrict__ dst, int ldd, int koff, int mode, int tile) {
    float* scr = (float*)smem;
    const int ntn = N / 128, kb = tile / ntn, nb = tile % ntn, k0 = kb * 64, n0 = nb * 128, tid = threadIdx.x;
    f32x4 v[4];
#pragma unroll
    for (int i = 0; i < 4; ++i) { const int idx = tid + 512 * i, kk = idx >> 5, n4 = idx & 31; v[i] = *(const f32x4*)(src + (size_t)(k0 + kk) * N + n0 + n4 * 4); }
#pragma unroll
    for (int i = 0; i < 4; ++i) { const int idx = tid + 512 * i, kk = idx >> 5, n4 = idx & 31;
#pragma unroll
        for (int c = 0; c < 4; ++c) scr[kk * 129 + n4 * 4 + c] = v[i][c]; }
    __syncthreads();
#pragma unroll
    for (int i = 0; i < 2; ++i) {
        const int o = tid + 512 * i, n = o >> 3, kc = (o & 7) * 8;
        u32x4 w;
        w.x = pk_bf16(scr[(kc + 0) * 129 + n], scr[(kc + 1) * 129 + n]); w.y = pk_bf16(scr[(kc + 2) * 129 + n], scr[(kc + 3) * 129 + n]);
        w.z = pk_bf16(scr[(kc + 4) * 129 + n], scr[(kc + 5) * 129 + n]); w.w = pk_bf16(scr[(kc + 6) * 129 + n], scr[(kc + 7) * 129 + n]);
        const int f = n0 + n;
        const int drow = mode == 0 ? f : ((f >> 7) * 256 + (mode == 2 ? 128 : 0) + (f & 127));
        *(u32x4*)(dst + (size_t)drow * ldd + koff + k0 + kc) = w;
    }
    __syncthreads();
}

__device__ __forceinline__ void phase0(const Params& p) {
    unsigned char* ws = p.ws;
    if (blockIdx.x == 0 && threadIdx.x < 64) ((unsigned*)(ws + WS_CTL))[threadIdx.x] = 0u;
    constexpr int J0 = 16 * 42, J1 = 8 * 8, J3 = 16 * 8, J4 = 16 * 22, J6 = 44 * 8, J7 = 4, J9 = 8;
    constexpr int NT = J0 + 2 * J1 + J3 + 2 * J4 + J6 + 2 * J7 + J9;
    constexpr int NR = MP / 32;
    for (int it = blockIdx.x; it < NT + NR; it += gridDim.x) {
        if (it >= NR) {
            int r = it - NR;
            if (r < J0) { transpose_tile(p.in[4], D, PIN, (bf16_t*)(ws + WS_WIN), D, 0, 0, r); continue; } r -= J0;
            if (r < J1) { transpose_tile(p.in[16], 512, D, (bf16_t*)(ws + WS_WSB), 512, 0, 0, r); continue; } r -= J1;
            if (r < J1) { transpose_tile(p.in[17], 512, D, (bf16_t*)(ws + WS_WRW), 512, 0, 0, r); continue; } r -= J1;
            if (r < J3) { transpose_tile(p.in[18], D, D, (bf16_t*)(ws + WS_WOUT), D, 0, 0, r); continue; } r -= J3;
            if (r < J4) { transpose_tile(p.in[21], D, DFF, (bf16_t*)(ws + WS_WGU), D, 0, 1, r); continue; } r -= J4;
            if (r < J4) { transpose_tile(p.in[22], D, DFF, (bf16_t*)(ws + WS_WGU), D, 0, 2, r); continue; } r -= J4;
            if (r < J6) { transpose_tile(p.in[23], DFF, D, (bf16_t*)(ws + WS_WD), DFF, 0, 0, r); continue; } r -= J6;
            if (r < J7) { transpose_tile(p.in[6], 64, 512, (bf16_t*)(ws + WS_WL), 256, 0, 0, r); continue; } r -= J7;
            if (r < J7) { transpose_tile(p.in[8], 64, 512, (bf16_t*)(ws + WS_WL), 256, 64, 0, r); continue; } r -= J7;
            transpose_tile(p.in[10], 128, 512, (bf16_t*)(ws + WS_WL), 256, 128, 0, r);
        } else {
            const int lane = threadIdx.x & 63, row0 = it * 32 + (threadIdx.x >> 6) * 4;
            f32x4 v[4][4];
#pragma unroll
            for (int r = 0; r < 4; ++r) {
                const int row = row0 + r, b = row / TP, t = row - b * TP;
                const float* src = t < NMETA ? p.in[1] + (size_t)t * D : p.in[0] + ((size_t)b * SEQ + (t < T ? t - NMETA : 0)) * D;
#pragma unroll
                for (int j = 0; j < 4; ++j) v[r][j] = *(const f32x4*)(src + 4 * lane + 256 * j);
            }
            f32x4 g[4];
#pragma unroll
            for (int j = 0; j < 4; ++j) g[j] = *(const f32x4*)(p.in[2] + 4 * lane + 256 * j);
#pragma unroll
            for (int r = 0; r < 4; ++r) {
                const int row = row0 + r, b = row / TP, t = row - b * TP;
                float ss = 0.f;
#pragma unroll
                for (int j = 0; j < 4; ++j) ss += (v[r][j][0] * v[r][j][0] + v[r][j][1] * v[r][j][1]) + (v[r][j][2] * v[r][j][2] + v[r][j][3] * v[r][j][3]);
                const float rs = t < T ? rsqrtf(wave_sum(ss) * (1.0f / D) + RMS_EPS) : 0.f;
                bf16_t* orow = (bf16_t*)(ws + O_A0) + (size_t)row * D;
#pragma unroll
                for (int j = 0; j < 4; ++j) {
                    u32x2 w; w.x = pk_bf16(v[r][j][0] * rs * g[j][0], v[r][j][1] * rs * g[j][1]); w.y = pk_bf16(v[r][j][2] * rs * g[j][2], v[r][j][3] * rs * g[j][3]);
                    *(u32x2*)(orow + 4 * lane + 256 * j) = w;
                }
            }
        }
    }
}

__device__ __forceinline__ void phase1(const Params& p) {
    unsigned char* ws = p.ws;
    EpiInProj<false> epi{(bf16_t*)(ws + R_QKV), (_Float16*)(ws + R_URW), (bf16_t*)p.out};
    gemm_phase((const bf16_t*)(ws + O_A0), (const bf16_t*)(ws + WS_WIN), D, MP / BM, 7, epi, (int)gridDim.x, (int)blockIdx.x, 0, 6);
}

constexpr int SI_R = 0, SI_W = 1, SI_K = 2, SI_V = 3, SI_KK = 4, SI_B = 5;
constexpr int ALD = 264;
constexpr int P2_WLS = 64 * ALD * 2;
constexpr int P2_MU = P2_WLS;
constexpr int P2_AL = P2_MU + 1024;
__device__ __forceinline__ void phase2_main(const Params& p) {
    unsigned char* ws = p.ws;
    const int tid = threadIdx.x, wave = tid >> 6, lane = tid & 63, fr = lane & 15, fq = lane >> 4;
    const int h = blockIdx.x & 7, nslot = (gridDim.x >> 3) * 8, slot = (blockIdx.x >> 3) * 8 + wave;
    const _Float16* urw = (const _Float16*)(ws + R_URW);
    const float* mu = p.in[5];
    bf16_t* WLs = (bf16_t*)smem;
    float* mus = (float*)(smem + P2_MU);
    bf16_t* Al = (bf16_t*)(smem + P2_AL) + wave * (16 * ALD);
    __syncthreads();
    {
        const bf16_t* WL = (const bf16_t*)(ws + WS_WL) + (size_t)h * 64 * 256;
#pragma unroll
        for (int i = 0; i < 4; ++i) { const int idx = tid + 512 * i, row = idx >> 5, c16 = idx & 31; *(u32x4*)(WLs + row * ALD + c16 * 8) = *(const u32x4*)(WL + row * 256 + c16 * 8); }
        if (tid < 256) mus[tid] = mu[1536 + tid];
    }
    __syncthreads();
    if (blockIdx.x >= nslot) return;
    _Float16* SI = (_Float16*)(ws + R_SI);
    bf16_t* G = (bf16_t*)(ws + R_G);
    constexpr size_t SIE = (size_t)MP * 512;
#pragma unroll 1
    for (int g = slot; g < NB * 514; g += nslot) {
        const int ub = g / 514, ui = g - ub * 514, row0 = ub * TP + ui * 16;
        {
            const int half = lane >> 5, pc = (lane & 31) * 8;
            const float sA = pc < 64 ? 2.f : 1.f, sC = pc < 64 ? -1.f : 0.f;
            const bool lin = pc >= 64 && pc < 128;
            const f32x4 mA = *(const f32x4*)(mu + 1536 + pc), mB = *(const f32x4*)(mu + 1536 + pc + 4);
            h16x8 c[8], pv[8];
#pragma unroll
            for (int q = 0; q < 8; ++q) {
                const int rowa = row0 + 2 * q + half, ta = rowa % TP;
                const _Float16* cur = urw + (size_t)rowa * RWS + 1536 + pc;
                c[q] = *(const h16x8*)cur;
                pv[q] = *(const h16x8*)(ta > 0 ? cur - RWS : cur);
            }
#pragma unroll
            for (int q = 0; q < 8; ++q) {
                const int ta = (row0 + 2 * q + half) % TP;
                float o[8];
#pragma unroll
                for (int e = 0; e < 8; ++e) {
                    const float cf = (float)c[q][e], pf = ta > 0 ? (float)pv[q][e] : 0.f;
                    const float xs = cf + (e < 4 ? mA[e & 3] : mB[e & 3]) * (pf - cf);
                    const float sg = __builtin_amdgcn_rcpf(1.0f + __expf(-sA * xs));
                    o[e] = lin ? xs : sA * sg + sC;
                }
                u32x4 w; w.x = pk_bf16(o[0], o[1]); w.y = pk_bf16(o[2], o[3]); w.z = pk_bf16(o[4], o[5]); w.w = pk_bf16(o[6], o[7]);
                *(u32x4*)(Al + (2 * q + half) * ALD + pc) = w;
            }
        }
        asm volatile("s_waitcnt lgkmcnt(0)" ::: "memory");
        __builtin_amdgcn_wave_barrier();
        f32x4 acc[4];
        auto lora = [&](auto kbeg_c, auto ksteps_c) {
            constexpr int kbeg = decltype(kbeg_c)::value, ksteps = decltype(ksteps_c)::value;
#pragma unroll
            for (int n = 0; n < 4; ++n) acc[n] = (f32x4){0.f, 0.f, 0.f, 0.f};
#pragma unroll
            for (int ks = 0; ks < ksteps; ++ks) {
                const bf16x8 af = *(const bf16x8*)(Al + fr * ALD + kbeg + ks * 32 + fq * 8);
#pragma unroll
                for (int n = 0; n < 4; ++n) {
                    const bf16x8 wf = *(const bf16x8*)(WLs + (n * 16 + fr) * ALD + kbeg + ks * 32 + fq * 8);
                    acc[n] = __builtin_amdgcn_mfma_f32_16x16x32_bf16(wf, af, acc[n], 0, 0, 0);
                }
            }
        };
        const int row = row0 + fr, b = row / TP, t = row - b * TP;
        const size_t base = ((size_t)(b * NH + h) * TP + t) * 64;
        const _Float16* ur = urw + (size_t)row * RWS;
        const size_t pb = base + fq * 16;
        lora(std::integral_constant<int, 0>{}, std::integral_constant<int, 2>{});
        {
            h16x8 wo[2];
#pragma unroll
            for (int n = 0; n < 4; ++n) {
                const f32x4 db = *(const f32x4*)(p.in[7] + h * 64 + n * 16 + fq * 4);
#pragma unroll
                for (int j = 0; j < 4; ++j) {
                    const float wl = -softplusf_(-(db[j] + acc[n][j])) - 0.5f;
                    const float e = __expf(wl);
                    wo[n >> 1][(n & 1) * 4 + j] = (_Float16)(1.0f - __expf(-e));
                }
            }
            *(h16x8*)(SI + SI_W * SIE + pb) = wo[0]; *(h16x8*)(SI + SI_W * SIE + pb + 8) = wo[1];
        }
        lora(std::integral_constant<int, 64>{}, std::integral_constant<int, 2>{});
        {
            const _Float16* up = ur + h * 64 + fq * 16;
            const _Float16* upp = t > 0 ? up - RWS : up;
            h16x8 kc[2], rc[2], vc[2], kp[2], rp[2], vp[2];
#pragma unroll
            for (int i = 0; i < 2; ++i) {
                rc[i] = *(const h16x8*)(up + i * 8); kc[i] = *(const h16x8*)(up + 512 + i * 8); vc[i] = *(const h16x8*)(up + 1024 + i * 8);
                rp[i] = *(const h16x8*)(upp + i * 8); kp[i] = *(const h16x8*)(upp + 512 + i * 8); vp[i] = *(const h16x8*)(upp + 1024 + i * 8);
            }
            float kv[4][4], av[4][4], kkr[4][4]; float ss = 0.f;
            h16x8 ro[2];
#pragma unroll
            for (int n = 0; n < 4; ++n) {
                const int c = n * 16 + fq * 4, c512 = h * 64 + c;
                const f32x4 muk = *(const f32x4*)(mu + 512 + c512), mur = *(const f32x4*)(mu + c512), muv = *(const f32x4*)(mu + 1024 + c512);
                const f32x4 ab = *(const f32x4*)(p.in[9] + c512), kkw = *(const f32x4*)(p.in[11] + c512);
                h16x4 vo;
#pragma unroll
                for (int j = 0; j < 4; ++j) {
                    const int i = n >> 1, e = (n & 1) * 4 + j;
                    const float kcf = (float)kc[i][e], kpf = t > 0 ? (float)kp[i][e] : 0.f;
                    const float rcf = (float)rc[i][e], rpf = t > 0 ? (float)rp[i][e] : 0.f;
                    const float vcf = (float)vc[i][e], vpf = t > 0 ? (float)vp[i][e] : 0.f;
                    kv[n][j] = kcf + muk[j] * (kpf - kcf);
                    ro[i][e] = (_Float16)(rcf + mur[j] * (rpf - rcf));
                    vo[j] = (_Float16)(vcf + muv[j] * (vpf - vcf));
                    av[n][j] = sigmoidf_(ab[j] + acc[n][j]);
                    kkr[n][j] = kv[n][j] * kkw[j];
                    ss += kkr[n][j] * kkr[n][j];
                }
                *(h16x4*)(SI + SI_V * SIE + base + c) = vo;
            }
            *(h16x8*)(SI + SI_R * SIE + pb) = ro[0]; *(h16x8*)(SI + SI_R * SIE + pb + 8) = ro[1];
            ss += __shfl_xor(ss, 16); ss += __shfl_xor(ss, 32);
            const float inv = fminf(__builtin_amdgcn_rsqf(ss), 1e12f);
            h16x8 ko[2], kko[2], bo[2];
#pragma unroll
            for (int n = 0; n < 4; ++n) {
                const f32x4 ka = *(const f32x4*)(p.in[12] + h * 64 + n * 16 + fq * 4);
#pragma unroll
                for (int j = 0; j < 4; ++j) {
                    const int i = n >> 1, e = (n & 1) * 4 + j;
                    const float kk = kkr[n][j] * inv;
                    ko[i][e] = (_Float16)(kv[n][j] * (1.0f + (av[n][j] - 1.0f) * ka[j]));
                    kko[i][e] = (_Float16)kk;
                    bo[i][e] = (_Float16)(kk * av[n][j]);
                }
            }
#pragma unroll
            for (int i = 0; i < 2; ++i) {
                *(h16x8*)(SI + SI_K * SIE + pb + i * 8) = ko[i]; *(h16x8*)(SI + SI_KK * SIE + pb + i * 8) = kko[i]; *(h16x8*)(SI + SI_B * SIE + pb + i * 8) = bo[i];
            }
        }
        lora(std::integral_constant<int, 128>{}, std::integral_constant<int, 4>{});
        {
            u32x4 g0, g1;
            g0.x = pk_bf16(acc[0][0], acc[0][1]); g0.y = pk_bf16(acc[0][2], acc[0][3]); g0.z = pk_bf16(acc[1][0], acc[1][1]); g0.w = pk_bf16(acc[1][2], acc[1][3]);
            g1.x = pk_bf16(acc[2][0], acc[2][1]); g1.y = pk_bf16(acc[2][2], acc[2][3]); g1.z = pk_bf16(acc[3][0], acc[3][1]); g1.w = pk_bf16(acc[3][2], acc[3][3]);
            *(u32x4*)(G + pb) = g0; *(u32x4*)(G + pb + 8) = g1;
        }
        asm volatile("s_waitcnt lgkmcnt(0)" ::: "memory");
        __builtin_amdgcn_wave_barrier();
    }
}
__device__ __forceinline__ void phase2_kmax(const Params& p, int item) {
    unsigned char* ws = p.ws;
    const int bh = item >> 2, qr = item & 3, tid = threadIdx.x;
    float* red = (float*)(smem + P2_AL + 8 * 16 * ALD * 2);
    float ss = 0.f;
    for (int t = qr * 2052 + tid; t < (qr + 1) * 2052; t += 512) {
        const bf16_t* kr = (const bf16_t*)(ws + R_QKV) + QKV_ONE / 2 + ((size_t)bh * TP + t) * 64;
        float s1 = 0.f;
#pragma unroll
        for (int q = 0; q < 8; ++q) {
            const u32x4 v = *(const u32x4*)(kr + q * 8);
#pragma unroll
            for (int e = 0; e < 4; ++e) { const float lo = __uint_as_float(v[e] << 16), hi = __uint_as_float(v[e] & 0xffff0000u); s1 += lo * lo + hi * hi; }
        }
        ss = fmaxf(ss, s1);
    }
#pragma unroll
    for (int o = 1; o < 64; o <<= 1) ss = fmaxf(ss, __shfl_xor(ss, o));
    __syncthreads();
    if ((tid & 63) == 0) red[tid >> 6] = ss;
    __syncthreads();
    if (tid == 0) {
        float m = red[0];
#pragma unroll
        for (int w = 1; w < 8; ++w) m = fmaxf(m, red[w]);
        ((float*)(ws + WS_CTL))[16 + item] = m;
    }
}
__device__ __forceinline__ void phase2(const Params& p) {
    phase2_main(p);
}

constexpr int SC_TC = 32, SC_NC = (T + SC_TC - 1) / SC_TC;
constexpr int SC_ARR = SC_TC * 64;
constexpr int SC_VOFF = 5 * SC_ARR, SC_COFF = SC_VOFF + SC_TC * 16;
constexpr int SC_BUF = (SC_COFF + SC_TC) * 4;
constexpr int SC_YOFF = 2 * SC_BUF, SC_YBUF = SC_TC * 16 * 4;
__device__ __forceinline__ float dot4(const f32x4& a, const f32x4& b) {
    f32x2 t = __builtin_shufflevector(a, a, 0, 1) * __builtin_shufflevector(b, b, 0, 1);
    t = __builtin_shufflevector(a, a, 2, 3) * __builtin_shufflevector(b, b, 2, 3) + t;
    return t[0] + t[1];
}
__device__ __forceinline__ void reduce16x2(float& a, float& b) {
    a += dppf<0xB1>(a); b += dppf<0xB1>(b); a += dppf<0x4E>(a); b += dppf<0x4E>(b);
    a += dppf<0x141>(a); b += dppf<0x141>(b); a += dppf<0x140>(a); b += dppf<0x140>(b);
}
__device__ __forceinline__ void scan_unit(const Params& p, int unit) {
    unsigned char* ws = p.ws;
    const int bh = unit >> 2, vr0 = (unit & 3) * 16, tid = threadIdx.x, wave = tid >> 6, lane = tid & 63;
    const _Float16* SI = (const _Float16*)(ws + R_SI);
    constexpr size_t SIE = (size_t)MP * 512;
    bf16_t* Y = (bf16_t*)(ws + O_Y);
    const size_t hb = (size_t)bh * TP * 64;
    __syncthreads();
    if (wave >= 4) {
        const int i = tid - 256, ip = i >= 8 ? i - 8 : i;
        const int arrs[5] = {SI_R, SI_W, SI_K, SI_KK, SI_B};
        u32x4 rg[5], rp[3]; unsigned rv;
        auto issue = [&](int c) {
            const size_t off = hb + (size_t)c * SC_TC * 64;
#pragma unroll
            for (int a = 0; a < 5; ++a) rg[a] = *(const u32x4*)(SI + arrs[a] * SIE + off + i * 8);
            rp[0] = *(const u32x4*)(SI + SI_W * SIE + off + ip * 8);
            rp[1] = *(const u32x4*)(SI + SI_K * SIE + off + ip * 8);
            rp[2] = *(const u32x4*)(SI + SI_B * SIE + off + ip * 8);
            rv = *(const unsigned*)(SI + SI_V * SIE + off + (i >> 3) * 64 + vr0 + (i & 7) * 2);
        };
        auto commit = [&](int bufi) {
            float* buf = (float*)(smem + bufi * SC_BUF);
            float f[5][8];
#pragma unroll
            for (int a = 0; a < 5; ++a) {
                const h16x8 hv = __builtin_bit_cast(h16x8, rg[a]);
#pragma unroll
                for (int e = 0; e < 8; ++e) f[a][e] = (float)hv[e];
            }
            const bool odd = (i >> 3) & 1;
            float ckk = 0.f, cbk = 0.f;
            {
                const h16x8 pw = __builtin_bit_cast(h16x8, rp[0]), pk = __builtin_bit_cast(h16x8, rp[1]), pb = __builtin_bit_cast(h16x8, rp[2]);
#pragma unroll
                for (int e = 0; e < 8; ++e) {
                    const float kk2 = f[3][e];
                    ckk += (float)pk[e] * kk2; cbk += (float)pb[e] * kk2;
                    if (odd) f[3][e] = (1.0f - (float)pw[e]) * kk2;
                }
            }
            ckk += dppf<0xB1>(ckk); cbk += dppf<0xB1>(cbk); ckk += dppf<0x4E>(ckk); cbk += dppf<0x4E>(cbk); ckk += dppf<0x141>(ckk); cbk += dppf<0x141>(cbk);
#pragma unroll
            for (int a = 0; a < 5; ++a) {
                f32x4 lo, hi;
#pragma unroll
                for (int e = 0; e < 4; ++e) { lo[e] = f[a][e]; hi[e] = f[a][4 + e]; }
                if (a == 1) { lo = 1.0f - lo; hi = 1.0f - hi; }
                if (a == 4) { lo = -lo; hi = -hi; }
                *(f32x4*)(buf + a * SC_ARR + i * 8) = lo; *(f32x4*)(buf + a * SC_ARR + i * 8 + 4) = hi;
            }
            const h16x2 v2 = __builtin_bit_cast(h16x2, rv);
            f32x2 vf; vf[0] = (float)v2[0]; vf[1] = (float)v2[1];
            *(f32x2*)(buf + SC_VOFF + (i >> 3) * 16 + (i & 7) * 2) = vf;
            if (odd && (i & 7) == 0) { f32x2 cf; cf[0] = ckk; cf[1] = cbk; *(f32x2*)(buf + SC_COFF + (i >> 4) * 2) = cf; }
        };
        auto yout = [&](int c) {
            const float* yb = (const float*)(smem + SC_YOFF + (c & 1) * SC_YBUF);
            const f32x2 v = *(const f32x2*)(yb + (i >> 3) * 16 + (i & 7) * 2);
            *(unsigned*)(Y + hb + (size_t)(c * SC_TC + (i >> 3)) * 64 + vr0 + (i & 7) * 2) = pk_bf16(v[0], v[1]);
        };
        issue(0); commit(0); issue(1);
        __syncthreads();
        for (int c = 0; c < SC_NC; ++c) {
            if (c > 0) yout(c - 1);
            if (c + 1 < SC_NC) commit((c + 1) & 1);
            if (c + 2 < SC_NC) issue(c + 2);
            __syncthreads();
        }
        yout(SC_NC - 1);
    } else {
        const int rl = wave * 4 + (lane >> 4), sub = lane & 15;
        const bool odd_lane = lane & 1; const int yoff = (lane & 1) * 16 + rl;
        f32x4 S = {0.f, 0.f, 0.f, 0.f};
        __syncthreads();
        for (int c = 0; c < SC_NC; ++c) {
            const float* buf = (const float*)(smem + (c & 1) * SC_BUF);
            float* yb = (float*)(smem + SC_YOFF + (c & 1) * SC_YBUF);
            const float* bp = buf + sub * 4;
#define SC_LD(arr, s) (*(const f32x4*)(bp + (arr) * SC_ARR + (s) * 64))
            f32x4 r1 = SC_LD(0, 0), w1 = SC_LD(1, 0), k1 = SC_LD(2, 0), q1 = SC_LD(3, 0), n1 = SC_LD(4, 0);
            f32x4 r2 = SC_LD(0, 1), w2 = SC_LD(1, 1), k2 = SC_LD(2, 1), g2 = SC_LD(3, 1), n2 = SC_LD(4, 1);
            float v1 = buf[SC_VOFF + rl], v2 = buf[SC_VOFF + 16 + rl];
            f32x2 cf = *(const f32x2*)(buf + SC_COFF);
#pragma unroll
            for (int pr = 0; pr < SC_TC / 2; ++pr) {
                const int sn = 2 * pr + 2;
                const f32x4 r1n = SC_LD(0, sn), w1n = SC_LD(1, sn), k1n = SC_LD(2, sn), q1n = SC_LD(3, sn), n1n = SC_LD(4, sn);
                const f32x4 r2n = SC_LD(0, sn + 1), w2n = SC_LD(1, sn + 1), k2n = SC_LD(2, sn + 1), g2n = SC_LD(3, sn + 1), n2n = SC_LD(4, sn + 1);
                const float v1n = buf[SC_VOFF + sn * 16 + rl], v2n = buf[SC_VOFF + (sn + 1) * 16 + rl];
                const f32x2 cfn = *(const f32x2*)(buf + SC_COFF + (pr + 1) * 2);
                __builtin_amdgcn_sched_barrier(0x7);
                float d1 = dot4(S, q1), e2 = dot4(S, g2);
                const f32x4 t1 = S * w1 + v1 * k1;
                reduce16x2(d1, e2);
                const float d2 = e2 + v1 * cf[0] - d1 * cf[1];
                const f32x4 S1 = t1 + d1 * n1;
                const f32x4 S2 = (S1 * w2 + v2 * k2) + d2 * n2;
                float y1 = dot4(S1, r1), y2 = dot4(S2, r2);
                y1 += dppf<0xB1>(y1); y2 += dppf<0xB1>(y2);
                float yz = odd_lane ? y2 : y1;
                yz += dppf<0x122>(yz); yz += dppf<0x124>(yz); yz += dppf<0x128>(yz);
                yb[(2 * pr) * 16 + yoff] = yz;
                S = S2;
                r1 = r1n; w1 = w1n; k1 = k1n; q1 = q1n; n1 = n1n; r2 = r2n; w2 = w2n; k2 = k2n; g2 = g2n; n2 = n2n; v1 = v1n; v2 = v2n; cf = cfn;
            }
#undef SC_LD
            __syncthreads();
        }
    }
}

constexpr int KLD = 72;
__device__ __forceinline__ void attn_unit(const Params& p, int unit) {
    unsigned char* ws = p.ws;
    const int qt = unit % 65, bh = unit / 65, b = bh >> 3, h = bh & 7;
    const int tid = threadIdx.x, wave = tid >> 6, lane = tid & 63, fr = lane & 15, fq = lane >> 4;
    const bf16_t* Q = (const bf16_t*)(ws + R_QKV) + (size_t)bh * TP * 64;
    const bf16_t* Kg = Q + QKV_ONE / 2;
    const bf16_t* Vg = Q + QKV_ONE;
    bf16_t* slots = (bf16_t*)smem;
    constexpr int SLOT = 2 * 64 * KLD;
    volatile int* flags = (volatile int*)(smem + 2 * SLOT * 2);
    const int t0 = qt * 128, tq = t0 + wave * 16 + fr;
    bf16x8 qf[2];
    qf[0] = *(const bf16x8*)(Q + (size_t)tq * 64 + fq * 8);
    qf[1] = *(const bf16x8*)(Q + (size_t)tq * 64 + 32 + fq * 8);
    float qs = 0.f;
#pragma unroll
    for (int s = 0; s < 2; ++s)
#pragma unroll
        for (int e = 0; e < 8; ++e) { const float f = bf2f((unsigned short)qf[s][e]); qs += f * f; }
    qs += __shfl_xor(qs, 16); qs += __shfl_xor(qs, 32);
    const f32x4 km4 = *(const f32x4*)((const float*)(ws + WS_CTL) + 16 + bh * 4);
    const float kmax = sqrtf(fmaxf(fmaxf(km4[0], km4[1]), fmaxf(km4[2], km4[3])));
    const float zb = sqrtf(qs) * kmax * 1.0001f + 88.0f;
    float Arow = 0.f;
    f32x4 O[4];
#pragma unroll
    for (int nd = 0; nd < 4; ++nd) O[nd] = (f32x4){0.f, 0.f, 0.f, 0.f};
    const int key = tid >> 3, dc = (tid & 7) * 8, half = wave >> 2;
    auto tile_store = [&](int blk, const u32x4& kv, const u32x4& vv) {
        bf16_t* Ks_ = slots + (blk & 1) * SLOT; bf16_t* Vt_ = Ks_ + 64 * KLD;
        *(u32x4*)(Ks_ + key * KLD + dc) = kv;
#pragma unroll
        for (int e = 0; e < 4; ++e) { Vt_[(dc + 2 * e) * KLD + key] = (bf16_t)(vv[e] & 0xffffu); Vt_[(dc + 2 * e + 1) * KLD + key] = (bf16_t)(vv[e] >> 16); }
    };
    const int ktop = qt * 2 + 1;
    {
        const u32x4 k0 = *(const u32x4*)(Kg + (size_t)(ktop * 64 + key) * 64 + dc), v0 = *(const u32x4*)(Vg + (size_t)(ktop * 64 + key) * 64 + dc);
        __syncthreads();
        tile_store(ktop, k0, v0);
    }
    u32x4 kvv = *(const u32x4*)(Kg + (size_t)((ktop - 1) * 64 + key) * 64 + dc);
    u32x4 vvv = *(const u32x4*)(Vg + (size_t)((ktop - 1) * 64 + key) * 64 + dc);
    for (int kt = ktop; kt >= 0; --kt) {
        const int kb = kt - 1 + half;
        const bool done = __all(Arow > zb) || kb < 0;
        if (lane == 0) flags[wave] = done ? 1 : 0;
        __syncthreads();
        int alld = 1;
#pragma unroll
        for (int w = 0; w < 8; ++w) alld &= flags[w];
        if (alld) break;
        if (kt >= 1) {
            tile_store(kt - 1, kvv, vvv);
            if (kt >= 2) {
                kvv = *(const u32x4*)(Kg + (size_t)((kt - 2) * 64 + key) * 64 + dc);
                vvv = *(const u32x4*)(Vg + (size_t)((kt - 2) * 64 + key) * 64 + dc);
            }
        }
        asm volatile("s_waitcnt lgkmcnt(0)" ::: "memory");
        __builtin_amdgcn_s_barrier();
        if (kb < 0) continue;
        const bf16_t* Ks = slots + (kb & 1) * SLOT; const bf16_t* Vt = Ks + 64 * KLD;
        f32x4 z[4];
#pragma unroll
        for (int n = 0; n < 4; ++n) {
            z[n] = (f32x4){0.f, 0.f, 0.f, 0.f};
#pragma unroll
            for (int s = 0; s < 2; ++s) {
                const bf16x8 kf = *(const bf16x8*)(Ks + (n * 16 + fr) * KLD + s * 32 + fq * 8);
                z[n] = __builtin_amdgcn_mfma_f32_16x16x32_bf16(kf, qf[s], z[n], 0, 0, 0);
            }
        }
        float sp[4][4], lt[4], ex[4], sg[4];
#pragma unroll
        for (int n = 0; n < 4; ++n) {
#pragma unroll
            for (int j = 0; j < 4; ++j) { const int s = kb * 64 + n * 16 + fq * 4 + j; sp[n][j] = s < tq ? softplusf_(z[n][j]) : 0.f; }
            sp[n][2] += sp[n][3]; sp[n][1] += sp[n][2]; sp[n][0] += sp[n][1];
            lt[n] = sp[n][0];
            const float a = __shfl_xor(lt[n], 16), pr = lt[n] + a, c = __shfl_xor(pr, 32);
            ex[n] = fq == 3 ? 0.f : (fq == 2 ? a : (fq == 1 ? c : a + c));
            sg[n] = pr + c;
        }
        float nsuf[4]; nsuf[3] = 0.f; nsuf[2] = sg[3]; nsuf[1] = nsuf[2] + sg[2]; nsuf[0] = nsuf[1] + sg[1];
        float wgt[4][4];
#pragma unroll
        for (int n = 0; n < 4; ++n)
#pragma unroll
            for (int j = 0; j < 4; ++j) {
                const int s = kb * 64 + n * 16 + fq * 4 + j;
                const float C = Arow + nsuf[n] + ex[n] + sp[n][j];
                wgt[n][j] = s < tq ? __expf(z[n][j] - C) : 0.f;
            }
        Arow += nsuf[0] + sg[0];
#pragma unroll
        for (int ks = 0; ks < 2; ++ks) {
            u32x4 pw; pw.x = pk_bf16(wgt[2 * ks][0], wgt[2 * ks][1]); pw.y = pk_bf16(wgt[2 * ks][2], wgt[2 * ks][3]);
            pw.z = pk_bf16(wgt[2 * ks + 1][0], wgt[2 * ks + 1][1]); pw.w = pk_bf16(wgt[2 * ks + 1][2], wgt[2 * ks + 1][3]);
            const bf16x8 pf = __builtin_bit_cast(bf16x8, pw);
#pragma unroll
            for (int nd = 0; nd < 4; ++nd) {
                u32x4 vw;
                const u32x2 v0 = *(const u32x2*)(Vt + (nd * 16 + fr) * KLD + (2 * ks) * 16 + fq * 4);
                const u32x2 v1 = *(const u32x2*)(Vt + (nd * 16 + fr) * KLD + (2 * ks + 1) * 16 + fq * 4);
                vw.x = v0.x; vw.y = v0.y; vw.z = v1.x; vw.w = v1.y;
                O[nd] = __builtin_amdgcn_mfma_f32_16x16x32_bf16(pf, __builtin_bit_cast(bf16x8, vw), O[nd], 0, 0, 0);
            }
        }
    }
    __syncthreads();
    bf16_t* osb = (bf16_t*)(ws + O_OSB);
#pragma unroll
    for (int j = 0; j < 4; ++j) {
        const int t = t0 + wave * 16 + fq * 4 + j;
        if (t >= NMETA && t < T) {
#pragma unroll
            for (int nd = 0; nd < 4; ++nd) osb[(size_t)(b * SEQ + t - NMETA) * 512 + h * 64 + nd * 16 + fr] = (bf16_t)(pk_bf16(O[nd][j], 0.f) & 0xffffu);
        }
    }
}

constexpr int N_SCAN = 128, N_ATTN = 32 * 65;
__device__ __forceinline__ void sub_barrier(unsigned* ctr, unsigned target, bool arrive) {
    asm volatile("s_waitcnt vmcnt(0)" ::: "memory");
    __syncthreads();
    if (threadIdx.x == 0) {
        if (arrive) { __builtin_amdgcn_fence(__ATOMIC_RELEASE, "agent"); asm volatile("s_waitcnt vmcnt(0)" ::: "memory"); (void)xb_add(ctr, 1u); }
        unsigned sp = 0u;
        while (xb_ld(ctr) < target) { __builtin_amdgcn_s_sleep(2); if (++sp > (1u << 22)) break; }
        __builtin_amdgcn_fence(__ATOMIC_ACQUIRE, "agent");
        asm volatile("s_waitcnt vmcnt(0)" ::: "memory");
    }
    __syncthreads();
}
__device__ __forceinline__ void phase3(const Params& p) {
    unsigned char* ws = p.ws;
    unsigned* ctl = (unsigned*)(ws + WS_CTL);
    const int nother = (int)gridDim.x - N_SCAN;
    if ((int)blockIdx.x < N_SCAN) {
        scan_unit(p, blockIdx.x);
    } else {
        EpiInProj<true> epi{(bf16_t*)(ws + R_QKV), (_Float16*)(ws + R_URW), (bf16_t*)p.out};
        gemm_phase((const bf16_t*)(ws + O_A0), (const bf16_t*)(ws + WS_WIN), D, MP / BM, 14, epi, nother, (int)blockIdx.x - N_SCAN, 6, 7);
        sub_barrier(ctl + 256, (unsigned)nother, true);
        for (int it = (int)blockIdx.x - N_SCAN; it < 128; it += nother) phase2_kmax(p, it);
        sub_barrier(ctl + 320, (unsigned)nother, true);
    }
    sub_barrier(ctl + 320, (unsigned)nother, false);
    volatile int* slot = (volatile int*)(smem + 131072 - 16);
    for (;;) {
        __syncthreads();
        if (threadIdx.x == 0) *slot = (int)atomicAdd(ctl, 1u);
        __syncthreads();
        const int u = *slot;
        if (u >= N_ATTN) break;
        attn_unit(p, u);
    }
}

__device__ __forceinline__ void phase3c(const Params& p) {
    unsigned char* ws = p.ws;
    const _Float16* SI = (const _Float16*)(ws + R_SI);
    constexpr size_t SIE = (size_t)MP * 512;
    const bf16_t* Y = (const bf16_t*)(ws + O_Y);
    const bf16_t* G = (const bf16_t*)(ws + R_G);
    bf16_t* orw = (bf16_t*)(ws + O_ORW);
    const int tid = threadIdx.x, sub = tid & 15;
    constexpr int U = 4;
    for (int it = blockIdx.x; it < 32 * 64; it += gridDim.x) {
        const int bh = it >> 6, c4 = it & 63, b = bh >> 3, h = bh & 7;
        const int c = h * 64 + sub * 4;
        const f32x4 gain = *(const f32x4*)(p.in[14] + c), bias = *(const f32x4*)(p.in[15] + c), rk = *(const f32x4*)(p.in[13] + c);
        u32x2 yb2[U]; f32x4 y[U]; h16x4 r4[U], k4[U], v4[U]; u32x2 g2[U];
#pragma unroll
        for (int u = 0; u < U; ++u) {
            const int t = NMETA + (c4 * U + u) * 32 + (tid >> 4);
            const size_t base = ((size_t)bh * TP + t) * 64 + sub * 4;
            const size_t pbase = ((size_t)bh * TP + t) * 64 + (sub & 3) * 16 + (sub >> 2) * 4;
            yb2[u] = *(const u32x2*)(Y + base);
            r4[u] = *(const h16x4*)(SI + SI_R * SIE + pbase); k4[u] = *(const h16x4*)(SI + SI_K * SIE + pbase); v4[u] = *(const h16x4*)(SI + SI_V * SIE + base);
            g2[u] = *(const u32x2*)(G + pbase);
        }
#pragma unroll
        for (int u = 0; u < U; ++u) {
            const int t = NMETA + (c4 * U + u) * 32 + (tid >> 4);
            y[u][0] = __uint_as_float(yb2[u].x << 16); y[u][1] = __uint_as_float(yb2[u].x & 0xffff0000u); y[u][2] = __uint_as_float(yb2[u].y << 16); y[u][3] = __uint_as_float(yb2[u].y & 0xffff0000u);
            const float mean = reduce16((y[u][0] + y[u][1]) + (y[u][2] + y[u][3])) * (1.0f / 64.0f);
            const f32x4 dy = y[u] - mean;
            const float var = reduce16((dy[0] * dy[0] + dy[1] * dy[1]) + (dy[2] * dy[2] + dy[3] * dy[3])) * (1.0f / 64.0f);
            const float rs = rsqrtf(var + GN_EPS);
            float bs = 0.f;
#pragma unroll
            for (int j = 0; j < 4; ++j) bs += (float)r4[u][j] * (float)k4[u][j] * rk[j];
            bs = reduce16(bs);
            const float gg[4] = {__uint_as_float(g2[u].x << 16), __uint_as_float(g2[u].x & 0xffff0000u), __uint_as_float(g2[u].y << 16), __uint_as_float(g2[u].y & 0xffff0000u)};
            float o[4];
#pragma unroll
            for (int j = 0; j < 4; ++j) o[j] = (dy[j] * rs * gain[j] + bias[j] + bs * (float)v4[u][j]) * gg[j];
            u32x2 w; w.x = pk_bf16(o[0], o[1]); w.y = pk_bf16(o[2], o[3]);
            *(u32x2*)(orw + (size_t)(b * SEQ + t - NMETA) * 512 + c) = w;
        }
    }
}

__device__ __forceinline__ void phase4(const Params& p) {
    unsigned char* ws = p.ws;
    EpiBranch1 e1{(bf16_t*)(ws + O_T1), (const bf16_t*)p.out};
    EpiBranch2 e2{(const bf16_t*)(ws + O_T1), (const bf16_t*)p.out, (bf16_t*)(ws + O_M)};
    gemm_phase((const bf16_t*)(ws + O_OSB), (const bf16_t*)(ws + WS_WSB), 512, MS / BM, D / BM, e1);
    gemm_phase((const bf16_t*)(ws + O_ORW), (const bf16_t*)(ws + WS_WRW), 512, MS / BM, D / BM, e2);
}
__device__ __forceinline__ void phase5(const Params& p) {
    unsigned char* ws = p.ws;
    EpiF32 e{(float*)(ws + O_P)};
    gemm_phase((const bf16_t*)(ws + O_M), (const bf16_t*)(ws + WS_WOUT), D, MS / BM, D / BM, e);
}
__device__ __forceinline__ void phase6(const Params& p) {
    unsigned char* ws = p.ws;
    const int lane = threadIdx.x & 63;
    f32x4 g1[4], g2[4];
#pragma unroll
    for (int j = 0; j < 4; ++j) { g1[j] = *(const f32x4*)(p.in[3] + 4 * lane + 256 * j); g2[j] = *(const f32x4*)(p.in[19] + 4 * lane + 256 * j); }
    for (int it = blockIdx.x; it < MS / 16; it += gridDim.x) {
        const int row0 = it * 16 + (threadIdx.x >> 6) * 2;
        f32x4 v[2][4], x[2][4];
#pragma unroll
        for (int r = 0; r < 2; ++r)
#pragma unroll
            for (int j = 0; j < 4; ++j) {
                v[r][j] = *(const f32x4*)((const float*)(ws + O_P) + (size_t)(row0 + r) * D + 4 * lane + 256 * j);
                x[r][j] = *(const f32x4*)(p.in[0] + (size_t)(row0 + r) * D + 4 * lane + 256 * j);
            }
#pragma unroll
        for (int r = 0; r < 2; ++r) {
            const int row = row0 + r;
            float ss = 0.f;
#pragma unroll
            for (int j = 0; j < 4; ++j) ss += (v[r][j][0] * v[r][j][0] + v[r][j][1] * v[r][j][1]) + (v[r][j][2] * v[r][j][2] + v[r][j][3] * v[r][j][3]);
            const float rs = rsqrtf(wave_sum(ss) * (1.0f / D) + RMS_EPS);
            float s2 = 0.f;
#pragma unroll
            for (int j = 0; j < 4; ++j) {
                v[r][j] = x[r][j] + v[r][j] * rs * g1[j];
                *(f32x4*)(p.out + (size_t)row * D + 4 * lane + 256 * j) = v[r][j];
                s2 += (v[r][j][0] * v[r][j][0] + v[r][j][1] * v[r][j][1]) + (v[r][j][2] * v[r][j][2] + v[r][j][3] * v[r][j][3]);
            }
            const float rs2 = rsqrtf(wave_sum(s2) * (1.0f / D) + RMS_EPS);
            bf16_t* fr_ = (bf16_t*)(ws + O_F) + (size_t)row * D;
#pragma unroll
            for (int j = 0; j < 4; ++j) {
                u32x2 w; w.x = pk_bf16(v[r][j][0] * rs2 * g2[j][0], v[r][j][1] * rs2 * g2[j][1]); w.y = pk_bf16(v[r][j][2] * rs2 * g2[j][2], v[r][j][3] * rs2 * g2[j][3]);
                *(u32x2*)(fr_ + 4 * lane + 256 * j) = w;
            }
        }
    }
}
__device__ __forceinline__ void phase7(const Params& p) {
    unsigned char* ws = p.ws;
    EpiGU e{(bf16_t*)(ws + O_ACT)};
    gemm_phase((const bf16_t*)(ws + O_F), (const bf16_t*)(ws + WS_WGU), D, MS / BM, 2 * DFF / BM, e);
}
__device__ __forceinline__ void phase8(const Params& p) {
    unsigned char* ws = p.ws;
    EpiF32 e{(float*)(ws + O_DN)};
    gemm_phase((const bf16_t*)(ws + O_ACT), (const bf16_t*)(ws + WS_WD), DFF, MS / BM, D / BM, e);
}
__device__ __forceinline__ void phase9(const Params& p) {
    unsigned char* ws = p.ws;
    const int lane = threadIdx.x & 63;
    f32x4 g[4];
#pragma unroll
    for (int j = 0; j < 4; ++j) g[j] = *(const f32x4*)(p.in[20] + 4 * lane + 256 * j);
    for (int it = blockIdx.x; it < MS / 16; it += gridDim.x) {
        const int row0 = it * 16 + (threadIdx.x >> 6) * 2;
        f32x4 v[2][4], h1[2][4];
#pragma unroll
        for (int r = 0; r < 2; ++r)
#pragma unroll
            for (int j = 0; j < 4; ++j) {
                v[r][j] = *(const f32x4*)((const float*)(ws + O_DN) + (size_t)(row0 + r) * D + 4 * lane + 256 * j);
                h1[r][j] = *(const f32x4*)(p.out + (size_t)(row0 + r) * D + 4 * lane + 256 * j);
            }
#pragma unroll
        for (int r = 0; r < 2; ++r) {
            float ss = 0.f;
#pragma unroll
            for (int j = 0; j < 4; ++j) ss += (v[r][j][0] * v[r][j][0] + v[r][j][1] * v[r][j][1]) + (v[r][j][2] * v[r][j][2] + v[r][j][3] * v[r][j][3]);
            const float rs = rsqrtf(wave_sum(ss) * (1.0f / D) + RMS_EPS);
#pragma unroll
            for (int j = 0; j < 4; ++j) *(f32x4*)(p.out + (size_t)(row0 + r) * D + 4 * lane + 256 * j) = h1[r][j] + v[r][j] * rs * g[j];
        }
    }
}

constexpr int N_PHASES = 11;
__device__ __forceinline__ void run_phase(const Params& p, int ph) {
    switch (ph) {
        case 0: phase0(p); break;
        case 1: phase1(p); break;
        case 2: phase2(p); break;
        case 3: phase3(p); break;
        case 4: phase3c(p); break;
        case 5: phase4(p); break;
        case 6: phase5(p); break;
        case 7: phase6(p); break;
        case 8: phase7(p); break;
        case 9: phase8(p); break;
        default: phase9(p); break;
    }
}

#if MULTI_LAUNCH
template <int PH> __global__ void __launch_bounds__(512) fwd_phase(Params p) { run_phase(p, PH); }
#else
__global__ void __launch_bounds__(512) fwd_mega(Params p) {
    cg::grid_group grid = cg::this_grid();
    volatile LAS unsigned* st = (volatile LAS unsigned*)(smem + 131072);
    if (threadIdx.x == 0) { st[0] = 0u; st[1] = 0u; }
    __syncthreads();
    const XcdBarrier xb = xcd_barrier_post((unsigned*)(p.ws + WS_BAR), st);
    if (p.out == nullptr) grid.sync();
    phase0(p); xcd_barrier(xb); phase1(p); xcd_barrier(xb); phase2(p); xcd_barrier(xb); phase3(p); xcd_barrier(xb); phase3c(p); xcd_barrier(xb);
    phase4(p); xcd_barrier(xb); phase5(p); xcd_barrier(xb); phase6(p); xcd_barrier(xb); phase7(p); xcd_barrier(xb); phase8(p); xcd_barrier(xb); phase9(p);
}
#endif

extern "C" void kernel_launch(void* const* d_in, const int* in_sizes, int n_in, void* d_out, int out_size, void* d_ws, size_t ws_size, hipStream_t stream) {
    static int grid = 0;
    if (grid == 0) {
        if (n_in != 24 || out_size != MS * D || ws_size < WS_END) { fprintf(stderr, "kernel_launch: unexpected shapes (n_in %d out %d ws %zu need %zu)\n", n_in, out_size, ws_size, (size_t)WS_END); grid = -1; return; }
        int dev = 0, cus = 0, per_cu = 0;
        (void)hipGetDevice(&dev);
        (void)hipDeviceGetAttribute(&cus, hipDeviceAttributeMultiprocessorCount, dev);
#if MULTI_LAUNCH
        per_cu = 1;
#else
        (void)hipFuncSetAttribute((const void*)fwd_mega, hipFuncAttributeMaxDynamicSharedMemorySize, LDS_BYTES);
        (void)hipOccupancyMaxActiveBlocksPerMultiprocessor(&per_cu, (const void*)fwd_mega, 512, LDS_BYTES);
        if (per_cu < 1) { fprintf(stderr, "kernel_launch: occupancy query says %d blocks per CU\n", per_cu); per_cu = 1; }
        if (per_cu > 1) per_cu = 1;
#endif
        grid = cus * per_cu;
        if (grid <= N_SCAN) { fprintf(stderr, "kernel_launch: grid %d too small (needs more than %d workgroups)\n", grid, N_SCAN); grid = -1; return; }
    }
    if (grid < 0) return;
    Params p{};
    for (int i = 0; i < 24; ++i) p.in[i] = (const float*)d_in[i];
    p.out = (float*)d_out; p.ws = (unsigned char*)d_ws;
#if MULTI_LAUNCH
#define LP(PH) do { (void)hipFuncSetAttribute((const void*)fwd_phase<PH>, hipFuncAttributeMaxDynamicSharedMemorySize, LDS_BYTES); hipLaunchKernelGGL(fwd_phase<PH>, dim3(grid), dim3(512), LDS_BYTES, stream, p); } while (0)
    LP(0); LP(1); LP(2); LP(3); LP(4); LP(5); LP(6); LP(7); LP(8); LP(9); LP(10);
#undef LP
#else
    if (hipMemsetAsync(d_ws, 0, WS_CTL_BYTES, stream) != hipSuccess) { fprintf(stderr, "kernel_launch: hipMemsetAsync of the control words failed\n"); return; }
    void* args[] = {&p};
    hipError_t e = hipLaunchCooperativeKernel((const void*)fwd_mega, dim3(grid), dim3(512), args, LDS_BYTES, stream);
    if (e != hipSuccess) fprintf(stderr, "cooperative launch failed: %s (grid %d)\n", hipGetErrorString(e), grid);
#endif
}
```

```cpp
#include <hip/hip_runtime.h>
#include <hip/hip_cooperative_groups.h>
#include <cstdio>
#include <cstdint>
#include <type_traits>
namespace cg = cooperative_groups;

#ifndef MULTI_LAUNCH
#define MULTI_LAUNCH 0
#endif

typedef unsigned short bf16_t;
typedef short bf16x8 __attribute__((ext_vector_type(8)));
typedef float f32x4 __attribute__((ext_vector_type(4)));
typedef float f32x2 __attribute__((ext_vector_type(2)));
typedef unsigned u32x2 __attribute__((ext_vector_type(2)));
typedef unsigned u32x4 __attribute__((ext_vector_type(4)));
typedef _Float16 h16x2 __attribute__((ext_vector_type(2)));
typedef _Float16 h16x4 __attribute__((ext_vector_type(4)));
typedef _Float16 h16x8 __attribute__((ext_vector_type(8)));

constexpr int D = 1024, NB = 4, SEQ = 8192, NMETA = 16, T = SEQ + NMETA, TP = 8320, MP = NB * TP, MS = NB * SEQ;
constexpr int PIN = 5376, DFF = 2816, NH = 8, RWS = 1792;
constexpr float RMS_EPS = 1e-6f, GN_EPS = 64e-5f;

constexpr size_t WS_CTL = 0;
constexpr size_t WS_BAR = 4096;
constexpr size_t WS_CTL_BYTES = 32768;
constexpr size_t WS_WIN = WS_CTL_BYTES;
constexpr size_t WS_WSB = WS_WIN + (size_t)PIN * D * 2;
constexpr size_t WS_WRW = WS_WSB + (size_t)D * 512 * 2;
constexpr size_t WS_WOUT = WS_WRW + (size_t)D * 512 * 2;
constexpr size_t WS_WGU = WS_WOUT + (size_t)D * D * 2;
constexpr size_t WS_WD = WS_WGU + (size_t)2 * DFF * D * 2;
constexpr size_t WS_WL = WS_WD + (size_t)D * DFF * 2;
constexpr size_t R_A0 = WS_WL + (size_t)512 * 256 * 2;
constexpr size_t R_URW = R_A0 + (size_t)MP * D * 2;
constexpr size_t R_QKV = R_URW;
constexpr size_t QKV_ONE = (size_t)MP * 512 * 2;
constexpr size_t R_SI = R_URW + (size_t)MP * RWS * 2;
constexpr size_t SI_ONE = (size_t)MP * 512 * 2;
constexpr size_t R_G = R_SI + 6 * SI_ONE;
constexpr size_t R_TAIL = R_G + SI_ONE;
constexpr size_t O_Y = R_TAIL;
constexpr size_t O_OSB = R_TAIL + SI_ONE;
constexpr size_t WS_END = O_OSB + (size_t)MS * 512 * 2;
constexpr size_t O_A0 = R_A0;
constexpr size_t O_ORW = R_A0;
constexpr size_t O_T1 = R_SI;
constexpr size_t O_M = R_SI + (size_t)MS * D * 4;
constexpr size_t O_P = R_A0;
constexpr size_t O_F = R_SI;
constexpr size_t O_ACT = R_A0;
constexpr size_t O_DN = R_SI + (size_t)MS * D * 2;
static_assert(3 * QKV_ONE <= (size_t)MP * RWS * 2, "overlay");
static_assert(O_M + (size_t)MS * D * 2 <= R_TAIL, "overlay");
static_assert(O_ACT + (size_t)MS * DFF * 2 <= R_SI, "overlay");
static_assert(O_P + (size_t)MS * D * 4 <= R_SI, "overlay");
static_assert(O_DN + (size_t)MS * D * 4 <= R_TAIL, "overlay");
static_assert(WS_END <= (size_t)512 * 1024 * 1024, "workspace");

constexpr int LDS_BYTES = 131072 + 64;

struct Params { const float* in[24]; float* out; unsigned char* ws; };

extern __shared__ __attribute__((aligned(16))) unsigned char smem[];

typedef __bf16 b16x2 __attribute__((ext_vector_type(2)));
__device__ __forceinline__ unsigned pk_bf16(float lo, float hi) { const f32x2 v = {lo, hi}; return __builtin_bit_cast(unsigned, __builtin_convertvector(v, b16x2)); }
__device__ __forceinline__ float bf2f(unsigned short v) { return __uint_as_float((unsigned)v << 16); }
__device__ __forceinline__ float sigmoidf_(float x) { return __builtin_amdgcn_rcpf(1.0f + __expf(-x)); }
__device__ __forceinline__ float softplusf_(float x) { return fmaxf(x, 0.f) + __logf(1.0f + __expf(-fabsf(x))); }
template <int CTRL> __device__ __forceinline__ float dppf(float x) { return __builtin_bit_cast(float, __builtin_amdgcn_mov_dpp(__builtin_bit_cast(int, x), CTRL, 0xf, 0xf, true)); }
__device__ __forceinline__ float reduce16(float v) {
    v += dppf<0xB1>(v); v += dppf<0x4E>(v); v += dppf<0x141>(v); v += dppf<0x140>(v); return v;
}
__device__ __forceinline__ float wave_sum(float v) {
#pragma unroll
    for (int o = 1; o < 64; o <<= 1) v += __shfl_xor(v, o);
    return v;
}

#define LAS __attribute__((address_space(3)))
#define XB_TMO      128
#define XB_XCNT(j)  (256  + 64 * (j))
#define XB_XSUB(j)  (1280 + 64 * (j))
#define XB_XGEN(j)  (2304 + 64 * (j))
#define XB_TOP      3328
#define XB_TOPGEN   3392
#define XCD_BAR_WORDS 3456
#define XB_SPIN_CAP (1u << 18)
__device__ __forceinline__ unsigned xb_ld(unsigned* p)              { return __hip_atomic_load(p, __ATOMIC_RELAXED, __HIP_MEMORY_SCOPE_AGENT); }
__device__ __forceinline__ unsigned xb_add(unsigned* p, unsigned v) { return __hip_atomic_fetch_add(p, v, __ATOMIC_RELAXED, __HIP_MEMORY_SCOPE_AGENT); }
__device__ __forceinline__ unsigned xb_xcc_id() { return (unsigned)__builtin_amdgcn_s_getreg((3 << 11) | 20) & 0xFu; }
#define XB_SPIN(cond, bar) do { unsigned _sp = 0; while (cond) { __builtin_amdgcn_s_sleep(1); \
    if ((++_sp & 255u) == 0u) { if (xb_ld(&(bar)[XB_TMO])) break; if (_sp > XB_SPIN_CAP) { atomicAdd(&(bar)[XB_TMO], 1u); break; } } } } while (0)
struct XcdBarrier { unsigned* bar; unsigned x; volatile LAS unsigned* st; };
__device__ __forceinline__ XcdBarrier xcd_barrier_post(unsigned* bar, volatile LAS unsigned* st) {
    XcdBarrier b; b.bar = bar; b.x = xb_xcc_id(); b.st = st;
    if (threadIdx.x == 0) (void)xb_add(&bar[XB_XCNT(b.x)], 1u);
    return b;
}
__device__ __forceinline__ void xcd_barrier_complete(unsigned* bar, unsigned x, unsigned& nloc, unsigned& nx) {
    const unsigned G = gridDim.x * gridDim.y * gridDim.z;
    unsigned sum, cnt, mine, sp = 0u;
    for (;;) {
        sum = 0u; cnt = 0u; mine = 0u;
#pragma unroll
        for (unsigned j = 0; j < 16; ++j) { const unsigned c = xb_ld(&bar[XB_XCNT(j)]); sum += c; cnt += (c > 0u) ? 1u : 0u; mine = (j == x) ? c : mine; }
        if (sum == G) break;
        __builtin_amdgcn_s_sleep(1);
        if ((++sp & 255u) == 0u) { if (xb_ld(&bar[XB_TMO])) break; if (sp > XB_SPIN_CAP) { atomicAdd(&bar[XB_TMO], 1u); break; } }
    }
    nloc = mine > 0u ? mine : 1u; nx = cnt > 0u ? cnt : 1u;
}
__device__ __forceinline__ void xcd_barrier(const XcdBarrier& b) {
    asm volatile("s_waitcnt vmcnt(0)" ::: "memory");
    __syncthreads();
    if (threadIdx.x == 0) {
        unsigned* bar = b.bar;
        __builtin_amdgcn_s_waitcnt(0);
        unsigned nloc = b.st[0], nx = b.st[1];
        if (nloc == 0u) { xcd_barrier_complete(bar, b.x, nloc, nx); b.st[0] = nloc; b.st[1] = nx; }
        const unsigned old = xb_add(&bar[XB_XSUB(b.x)], 1u);
        const unsigned gen = old / nloc;
        if (old + 1u == (gen + 1u) * nloc) {
            __builtin_amdgcn_fence(__ATOMIC_RELEASE, "agent");
            asm volatile("s_waitcnt vmcnt(0)" ::: "memory");
            const unsigned og = xb_add(&bar[XB_TOP], 1u);
            const unsigned tg = og / nx;
            if (og + 1u == (tg + 1u) * nx) xb_add(&bar[XB_TOPGEN], 1u);
            else XB_SPIN(xb_ld(&bar[XB_TOPGEN]) == tg, bar);
            __builtin_amdgcn_fence(__ATOMIC_ACQUIRE, "agent");
            xb_add(&bar[XB_XGEN(b.x)], 1u);
            asm volatile("s_waitcnt vmcnt(0)" ::: "memory");
        } else {
            XB_SPIN(xb_ld(&bar[XB_XGEN(b.x)]) == gen, bar);
            __builtin_amdgcn_fence(__ATOMIC_ACQUIRE, "agent");
            asm volatile("s_waitcnt vmcnt(0)" ::: "memory");
        }
    }
    __syncthreads();
}

constexpr int BM = 256, BK = 64, HALF = 128, HTB = HALF * BK * 2, NXCD = 8, WGM = 8;
__device__ __forceinline__ int lds_byte(int r, int c) { const int st = (r >> 4) * 2 + (c >> 5), rr = r & 15, cc = c & 31, ob = rr * 64 + cc * 2; return st * 1024 + (ob ^ (((ob >> 9) & 1) << 5)); }
__device__ __forceinline__ void stage_rc(int b, int& R, int& C) { const int st = b / 1024, sb = b % 1024, swz = sb ^ (((sb >> 9) & 1) << 5); R = (st >> 1) * 16 + swz / 64; C = (st & 1) * 32 + (swz % 64) / 2; }
struct Unit { int pm, pn; };
struct Sched {
    int nM, nN, nwg, G, c;
    __device__ __forceinline__ bool next(int i, Unit& u) const {
        const long L = (long)i * G + c; if (L >= nwg) return false;
        int wgid = (int)L; { const int q = nwg / NXCD, r = nwg % NXCD, xcd = wgid % NXCD, off = wgid / NXCD; wgid = (xcd < r ? xcd * (q + 1) : r * (q + 1) + (xcd - r) * q) + off; }
        const int nig = WGM * nN, gid = wgid / nig, fm = gid * WGM, gsz = (nM - fm) < WGM ? (nM - fm) : WGM;
        u.pm = fm + ((wgid % nig) % gsz); u.pn = (wgid % nig) / gsz; return true;
    }
};

template <class Epi>
__device__ __forceinline__ void gemm_phase(const bf16_t* __restrict__ Ag, const bf16_t* __restrict__ Btg, const int K, const int nM, const int nN, const Epi& E,
                                           const int G = (int)gridDim.x, const int c = (int)blockIdx.x, const int pn_from = 1 << 30, const int pn_add = 0) {
    LAS unsigned char* lds = (LAS unsigned char*)smem;
    const int tid = threadIdx.x, wid = __builtin_amdgcn_readfirstlane(tid >> 6), lane = tid & 63, wr = wid >> 2, wc = wid & 3, fr = lane & 15, fq = lane >> 4;
    const int nt = K / BK;
    Sched S; S.nM = nM; S.nN = nN; S.nwg = nM * nN; S.G = G; S.c = c;
    unsigned voffA[2], voffB[2];
#pragma unroll
    for (int i = 0; i < 2; ++i) { int R, C; stage_rc(tid * 16 + i * 8192, R, C);
        const int Rb = Epi::PERM ? ((R & ~31) + 8 * ((R & 15) >> 2) + 4 * ((R & 31) >> 4) + (R & 3)) : R;
        voffA[i] = (unsigned)(R * K + C) * 2u; voffB[i] = (unsigned)(Rb * K + C) * 2u; }
    const size_t kstep = (size_t)(BK * 2);
    const size_t hstep = (size_t)HALF * K * 2;
    const size_t tstep = 2 * hstep;
    const unsigned ldsw = (unsigned)wid * 1024u;
    const int aoff = lds_byte(wr * 64 + fr, fq * 8), boff = lds_byte(wc * 32 + fr, fq * 8);
#define PG8_SA(b, h) (((b) * 2 + (h)) * HTB)
#define PG8_SB(b, h) ((4 + (b) * 2 + (h)) * HTB)
#define PG8_STAGE(bufoff, gbase, voff) do { _Pragma("unroll") for (int _i = 0; _i < 2; ++_i) \
        __builtin_amdgcn_global_load_lds((const unsigned*)((const char*)(gbase) + (voff)[_i]), (LAS unsigned*)(lds + (bufoff) + ldsw + _i * 8192), 16, 0, 0); } while (0)
#define PG8_LDA(dst, b, h) do { _Pragma("unroll") for (int m = 0; m < 4; ++m) _Pragma("unroll") for (int k = 0; k < 2; ++k) dst[m][k] = *(const LAS bf16x8*)(lds + PG8_SA(b, h) + aoff + m * 2048 + k * 1024); } while (0)
#define PG8_LDB(dst, b, h) do { _Pragma("unroll") for (int n = 0; n < 2; ++n) _Pragma("unroll") for (int k = 0; k < 2; ++k) dst[n][k] = *(const LAS bf16x8*)(lds + PG8_SB(b, h) + boff + n * 2048 + k * 1024); } while (0)
#define PG8_MMA(ai, bj, At, Bt) do { __builtin_amdgcn_s_setprio(1); _Pragma("unroll") for (int m = 0; m < 4; ++m) _Pragma("unroll") for (int n = 0; n < 2; ++n) _Pragma("unroll") for (int k = 0; k < 2; ++k) \
        acc[ai][bj][m][n] = __builtin_amdgcn_mfma_f32_16x16x32_bf16(Bt[n][k], At[m][k], acc[ai][bj][m][n], 0, 0, 0); __builtin_amdgcn_s_setprio(0); } while (0)
#define PG8_WAIT_V(n) asm volatile("s_waitcnt vmcnt(" #n ")" ::: "memory")
#define PG8_WAIT_L(n) asm volatile("s_waitcnt lgkmcnt(" #n ")" ::: "memory")
#define PG8_BAR __builtin_amdgcn_s_barrier()
#define PG8_SCHED __builtin_amdgcn_sched_barrier(0)
    Unit cur, nxt; int ui = 0;
    __syncthreads();
    if (!S.next(0, cur)) return;
    if (cur.pn >= pn_from) cur.pn += pn_add;
    f32x4 acc[2][2][4][2];
#pragma unroll
    for (int a = 0; a < 2; ++a)
#pragma unroll
        for (int b = 0; b < 2; ++b)
#pragma unroll
            for (int m = 0; m < 4; ++m)
#pragma unroll
                for (int n = 0; n < 2; ++n) acc[a][b][m][n] = (f32x4){0.f, 0.f, 0.f, 0.f};
    bf16x8 At[4][2], B0[2][2], B1[2][2];
    const char* cA = (const char*)Ag + (size_t)cur.pm * tstep; const char* cB = (const char*)Btg + (size_t)cur.pn * tstep;
    PG8_STAGE(PG8_SB(0, 0), cB, voffB); PG8_STAGE(PG8_SA(0, 0), cA, voffA); PG8_STAGE(PG8_SB(0, 1), cB + hstep, voffB); PG8_STAGE(PG8_SA(0, 1), cA + hstep, voffA);
    if (wr == 1) PG8_BAR;
    PG8_WAIT_V(4); PG8_BAR;
    PG8_STAGE(PG8_SB(1, 0), cB + kstep, voffB); PG8_STAGE(PG8_SA(1, 0), cA + kstep, voffA); PG8_STAGE(PG8_SB(1, 1), cB + hstep + kstep, voffB);
    PG8_WAIT_V(6); PG8_BAR;
    for (;;) {
        const bool has_next = S.next(ui + 1, nxt);
        if (has_next && nxt.pn >= pn_from) nxt.pn += pn_add;
        const char* nA = has_next ? (const char*)Ag + (size_t)nxt.pm * tstep : cA; const char* nB = has_next ? (const char*)Btg + (size_t)nxt.pn * tstep : cB;
        for (int t = 0; t < nt; t += 2) {
            const bool last = (t == nt - 2);
            const char* a1 = cA + (size_t)(t + 1) * kstep;
            const char* a2 = last ? nA : cA + (size_t)(t + 2) * kstep; const char* b2 = last ? nB : cB + (size_t)(t + 2) * kstep;
            const char* a3 = a2 + kstep; const char* b3 = b2 + kstep;
            PG8_LDB(B0, 0, 0); PG8_SCHED; PG8_LDA(At, 0, 0); PG8_STAGE(PG8_SA(1, 1), a1 + hstep, voffA);
            PG8_WAIT_L(8); PG8_BAR; PG8_WAIT_L(0); PG8_MMA(0, 0, At, B0); PG8_BAR; PG8_SCHED;
            PG8_LDB(B1, 0, 1); PG8_STAGE(PG8_SB(0, 0), b2, voffB);
            PG8_BAR; PG8_WAIT_L(0); PG8_MMA(0, 1, At, B1); PG8_BAR;
            PG8_LDA(At, 0, 1); PG8_STAGE(PG8_SA(0, 0), a2, voffA);
            PG8_BAR; PG8_WAIT_L(0); PG8_MMA(1, 0, At, B0); PG8_BAR; PG8_SCHED;
            PG8_STAGE(PG8_SB(0, 1), b2 + hstep, voffB);
            PG8_WAIT_V(6); PG8_BAR; PG8_MMA(1, 1, At, B1); PG8_BAR;
            PG8_LDB(B0, 1, 0); PG8_SCHED; PG8_LDA(At, 1, 0); PG8_STAGE(PG8_SA(0, 1), a2 + hstep, voffA);
            PG8_WAIT_L(8); PG8_BAR; PG8_WAIT_L(0); PG8_MMA(0, 0, At, B0); PG8_BAR; PG8_SCHED;
            PG8_LDB(B1, 1, 1); PG8_STAGE(PG8_SB(1, 0), b3, voffB);
            PG8_BAR; PG8_WAIT_L(0); PG8_MMA(0, 1, At, B1); PG8_BAR;
            PG8_LDA(At, 1, 1); PG8_STAGE(PG8_SA(1, 0), a3, voffA);
            PG8_BAR; PG8_WAIT_L(0); PG8_MMA(1, 0, At, B0); PG8_BAR; PG8_SCHED;
            PG8_STAGE(PG8_SB(1, 1), b3 + hstep, voffB);
            PG8_WAIT_V(6); PG8_BAR; PG8_MMA(1, 1, At, B1); PG8_BAR;
        }
        {
            const int brow = cur.pm * BM, bcol = cur.pn * BM;
#pragma unroll
            for (int ai = 0; ai < 2; ++ai)
#pragma unroll
                for (int m = 0; m < 4; ++m) {
                    E.row(brow + ai * HALF + wr * 64 + m * 16 + fr, bcol + wc * 32, fq, acc[ai][0][m][0], acc[ai][0][m][1], acc[ai][1][m][0], acc[ai][1][m][1]);
                    asm volatile("" ::: "memory");
                }
        }
        if (!has_next) break;
#pragma unroll
        for (int a = 0; a < 2; ++a)
#pragma unroll
            for (int b = 0; b < 2; ++b)
#pragma unroll
                for (int m = 0; m < 4; ++m)
#pragma unroll
                    for (int n = 0; n < 2; ++n) acc[a][b][m][n] = (f32x4){0.f, 0.f, 0.f, 0.f};
        cur = nxt; cA = nA; cB = nB; ++ui;
    }
    PG8_WAIT_V(0);
    if (wr == 0) PG8_BAR;
    PG8_BAR;
#undef PG8_SA
#undef PG8_SB
#undef PG8_STAGE
#undef PG8_LDA
#undef PG8_LDB
#undef PG8_MMA
#undef PG8_WAIT_V
#undef PG8_WAIT_L
#undef PG8_BAR
#undef PG8_SCHED
}

template <bool PERM_> struct EpiInProj {
    static constexpr bool PERM = PERM_;
    bf16_t* qkv; _Float16* urw; bf16_t* gates;
    __device__ __forceinline__ void one(int row, int col, const f32x4& v) const {
        if (col < 1536) {
            const int which = col >> 9, hc = col & 511, h = hc >> 6, d = hc & 63, b = row / TP, t = row - b * TP;
            const float s = which == 0 ? 0.125f : 1.0f;
            u32x2 w; w.x = pk_bf16(v[0] * s, v[1] * s); w.y = pk_bf16(v[2] * s, v[3] * s);
            *(u32x2*)(qkv + (size_t)which * (QKV_ONE / 2) + ((size_t)(b * NH + h) * TP + t) * 64 + d) = w;
        } else if (col < 3328) {
            h16x4 o; o[0] = (_Float16)v[0]; o[1] = (_Float16)v[1]; o[2] = (_Float16)v[2]; o[3] = (_Float16)v[3];
            *(h16x4*)(urw + (size_t)row * RWS + (col - 1536)) = o;
        } else {
            const int b = row / TP, t = row - b * TP;
            if (t >= NMETA && t < T) {
                u32x2 w; w.x = pk_bf16(sigmoidf_(v[0]), sigmoidf_(v[1])); w.y = pk_bf16(sigmoidf_(v[2]), sigmoidf_(v[3]));
                *(u32x2*)(gates + (size_t)(b * SEQ + t - NMETA) * 2048 + (col - 3328)) = w;
            }
        }
    }
    __device__ __forceinline__ void half(int row, int col32, int fq, const f32x4& v0, const f32x4& v1) const {
        if constexpr (PERM_) {
            const int col = col32 + 8 * fq, b = row / TP, t = row - b * TP;
            if (col < 1536) {
                const int which = col >> 9, hc = col & 511, h = hc >> 6, d = hc & 63;
                const float s = which == 0 ? 0.125f : 1.0f;
                u32x4 w; w.x = pk_bf16(v0[0] * s, v0[1] * s); w.y = pk_bf16(v0[2] * s, v0[3] * s); w.z = pk_bf16(v1[0] * s, v1[1] * s); w.w = pk_bf16(v1[2] * s, v1[3] * s);
                *(u32x4*)(qkv + (size_t)which * (QKV_ONE / 2) + ((size_t)(b * NH + h) * TP + t) * 64 + d) = w;
            } else if (t >= NMETA && t < T) {
                u32x4 w; w.x = pk_bf16(sigmoidf_(v0[0]), sigmoidf_(v0[1])); w.y = pk_bf16(sigmoidf_(v0[2]), sigmoidf_(v0[3]));
                w.z = pk_bf16(sigmoidf_(v1[0]), sigmoidf_(v1[1])); w.w = pk_bf16(sigmoidf_(v1[2]), sigmoidf_(v1[3]));
                *(u32x4*)(gates + (size_t)(b * SEQ + t - NMETA) * 2048 + (col - 3328)) = w;
            }
        } else {
            if (col32 >= 1536 && col32 < 3072) {
                const int c = col32 - 1536, pos = (c & ~63) + fq * 16 + ((c & 63) >> 4) * 4;
                h16x8 o;
#pragma unroll
                for (int j = 0; j < 4; ++j) { o[j] = (_Float16)v0[j]; o[4 + j] = (_Float16)v1[j]; }
                *(h16x8*)(urw + (size_t)row * RWS + pos) = o;
            } else { one(row, col32 + 4 * fq, v0); one(row, col32 + 16 + 4 * fq, v1); }
        }
    }
    __device__ __forceinline__ void row(int r, int col32, int fq, const f32x4& a00, const f32x4& a01, const f32x4& a10, const f32x4& a11) const { half(r, col32, fq, a00, a01); half(r, col32 + HALF, fq, a10, a11); }
};
__device__ __forceinline__ void bf8_to_f(const u32x4& g, float (&f)[8]) {
#pragma unroll
    for (int i = 0; i < 4; ++i) { f[2 * i] = __uint_as_float(g[i] << 16); f[2 * i + 1] = __uint_as_float(g[i] & 0xffff0000u); }
}
struct EpiBranch1 {
    static constexpr bool PERM = true;
    bf16_t* t1; const bf16_t* gates;
    __device__ __forceinline__ void half(int row, int col32, int fq, const f32x4& v0, const f32x4& v1) const {
        const int col = col32 + 8 * fq;
        float g[8]; bf8_to_f(*(const u32x4*)(gates + (size_t)row * 2048 + col), g);
        u32x4 w; w.x = pk_bf16(v0[0] * g[0], v0[1] * g[1]); w.y = pk_bf16(v0[2] * g[2], v0[3] * g[3]); w.z = pk_bf16(v1[0] * g[4], v1[1] * g[5]); w.w = pk_bf16(v1[2] * g[6], v1[3] * g[7]);
        *(u32x4*)(t1 + (size_t)row * D + col) = w;
    }
    __device__ __forceinline__ void row(int r, int col32, int fq, const f32x4& a00, const f32x4& a01, const f32x4& a10, const f32x4& a11) const { half(r, col32, fq, a00, a01); half(r, col32 + HALF, fq, a10, a11); }
};
struct EpiBranch2 {
    static constexpr bool PERM = true;
    const bf16_t* t1; const bf16_t* gates; bf16_t* m;
    __device__ __forceinline__ void half(int row, int col32, int fq, const f32x4& v0, const f32x4& v1) const {
        const int col = col32 + 8 * fq;
        float g[8], a[8]; bf8_to_f(*(const u32x4*)(gates + (size_t)row * 2048 + 1024 + col), g); bf8_to_f(*(const u32x4*)(t1 + (size_t)row * D + col), a);
        u32x4 w; w.x = pk_bf16(a[0] + v0[0] * g[0], a[1] + v0[1] * g[1]); w.y = pk_bf16(a[2] + v0[2] * g[2], a[3] + v0[3] * g[3]);
        w.z = pk_bf16(a[4] + v1[0] * g[4], a[5] + v1[1] * g[5]); w.w = pk_bf16(a[6] + v1[2] * g[6], a[7] + v1[3] * g[7]);
        *(u32x4*)(m + (size_t)row * D + col) = w;
    }
    __device__ __forceinline__ void row(int r, int col32, int fq, const f32x4& a00, const f32x4& a01, const f32x4& a10, const f32x4& a11) const { half(r, col32, fq, a00, a01); half(r, col32 + HALF, fq, a10, a11); }
};
struct EpiF32 {
    static constexpr bool PERM = true;
    float* o;
    __device__ __forceinline__ void row(int r, int col32, int fq, const f32x4& a00, const f32x4& a01, const f32x4& a10, const f32x4& a11) const {
        float* q = o + (size_t)r * D + col32 + 8 * fq;
        *(f32x4*)q = a00; *(f32x4*)(q + 4) = a01; *(f32x4*)(q + HALF) = a10; *(f32x4*)(q + HALF + 4) = a11;
    }
};
struct EpiBf16 {
    static constexpr bool PERM = true;
    bf16_t* o;
    __device__ __forceinline__ void row(int r, int col32, int fq, const f32x4& a00, const f32x4& a01, const f32x4& a10, const f32x4& a11) const {
        bf16_t* q = o + (size_t)r * D + col32 + 8 * fq;
        u32x4 w0, w1;
        w0.x = pk_bf16(a00[0], a00[1]); w0.y = pk_bf16(a00[2], a00[3]); w0.z = pk_bf16(a01[0], a01[1]); w0.w = pk_bf16(a01[2], a01[3]);
        w1.x = pk_bf16(a10[0], a10[1]); w1.y = pk_bf16(a10[2], a10[3]); w1.z = pk_bf16(a11[0], a11[1]); w1.w = pk_bf16(a11[2], a11[3]);
        *(u32x4*)q = w0; *(u32x4*)(q + HALF) = w1;
    }
};
struct EpiGU {
    static constexpr bool PERM = true;
    bf16_t* act;
    __device__ __forceinline__ void row(int r, int col32, int fq, const f32x4& g0, const f32x4& g1, const f32x4& u0, const f32x4& u1) const {
        float o[8];
#pragma unroll
        for (int j = 0; j < 4; ++j) { o[j] = g0[j] * sigmoidf_(g0[j]) * u0[j]; o[4 + j] = g1[j] * sigmoidf_(g1[j]) * u1[j]; }
        u32x4 w; w.x = pk_bf16(o[0], o[1]); w.y = pk_bf16(o[2], o[3]); w.z = pk_bf16(o[4], o[5]); w.w = pk_bf16(o[6], o[7]);
        const int pn = col32 >> 8, cin = (col32 & 255) + 8 * fq;
        *(u32x4*)(act + (size_t)r * DFF + pn * 128 + cin) = w;
    }
};

__device__ __forceinline__ void transpose_tile(const float* __restrict__ src, int K, int N, bf16_t* __restrict__ dst, int ldd, int koff, int mode, int tile) {
    float* scr = (float*)smem;
    const int ntn = N / 128, kb = tile / ntn, nb = tile % ntn, k0 = kb * 64, n0 = nb * 128, tid = threadIdx.x;
    f32x4 v[4];
#pragma unroll
    for (int i = 0; i < 4; ++i) { const int idx = tid + 512 * i, kk = idx >> 5, n4 = idx & 31; v[i] = *(const f32x4*)(src + (size_t)(k0 + kk) * N + n0 + n4 * 4); }
#pragma unroll
    for (int i = 0; i < 4; ++i) { const int idx = tid + 512 * i, kk = idx >> 5, n4 = idx & 31;
#pragma unroll
        for (int c = 0; c < 4; ++c) scr[kk * 129 + n4 * 4 + c] = v[i][c]; }
    __syncthreads();
#pragma unroll
    for (int i = 0; i < 2; ++i) {
        const int o = tid + 512 * i, n = o >> 3, kc = (o & 7) * 8;
        u32x4 w;
        w.x = pk_bf16(scr[(kc + 0) * 129 + n], scr[(kc + 1) * 129 + n]); w.y = pk_bf16(scr[(kc + 2) * 129 + n], scr[(kc + 3) * 129 + n]);
        w.z = pk_bf16(scr[(kc + 4) * 129 + n], scr[(kc + 5) * 129 + n]); w.w = pk_bf16(scr[(kc + 6) * 129 + n], scr[(kc + 7) * 129 + n]);
        const int f = n0 + n;
        const int drow = mode == 0 ? f : ((f >> 7) * 256 + (mode == 2 ? 128 : 0) + (f & 127));
        *(u32x4*)(dst + (size_t)drow * ldd + koff + k0 + kc) = w;
    }
    __syncthreads();
}

__device__ __forceinline__ void phase0(const Params& p) {
    unsigned char* ws = p.ws;
    if (blockIdx.x == 0 && threadIdx.x < 64) ((unsigned*)(ws + WS_CTL))[threadIdx.x] = 0u;
    constexpr int J0 = 16 * 42, J1 = 8 * 8, J3 = 16 * 8, J4 = 16 * 22, J6 = 44 * 8, J7 = 4, J9 = 8;
    constexpr int NT = J0 + 2 * J1 + J3 + 2 * J4 + J6 + 2 * J7 + J9;
    constexpr int NR = MP / 32;
    for (int it = blockIdx.x; it < NT + NR; it += gridDim.x) {
        if (it >= NR) {
            int r = it - NR;
            if (r < J0) { transpose_tile(p.in[4], D, PIN, (bf16_t*)(ws + WS_WIN), D, 0, 0, r); continue; } r -= J0;
            if (r < J1) { transpose_tile(p.in[16], 512, D, (bf16_t*)(ws + WS_WSB), 512, 0, 0, r); continue; } r -= J1;
            if (r < J1) { transpose_tile(p.in[17], 512, D, (bf16_t*)(ws + WS_WRW), 512, 0, 0, r); continue; } r -= J1;
            if (r < J3) { transpose_tile(p.in[18], D, D, (bf16_t*)(ws + WS_WOUT), D, 0, 0, r); continue; } r -= J3;
            if (r < J4) { transpose_tile(p.in[21], D, DFF, (bf16_t*)(ws + WS_WGU), D, 0, 1, r); continue; } r -= J4;
            if (r < J4) { transpose_tile(p.in[22], D, DFF, (bf16_t*)(ws + WS_WGU), D, 0, 2, r); continue; } r -= J4;
            if (r < J6) { transpose_tile(p.in[23], DFF, D, (bf16_t*)(ws + WS_WD), DFF, 0, 0, r); continue; } r -= J6;
            if (r < J7) { transpose_tile(p.in[6], 64, 512, (bf16_t*)(ws + WS_WL), 256, 0, 0, r); continue; } r -= J7;
            if (r < J7) { transpose_tile(p.in[8], 64, 512, (bf16_t*)(ws + WS_WL), 256, 64, 0, r); continue; } r -= J7;
            transpose_tile(p.in[10], 128, 512, (bf16_t*)(ws + WS_WL), 256, 128, 0, r);
        } else {
            const int lane = threadIdx.x & 63, row0 = it * 32 + (threadIdx.x >> 6) * 4;
            f32x4 v[4][4];
#pragma unroll
            for (int r = 0; r < 4; ++r) {
                const int row = row0 + r, b = row / TP, t = row - b * TP;
                const float* src = t < NMETA ? p.in[1] + (size_t)t * D : p.in[0] + ((size_t)b * SEQ + (t < T ? t - NMETA : 0)) * D;
#pragma unroll
                for (int j = 0; j < 4; ++j) v[r][j] = *(const f32x4*)(src + 4 * lane + 256 * j);
            }
            f32x4 g[4];
#pragma unroll
            for (int j = 0; j < 4; ++j) g[j] = *(const f32x4*)(p.in[2] + 4 * lane + 256 * j);
#pragma unroll
            for (int r = 0; r < 4; ++r) {
                const int row = row0 + r, b = row / TP, t = row - b * TP;
                float ss = 0.f;
#pragma unroll
                for (int j = 0; j < 4; ++j) ss += (v[r][j][0] * v[r][j][0] + v[r][j][1] * v[r][j][1]) + (v[r][j][2] * v[r][j][2] + v[r][j][3] * v[r][j][3]);
                const float rs = t < T ? rsqrtf(wave_sum(ss) * (1.0f / D) + RMS_EPS) : 0.f;
                bf16_t* orow = (bf16_t*)(ws + O_A0) + (size_t)row * D;
#pragma unroll
                for (int j = 0; j < 4; ++j) {
                    u32x2 w; w.x = pk_bf16(v[r][j][0] * rs * g[j][0], v[r][j][1] * rs * g[j][1]); w.y = pk_bf16(v[r][j][2] * rs * g[j][2], v[r][j][3] * rs * g[j][3]);
                    *(u32x2*)(orow + 4 * lane + 256 * j) = w;
                }
            }
        }
    }
}

__device__ __forceinline__ void phase1(const Params& p) {
    unsigned char* ws = p.ws;
    EpiInProj<false> epi{(bf16_t*)(ws + R_QKV), (_Float16*)(ws + R_URW), (bf16_t*)p.out};
    gemm_phase((const bf16_t*)(ws + O_A0), (const bf16_t*)(ws + WS_WIN), D, MP / BM, 7, epi, (int)gridDim.x, (int)blockIdx.x, 0, 6);
}

constexpr int SI_R = 0, SI_W = 1, SI_K = 2, SI_V = 3, SI_KK = 4, SI_B = 5;
constexpr int ALD = 264;
constexpr int P2_WLS = 64 * ALD * 2;
constexpr int P2_MU = P2_WLS;
constexpr int P2_AL = P2_MU + 1024;
__device__ __forceinline__ void phase2_main(const Params& p) {
    unsigned char* ws = p.ws;
    const int tid = threadIdx.x, wave = tid >> 6, lane = tid & 63, fr = lane & 15, fq = lane >> 4;
    const int h = blockIdx.x & 7, nslot = (gridDim.x >> 3) * 8, slot = (blockIdx.x >> 3) * 8 + wave;
    const _Float16* urw = (const _Float16*)(ws + R_URW);
    const float* mu = p.in[5];
    bf16_t* WLs = (bf16_t*)smem;
    float* mus = (float*)(smem + P2_MU);
    bf16_t* Al = (bf16_t*)(smem + P2_AL) + wave * (16 * ALD);
    __syncthreads();
    {
        const bf16_t* WL = (const bf16_t*)(ws + WS_WL) + (size_t)h * 64 * 256;
#pragma unroll
        for (int i = 0; i < 4; ++i) { const int idx = tid + 512 * i, row = idx >> 5, c16 = idx & 31; *(u32x4*)(WLs + row * ALD + c16 * 8) = *(const u32x4*)(WL + row * 256 + c16 * 8); }
        if (tid < 256) mus[tid] = mu[1536 + tid];
    }
    __syncthreads();
    if (blockIdx.x >= nslot) return;
    _Float16* SI = (_Float16*)(ws + R_SI);
    bf16_t* G = (bf16_t*)(ws + R_G);
    constexpr size_t SIE = (size_t)MP * 512;
#pragma unroll 1
    for (int g = slot; g < NB * 514; g += nslot) {
        const int ub = g / 514, ui = g - ub * 514, row0 = ub * TP + ui * 16;
        {
            const int half = lane >> 5, pc = (lane & 31) * 8;
            const float sA = pc < 64 ? 2.f : 1.f, sC = pc < 64 ? -1.f : 0.f;
            const bool lin = pc >= 64 && pc < 128;
            const f32x4 mA = *(const f32x4*)(mu + 1536 + pc), mB = *(const f32x4*)(mu + 1536 + pc + 4);
            h16x8 c[8], pv[8];
#pragma unroll
            for (int q = 0; q < 8; ++q) {
                const int rowa = row0 + 2 * q + half, ta = rowa % TP;
                const _Float16* cur = urw + (size_t)rowa * RWS + 1536 + pc;
                c[q] = *(const h16x8*)cur;
                pv[q] = *(const h16x8*)(ta > 0 ? cur - RWS : cur);
            }
#pragma unroll
            for (int q = 0; q < 8; ++q) {
                const int ta = (row0 + 2 * q + half) % TP;
                float o[8];
#pragma unroll
                for (int e = 0; e < 8; ++e) {
                    const float cf = (float)c[q][e], pf = ta > 0 ? (float)pv[q][e] : 0.f;
                    const float xs = cf + (e < 4 ? mA[e & 3] : mB[e & 3]) * (pf - cf);
                    const float sg = __builtin_amdgcn_rcpf(1.0f + __expf(-sA * xs));
                    o[e] = lin ? xs : sA * sg + sC;
                }
                u32x4 w; w.x = pk_bf16(o[0], o[1]); w.y = pk_bf16(o[2], o[3]); w.z = pk_bf16(o[4], o[5]); w.w = pk_bf16(o[6], o[7]);
                *(u32x4*)(Al + (2 * q + half) * ALD + pc) = w;
            }
        }
        asm volatile("s_waitcnt lgkmcnt(0)" ::: "memory");
        __builtin_amdgcn_wave_barrier();
        f32x4 acc[4];
        auto lora = [&](auto kbeg_c, auto ksteps_c) {
            constexpr int kbeg = decltype(kbeg_c)::value, ksteps = decltype(ksteps_c)::value;
#pragma unroll
            for (int n = 0; n < 4; ++n) acc[n] = (f32x4){0.f, 0.f, 0.f, 0.f};
#pragma unroll
            for (int ks = 0; ks < ksteps; ++ks) {
                const bf16x8 af = *(const bf16x8*)(Al + fr * ALD + kbeg + ks * 32 + fq * 8);
#pragma unroll
                for (int n = 0; n < 4; ++n) {
                    const bf16x8 wf = *(const bf16x8*)(WLs + (n * 16 + fr) * ALD + kbeg + ks * 32 + fq * 8);
                    acc[n] = __builtin_amdgcn_mfma_f32_16x16x32_bf16(wf, af, acc[n], 0, 0, 0);
                }
            }
        };
        const int row = row0 + fr, b = row / TP, t = row - b * TP;
        const size_t base = ((size_t)(b * NH + h) * TP + t) * 64;
        const _Float16* ur = urw + (size_t)row * RWS;
        const size_t pb = base + fq * 16;
        lora(std::integral_constant<int, 0>{}, std::integral_constant<int, 2>{});
        {
            h16x8 wo[2];
#pragma unroll
            for (int n = 0; n < 4; ++n) {
                const f32x4 db = *(const f32x4*)(p.in[7] + h * 64 + n * 16 + fq * 4);
#pragma unroll
                for (int j = 0; j < 4; ++j) {
                    const float wl = -softplusf_(-(db[j] + acc[n][j])) - 0.5f;
                    const float e = __expf(wl);
                    wo[n >> 1][(n & 1) * 4 + j] = (_Float16)(1.0f - __expf(-e));
                }
            }
            *(h16x8*)(SI + SI_W * SIE + pb) = wo[0]; *(h16x8*)(SI + SI_W * SIE + pb + 8) = wo[1];
        }
        lora(std::integral_constant<int, 64>{}, std::integral_constant<int, 2>{});
        {
            const _Float16* up = ur + h * 64 + fq * 16;
            const _Float16* upp = t > 0 ? up - RWS : up;
            h16x8 kc[2], rc[2], vc[2], kp[2], rp[2], vp[2];
#pragma unroll
            for (int i = 0; i < 2; ++i) {
                rc[i] = *(const h16x8*)(up + i * 8); kc[i] = *(const h16x8*)(up + 512 + i * 8); vc[i] = *(const h16x8*)(up + 1024 + i * 8);
                rp[i] = *(const h16x8*)(upp + i * 8); kp[i] = *(const h16x8*)(upp + 512 + i * 8); vp[i] = *(const h16x8*)(upp + 1024 + i * 8);
            }
            float kv[4][4], av[4][4], kkr[4][4]; float ss = 0.f;
            h16x8 ro[2];
#pragma unroll
            for (int n = 0; n < 4; ++n) {
                const int c = n * 16 + fq * 4, c512 = h * 64 + c;
                const f32x4 muk = *(const f32x4*)(mu + 512 + c512), mur = *(const f32x4*)(mu + c512), muv = *(const f32x4*)(mu + 1024 + c512);
                const f32x4 ab = *(const f32x4*)(p.in[9] + c512), kkw = *(const f32x4*)(p.in[11] + c512);
                h16x4 vo;
#pragma unroll
                for (int j = 0; j < 4; ++j) {
                    const int i = n >> 1, e = (n & 1) * 4 + j;
                    const float kcf = (float)kc[i][e], kpf = t > 0 ? (float)kp[i][e] : 0.f;
                    const float rcf = (float)rc[i][e], rpf = t > 0 ? (float)rp[i][e] : 0.f;
                    const float vcf = (float)vc[i][e], vpf = t > 0 ? (float)vp[i][e] : 0.f;
                    kv[n][j] = kcf + muk[j] * (kpf - kcf);
                    ro[i][e] = (_Float16)(rcf + mur[j] * (rpf - rcf));
                    vo[j] = (_Float16)(vcf + muv[j] * (vpf - vcf));
                    av[n][j] = sigmoidf_(ab[j] + acc[n][j]);
                    kkr[n][j] = kv[n][j] * kkw[j];
                    ss += kkr[n][j] * kkr[n][j];
                }
                *(h16x4*)(SI + SI_V * SIE + base + c) = vo;
            }
            *(h16x8*)(SI + SI_R * SIE + pb) = ro[0]; *(h16x8*)(SI + SI_R * SIE + pb + 8) = ro[1];
            ss += __shfl_xor(ss, 16); ss += __shfl_xor(ss, 32);
            const float inv = fminf(__builtin_amdgcn_rsqf(ss), 1e12f);
            h16x8 ko[2], kko[2], bo[2];
#pragma unroll
            for (int n = 0; n < 4; ++n) {
                const f32x4 ka = *(const f32x4*)(p.in[12] + h * 64 + n * 16 + fq * 4);
#pragma unroll
                for (int j = 0; j < 4; ++j) {
                    const int i = n >> 1, e = (n & 1) * 4 + j;
                    const float kk = kkr[n][j] * inv;
                    ko[i][e] = (_Float16)(kv[n][j] * (1.0f + (av[n][j] - 1.0f) * ka[j]));
                    kko[i][e] = (_Float16)kk;
                    bo[i][e] = (_Float16)(kk * av[n][j]);
                }
            }
#pragma unroll
            for (int i = 0; i < 2; ++i) {
                *(h16x8*)(SI + SI_K * SIE + pb + i * 8) = ko[i]; *(h16x8*)(SI + SI_KK * SIE + pb + i * 8) = kko[i]; *(h16x8*)(SI + SI_B * SIE + pb + i * 8) = bo[i];
            }
        }
        lora(std::integral_constant<int, 128>{}, std::integral_constant<int, 4>{});
        {
            u32x4 g0, g1;
            g0.x = pk_bf16(acc[0][0], acc[0][1]); g0.y = pk_bf16(acc[0][2], acc[0][3]); g0.z = pk_bf16(acc[1][0], acc[1][1]); g0.w = pk_bf16(acc[1][2], acc[1][3]);
            g1.x = pk_bf16(acc[2][0], acc[2][1]); g1.y = pk_bf16(acc[2][2], acc[2][3]); g1.z = pk_bf16(acc[3][0], acc[3][1]); g1.w = pk_bf16(acc[3][2], acc[3][3]);
            *(u32x4*)(G + pb) = g0; *(u32x4*)(G + pb + 8) = g1;
        }
        asm volatile("s_waitcnt lgkmcnt(0)" ::: "memory");
        __builtin_amdgcn_wave_barrier();
    }
}
__device__ __forceinline__ void phase2_kmax(const Params& p, int item) {
    unsigned char* ws = p.ws;
    const int bh = item >> 2, qr = item & 3, tid = threadIdx.x;
    float* red = (float*)(smem + P2_AL + 8 * 16 * ALD * 2);
    float ss = 0.f;
    for (int t = qr * 2052 + tid; t < (qr + 1) * 2052; t += 512) {
        const bf16_t* kr = (const bf16_t*)(ws + R_QKV) + QKV_ONE / 2 + ((size_t)bh * TP + t) * 64;
        float s1 = 0.f;
#pragma unroll
        for (int q = 0; q < 8; ++q) {
            const u32x4 v = *(const u32x4*)(kr + q * 8);
#pragma unroll
            for (int e = 0; e < 4; ++e) { const float lo = __uint_as_float(v[e] << 16), hi = __uint_as_float(v[e] & 0xffff0000u); s1 += lo * lo + hi * hi; }
        }
        ss = fmaxf(ss, s1);
    }
#pragma unroll
    for (int o = 1; o < 64; o <<= 1) ss = fmaxf(ss, __shfl_xor(ss, o));
    __syncthreads();
    if ((tid & 63) == 0) red[tid >> 6] = ss;
    __syncthreads();
    if (tid == 0) {
        float m = red[0];
#pragma unroll
        for (int w = 1; w < 8; ++w) m = fmaxf(m, red[w]);
        ((float*)(ws + WS_CTL))[16 + item] = m;
    }
}
__device__ __forceinline__ void phase2(const Params& p) {
    phase2_main(p);
}

constexpr int SC_TC = 32, SC_NC = (T + SC_TC - 1) / SC_TC;
constexpr int SC_ARR = SC_TC * 64;
constexpr int SC_VOFF = 5 * SC_ARR, SC_COFF = SC_VOFF + SC_TC * 16;
constexpr int SC_BUF = (SC_COFF + SC_TC) * 4;
constexpr int SC_YOFF = 2 * SC_BUF, SC_YBUF = SC_TC * 16 * 4;
__device__ __forceinline__ float dot4(const f32x4& a, const f32x4& b) {
    f32x2 t = __builtin_shufflevector(a, a, 0, 1) * __builtin_shufflevector(b, b, 0, 1);
    t = __builtin_shufflevector(a, a, 2, 3) * __builtin_shufflevector(b, b, 2, 3) + t;
    return t[0] + t[1];
}
__device__ __forceinline__ void reduce16x2(float& a, float& b) {
    a += dppf<0xB1>(a); b += dppf<0xB1>(b); a += dppf<0x4E>(a); b += dppf<0x4E>(b);
    a += dppf<0x141>(a); b += dppf<0x141>(b); a += dppf<0x140>(a); b += dppf<0x140>(b);
}
__device__ __forceinline__ void scan_unit(const Params& p, int unit) {
    unsigned char* ws = p.ws;
    const int bh = unit >> 2, vr0 = (unit & 3) * 16, tid = threadIdx.x, wave = tid >> 6, lane = tid & 63;
    const _Float16* SI = (const _Float16*)(ws + R_SI);
    constexpr size_t SIE = (size_t)MP * 512;
    bf16_t* Y = (bf16_t*)(ws + O_Y);
    const size_t hb = (size_t)bh * TP * 64;
    __syncthreads();
    if (wave >= 4) {
        const int i = tid - 256, ip = i >= 8 ? i - 8 : i;
        const int arrs[5] = {SI_R, SI_W, SI_K, SI_KK, SI_B};
        u32x4 rg[5], rp[3]; unsigned rv;
        auto issue = [&](int c) {
            const size_t off = hb + (size_t)c * SC_TC * 64;
#pragma unroll
            for (int a = 0; a < 5; ++a) rg[a] = *(const u32x4*)(SI + arrs[a] * SIE + off + i * 8);
            rp[0] = *(const u32x4*)(SI + SI_W * SIE + off + ip * 8);
            rp[1] = *(const u32x4*)(SI + SI_K * SIE + off + ip * 8);
            rp[2] = *(const u32x4*)(SI + SI_B * SIE + off + ip * 8);
            rv = *(const unsigned*)(SI + SI_V * SIE + off + (i >> 3) * 64 + vr0 + (i & 7) * 2);
        };
        auto commit = [&](int bufi) {
            float* buf = (float*)(smem + bufi * SC_BUF);
            float f[5][8];
#pragma unroll
            for (int a = 0; a < 5; ++a) {
                const h16x8 hv = __builtin_bit_cast(h16x8, rg[a]);
#pragma unroll
                for (int e = 0; e < 8; ++e) f[a][e] = (float)hv[e];
            }
            const bool odd = (i >> 3) & 1;
            float ckk = 0.f, cbk = 0.f;
            {
                const h16x8 pw = __builtin_bit_cast(h16x8, rp[0]), pk = __builtin_bit_cast(h16x8, rp[1]), pb = __builtin_bit_cast(h16x8, rp[2]);
#pragma unroll
                for (int e = 0; e < 8; ++e) {
                    const float kk2 = f[3][e];
                    ckk += (float)pk[e] * kk2; cbk += (float)pb[e] * kk2;
                    if (odd) f[3][e] = (1.0f - (float)pw[e]) * kk2;
                }
            }
            ckk += dppf<0xB1>(ckk); cbk += dppf<0xB1>(cbk); ckk += dppf<0x4E>(ckk); cbk += dppf<0x4E>(cbk); ckk += dppf<0x141>(ckk); cbk += dppf<0x141>(cbk);
#pragma unroll
            for (int a = 0; a < 5; ++a) {
                f32x4 lo, hi;
#pragma unroll
                for (int e = 0; e < 4; ++e) { lo[e] = f[a][e]; hi[e] = f[a][4 + e]; }
                if (a == 1) { lo = 1.0f - lo; hi = 1.0f - hi; }
                if (a == 4) { lo = -lo; hi = -hi; }
                *(f32x4*)(buf + a * SC_ARR + i * 8) = lo; *(f32x4*)(buf + a * SC_ARR + i * 8 + 4) = hi;
            }
            const h16x2 v2 = __builtin_bit_cast(h16x2, rv);
            f32x2 vf; vf[0] = (float)v2[0]; vf[1] = (float)v2[1];
            *(f32x2*)(buf + SC_VOFF + (i >> 3) * 16 + (i & 7) * 2) = vf;
            if (odd && (i & 7) == 0) { f32x2 cf; cf[0] = ckk; cf[1] = cbk; *(f32x2*)(buf + SC_COFF + (i >> 4) * 2) = cf; }
        };
        auto yout = [&](int c) {
            const float* yb = (const float*)(smem + SC_YOFF + (c & 1) * SC_YBUF);
            const f32x2 v = *(const f32x2*)(yb + (i >> 3) * 16 + (i & 7) * 2);
            *(unsigned*)(Y + hb + (size_t)(c * SC_TC + (i >> 3)) * 64 + vr0 + (i & 7) * 2) = pk_bf16(v[0], v[1]);
        };
        issue(0); commit(0); issue(1);
        __syncthreads();
        for (int c = 0; c < SC_NC; ++c) {
            if (c > 0) yout(c - 1);
            if (c + 1 < SC_NC) commit((c + 1) & 1);
            if (c + 2 < SC_NC) issue(c + 2);
            __syncthreads();
        }
        yout(SC_NC - 1);
    } else {
        const int rl = wave * 4 + (lane >> 4), sub = lane & 15;
        const bool odd_lane = lane & 1; const int yoff = (lane & 1) * 16 + rl;
        f32x4 S = {0.f, 0.f, 0.f, 0.f};
        __syncthreads();
        for (int c = 0; c < SC_NC; ++c) {
            const float* buf = (const float*)(smem + (c & 1) * SC_BUF);
            float* yb = (float*)(smem + SC_YOFF + (c & 1) * SC_YBUF);
            const float* bp = buf + sub * 4;
#define SC_LD(arr, s) (*(const f32x4*)(bp + (arr) * SC_ARR + (s) * 64))
            f32x4 r1 = SC_LD(0, 0), w1 = SC_LD(1, 0), k1 = SC_LD(2, 0), q1 = SC_LD(3, 0), n1 = SC_LD(4, 0);
            f32x4 r2 = SC_LD(0, 1), w2 = SC_LD(1, 1), k2 = SC_LD(2, 1), g2 = SC_LD(3, 1), n2 = SC_LD(4, 1);
            float v1 = buf[SC_VOFF + rl], v2 = buf[SC_VOFF + 16 + rl];
            f32x2 cf = *(const f32x2*)(buf + SC_COFF);
#pragma unroll
            for (int pr = 0; pr < SC_TC / 2; ++pr) {
                const int sn = 2 * pr + 2;
                const f32x4 r1n = SC_LD(0, sn), w1n = SC_LD(1, sn), k1n = SC_LD(2, sn), q1n = SC_LD(3, sn), n1n = SC_LD(4, sn);
                const f32x4 r2n = SC_LD(0, sn + 1), w2n = SC_LD(1, sn + 1), k2n = SC_LD(2, sn + 1), g2n = SC_LD(3, sn + 1), n2n = SC_LD(4, sn + 1);
                const float v1n = buf[SC_VOFF + sn * 16 + rl], v2n = buf[SC_VOFF + (sn + 1) * 16 + rl];
                const f32x2 cfn = *(const f32x2*)(buf + SC_COFF + (pr + 1) * 2);
                __builtin_amdgcn_sched_barrier(0x7);
                float d1 = dot4(S, q1), e2 = dot4(S, g2);
                const f32x4 t1 = S * w1 + v1 * k1;
                reduce16x2(d1, e2);
                const float d2 = e2 + v1 * cf[0] - d1 * cf[1];
                const f32x4 S1 = t1 + d1 * n1;
                const f32x4 S2 = (S1 * w2 + v2 * k2) + d2 * n2;
                float y1 = dot4(S1, r1), y2 = dot4(S2, r2);
                y1 += dppf<0xB1>(y1); y2 += dppf<0xB1>(y2);
                float yz = odd_lane ? y2 : y1;
                yz += dppf<0x122>(yz); yz += dppf<0x124>(yz); yz += dppf<0x128>(yz);
                yb[(2 * pr) * 16 + yoff] = yz;
                S = S2;
                r1 = r1n; w1 = w1n; k1 = k1n; q1 = q1n; n1 = n1n; r2 = r2n; w2 = w2n; k2 = k2n; g2 = g2n; n2 = n2n; v1 = v1n; v2 = v2n; cf = cfn;
            }
#undef SC_LD
            __syncthreads();
        }
    }
}

constexpr int KLD = 72;
__device__ __forceinline__ void attn_unit(const Params& p, int unit) {
    unsigned char* ws = p.ws;
    const int qt = unit % 65, bh = unit / 65, b = bh >> 3, h = bh & 7;
    const int tid = threadIdx.x, wave = tid >> 6, lane = tid & 63, fr = lane & 15, fq = lane >> 4;
    const bf16_t* Q = (const bf16_t*)(ws + R_QKV) + (size_t)bh * TP * 64;
    const bf16_t* Kg = Q + QKV_ONE / 2;
    const bf16_t* Vg = Q + QKV_ONE;
    bf16_t* slots = (bf16_t*)smem;
    constexpr int SLOT = 2 * 64 * KLD;
    volatile int* flags = (volatile int*)(smem + 2 * SLOT * 2);
    const int t0 = qt * 128, tq = t0 + wave * 16 + fr;
    bf16x8 qf[2];
    qf[0] = *(const bf16x8*)(Q + (size_t)tq * 64 + fq * 8);
    qf[1] = *(const bf16x8*)(Q + (size_t)tq * 64 + 32 + fq * 8);
    float qs = 0.f;
#pragma unroll
    for (int s = 0; s < 2; ++s)
#pragma unroll
        for (int e = 0; e < 8; ++e) { const float f = bf2f((unsigned short)qf[s][e]); qs += f * f; }
    qs += __shfl_xor(qs, 16); qs += __shfl_xor(qs, 32);
    const f32x4 km4 = *(const f32x4*)((const float*)(ws + WS_CTL) + 16 + bh * 4);
    const float kmax = sqrtf(fmaxf(fmaxf(km4[0], km4[1]), fmaxf(km4[2], km4[3])));
    const float zb = sqrtf(qs) * kmax * 1.0001f + 88.0f;
    float Arow = 0.f;
    f32x4 O[4];
#pragma unroll
    for (int nd = 0; nd < 4; ++nd) O[nd] = (f32x4){0.f, 0.f, 0.f, 0.f};
    const int key = tid >> 3, dc = (tid & 7) * 8, half = wave >> 2;
    auto tile_store = [&](int blk, const u32x4& kv, const u32x4& vv) {
        bf16_t* Ks_ = slots + (blk & 1) * SLOT; bf16_t* Vt_ = Ks_ + 64 * KLD;
        *(u32x4*)(Ks_ + key * KLD + dc) = kv;
#pragma unroll
        for (int e = 0; e < 4; ++e) { Vt_[(dc + 2 * e) * KLD + key] = (bf16_t)(vv[e] & 0xffffu); Vt_[(dc + 2 * e + 1) * KLD + key] = (bf16_t)(vv[e] >> 16); }
    };
    const int ktop = qt * 2 + 1;
    {
        const u32x4 k0 = *(const u32x4*)(Kg + (size_t)(ktop * 64 + key) * 64 + dc), v0 = *(const u32x4*)(Vg + (size_t)(ktop * 64 + key) * 64 + dc);
        __syncthreads();
        tile_store(ktop, k0, v0);
    }
    u32x4 kvv = *(const u32x4*)(Kg + (size_t)((ktop - 1) * 64 + key) * 64 + dc);
    u32x4 vvv = *(const u32x4*)(Vg + (size_t)((ktop - 1) * 64 + key) * 64 + dc);
    for (int kt = ktop; kt >= 0; --kt) {
        const int kb = kt - 1 + half;
        const bool done = __all(Arow > zb) || kb < 0;
        if (lane == 0) flags[wave] = done ? 1 : 0;
        __syncthreads();
        int alld = 1;
#pragma unroll
        for (int w = 0; w < 8; ++w) alld &= flags[w];
        if (alld) break;
        if (kt >= 1) {
            tile_store(kt - 1, kvv, vvv);
            if (kt >= 2) {
                kvv = *(const u32x4*)(Kg + (size_t)((kt - 2) * 64 + key) * 64 + dc);
                vvv = *(const u32x4*)(Vg + (size_t)((kt - 2) * 64 + key) * 64 + dc);
            }
        }
        asm volatile("s_waitcnt lgkmcnt(0)" ::: "memory");
        __builtin_amdgcn_s_barrier();
        if (kb < 0) continue;
        const bf16_t* Ks = slots + (kb & 1) * SLOT; const bf16_t* Vt = Ks + 64 * KLD;
        f32x4 z[4];
#pragma unroll
        for (int n = 0; n < 4; ++n) {
            z[n] = (f32x4){0.f, 0.f, 0.f, 0.f};
#pragma unroll
            for (int s = 0; s < 2; ++s) {
                const bf16x8 kf = *(const bf16x8*)(Ks + (n * 16 + fr) * KLD + s * 32 + fq * 8);
                z[n] = __builtin_amdgcn_mfma_f32_16x16x32_bf16(kf, qf[s], z[n], 0, 0, 0);
            }
        }
        float sp[4][4], lt[4], ex[4], sg[4];
#pragma unroll
        for (int n = 0; n < 4; ++n) {
#pragma unroll
            for (int j = 0; j < 4; ++j) { const int s = kb * 64 + n * 16 + fq * 4 + j; sp[n][j] = s < tq ? softplusf_(z[n][j]) : 0.f; }
            sp[n][2] += sp[n][3]; sp[n][1] += sp[n][2]; sp[n][0] += sp[n][1];
            lt[n] = sp[n][0];
            const float a = __shfl_xor(lt[n], 16), pr = lt[n] + a, c = __shfl_xor(pr, 32);
            ex[n] = fq == 3 ? 0.f : (fq == 2 ? a : (fq == 1 ? c : a + c));
            sg[n] = pr + c;
        }
        float nsuf[4]; nsuf[3] = 0.f; nsuf[2] = sg[3]; nsuf[1] = nsuf[2] + sg[2]; nsuf[0] = nsuf[1] + sg[1];
        float wgt[4][4];
#pragma unroll
        for (int n = 0; n < 4; ++n)
#pragma unroll
            for (int j = 0; j < 4; ++j) {
                const int s = kb * 64 + n * 16 + fq * 4 + j;
                const float C = Arow + nsuf[n] + ex[n] + sp[n][j];
                wgt[n][j] = s < tq ? __expf(z[n][j] - C) : 0.f;
            }
        Arow += nsuf[0] + sg[0];
#pragma unroll
        for (int ks = 0; ks < 2; ++ks) {
            u32x4 pw; pw.x = pk_bf16(wgt[2 * ks][0], wgt[2 * ks][1]); pw.y = pk_bf16(wgt[2 * ks][2], wgt[2 * ks][3]);
            pw.z = pk_bf16(wgt[2 * ks + 1][0], wgt[2 * ks + 1][1]); pw.w = pk_bf16(wgt[2 * ks + 1][2], wgt[2 * ks + 1][3]);
            const bf16x8 pf = __builtin_bit_cast(bf16x8, pw);
#pragma unroll
            for (int nd = 0; nd < 4; ++nd) {
                u32x4 vw;
                const u32x2 v0 = *(const u32x2*)(Vt + (nd * 16 + fr) * KLD + (2 * ks) * 16 + fq * 4);
                const u32x2 v1 = *(const u32x2*)(Vt + (nd * 16 + fr) * KLD + (2 * ks + 1) * 16 + fq * 4);
                vw.x = v0.x; vw.y = v0.y; vw.z = v1.x; vw.w = v1.y;
                O[nd] = __builtin_amdgcn_mfma_f32_16x16x32_bf16(pf, __builtin_bit_cast(bf16x8, vw), O[nd], 0, 0, 0);
            }
        }
    }
    __syncthreads();
    bf16_t* Ot = (bf16_t*)smem;
#pragma unroll
    for (int j = 0; j < 4; ++j)
#pragma unroll
        for (int nd = 0; nd < 4; ++nd) Ot[(wave * 16 + fq * 4 + j) * KLD + nd * 16 + fr] = (bf16_t)(pk_bf16(O[nd][j], 0.f) & 0xffffu);
    __syncthreads();
    bf16_t* osb = (bf16_t*)(ws + O_OSB);
#pragma unroll
    for (int i = 0; i < 2; ++i) {
        const int idx = tid + 512 * i, r = idx >> 3, pc8 = (idx & 7) * 8, t = t0 + r;
        if (t >= NMETA && t < T) *(u32x4*)(osb + (size_t)(b * SEQ + t - NMETA) * 512 + h * 64 + pc8) = *(const u32x4*)(Ot + r * KLD + pc8);
    }
}

constexpr int N_SCAN = 128, N_ATTN = 32 * 65;
__device__ __forceinline__ void sub_barrier(unsigned* ctr, unsigned target, bool arrive) {
    asm volatile("s_waitcnt vmcnt(0)" ::: "memory");
    __syncthreads();
    if (threadIdx.x == 0) {
        if (arrive) { __builtin_amdgcn_fence(__ATOMIC_RELEASE, "agent"); asm volatile("s_waitcnt vmcnt(0)" ::: "memory"); (void)xb_add(ctr, 1u); }
        unsigned sp = 0u;
        while (xb_ld(ctr) < target) { __builtin_amdgcn_s_sleep(2); if (++sp > (1u << 22)) break; }
        __builtin_amdgcn_fence(__ATOMIC_ACQUIRE, "agent");
        asm volatile("s_waitcnt vmcnt(0)" ::: "memory");
    }
    __syncthreads();
}
__device__ __forceinline__ void phase3(const Params& p) {
    unsigned char* ws = p.ws;
    unsigned* ctl = (unsigned*)(ws + WS_CTL);
    const int nother = (int)gridDim.x - N_SCAN;
    if ((int)blockIdx.x < N_SCAN) {
        scan_unit(p, blockIdx.x);
    } else {
        EpiInProj<true> epi{(bf16_t*)(ws + R_QKV), (_Float16*)(ws + R_URW), (bf16_t*)p.out};
        gemm_phase((const bf16_t*)(ws + O_A0), (const bf16_t*)(ws + WS_WIN), D, MP / BM, 14, epi, nother, (int)blockIdx.x - N_SCAN, 6, 7);
        sub_barrier(ctl + 256, (unsigned)nother, true);
        for (int it = (int)blockIdx.x - N_SCAN; it < 128; it += nother) phase2_kmax(p, it);
        sub_barrier(ctl + 320, (unsigned)nother, true);
    }
    sub_barrier(ctl + 320, (unsigned)nother, false);
    volatile int* slot = (volatile int*)(smem + 131072 - 16);
    for (;;) {
        __syncthreads();
        if (threadIdx.x == 0) *slot = (int)atomicAdd(ctl, 1u);
        __syncthreads();
        const int u = *slot;
        if (u >= N_ATTN) break;
        attn_unit(p, u);
    }
}

__device__ __forceinline__ void phase3c(const Params& p) {
    unsigned char* ws = p.ws;
    const _Float16* SI = (const _Float16*)(ws + R_SI);
    constexpr size_t SIE = (size_t)MP * 512;
    const bf16_t* Y = (const bf16_t*)(ws + O_Y);
    const bf16_t* G = (const bf16_t*)(ws + R_G);
    bf16_t* orw = (bf16_t*)(ws + O_ORW);
    const int tid = threadIdx.x, sub = tid & 15;
    constexpr int U = 4;
    for (int it = blockIdx.x; it < 32 * 64; it += gridDim.x) {
        const int bh = it >> 6, c4 = it & 63, b = bh >> 3, h = bh & 7;
        const int c = h * 64 + sub * 4;
        const f32x4 gain = *(const f32x4*)(p.in[14] + c), bias = *(const f32x4*)(p.in[15] + c), rk = *(const f32x4*)(p.in[13] + c);
        u32x2 yb2[U]; f32x4 y[U]; h16x4 r4[U], k4[U], v4[U]; u32x2 g2[U];
#pragma unroll
        for (int u = 0; u < U; ++u) {
            const int t = NMETA + (c4 * U + u) * 32 + (tid >> 4);
            const size_t base = ((size_t)bh * TP + t) * 64 + sub * 4;
            const size_t pbase = ((size_t)bh * TP + t) * 64 + (sub & 3) * 16 + (sub >> 2) * 4;
            yb2[u] = *(const u32x2*)(Y + base);
            r4[u] = *(const h16x4*)(SI + SI_R * SIE + pbase); k4[u] = *(const h16x4*)(SI + SI_K * SIE + pbase); v4[u] = *(const h16x4*)(SI + SI_V * SIE + base);
            g2[u] = *(const u32x2*)(G + pbase);
        }
#pragma unroll
        for (int u = 0; u < U; ++u) {
            const int t = NMETA + (c4 * U + u) * 32 + (tid >> 4);
            y[u][0] = __uint_as_float(yb2[u].x << 16); y[u][1] = __uint_as_float(yb2[u].x & 0xffff0000u); y[u][2] = __uint_as_float(yb2[u].y << 16); y[u][3] = __uint_as_float(yb2[u].y & 0xffff0000u);
            const float mean = reduce16((y[u][0] + y[u][1]) + (y[u][2] + y[u][3])) * (1.0f / 64.0f);
            const f32x4 dy = y[u] - mean;
            const float var = reduce16((dy[0] * dy[0] + dy[1] * dy[1]) + (dy[2] * dy[2] + dy[3] * dy[3])) * (1.0f / 64.0f);
            const float rs = rsqrtf(var + GN_EPS);
            float bs = 0.f;
#pragma unroll
            for (int j = 0; j < 4; ++j) bs += (float)r4[u][j] * (float)k4[u][j] * rk[j];
            bs = reduce16(bs);
            const float gg[4] = {__uint_as_float(g2[u].x << 16), __uint_as_float(g2[u].x & 0xffff0000u), __uint_as_float(g2[u].y << 16), __uint_as_float(g2[u].y & 0xffff0000u)};
            float o[4];
#pragma unroll
            for (int j = 0; j < 4; ++j) o[j] = (dy[j] * rs * gain[j] + bias[j] + bs * (float)v4[u][j]) * gg[j];
            u32x2 w; w.x = pk_bf16(o[0], o[1]); w.y = pk_bf16(o[2], o[3]);
            *(u32x2*)(orw + (size_t)(b * SEQ + t - NMETA) * 512 + c) = w;
        }
    }
}

__device__ __forceinline__ void phase4(const Params& p) {
    unsigned char* ws = p.ws;
    EpiBranch1 e1{(bf16_t*)(ws + O_T1), (const bf16_t*)p.out};
    EpiBranch2 e2{(const bf16_t*)(ws + O_T1), (const bf16_t*)p.out, (bf16_t*)(ws + O_M)};
    gemm_phase((const bf16_t*)(ws + O_OSB), (const bf16_t*)(ws + WS_WSB), 512, MS / BM, D / BM, e1);
    gemm_phase((const bf16_t*)(ws + O_ORW), (const bf16_t*)(ws + WS_WRW), 512, MS / BM, D / BM, e2);
}
__device__ __forceinline__ void phase5(const Params& p) {
    unsigned char* ws = p.ws;
    EpiBf16 e{(bf16_t*)(ws + O_P)};
    gemm_phase((const bf16_t*)(ws + O_M), (const bf16_t*)(ws + WS_WOUT), D, MS / BM, D / BM, e);
}
__device__ __forceinline__ void phase6(const Params& p) {
    unsigned char* ws = p.ws;
    const int lane = threadIdx.x & 63;
    f32x4 g1[4], g2[4];
#pragma unroll
    for (int j = 0; j < 4; ++j) { g1[j] = *(const f32x4*)(p.in[3] + 4 * lane + 256 * j); g2[j] = *(const f32x4*)(p.in[19] + 4 * lane + 256 * j); }
    for (int it = blockIdx.x; it < MS / 16; it += gridDim.x) {
        const int row0 = it * 16 + (threadIdx.x >> 6) * 2;
        f32x4 v[2][4], x[2][4];
#pragma unroll
        for (int r = 0; r < 2; ++r)
#pragma unroll
            for (int j = 0; j < 4; ++j) {
                { const u32x2 pb2 = *(const u32x2*)((const bf16_t*)(ws + O_P) + (size_t)(row0 + r) * D + 4 * lane + 256 * j);
                  v[r][j] = (f32x4){__uint_as_float(pb2.x << 16), __uint_as_float(pb2.x & 0xffff0000u), __uint_as_float(pb2.y << 16), __uint_as_float(pb2.y & 0xffff0000u)}; }
                x[r][j] = *(const f32x4*)(p.in[0] + (size_t)(row0 + r) * D + 4 * lane + 256 * j);
            }
#pragma unroll
        for (int r = 0; r < 2; ++r) {
            const int row = row0 + r;
            float ss = 0.f;
#pragma unroll
            for (int j = 0; j < 4; ++j) ss += (v[r][j][0] * v[r][j][0] + v[r][j][1] * v[r][j][1]) + (v[r][j][2] * v[r][j][2] + v[r][j][3] * v[r][j][3]);
            const float rs = rsqrtf(wave_sum(ss) * (1.0f / D) + RMS_EPS);
            float s2 = 0.f;
#pragma unroll
            for (int j = 0; j < 4; ++j) {
                v[r][j] = x[r][j] + v[r][j] * rs * g1[j];
                *(f32x4*)(p.out + (size_t)row * D + 4 * lane + 256 * j) = v[r][j];
                s2 += (v[r][j][0] * v[r][j][0] + v[r][j][1] * v[r][j][1]) + (v[r][j][2] * v[r][j][2] + v[r][j][3] * v[r][j][3]);
            }
            const float rs2 = rsqrtf(wave_sum(s2) * (1.0f / D) + RMS_EPS);
            bf16_t* fr_ = (bf16_t*)(ws + O_F) + (size_t)row * D;
#pragma unroll
            for (int j = 0; j < 4; ++j) {
                u32x2 w; w.x = pk_bf16(v[r][j][0] * rs2 * g2[j][0], v[r][j][1] * rs2 * g2[j][1]); w.y = pk_bf16(v[r][j][2] * rs2 * g2[j][2], v[r][j][3] * rs2 * g2[j][3]);
                *(u32x2*)(fr_ + 4 * lane + 256 * j) = w;
            }
        }
    }
}
__device__ __forceinline__ void phase7(const Params& p) {
    unsigned char* ws = p.ws;
    EpiGU e{(bf16_t*)(ws + O_ACT)};
    gemm_phase((const bf16_t*)(ws + O_F), (const bf16_t*)(ws + WS_WGU), D, MS / BM, 2 * DFF / BM, e);
}
__device__ __forceinline__ void phase8(const Params& p) {
    unsigned char* ws = p.ws;
    EpiBf16 e{(bf16_t*)(ws + O_DN)};
    gemm_phase((const bf16_t*)(ws + O_ACT), (const bf16_t*)(ws + WS_WD), DFF, MS / BM, D / BM, e);
}
__device__ __forceinline__ void phase9(const Params& p) {
    unsigned char* ws = p.ws;
    const int lane = threadIdx.x & 63;
    f32x4 g[4];
#pragma unroll
    for (int j = 0; j < 4; ++j) g[j] = *(const f32x4*)(p.in[20] + 4 * lane + 256 * j);
    for (int it = blockIdx.x; it < MS / 16; it += gridDim.x) {
        const int row0 = it * 16 + (threadIdx.x >> 6) * 2;
        f32x4 v[2][4], h1[2][4];
#pragma unroll
        for (int r = 0; r < 2; ++r)
#pragma unroll
            for (int j = 0; j < 4; ++j) {
                { const u32x2 db2 = *(const u32x2*)((const bf16_t*)(ws + O_DN) + (size_t)(row0 + r) * D + 4 * lane + 256 * j);
                  v[r][j] = (f32x4){__uint_as_float(db2.x << 16), __uint_as_float(db2.x & 0xffff0000u), __uint_as_float(db2.y << 16), __uint_as_float(db2.y & 0xffff0000u)}; }
                h1[r][j] = *(const f32x4*)(p.out + (size_t)(row0 + r) * D + 4 * lane + 256 * j);
            }
#pragma unroll
        for (int r = 0; r < 2; ++r) {
            float ss = 0.f;
#pragma unroll
            for (int j = 0; j < 4; ++j) ss += (v[r][j][0] * v[r][j][0] + v[r][j][1] * v[r][j][1]) + (v[r][j][2] * v[r][j][2] + v[r][j][3] * v[r][j][3]);
            const float rs = rsqrtf(wave_sum(ss) * (1.0f / D) + RMS_EPS);
#pragma unroll
            for (int j = 0; j < 4; ++j) *(f32x4*)(p.out + (size_t)(row0 + r) * D + 4 * lane + 256 * j) = h1[r][j] + v[r][j] * rs * g[j];
        }
    }
}

constexpr int N_PHASES = 11;
__device__ __forceinline__ void run_phase(const Params& p, int ph) {
    switch (ph) {
        case 0: phase0(p); break;
        case 1: phase1(p); break;
        case 2: phase2(p); break;
        case 3: phase3(p); break;
        case 4: phase3c(p); break;
        case 5: phase4(p); break;
        case 6: phase5(p); break;
        case 7: phase6(p); break;
        case 8: phase7(p); break;
        case 9: phase8(p); break;
        default: phase9(p); break;
    }
}

#if MULTI_LAUNCH
template <int PH> __global__ void __launch_bounds__(512) fwd_phase(Params p) { run_phase(p, PH); }
#else
__global__ void __launch_bounds__(512) fwd_mega(Params p) {
    cg::grid_group grid = cg::this_grid();
    volatile LAS unsigned* st = (volatile LAS unsigned*)(smem + 131072);
    if (threadIdx.x == 0) { st[0] = 0u; st[1] = 0u; }
    __syncthreads();
    const XcdBarrier xb = xcd_barrier_post((unsigned*)(p.ws + WS_BAR), st);
    if (p.out == nullptr) grid.sync();
    phase0(p); xcd_barrier(xb); phase1(p); xcd_barrier(xb); phase2(p); xcd_barrier(xb); phase3(p); xcd_barrier(xb); phase3c(p); xcd_barrier(xb);
    phase4(p); xcd_barrier(xb); phase5(p); xcd_barrier(xb); phase6(p); xcd_barrier(xb); phase7(p); xcd_barrier(xb); phase8(p); xcd_barrier(xb); phase9(p);
}
#endif

extern "C" void kernel_launch(void* const* d_in, const int* in_sizes, int n_in, void* d_out, int out_size, void* d_ws, size_t ws_size, hipStream_t stream) {
    static int grid = 0;
    if (grid == 0) {
        if (n_in != 24 || out_size != MS * D || ws_size < WS_END) { fprintf(stderr, "kernel_launch: unexpected shapes (n_in %d out %d ws %zu need %zu)\n", n_in, out_size, ws_size, (size_t)WS_END); grid = -1; return; }
        int dev = 0, cus = 0, per_cu = 0;
        (void)hipGetDevice(&dev);
        (void)hipDeviceGetAttribute(&cus, hipDeviceAttributeMultiprocessorCount, dev);
#if MULTI_LAUNCH
        per_cu = 1;
#else
        (void)hipFuncSetAttribute((const void*)fwd_mega, hipFuncAttributeMaxDynamicSharedMemorySize, LDS_BYTES);
        (void)hipOccupancyMaxActiveBlocksPerMultiprocessor(&per_cu, (const void*)fwd_mega, 512, LDS_BYTES);
        if (per_cu < 1) { fprintf(stderr, "kernel_launch: occupancy query says %d blocks per CU\n", per_cu); per_cu = 1; }
        if (per_cu > 1) per_cu = 1;
#endif
        grid = cus * per_cu;
        if (grid <= N_SCAN) { fprintf(stderr, "kernel_launch: grid %d too small (needs more than %d workgroups)\n", grid, N_SCAN); grid = -1; return; }
    }
    if (grid < 0) return;
    Params p{};
    for (int i = 0; i < 24; ++i) p.in[i] = (const float*)d_in[i];
    p.out = (float*)d_out; p.ws = (unsigned char*)d_ws;
#if MULTI_LAUNCH
#define LP(PH) do { (void)hipFuncSetAttribute((const void*)fwd_phase<PH>, hipFuncAttributeMaxDynamicSharedMemorySize, LDS_BYTES); hipLaunchKernelGGL(fwd_phase<PH>, dim3(grid), dim3(512), LDS_BYTES, stream, p); } while (0)
    LP(0); LP(1); LP(2); LP(3); LP(4); LP(5); LP(6); LP(7); LP(8); LP(9); LP(10);
#undef LP
#else
    if (hipMemsetAsync(d_ws, 0, WS_CTL_BYTES, stream) != hipSuccess) { fprintf(stderr, "kernel_launch: hipMemsetAsync of the control words failed\n"); return; }
    void* args[] = {&p};
    hipError_t e = hipLaunchCooperativeKernel((const void*)fwd_mega, dim3(grid), dim3(512), args, LDS_BYTES, stream);
    if (e != hipSuccess) fprintf(stderr, "cooperative launch failed: %s (grid %d)\n", hipGetErrorString(e), grid);
#endif
}
```

```cpp
#include <hip/hip_runtime.h>
#include <hip/hip_cooperative_groups.h>
#include <cstdio>
#include <cstdint>
#include <type_traits>
namespace cg = cooperative_groups;

#ifndef MULTI_LAUNCH
#define MULTI_LAUNCH 0
#endif

typedef unsigned short bf16_t;
typedef short bf16x8 __attribute__((ext_vector_type(8)));
typedef float f32x4 __attribute__((ext_vector_type(4)));
typedef float f32x2 __attribute__((ext_vector_type(2)));
typedef unsigned u32x2 __attribute__((ext_vector_type(2)));
typedef unsigned u32x4 __attribute__((ext_vector_type(4)));
typedef _Float16 h16x2 __attribute__((ext_vector_type(2)));
typedef _Float16 h16x4 __attribute__((ext_vector_type(4)));
typedef _Float16 h16x8 __attribute__((ext_vector_type(8)));

constexpr int D = 1024, NB = 4, SEQ = 8192, NMETA = 16, T = SEQ + NMETA, TP = 8320, MP = NB * TP, MS = NB * SEQ;
constexpr int PIN = 5376, DFF = 2816, NH = 8, RWS = 1792;
constexpr float RMS_EPS = 1e-6f, GN_EPS = 64e-5f;

constexpr size_t WS_CTL = 0;
constexpr size_t WS_BAR = 4096;
constexpr size_t WS_CTL_BYTES = 32768;
constexpr size_t WS_WIN = WS_CTL_BYTES;
constexpr size_t WS_WSB = WS_WIN + (size_t)PIN * D * 2;
constexpr size_t WS_WRW = WS_WSB + (size_t)D * 512 * 2;
constexpr size_t WS_WOUT = WS_WRW + (size_t)D * 512 * 2;
constexpr size_t WS_WGU = WS_WOUT + (size_t)D * D * 2;
constexpr size_t WS_WD = WS_WGU + (size_t)2 * DFF * D * 2;
constexpr size_t WS_WL = WS_WD + (size_t)D * DFF * 2;
constexpr size_t R_A0 = WS_WL + (size_t)512 * 256 * 2;
constexpr size_t R_URW = R_A0 + (size_t)MP * D * 2;
constexpr size_t R_QKV = R_URW;
constexpr size_t QKV_ONE = (size_t)MP * 512 * 2;
constexpr size_t R_SI = R_URW + (size_t)MP * RWS * 2;
constexpr size_t SI_ONE = (size_t)MP * 512 * 2;
constexpr size_t R_G = R_SI + 6 * SI_ONE;
constexpr size_t R_TAIL = R_G + SI_ONE;
constexpr size_t O_Y = R_TAIL;
constexpr size_t O_OSB = R_TAIL + SI_ONE;
constexpr size_t WS_END = O_OSB + (size_t)MS * 512 * 2;
constexpr size_t O_A0 = R_A0;
constexpr size_t O_ORW = R_A0;
constexpr size_t O_T1 = R_SI;
constexpr size_t O_M = R_SI + (size_t)MS * D * 4;
constexpr size_t O_P = R_A0;
constexpr size_t O_F = R_SI;
constexpr size_t O_ACT = R_A0;
constexpr size_t O_DN = R_SI + (size_t)MS * D * 2;
static_assert(3 * QKV_ONE <= (size_t)MP * RWS * 2, "overlay");
static_assert(O_M + (size_t)MS * D * 2 <= R_TAIL, "overlay");
static_assert(O_ACT + (size_t)MS * DFF * 2 <= R_SI, "overlay");
static_assert(O_P + (size_t)MS * D * 4 <= R_SI, "overlay");
static_assert(O_DN + (size_t)MS * D * 4 <= R_TAIL, "overlay");
static_assert(WS_END <= (size_t)512 * 1024 * 1024, "workspace");

constexpr int LDS_BYTES = 131072 + 64;

struct Params { const float* in[24]; float* out; unsigned char* ws; };

extern __shared__ __attribute__((aligned(16))) unsigned char smem[];

typedef __bf16 b16x2 __attribute__((ext_vector_type(2)));
__device__ __forceinline__ unsigned pk_bf16(float lo, float hi) { const f32x2 v = {lo, hi}; return __builtin_bit_cast(unsigned, __builtin_convertvector(v, b16x2)); }
__device__ __forceinline__ float bf2f(unsigned short v) { return __uint_as_float((unsigned)v << 16); }
__device__ __forceinline__ float sigmoidf_(float x) { return __builtin_amdgcn_rcpf(1.0f + __expf(-x)); }
__device__ __forceinline__ float softplusf_(float x) { return fmaxf(x, 0.f) + __logf(1.0f + __expf(-fabsf(x))); }
template <int CTRL> __device__ __forceinline__ float dppf(float x) { return __builtin_bit_cast(float, __builtin_amdgcn_mov_dpp(__builtin_bit_cast(int, x), CTRL, 0xf, 0xf, true)); }
__device__ __forceinline__ float reduce16(float v) {
    v += dppf<0xB1>(v); v += dppf<0x4E>(v); v += dppf<0x141>(v); v += dppf<0x140>(v); return v;
}
__device__ __forceinline__ float wave_sum(float v) {
#pragma unroll
    for (int o = 1; o < 64; o <<= 1) v += __shfl_xor(v, o);
    return v;
}

#define LAS __attribute__((address_space(3)))
#define XB_TMO      128
#define XB_XCNT(j)  (256  + 64 * (j))
#define XB_XSUB(j)  (1280 + 64 * (j))
#define XB_XGEN(j)  (2304 + 64 * (j))
#define XB_TOP      3328
#define XB_TOPGEN   3392
#define XCD_BAR_WORDS 3456
#define XB_SPIN_CAP (1u << 18)
__device__ __forceinline__ unsigned xb_ld(unsigned* p)              { return __hip_atomic_load(p, __ATOMIC_RELAXED, __HIP_MEMORY_SCOPE_AGENT); }
__device__ __forceinline__ unsigned xb_add(unsigned* p, unsigned v) { return __hip_atomic_fetch_add(p, v, __ATOMIC_RELAXED, __HIP_MEMORY_SCOPE_AGENT); }
__device__ __forceinline__ unsigned xb_xcc_id() { return (unsigned)__builtin_amdgcn_s_getreg((3 << 11) | 20) & 0xFu; }
#define XB_SPIN(cond, bar) do { unsigned _sp = 0; while (cond) { __builtin_amdgcn_s_sleep(1); \
    if ((++_sp & 255u) == 0u) { if (xb_ld(&(bar)[XB_TMO])) break; if (_sp > XB_SPIN_CAP) { atomicAdd(&(bar)[XB_TMO], 1u); break; } } } } while (0)
struct XcdBarrier { unsigned* bar; unsigned x; volatile LAS unsigned* st; };
__device__ __forceinline__ XcdBarrier xcd_barrier_post(unsigned* bar, volatile LAS unsigned* st) {
    XcdBarrier b; b.bar = bar; b.x = xb_xcc_id(); b.st = st;
    if (threadIdx.x == 0) (void)xb_add(&bar[XB_XCNT(b.x)], 1u);
    return b;
}
__device__ __forceinline__ void xcd_barrier_complete(unsigned* bar, unsigned x, unsigned& nloc, unsigned& nx) {
    const unsigned G = gridDim.x * gridDim.y * gridDim.z;
    unsigned sum, cnt, mine, sp = 0u;
    for (;;) {
        sum = 0u; cnt = 0u; mine = 0u;
#pragma unroll
        for (unsigned j = 0; j < 16; ++j) { const unsigned c = xb_ld(&bar[XB_XCNT(j)]); sum += c; cnt += (c > 0u) ? 1u : 0u; mine = (j == x) ? c : mine; }
        if (sum == G) break;
        __builtin_amdgcn_s_sleep(1);
        if ((++sp & 255u) == 0u) { if (xb_ld(&bar[XB_TMO])) break; if (sp > XB_SPIN_CAP) { atomicAdd(&bar[XB_TMO], 1u); break; } }
    }
    nloc = mine > 0u ? mine : 1u; nx = cnt > 0u ? cnt : 1u;
}
__device__ __forceinline__ void xcd_barrier(const XcdBarrier& b) {
    asm volatile("s_waitcnt vmcnt(0)" ::: "memory");
    __syncthreads();
    if (threadIdx.x == 0) {
        unsigned* bar = b.bar;
        __builtin_amdgcn_s_waitcnt(0);
        unsigned nloc = b.st[0], nx = b.st[1];
        if (nloc == 0u) { xcd_barrier_complete(bar, b.x, nloc, nx); b.st[0] = nloc; b.st[1] = nx; }
        const unsigned old = xb_add(&bar[XB_XSUB(b.x)], 1u);
        const unsigned gen = old / nloc;
        if (old + 1u == (gen + 1u) * nloc) {
            __builtin_amdgcn_fence(__ATOMIC_RELEASE, "agent");
            asm volatile("s_waitcnt vmcnt(0)" ::: "memory");
            const unsigned og = xb_add(&bar[XB_TOP], 1u);
            const unsigned tg = og / nx;
            if (og + 1u == (tg + 1u) * nx) xb_add(&bar[XB_TOPGEN], 1u);
            else XB_SPIN(xb_ld(&bar[XB_TOPGEN]) == tg, bar);
            __builtin_amdgcn_fence(__ATOMIC_ACQUIRE, "agent");
            xb_add(&bar[XB_XGEN(b.x)], 1u);
            asm volatile("s_waitcnt vmcnt(0)" ::: "memory");
        } else {
            XB_SPIN(xb_ld(&bar[XB_XGEN(b.x)]) == gen, bar);
            __builtin_amdgcn_fence(__ATOMIC_ACQUIRE, "agent");
            asm volatile("s_waitcnt vmcnt(0)" ::: "memory");
        }
    }
    __syncthreads();
}

constexpr int BM = 256, BK = 64, HALF = 128, HTB = HALF * BK * 2, NXCD = 8, WGM = 8;
__device__ __forceinline__ int lds_byte(int r, int c) { const int st = (r >> 4) * 2 + (c >> 5), rr = r & 15, cc = c & 31, ob = rr * 64 + cc * 2; return st * 1024 + (ob ^ (((ob >> 9) & 1) << 5)); }
__device__ __forceinline__ void stage_rc(int b, int& R, int& C) { const int st = b / 1024, sb = b % 1024, swz = sb ^ (((sb >> 9) & 1) << 5); R = (st >> 1) * 16 + swz / 64; C = (st & 1) * 32 + (swz % 64) / 2; }
struct Unit { int pm, pn; };
struct Sched {
    int nM, nN, nwg, G, c;
    __device__ __forceinline__ bool next(int i, Unit& u) const {
        const long L = (long)i * G + c; if (L >= nwg) return false;
        int wgid = (int)L; { const int q = nwg / NXCD, r = nwg % NXCD, xcd = wgid % NXCD, off = wgid / NXCD; wgid = (xcd < r ? xcd * (q + 1) : r * (q + 1) + (xcd - r) * q) + off; }
        const int nig = WGM * nN, gid = wgid / nig, fm = gid * WGM, gsz = (nM - fm) < WGM ? (nM - fm) : WGM;
        u.pm = fm + ((wgid % nig) % gsz); u.pn = (wgid % nig) / gsz; return true;
    }
};

template <class Epi>
__device__ __forceinline__ void gemm_phase(const bf16_t* __restrict__ Ag, const bf16_t* __restrict__ Btg, const int K, const int nM, const int nN, const Epi& E,
                                           const int G = (int)gridDim.x, const int c = (int)blockIdx.x, const int pn_from = 1 << 30, const int pn_add = 0) {
    LAS unsigned char* lds = (LAS unsigned char*)smem;
    const int tid = threadIdx.x, wid = __builtin_amdgcn_readfirstlane(tid >> 6), lane = tid & 63, wr = wid >> 2, wc = wid & 3, fr = lane & 15, fq = lane >> 4;
    const int nt = K / BK;
    Sched S; S.nM = nM; S.nN = nN; S.nwg = nM * nN; S.G = G; S.c = c;
    unsigned voffA[2], voffB[2];
#pragma unroll
    for (int i = 0; i < 2; ++i) { int R, C; stage_rc(tid * 16 + i * 8192, R, C);
        const int Rb = Epi::PERM ? ((R & ~31) + 8 * ((R & 15) >> 2) + 4 * ((R & 31) >> 4) + (R & 3)) : R;
        voffA[i] = (unsigned)(R * K + C) * 2u; voffB[i] = (unsigned)(Rb * K + C) * 2u; }
    const size_t kstep = (size_t)(BK * 2);
    const size_t hstep = (size_t)HALF * K * 2;
    const size_t tstep = 2 * hstep;
    const unsigned ldsw = (unsigned)wid * 1024u;
    const int aoff = lds_byte(wr * 64 + fr, fq * 8), boff = lds_byte(wc * 32 + fr, fq * 8);
#define PG8_SA(b, h) (((b) * 2 + (h)) * HTB)
#define PG8_SB(b, h) ((4 + (b) * 2 + (h)) * HTB)
#define PG8_STAGE(bufoff, gbase, voff) do { _Pragma("unroll") for (int _i = 0; _i < 2; ++_i) \
        __builtin_amdgcn_global_load_lds((const unsigned*)((const char*)(gbase) + (voff)[_i]), (LAS unsigned*)(lds + (bufoff) + ldsw + _i * 8192), 16, 0, 0); } while (0)
#define PG8_LDA(dst, b, h) do { _Pragma("unroll") for (int m = 0; m < 4; ++m) _Pragma("unroll") for (int k = 0; k < 2; ++k) dst[m][k] = *(const LAS bf16x8*)(lds + PG8_SA(b, h) + aoff + m * 2048 + k * 1024); } while (0)
#define PG8_LDB(dst, b, h) do { _Pragma("unroll") for (int n = 0; n < 2; ++n) _Pragma("unroll") for (int k = 0; k < 2; ++k) dst[n][k] = *(const LAS bf16x8*)(lds + PG8_SB(b, h) + boff + n * 2048 + k * 1024); } while (0)
#define PG8_MMA(ai, bj, At, Bt) do { __builtin_amdgcn_s_setprio(1); _Pragma("unroll") for (int m = 0; m < 4; ++m) _Pragma("unroll") for (int n = 0; n < 2; ++n) _Pragma("unroll") for (int k = 0; k < 2; ++k) \
        acc[ai][bj][m][n] = __builtin_amdgcn_mfma_f32_16x16x32_bf16(Bt[n][k], At[m][k], acc[ai][bj][m][n], 0, 0, 0); __builtin_amdgcn_s_setprio(0); } while (0)
#define PG8_WAIT_V(n) asm volatile("s_waitcnt vmcnt(" #n ")" ::: "memory")
#define PG8_WAIT_L(n) asm volatile("s_waitcnt lgkmcnt(" #n ")" ::: "memory")
#define PG8_BAR __builtin_amdgcn_s_barrier()
#define PG8_SCHED __builtin_amdgcn_sched_barrier(0)
    Unit cur, nxt; int ui = 0;
    __syncthreads();
    if (!S.next(0, cur)) return;
    if (cur.pn >= pn_from) cur.pn += pn_add;
    f32x4 acc[2][2][4][2];
#pragma unroll
    for (int a = 0; a < 2; ++a)
#pragma unroll
        for (int b = 0; b < 2; ++b)
#pragma unroll
            for (int m = 0; m < 4; ++m)
#pragma unroll
                for (int n = 0; n < 2; ++n) acc[a][b][m][n] = (f32x4){0.f, 0.f, 0.f, 0.f};
    bf16x8 At[4][2], B0[2][2], B1[2][2];
    const char* cA = (const char*)Ag + (size_t)cur.pm * tstep; const char* cB = (const char*)Btg + (size_t)cur.pn * tstep;
    PG8_STAGE(PG8_SB(0, 0), cB, voffB); PG8_STAGE(PG8_SA(0, 0), cA, voffA); PG8_STAGE(PG8_SB(0, 1), cB + hstep, voffB); PG8_STAGE(PG8_SA(0, 1), cA + hstep, voffA);
    if (wr == 1) PG8_BAR;
    PG8_WAIT_V(4); PG8_BAR;
    PG8_STAGE(PG8_SB(1, 0), cB + kstep, voffB); PG8_STAGE(PG8_SA(1, 0), cA + kstep, voffA); PG8_STAGE(PG8_SB(1, 1), cB + hstep + kstep, voffB);
    PG8_WAIT_V(6); PG8_BAR;
    for (;;) {
        const bool has_next = S.next(ui + 1, nxt);
        if (has_next && nxt.pn >= pn_from) nxt.pn += pn_add;
        const char* nA = has_next ? (const char*)Ag + (size_t)nxt.pm * tstep : cA; const char* nB = has_next ? (const char*)Btg + (size_t)nxt.pn * tstep : cB;
        for (int t = 0; t < nt; t += 2) {
            const bool last = (t == nt - 2);
            const char* a1 = cA + (size_t)(t + 1) * kstep;
            const char* a2 = last ? nA : cA + (size_t)(t + 2) * kstep; const char* b2 = last ? nB : cB + (size_t)(t + 2) * kstep;
            const char* a3 = a2 + kstep; const char* b3 = b2 + kstep;
            PG8_LDB(B0, 0, 0); PG8_SCHED; PG8_LDA(At, 0, 0); PG8_STAGE(PG8_SA(1, 1), a1 + hstep, voffA);
            PG8_WAIT_L(8); PG8_BAR; PG8_WAIT_L(0); PG8_MMA(0, 0, At, B0); PG8_BAR; PG8_SCHED;
            PG8_LDB(B1, 0, 1); PG8_STAGE(PG8_SB(0, 0), b2, voffB);
            PG8_BAR; PG8_WAIT_L(0); PG8_MMA(0, 1, At, B1); PG8_BAR;
            PG8_LDA(At, 0, 1); PG8_STAGE(PG8_SA(0, 0), a2, voffA);
            PG8_BAR; PG8_WAIT_L(0); PG8_MMA(1, 0, At, B0); PG8_BAR; PG8_SCHED;
            PG8_STAGE(PG8_SB(0, 1), b2 + hstep, voffB);
            PG8_WAIT_V(6); PG8_BAR; PG8_MMA(1, 1, At, B1); PG8_BAR;
            PG8_LDB(B0, 1, 0); PG8_SCHED; PG8_LDA(At, 1, 0); PG8_STAGE(PG8_SA(0, 1), a2 + hstep, voffA);
            PG8_WAIT_L(8); PG8_BAR; PG8_WAIT_L(0); PG8_MMA(0, 0, At, B0); PG8_BAR; PG8_SCHED;
            PG8_LDB(B1, 1, 1); PG8_STAGE(PG8_SB(1, 0), b3, voffB);
            PG8_BAR; PG8_WAIT_L(0); PG8_MMA(0, 1, At, B1); PG8_BAR;
            PG8_LDA(At, 1, 1); PG8_STAGE(PG8_SA(1, 0), a3, voffA);
            PG8_BAR; PG8_WAIT_L(0); PG8_MMA(1, 0, At, B0); PG8_BAR; PG8_SCHED;
            PG8_STAGE(PG8_SB(1, 1), b3 + hstep, voffB);
            PG8_WAIT_V(6); PG8_BAR; PG8_MMA(1, 1, At, B1); PG8_BAR;
        }
        {
            const int brow = cur.pm * BM, bcol = cur.pn * BM;
#pragma unroll
            for (int ai = 0; ai < 2; ++ai)
#pragma unroll
                for (int m = 0; m < 4; ++m) {
                    E.row(brow + ai * HALF + wr * 64 + m * 16 + fr, bcol + wc * 32, fq, acc[ai][0][m][0], acc[ai][0][m][1], acc[ai][1][m][0], acc[ai][1][m][1]);
                    asm volatile("" ::: "memory");
                }
        }
        if (!has_next) break;
#pragma unroll
        for (int a = 0; a < 2; ++a)
#pragma unroll
            for (int b = 0; b < 2; ++b)
#pragma unroll
                for (int m = 0; m < 4; ++m)
#pragma unroll
                    for (int n = 0; n < 2; ++n) acc[a][b][m][n] = (f32x4){0.f, 0.f, 0.f, 0.f};
        cur = nxt; cA = nA; cB = nB; ++ui;
    }
    PG8_WAIT_V(0);
    if (wr == 0) PG8_BAR;
    PG8_BAR;
#undef PG8_SA
#undef PG8_SB
#undef PG8_STAGE
#undef PG8_LDA
#undef PG8_LDB
#undef PG8_MMA
#undef PG8_WAIT_V
#undef PG8_WAIT_L
#undef PG8_BAR
#undef PG8_SCHED
}

template <bool PERM_> struct EpiInProj {
    static constexpr bool PERM = PERM_;
    bf16_t* qkv; _Float16* urw; bf16_t* gates;
    __device__ __forceinline__ void one(int row, int col, const f32x4& v) const {
        if (col < 1536) {
            const int which = col >> 9, hc = col & 511, h = hc >> 6, d = hc & 63, b = row / TP, t = row - b * TP;
            const float s = which == 0 ? 0.125f : 1.0f;
            u32x2 w; w.x = pk_bf16(v[0] * s, v[1] * s); w.y = pk_bf16(v[2] * s, v[3] * s);
            *(u32x2*)(qkv + (size_t)which * (QKV_ONE / 2) + ((size_t)(b * NH + h) * TP + t) * 64 + d) = w;
        } else if (col < 3328) {
            h16x4 o; o[0] = (_Float16)v[0]; o[1] = (_Float16)v[1]; o[2] = (_Float16)v[2]; o[3] = (_Float16)v[3];
            *(h16x4*)(urw + (size_t)row * RWS + (col - 1536)) = o;
        } else {
            const int b = row / TP, t = row - b * TP;
            if (t >= NMETA && t < T) {
                u32x2 w; w.x = pk_bf16(sigmoidf_(v[0]), sigmoidf_(v[1])); w.y = pk_bf16(sigmoidf_(v[2]), sigmoidf_(v[3]));
                *(u32x2*)(gates + (size_t)(b * SEQ + t - NMETA) * 2048 + (col - 3328)) = w;
            }
        }
    }
    __device__ __forceinline__ void half(int row, int col32, int fq, const f32x4& v0, const f32x4& v1) const {
        if constexpr (PERM_) {
            const int col = col32 + 8 * fq, b = row / TP, t = row - b * TP;
            if (col < 1536) {
                const int which = col >> 9, hc = col & 511, h = hc >> 6, d = hc & 63;
                const float s = which == 0 ? 0.125f : 1.0f;
                u32x4 w; w.x = pk_bf16(v0[0] * s, v0[1] * s); w.y = pk_bf16(v0[2] * s, v0[3] * s); w.z = pk_bf16(v1[0] * s, v1[1] * s); w.w = pk_bf16(v1[2] * s, v1[3] * s);
                *(u32x4*)(qkv + (size_t)which * (QKV_ONE / 2) + ((size_t)(b * NH + h) * TP + t) * 64 + d) = w;
            } else if (t >= NMETA && t < T) {
                u32x4 w; w.x = pk_bf16(sigmoidf_(v0[0]), sigmoidf_(v0[1])); w.y = pk_bf16(sigmoidf_(v0[2]), sigmoidf_(v0[3]));
                w.z = pk_bf16(sigmoidf_(v1[0]), sigmoidf_(v1[1])); w.w = pk_bf16(sigmoidf_(v1[2]), sigmoidf_(v1[3]));
                *(u32x4*)(gates + (size_t)(b * SEQ + t - NMETA) * 2048 + (col - 3328)) = w;
            }
        } else {
            if (col32 >= 1536 && col32 < 3072) {
                const int c = col32 - 1536, pos = (c & ~63) + fq * 16 + ((c & 63) >> 4) * 4;
                h16x8 o;
#pragma unroll
                for (int j = 0; j < 4; ++j) { o[j] = (_Float16)v0[j]; o[4 + j] = (_Float16)v1[j]; }
                *(h16x8*)(urw + (size_t)row * RWS + pos) = o;
            } else { one(row, col32 + 4 * fq, v0); one(row, col32 + 16 + 4 * fq, v1); }
        }
    }
    __device__ __forceinline__ void row(int r, int col32, int fq, const f32x4& a00, const f32x4& a01, const f32x4& a10, const f32x4& a11) const { half(r, col32, fq, a00, a01); half(r, col32 + HALF, fq, a10, a11); }
};
__device__ __forceinline__ void bf8_to_f(const u32x4& g, float (&f)[8]) {
#pragma unroll
    for (int i = 0; i < 4; ++i) { f[2 * i] = __uint_as_float(g[i] << 16); f[2 * i + 1] = __uint_as_float(g[i] & 0xffff0000u); }
}
struct EpiBranch1 {
    static constexpr bool PERM = true;
    bf16_t* t1; const bf16_t* gates;
    __device__ __forceinline__ void half(int row, int col32, int fq, const f32x4& v0, const f32x4& v1) const {
        const int col = col32 + 8 * fq;
        float g[8]; bf8_to_f(*(const u32x4*)(gates + (size_t)row * 2048 + col), g);
        u32x4 w; w.x = pk_bf16(v0[0] * g[0], v0[1] * g[1]); w.y = pk_bf16(v0[2] * g[2], v0[3] * g[3]); w.z = pk_bf16(v1[0] * g[4], v1[1] * g[5]); w.w = pk_bf16(v1[2] * g[6], v1[3] * g[7]);
        *(u32x4*)(t1 + (size_t)row * D + col) = w;
    }
    __device__ __forceinline__ void row(int r, int col32, int fq, const f32x4& a00, const f32x4& a01, const f32x4& a10, const f32x4& a11) const { half(r, col32, fq, a00, a01); half(r, col32 + HALF, fq, a10, a11); }
};
struct EpiBranch2 {
    static constexpr bool PERM = true;
    const bf16_t* t1; const bf16_t* gates; bf16_t* m;
    __device__ __forceinline__ void half(int row, int col32, int fq, const f32x4& v0, const f32x4& v1) const {
        const int col = col32 + 8 * fq;
        float g[8], a[8]; bf8_to_f(*(const u32x4*)(gates + (size_t)row * 2048 + 1024 + col), g); bf8_to_f(*(const u32x4*)(t1 + (size_t)row * D + col), a);
        u32x4 w; w.x = pk_bf16(a[0] + v0[0] * g[0], a[1] + v0[1] * g[1]); w.y = pk_bf16(a[2] + v0[2] * g[2], a[3] + v0[3] * g[3]);
        w.z = pk_bf16(a[4] + v1[0] * g[4], a[5] + v1[1] * g[5]); w.w = pk_bf16(a[6] + v1[2] * g[6], a[7] + v1[3] * g[7]);
        *(u32x4*)(m + (size_t)row * D + col) = w;
    }
    __device__ __forceinline__ void row(int r, int col32, int fq, const f32x4& a00, const f32x4& a01, const f32x4& a10, const f32x4& a11) const { half(r, col32, fq, a00, a01); half(r, col32 + HALF, fq, a10, a11); }
};
struct EpiF32 {
    static constexpr bool PERM = true;
    float* o;
    __device__ __forceinline__ void row(int r, int col32, int fq, const f32x4& a00, const f32x4& a01, const f32x4& a10, const f32x4& a11) const {
        float* q = o + (size_t)r * D + col32 + 8 * fq;
        *(f32x4*)q = a00; *(f32x4*)(q + 4) = a01; *(f32x4*)(q + HALF) = a10; *(f32x4*)(q + HALF + 4) = a11;
    }
};
struct EpiBf16 {
    static constexpr bool PERM = true;
    bf16_t* o;
    __device__ __forceinline__ void row(int r, int col32, int fq, const f32x4& a00, const f32x4& a01, const f32x4& a10, const f32x4& a11) const {
        bf16_t* q = o + (size_t)r * D + col32 + 8 * fq;
        u32x4 w0, w1;
        w0.x = pk_bf16(a00[0], a00[1]); w0.y = pk_bf16(a00[2], a00[3]); w0.z = pk_bf16(a01[0], a01[1]); w0.w = pk_bf16(a01[2], a01[3]);
        w1.x = pk_bf16(a10[0], a10[1]); w1.y = pk_bf16(a10[2], a10[3]); w1.z = pk_bf16(a11[0], a11[1]); w1.w = pk_bf16(a11[2], a11[3]);
        *(u32x4*)q = w0; *(u32x4*)(q + HALF) = w1;
    }
};
struct EpiGU {
    static constexpr bool PERM = true;
    bf16_t* act;
    __device__ __forceinline__ void row(int r, int col32, int fq, const f32x4& g0, const f32x4& g1, const f32x4& u0, const f32x4& u1) const {
        float o[8];
#pragma unroll
        for (int j = 0; j < 4; ++j) { o[j] = g0[j] * sigmoidf_(g0[j]) * u0[j]; o[4 + j] = g1[j] * sigmoidf_(g1[j]) * u1[j]; }
        u32x4 w; w.x = pk_bf16(o[0], o[1]); w.y = pk_bf16(o[2], o[3]); w.z = pk_bf16(o[4], o[5]); w.w = pk_bf16(o[6], o[7]);
        const int pn = col32 >> 8, cin = (col32 & 255) + 8 * fq;
        *(u32x4*)(act + (size_t)r * DFF + pn * 128 + cin) = w;
    }
};

__device__ __forceinline__ void transpose_tile(const float* __restrict__ src, int K, int N, bf16_t* __restrict__ dst, int ldd, int koff, int mode, int tile) {
    float* scr = (float*)smem;
    const int ntn = N / 128, kb = tile / ntn, nb = tile % ntn, k0 = kb * 64, n0 = nb * 128, tid = threadIdx.x;
    f32x4 v[4];
#pragma unroll
    for (int i = 0; i < 4; ++i) { const int idx = tid + 512 * i, kk = idx >> 5, n4 = idx & 31; v[i] = *(const f32x4*)(src + (size_t)(k0 + kk) * N + n0 + n4 * 4); }
#pragma unroll
    for (int i = 0; i < 4; ++i) { const int idx = tid + 512 * i, kk = idx >> 5, n4 = idx & 31;
#pragma unroll
        for (int c = 0; c < 4; ++c) scr[kk * 129 + n4 * 4 + c] = v[i][c]; }
    __syncthreads();
#pragma unroll
    for (int i = 0; i < 2; ++i) {
        const int o = tid + 512 * i, n = o >> 3, kc = (o & 7) * 8;
        u32x4 w;
        w.x = pk_bf16(scr[(kc + 0) * 129 + n], scr[(kc + 1) * 129 + n]); w.y = pk_bf16(scr[(kc + 2) * 129 + n], scr[(kc + 3) * 129 + n]);
        w.z = pk_bf16(scr[(kc + 4) * 129 + n], scr[(kc + 5) * 129 + n]); w.w = pk_bf16(scr[(kc + 6) * 129 + n], scr[(kc + 7) * 129 + n]);
        const int f = n0 + n;
        const int drow = mode == 0 ? f : ((f >> 7) * 256 + (mode == 2 ? 128 : 0) + (f & 127));
        *(u32x4*)(dst + (size_t)drow * ldd + koff + k0 + kc) = w;
    }
    __syncthreads();
}

__device__ __forceinline__ void phase0(const Params& p) {
    unsigned char* ws = p.ws;
    if (blockIdx.x == 0 && threadIdx.x < 64) ((unsigned*)(ws + WS_CTL))[threadIdx.x] = 0u;
    constexpr int J0 = 16 * 42, J1 = 8 * 8, J3 = 16 * 8, J4 = 16 * 22, J6 = 44 * 8, J7 = 4, J9 = 8;
    constexpr int NT = J0 + 2 * J1 + J3 + 2 * J4 + J6 + 2 * J7 + J9;
    constexpr int NR = MP / 32;
    for (int it = blockIdx.x; it < NT + NR; it += gridDim.x) {
        if (it >= NR) {
            int r = it - NR;
            if (r < J0) { transpose_tile(p.in[4], D, PIN, (bf16_t*)(ws + WS_WIN), D, 0, 0, r); continue; } r -= J0;
            if (r < J1) { transpose_tile(p.in[16], 512, D, (bf16_t*)(ws + WS_WSB), 512, 0, 0, r); continue; } r -= J1;
            if (r < J1) { transpose_tile(p.in[17], 512, D, (bf16_t*)(ws + WS_WRW), 512, 0, 0, r); continue; } r -= J1;
            if (r < J3) { transpose_tile(p.in[18], D, D, (bf16_t*)(ws + WS_WOUT), D, 0, 0, r); continue; } r -= J3;
            if (r < J4) { transpose_tile(p.in[21], D, DFF, (bf16_t*)(ws + WS_WGU), D, 0, 1, r); continue; } r -= J4;
            if (r < J4) { transpose_tile(p.in[22], D, DFF, (bf16_t*)(ws + WS_WGU), D, 0, 2, r); continue; } r -= J4;
            if (r < J6) { transpose_tile(p.in[23], DFF, D, (bf16_t*)(ws + WS_WD), DFF, 0, 0, r); continue; } r -= J6;
            if (r < J7) { transpose_tile(p.in[6], 64, 512, (bf16_t*)(ws + WS_WL), 256, 0, 0, r); continue; } r -= J7;
            if (r < J7) { transpose_tile(p.in[8], 64, 512, (bf16_t*)(ws + WS_WL), 256, 64, 0, r); continue; } r -= J7;
            transpose_tile(p.in[10], 128, 512, (bf16_t*)(ws + WS_WL), 256, 128, 0, r);
        } else {
            const int lane = threadIdx.x & 63, row0 = it * 32 + (threadIdx.x >> 6) * 4;
            f32x4 v[4][4];
#pragma unroll
            for (int r = 0; r < 4; ++r) {
                const int row = row0 + r, b = row / TP, t = row - b * TP;
                const float* src = t < NMETA ? p.in[1] + (size_t)t * D : p.in[0] + ((size_t)b * SEQ + (t < T ? t - NMETA : 0)) * D;
#pragma unroll
                for (int j = 0; j < 4; ++j) v[r][j] = *(const f32x4*)(src + 4 * lane + 256 * j);
            }
            f32x4 g[4];
#pragma unroll
            for (int j = 0; j < 4; ++j) g[j] = *(const f32x4*)(p.in[2] + 4 * lane + 256 * j);
#pragma unroll
            for (int r = 0; r < 4; ++r) {
                const int row = row0 + r, b = row / TP, t = row - b * TP;
                float ss = 0.f;
#pragma unroll
                for (int j = 0; j < 4; ++j) ss += (v[r][j][0] * v[r][j][0] + v[r][j][1] * v[r][j][1]) + (v[r][j][2] * v[r][j][2] + v[r][j][3] * v[r][j][3]);
                const float rs = t < T ? rsqrtf(wave_sum(ss) * (1.0f / D) + RMS_EPS) : 0.f;
                bf16_t* orow = (bf16_t*)(ws + O_A0) + (size_t)row * D;
#pragma unroll
                for (int j = 0; j < 4; ++j) {
                    u32x2 w; w.x = pk_bf16(v[r][j][0] * rs * g[j][0], v[r][j][1] * rs * g[j][1]); w.y = pk_bf16(v[r][j][2] * rs * g[j][2], v[r][j][3] * rs * g[j][3]);
                    *(u32x2*)(orow + 4 * lane + 256 * j) = w;
                }
            }
        }
    }
}

__device__ __forceinline__ void phase1(const Params& p) {
    unsigned char* ws = p.ws;
    EpiInProj<false> epi{(bf16_t*)(ws + R_QKV), (_Float16*)(ws + R_URW), (bf16_t*)p.out};
    gemm_phase((const bf16_t*)(ws + O_A0), (const bf16_t*)(ws + WS_WIN), D, MP / BM, 7, epi, (int)gridDim.x, (int)blockIdx.x, 0, 6);
}

constexpr int SI_R = 0, SI_W = 1, SI_K = 2, SI_V = 3, SI_KK = 4, SI_B = 5;
constexpr int ALD = 264;
constexpr int P2_WLS = 64 * ALD * 2;
constexpr int P2_MU = P2_WLS;
constexpr int P2_AL = P2_MU + 1024;
__device__ __forceinline__ void phase2_main(const Params& p) {
    unsigned char* ws = p.ws;
    const int tid = threadIdx.x, wave = tid >> 6, lane = tid & 63, fr = lane & 15, fq = lane >> 4;
    const int h = blockIdx.x & 7, nslot = (gridDim.x >> 3) * 8, slot = (blockIdx.x >> 3) * 8 + wave;
    const _Float16* urw = (const _Float16*)(ws + R_URW);
    const float* mu = p.in[5];
    bf16_t* WLs = (bf16_t*)smem;
    float* mus = (float*)(smem + P2_MU);
    bf16_t* Al = (bf16_t*)(smem + P2_AL) + wave * (16 * ALD);
    __syncthreads();
    {
        const bf16_t* WL = (const bf16_t*)(ws + WS_WL) + (size_t)h * 64 * 256;
#pragma unroll
        for (int i = 0; i < 4; ++i) { const int idx = tid + 512 * i, row = idx >> 5, c16 = idx & 31; *(u32x4*)(WLs + row * ALD + c16 * 8) = *(const u32x4*)(WL + row * 256 + c16 * 8); }
        if (tid < 256) mus[tid] = mu[1536 + tid];
    }
    __syncthreads();
    if (blockIdx.x >= nslot) return;
    _Float16* SI = (_Float16*)(ws + R_SI);
    bf16_t* G = (bf16_t*)(ws + R_G);
    constexpr size_t SIE = (size_t)MP * 512;
#pragma unroll 1
    for (int g = slot; g < NB * 514; g += nslot) {
        const int ub = g / 514, ui = g - ub * 514, row0 = ub * TP + ui * 16;
        {
            const int half = lane >> 5, pc = (lane & 31) * 8;
            const float sA = pc < 64 ? 2.f : 1.f, sC = pc < 64 ? -1.f : 0.f;
            const bool lin = pc >= 64 && pc < 128;
            const f32x4 mA = *(const f32x4*)(mu + 1536 + pc), mB = *(const f32x4*)(mu + 1536 + pc + 4);
            h16x8 c[8], pv[8];
#pragma unroll
            for (int q = 0; q < 8; ++q) {
                const int rowa = row0 + 2 * q + half, ta = rowa % TP;
                const _Float16* cur = urw + (size_t)rowa * RWS + 1536 + pc;
                c[q] = *(const h16x8*)cur;
                pv[q] = *(const h16x8*)(ta > 0 ? cur - RWS : cur);
            }
#pragma unroll
            for (int q = 0; q < 8; ++q) {
                const int ta = (row0 + 2 * q + half) % TP;
                float o[8];
#pragma unroll
                for (int e = 0; e < 8; ++e) {
                    const float cf = (float)c[q][e], pf = ta > 0 ? (float)pv[q][e] : 0.f;
                    const float xs = cf + (e < 4 ? mA[e & 3] : mB[e & 3]) * (pf - cf);
                    const float sg = __builtin_amdgcn_rcpf(1.0f + __expf(-sA * xs));
                    o[e] = lin ? xs : sA * sg + sC;
                }
                u32x4 w; w.x = pk_bf16(o[0], o[1]); w.y = pk_bf16(o[2], o[3]); w.z = pk_bf16(o[4], o[5]); w.w = pk_bf16(o[6], o[7]);
                *(u32x4*)(Al + (2 * q + half) * ALD + pc) = w;
            }
        }
        asm volatile("s_waitcnt lgkmcnt(0)" ::: "memory");
        __builtin_amdgcn_wave_barrier();
        f32x4 acc[4];
        auto lora = [&](auto kbeg_c, auto ksteps_c) {
            constexpr int kbeg = decltype(kbeg_c)::value, ksteps = decltype(ksteps_c)::value;
#pragma unroll
            for (int n = 0; n < 4; ++n) acc[n] = (f32x4){0.f, 0.f, 0.f, 0.f};
#pragma unroll
            for (int ks = 0; ks < ksteps; ++ks) {
                const bf16x8 af = *(const bf16x8*)(Al + fr * ALD + kbeg + ks * 32 + fq * 8);
#pragma unroll
                for (int n = 0; n < 4; ++n) {
                    const bf16x8 wf = *(const bf16x8*)(WLs + (n * 16 + fr) * ALD + kbeg + ks * 32 + fq * 8);
                    acc[n] = __builtin_amdgcn_mfma_f32_16x16x32_bf16(wf, af, acc[n], 0, 0, 0);
                }
            }
        };
        const int row = row0 + fr, b = row / TP, t = row - b * TP;
        const size_t base = ((size_t)(b * NH + h) * TP + t) * 64;
        const _Float16* ur = urw + (size_t)row * RWS;
        const size_t pb = base + fq * 16;
        lora(std::integral_constant<int, 0>{}, std::integral_constant<int, 2>{});
        {
            h16x8 wo[2];
#pragma unroll
            for (int n = 0; n < 4; ++n) {
                const f32x4 db = *(const f32x4*)(p.in[7] + h * 64 + n * 16 + fq * 4);
#pragma unroll
                for (int j = 0; j < 4; ++j) {
                    const float wl = -softplusf_(-(db[j] + acc[n][j])) - 0.5f;
                    const float e = __expf(wl);
                    wo[n >> 1][(n & 1) * 4 + j] = (_Float16)(1.0f - __expf(-e));
                }
            }
            *(h16x8*)(SI + SI_W * SIE + pb) = wo[0]; *(h16x8*)(SI + SI_W * SIE + pb + 8) = wo[1];
        }
        lora(std::integral_constant<int, 64>{}, std::integral_constant<int, 2>{});
        {
            const _Float16* up = ur + h * 64 + fq * 16;
            const _Float16* upp = t > 0 ? up - RWS : up;
            h16x8 kc[2], rc[2], vc[2], kp[2], rp[2], vp[2];
#pragma unroll
            for (int i = 0; i < 2; ++i) {
                rc[i] = *(const h16x8*)(up + i * 8); kc[i] = *(const h16x8*)(up + 512 + i * 8); vc[i] = *(const h16x8*)(up + 1024 + i * 8);
                rp[i] = *(const h16x8*)(upp + i * 8); kp[i] = *(const h16x8*)(upp + 512 + i * 8); vp[i] = *(const h16x8*)(upp + 1024 + i * 8);
            }
            float kv[4][4], av[4][4], kkr[4][4]; float ss = 0.f;
            h16x8 ro[2];
#pragma unroll
            for (int n = 0; n < 4; ++n) {
                const int c = n * 16 + fq * 4, c512 = h * 64 + c;
                const f32x4 muk = *(const f32x4*)(mu + 512 + c512), mur = *(const f32x4*)(mu + c512), muv = *(const f32x4*)(mu + 1024 + c512);
                const f32x4 ab = *(const f32x4*)(p.in[9] + c512), kkw = *(const f32x4*)(p.in[11] + c512);
                h16x4 vo;
#pragma unroll
                for (int j = 0; j < 4; ++j) {
                    const int i = n >> 1, e = (n & 1) * 4 + j;
                    const float kcf = (float)kc[i][e], kpf = t > 0 ? (float)kp[i][e] : 0.f;
                    const float rcf = (float)rc[i][e], rpf = t > 0 ? (float)rp[i][e] : 0.f;
                    const float vcf = (float)vc[i][e], vpf = t > 0 ? (float)vp[i][e] : 0.f;
                    kv[n][j] = kcf + muk[j] * (kpf - kcf);
                    ro[i][e] = (_Float16)(rcf + mur[j] * (rpf - rcf));
                    vo[j] = (_Float16)(vcf + muv[j] * (vpf - vcf));
                    av[n][j] = sigmoidf_(ab[j] + acc[n][j]);
                    kkr[n][j] = kv[n][j] * kkw[j];
                    ss += kkr[n][j] * kkr[n][j];
                }
                *(h16x4*)(SI + SI_V * SIE + base + c) = vo;
            }
            *(h16x8*)(SI + SI_R * SIE + pb) = ro[0]; *(h16x8*)(SI + SI_R * SIE + pb + 8) = ro[1];
            ss += __shfl_xor(ss, 16); ss += __shfl_xor(ss, 32);
            const float inv = fminf(__builtin_amdgcn_rsqf(ss), 1e12f);
            h16x8 ko[2], kko[2], bo[2];
#pragma unroll
            for (int n = 0; n < 4; ++n) {
                const f32x4 ka = *(const f32x4*)(p.in[12] + h * 64 + n * 16 + fq * 4);
#pragma unroll
                for (int j = 0; j < 4; ++j) {
                    const int i = n >> 1, e = (n & 1) * 4 + j;
                    const float kk = kkr[n][j] * inv;
                    ko[i][e] = (_Float16)(kv[n][j] * (1.0f + (av[n][j] - 1.0f) * ka[j]));
                    kko[i][e] = (_Float16)kk;
                    bo[i][e] = (_Float16)(kk * av[n][j]);
                }
            }
#pragma unroll
            for (int i = 0; i < 2; ++i) {
                *(h16x8*)(SI + SI_K * SIE + pb + i * 8) = ko[i]; *(h16x8*)(SI + SI_KK * SIE + pb + i * 8) = kko[i]; *(h16x8*)(SI + SI_B * SIE + pb + i * 8) = bo[i];
            }
        }
        lora(std::integral_constant<int, 128>{}, std::integral_constant<int, 4>{});
        {
            u32x4 g0, g1;
            g0.x = pk_bf16(acc[0][0], acc[0][1]); g0.y = pk_bf16(acc[0][2], acc[0][3]); g0.z = pk_bf16(acc[1][0], acc[1][1]); g0.w = pk_bf16(acc[1][2], acc[1][3]);
            g1.x = pk_bf16(acc[2][0], acc[2][1]); g1.y = pk_bf16(acc[2][2], acc[2][3]); g1.z = pk_bf16(acc[3][0], acc[3][1]); g1.w = pk_bf16(acc[3][2], acc[3][3]);
            *(u32x4*)(G + pb) = g0; *(u32x4*)(G + pb + 8) = g1;
        }
        asm volatile("s_waitcnt lgkmcnt(0)" ::: "memory");
        __builtin_amdgcn_wave_barrier();
    }
}
__device__ __forceinline__ void phase2_kmax(const Params& p, int item) {
    unsigned char* ws = p.ws;
    const int bh = item >> 2, qr = item & 3, tid = threadIdx.x;
    float* red = (float*)(smem + P2_AL + 8 * 16 * ALD * 2);
    float ss = 0.f;
    for (int t = qr * 2052 + tid; t < (qr + 1) * 2052; t += 512) {
        const bf16_t* kr = (const bf16_t*)(ws + R_QKV) + QKV_ONE / 2 + ((size_t)bh * TP + t) * 64;
        float s1 = 0.f;
#pragma unroll
        for (int q = 0; q < 8; ++q) {
            const u32x4 v = *(const u32x4*)(kr + q * 8);
#pragma unroll
            for (int e = 0; e < 4; ++e) { const float lo = __uint_as_float(v[e] << 16), hi = __uint_as_float(v[e] & 0xffff0000u); s1 += lo * lo + hi * hi; }
        }
        ss = fmaxf(ss, s1);
    }
#pragma unroll
    for (int o = 1; o < 64; o <<= 1) ss = fmaxf(ss, __shfl_xor(ss, o));
    __syncthreads();
    if ((tid & 63) == 0) red[tid >> 6] = ss;
    __syncthreads();
    if (tid == 0) {
        float m = red[0];
#pragma unroll
        for (int w = 1; w < 8; ++w) m = fmaxf(m, red[w]);
        ((float*)(ws + WS_CTL))[16 + item] = m;
    }
}
__device__ __forceinline__ void phase2(const Params& p) {
    phase2_main(p);
}

constexpr int SC_TC = 32, SC_NC = (T + SC_TC - 1) / SC_TC;
constexpr int SC_ARR = SC_TC * 64;
constexpr int SC_VOFF = 5 * SC_ARR, SC_COFF = SC_VOFF + SC_TC * 16;
constexpr int SC_BUF = (SC_COFF + SC_TC) * 4;
constexpr int SC_YOFF = 2 * SC_BUF, SC_YBUF = SC_TC * 16 * 4;
__device__ __forceinline__ float dot4(const f32x4& a, const f32x4& b) {
    f32x2 t = __builtin_shufflevector(a, a, 0, 1) * __builtin_shufflevector(b, b, 0, 1);
    t = __builtin_shufflevector(a, a, 2, 3) * __builtin_shufflevector(b, b, 2, 3) + t;
    return t[0] + t[1];
}
__device__ __forceinline__ void reduce16x2(float& a, float& b) {
    a += dppf<0xB1>(a); b += dppf<0xB1>(b); a += dppf<0x4E>(a); b += dppf<0x4E>(b);
    a += dppf<0x141>(a); b += dppf<0x141>(b); a += dppf<0x140>(a); b += dppf<0x140>(b);
}
__device__ __forceinline__ void scan_unit(const Params& p, int unit) {
    unsigned char* ws = p.ws;
    const int bh = unit >> 2, vr0 = (unit & 3) * 16, tid = threadIdx.x, wave = tid >> 6, lane = tid & 63;
    const _Float16* SI = (const _Float16*)(ws + R_SI);
    constexpr size_t SIE = (size_t)MP * 512;
    bf16_t* Y = (bf16_t*)(ws + O_Y);
    const size_t hb = (size_t)bh * TP * 64;
    __syncthreads();
    if (wave >= 4) {
        const int i = tid - 256, ip = i >= 8 ? i - 8 : i;
        const int arrs[5] = {SI_R, SI_W, SI_K, SI_KK, SI_B};
        u32x4 rg[5], rp[3]; unsigned rv;
        auto issue = [&](int c) {
            const size_t off = hb + (size_t)c * SC_TC * 64;
#pragma unroll
            for (int a = 0; a < 5; ++a) rg[a] = *(const u32x4*)(SI + arrs[a] * SIE + off + i * 8);
            rp[0] = *(const u32x4*)(SI + SI_W * SIE + off + ip * 8);
            rp[1] = *(const u32x4*)(SI + SI_K * SIE + off + ip * 8);
            rp[2] = *(const u32x4*)(SI + SI_B * SIE + off + ip * 8);
            rv = *(const unsigned*)(SI + SI_V * SIE + off + (i >> 3) * 64 + vr0 + (i & 7) * 2);
        };
        auto commit = [&](int bufi) {
            float* buf = (float*)(smem + bufi * SC_BUF);
            float f[5][8];
#pragma unroll
            for (int a = 0; a < 5; ++a) {
                const h16x8 hv = __builtin_bit_cast(h16x8, rg[a]);
#pragma unroll
                for (int e = 0; e < 8; ++e) f[a][e] = (float)hv[e];
            }
            const bool odd = (i >> 3) & 1;
            float ckk = 0.f, cbk = 0.f;
            {
                const h16x8 pw = __builtin_bit_cast(h16x8, rp[0]), pk = __builtin_bit_cast(h16x8, rp[1]), pb = __builtin_bit_cast(h16x8, rp[2]);
#pragma unroll
                for (int e = 0; e < 8; ++e) {
                    const float kk2 = f[3][e];
                    ckk += (float)pk[e] * kk2; cbk += (float)pb[e] * kk2;
                    if (odd) f[3][e] = (1.0f - (float)pw[e]) * kk2;
                }
            }
            ckk += dppf<0xB1>(ckk); cbk += dppf<0xB1>(cbk); ckk += dppf<0x4E>(ckk); cbk += dppf<0x4E>(cbk); ckk += dppf<0x141>(ckk); cbk += dppf<0x141>(cbk);
#pragma unroll
            for (int a = 0; a < 5; ++a) {
                f32x4 lo, hi;
#pragma unroll
                for (int e = 0; e < 4; ++e) { lo[e] = f[a][e]; hi[e] = f[a][4 + e]; }
                if (a == 1) { lo = 1.0f - lo; hi = 1.0f - hi; }
                if (a == 4) { lo = -lo; hi = -hi; }
                *(f32x4*)(buf + a * SC_ARR + i * 8) = lo; *(f32x4*)(buf + a * SC_ARR + i * 8 + 4) = hi;
            }
            const h16x2 v2 = __builtin_bit_cast(h16x2, rv);
            f32x2 vf; vf[0] = (float)v2[0]; vf[1] = (float)v2[1];
            *(f32x2*)(buf + SC_VOFF + (i >> 3) * 16 + (i & 7) * 2) = vf;
            if (odd && (i & 7) == 0) { f32x2 cf; cf[0] = ckk; cf[1] = cbk; *(f32x2*)(buf + SC_COFF + (i >> 4) * 2) = cf; }
        };
        auto yout = [&](int c) {
            const float* yb = (const float*)(smem + SC_YOFF + (c & 1) * SC_YBUF);
            const f32x2 v = *(const f32x2*)(yb + (i >> 3) * 16 + (i & 7) * 2);
            *(unsigned*)(Y + hb + (size_t)(c * SC_TC + (i >> 3)) * 64 + vr0 + (i & 7) * 2) = pk_bf16(v[0], v[1]);
        };
        issue(0); commit(0); issue(1);
        __syncthreads();
        for (int c = 0; c < SC_NC; ++c) {
            if (c > 0) yout(c - 1);
            if (c + 1 < SC_NC) commit((c + 1) & 1);
            if (c + 2 < SC_NC) issue(c + 2);
            __syncthreads();
        }
        yout(SC_NC - 1);
    } else {
        const int rl = wave * 4 + (lane >> 4), sub = lane & 15;
        const bool odd_lane = lane & 1; const int yoff = (lane & 1) * 16 + rl;
        f32x4 S = {0.f, 0.f, 0.f, 0.f};
        __builtin_amdgcn_s_setprio(3);
        __syncthreads();
        for (int c = 0; c < SC_NC; ++c) {
            const float* buf = (const float*)(smem + (c & 1) * SC_BUF);
            float* yb = (float*)(smem + SC_YOFF + (c & 1) * SC_YBUF);
            const float* bp = buf + sub * 4;
#define SC_LD(arr, s) (*(const f32x4*)(bp + (arr) * SC_ARR + (s) * 64))
            f32x4 r1 = SC_LD(0, 0), w1 = SC_LD(1, 0), k1 = SC_LD(2, 0), q1 = SC_LD(3, 0), n1 = SC_LD(4, 0);
            f32x4 r2 = SC_LD(0, 1), w2 = SC_LD(1, 1), k2 = SC_LD(2, 1), g2 = SC_LD(3, 1), n2 = SC_LD(4, 1);
            float v1 = buf[SC_VOFF + rl], v2 = buf[SC_VOFF + 16 + rl];
            f32x2 cf = *(const f32x2*)(buf + SC_COFF);
#pragma unroll
            for (int pr = 0; pr < SC_TC / 2; ++pr) {
                const int sn = 2 * pr + 2;
                const f32x4 r1n = SC_LD(0, sn), w1n = SC_LD(1, sn), k1n = SC_LD(2, sn), q1n = SC_LD(3, sn), n1n = SC_LD(4, sn);
                const f32x4 r2n = SC_LD(0, sn + 1), w2n = SC_LD(1, sn + 1), k2n = SC_LD(2, sn + 1), g2n = SC_LD(3, sn + 1), n2n = SC_LD(4, sn + 1);
                const float v1n = buf[SC_VOFF + sn * 16 + rl], v2n = buf[SC_VOFF + (sn + 1) * 16 + rl];
                const f32x2 cfn = *(const f32x2*)(buf + SC_COFF + (pr + 1) * 2);
                __builtin_amdgcn_sched_barrier(0x7);
                float d1 = dot4(S, q1), e2 = dot4(S, g2);
                const f32x4 t1 = S * w1 + v1 * k1;
                reduce16x2(d1, e2);
                const float d2 = e2 + v1 * cf[0] - d1 * cf[1];
                const f32x4 S1 = t1 + d1 * n1;
                const f32x4 S2 = (S1 * w2 + v2 * k2) + d2 * n2;
                float y1 = dot4(S1, r1), y2 = dot4(S2, r2);
                y1 += dppf<0xB1>(y1); y2 += dppf<0xB1>(y2);
                float yz = odd_lane ? y2 : y1;
                yz += dppf<0x122>(yz); yz += dppf<0x124>(yz); yz += dppf<0x128>(yz);
                yb[(2 * pr) * 16 + yoff] = yz;
                S = S2;
                r1 = r1n; w1 = w1n; k1 = k1n; q1 = q1n; n1 = n1n; r2 = r2n; w2 = w2n; k2 = k2n; g2 = g2n; n2 = n2n; v1 = v1n; v2 = v2n; cf = cfn;
            }
#undef SC_LD
            __syncthreads();
        }
        __builtin_amdgcn_s_setprio(0);
    }
}

constexpr int KLD = 72;
__device__ __forceinline__ void attn_unit(const Params& p, int unit) {
    unsigned char* ws = p.ws;
    const int qt = unit % 65, bh = unit / 65, b = bh >> 3, h = bh & 7;
    const int tid = threadIdx.x, wave = tid >> 6, lane = tid & 63, fr = lane & 15, fq = lane >> 4;
    const bf16_t* Q = (const bf16_t*)(ws + R_QKV) + (size_t)bh * TP * 64;
    const bf16_t* Kg = Q + QKV_ONE / 2;
    const bf16_t* Vg = Q + QKV_ONE;
    bf16_t* slots = (bf16_t*)smem;
    constexpr int SLOT = 2 * 64 * KLD;
    volatile int* flags = (volatile int*)(smem + 2 * SLOT * 2);
    const int t0 = qt * 128, tq = t0 + wave * 16 + fr;
    bf16x8 qf[2];
    qf[0] = *(const bf16x8*)(Q + (size_t)tq * 64 + fq * 8);
    qf[1] = *(const bf16x8*)(Q + (size_t)tq * 64 + 32 + fq * 8);
    float qs = 0.f;
#pragma unroll
    for (int s = 0; s < 2; ++s)
#pragma unroll
        for (int e = 0; e < 8; ++e) { const float f = bf2f((unsigned short)qf[s][e]); qs += f * f; }
    qs += __shfl_xor(qs, 16); qs += __shfl_xor(qs, 32);
    const f32x4 km4 = *(const f32x4*)((const float*)(ws + WS_CTL) + 16 + bh * 4);
    const float kmax = sqrtf(fmaxf(fmaxf(km4[0], km4[1]), fmaxf(km4[2], km4[3])));
    const float zb = sqrtf(qs) * kmax * 1.0001f + 88.0f;
    float Arow = 0.f;
    f32x4 O[4];
#pragma unroll
    for (int nd = 0; nd < 4; ++nd) O[nd] = (f32x4){0.f, 0.f, 0.f, 0.f};
    const int key = tid >> 3, dc = (tid & 7) * 8, half = wave >> 2;
    auto tile_store = [&](int blk, const u32x4& kv, const u32x4& vv) {
        bf16_t* Ks_ = slots + (blk & 1) * SLOT; bf16_t* Vt_ = Ks_ + 64 * KLD;
        *(u32x4*)(Ks_ + key * KLD + dc) = kv;
#pragma unroll
        for (int e = 0; e < 4; ++e) { Vt_[(dc + 2 * e) * KLD + key] = (bf16_t)(vv[e] & 0xffffu); Vt_[(dc + 2 * e + 1) * KLD + key] = (bf16_t)(vv[e] >> 16); }
    };
    const int ktop = qt * 2 + 1;
    {
        const u32x4 k0 = *(const u32x4*)(Kg + (size_t)(ktop * 64 + key) * 64 + dc), v0 = *(const u32x4*)(Vg + (size_t)(ktop * 64 + key) * 64 + dc);
        __syncthreads();
        tile_store(ktop, k0, v0);
    }
    u32x4 kvv = *(const u32x4*)(Kg + (size_t)((ktop - 1) * 64 + key) * 64 + dc);
    u32x4 vvv = *(const u32x4*)(Vg + (size_t)((ktop - 1) * 64 + key) * 64 + dc);
    for (int kt = ktop; kt >= 0; --kt) {
        const int kb = kt - 1 + half;
        const bool done = __all(Arow > zb) || kb < 0;
        if (lane == 0) flags[wave] = done ? 1 : 0;
        __syncthreads();
        int alld = 1;
#pragma unroll
        for (int w = 0; w < 8; ++w) alld &= flags[w];
        if (alld) break;
        if (kt >= 1) {
            tile_store(kt - 1, kvv, vvv);
            if (kt >= 2) {
                kvv = *(const u32x4*)(Kg + (size_t)((kt - 2) * 64 + key) * 64 + dc);
                vvv = *(const u32x4*)(Vg + (size_t)((kt - 2) * 64 + key) * 64 + dc);
            }
        }
        asm volatile("s_waitcnt lgkmcnt(0)" ::: "memory");
        __builtin_amdgcn_s_barrier();
        if (kb < 0) continue;
        const bf16_t* Ks = slots + (kb & 1) * SLOT; const bf16_t* Vt = Ks + 64 * KLD;
        f32x4 z[4];
#pragma unroll
        for (int n = 0; n < 4; ++n) {
            z[n] = (f32x4){0.f, 0.f, 0.f, 0.f};
#pragma unroll
            for (int s = 0; s < 2; ++s) {
                const bf16x8 kf = *(const bf16x8*)(Ks + (n * 16 + fr) * KLD + s * 32 + fq * 8);
                z[n] = __builtin_amdgcn_mfma_f32_16x16x32_bf16(kf, qf[s], z[n], 0, 0, 0);
            }
        }
        float sp[4][4], lt[4], ex[4], sg[4];
#pragma unroll
        for (int n = 0; n < 4; ++n) {
#pragma unroll
            for (int j = 0; j < 4; ++j) { const int s = kb * 64 + n * 16 + fq * 4 + j; sp[n][j] = s < tq ? softplusf_(z[n][j]) : 0.f; }
            sp[n][2] += sp[n][3]; sp[n][1] += sp[n][2]; sp[n][0] += sp[n][1];
            lt[n] = sp[n][0];
            const float a = __shfl_xor(lt[n], 16), pr = lt[n] + a, c = __shfl_xor(pr, 32);
            ex[n] = fq == 3 ? 0.f : (fq == 2 ? a : (fq == 1 ? c : a + c));
            sg[n] = pr + c;
        }
        float nsuf[4]; nsuf[3] = 0.f; nsuf[2] = sg[3]; nsuf[1] = nsuf[2] + sg[2]; nsuf[0] = nsuf[1] + sg[1];
        float wgt[4][4];
#pragma unroll
        for (int n = 0; n < 4; ++n)
#pragma unroll
            for (int j = 0; j < 4; ++j) {
                const int s = kb * 64 + n * 16 + fq * 4 + j;
                const float C = Arow + nsuf[n] + ex[n] + sp[n][j];
                wgt[n][j] = s < tq ? __expf(z[n][j] - C) : 0.f;
            }
        Arow += nsuf[0] + sg[0];
#pragma unroll
        for (int ks = 0; ks < 2; ++ks) {
            u32x4 pw; pw.x = pk_bf16(wgt[2 * ks][0], wgt[2 * ks][1]); pw.y = pk_bf16(wgt[2 * ks][2], wgt[2 * ks][3]);
            pw.z = pk_bf16(wgt[2 * ks + 1][0], wgt[2 * ks + 1][1]); pw.w = pk_bf16(wgt[2 * ks + 1][2], wgt[2 * ks + 1][3]);
            const bf16x8 pf = __builtin_bit_cast(bf16x8, pw);
#pragma unroll
            for (int nd = 0; nd < 4; ++nd) {
                u32x4 vw;
                const u32x2 v0 = *(const u32x2*)(Vt + (nd * 16 + fr) * KLD + (2 * ks) * 16 + fq * 4);
                const u32x2 v1 = *(const u32x2*)(Vt + (nd * 16 + fr) * KLD + (2 * ks + 1) * 16 + fq * 4);
                vw.x = v0.x; vw.y = v0.y; vw.z = v1.x; vw.w = v1.y;
                O[nd] = __builtin_amdgcn_mfma_f32_16x16x32_bf16(pf, __builtin_bit_cast(bf16x8, vw), O[nd], 0, 0, 0);
            }
        }
    }
    __syncthreads();
    bf16_t* Ot = (bf16_t*)smem;
#pragma unroll
    for (int j = 0; j < 4; ++j)
#pragma unroll
        for (int nd = 0; nd < 4; ++nd) Ot[(wave * 16 + fq * 4 + j) * KLD + nd * 16 + fr] = (bf16_t)(pk_bf16(O[nd][j], 0.f) & 0xffffu);
    __syncthreads();
    bf16_t* osb = (bf16_t*)(ws + O_OSB);
#pragma unroll
    for (int i = 0; i < 2; ++i) {
        const int idx = tid + 512 * i, r = idx >> 3, pc8 = (idx & 7) * 8, t = t0 + r;
        if (t >= NMETA && t < T) *(u32x4*)(osb + (size_t)(b * SEQ + t - NMETA) * 512 + h * 64 + pc8) = *(const u32x4*)(Ot + r * KLD + pc8);
    }
}

constexpr int N_SCAN = 128, N_ATTN = 32 * 65;
__device__ __forceinline__ void sub_barrier(unsigned* ctr, unsigned target, bool arrive) {
    asm volatile("s_waitcnt vmcnt(0)" ::: "memory");
    __syncthreads();
    if (threadIdx.x == 0) {
        if (arrive) { __builtin_amdgcn_fence(__ATOMIC_RELEASE, "agent"); asm volatile("s_waitcnt vmcnt(0)" ::: "memory"); (void)xb_add(ctr, 1u); }
        unsigned sp = 0u;
        while (xb_ld(ctr) < target) { __builtin_amdgcn_s_sleep(2); if (++sp > (1u << 22)) break; }
        __builtin_amdgcn_fence(__ATOMIC_ACQUIRE, "agent");
        asm volatile("s_waitcnt vmcnt(0)" ::: "memory");
    }
    __syncthreads();
}
__device__ __forceinline__ void phase3(const Params& p) {
    unsigned char* ws = p.ws;
    unsigned* ctl = (unsigned*)(ws + WS_CTL);
    const int nother = (int)gridDim.x - N_SCAN;
    if ((int)blockIdx.x < N_SCAN) {
        scan_unit(p, blockIdx.x);
    } else {
        EpiInProj<true> epi{(bf16_t*)(ws + R_QKV), (_Float16*)(ws + R_URW), (bf16_t*)p.out};
        gemm_phase((const bf16_t*)(ws + O_A0), (const bf16_t*)(ws + WS_WIN), D, MP / BM, 14, epi, nother, (int)blockIdx.x - N_SCAN, 6, 7);
        sub_barrier(ctl + 256, (unsigned)nother, true);
        for (int it = (int)blockIdx.x - N_SCAN; it < 128; it += nother) phase2_kmax(p, it);
        sub_barrier(ctl + 320, (unsigned)nother, true);
    }
    sub_barrier(ctl + 320, (unsigned)nother, false);
    volatile int* slot = (volatile int*)(smem + 131072 - 16);
    for (;;) {
        __syncthreads();
        if (threadIdx.x == 0) *slot = (int)atomicAdd(ctl, 1u);
        __syncthreads();
        const int u = *slot;
        if (u >= N_ATTN) break;
        attn_unit(p, u);
    }
}

__device__ __forceinline__ void phase3c(const Params& p) {
    unsigned char* ws = p.ws;
    const _Float16* SI = (const _Float16*)(ws + R_SI);
    constexpr size_t SIE = (size_t)MP * 512;
    const bf16_t* Y = (const bf16_t*)(ws + O_Y);
    const bf16_t* G = (const bf16_t*)(ws + R_G);
    bf16_t* orw = (bf16_t*)(ws + O_ORW);
    const int tid = threadIdx.x, sub = tid & 15;
    constexpr int U = 4;
    for (int it = blockIdx.x; it < 32 * 64; it += gridDim.x) {
        const int bh = it >> 6, c4 = it & 63, b = bh >> 3, h = bh & 7;
        const int c = h * 64 + sub * 4;
        const f32x4 gain = *(const f32x4*)(p.in[14] + c), bias = *(const f32x4*)(p.in[15] + c), rk = *(const f32x4*)(p.in[13] + c);
        u32x2 yb2[U]; f32x4 y[U]; h16x4 r4[U], k4[U], v4[U]; u32x2 g2[U];
#pragma unroll
        for (int u = 0; u < U; ++u) {
            const int t = NMETA + (c4 * U + u) * 32 + (tid >> 4);
            const size_t base = ((size_t)bh * TP + t) * 64 + sub * 4;
            const size_t pbase = ((size_t)bh * TP + t) * 64 + (sub & 3) * 16 + (sub >> 2) * 4;
            yb2[u] = *(const u32x2*)(Y + base);
            r4[u] = *(const h16x4*)(SI + SI_R * SIE + pbase); k4[u] = *(const h16x4*)(SI + SI_K * SIE + pbase); v4[u] = *(const h16x4*)(SI + SI_V * SIE + base);
            g2[u] = *(const u32x2*)(G + pbase);
        }
#pragma unroll
        for (int u = 0; u < U; ++u) {
            const int t = NMETA + (c4 * U + u) * 32 + (tid >> 4);
            y[u][0] = __uint_as_float(yb2[u].x << 16); y[u][1] = __uint_as_float(yb2[u].x & 0xffff0000u); y[u][2] = __uint_as_float(yb2[u].y << 16); y[u][3] = __uint_as_float(yb2[u].y & 0xffff0000u);
            const float mean = reduce16((y[u][0] + y[u][1]) + (y[u][2] + y[u][3])) * (1.0f / 64.0f);
            const f32x4 dy = y[u] - mean;
            const float var = reduce16((dy[0] * dy[0] + dy[1] * dy[1]) + (dy[2] * dy[2] + dy[3] * dy[3])) * (1.0f / 64.0f);
            const float rs = rsqrtf(var + GN_EPS);
            float bs = 0.f;
#pragma unroll
            for (int j = 0; j < 4; ++j) bs += (float)r4[u][j] * (float)k4[u][j] * rk[j];
            bs = reduce16(bs);
            const float gg[4] = {__uint_as_float(g2[u].x << 16), __uint_as_float(g2[u].x & 0xffff0000u), __uint_as_float(g2[u].y << 16), __uint_as_float(g2[u].y & 0xffff0000u)};
            float o[4];
#pragma unroll
            for (int j = 0; j < 4; ++j) o[j] = (dy[j] * rs * gain[j] + bias[j] + bs * (float)v4[u][j]) * gg[j];
            u32x2 w; w.x = pk_bf16(o[0], o[1]); w.y = pk_bf16(o[2], o[3]);
            *(u32x2*)(orw + (size_t)(b * SEQ + t - NMETA) * 512 + c) = w;
        }
    }
}

__device__ __forceinline__ void phase4(const Params& p) {
    unsigned char* ws = p.ws;
    EpiBranch1 e1{(bf16_t*)(ws + O_T1), (const bf16_t*)p.out};
    EpiBranch2 e2{(const bf16_t*)(ws + O_T1), (const bf16_t*)p.out, (bf16_t*)(ws + O_M)};
    gemm_phase((const bf16_t*)(ws + O_OSB), (const bf16_t*)(ws + WS_WSB), 512, MS / BM, D / BM, e1);
    gemm_phase((const bf16_t*)(ws + O_ORW), (const bf16_t*)(ws + WS_WRW), 512, MS / BM, D / BM, e2);
}
__device__ __forceinline__ void phase5(const Params& p) {
    unsigned char* ws = p.ws;
    EpiBf16 e{(bf16_t*)(ws + O_P)};
    gemm_phase((const bf16_t*)(ws + O_M), (const bf16_t*)(ws + WS_WOUT), D, MS / BM, D / BM, e);
}
__device__ __forceinline__ void phase6(const Params& p) {
    unsigned char* ws = p.ws;
    const int lane = threadIdx.x & 63;
    f32x4 g1[4], g2[4];
#pragma unroll
    for (int j = 0; j < 4; ++j) { g1[j] = *(const f32x4*)(p.in[3] + 4 * lane + 256 * j); g2[j] = *(const f32x4*)(p.in[19] + 4 * lane + 256 * j); }
    for (int it = blockIdx.x; it < MS / 16; it += gridDim.x) {
        const int row0 = it * 16 + (threadIdx.x >> 6) * 2;
        f32x4 v[2][4], x[2][4];
#pragma unroll
        for (int r = 0; r < 2; ++r)
#pragma unroll
            for (int j = 0; j < 4; ++j) {
                { const u32x2 pb2 = *(const u32x2*)((const bf16_t*)(ws + O_P) + (size_t)(row0 + r) * D + 4 * lane + 256 * j);
                  v[r][j] = (f32x4){__uint_as_float(pb2.x << 16), __uint_as_float(pb2.x & 0xffff0000u), __uint_as_float(pb2.y << 16), __uint_as_float(pb2.y & 0xffff0000u)}; }
                x[r][j] = *(const f32x4*)(p.in[0] + (size_t)(row0 + r) * D + 4 * lane + 256 * j);
            }
#pragma unroll
        for (int r = 0; r < 2; ++r) {
            const int row = row0 + r;
            float ss = 0.f;
#pragma unroll
            for (int j = 0; j < 4; ++j) ss += (v[r][j][0] * v[r][j][0] + v[r][j][1] * v[r][j][1]) + (v[r][j][2] * v[r][j][2] + v[r][j][3] * v[r][j][3]);
            const float rs = rsqrtf(wave_sum(ss) * (1.0f / D) + RMS_EPS);
            float s2 = 0.f;
#pragma unroll
            for (int j = 0; j < 4; ++j) {
                v[r][j] = x[r][j] + v[r][j] * rs * g1[j];
                *(f32x4*)(p.out + (size_t)row * D + 4 * lane + 256 * j) = v[r][j];
                s2 += (v[r][j][0] * v[r][j][0] + v[r][j][1] * v[r][j][1]) + (v[r][j][2] * v[r][j][2] + v[r][j][3] * v[r][j][3]);
            }
            const float rs2 = rsqrtf(wave_sum(s2) * (1.0f / D) + RMS_EPS);
            bf16_t* fr_ = (bf16_t*)(ws + O_F) + (size_t)row * D;
#pragma unroll
            for (int j = 0; j < 4; ++j) {
                u32x2 w; w.x = pk_bf16(v[r][j][0] * rs2 * g2[j][0], v[r][j][1] * rs2 * g2[j][1]); w.y = pk_bf16(v[r][j][2] * rs2 * g2[j][2], v[r][j][3] * rs2 * g2[j][3]);
                *(u32x2*)(fr_ + 4 * lane + 256 * j) = w;
            }
        }
    }
}
__device__ __forceinline__ void phase7(const Params& p) {
    unsigned char* ws = p.ws;
    EpiGU e{(bf16_t*)(ws + O_ACT)};
    gemm_phase((const bf16_t*)(ws + O_F), (const bf16_t*)(ws + WS_WGU), D, MS / BM, 2 * DFF / BM, e);
}
__device__ __forceinline__ void phase8(const Params& p) {
    unsigned char* ws = p.ws;
    EpiBf16 e{(bf16_t*)(ws + O_DN)};
    gemm_phase((const bf16_t*)(ws + O_ACT), (const bf16_t*)(ws + WS_WD), DFF, MS / BM, D / BM, e);
}
__device__ __forceinline__ void phase9(const Params& p) {
    unsigned char* ws = p.ws;
    const int lane = threadIdx.x & 63;
    f32x4 g[4];
#pragma unroll
    for (int j = 0; j < 4; ++j) g[j] = *(const f32x4*)(p.in[20] + 4 * lane + 256 * j);
    for (int it = blockIdx.x; it < MS / 16; it += gridDim.x) {
        const int row0 = it * 16 + (threadIdx.x >> 6) * 2;
        f32x4 v[2][4], h1[2][4];
#pragma unroll
        for (int r = 0; r < 2; ++r)
#pragma unroll
            for (int j = 0; j < 4; ++j) {
                { const u32x2 db2 = *(const u32x2*)((const bf16_t*)(ws + O_DN) + (size_t)(row0 + r) * D + 4 * lane + 256 * j);
                  v[r][j] = (f32x4){__uint_as_float(db2.x << 16), __uint_as_float(db2.x & 0xffff0000u), __uint_as_float(db2.y << 16), __uint_as_float(db2.y & 0xffff0000u)}; }
                h1[r][j] = *(const f32x4*)(p.out + (size_t)(row0 + r) * D + 4 * lane + 256 * j);
            }
#pragma unroll
        for (int r = 0; r < 2; ++r) {
            float ss = 0.f;
#pragma unroll
            for (int j = 0; j < 4; ++j) ss += (v[r][j][0] * v[r][j][0] + v[r][j][1] * v[r][j][1]) + (v[r][j][2] * v[r][j][2] + v[r][j][3] * v[r][j][3]);
            const float rs = rsqrtf(wave_sum(ss) * (1.0f / D) + RMS_EPS);
#pragma unroll
            for (int j = 0; j < 4; ++j) *(f32x4*)(p.out + (size_t)(row0 + r) * D + 4 * lane + 256 * j) = h1[r][j] + v[r][j] * rs * g[j];
        }
    }
}

constexpr int N_PHASES = 11;
__device__ __forceinline__ void run_phase(const Params& p, int ph) {
    switch (ph) {
        case 0: phase0(p); break;
        case 1: phase1(p); break;
        case 2: phase2(p); break;
        case 3: phase3(p); break;
        case 4: phase3c(p); break;
        case 5: phase4(p); break;
        case 6: phase5(p); break;
        case 7: phase6(p); break;
        case 8: phase7(p); break;
        case 9: phase8(p); break;
        default: phase9(p); break;
    }
}

#if MULTI_LAUNCH
template <int PH> __global__ void __launch_bounds__(512) fwd_phase(Params p) { run_phase(p, PH); }
#else
__global__ void __launch_bounds__(512) fwd_mega(Params p) {
    cg::grid_group grid = cg::this_grid();
    volatile LAS unsigned* st = (volatile LAS unsigned*)(smem + 131072);
    if (threadIdx.x == 0) { st[0] = 0u; st[1] = 0u; }
    __syncthreads();
    const XcdBarrier xb = xcd_barrier_post((unsigned*)(p.ws + WS_BAR), st);
    if (p.out == nullptr) grid.sync();
    phase0(p); xcd_barrier(xb); phase1(p); xcd_barrier(xb); phase2(p); xcd_barrier(xb); phase3(p); xcd_barrier(xb); phase3c(p); xcd_barrier(xb);
    phase4(p); xcd_barrier(xb); phase5(p); xcd_barrier(xb); phase6(p); xcd_barrier(xb); phase7(p); xcd_barrier(xb); phase8(p); xcd_barrier(xb); phase9(p);
}
#endif

extern "C" void kernel_launch(void* const* d_in, const int* in_sizes, int n_in, void* d_out, int out_size, void* d_ws, size_t ws_size, hipStream_t stream) {
    static int grid = 0;
    if (grid == 0) {
        if (n_in != 24 || out_size != MS * D || ws_size < WS_END) { fprintf(stderr, "kernel_launch: unexpected shapes (n_in %d out %d ws %zu need %zu)\n", n_in, out_size, ws_size, (size_t)WS_END); grid = -1; return; }
        int dev = 0, cus = 0, per_cu = 0;
        (void)hipGetDevice(&dev);
        (void)hipDeviceGetAttribute(&cus, hipDeviceAttributeMultiprocessorCount, dev);
#if MULTI_LAUNCH
        per_cu = 1;
#else
        (void)hipFuncSetAttribute((const void*)fwd_mega, hipFuncAttributeMaxDynamicSharedMemorySize, LDS_BYTES);
        (void)hipOccupancyMaxActiveBlocksPerMultiprocessor(&per_cu, (const void*)fwd_mega, 512, LDS_BYTES);
        if (per_cu < 1) { fprintf(stderr, "kernel_launch: occupancy query says %d blocks per CU\n", per_cu); per_cu = 1; }
        if (per_cu > 1) per_cu = 1;
#endif
        grid = cus * per_cu;
        if (grid <= N_SCAN) { fprintf(stderr, "kernel_launch: grid %d too small (needs more than %d workgroups)\n", grid, N_SCAN); grid = -1; return; }
    }
    if (grid < 0) return;
    Params p{};
    for (int i = 0; i < 24; ++i) p.in[i] = (const float*)d_in[i];
    p.out = (float*)d_out; p.ws = (unsigned char*)d_ws;
#if MULTI_LAUNCH
#define LP(PH) do { (void)hipFuncSetAttribute((const void*)fwd_phase<PH>, hipFuncAttributeMaxDynamicSharedMemorySize, LDS_BYTES); hipLaunchKernelGGL(fwd_phase<PH>, dim3(grid), dim3(512), LDS_BYTES, stream, p); } while (0)
    LP(0); LP(1); LP(2); LP(3); LP(4); LP(5); LP(6); LP(7); LP(8); LP(9); LP(10);
#undef LP
#else
    if (hipMemsetAsync(d_ws, 0, WS_CTL_BYTES, stream) != hipSuccess) { fprintf(stderr, "kernel_launch: hipMemsetAsync of the control words failed\n"); return; }
    void* args[] = {&p};
    hipError_t e = hipLaunchCooperativeKernel((const void*)fwd_mega, dim3(grid), dim3(512), args, LDS_BYTES, stream);
    if (e != hipSuccess) fprintf(stderr, "cooperative launch failed: %s (grid %d)\n", hipGetErrorString(e), grid);
#endif
}
```

```cpp
#include <hip/hip_runtime.h>
#include <hip/hip_cooperative_groups.h>
#include <cstdio>
#include <cstdint>
#include <type_traits>
namespace cg = cooperative_groups;

#ifndef MULTI_LAUNCH
#define MULTI_LAUNCH 0
#endif

typedef unsigned short bf16_t;
typedef short bf16x8 __attribute__((ext_vector_type(8)));
typedef float f32x4 __attribute__((ext_vector_type(4)));
typedef float f32x2 __attribute__((ext_vector_type(2)));
typedef unsigned u32x2 __attribute__((ext_vector_type(2)));
typedef unsigned u32x4 __attribute__((ext_vector_type(4)));
typedef _Float16 h16x2 __attribute__((ext_vector_type(2)));
typedef _Float16 h16x4 __attribute__((ext_vector_type(4)));
typedef _Float16 h16x8 __attribute__((ext_vector_type(8)));

constexpr int D = 1024, NB = 4, SEQ = 8192, NMETA = 16, T = SEQ + NMETA, TP = 8320, MP = NB * TP, MS = NB * SEQ;
constexpr int PIN = 5376, DFF = 2816, NH = 8, RWS = 1792;
constexpr float RMS_EPS = 1e-6f, GN_EPS = 64e-5f;

constexpr size_t WS_CTL = 0;
constexpr size_t WS_BAR = 4096;
constexpr size_t WS_CTL_BYTES = 32768;
constexpr size_t WS_WIN = WS_CTL_BYTES;
constexpr size_t WS_WSB = WS_WIN + (size_t)PIN * D * 2;
constexpr size_t WS_WRW = WS_WSB + (size_t)D * 512 * 2;
constexpr size_t WS_WOUT = WS_WRW + (size_t)D * 512 * 2;
constexpr size_t WS_WGU = WS_WOUT + (size_t)D * D * 2;
constexpr size_t WS_WD = WS_WGU + (size_t)2 * DFF * D * 2;
constexpr size_t WS_WL = WS_WD + (size_t)D * DFF * 2;
constexpr size_t R_A0 = WS_WL + (size_t)512 * 256 * 2;
constexpr size_t R_URW = R_A0 + (size_t)MP * D * 2;
constexpr size_t R_QKV = R_URW;
constexpr size_t QKV_ONE = (size_t)MP * 512 * 2;
constexpr size_t R_SI = R_URW + (size_t)MP * RWS * 2;
constexpr size_t SI_ONE = (size_t)MP * 512 * 2;
constexpr size_t R_G = R_SI + 6 * SI_ONE;
constexpr size_t R_TAIL = R_G + SI_ONE;
constexpr size_t O_Y = R_TAIL;
constexpr size_t O_OSB = R_TAIL + SI_ONE;
constexpr size_t WS_END = O_OSB + (size_t)MS * 512 * 2;
constexpr size_t O_A0 = R_A0;
constexpr size_t O_ORW = R_A0;
constexpr size_t O_T1 = R_SI;
constexpr size_t O_M = R_SI + (size_t)MS * D * 4;
constexpr size_t O_P = R_A0;
constexpr size_t O_F = R_SI;
constexpr size_t O_ACT = R_A0;
constexpr size_t O_DN = R_SI + (size_t)MS * D * 2;
static_assert(3 * QKV_ONE <= (size_t)MP * RWS * 2, "overlay");
static_assert(O_M + (size_t)MS * D * 2 <= R_TAIL, "overlay");
static_assert(O_ACT + (size_t)MS * DFF * 2 <= R_SI, "overlay");
static_assert(O_P + (size_t)MS * D * 4 <= R_SI, "overlay");
static_assert(O_DN + (size_t)MS * D * 4 <= R_TAIL, "overlay");
static_assert(WS_END <= (size_t)512 * 1024 * 1024, "workspace");

constexpr int LDS_BYTES = 131072 + 64;

struct Params { const float* in[24]; float* out; unsigned char* ws; };

extern __shared__ __attribute__((aligned(16))) unsigned char smem[];

typedef __bf16 b16x2 __attribute__((ext_vector_type(2)));
__device__ __forceinline__ unsigned pk_bf16(float lo, float hi) { const f32x2 v = {lo, hi}; return __builtin_bit_cast(unsigned, __builtin_convertvector(v, b16x2)); }
__device__ __forceinline__ float bf2f(unsigned short v) { return __uint_as_float((unsigned)v << 16); }
__device__ __forceinline__ float sigmoidf_(float x) { return __builtin_amdgcn_rcpf(1.0f + __expf(-x)); }
__device__ __forceinline__ float softplusf_(float x) { return fmaxf(x, 0.f) + __logf(1.0f + __expf(-fabsf(x))); }
template <int CTRL> __device__ __forceinline__ float dppf(float x) { return __builtin_bit_cast(float, __builtin_amdgcn_mov_dpp(__builtin_bit_cast(int, x), CTRL, 0xf, 0xf, true)); }
__device__ __forceinline__ float reduce16(float v) {
    v += dppf<0xB1>(v); v += dppf<0x4E>(v); v += dppf<0x141>(v); v += dppf<0x140>(v); return v;
}
__device__ __forceinline__ float wave_sum(float v) {
#pragma unroll
    for (int o = 1; o < 64; o <<= 1) v += __shfl_xor(v, o);
    return v;
}

#define LAS __attribute__((address_space(3)))
#define XB_TMO      128
#define XB_XCNT(j)  (256  + 64 * (j))
#define XB_XSUB(j)  (1280 + 64 * (j))
#define XB_XGEN(j)  (2304 + 64 * (j))
#define XB_TOP      3328
#define XB_TOPGEN   3392
#define XCD_BAR_WORDS 3456
#define XB_SPIN_CAP (1u << 18)
__device__ __forceinline__ unsigned xb_ld(unsigned* p)              { return __hip_atomic_load(p, __ATOMIC_RELAXED, __HIP_MEMORY_SCOPE_AGENT); }
__device__ __forceinline__ unsigned xb_add(unsigned* p, unsigned v) { return __hip_atomic_fetch_add(p, v, __ATOMIC_RELAXED, __HIP_MEMORY_SCOPE_AGENT); }
__device__ __forceinline__ unsigned xb_xcc_id() { return (unsigned)__builtin_amdgcn_s_getreg((3 << 11) | 20) & 0xFu; }
#define XB_SPIN(cond, bar) do { unsigned _sp = 0; while (cond) { __builtin_amdgcn_s_sleep(1); \
    if ((++_sp & 255u) == 0u) { if (xb_ld(&(bar)[XB_TMO])) break; if (_sp > XB_SPIN_CAP) { atomicAdd(&(bar)[XB_TMO], 1u); break; } } } } while (0)
struct XcdBarrier { unsigned* bar; unsigned x; volatile LAS unsigned* st; };
__device__ __forceinline__ XcdBarrier xcd_barrier_post(unsigned* bar, volatile LAS unsigned* st) {
    XcdBarrier b; b.bar = bar; b.x = xb_xcc_id(); b.st = st;
    if (threadIdx.x == 0) (void)xb_add(&bar[XB_XCNT(b.x)], 1u);
    return b;
}
__device__ __forceinline__ void xcd_barrier_complete(unsigned* bar, unsigned x, unsigned& nloc, unsigned& nx) {
    const unsigned G = gridDim.x * gridDim.y * gridDim.z;
    unsigned sum, cnt, mine, sp = 0u;
    for (;;) {
        sum = 0u; cnt = 0u; mine = 0u;
#pragma unroll
        for (unsigned j = 0; j < 16; ++j) { const unsigned c = xb_ld(&bar[XB_XCNT(j)]); sum += c; cnt += (c > 0u) ? 1u : 0u; mine = (j == x) ? c : mine; }
        if (sum == G) break;
        __builtin_amdgcn_s_sleep(1);
        if ((++sp & 255u) == 0u) { if (xb_ld(&bar[XB_TMO])) break; if (sp > XB_SPIN_CAP) { atomicAdd(&bar[XB_TMO], 1u); break; } }
    }
    nloc = mine > 0u ? mine : 1u; nx = cnt > 0u ? cnt : 1u;
}
__device__ __forceinline__ void xcd_barrier(const XcdBarrier& b) {
    asm volatile("s_waitcnt vmcnt(0)" ::: "memory");
    __syncthreads();
    if (threadIdx.x == 0) {
        unsigned* bar = b.bar;
        __builtin_amdgcn_s_waitcnt(0);
        unsigned nloc = b.st[0], nx = b.st[1];
        if (nloc == 0u) { xcd_barrier_complete(bar, b.x, nloc, nx); b.st[0] = nloc; b.st[1] = nx; }
        const unsigned old = xb_add(&bar[XB_XSUB(b.x)], 1u);
        const unsigned gen = old / nloc;
        if (old + 1u == (gen + 1u) * nloc) {
            __builtin_amdgcn_fence(__ATOMIC_RELEASE, "agent");
            asm volatile("s_waitcnt vmcnt(0)" ::: "memory");
            const unsigned og = xb_add(&bar[XB_TOP], 1u);
            const unsigned tg = og / nx;
            if (og + 1u == (tg + 1u) * nx) xb_add(&bar[XB_TOPGEN], 1u);
            else XB_SPIN(xb_ld(&bar[XB_TOPGEN]) == tg, bar);
            __builtin_amdgcn_fence(__ATOMIC_ACQUIRE, "agent");
            xb_add(&bar[XB_XGEN(b.x)], 1u);
            asm volatile("s_waitcnt vmcnt(0)" ::: "memory");
        } else {
            XB_SPIN(xb_ld(&bar[XB_XGEN(b.x)]) == gen, bar);
            __builtin_amdgcn_fence(__ATOMIC_ACQUIRE, "agent");
            asm volatile("s_waitcnt vmcnt(0)" ::: "memory");
        }
    }
    __syncthreads();
}

constexpr int BM = 256, BK = 64, HALF = 128, HTB = HALF * BK * 2, NXCD = 8, WGM = 8;
__device__ __forceinline__ int lds_byte(int r, int c) { const int st = (r >> 4) * 2 + (c >> 5), rr = r & 15, cc = c & 31, ob = rr * 64 + cc * 2; return st * 1024 + (ob ^ (((ob >> 9) & 1) << 5)); }
__device__ __forceinline__ void stage_rc(int b, int& R, int& C) { const int st = b / 1024, sb = b % 1024, swz = sb ^ (((sb >> 9) & 1) << 5); R = (st >> 1) * 16 + swz / 64; C = (st & 1) * 32 + (swz % 64) / 2; }
struct Unit { int pm, pn; };
struct Sched {
    int nM, nN, nwg, G, c;
    __device__ __forceinline__ bool next(int i, Unit& u) const {
        const long L = (long)i * G + c; if (L >= nwg) return false;
        int wgid = (int)L; { const int q = nwg / NXCD, r = nwg % NXCD, xcd = wgid % NXCD, off = wgid / NXCD; wgid = (xcd < r ? xcd * (q + 1) : r * (q + 1) + (xcd - r) * q) + off; }
        const int nig = WGM * nN, gid = wgid / nig, fm = gid * WGM, gsz = (nM - fm) < WGM ? (nM - fm) : WGM;
        u.pm = fm + ((wgid % nig) % gsz); u.pn = (wgid % nig) / gsz; return true;
    }
};

template <class Epi>
__device__ __forceinline__ void gemm_phase(const bf16_t* __restrict__ Ag, const bf16_t* __restrict__ Btg, const int K, const int nM, const int nN, const Epi& E,
                                           const int G = (int)gridDim.x, const int c = (int)blockIdx.x, const int pn_from = 1 << 30, const int pn_add = 0) {
    LAS unsigned char* lds = (LAS unsigned char*)smem;
    const int tid = threadIdx.x, wid = __builtin_amdgcn_readfirstlane(tid >> 6), lane = tid & 63, wr = wid >> 2, wc = wid & 3, fr = lane & 15, fq = lane >> 4;
    const int nt = K / BK;
    Sched S; S.nM = nM; S.nN = nN; S.nwg = nM * nN; S.G = G; S.c = c;
    unsigned voffA[2], voffB[2];
#pragma unroll
    for (int i = 0; i < 2; ++i) { int R, C; stage_rc(tid * 16 + i * 8192, R, C);
        const int Rb = Epi::PERM ? ((R & ~31) + 8 * ((R & 15) >> 2) + 4 * ((R & 31) >> 4) + (R & 3)) : R;
        voffA[i] = (unsigned)(R * K + C) * 2u; voffB[i] = (unsigned)(Rb * K + C) * 2u; }
    const size_t kstep = (size_t)(BK * 2);
    const size_t hstep = (size_t)HALF * K * 2;
    const size_t tstep = 2 * hstep;
    const unsigned ldsw = (unsigned)wid * 1024u;
    const int aoff = lds_byte(wr * 64 + fr, fq * 8), boff = lds_byte(wc * 32 + fr, fq * 8);
#define PG8_SA(b, h) (((b) * 2 + (h)) * HTB)
#define PG8_SB(b, h) ((4 + (b) * 2 + (h)) * HTB)
#define PG8_STAGE(bufoff, gbase, voff) do { _Pragma("unroll") for (int _i = 0; _i < 2; ++_i) \
        __builtin_amdgcn_global_load_lds((const unsigned*)((const char*)(gbase) + (voff)[_i]), (LAS unsigned*)(lds + (bufoff) + ldsw + _i * 8192), 16, 0, 0); } while (0)
#define PG8_LDA(dst, b, h) do { _Pragma("unroll") for (int m = 0; m < 4; ++m) _Pragma("unroll") for (int k = 0; k < 2; ++k) dst[m][k] = *(const LAS bf16x8*)(lds + PG8_SA(b, h) + aoff + m * 2048 + k * 1024); } while (0)
#define PG8_LDB(dst, b, h) do { _Pragma("unroll") for (int n = 0; n < 2; ++n) _Pragma("unroll") for (int k = 0; k < 2; ++k) dst[n][k] = *(const LAS bf16x8*)(lds + PG8_SB(b, h) + boff + n * 2048 + k * 1024); } while (0)
#define PG8_MMA(ai, bj, At, Bt) do { __builtin_amdgcn_s_setprio(1); _Pragma("unroll") for (int m = 0; m < 4; ++m) _Pragma("unroll") for (int n = 0; n < 2; ++n) _Pragma("unroll") for (int k = 0; k < 2; ++k) \
        acc[ai][bj][m][n] = __builtin_amdgcn_mfma_f32_16x16x32_bf16(Bt[n][k], At[m][k], acc[ai][bj][m][n], 0, 0, 0); __builtin_amdgcn_s_setprio(0); } while (0)
#define PG8_WAIT_V(n) asm volatile("s_waitcnt vmcnt(" #n ")" ::: "memory")
#define PG8_WAIT_L(n) asm volatile("s_waitcnt lgkmcnt(" #n ")" ::: "memory")
#define PG8_BAR __builtin_amdgcn_s_barrier()
#define PG8_SCHED __builtin_amdgcn_sched_barrier(0)
    Unit cur, nxt; int ui = 0;
    __syncthreads();
    if (!S.next(0, cur)) return;
    if (cur.pn >= pn_from) cur.pn += pn_add;
    f32x4 acc[2][2][4][2];
#pragma unroll
    for (int a = 0; a < 2; ++a)
#pragma unroll
        for (int b = 0; b < 2; ++b)
#pragma unroll
            for (int m = 0; m < 4; ++m)
#pragma unroll
                for (int n = 0; n < 2; ++n) acc[a][b][m][n] = (f32x4){0.f, 0.f, 0.f, 0.f};
    bf16x8 At[4][2], B0[2][2], B1[2][2];
    const char* cA = (const char*)Ag + (size_t)cur.pm * tstep; const char* cB = (const char*)Btg + (size_t)cur.pn * tstep;
    PG8_STAGE(PG8_SB(0, 0), cB, voffB); PG8_STAGE(PG8_SB(0, 1), cB + hstep, voffB); PG8_STAGE(PG8_SA(0, 0), cA, voffA); PG8_STAGE(PG8_SA(0, 1), cA + hstep, voffA);
    if (wr == 1) PG8_BAR;
    PG8_WAIT_V(2); PG8_BAR;
    PG8_STAGE(PG8_SB(1, 0), cB + kstep, voffB); PG8_STAGE(PG8_SA(1, 0), cA + kstep, voffA); PG8_STAGE(PG8_SB(1, 1), cB + hstep + kstep, voffB);
    PG8_WAIT_V(6); PG8_BAR;
    for (;;) {
        const bool has_next = S.next(ui + 1, nxt);
        if (has_next && nxt.pn >= pn_from) nxt.pn += pn_add;
        const char* nA = has_next ? (const char*)Ag + (size_t)nxt.pm * tstep : cA; const char* nB = has_next ? (const char*)Btg + (size_t)nxt.pn * tstep : cB;
        for (int t = 0; t < nt; t += 2) {
            const bool last = (t == nt - 2);
            const char* a1 = cA + (size_t)(t + 1) * kstep;
            const char* a2 = last ? nA : cA + (size_t)(t + 2) * kstep; const char* b2 = last ? nB : cB + (size_t)(t + 2) * kstep;
            const char* a3 = a2 + kstep; const char* b3 = b2 + kstep;
            PG8_LDB(B0, 0, 0); PG8_LDB(B1, 0, 1); PG8_SCHED; PG8_LDA(At, 0, 0); PG8_STAGE(PG8_SA(1, 1), a1 + hstep, voffA);
            PG8_WAIT_V(8); PG8_WAIT_L(0); PG8_BAR; PG8_MMA(0, 0, At, B0); PG8_MMA(0, 1, At, B1); PG8_BAR; PG8_SCHED;
            PG8_LDA(At, 0, 1); PG8_STAGE(PG8_SB(0, 0), b2, voffB); PG8_STAGE(PG8_SB(0, 1), b2 + hstep, voffB); PG8_STAGE(PG8_SA(0, 0), a2, voffA);
            PG8_WAIT_V(8); PG8_WAIT_L(0); PG8_BAR; PG8_MMA(1, 0, At, B0); PG8_MMA(1, 1, At, B1); PG8_BAR; PG8_SCHED;
            PG8_LDB(B0, 1, 0); PG8_LDB(B1, 1, 1); PG8_SCHED; PG8_LDA(At, 1, 0); PG8_STAGE(PG8_SA(0, 1), a2 + hstep, voffA);
            PG8_WAIT_V(8); PG8_WAIT_L(0); PG8_BAR; PG8_MMA(0, 0, At, B0); PG8_MMA(0, 1, At, B1); PG8_BAR; PG8_SCHED;
            PG8_LDA(At, 1, 1); PG8_STAGE(PG8_SB(1, 0), b3, voffB); PG8_STAGE(PG8_SB(1, 1), b3 + hstep, voffB); PG8_STAGE(PG8_SA(1, 0), a3, voffA);
            PG8_WAIT_V(8); PG8_WAIT_L(0); PG8_BAR; PG8_MMA(1, 0, At, B0); PG8_MMA(1, 1, At, B1); PG8_BAR; PG8_SCHED;
        }
        if (wr == 0) PG8_BAR;
        {
            const int brow = cur.pm * BM, bcol = cur.pn * BM;
#pragma unroll
            for (int ai = 0; ai < 2; ++ai)
#pragma unroll
                for (int m = 0; m < 4; ++m) {
                    E.row(brow + ai * HALF + wr * 64 + m * 16 + fr, bcol + wc * 32, fq, acc[ai][0][m][0], acc[ai][0][m][1], acc[ai][1][m][0], acc[ai][1][m][1]);
                    asm volatile("" ::: "memory");
                }
        }
        if (!has_next) break;
#pragma unroll
        for (int a = 0; a < 2; ++a)
#pragma unroll
            for (int b = 0; b < 2; ++b)
#pragma unroll
                for (int m = 0; m < 4; ++m)
#pragma unroll
                    for (int n = 0; n < 2; ++n) acc[a][b][m][n] = (f32x4){0.f, 0.f, 0.f, 0.f};
        cur = nxt; cA = nA; cB = nB; ++ui;
        if (wr == 1) PG8_BAR;
    }
    PG8_WAIT_V(0);
    PG8_BAR;
#undef PG8_SA
#undef PG8_SB
#undef PG8_STAGE
#undef PG8_LDA
#undef PG8_LDB
#undef PG8_MMA
#undef PG8_WAIT_V
#undef PG8_WAIT_L
#undef PG8_BAR
#undef PG8_SCHED
}

template <bool PERM_> struct EpiInProj {
    static constexpr bool PERM = PERM_;
    bf16_t* qkv; _Float16* urw; bf16_t* gates;
    __device__ __forceinline__ void one(int row, int col, const f32x4& v) const {
        if (col < 1536) {
            const int which = col >> 9, hc = col & 511, h = hc >> 6, d = hc & 63, b = row / TP, t = row - b * TP;
            const float s = which == 0 ? 0.125f : 1.0f;
            u32x2 w; w.x = pk_bf16(v[0] * s, v[1] * s); w.y = pk_bf16(v[2] * s, v[3] * s);
            *(u32x2*)(qkv + (size_t)which * (QKV_ONE / 2) + ((size_t)(b * NH + h) * TP + t) * 64 + d) = w;
        } else if (col < 3328) {
            h16x4 o; o[0] = (_Float16)v[0]; o[1] = (_Float16)v[1]; o[2] = (_Float16)v[2]; o[3] = (_Float16)v[3];
            *(h16x4*)(urw + (size_t)row * RWS + (col - 1536)) = o;
        } else {
            const int b = row / TP, t = row - b * TP;
            if (t >= NMETA && t < T) {
                u32x2 w; w.x = pk_bf16(sigmoidf_(v[0]), sigmoidf_(v[1])); w.y = pk_bf16(sigmoidf_(v[2]), sigmoidf_(v[3]));
                *(u32x2*)(gates + (size_t)(b * SEQ + t - NMETA) * 2048 + (col - 3328)) = w;
            }
        }
    }
    __device__ __forceinline__ void half(int row, int col32, int fq, const f32x4& v0, const f32x4& v1) const {
        if constexpr (PERM_) {
            const int col = col32 + 8 * fq, b = row / TP, t = row - b * TP;
            if (col < 1536) {
                const int which = col >> 9, hc = col & 511, h = hc >> 6, d = hc & 63;
                const float s = which == 0 ? 0.125f : 1.0f;
                u32x4 w; w.x = pk_bf16(v0[0] * s, v0[1] * s); w.y = pk_bf16(v0[2] * s, v0[3] * s); w.z = pk_bf16(v1[0] * s, v1[1] * s); w.w = pk_bf16(v1[2] * s, v1[3] * s);
                *(u32x4*)(qkv + (size_t)which * (QKV_ONE / 2) + ((size_t)(b * NH + h) * TP + t) * 64 + d) = w;
            } else if (t >= NMETA && t < T) {
                u32x4 w; w.x = pk_bf16(sigmoidf_(v0[0]), sigmoidf_(v0[1])); w.y = pk_bf16(sigmoidf_(v0[2]), sigmoidf_(v0[3]));
                w.z = pk_bf16(sigmoidf_(v1[0]), sigmoidf_(v1[1])); w.w = pk_bf16(sigmoidf_(v1[2]), sigmoidf_(v1[3]));
                *(u32x4*)(gates + (size_t)(b * SEQ + t - NMETA) * 2048 + (col - 3328)) = w;
            }
        } else {
            if (col32 >= 1536 && col32 < 3072) {
                const int c = col32 - 1536, pos = (c & ~63) + fq * 16 + ((c & 63) >> 4) * 4;
                h16x8 o;
#pragma unroll
                for (int j = 0; j < 4; ++j) { o[j] = (_Float16)v0[j]; o[4 + j] = (_Float16)v1[j]; }
                *(h16x8*)(urw + (size_t)row * RWS + pos) = o;
            } else { one(row, col32 + 4 * fq, v0); one(row, col32 + 16 + 4 * fq, v1); }
        }
    }
    __device__ __forceinline__ void row(int r, int col32, int fq, const f32x4& a00, const f32x4& a01, const f32x4& a10, const f32x4& a11) const { half(r, col32, fq, a00, a01); half(r, col32 + HALF, fq, a10, a11); }
};
__device__ __forceinline__ void bf8_to_f(const u32x4& g, float (&f)[8]) {
#pragma unroll
    for (int i = 0; i < 4; ++i) { f[2 * i] = __uint_as_float(g[i] << 16); f[2 * i + 1] = __uint_as_float(g[i] & 0xffff0000u); }
}
struct EpiBranch1 {
    static constexpr bool PERM = true;
    bf16_t* t1; const bf16_t* gates;
    __device__ __forceinline__ void half(int row, int col32, int fq, const f32x4& v0, const f32x4& v1) const {
        const int col = col32 + 8 * fq;
        float g[8]; bf8_to_f(*(const u32x4*)(gates + (size_t)row * 2048 + col), g);
        u32x4 w; w.x = pk_bf16(v0[0] * g[0], v0[1] * g[1]); w.y = pk_bf16(v0[2] * g[2], v0[3] * g[3]); w.z = pk_bf16(v1[0] * g[4], v1[1] * g[5]); w.w = pk_bf16(v1[2] * g[6], v1[3] * g[7]);
        *(u32x4*)(t1 + (size_t)row * D + col) = w;
    }
    __device__ __forceinline__ void row(int r, int col32, int fq, const f32x4& a00, const f32x4& a01, const f32x4& a10, const f32x4& a11) const { half(r, col32, fq, a00, a01); half(r, col32 + HALF, fq, a10, a11); }
};
struct EpiBranch2 {
    static constexpr bool PERM = true;
    const bf16_t* t1; const bf16_t* gates; bf16_t* m;
    __device__ __forceinline__ void half(int row, int col32, int fq, const f32x4& v0, const f32x4& v1) const {
        const int col = col32 + 8 * fq;
        float g[8], a[8]; bf8_to_f(*(const u32x4*)(gates + (size_t)row * 2048 + 1024 + col), g); bf8_to_f(*(const u32x4*)(t1 + (size_t)row * D + col), a);
        u32x4 w; w.x = pk_bf16(a[0] + v0[0] * g[0], a[1] + v0[1] * g[1]); w.y = pk_bf16(a[2] + v0[2] * g[2], a[3] + v0[3] * g[3]);
        w.z = pk_bf16(a[4] + v1[0] * g[4], a[5] + v1[1] * g[5]); w.w = pk_bf16(a[6] + v1[2] * g[6], a[7] + v1[3] * g[7]);
        *(u32x4*)(m + (size_t)row * D + col) = w;
    }
    __device__ __forceinline__ void row(int r, int col32, int fq, const f32x4& a00, const f32x4& a01, const f32x4& a10, const f32x4& a11) const { half(r, col32, fq, a00, a01); half(r, col32 + HALF, fq, a10, a11); }
};
struct EpiF32 {
    static constexpr bool PERM = true;
    float* o;
    __device__ __forceinline__ void row(int r, int col32, int fq, const f32x4& a00, const f32x4& a01, const f32x4& a10, const f32x4& a11) const {
        float* q = o + (size_t)r * D + col32 + 8 * fq;
        *(f32x4*)q = a00; *(f32x4*)(q + 4) = a01; *(f32x4*)(q + HALF) = a10; *(f32x4*)(q + HALF + 4) = a11;
    }
};
struct EpiBf16 {
    static constexpr bool PERM = true;
    bf16_t* o;
    __device__ __forceinline__ void row(int r, int col32, int fq, const f32x4& a00, const f32x4& a01, const f32x4& a10, const f32x4& a11) const {
        bf16_t* q = o + (size_t)r * D + col32 + 8 * fq;
        u32x4 w0, w1;
        w0.x = pk_bf16(a00[0], a00[1]); w0.y = pk_bf16(a00[2], a00[3]); w0.z = pk_bf16(a01[0], a01[1]); w0.w = pk_bf16(a01[2], a01[3]);
        w1.x = pk_bf16(a10[0], a10[1]); w1.y = pk_bf16(a10[2], a10[3]); w1.z = pk_bf16(a11[0], a11[1]); w1.w = pk_bf16(a11[2], a11[3]);
        *(u32x4*)q = w0; *(u32x4*)(q + HALF) = w1;
    }
};
struct EpiGU {
    static constexpr bool PERM = true;
    bf16_t* act;
    __device__ __forceinline__ void row(int r, int col32, int fq, const f32x4& g0, const f32x4& g1, const f32x4& u0, const f32x4& u1) const {
        float o[8];
#pragma unroll
        for (int j = 0; j < 4; ++j) { o[j] = g0[j] * sigmoidf_(g0[j]) * u0[j]; o[4 + j] = g1[j] * sigmoidf_(g1[j]) * u1[j]; }
        u32x4 w; w.x = pk_bf16(o[0], o[1]); w.y = pk_bf16(o[2], o[3]); w.z = pk_bf16(o[4], o[5]); w.w = pk_bf16(o[6], o[7]);
        const int pn = col32 >> 8, cin = (col32 & 255) + 8 * fq;
        *(u32x4*)(act + (size_t)r * DFF + pn * 128 + cin) = w;
    }
};

__device__ __forceinline__ void transpose_tile(const float* __restrict__ src, int K, int N, bf16_t* __restrict__ dst, int ldd, int koff, int mode, int tile) {
    float* scr = (float*)smem;
    const int ntn = N / 128, kb = tile / ntn, nb = tile % ntn, k0 = kb * 64, n0 = nb * 128, tid = threadIdx.x;
    f32x4 v[4];
#pragma unroll
    for (int i = 0; i < 4; ++i) { const int idx = tid + 512 * i, kk = idx >> 5, n4 = idx & 31; v[i] = *(const f32x4*)(src + (size_t)(k0 + kk) * N + n0 + n4 * 4); }
#pragma unroll
    for (int i = 0; i < 4; ++i) { const int idx = tid + 512 * i, kk = idx >> 5, n4 = idx & 31;
#pragma unroll
        for (int c = 0; c < 4; ++c) scr[kk * 129 + n4 * 4 + c] = v[i][c]; }
    __syncthreads();
#pragma unroll
    for (int i = 0; i < 2; ++i) {
        const int o = tid + 512 * i, n = o >> 3, kc = (o & 7) * 8;
        u32x4 w;
        w.x = pk_bf16(scr[(kc + 0) * 129 + n], scr[(kc + 1) * 129 + n]); w.y = pk_bf16(scr[(kc + 2) * 129 + n], scr[(kc + 3) * 129 + n]);
        w.z = pk_bf16(scr[(kc + 4) * 129 + n], scr[(kc + 5) * 129 + n]); w.w = pk_bf16(scr[(kc + 6) * 129 + n], scr[(kc + 7) * 129 + n]);
        const int f = n0 + n;
        const int drow = mode == 0 ? f : ((f >> 7) * 256 + (mode == 2 ? 128 : 0) + (f & 127));
        *(u32x4*)(dst + (size_t)drow * ldd + koff + k0 + kc) = w;
    }
    __syncthreads();
}

__device__ __forceinline__ void phase0(const Params& p) {
    unsigned char* ws = p.ws;
    if (blockIdx.x == 0 && threadIdx.x < 64) ((unsigned*)(ws + WS_CTL))[threadIdx.x] = 0u;
    constexpr int J0 = 16 * 42, J1 = 8 * 8, J3 = 16 * 8, J4 = 16 * 22, J6 = 44 * 8, J7 = 4, J9 = 8;
    constexpr int NT = J0 + 2 * J1 + J3 + 2 * J4 + J6 + 2 * J7 + J9;
    constexpr int NR = MP / 32;
    for (int it = blockIdx.x; it < NT + NR; it += gridDim.x) {
        if (it >= NR) {
            int r = it - NR;
            if (r < J0) { transpose_tile(p.in[4], D, PIN, (bf16_t*)(ws + WS_WIN), D, 0, 0, r); continue; } r -= J0;
            if (r < J1) { transpose_tile(p.in[16], 512, D, (bf16_t*)(ws + WS_WSB), 512, 0, 0, r); continue; } r -= J1;
            if (r < J1) { transpose_tile(p.in[17], 512, D, (bf16_t*)(ws + WS_WRW), 512, 0, 0, r); continue; } r -= J1;
            if (r < J3) { transpose_tile(p.in[18], D, D, (bf16_t*)(ws + WS_WOUT), D, 0, 0, r); continue; } r -= J3;
            if (r < J4) { transpose_tile(p.in[21], D, DFF, (bf16_t*)(ws + WS_WGU), D, 0, 1, r); continue; } r -= J4;
            if (r < J4) { transpose_tile(p.in[22], D, DFF, (bf16_t*)(ws + WS_WGU), D, 0, 2, r); continue; } r -= J4;
            if (r < J6) { transpose_tile(p.in[23], DFF, D, (bf16_t*)(ws + WS_WD), DFF, 0, 0, r); continue; } r -= J6;
            if (r < J7) { transpose_tile(p.in[6], 64, 512, (bf16_t*)(ws + WS_WL), 256, 0, 0, r); continue; } r -= J7;
            if (r < J7) { transpose_tile(p.in[8], 64, 512, (bf16_t*)(ws + WS_WL), 256, 64, 0, r); continue; } r -= J7;
            transpose_tile(p.in[10], 128, 512, (bf16_t*)(ws + WS_WL), 256, 128, 0, r);
        } else {
            const int lane = threadIdx.x & 63, row0 = it * 32 + (threadIdx.x >> 6) * 4;
            f32x4 v[4][4];
#pragma unroll
            for (int r = 0; r < 4; ++r) {
                const int row = row0 + r, b = row / TP, t = row - b * TP;
                const float* src = t < NMETA ? p.in[1] + (size_t)t * D : p.in[0] + ((size_t)b * SEQ + (t < T ? t - NMETA : 0)) * D;
#pragma unroll
                for (int j = 0; j < 4; ++j) v[r][j] = *(const f32x4*)(src + 4 * lane + 256 * j);
            }
            f32x4 g[4];
#pragma unroll
            for (int j = 0; j < 4; ++j) g[j] = *(const f32x4*)(p.in[2] + 4 * lane + 256 * j);
#pragma unroll
            for (int r = 0; r < 4; ++r) {
                const int row = row0 + r, b = row / TP, t = row - b * TP;
                float ss = 0.f;
#pragma unroll
                for (int j = 0; j < 4; ++j) ss += (v[r][j][0] * v[r][j][0] + v[r][j][1] * v[r][j][1]) + (v[r][j][2] * v[r][j][2] + v[r][j][3] * v[r][j][3]);
                const float rs = t < T ? rsqrtf(wave_sum(ss) * (1.0f / D) + RMS_EPS) : 0.f;
                bf16_t* orow = (bf16_t*)(ws + O_A0) + (size_t)row * D;
#pragma unroll
                for (int j = 0; j < 4; ++j) {
                    u32x2 w; w.x = pk_bf16(v[r][j][0] * rs * g[j][0], v[r][j][1] * rs * g[j][1]); w.y = pk_bf16(v[r][j][2] * rs * g[j][2], v[r][j][3] * rs * g[j][3]);
                    *(u32x2*)(orow + 4 * lane + 256 * j) = w;
                }
            }
        }
    }
}

__device__ __forceinline__ void phase1(const Params& p) {
    unsigned char* ws = p.ws;
    EpiInProj<false> epi{(bf16_t*)(ws + R_QKV), (_Float16*)(ws + R_URW), (bf16_t*)p.out};
    gemm_phase((const bf16_t*)(ws + O_A0), (const bf16_t*)(ws + WS_WIN), D, MP / BM, 7, epi, (int)gridDim.x, (int)blockIdx.x, 0, 6);
}

constexpr int SI_R = 0, SI_W = 1, SI_K = 2, SI_V = 3, SI_KK = 4, SI_B = 5;
constexpr int ALD = 264;
constexpr int P2_WLS = 64 * ALD * 2;
constexpr int P2_MU = P2_WLS;
constexpr int P2_AL = P2_MU + 1024;
__device__ __forceinline__ void phase2_main(const Params& p) {
    unsigned char* ws = p.ws;
    const int tid = threadIdx.x, wave = tid >> 6, lane = tid & 63, fr = lane & 15, fq = lane >> 4;
    const int h = blockIdx.x & 7, nslot = (gridDim.x >> 3) * 8, slot = (blockIdx.x >> 3) * 8 + wave;
    const _Float16* urw = (const _Float16*)(ws + R_URW);
    const float* mu = p.in[5];
    bf16_t* WLs = (bf16_t*)smem;
    float* mus = (float*)(smem + P2_MU);
    bf16_t* Al = (bf16_t*)(smem + P2_AL) + wave * (16 * ALD);
    __syncthreads();
    {
        const bf16_t* WL = (const bf16_t*)(ws + WS_WL) + (size_t)h * 64 * 256;
#pragma unroll
        for (int i = 0; i < 4; ++i) { const int idx = tid + 512 * i, row = idx >> 5, c16 = idx & 31; *(u32x4*)(WLs + row * ALD + c16 * 8) = *(const u32x4*)(WL + row * 256 + c16 * 8); }
        if (tid < 256) mus[tid] = mu[1536 + tid];
    }
    __syncthreads();
    if (blockIdx.x >= nslot) return;
    _Float16* SI = (_Float16*)(ws + R_SI);
    bf16_t* G = (bf16_t*)(ws + R_G);
    constexpr size_t SIE = (size_t)MP * 512;
#pragma unroll 1
    for (int g = slot; g < NB * 514; g += nslot) {
        const int ub = g / 514, ui = g - ub * 514, row0 = ub * TP + ui * 16;
        {
            const int half = lane >> 5, pc = (lane & 31) * 8;
            const float sA = pc < 64 ? 2.f : 1.f, sC = pc < 64 ? -1.f : 0.f;
            const bool lin = pc >= 64 && pc < 128;
            const f32x4 mA = *(const f32x4*)(mu + 1536 + pc), mB = *(const f32x4*)(mu + 1536 + pc + 4);
            h16x8 c[8], pv[8];
#pragma unroll
            for (int q = 0; q < 8; ++q) {
                const int rowa = row0 + 2 * q + half, ta = rowa % TP;
                const _Float16* cur = urw + (size_t)rowa * RWS + 1536 + pc;
                c[q] = *(const h16x8*)cur;
                pv[q] = *(const h16x8*)(ta > 0 ? cur - RWS : cur);
            }
#pragma unroll
            for (int q = 0; q < 8; ++q) {
                const int ta = (row0 + 2 * q + half) % TP;
                float o[8];
#pragma unroll
                for (int e = 0; e < 8; ++e) {
                    const float cf = (float)c[q][e], pf = ta > 0 ? (float)pv[q][e] : 0.f;
                    const float xs = cf + (e < 4 ? mA[e & 3] : mB[e & 3]) * (pf - cf);
                    const float sg = __builtin_amdgcn_rcpf(1.0f + __expf(-sA * xs));
                    o[e] = lin ? xs : sA * sg + sC;
                }
                u32x4 w; w.x = pk_bf16(o[0], o[1]); w.y = pk_bf16(o[2], o[3]); w.z = pk_bf16(o[4], o[5]); w.w = pk_bf16(o[6], o[7]);
                *(u32x4*)(Al + (2 * q + half) * ALD + pc) = w;
            }
        }
        asm volatile("s_waitcnt lgkmcnt(0)" ::: "memory");
        __builtin_amdgcn_wave_barrier();
        f32x4 acc[4];
        auto lora = [&](auto kbeg_c, auto ksteps_c) {
            constexpr int kbeg = decltype(kbeg_c)::value, ksteps = decltype(ksteps_c)::value;
#pragma unroll
            for (int n = 0; n < 4; ++n) acc[n] = (f32x4){0.f, 0.f, 0.f, 0.f};
#pragma unroll
            for (int ks = 0; ks < ksteps; ++ks) {
                const bf16x8 af = *(const bf16x8*)(Al + fr * ALD + kbeg + ks * 32 + fq * 8);
#pragma unroll
                for (int n = 0; n < 4; ++n) {
                    const bf16x8 wf = *(const bf16x8*)(WLs + (n * 16 + fr) * ALD + kbeg + ks * 32 + fq * 8);
                    acc[n] = __builtin_amdgcn_mfma_f32_16x16x32_bf16(wf, af, acc[n], 0, 0, 0);
                }
            }
        };
        const int row = row0 + fr, b = row / TP, t = row - b * TP;
        const size_t base = ((size_t)(b * NH + h) * TP + t) * 64;
        const _Float16* ur = urw + (size_t)row * RWS;
        const size_t pb = base + fq * 16;
        lora(std::integral_constant<int, 0>{}, std::integral_constant<int, 2>{});
        {
            h16x8 wo[2];
#pragma unroll
            for (int n = 0; n < 4; ++n) {
                const f32x4 db = *(const f32x4*)(p.in[7] + h * 64 + n * 16 + fq * 4);
#pragma unroll
                for (int j = 0; j < 4; ++j) {
                    const float wl = -softplusf_(-(db[j] + acc[n][j])) - 0.5f;
                    const float e = __expf(wl);
                    wo[n >> 1][(n & 1) * 4 + j] = (_Float16)(1.0f - __expf(-e));
                }
            }
            *(h16x8*)(SI + SI_W * SIE + pb) = wo[0]; *(h16x8*)(SI + SI_W * SIE + pb + 8) = wo[1];
        }
        lora(std::integral_constant<int, 64>{}, std::integral_constant<int, 2>{});
        {
            const _Float16* up = ur + h * 64 + fq * 16;
            const _Float16* upp = t > 0 ? up - RWS : up;
            h16x8 kc[2], rc[2], vc[2], kp[2], rp[2], vp[2];
#pragma unroll
            for (int i = 0; i < 2; ++i) {
                rc[i] = *(const h16x8*)(up + i * 8); kc[i] = *(const h16x8*)(up + 512 + i * 8); vc[i] = *(const h16x8*)(up + 1024 + i * 8);
                rp[i] = *(const h16x8*)(upp + i * 8); kp[i] = *(const h16x8*)(upp + 512 + i * 8); vp[i] = *(const h16x8*)(upp + 1024 + i * 8);
            }
            float kv[4][4], av[4][4], kkr[4][4]; float ss = 0.f;
            h16x8 ro[2];
#pragma unroll
            for (int n = 0; n < 4; ++n) {
                const int c = n * 16 + fq * 4, c512 = h * 64 + c;
                const f32x4 muk = *(const f32x4*)(mu + 512 + c512), mur = *(const f32x4*)(mu + c512), muv = *(const f32x4*)(mu + 1024 + c512);
                const f32x4 ab = *(const f32x4*)(p.in[9] + c512), kkw = *(const f32x4*)(p.in[11] + c512);
                h16x4 vo;
#pragma unroll
                for (int j = 0; j < 4; ++j) {
                    const int i = n >> 1, e = (n & 1) * 4 + j;
                    const float kcf = (float)kc[i][e], kpf = t > 0 ? (float)kp[i][e] : 0.f;
                    const float rcf = (float)rc[i][e], rpf = t > 0 ? (float)rp[i][e] : 0.f;
                    const float vcf = (float)vc[i][e], vpf = t > 0 ? (float)vp[i][e] : 0.f;
                    kv[n][j] = kcf + muk[j] * (kpf - kcf);
                    ro[i][e] = (_Float16)(rcf + mur[j] * (rpf - rcf));
                    vo[j] = (_Float16)(vcf + muv[j] * (vpf - vcf));
                    av[n][j] = sigmoidf_(ab[j] + acc[n][j]);
                    kkr[n][j] = kv[n][j] * kkw[j];
                    ss += kkr[n][j] * kkr[n][j];
                }
                *(h16x4*)(SI + SI_V * SIE + base + c) = vo;
            }
            *(h16x8*)(SI + SI_R * SIE + pb) = ro[0]; *(h16x8*)(SI + SI_R * SIE + pb + 8) = ro[1];
            ss += __shfl_xor(ss, 16); ss += __shfl_xor(ss, 32);
            const float inv = fminf(__builtin_amdgcn_rsqf(ss), 1e12f);
            h16x8 ko[2], kko[2], bo[2];
#pragma unroll
            for (int n = 0; n < 4; ++n) {
                const f32x4 ka = *(const f32x4*)(p.in[12] + h * 64 + n * 16 + fq * 4);
#pragma unroll
                for (int j = 0; j < 4; ++j) {
                    const int i = n >> 1, e = (n & 1) * 4 + j;
                    const float kk = kkr[n][j] * inv;
                    ko[i][e] = (_Float16)(kv[n][j] * (1.0f + (av[n][j] - 1.0f) * ka[j]));
                    kko[i][e] = (_Float16)kk;
                    bo[i][e] = (_Float16)(kk * av[n][j]);
                }
            }
#pragma unroll
            for (int i = 0; i < 2; ++i) {
                *(h16x8*)(SI + SI_K * SIE + pb + i * 8) = ko[i]; *(h16x8*)(SI + SI_KK * SIE + pb + i * 8) = kko[i]; *(h16x8*)(SI + SI_B * SIE + pb + i * 8) = bo[i];
            }
        }
        lora(std::integral_constant<int, 128>{}, std::integral_constant<int, 4>{});
        {
            u32x4 g0, g1;
            g0.x = pk_bf16(acc[0][0], acc[0][1]); g0.y = pk_bf16(acc[0][2], acc[0][3]); g0.z = pk_bf16(acc[1][0], acc[1][1]); g0.w = pk_bf16(acc[1][2], acc[1][3]);
            g1.x = pk_bf16(acc[2][0], acc[2][1]); g1.y = pk_bf16(acc[2][2], acc[2][3]); g1.z = pk_bf16(acc[3][0], acc[3][1]); g1.w = pk_bf16(acc[3][2], acc[3][3]);
            *(u32x4*)(G + pb) = g0; *(u32x4*)(G + pb + 8) = g1;
        }
        asm volatile("s_waitcnt lgkmcnt(0)" ::: "memory");
        __builtin_amdgcn_wave_barrier();
    }
}
__device__ __forceinline__ void phase2_kmax(const Params& p, int item) {
    unsigned char* ws = p.ws;
    const int bh = item >> 2, qr = item & 3, tid = threadIdx.x;
    float* red = (float*)(smem + P2_AL + 8 * 16 * ALD * 2);
    float ss = 0.f;
    for (int t = qr * 2052 + tid; t < (qr + 1) * 2052; t += 512) {
        const bf16_t* kr = (const bf16_t*)(ws + R_QKV) + QKV_ONE / 2 + ((size_t)bh * TP + t) * 64;
        float s1 = 0.f;
#pragma unroll
        for (int q = 0; q < 8; ++q) {
            const u32x4 v = *(const u32x4*)(kr + q * 8);
#pragma unroll
            for (int e = 0; e < 4; ++e) { const float lo = __uint_as_float(v[e] << 16), hi = __uint_as_float(v[e] & 0xffff0000u); s1 += lo * lo + hi * hi; }
        }
        ss = fmaxf(ss, s1);
    }
#pragma unroll
    for (int o = 1; o < 64; o <<= 1) ss = fmaxf(ss, __shfl_xor(ss, o));
    __syncthreads();
    if ((tid & 63) == 0) red[tid >> 6] = ss;
    __syncthreads();
    if (tid == 0) {
        float m = red[0];
#pragma unroll
        for (int w = 1; w < 8; ++w) m = fmaxf(m, red[w]);
        ((float*)(ws + WS_CTL))[16 + item] = m;
    }
}
__device__ __forceinline__ void phase2(const Params& p) {
    phase2_main(p);
}

constexpr int SC_TC = 32, SC_NC = (T + SC_TC - 1) / SC_TC;
constexpr int SC_ARR = SC_TC * 64;
constexpr int SC_VOFF = 5 * SC_ARR, SC_COFF = SC_VOFF + SC_TC * 16;
constexpr int SC_BUF = (SC_COFF + SC_TC) * 4;
constexpr int SC_YOFF = 2 * SC_BUF, SC_YBUF = SC_TC * 16 * 4;
__device__ __forceinline__ float dot4(const f32x4& a, const f32x4& b) {
    f32x2 t = __builtin_shufflevector(a, a, 0, 1) * __builtin_shufflevector(b, b, 0, 1);
    t = __builtin_shufflevector(a, a, 2, 3) * __builtin_shufflevector(b, b, 2, 3) + t;
    return t[0] + t[1];
}
__device__ __forceinline__ void reduce16x2(float& a, float& b) {
    a += dppf<0xB1>(a); b += dppf<0xB1>(b); a += dppf<0x4E>(a); b += dppf<0x4E>(b);
    a += dppf<0x141>(a); b += dppf<0x141>(b); a += dppf<0x140>(a); b += dppf<0x140>(b);
}
__device__ __forceinline__ void scan_unit(const Params& p, int unit) {
    unsigned char* ws = p.ws;
    const int bh = unit >> 2, vr0 = (unit & 3) * 16, tid = threadIdx.x, wave = tid >> 6, lane = tid & 63;
    const _Float16* SI = (const _Float16*)(ws + R_SI);
    constexpr size_t SIE = (size_t)MP * 512;
    bf16_t* Y = (bf16_t*)(ws + O_Y);
    const size_t hb = (size_t)bh * TP * 64;
    __syncthreads();
    if (wave >= 4) {
        const int i = tid - 256, ip = i >= 8 ? i - 8 : i;
        const int arrs[5] = {SI_R, SI_W, SI_K, SI_KK, SI_B};
        u32x4 rg[5], rp[3]; unsigned rv;
        auto issue = [&](int c) {
            const size_t off = hb + (size_t)c * SC_TC * 64;
#pragma unroll
            for (int a = 0; a < 5; ++a) rg[a] = *(const u32x4*)(SI + arrs[a] * SIE + off + i * 8);
            rp[0] = *(const u32x4*)(SI + SI_W * SIE + off + ip * 8);
            rp[1] = *(const u32x4*)(SI + SI_K * SIE + off + ip * 8);
            rp[2] = *(const u32x4*)(SI + SI_B * SIE + off + ip * 8);
            rv = *(const unsigned*)(SI + SI_V * SIE + off + (i >> 3) * 64 + vr0 + (i & 7) * 2);
        };
        auto commit = [&](int bufi) {
            float* buf = (float*)(smem + bufi * SC_BUF);
            float f[5][8];
#pragma unroll
            for (int a = 0; a < 5; ++a) {
                const h16x8 hv = __builtin_bit_cast(h16x8, rg[a]);
#pragma unroll
                for (int e = 0; e < 8; ++e) f[a][e] = (float)hv[e];
            }
            const bool odd = (i >> 3) & 1;
            float ckk = 0.f, cbk = 0.f;
            {
                const h16x8 pw = __builtin_bit_cast(h16x8, rp[0]), pk = __builtin_bit_cast(h16x8, rp[1]), pb = __builtin_bit_cast(h16x8, rp[2]);
#pragma unroll
                for (int e = 0; e < 8; ++e) {
                    const float kk2 = f[3][e];
                    ckk += (float)pk[e] * kk2; cbk += (float)pb[e] * kk2;
                    if (odd) f[3][e] = (1.0f - (float)pw[e]) * kk2;
                }
            }
            ckk += dppf<0xB1>(ckk); cbk += dppf<0xB1>(cbk); ckk += dppf<0x4E>(ckk); cbk += dppf<0x4E>(cbk); ckk += dppf<0x141>(ckk); cbk += dppf<0x141>(cbk);
#pragma unroll
            for (int a = 0; a < 5; ++a) {
                f32x4 lo, hi;
#pragma unroll
                for (int e = 0; e < 4; ++e) { lo[e] = f[a][e]; hi[e] = f[a][4 + e]; }
                if (a == 1) { lo = 1.0f - lo; hi = 1.0f - hi; }
                if (a == 4) { lo = -lo; hi = -hi; }
                *(f32x4*)(buf + a * SC_ARR + i * 8) = lo; *(f32x4*)(buf + a * SC_ARR + i * 8 + 4) = hi;
            }
            const h16x2 v2 = __builtin_bit_cast(h16x2, rv);
            f32x2 vf; vf[0] = (float)v2[0]; vf[1] = (float)v2[1];
            *(f32x2*)(buf + SC_VOFF + (i >> 3) * 16 + (i & 7) * 2) = vf;
            if (odd && (i & 7) == 0) { f32x2 cf; cf[0] = ckk; cf[1] = cbk; *(f32x2*)(buf + SC_COFF + (i >> 4) * 2) = cf; }
        };
        auto yout = [&](int c) {
            const float* yb = (const float*)(smem + SC_YOFF + (c & 1) * SC_YBUF);
            const f32x2 v = *(const f32x2*)(yb + (i >> 3) * 16 + (i & 7) * 2);
            *(unsigned*)(Y + hb + (size_t)(c * SC_TC + (i >> 3)) * 64 + vr0 + (i & 7) * 2) = pk_bf16(v[0], v[1]);
        };
        issue(0); commit(0); issue(1);
        __syncthreads();
        for (int c = 0; c < SC_NC; ++c) {
            if (c > 0) yout(c - 1);
            if (c + 1 < SC_NC) commit((c + 1) & 1);
            if (c + 2 < SC_NC) issue(c + 2);
            __syncthreads();
        }
        yout(SC_NC - 1);
    } else {
        const int rl = wave * 4 + (lane >> 4), sub = lane & 15;
        const bool odd_lane = lane & 1; const int yoff = (lane & 1) * 16 + rl;
        f32x4 S = {0.f, 0.f, 0.f, 0.f};
        __builtin_amdgcn_s_setprio(3);
        __syncthreads();
        for (int c = 0; c < SC_NC; ++c) {
            const float* buf = (const float*)(smem + (c & 1) * SC_BUF);
            float* yb = (float*)(smem + SC_YOFF + (c & 1) * SC_YBUF);
            const float* bp = buf + sub * 4;
#define SC_LD(arr, s) (*(const f32x4*)(bp + (arr) * SC_ARR + (s) * 64))
            f32x4 r1 = SC_LD(0, 0), w1 = SC_LD(1, 0), k1 = SC_LD(2, 0), q1 = SC_LD(3, 0), n1 = SC_LD(4, 0);
            f32x4 r2 = SC_LD(0, 1), w2 = SC_LD(1, 1), k2 = SC_LD(2, 1), g2 = SC_LD(3, 1), n2 = SC_LD(4, 1);
            float v1 = buf[SC_VOFF + rl], v2 = buf[SC_VOFF + 16 + rl];
            f32x2 cf = *(const f32x2*)(buf + SC_COFF);
#pragma unroll
            for (int pr = 0; pr < SC_TC / 2; ++pr) {
                const int sn = 2 * pr + 2;
                const f32x4 r1n = SC_LD(0, sn), w1n = SC_LD(1, sn), k1n = SC_LD(2, sn), q1n = SC_LD(3, sn), n1n = SC_LD(4, sn);
                const f32x4 r2n = SC_LD(0, sn + 1), w2n = SC_LD(1, sn + 1), k2n = SC_LD(2, sn + 1), g2n = SC_LD(3, sn + 1), n2n = SC_LD(4, sn + 1);
                const float v1n = buf[SC_VOFF + sn * 16 + rl], v2n = buf[SC_VOFF + (sn + 1) * 16 + rl];
                const f32x2 cfn = *(const f32x2*)(buf + SC_COFF + (pr + 1) * 2);
                __builtin_amdgcn_sched_barrier(0x7);
                float d1 = dot4(S, q1), e2 = dot4(S, g2);
                const f32x4 t1 = S * w1 + v1 * k1;
                reduce16x2(d1, e2);
                const float d2 = e2 + v1 * cf[0] - d1 * cf[1];
                const f32x4 S1 = t1 + d1 * n1;
                const f32x4 S2 = (S1 * w2 + v2 * k2) + d2 * n2;
                float y1 = dot4(S1, r1), y2 = dot4(S2, r2);
                y1 += dppf<0xB1>(y1); y2 += dppf<0xB1>(y2);
                float yz = odd_lane ? y2 : y1;
                yz += dppf<0x122>(yz); yz += dppf<0x124>(yz); yz += dppf<0x128>(yz);
                yb[(2 * pr) * 16 + yoff] = yz;
                S = S2;
                r1 = r1n; w1 = w1n; k1 = k1n; q1 = q1n; n1 = n1n; r2 = r2n; w2 = w2n; k2 = k2n; g2 = g2n; n2 = n2n; v1 = v1n; v2 = v2n; cf = cfn;
            }
#undef SC_LD
            __syncthreads();
        }
        __builtin_amdgcn_s_setprio(0);
    }
}

constexpr int KLD = 72;
__device__ __forceinline__ void attn_unit(const Params& p, int unit) {
    unsigned char* ws = p.ws;
    const int qt = unit % 65, bh = unit / 65, b = bh >> 3, h = bh & 7;
    const int tid = threadIdx.x, wave = tid >> 6, lane = tid & 63, fr = lane & 15, fq = lane >> 4;
    const bf16_t* Q = (const bf16_t*)(ws + R_QKV) + (size_t)bh * TP * 64;
    const bf16_t* Kg = Q + QKV_ONE / 2;
    const bf16_t* Vg = Q + QKV_ONE;
    bf16_t* slots = (bf16_t*)smem;
    constexpr int SLOT = 2 * 64 * KLD;
    volatile int* flags = (volatile int*)(smem + 2 * SLOT * 2);
    const int t0 = qt * 128, tq = t0 + wave * 16 + fr;
    bf16x8 qf[2];
    qf[0] = *(const bf16x8*)(Q + (size_t)tq * 64 + fq * 8);
    qf[1] = *(const bf16x8*)(Q + (size_t)tq * 64 + 32 + fq * 8);
    float qs = 0.f;
#pragma unroll
    for (int s = 0; s < 2; ++s)
#pragma unroll
        for (int e = 0; e < 8; ++e) { const float f = bf2f((unsigned short)qf[s][e]); qs += f * f; }
    qs += __shfl_xor(qs, 16); qs += __shfl_xor(qs, 32);
    const f32x4 km4 = *(const f32x4*)((const float*)(ws + WS_CTL) + 16 + bh * 4);
    const float kmax = sqrtf(fmaxf(fmaxf(km4[0], km4[1]), fmaxf(km4[2], km4[3])));
    const float zb = sqrtf(qs) * kmax * 1.0001f + 88.0f;
    float Arow = 0.f;
    f32x4 O[4];
#pragma unroll
    for (int nd = 0; nd < 4; ++nd) O[nd] = (f32x4){0.f, 0.f, 0.f, 0.f};
    const int key = tid >> 3, dc = (tid & 7) * 8, half = wave >> 2;
    auto tile_store = [&](int blk, const u32x4& kv, const u32x4& vv) {
        bf16_t* Ks_ = slots + (blk & 1) * SLOT; bf16_t* Vt_ = Ks_ + 64 * KLD;
        *(u32x4*)(Ks_ + key * KLD + dc) = kv;
#pragma unroll
        for (int e = 0; e < 4; ++e) { Vt_[(dc + 2 * e) * KLD + key] = (bf16_t)(vv[e] & 0xffffu); Vt_[(dc + 2 * e + 1) * KLD + key] = (bf16_t)(vv[e] >> 16); }
    };
    const int ktop = qt * 2 + 1;
    {
        const u32x4 k0 = *(const u32x4*)(Kg + (size_t)(ktop * 64 + key) * 64 + dc), v0 = *(const u32x4*)(Vg + (size_t)(ktop * 64 + key) * 64 + dc);
        __syncthreads();
        tile_store(ktop, k0, v0);
    }
    u32x4 kvv = *(const u32x4*)(Kg + (size_t)((ktop - 1) * 64 + key) * 64 + dc);
    u32x4 vvv = *(const u32x4*)(Vg + (size_t)((ktop - 1) * 64 + key) * 64 + dc);
    for (int kt = ktop; kt >= 0; --kt) {
        const int kb = kt - 1 + half;
        const bool done = __all(Arow > zb) || kb < 0;
        if (lane == 0) flags[wave] = done ? 1 : 0;
        __syncthreads();
        int alld = 1;
#pragma unroll
        for (int w = 0; w < 8; ++w) alld &= flags[w];
        if (alld) break;
        if (kt >= 1) {
            tile_store(kt - 1, kvv, vvv);
            if (kt >= 2) {
                kvv = *(const u32x4*)(Kg + (size_t)((kt - 2) * 64 + key) * 64 + dc);
                vvv = *(const u32x4*)(Vg + (size_t)((kt - 2) * 64 + key) * 64 + dc);
            }
        }
        asm volatile("s_waitcnt lgkmcnt(0)" ::: "memory");
        __builtin_amdgcn_s_barrier();
        if (kb < 0) continue;
        const bf16_t* Ks = slots + (kb & 1) * SLOT; const bf16_t* Vt = Ks + 64 * KLD;
        f32x4 z[4];
#pragma unroll
        for (int n = 0; n < 4; ++n) {
            z[n] = (f32x4){0.f, 0.f, 0.f, 0.f};
#pragma unroll
            for (int s = 0; s < 2; ++s) {
                const bf16x8 kf = *(const bf16x8*)(Ks + (n * 16 + fr) * KLD + s * 32 + fq * 8);
                z[n] = __builtin_amdgcn_mfma_f32_16x16x32_bf16(kf, qf[s], z[n], 0, 0, 0);
            }
        }
        float sp[4][4], lt[4], ex[4], sg[4];
#pragma unroll
        for (int n = 0; n < 4; ++n) {
#pragma unroll
            for (int j = 0; j < 4; ++j) { const int s = kb * 64 + n * 16 + fq * 4 + j; sp[n][j] = s < tq ? softplusf_(z[n][j]) : 0.f; }
            sp[n][2] += sp[n][3]; sp[n][1] += sp[n][2]; sp[n][0] += sp[n][1];
            lt[n] = sp[n][0];
            const float a = __shfl_xor(lt[n], 16), pr = lt[n] + a, c = __shfl_xor(pr, 32);
            ex[n] = fq == 3 ? 0.f : (fq == 2 ? a : (fq == 1 ? c : a + c));
            sg[n] = pr + c;
        }
        float nsuf[4]; nsuf[3] = 0.f; nsuf[2] = sg[3]; nsuf[1] = nsuf[2] + sg[2]; nsuf[0] = nsuf[1] + sg[1];
        float wgt[4][4];
#pragma unroll
        for (int n = 0; n < 4; ++n)
#pragma unroll
            for (int j = 0; j < 4; ++j) {
                const int s = kb * 64 + n * 16 + fq * 4 + j;
                const float C = Arow + nsuf[n] + ex[n] + sp[n][j];
                wgt[n][j] = s < tq ? __expf(z[n][j] - C) : 0.f;
            }
        Arow += nsuf[0] + sg[0];
#pragma unroll
        for (int ks = 0; ks < 2; ++ks) {
            u32x4 pw; pw.x = pk_bf16(wgt[2 * ks][0], wgt[2 * ks][1]); pw.y = pk_bf16(wgt[2 * ks][2], wgt[2 * ks][3]);
            pw.z = pk_bf16(wgt[2 * ks + 1][0], wgt[2 * ks + 1][1]); pw.w = pk_bf16(wgt[2 * ks + 1][2], wgt[2 * ks + 1][3]);
            const bf16x8 pf = __builtin_bit_cast(bf16x8, pw);
#pragma unroll
            for (int nd = 0; nd < 4; ++nd) {
                u32x4 vw;
                const u32x2 v0 = *(const u32x2*)(Vt + (nd * 16 + fr) * KLD + (2 * ks) * 16 + fq * 4);
                const u32x2 v1 = *(const u32x2*)(Vt + (nd * 16 + fr) * KLD + (2 * ks + 1) * 16 + fq * 4);
                vw.x = v0.x; vw.y = v0.y; vw.z = v1.x; vw.w = v1.y;
                O[nd] = __builtin_amdgcn_mfma_f32_16x16x32_bf16(pf, __builtin_bit_cast(bf16x8, vw), O[nd], 0, 0, 0);
            }
        }
    }
    __syncthreads();
    bf16_t* Ot = (bf16_t*)smem;
#pragma unroll
    for (int j = 0; j < 4; ++j)
#pragma unroll
        for (int nd = 0; nd < 4; ++nd) Ot[(wave * 16 + fq * 4 + j) * KLD + nd * 16 + fr] = (bf16_t)(pk_bf16(O[nd][j], 0.f) & 0xffffu);
    __syncthreads();
    bf16_t* osb = (bf16_t*)(ws + O_OSB);
#pragma unroll
    for (int i = 0; i < 2; ++i) {
        const int idx = tid + 512 * i, r = idx >> 3, pc8 = (idx & 7) * 8, t = t0 + r;
        if (t >= NMETA && t < T) *(u32x4*)(osb + (size_t)(b * SEQ + t - NMETA) * 512 + h * 64 + pc8) = *(const u32x4*)(Ot + r * KLD + pc8);
    }
}

constexpr int N_SCAN = 128, N_ATTN = 32 * 65;
__device__ __forceinline__ void sub_barrier(unsigned* ctr, unsigned target, bool arrive) {
    asm volatile("s_waitcnt vmcnt(0)" ::: "memory");
    __syncthreads();
    if (threadIdx.x == 0) {
        if (arrive) { __builtin_amdgcn_fence(__ATOMIC_RELEASE, "agent"); asm volatile("s_waitcnt vmcnt(0)" ::: "memory"); (void)xb_add(ctr, 1u); }
        unsigned sp = 0u;
        while (xb_ld(ctr) < target) { __builtin_amdgcn_s_sleep(2); if (++sp > (1u << 22)) break; }
        __builtin_amdgcn_fence(__ATOMIC_ACQUIRE, "agent");
        asm volatile("s_waitcnt vmcnt(0)" ::: "memory");
    }
    __syncthreads();
}
__device__ __forceinline__ void phase3(const Params& p) {
    unsigned char* ws = p.ws;
    unsigned* ctl = (unsigned*)(ws + WS_CTL);
    const int nother = (int)gridDim.x - N_SCAN;
    if ((int)blockIdx.x < N_SCAN) {
        scan_unit(p, blockIdx.x);
    } else {
        EpiInProj<true> epi{(bf16_t*)(ws + R_QKV), (_Float16*)(ws + R_URW), (bf16_t*)p.out};
        gemm_phase((const bf16_t*)(ws + O_A0), (const bf16_t*)(ws + WS_WIN), D, MP / BM, 14, epi, nother, (int)blockIdx.x - N_SCAN, 6, 7);
        sub_barrier(ctl + 256, (unsigned)nother, true);
        for (int it = (int)blockIdx.x - N_SCAN; it < 128; it += nother) phase2_kmax(p, it);
        sub_barrier(ctl + 320, (unsigned)nother, true);
    }
    sub_barrier(ctl + 320, (unsigned)nother, false);
    volatile int* slot = (volatile int*)(smem + 131072 - 16);
    for (;;) {
        __syncthreads();
        if (threadIdx.x == 0) *slot = (int)atomicAdd(ctl, 1u);
        __syncthreads();
        const int u = *slot;
        if (u >= N_ATTN) break;
        attn_unit(p, u);
    }
}

__device__ __forceinline__ void phase3c(const Params& p) {
    unsigned char* ws = p.ws;
    const _Float16* SI = (const _Float16*)(ws + R_SI);
    constexpr size_t SIE = (size_t)MP * 512;
    const bf16_t* Y = (const bf16_t*)(ws + O_Y);
    const bf16_t* G = (const bf16_t*)(ws + R_G);
    bf16_t* orw = (bf16_t*)(ws + O_ORW);
    const int tid = threadIdx.x, sub = tid & 15;
    constexpr int U = 4;
    for (int it = blockIdx.x; it < 32 * 64; it += gridDim.x) {
        const int bh = it >> 6, c4 = it & 63, b = bh >> 3, h = bh & 7;
        const int c = h * 64 + sub * 4;
        const f32x4 gain = *(const f32x4*)(p.in[14] + c), bias = *(const f32x4*)(p.in[15] + c), rk = *(const f32x4*)(p.in[13] + c);
        u32x2 yb2[U]; f32x4 y[U]; h16x4 r4[U], k4[U], v4[U]; u32x2 g2[U];
#pragma unroll
        for (int u = 0; u < U; ++u) {
            const int t = NMETA + (c4 * U + u) * 32 + (tid >> 4);
            const size_t base = ((size_t)bh * TP + t) * 64 + sub * 4;
            const size_t pbase = ((size_t)bh * TP + t) * 64 + (sub & 3) * 16 + (sub >> 2) * 4;
            yb2[u] = *(const u32x2*)(Y + base);
            r4[u] = *(const h16x4*)(SI + SI_R * SIE + pbase); k4[u] = *(const h16x4*)(SI + SI_K * SIE + pbase); v4[u] = *(const h16x4*)(SI + SI_V * SIE + base);
            g2[u] = *(const u32x2*)(G + pbase);
        }
#pragma unroll
        for (int u = 0; u < U; ++u) {
            const int t = NMETA + (c4 * U + u) * 32 + (tid >> 4);
            y[u][0] = __uint_as_float(yb2[u].x << 16); y[u][1] = __uint_as_float(yb2[u].x & 0xffff0000u); y[u][2] = __uint_as_float(yb2[u].y << 16); y[u][3] = __uint_as_float(yb2[u].y & 0xffff0000u);
            const float mean = reduce16((y[u][0] + y[u][1]) + (y[u][2] + y[u][3])) * (1.0f / 64.0f);
            const f32x4 dy = y[u] - mean;
            const float var = reduce16((dy[0] * dy[0] + dy[1] * dy[1]) + (dy[2] * dy[2] + dy[3] * dy[3])) * (1.0f / 64.0f);
            const float rs = rsqrtf(var + GN_EPS);
            float bs = 0.f;
#pragma unroll
            for (int j = 0; j < 4; ++j) bs += (float)r4[u][j] * (float)k4[u][j] * rk[j];
            bs = reduce16(bs);
            const float gg[4] = {__uint_as_float(g2[u].x << 16), __uint_as_float(g2[u].x & 0xffff0000u), __uint_as_float(g2[u].y << 16), __uint_as_float(g2[u].y & 0xffff0000u)};
            float o[4];
#pragma unroll
            for (int j = 0; j < 4; ++j) o[j] = (dy[j] * rs * gain[j] + bias[j] + bs * (float)v4[u][j]) * gg[j];
            u32x2 w; w.x = pk_bf16(o[0], o[1]); w.y = pk_bf16(o[2], o[3]);
            *(u32x2*)(orw + (size_t)(b * SEQ + t - NMETA) * 512 + c) = w;
        }
    }
}

__device__ __forceinline__ void phase4(const Params& p) {
    unsigned char* ws = p.ws;
    EpiBranch1 e1{(bf16_t*)(ws + O_T1), (const bf16_t*)p.out};
    EpiBranch2 e2{(const bf16_t*)(ws + O_T1), (const bf16_t*)p.out, (bf16_t*)(ws + O_M)};
    gemm_phase((const bf16_t*)(ws + O_OSB), (const bf16_t*)(ws + WS_WSB), 512, MS / BM, D / BM, e1);
    gemm_phase((const bf16_t*)(ws + O_ORW), (const bf16_t*)(ws + WS_WRW), 512, MS / BM, D / BM, e2);
}
__device__ __forceinline__ void phase5(const Params& p) {
    unsigned char* ws = p.ws;
    EpiBf16 e{(bf16_t*)(ws + O_P)};
    gemm_phase((const bf16_t*)(ws + O_M), (const bf16_t*)(ws + WS_WOUT), D, MS / BM, D / BM, e);
}
__device__ __forceinline__ void phase6(const Params& p) {
    unsigned char* ws = p.ws;
    const int lane = threadIdx.x & 63;
    f32x4 g1[4], g2[4];
#pragma unroll
    for (int j = 0; j < 4; ++j) { g1[j] = *(const f32x4*)(p.in[3] + 4 * lane + 256 * j); g2[j] = *(const f32x4*)(p.in[19] + 4 * lane + 256 * j); }
    for (int it = blockIdx.x; it < MS / 16; it += gridDim.x) {
        const int row0 = it * 16 + (threadIdx.x >> 6) * 2;
        f32x4 v[2][4], x[2][4];
#pragma unroll
        for (int r = 0; r < 2; ++r)
#pragma unroll
            for (int j = 0; j < 4; ++j) {
                { const u32x2 pb2 = *(const u32x2*)((const bf16_t*)(ws + O_P) + (size_t)(row0 + r) * D + 4 * lane + 256 * j);
                  v[r][j] = (f32x4){__uint_as_float(pb2.x << 16), __uint_as_float(pb2.x & 0xffff0000u), __uint_as_float(pb2.y << 16), __uint_as_float(pb2.y & 0xffff0000u)}; }
                x[r][j] = *(const f32x4*)(p.in[0] + (size_t)(row0 + r) * D + 4 * lane + 256 * j);
            }
#pragma unroll
        for (int r = 0; r < 2; ++r) {
            const int row = row0 + r;
            float ss = 0.f;
#pragma unroll
            for (int j = 0; j < 4; ++j) ss += (v[r][j][0] * v[r][j][0] + v[r][j][1] * v[r][j][1]) + (v[r][j][2] * v[r][j][2] + v[r][j][3] * v[r][j][3]);
            const float rs = rsqrtf(wave_sum(ss) * (1.0f / D) + RMS_EPS);
            float s2 = 0.f;
#pragma unroll
            for (int j = 0; j < 4; ++j) {
                v[r][j] = x[r][j] + v[r][j] * rs * g1[j];
                *(f32x4*)(p.out + (size_t)row * D + 4 * lane + 256 * j) = v[r][j];
                s2 += (v[r][j][0] * v[r][j][0] + v[r][j][1] * v[r][j][1]) + (v[r][j][2] * v[r][j][2] + v[r][j][3] * v[r][j][3]);
            }
            const float rs2 = rsqrtf(wave_sum(s2) * (1.0f / D) + RMS_EPS);
            bf16_t* fr_ = (bf16_t*)(ws + O_F) + (size_t)row * D;
#pragma unroll
            for (int j = 0; j < 4; ++j) {
                u32x2 w; w.x = pk_bf16(v[r][j][0] * rs2 * g2[j][0], v[r][j][1] * rs2 * g2[j][1]); w.y = pk_bf16(v[r][j][2] * rs2 * g2[j][2], v[r][j][3] * rs2 * g2[j][3]);
                *(u32x2*)(fr_ + 4 * lane + 256 * j) = w;
            }
        }
    }
}
__device__ __forceinline__ void phase7(const Params& p) {
    unsigned char* ws = p.ws;
    EpiGU e{(bf16_t*)(ws + O_ACT)};
    gemm_phase((const bf16_t*)(ws + O_F), (const bf16_t*)(ws + WS_WGU), D, MS / BM, 2 * DFF / BM, e);
}
__device__ __forceinline__ void phase8(const Params& p) {
    unsigned char* ws = p.ws;
    EpiBf16 e{(bf16_t*)(ws + O_DN)};
    gemm_phase((const bf16_t*)(ws + O_ACT), (const bf16_t*)(ws + WS_WD), DFF, MS / BM, D / BM, e);
}
__device__ __forceinline__ void phase9(const Params& p) {
    unsigned char* ws = p.ws;
    const int lane = threadIdx.x & 63;
    f32x4 g[4];
#pragma unroll
    for (int j = 0; j < 4; ++j) g[j] = *(const f32x4*)(p.in[20] + 4 * lane + 256 * j);
    for (int it = blockIdx.x; it < MS / 16; it += gridDim.x) {
        const int row0 = it * 16 + (threadIdx.x >> 6) * 2;
        f32x4 v[2][4], h1[2][4];
#pragma unroll
        for (int r = 0; r < 2; ++r)
#pragma unroll
            for (int j = 0; j < 4; ++j) {
                { const u32x2 db2 = *(const u32x2*)((const bf16_t*)(ws + O_DN) + (size_t)(row0 + r) * D + 4 * lane + 256 * j);
                  v[r][j] = (f32x4){__uint_as_float(db2.x << 16), __uint_as_float(db2.x & 0xffff0000u), __uint_as_float(db2.y << 16), __uint_as_float(db2.y & 0xffff0000u)}; }
                h1[r][j] = *(const f32x4*)(p.out + (size_t)(row0 + r) * D + 4 * lane + 256 * j);
            }
#pragma unroll
        for (int r = 0; r < 2; ++r) {
            float ss = 0.f;
#pragma unroll
            for (int j = 0; j < 4; ++j) ss += (v[r][j][0] * v[r][j][0] + v[r][j][1] * v[r][j][1]) + (v[r][j][2] * v[r][j][2] + v[r][j][3] * v[r][j][3]);
            const float rs = rsqrtf(wave_sum(ss) * (1.0f / D) + RMS_EPS);
#pragma unroll
            for (int j = 0; j < 4; ++j) *(f32x4*)(p.out + (size_t)(row0 + r) * D + 4 * lane + 256 * j) = h1[r][j] + v[r][j] * rs * g[j];
        }
    }
}

constexpr int N_PHASES = 11;
__device__ __forceinline__ void run_phase(const Params& p, int ph) {
    switch (ph) {
        case 0: phase0(p); break;
        case 1: phase1(p); break;
        case 2: phase2(p); break;
        case 3: phase3(p); break;
        case 4: phase3c(p); break;
        case 5: phase4(p); break;
        case 6: phase5(p); break;
        case 7: phase6(p); break;
        case 8: phase7(p); break;
        case 9: phase8(p); break;
        default: phase9(p); break;
    }
}

#if MULTI_LAUNCH
template <int PH> __global__ void __launch_bounds__(512) fwd_phase(Params p) { run_phase(p, PH); }
#else
__global__ void __launch_bounds__(512) fwd_mega(Params p) {
    cg::grid_group grid = cg::this_grid();
    volatile LAS unsigned* st = (volatile LAS unsigned*)(smem + 131072);
    if (threadIdx.x == 0) { st[0] = 0u; st[1] = 0u; }
    __syncthreads();
    const XcdBarrier xb = xcd_barrier_post((unsigned*)(p.ws + WS_BAR), st);
    if (p.out == nullptr) grid.sync();
    phase0(p); xcd_barrier(xb); phase1(p); xcd_barrier(xb); phase2(p); xcd_barrier(xb); phase3(p); xcd_barrier(xb); phase3c(p); xcd_barrier(xb);
    phase4(p); xcd_barrier(xb); phase5(p); xcd_barrier(xb); phase6(p); xcd_barrier(xb); phase7(p); xcd_barrier(xb); phase8(p); xcd_barrier(xb); phase9(p);
}
#endif

extern "C" void kernel_launch(void* const* d_in, const int* in_sizes, int n_in, void* d_out, int out_size, void* d_ws, size_t ws_size, hipStream_t stream) {
    static int grid = 0;
    if (grid == 0) {
        if (n_in != 24 || out_size != MS * D || ws_size < WS_END) { fprintf(stderr, "kernel_launch: unexpected shapes (n_in %d out %d ws %zu need %zu)\n", n_in, out_size, ws_size, (size_t)WS_END); grid = -1; return; }
        int dev = 0, cus = 0, per_cu = 0;
        (void)hipGetDevice(&dev);
        (void)hipDeviceGetAttribute(&cus, hipDeviceAttributeMultiprocessorCount, dev);
#if MULTI_LAUNCH
        per_cu = 1;
#else
        (void)hipFuncSetAttribute((const void*)fwd_mega, hipFuncAttributeMaxDynamicSharedMemorySize, LDS_BYTES);
        (void)hipOccupancyMaxActiveBlocksPerMultiprocessor(&per_cu, (const void*)fwd_mega, 512, LDS_BYTES);
        if (per_cu < 1) { fprintf(stderr, "kernel_launch: occupancy query says %d blocks per CU\n", per_cu); per_cu = 1; }
        if (per_cu > 1) per_cu = 1;
#endif
        grid = cus * per_cu;
        if (grid <= N_SCAN) { fprintf(stderr, "kernel_launch: grid %d too small (needs more than %d workgroups)\n", grid, N_SCAN); grid = -1; return; }
    }
    if (grid < 0) return;
    Params p{};
    for (int i = 0; i < 24; ++i) p.in[i] = (const float*)d_in[i];
    p.out = (float*)d_out; p.ws = (unsigned char*)d_ws;
#if MULTI_LAUNCH
#define LP(PH) do { (void)hipFuncSetAttribute((const void*)fwd_phase<PH>, hipFuncAttributeMaxDynamicSharedMemorySize, LDS_BYTES); hipLaunchKernelGGL(fwd_phase<PH>, dim3(grid), dim3(512), LDS_BYTES, stream, p); } while (0)
    LP(0); LP(1); LP(2); LP(3); LP(4); LP(5); LP(6); LP(7); LP(8); LP(9); LP(10);
#undef LP
#else
    if (hipMemsetAsync(d_ws, 0, WS_CTL_BYTES, stream) != hipSuccess) { fprintf(stderr, "kernel_launch: hipMemsetAsync of the control words failed\n"); return; }
    void* args[] = {&p};
    hipError_t e = hipLaunchCooperativeKernel((const void*)fwd_mega, dim3(grid), dim3(512), args, LDS_BYTES, stream);
    if (e != hipSuccess) fprintf(stderr, "cooperative launch failed: %s (grid %d)\n", hipGetErrorString(e), grid);
#endif
}
```

```cpp
#include <hip/hip_runtime.h>
#include <hip/hip_cooperative_groups.h>
#include <cstdio>
#include <cstdint>
#include <type_traits>
namespace cg = cooperative_groups;

#ifndef MULTI_LAUNCH
#define MULTI_LAUNCH 0
#endif

typedef unsigned short bf16_t;
typedef short bf16x8 __attribute__((ext_vector_type(8)));
typedef float f32x4 __attribute__((ext_vector_type(4)));
typedef float f32x2 __attribute__((ext_vector_type(2)));
typedef unsigned u32x2 __attribute__((ext_vector_type(2)));
typedef unsigned u32x4 __attribute__((ext_vector_type(4)));
typedef _Float16 h16x2 __attribute__((ext_vector_type(2)));
typedef _Float16 h16x4 __attribute__((ext_vector_type(4)));
typedef _Float16 h16x8 __attribute__((ext_vector_type(8)));

constexpr int D = 1024, NB = 4, SEQ = 8192, NMETA = 16, T = SEQ + NMETA, TP = 8320, MP = NB * TP, MS = NB * SEQ;
constexpr int PIN = 5376, DFF = 2816, NH = 8, RWS = 1792;
constexpr float RMS_EPS = 1e-6f, GN_EPS = 64e-5f;

constexpr size_t WS_CTL = 0;
constexpr size_t WS_BAR = 4096;
constexpr size_t WS_CTL_BYTES = 32768;
constexpr size_t WS_WIN = WS_CTL_BYTES;
constexpr size_t WS_WSB = WS_WIN + (size_t)PIN * D * 2;
constexpr size_t WS_WRW = WS_WSB + (size_t)D * 512 * 2;
constexpr size_t WS_WOUT = WS_WRW + (size_t)D * 512 * 2;
constexpr size_t WS_WGU = WS_WOUT + (size_t)D * D * 2;
constexpr size_t WS_WD = WS_WGU + (size_t)2 * DFF * D * 2;
constexpr size_t WS_WL = WS_WD + (size_t)D * DFF * 2;
constexpr size_t R_A0 = WS_WL + (size_t)512 * 256 * 2;
constexpr size_t R_URW = R_A0 + (size_t)MP * D * 2;
constexpr size_t R_QKV = R_URW;
constexpr size_t QKV_ONE = (size_t)MP * 512 * 2;
constexpr size_t R_SI = R_URW + (size_t)MP * RWS * 2;
constexpr size_t SI_ONE = (size_t)MP * 512 * 2;
constexpr size_t R_G = R_SI + 6 * SI_ONE;
constexpr size_t R_TAIL = R_G + SI_ONE;
constexpr size_t O_Y = R_TAIL;
constexpr size_t O_OSB = R_TAIL + SI_ONE;
constexpr size_t WS_END = O_OSB + (size_t)MS * 512 * 2;
constexpr size_t O_A0 = R_A0;
constexpr size_t O_ORW = R_A0;
constexpr size_t O_T1 = R_SI;
constexpr size_t O_M = R_SI + (size_t)MS * D * 4;
constexpr size_t O_P = R_A0;
constexpr size_t O_F = R_SI;
constexpr size_t O_ACT = R_A0;
constexpr size_t O_DN = R_SI + (size_t)MS * D * 2;
static_assert(3 * QKV_ONE <= (size_t)MP * RWS * 2, "overlay");
static_assert(O_M + (size_t)MS * D * 2 <= R_TAIL, "overlay");
static_assert(O_ACT + (size_t)MS * DFF * 2 <= R_SI, "overlay");
static_assert(O_P + (size_t)MS * D * 4 <= R_SI, "overlay");
static_assert(O_DN + (size_t)MS * D * 4 <= R_TAIL, "overlay");
static_assert(WS_END <= (size_t)512 * 1024 * 1024, "workspace");

constexpr int LDS_BYTES = 131072 + 64;

struct Params { const float* in[24]; float* out; unsigned char* ws; };

extern __shared__ __attribute__((aligned(16))) unsigned char smem[];

typedef __bf16 b16x2 __attribute__((ext_vector_type(2)));
__device__ __forceinline__ unsigned pk_bf16(float lo, float hi) { const f32x2 v = {lo, hi}; return __builtin_bit_cast(unsigned, __builtin_convertvector(v, b16x2)); }
__device__ __forceinline__ float bf2f(unsigned short v) { return __uint_as_float((unsigned)v << 16); }
__device__ __forceinline__ float sigmoidf_(float x) { return __builtin_amdgcn_rcpf(1.0f + __expf(-x)); }
__device__ __forceinline__ float softplusf_(float x) { return fmaxf(x, 0.f) + __logf(1.0f + __expf(-fabsf(x))); }
template <int CTRL> __device__ __forceinline__ float dppf(float x) { return __builtin_bit_cast(float, __builtin_amdgcn_mov_dpp(__builtin_bit_cast(int, x), CTRL, 0xf, 0xf, true)); }
__device__ __forceinline__ float reduce16(float v) {
    v += dppf<0xB1>(v); v += dppf<0x4E>(v); v += dppf<0x141>(v); v += dppf<0x140>(v); return v;
}
__device__ __forceinline__ float wave_sum(float v) {
#pragma unroll
    for (int o = 1; o < 64; o <<= 1) v += __shfl_xor(v, o);
    return v;
}

#define LAS __attribute__((address_space(3)))
#define XB_TMO      128
#define XB_XCNT(j)  (256  + 64 * (j))
#define XB_XSUB(j)  (1280 + 64 * (j))
#define XB_XGEN(j)  (2304 + 64 * (j))
#define XB_TOP      3328
#define XB_TOPGEN   3392
#define XCD_BAR_WORDS 3456
#define XB_SPIN_CAP (1u << 18)
__device__ __forceinline__ unsigned xb_ld(unsigned* p)              { return __hip_atomic_load(p, __ATOMIC_RELAXED, __HIP_MEMORY_SCOPE_AGENT); }
__device__ __forceinline__ unsigned xb_add(unsigned* p, unsigned v) { return __hip_atomic_fetch_add(p, v, __ATOMIC_RELAXED, __HIP_MEMORY_SCOPE_AGENT); }
__device__ __forceinline__ unsigned xb_xcc_id() { return (unsigned)__builtin_amdgcn_s_getreg((3 << 11) | 20) & 0xFu; }
#define XB_SPIN(cond, bar) do { unsigned _sp = 0; while (cond) { __builtin_amdgcn_s_sleep(1); \
    if ((++_sp & 255u) == 0u) { if (xb_ld(&(bar)[XB_TMO])) break; if (_sp > XB_SPIN_CAP) { atomicAdd(&(bar)[XB_TMO], 1u); break; } } } } while (0)
struct XcdBarrier { unsigned* bar; unsigned x; volatile LAS unsigned* st; };
__device__ __forceinline__ XcdBarrier xcd_barrier_post(unsigned* bar, volatile LAS unsigned* st) {
    XcdBarrier b; b.bar = bar; b.x = xb_xcc_id(); b.st = st;
    if (threadIdx.x == 0) (void)xb_add(&bar[XB_XCNT(b.x)], 1u);
    return b;
}
__device__ __forceinline__ void xcd_barrier_complete(unsigned* bar, unsigned x, unsigned& nloc, unsigned& nx) {
    const unsigned G = gridDim.x * gridDim.y * gridDim.z;
    unsigned sum, cnt, mine, sp = 0u;
    for (;;) {
        sum = 0u; cnt = 0u; mine = 0u;
#pragma unroll
        for (unsigned j = 0; j < 16; ++j) { const unsigned c = xb_ld(&bar[XB_XCNT(j)]); sum += c; cnt += (c > 0u) ? 1u : 0u; mine = (j == x) ? c : mine; }
        if (sum == G) break;
        __builtin_amdgcn_s_sleep(1);
        if ((++sp & 255u) == 0u) { if (xb_ld(&bar[XB_TMO])) break; if (sp > XB_SPIN_CAP) { atomicAdd(&bar[XB_TMO], 1u); break; } }
    }
    nloc = mine > 0u ? mine : 1u; nx = cnt > 0u ? cnt : 1u;
}
__device__ __forceinline__ void xcd_barrier(const XcdBarrier& b) {
    asm volatile("s_waitcnt vmcnt(0)" ::: "memory");
    __syncthreads();
    if (threadIdx.x == 0) {
        unsigned* bar = b.bar;
        __builtin_amdgcn_s_waitcnt(0);
        unsigned nloc = b.st[0], nx = b.st[1];
        if (nloc == 0u) { xcd_barrier_complete(bar, b.x, nloc, nx); b.st[0] = nloc; b.st[1] = nx; }
        const unsigned old = xb_add(&bar[XB_XSUB(b.x)], 1u);
        const unsigned gen = old / nloc;
        if (old + 1u == (gen + 1u) * nloc) {
            __builtin_amdgcn_fence(__ATOMIC_RELEASE, "agent");
            asm volatile("s_waitcnt vmcnt(0)" ::: "memory");
            const unsigned og = xb_add(&bar[XB_TOP], 1u);
            const unsigned tg = og / nx;
            if (og + 1u == (tg + 1u) * nx) xb_add(&bar[XB_TOPGEN], 1u);
            else XB_SPIN(xb_ld(&bar[XB_TOPGEN]) == tg, bar);
            __builtin_amdgcn_fence(__ATOMIC_ACQUIRE, "agent");
            xb_add(&bar[XB_XGEN(b.x)], 1u);
            asm volatile("s_waitcnt vmcnt(0)" ::: "memory");
        } else {
            XB_SPIN(xb_ld(&bar[XB_XGEN(b.x)]) == gen, bar);
            __builtin_amdgcn_fence(__ATOMIC_ACQUIRE, "agent");
            asm volatile("s_waitcnt vmcnt(0)" ::: "memory");
        }
    }
    __syncthreads();
}

constexpr int BM = 256, BK = 64, HALF = 128, HTB = HALF * BK * 2, NXCD = 8, WGM = 8;
__device__ __forceinline__ int lds_byte(int r, int c) { const int st = (r >> 4) * 2 + (c >> 5), rr = r & 15, cc = c & 31, ob = rr * 64 + cc * 2; return st * 1024 + (ob ^ (((ob >> 9) & 1) << 5)); }
__device__ __forceinline__ void stage_rc(int b, int& R, int& C) { const int st = b / 1024, sb = b % 1024, swz = sb ^ (((sb >> 9) & 1) << 5); R = (st >> 1) * 16 + swz / 64; C = (st & 1) * 32 + (swz % 64) / 2; }
struct Unit { int pm, pn; };
struct Sched {
    int nM, nN, nwg, G, c;
    __device__ __forceinline__ bool next(int i, Unit& u) const {
        const long L = (long)i * G + c; if (L >= nwg) return false;
        int wgid = (int)L; { const int q = nwg / NXCD, r = nwg % NXCD, xcd = wgid % NXCD, off = wgid / NXCD; wgid = (xcd < r ? xcd * (q + 1) : r * (q + 1) + (xcd - r) * q) + off; }
        const int nig = WGM * nN, gid = wgid / nig, fm = gid * WGM, gsz = (nM - fm) < WGM ? (nM - fm) : WGM;
        u.pm = fm + ((wgid % nig) % gsz); u.pn = (wgid % nig) / gsz; return true;
    }
};

template <class Epi>
__device__ __forceinline__ void gemm_phase(const bf16_t* __restrict__ Ag, const bf16_t* __restrict__ Btg, const int K, const int nM, const int nN, const Epi& E,
                                           const int G = (int)gridDim.x, const int c = (int)blockIdx.x, const int pn_from = 1 << 30, const int pn_add = 0) {
    LAS unsigned char* lds = (LAS unsigned char*)smem;
    const int tid = threadIdx.x, wid = __builtin_amdgcn_readfirstlane(tid >> 6), lane = tid & 63, wr = wid >> 2, wc = wid & 3, fr = lane & 15, fq = lane >> 4;
    const int nt = K / BK;
    Sched S; S.nM = nM; S.nN = nN; S.nwg = nM * nN; S.G = G; S.c = c;
    unsigned voffA[2], voffB[2];
#pragma unroll
    for (int i = 0; i < 2; ++i) { int R, C; stage_rc(tid * 16 + i * 8192, R, C);
        const int Rb = Epi::PERM ? ((R & ~31) + 8 * ((R & 15) >> 2) + 4 * ((R & 31) >> 4) + (R & 3)) : R;
        voffA[i] = (unsigned)(R * K + C) * 2u; voffB[i] = (unsigned)(Rb * K + C) * 2u; }
    const size_t kstep = (size_t)(BK * 2);
    const size_t hstep = (size_t)HALF * K * 2;
    const size_t tstep = 2 * hstep;
    const unsigned ldsw = (unsigned)wid * 1024u;
    const int aoff = lds_byte(wr * 64 + fr, fq * 8), boff = lds_byte(wc * 32 + fr, fq * 8);
#define PG8_SA(b, h) (((b) * 2 + (h)) * HTB)
#define PG8_SB(b, h) ((4 + (b) * 2 + (h)) * HTB)
#define PG8_STAGE(bufoff, gbase, voff) do { _Pragma("unroll") for (int _i = 0; _i < 2; ++_i) \
        __builtin_amdgcn_global_load_lds((const unsigned*)((const char*)(gbase) + (voff)[_i]), (LAS unsigned*)(lds + (bufoff) + ldsw + _i * 8192), 16, 0, 0); } while (0)
#define PG8_LDA(dst, b, h) do { _Pragma("unroll") for (int m = 0; m < 4; ++m) _Pragma("unroll") for (int k = 0; k < 2; ++k) dst[m][k] = *(const LAS bf16x8*)(lds + PG8_SA(b, h) + aoff + m * 2048 + k * 1024); } while (0)
#define PG8_LDB(dst, b, h) do { _Pragma("unroll") for (int n = 0; n < 2; ++n) _Pragma("unroll") for (int k = 0; k < 2; ++k) dst[n][k] = *(const LAS bf16x8*)(lds + PG8_SB(b, h) + boff + n * 2048 + k * 1024); } while (0)
#define PG8_MMA(ai, bj, At, Bt) do { __builtin_amdgcn_s_setprio(1); _Pragma("unroll") for (int m = 0; m < 4; ++m) _Pragma("unroll") for (int n = 0; n < 2; ++n) _Pragma("unroll") for (int k = 0; k < 2; ++k) \
        acc[ai][bj][m][n] = __builtin_amdgcn_mfma_f32_16x16x32_bf16(Bt[n][k], At[m][k], acc[ai][bj][m][n], 0, 0, 0); __builtin_amdgcn_s_setprio(0); } while (0)
#define PG8_WAIT_V(n) asm volatile("s_waitcnt vmcnt(" #n ")" ::: "memory")
#define PG8_WAIT_L(n) asm volatile("s_waitcnt lgkmcnt(" #n ")" ::: "memory")
#define PG8_BAR __builtin_amdgcn_s_barrier()
#define PG8_SCHED __builtin_amdgcn_sched_barrier(0)
    Unit cur, nxt; int ui = 0;
    __syncthreads();
    if (!S.next(0, cur)) return;
    if (cur.pn >= pn_from) cur.pn += pn_add;
    f32x4 acc[2][2][4][2];
#pragma unroll
    for (int a = 0; a < 2; ++a)
#pragma unroll
        for (int b = 0; b < 2; ++b)
#pragma unroll
            for (int m = 0; m < 4; ++m)
#pragma unroll
                for (int n = 0; n < 2; ++n) acc[a][b][m][n] = (f32x4){0.f, 0.f, 0.f, 0.f};
    bf16x8 At[4][2], B0[2][2], B1[2][2];
    const char* cA = (const char*)Ag + (size_t)cur.pm * tstep; const char* cB = (const char*)Btg + (size_t)cur.pn * tstep;
    PG8_STAGE(PG8_SB(0, 0), cB, voffB); PG8_STAGE(PG8_SB(0, 1), cB + hstep, voffB); PG8_STAGE(PG8_SA(0, 0), cA, voffA); PG8_STAGE(PG8_SA(0, 1), cA + hstep, voffA);
    if (wr == 1) PG8_BAR;
    PG8_WAIT_V(2); PG8_BAR;
    PG8_STAGE(PG8_SB(1, 0), cB + kstep, voffB); PG8_STAGE(PG8_SA(1, 0), cA + kstep, voffA); PG8_STAGE(PG8_SB(1, 1), cB + hstep + kstep, voffB);
    PG8_WAIT_V(6); PG8_BAR;
    for (;;) {
        const bool has_next = S.next(ui + 1, nxt);
        if (has_next && nxt.pn >= pn_from) nxt.pn += pn_add;
        const char* nA = has_next ? (const char*)Ag + (size_t)nxt.pm * tstep : cA; const char* nB = has_next ? (const char*)Btg + (size_t)nxt.pn * tstep : cB;
        for (int t = 0; t < nt; t += 2) {
            const bool last = (t == nt - 2);
            const char* a1 = cA + (size_t)(t + 1) * kstep;
            const char* a2 = last ? nA : cA + (size_t)(t + 2) * kstep; const char* b2 = last ? nB : cB + (size_t)(t + 2) * kstep;
            const char* a3 = a2 + kstep; const char* b3 = b2 + kstep;
            PG8_LDB(B0, 0, 0); PG8_LDB(B1, 0, 1); PG8_SCHED; PG8_LDA(At, 0, 0); PG8_STAGE(PG8_SA(1, 1), a1 + hstep, voffA);
            PG8_WAIT_V(8); PG8_WAIT_L(0); PG8_BAR; PG8_MMA(0, 0, At, B0); PG8_MMA(0, 1, At, B1); PG8_BAR; PG8_SCHED;
            PG8_LDA(At, 0, 1); PG8_STAGE(PG8_SB(0, 0), b2, voffB); PG8_STAGE(PG8_SB(0, 1), b2 + hstep, voffB); PG8_STAGE(PG8_SA(0, 0), a2, voffA);
            PG8_WAIT_V(8); PG8_WAIT_L(0); PG8_BAR; PG8_MMA(1, 0, At, B0); PG8_MMA(1, 1, At, B1); PG8_BAR; PG8_SCHED;
            PG8_LDB(B0, 1, 0); PG8_LDB(B1, 1, 1); PG8_SCHED; PG8_LDA(At, 1, 0); PG8_STAGE(PG8_SA(0, 1), a2 + hstep, voffA);
            PG8_WAIT_V(8); PG8_WAIT_L(0); PG8_BAR; PG8_MMA(0, 0, At, B0); PG8_MMA(0, 1, At, B1); PG8_BAR; PG8_SCHED;
            PG8_LDA(At, 1, 1); PG8_STAGE(PG8_SB(1, 0), b3, voffB); PG8_STAGE(PG8_SB(1, 1), b3 + hstep, voffB); PG8_STAGE(PG8_SA(1, 0), a3, voffA);
            PG8_WAIT_V(8); PG8_WAIT_L(0); PG8_BAR; PG8_MMA(1, 0, At, B0); PG8_MMA(1, 1, At, B1); PG8_BAR; PG8_SCHED;
        }
        if (wr == 0) PG8_BAR;
        {
            const int brow = cur.pm * BM, bcol = cur.pn * BM;
#pragma unroll
            for (int ai = 0; ai < 2; ++ai)
#pragma unroll
                for (int m = 0; m < 4; ++m) {
                    E.row(brow + ai * HALF + wr * 64 + m * 16 + fr, bcol + wc * 32, fq, acc[ai][0][m][0], acc[ai][0][m][1], acc[ai][1][m][0], acc[ai][1][m][1]);
                    asm volatile("" ::: "memory");
                }
        }
        if (!has_next) break;
#pragma unroll
        for (int a = 0; a < 2; ++a)
#pragma unroll
            for (int b = 0; b < 2; ++b)
#pragma unroll
                for (int m = 0; m < 4; ++m)
#pragma unroll
                    for (int n = 0; n < 2; ++n) acc[a][b][m][n] = (f32x4){0.f, 0.f, 0.f, 0.f};
        cur = nxt; cA = nA; cB = nB; ++ui;
        if (wr == 1) PG8_BAR;
    }
    PG8_WAIT_V(0);
    PG8_BAR;
#undef PG8_SA
#undef PG8_SB
#undef PG8_STAGE
#undef PG8_LDA
#undef PG8_LDB
#undef PG8_MMA
#undef PG8_WAIT_V
#undef PG8_WAIT_L
#undef PG8_BAR
#undef PG8_SCHED
}

template <bool PERM_> struct EpiInProj {
    static constexpr bool PERM = PERM_;
    bf16_t* qkv; _Float16* urw; bf16_t* gates;
    __device__ __forceinline__ void one(int row, int col, const f32x4& v) const {
        if (col < 1536) {
            const int which = col >> 9, hc = col & 511, h = hc >> 6, d = hc & 63, b = row / TP, t = row - b * TP;
            const float s = which == 0 ? 0.125f : 1.0f;
            u32x2 w; w.x = pk_bf16(v[0] * s, v[1] * s); w.y = pk_bf16(v[2] * s, v[3] * s);
            *(u32x2*)(qkv + (size_t)which * (QKV_ONE / 2) + ((size_t)(b * NH + h) * TP + t) * 64 + d) = w;
        } else if (col < 3328) {
            h16x4 o; o[0] = (_Float16)v[0]; o[1] = (_Float16)v[1]; o[2] = (_Float16)v[2]; o[3] = (_Float16)v[3];
            *(h16x4*)(urw + (size_t)row * RWS + (col - 1536)) = o;
        } else {
            const int b = row / TP, t = row - b * TP;
            if (t >= NMETA && t < T) {
                u32x2 w; w.x = pk_bf16(sigmoidf_(v[0]), sigmoidf_(v[1])); w.y = pk_bf16(sigmoidf_(v[2]), sigmoidf_(v[3]));
                *(u32x2*)(gates + (size_t)(b * SEQ + t - NMETA) * 2048 + (col - 3328)) = w;
            }
        }
    }
    __device__ __forceinline__ void half(int row, int col32, int fq, const f32x4& v0, const f32x4& v1) const {
        if constexpr (PERM_) {
            const int col = col32 + 8 * fq, b = row / TP, t = row - b * TP;
            if (col < 1536) {
                const int which = col >> 9, hc = col & 511, h = hc >> 6, d = hc & 63;
                const float s = which == 0 ? 0.125f : 1.0f;
                u32x4 w; w.x = pk_bf16(v0[0] * s, v0[1] * s); w.y = pk_bf16(v0[2] * s, v0[3] * s); w.z = pk_bf16(v1[0] * s, v1[1] * s); w.w = pk_bf16(v1[2] * s, v1[3] * s);
                *(u32x4*)(qkv + (size_t)which * (QKV_ONE / 2) + ((size_t)(b * NH + h) * TP + t) * 64 + d) = w;
            } else if (t >= NMETA && t < T) {
                u32x4 w; w.x = pk_bf16(sigmoidf_(v0[0]), sigmoidf_(v0[1])); w.y = pk_bf16(sigmoidf_(v0[2]), sigmoidf_(v0[3]));
                w.z = pk_bf16(sigmoidf_(v1[0]), sigmoidf_(v1[1])); w.w = pk_bf16(sigmoidf_(v1[2]), sigmoidf_(v1[3]));
                *(u32x4*)(gates + (size_t)(b * SEQ + t - NMETA) * 2048 + (col - 3328)) = w;
            }
        } else {
            if (col32 >= 1536 && col32 < 3072) {
                const int c = col32 - 1536, pos = (c & ~63) + fq * 16 + ((c & 63) >> 4) * 4;
                h16x8 o;
#pragma unroll
                for (int j = 0; j < 4; ++j) { o[j] = (_Float16)v0[j]; o[4 + j] = (_Float16)v1[j]; }
                *(h16x8*)(urw + (size_t)row * RWS + pos) = o;
            } else { one(row, col32 + 4 * fq, v0); one(row, col32 + 16 + 4 * fq, v1); }
        }
    }
    __device__ __forceinline__ void row(int r, int col32, int fq, const f32x4& a00, const f32x4& a01, const f32x4& a10, const f32x4& a11) const { half(r, col32, fq, a00, a01); half(r, col32 + HALF, fq, a10, a11); }
};
__device__ __forceinline__ void bf8_to_f(const u32x4& g, float (&f)[8]) {
#pragma unroll
    for (int i = 0; i < 4; ++i) { f[2 * i] = __uint_as_float(g[i] << 16); f[2 * i + 1] = __uint_as_float(g[i] & 0xffff0000u); }
}
struct EpiBranch1 {
    static constexpr bool PERM = true;
    bf16_t* t1; const bf16_t* gates;
    __device__ __forceinline__ void half(int row, int col32, int fq, const f32x4& v0, const f32x4& v1) const {
        const int col = col32 + 8 * fq;
        float g[8]; bf8_to_f(*(const u32x4*)(gates + (size_t)row * 2048 + col), g);
        u32x4 w; w.x = pk_bf16(v0[0] * g[0], v0[1] * g[1]); w.y = pk_bf16(v0[2] * g[2], v0[3] * g[3]); w.z = pk_bf16(v1[0] * g[4], v1[1] * g[5]); w.w = pk_bf16(v1[2] * g[6], v1[3] * g[7]);
        *(u32x4*)(t1 + (size_t)row * D + col) = w;
    }
    __device__ __forceinline__ void row(int r, int col32, int fq, const f32x4& a00, const f32x4& a01, const f32x4& a10, const f32x4& a11) const { half(r, col32, fq, a00, a01); half(r, col32 + HALF, fq, a10, a11); }
};
struct EpiBranch2 {
    static constexpr bool PERM = true;
    const bf16_t* t1; const bf16_t* gates; bf16_t* m;
    __device__ __forceinline__ void half(int row, int col32, int fq, const f32x4& v0, const f32x4& v1) const {
        const int col = col32 + 8 * fq;
        float g[8], a[8]; bf8_to_f(*(const u32x4*)(gates + (size_t)row * 2048 + 1024 + col), g); bf8_to_f(*(const u32x4*)(t1 + (size_t)row * D + col), a);
        u32x4 w; w.x = pk_bf16(a[0] + v0[0] * g[0], a[1] + v0[1] * g[1]); w.y = pk_bf16(a[2] + v0[2] * g[2], a[3] + v0[3] * g[3]);
        w.z = pk_bf16(a[4] + v1[0] * g[4], a[5] + v1[1] * g[5]); w.w = pk_bf16(a[6] + v1[2] * g[6], a[7] + v1[3] * g[7]);
        *(u32x4*)(m + (size_t)row * D + col) = w;
    }
    __device__ __forceinline__ void row(int r, int col32, int fq, const f32x4& a00, const f32x4& a01, const f32x4& a10, const f32x4& a11) const { half(r, col32, fq, a00, a01); half(r, col32 + HALF, fq, a10, a11); }
};
struct EpiF32 {
    static constexpr bool PERM = true;
    float* o;
    __device__ __forceinline__ void row(int r, int col32, int fq, const f32x4& a00, const f32x4& a01, const f32x4& a10, const f32x4& a11) const {
        float* q = o + (size_t)r * D + col32 + 8 * fq;
        *(f32x4*)q = a00; *(f32x4*)(q + 4) = a01; *(f32x4*)(q + HALF) = a10; *(f32x4*)(q + HALF + 4) = a11;
    }
};
struct EpiBf16 {
    static constexpr bool PERM = true;
    bf16_t* o;
    __device__ __forceinline__ void row(int r, int col32, int fq, const f32x4& a00, const f32x4& a01, const f32x4& a10, const f32x4& a11) const {
        bf16_t* q = o + (size_t)r * D + col32 + 8 * fq;
        u32x4 w0, w1;
        w0.x = pk_bf16(a00[0], a00[1]); w0.y = pk_bf16(a00[2], a00[3]); w0.z = pk_bf16(a01[0], a01[1]); w0.w = pk_bf16(a01[2], a01[3]);
        w1.x = pk_bf16(a10[0], a10[1]); w1.y = pk_bf16(a10[2], a10[3]); w1.z = pk_bf16(a11[0], a11[1]); w1.w = pk_bf16(a11[2], a11[3]);
        *(u32x4*)q = w0; *(u32x4*)(q + HALF) = w1;
    }
};
struct EpiGU {
    static constexpr bool PERM = true;
    bf16_t* act;
    __device__ __forceinline__ void row(int r, int col32, int fq, const f32x4& g0, const f32x4& g1, const f32x4& u0, const f32x4& u1) const {
        float o[8];
#pragma unroll
        for (int j = 0; j < 4; ++j) { o[j] = g0[j] * sigmoidf_(g0[j]) * u0[j]; o[4 + j] = g1[j] * sigmoidf_(g1[j]) * u1[j]; }
        u32x4 w; w.x = pk_bf16(o[0], o[1]); w.y = pk_bf16(o[2], o[3]); w.z = pk_bf16(o[4], o[5]); w.w = pk_bf16(o[6], o[7]);
        const int pn = col32 >> 8, cin = (col32 & 255) + 8 * fq;
        *(u32x4*)(act + (size_t)r * DFF + pn * 128 + cin) = w;
    }
};

__device__ __forceinline__ void transpose_tile(const float* __restrict__ src, int K, int N, bf16_t* __restrict__ dst, int ldd, int koff, int mode, int tile) {
    float* scr = (float*)smem;
    const int ntn = N / 128, kb = tile / ntn, nb = tile % ntn, k0 = kb * 64, n0 = nb * 128, tid = threadIdx.x;
    f32x4 v[4];
#pragma unroll
    for (int i = 0; i < 4; ++i) { const int idx = tid + 512 * i, kk = idx >> 5, n4 = idx & 31; v[i] = *(const f32x4*)(src + (size_t)(k0 + kk) * N + n0 + n4 * 4); }
#pragma unroll
    for (int i = 0; i < 4; ++i) { const int idx = tid + 512 * i, kk = idx >> 5, n4 = idx & 31;
#pragma unroll
        for (int c = 0; c < 4; ++c) scr[kk * 129 + n4 * 4 + c] = v[i][c]; }
    __syncthreads();
#pragma unroll
    for (int i = 0; i < 2; ++i) {
        const int o = tid + 512 * i, n = o >> 3, kc = (o & 7) * 8;
        u32x4 w;
        w.x = pk_bf16(scr[(kc + 0) * 129 + n], scr[(kc + 1) * 129 + n]); w.y = pk_bf16(scr[(kc + 2) * 129 + n], scr[(kc + 3) * 129 + n]);
        w.z = pk_bf16(scr[(kc + 4) * 129 + n], scr[(kc + 5) * 129 + n]); w.w = pk_bf16(scr[(kc + 6) * 129 + n], scr[(kc + 7) * 129 + n]);
        const int f = n0 + n;
        const int drow = mode == 0 ? f : ((f >> 7) * 256 + (mode == 2 ? 128 : 0) + (f & 127));
        *(u32x4*)(dst + (size_t)drow * ldd + koff + k0 + kc) = w;
    }
    __syncthreads();
}

__device__ __forceinline__ void phase0(const Params& p) {
    unsigned char* ws = p.ws;
    if (blockIdx.x == 0 && threadIdx.x < 64) ((unsigned*)(ws + WS_CTL))[threadIdx.x] = 0u;
    constexpr int J0 = 16 * 42, J1 = 8 * 8, J3 = 16 * 8, J4 = 16 * 22, J6 = 44 * 8, J7 = 4, J9 = 8;
    constexpr int NT = J0 + 2 * J1 + J3 + 2 * J4 + J6 + 2 * J7 + J9;
    constexpr int NR = MP / 32;
    for (int it = blockIdx.x; it < NT + NR; it += gridDim.x) {
        if (it >= NR) {
            int r = it - NR;
            if (r < J0) { transpose_tile(p.in[4], D, PIN, (bf16_t*)(ws + WS_WIN), D, 0, 0, r); continue; } r -= J0;
            if (r < J1) { transpose_tile(p.in[16], 512, D, (bf16_t*)(ws + WS_WSB), 512, 0, 0, r); continue; } r -= J1;
            if (r < J1) { transpose_tile(p.in[17], 512, D, (bf16_t*)(ws + WS_WRW), 512, 0, 0, r); continue; } r -= J1;
            if (r < J3) { transpose_tile(p.in[18], D, D, (bf16_t*)(ws + WS_WOUT), D, 0, 0, r); continue; } r -= J3;
            if (r < J4) { transpose_tile(p.in[21], D, DFF, (bf16_t*)(ws + WS_WGU), D, 0, 1, r); continue; } r -= J4;
            if (r < J4) { transpose_tile(p.in[22], D, DFF, (bf16_t*)(ws + WS_WGU), D, 0, 2, r); continue; } r -= J4;
            if (r < J6) { transpose_tile(p.in[23], DFF, D, (bf16_t*)(ws + WS_WD), DFF, 0, 0, r); continue; } r -= J6;
            if (r < J7) { transpose_tile(p.in[6], 64, 512, (bf16_t*)(ws + WS_WL), 256, 0, 0, r); continue; } r -= J7;
            if (r < J7) { transpose_tile(p.in[8], 64, 512, (bf16_t*)(ws + WS_WL), 256, 64, 0, r); continue; } r -= J7;
            transpose_tile(p.in[10], 128, 512, (bf16_t*)(ws + WS_WL), 256, 128, 0, r);
        } else {
            const int lane = threadIdx.x & 63, row0 = it * 32 + (threadIdx.x >> 6) * 4;
            f32x4 v[4][4];
#pragma unroll
            for (int r = 0; r < 4; ++r) {
                const int row = row0 + r, b = row / TP, t = row - b * TP;
                const float* src = t < NMETA ? p.in[1] + (size_t)t * D : p.in[0] + ((size_t)b * SEQ + (t < T ? t - NMETA : 0)) * D;
#pragma unroll
                for (int j = 0; j < 4; ++j) v[r][j] = *(const f32x4*)(src + 4 * lane + 256 * j);
            }
            f32x4 g[4];
#pragma unroll
            for (int j = 0; j < 4; ++j) g[j] = *(const f32x4*)(p.in[2] + 4 * lane + 256 * j);
#pragma unroll
            for (int r = 0; r < 4; ++r) {
                const int row = row0 + r, b = row / TP, t = row - b * TP;
                float ss = 0.f;
#pragma unroll
                for (int j = 0; j < 4; ++j) ss += (v[r][j][0] * v[r][j][0] + v[r][j][1] * v[r][j][1]) + (v[r][j][2] * v[r][j][2] + v[r][j][3] * v[r][j][3]);
                const float rs = t < T ? rsqrtf(wave_sum(ss) * (1.0f / D) + RMS_EPS) : 0.f;
                bf16_t* orow = (bf16_t*)(ws + O_A0) + (size_t)row * D;
#pragma unroll
                for (int j = 0; j < 4; ++j) {
                    u32x2 w; w.x = pk_bf16(v[r][j][0] * rs * g[j][0], v[r][j][1] * rs * g[j][1]); w.y = pk_bf16(v[r][j][2] * rs * g[j][2], v[r][j][3] * rs * g[j][3]);
                    *(u32x2*)(orow + 4 * lane + 256 * j) = w;
                }
            }
        }
    }
}

__device__ __forceinline__ void phase1(const Params& p) {
    unsigned char* ws = p.ws;
    EpiInProj<false> epi{(bf16_t*)(ws + R_QKV), (_Float16*)(ws + R_URW), (bf16_t*)p.out};
    gemm_phase((const bf16_t*)(ws + O_A0), (const bf16_t*)(ws + WS_WIN), D, MP / BM, 7, epi, (int)gridDim.x, (int)blockIdx.x, 0, 6);
}

constexpr int SI_R = 0, SI_W = 1, SI_K = 2, SI_V = 3, SI_KK = 4, SI_B = 5;
constexpr int ALD = 264;
constexpr int P2_WLS = 64 * ALD * 2;
constexpr int P2_MU = P2_WLS;
constexpr int P2_AL = P2_MU + 1024;
__device__ __forceinline__ void phase2_main(const Params& p) {
    unsigned char* ws = p.ws;
    const int tid = threadIdx.x, wave = tid >> 6, lane = tid & 63, fr = lane & 15, fq = lane >> 4;
    const int h = blockIdx.x & 7, nslot = (gridDim.x >> 3) * 8, slot = (blockIdx.x >> 3) * 8 + wave;
    const _Float16* urw = (const _Float16*)(ws + R_URW);
    const float* mu = p.in[5];
    bf16_t* WLs = (bf16_t*)smem;
    float* mus = (float*)(smem + P2_MU);
    bf16_t* Al = (bf16_t*)(smem + P2_AL) + wave * (16 * ALD);
    __syncthreads();
    {
        const bf16_t* WL = (const bf16_t*)(ws + WS_WL) + (size_t)h * 64 * 256;
#pragma unroll
        for (int i = 0; i < 4; ++i) { const int idx = tid + 512 * i, row = idx >> 5, c16 = idx & 31; *(u32x4*)(WLs + row * ALD + c16 * 8) = *(const u32x4*)(WL + row * 256 + c16 * 8); }
        if (tid < 256) mus[tid] = mu[1536 + tid];
    }
    __syncthreads();
    if (blockIdx.x >= nslot) return;
    _Float16* SI = (_Float16*)(ws + R_SI);
    bf16_t* G = (bf16_t*)(ws + R_G);
    constexpr size_t SIE = (size_t)MP * 512;
#pragma unroll 1
    for (int g = slot; g < NB * 514; g += nslot) {
        const int ub = g / 514, ui = g - ub * 514, row0 = ub * TP + ui * 16;
        {
            const int half = lane >> 5, pc = (lane & 31) * 8;
            const float sA = pc < 64 ? 2.f : 1.f, sC = pc < 64 ? -1.f : 0.f;
            const bool lin = pc >= 64 && pc < 128;
            const f32x4 mA = *(const f32x4*)(mu + 1536 + pc), mB = *(const f32x4*)(mu + 1536 + pc + 4);
            h16x8 c[8], pv[8];
#pragma unroll
            for (int q = 0; q < 8; ++q) {
                const int rowa = row0 + 2 * q + half, ta = rowa % TP;
                const _Float16* cur = urw + (size_t)rowa * RWS + 1536 + pc;
                c[q] = *(const h16x8*)cur;
                pv[q] = *(const h16x8*)(ta > 0 ? cur - RWS : cur);
            }
#pragma unroll
            for (int q = 0; q < 8; ++q) {
                const int ta = (row0 + 2 * q + half) % TP;
                float o[8];
#pragma unroll
                for (int e = 0; e < 8; ++e) {
                    const float cf = (float)c[q][e], pf = ta > 0 ? (float)pv[q][e] : 0.f;
                    const float xs = cf + (e < 4 ? mA[e & 3] : mB[e & 3]) * (pf - cf);
                    const float sg = __builtin_amdgcn_rcpf(1.0f + __expf(-sA * xs));
                    o[e] = lin ? xs : sA * sg + sC;
                }
                u32x4 w; w.x = pk_bf16(o[0], o[1]); w.y = pk_bf16(o[2], o[3]); w.z = pk_bf16(o[4], o[5]); w.w = pk_bf16(o[6], o[7]);
                *(u32x4*)(Al + (2 * q + half) * ALD + pc) = w;
            }
        }
        asm volatile("s_waitcnt lgkmcnt(0)" ::: "memory");
        __builtin_amdgcn_wave_barrier();
        f32x4 acc[4];
        auto lora = [&](auto kbeg_c, auto ksteps_c) {
            constexpr int kbeg = decltype(kbeg_c)::value, ksteps = decltype(ksteps_c)::value;
#pragma unroll
            for (int n = 0; n < 4; ++n) acc[n] = (f32x4){0.f, 0.f, 0.f, 0.f};
#pragma unroll
            for (int ks = 0; ks < ksteps; ++ks) {
                const bf16x8 af = *(const bf16x8*)(Al + fr * ALD + kbeg + ks * 32 + fq * 8);
#pragma unroll
                for (int n = 0; n < 4; ++n) {
                    const bf16x8 wf = *(const bf16x8*)(WLs + (n * 16 + fr) * ALD + kbeg + ks * 32 + fq * 8);
                    acc[n] = __builtin_amdgcn_mfma_f32_16x16x32_bf16(wf, af, acc[n], 0, 0, 0);
                }
            }
        };
        const int row = row0 + fr, b = row / TP, t = row - b * TP;
        const size_t base = ((size_t)(b * NH + h) * TP + t) * 448;
        const _Float16* ur = urw + (size_t)row * RWS;
        const size_t pb = base + fq * 16;
        lora(std::integral_constant<int, 0>{}, std::integral_constant<int, 2>{});
        {
            h16x8 wo[2];
#pragma unroll
            for (int n = 0; n < 4; ++n) {
                const f32x4 db = *(const f32x4*)(p.in[7] + h * 64 + n * 16 + fq * 4);
#pragma unroll
                for (int j = 0; j < 4; ++j) {
                    const float e = sigmoidf_(db[j] + acc[n][j]) * 0.60653065971f;
                    wo[n >> 1][(n & 1) * 4 + j] = (_Float16)(1.0f - __expf(-e));
                }
            }
            *(h16x8*)(SI + SI_W * 64 + pb) = wo[0]; *(h16x8*)(SI + SI_W * 64 + pb + 8) = wo[1];
        }
        lora(std::integral_constant<int, 64>{}, std::integral_constant<int, 2>{});
        {
            const _Float16* up = ur + h * 64 + fq * 16;
            const _Float16* upp = t > 0 ? up - RWS : up;
            h16x8 kc[2], rc[2], vc[2], kp[2], rp[2], vp[2];
#pragma unroll
            for (int i = 0; i < 2; ++i) {
                rc[i] = *(const h16x8*)(up + i * 8); kc[i] = *(const h16x8*)(up + 512 + i * 8); vc[i] = *(const h16x8*)(up + 1024 + i * 8);
                rp[i] = *(const h16x8*)(upp + i * 8); kp[i] = *(const h16x8*)(upp + 512 + i * 8); vp[i] = *(const h16x8*)(upp + 1024 + i * 8);
            }
            float kv[4][4], av[4][4], kkr[4][4]; float ss = 0.f;
            h16x8 ro[2];
#pragma unroll
            for (int n = 0; n < 4; ++n) {
                const int c = n * 16 + fq * 4, c512 = h * 64 + c;
                const f32x4 muk = *(const f32x4*)(mu + 512 + c512), mur = *(const f32x4*)(mu + c512), muv = *(const f32x4*)(mu + 1024 + c512);
                const f32x4 ab = *(const f32x4*)(p.in[9] + c512), kkw = *(const f32x4*)(p.in[11] + c512);
                h16x4 vo;
#pragma unroll
                for (int j = 0; j < 4; ++j) {
                    const int i = n >> 1, e = (n & 1) * 4 + j;
                    const float kcf = (float)kc[i][e], kpf = t > 0 ? (float)kp[i][e] : 0.f;
                    const float rcf = (float)rc[i][e], rpf = t > 0 ? (float)rp[i][e] : 0.f;
                    const float vcf = (float)vc[i][e], vpf = t > 0 ? (float)vp[i][e] : 0.f;
                    kv[n][j] = kcf + muk[j] * (kpf - kcf);
                    ro[i][e] = (_Float16)(rcf + mur[j] * (rpf - rcf));
                    vo[j] = (_Float16)(vcf + muv[j] * (vpf - vcf));
                    av[n][j] = sigmoidf_(ab[j] + acc[n][j]);
                    kkr[n][j] = kv[n][j] * kkw[j];
                    ss += kkr[n][j] * kkr[n][j];
                }
                *(h16x4*)(SI + SI_V * 64 + base + c) = vo;
            }
            *(h16x8*)(SI + SI_R * 64 + pb) = ro[0]; *(h16x8*)(SI + SI_R * 64 + pb + 8) = ro[1];
            ss += __shfl_xor(ss, 16); ss += __shfl_xor(ss, 32);
            const float inv = fminf(__builtin_amdgcn_rsqf(ss), 1e12f);
            h16x8 ko[2], kko[2], bo[2];
#pragma unroll
            for (int n = 0; n < 4; ++n) {
                const f32x4 ka = *(const f32x4*)(p.in[12] + h * 64 + n * 16 + fq * 4);
#pragma unroll
                for (int j = 0; j < 4; ++j) {
                    const int i = n >> 1, e = (n & 1) * 4 + j;
                    const float kk = kkr[n][j] * inv;
                    ko[i][e] = (_Float16)(kv[n][j] * (1.0f + (av[n][j] - 1.0f) * ka[j]));
                    kko[i][e] = (_Float16)kk;
                    bo[i][e] = (_Float16)(kk * av[n][j]);
                }
            }
#pragma unroll
            for (int i = 0; i < 2; ++i) {
                *(h16x8*)(SI + SI_K * 64 + pb + i * 8) = ko[i]; *(h16x8*)(SI + SI_KK * 64 + pb + i * 8) = kko[i]; *(h16x8*)(SI + SI_B * 64 + pb + i * 8) = bo[i];
            }
        }
        lora(std::integral_constant<int, 128>{}, std::integral_constant<int, 4>{});
        {
            u32x4 g0, g1;
            g0.x = pk_bf16(acc[0][0], acc[0][1]); g0.y = pk_bf16(acc[0][2], acc[0][3]); g0.z = pk_bf16(acc[1][0], acc[1][1]); g0.w = pk_bf16(acc[1][2], acc[1][3]);
            g1.x = pk_bf16(acc[2][0], acc[2][1]); g1.y = pk_bf16(acc[2][2], acc[2][3]); g1.z = pk_bf16(acc[3][0], acc[3][1]); g1.w = pk_bf16(acc[3][2], acc[3][3]);
            *(u32x4*)((bf16_t*)SI + 6 * 64 + pb) = g0; *(u32x4*)((bf16_t*)SI + 6 * 64 + pb + 8) = g1;
        }
        asm volatile("s_waitcnt lgkmcnt(0)" ::: "memory");
        __builtin_amdgcn_wave_barrier();
    }
}
__device__ __forceinline__ void phase2_kmax(const Params& p, int item) {
    unsigned char* ws = p.ws;
    const int bh = item >> 2, qr = item & 3, tid = threadIdx.x;
    float* red = (float*)(smem + P2_AL + 8 * 16 * ALD * 2);
    float ss = 0.f;
    for (int t = qr * 2052 + tid; t < (qr + 1) * 2052; t += 512) {
        const bf16_t* kr = (const bf16_t*)(ws + R_QKV) + QKV_ONE / 2 + ((size_t)bh * TP + t) * 64;
        float s1 = 0.f;
#pragma unroll
        for (int q = 0; q < 8; ++q) {
            const u32x4 v = *(const u32x4*)(kr + q * 8);
#pragma unroll
            for (int e = 0; e < 4; ++e) { const float lo = __uint_as_float(v[e] << 16), hi = __uint_as_float(v[e] & 0xffff0000u); s1 += lo * lo + hi * hi; }
        }
        ss = fmaxf(ss, s1);
    }
#pragma unroll
    for (int o = 1; o < 64; o <<= 1) ss = fmaxf(ss, __shfl_xor(ss, o));
    __syncthreads();
    if ((tid & 63) == 0) red[tid >> 6] = ss;
    __syncthreads();
    if (tid == 0) {
        float m = red[0];
#pragma unroll
        for (int w = 1; w < 8; ++w) m = fmaxf(m, red[w]);
        ((float*)(ws + WS_CTL))[16 + item] = m;
    }
}
__device__ __forceinline__ void phase2(const Params& p) {
    phase2_main(p);
}

constexpr int SC_TC = 32, SC_NC = (T + SC_TC - 1) / SC_TC;
constexpr int SC_ARR = SC_TC * 64;
constexpr int SC_VOFF = 5 * SC_ARR, SC_COFF = SC_VOFF + SC_TC * 16;
constexpr int SC_BUF = (SC_COFF + SC_TC) * 4;
constexpr int SC_YOFF = 2 * SC_BUF, SC_YBUF = SC_TC * 16 * 4;
__device__ __forceinline__ float dot4(const f32x4& a, const f32x4& b) {
    f32x2 t = __builtin_shufflevector(a, a, 0, 1) * __builtin_shufflevector(b, b, 0, 1);
    t = __builtin_shufflevector(a, a, 2, 3) * __builtin_shufflevector(b, b, 2, 3) + t;
    return t[0] + t[1];
}
__device__ __forceinline__ void reduce16x2(float& a, float& b) {
    a += dppf<0xB1>(a); b += dppf<0xB1>(b); a += dppf<0x4E>(a); b += dppf<0x4E>(b);
    a += dppf<0x141>(a); b += dppf<0x141>(b); a += dppf<0x140>(a); b += dppf<0x140>(b);
}
__device__ __forceinline__ void scan_unit(const Params& p, int unit) {
    unsigned char* ws = p.ws;
    const int bh = unit >> 2, vr0 = (unit & 3) * 16, tid = threadIdx.x, wave = tid >> 6, lane = tid & 63;
    const _Float16* SI = (const _Float16*)(ws + R_SI);
    constexpr size_t SIE = (size_t)MP * 512;
    bf16_t* Y = (bf16_t*)(ws + O_Y);
    const size_t hb = (size_t)bh * TP * 64;
    __syncthreads();
    if (wave >= 4) {
        const int i = tid - 256, ip = i >= 8 ? i - 8 : i;
        const int arrs[5] = {SI_R, SI_W, SI_K, SI_KK, SI_B};
        u32x4 rg[5], rp[3]; unsigned rv;
        auto issue = [&](int c) {
            const size_t off = ((size_t)bh * TP + (size_t)c * SC_TC + (i >> 3)) * 448 + (i & 7) * 8;
            const size_t offp = i >= 8 ? off - 448 : off;
#pragma unroll
            for (int a = 0; a < 5; ++a) rg[a] = *(const u32x4*)(SI + arrs[a] * 64 + off);
            rp[0] = *(const u32x4*)(SI + SI_W * 64 + offp);
            rp[1] = *(const u32x4*)(SI + SI_K * 64 + offp);
            rp[2] = *(const u32x4*)(SI + SI_B * 64 + offp);
            rv = *(const unsigned*)(SI + SI_V * 64 + off - (i & 7) * 8 + vr0 + (i & 7) * 2);
        };
        auto commit = [&](int bufi) {
            float* buf = (float*)(smem + bufi * SC_BUF);
            float f[5][8];
#pragma unroll
            for (int a = 0; a < 5; ++a) {
                const h16x8 hv = __builtin_bit_cast(h16x8, rg[a]);
#pragma unroll
                for (int e = 0; e < 8; ++e) f[a][e] = (float)hv[e];
            }
            const bool odd = (i >> 3) & 1;
            float ckk = 0.f, cbk = 0.f;
            {
                const h16x8 pw = __builtin_bit_cast(h16x8, rp[0]), pk = __builtin_bit_cast(h16x8, rp[1]), pb = __builtin_bit_cast(h16x8, rp[2]);
#pragma unroll
                for (int e = 0; e < 8; ++e) {
                    const float kk2 = f[3][e];
                    ckk += (float)pk[e] * kk2; cbk += (float)pb[e] * kk2;
                    if (odd) f[3][e] = (1.0f - (float)pw[e]) * kk2;
                }
            }
            ckk += dppf<0xB1>(ckk); cbk += dppf<0xB1>(cbk); ckk += dppf<0x4E>(ckk); cbk += dppf<0x4E>(cbk); ckk += dppf<0x141>(ckk); cbk += dppf<0x141>(cbk);
#pragma unroll
            for (int a = 0; a < 5; ++a) {
                f32x4 lo, hi;
#pragma unroll
                for (int e = 0; e < 4; ++e) { lo[e] = f[a][e]; hi[e] = f[a][4 + e]; }
                if (a == 1) { lo = 1.0f - lo; hi = 1.0f - hi; }
                if (a == 4) { lo = -lo; hi = -hi; }
                *(f32x4*)(buf + a * SC_ARR + i * 8) = lo; *(f32x4*)(buf + a * SC_ARR + i * 8 + 4) = hi;
            }
            const h16x2 v2 = __builtin_bit_cast(h16x2, rv);
            f32x2 vf; vf[0] = (float)v2[0]; vf[1] = (float)v2[1];
            *(f32x2*)(buf + SC_VOFF + (i >> 3) * 16 + (i & 7) * 2) = vf;
            if (odd && (i & 7) == 0) { f32x2 cf; cf[0] = ckk; cf[1] = cbk; *(f32x2*)(buf + SC_COFF + (i >> 4) * 2) = cf; }
        };
        auto yout = [&](int c) {
            const float* yb = (const float*)(smem + SC_YOFF + (c & 1) * SC_YBUF);
            const f32x2 v = *(const f32x2*)(yb + (i >> 3) * 16 + (i & 7) * 2);
            *(unsigned*)(Y + hb + (size_t)(c * SC_TC + (i >> 3)) * 64 + vr0 + (i & 7) * 2) = pk_bf16(v[0], v[1]);
        };
        issue(0); commit(0); issue(1);
        __syncthreads();
        for (int c = 0; c < SC_NC; ++c) {
            if (c > 0) yout(c - 1);
            if (c + 1 < SC_NC) commit((c + 1) & 1);
            if (c + 2 < SC_NC) issue(c + 2);
            __syncthreads();
        }
        yout(SC_NC - 1);
    } else {
        const int rl = wave * 4 + (lane >> 4), sub = lane & 15;
        const bool odd_lane = lane & 1; const int yoff = (lane & 1) * 16 + rl;
        f32x4 S = {0.f, 0.f, 0.f, 0.f};
        __builtin_amdgcn_s_setprio(3);
        __syncthreads();
        for (int c = 0; c < SC_NC; ++c) {
            const float* buf = (const float*)(smem + (c & 1) * SC_BUF);
            float* yb = (float*)(smem + SC_YOFF + (c & 1) * SC_YBUF);
            const float* bp = buf + sub * 4;
#define SC_LD(arr, s) (*(const f32x4*)(bp + (arr) * SC_ARR + (s) * 64))
            f32x4 r1 = SC_LD(0, 0), w1 = SC_LD(1, 0), k1 = SC_LD(2, 0), q1 = SC_LD(3, 0), n1 = SC_LD(4, 0);
            f32x4 r2 = SC_LD(0, 1), w2 = SC_LD(1, 1), k2 = SC_LD(2, 1), g2 = SC_LD(3, 1), n2 = SC_LD(4, 1);
            float v1 = buf[SC_VOFF + rl], v2 = buf[SC_VOFF + 16 + rl];
            f32x2 cf = *(const f32x2*)(buf + SC_COFF);
#pragma unroll
            for (int pr = 0; pr < SC_TC / 2; ++pr) {
                const int sn = 2 * pr + 2;
                const f32x4 r1n = SC_LD(0, sn), w1n = SC_LD(1, sn), k1n = SC_LD(2, sn), q1n = SC_LD(3, sn), n1n = SC_LD(4, sn);
                const f32x4 r2n = SC_LD(0, sn + 1), w2n = SC_LD(1, sn + 1), k2n = SC_LD(2, sn + 1), g2n = SC_LD(3, sn + 1), n2n = SC_LD(4, sn + 1);
                const float v1n = buf[SC_VOFF + sn * 16 + rl], v2n = buf[SC_VOFF + (sn + 1) * 16 + rl];
                const f32x2 cfn = *(const f32x2*)(buf + SC_COFF + (pr + 1) * 2);
                __builtin_amdgcn_sched_barrier(0x7);
                float d1 = dot4(S, q1), e2 = dot4(S, g2);
                const f32x4 t1 = S * w1 + v1 * k1;
                reduce16x2(d1, e2);
                const float d2 = e2 + v1 * cf[0] - d1 * cf[1];
                const f32x4 S1 = t1 + d1 * n1;
                const f32x4 S2 = (S1 * w2 + v2 * k2) + d2 * n2;
                float y1 = dot4(S1, r1), y2 = dot4(S2, r2);
                y1 += dppf<0xB1>(y1); y2 += dppf<0xB1>(y2);
                float yz = odd_lane ? y2 : y1;
                yz += dppf<0x122>(yz); yz += dppf<0x124>(yz); yz += dppf<0x128>(yz);
                yb[(2 * pr) * 16 + yoff] = yz;
                S = S2;
                r1 = r1n; w1 = w1n; k1 = k1n; q1 = q1n; n1 = n1n; r2 = r2n; w2 = w2n; k2 = k2n; g2 = g2n; n2 = n2n; v1 = v1n; v2 = v2n; cf = cfn;
            }
#undef SC_LD
            __syncthreads();
        }
        __builtin_amdgcn_s_setprio(0);
    }
}

constexpr int KLD = 72;
__device__ __forceinline__ void attn_unit(const Params& p, int unit) {
    unsigned char* ws = p.ws;
    const int qt = unit % 65, bh = unit / 65, b = bh >> 3, h = bh & 7;
    const int tid = threadIdx.x, wave = tid >> 6, lane = tid & 63, fr = lane & 15, fq = lane >> 4;
    const bf16_t* Q = (const bf16_t*)(ws + R_QKV) + (size_t)bh * TP * 64;
    const bf16_t* Kg = Q + QKV_ONE / 2;
    const bf16_t* Vg = Q + QKV_ONE;
    bf16_t* slots = (bf16_t*)smem;
    constexpr int SLOT = 2 * 64 * KLD;
    volatile int* flags = (volatile int*)(smem + 2 * SLOT * 2);
    const int t0 = qt * 128, tq = t0 + wave * 16 + fr;
    bf16x8 qf[2];
    qf[0] = *(const bf16x8*)(Q + (size_t)tq * 64 + fq * 8);
    qf[1] = *(const bf16x8*)(Q + (size_t)tq * 64 + 32 + fq * 8);
    float qs = 0.f;
#pragma unroll
    for (int s = 0; s < 2; ++s)
#pragma unroll
        for (int e = 0; e < 8; ++e) { const float f = bf2f((unsigned short)qf[s][e]); qs += f * f; }
    qs += __shfl_xor(qs, 16); qs += __shfl_xor(qs, 32);
    const f32x4 km4 = *(const f32x4*)((const float*)(ws + WS_CTL) + 16 + bh * 4);
    const float kmax = sqrtf(fmaxf(fmaxf(km4[0], km4[1]), fmaxf(km4[2], km4[3])));
    const float zb = sqrtf(qs) * kmax * 1.0001f + 88.0f;
    float Arow = 0.f;
    f32x4 O[4];
#pragma unroll
    for (int nd = 0; nd < 4; ++nd) O[nd] = (f32x4){0.f, 0.f, 0.f, 0.f};
    const int key = tid >> 3, dc = (tid & 7) * 8, half = wave >> 2;
    auto tile_store = [&](int blk, const u32x4& kv, const u32x4& vv) {
        bf16_t* Ks_ = slots + (blk & 1) * SLOT; bf16_t* Vt_ = Ks_ + 64 * KLD;
        *(u32x4*)(Ks_ + key * KLD + dc) = kv;
#pragma unroll
        for (int e = 0; e < 4; ++e) { Vt_[(dc + 2 * e) * KLD + key] = (bf16_t)(vv[e] & 0xffffu); Vt_[(dc + 2 * e + 1) * KLD + key] = (bf16_t)(vv[e] >> 16); }
    };
    const int ktop = qt * 2 + 1;
    {
        const u32x4 k0 = *(const u32x4*)(Kg + (size_t)(ktop * 64 + key) * 64 + dc), v0 = *(const u32x4*)(Vg + (size_t)(ktop * 64 + key) * 64 + dc);
        __syncthreads();
        tile_store(ktop, k0, v0);
    }
    u32x4 kvv = *(const u32x4*)(Kg + (size_t)((ktop - 1) * 64 + key) * 64 + dc);
    u32x4 vvv = *(const u32x4*)(Vg + (size_t)((ktop - 1) * 64 + key) * 64 + dc);
    for (int kt = ktop; kt >= 0; --kt) {
        const int kb = kt - 1 + half;
        const bool done = __all(Arow > zb) || kb < 0;
        if (lane == 0) flags[wave] = done ? 1 : 0;
        __syncthreads();
        int alld = 1;
#pragma unroll
        for (int w = 0; w < 8; ++w) alld &= flags[w];
        if (alld) break;
        if (kt >= 1) {
            tile_store(kt - 1, kvv, vvv);
            if (kt >= 2) {
                kvv = *(const u32x4*)(Kg + (size_t)((kt - 2) * 64 + key) * 64 + dc);
                vvv = *(const u32x4*)(Vg + (size_t)((kt - 2) * 64 + key) * 64 + dc);
            }
        }
        asm volatile("s_waitcnt lgkmcnt(0)" ::: "memory");
        __builtin_amdgcn_s_barrier();
        if (kb < 0) continue;
        const bf16_t* Ks = slots + (kb & 1) * SLOT; const bf16_t* Vt = Ks + 64 * KLD;
        f32x4 z[4];
#pragma unroll
        for (int n = 0; n < 4; ++n) {
            z[n] = (f32x4){0.f, 0.f, 0.f, 0.f};
#pragma unroll
            for (int s = 0; s < 2; ++s) {
                const bf16x8 kf = *(const bf16x8*)(Ks + (n * 16 + fr) * KLD + s * 32 + fq * 8);
                z[n] = __builtin_amdgcn_mfma_f32_16x16x32_bf16(kf, qf[s], z[n], 0, 0, 0);
            }
        }
        float sp[4][4], lt[4], ex[4], sg[4];
#pragma unroll
        for (int n = 0; n < 4; ++n) {
#pragma unroll
            for (int j = 0; j < 4; ++j) { const int s = kb * 64 + n * 16 + fq * 4 + j; sp[n][j] = s < tq ? softplusf_(z[n][j]) : 0.f; }
            sp[n][2] += sp[n][3]; sp[n][1] += sp[n][2]; sp[n][0] += sp[n][1];
            lt[n] = sp[n][0];
            const float a = __shfl_xor(lt[n], 16), pr = lt[n] + a, c = __shfl_xor(pr, 32);
            ex[n] = fq == 3 ? 0.f : (fq == 2 ? a : (fq == 1 ? c : a + c));
            sg[n] = pr + c;
        }
        float nsuf[4]; nsuf[3] = 0.f; nsuf[2] = sg[3]; nsuf[1] = nsuf[2] + sg[2]; nsuf[0] = nsuf[1] + sg[1];
        float wgt[4][4];
#pragma unroll
        for (int n = 0; n < 4; ++n)
#pragma unroll
            for (int j = 0; j < 4; ++j) {
                const int s = kb * 64 + n * 16 + fq * 4 + j;
                const float C = Arow + nsuf[n] + ex[n] + sp[n][j];
                wgt[n][j] = s < tq ? __expf(z[n][j] - C) : 0.f;
            }
        Arow += nsuf[0] + sg[0];
#pragma unroll
        for (int ks = 0; ks < 2; ++ks) {
            u32x4 pw; pw.x = pk_bf16(wgt[2 * ks][0], wgt[2 * ks][1]); pw.y = pk_bf16(wgt[2 * ks][2], wgt[2 * ks][3]);
            pw.z = pk_bf16(wgt[2 * ks + 1][0], wgt[2 * ks + 1][1]); pw.w = pk_bf16(wgt[2 * ks + 1][2], wgt[2 * ks + 1][3]);
            const bf16x8 pf = __builtin_bit_cast(bf16x8, pw);
#pragma unroll
            for (int nd = 0; nd < 4; ++nd) {
                u32x4 vw;
                const u32x2 v0 = *(const u32x2*)(Vt + (nd * 16 + fr) * KLD + (2 * ks) * 16 + fq * 4);
                const u32x2 v1 = *(const u32x2*)(Vt + (nd * 16 + fr) * KLD + (2 * ks + 1) * 16 + fq * 4);
                vw.x = v0.x; vw.y = v0.y; vw.z = v1.x; vw.w = v1.y;
                O[nd] = __builtin_amdgcn_mfma_f32_16x16x32_bf16(pf, __builtin_bit_cast(bf16x8, vw), O[nd], 0, 0, 0);
            }
        }
    }
    __syncthreads();
    bf16_t* Ot = (bf16_t*)smem;
#pragma unroll
    for (int j = 0; j < 4; ++j)
#pragma unroll
        for (int nd = 0; nd < 4; ++nd) Ot[(wave * 16 + fq * 4 + j) * KLD + nd * 16 + fr] = (bf16_t)(pk_bf16(O[nd][j], 0.f) & 0xffffu);
    __syncthreads();
    bf16_t* osb = (bf16_t*)(ws + O_OSB);
#pragma unroll
    for (int i = 0; i < 2; ++i) {
        const int idx = tid + 512 * i, r = idx >> 3, pc8 = (idx & 7) * 8, t = t0 + r;
        if (t >= NMETA && t < T) *(u32x4*)(osb + (size_t)(b * SEQ + t - NMETA) * 512 + h * 64 + pc8) = *(const u32x4*)(Ot + r * KLD + pc8);
    }
}

constexpr int N_SCAN = 128, N_ATTN = 32 * 65;
__device__ __forceinline__ void sub_barrier(unsigned* ctr, unsigned target, bool arrive) {
    asm volatile("s_waitcnt vmcnt(0)" ::: "memory");
    __syncthreads();
    if (threadIdx.x == 0) {
        if (arrive) { __builtin_amdgcn_fence(__ATOMIC_RELEASE, "agent"); asm volatile("s_waitcnt vmcnt(0)" ::: "memory"); (void)xb_add(ctr, 1u); }
        unsigned sp = 0u;
        while (xb_ld(ctr) < target) { __builtin_amdgcn_s_sleep(2); if (++sp > (1u << 22)) break; }
        __builtin_amdgcn_fence(__ATOMIC_ACQUIRE, "agent");
        asm volatile("s_waitcnt vmcnt(0)" ::: "memory");
    }
    __syncthreads();
}
__device__ __forceinline__ void phase3(const Params& p) {
    unsigned char* ws = p.ws;
    unsigned* ctl = (unsigned*)(ws + WS_CTL);
    const int nother = (int)gridDim.x - N_SCAN;
    if ((int)blockIdx.x < N_SCAN) {
        scan_unit(p, blockIdx.x);
    } else {
        EpiInProj<true> epi{(bf16_t*)(ws + R_QKV), (_Float16*)(ws + R_URW), (bf16_t*)p.out};
        gemm_phase((const bf16_t*)(ws + O_A0), (const bf16_t*)(ws + WS_WIN), D, MP / BM, 14, epi, nother, (int)blockIdx.x - N_SCAN, 6, 7);
        sub_barrier(ctl + 256, (unsigned)nother, true);
        for (int it = (int)blockIdx.x - N_SCAN; it < 128; it += nother) phase2_kmax(p, it);
        sub_barrier(ctl + 320, (unsigned)nother, true);
    }
    sub_barrier(ctl + 320, (unsigned)nother, false);
    volatile int* slot = (volatile int*)(smem + 131072 - 16);
    for (;;) {
        __syncthreads();
        if (threadIdx.x == 0) *slot = (int)atomicAdd(ctl, 1u);
        __syncthreads();
        const int u = *slot;
        if (u >= N_ATTN) break;
        attn_unit(p, u);
    }
}

__device__ __forceinline__ void phase3c(const Params& p) {
    unsigned char* ws = p.ws;
    const _Float16* SI = (const _Float16*)(ws + R_SI);
    constexpr size_t SIE = (size_t)MP * 512;
    const bf16_t* Y = (const bf16_t*)(ws + O_Y);
    const bf16_t* G = (const bf16_t*)(ws + R_G);
    bf16_t* orw = (bf16_t*)(ws + O_ORW);
    const int tid = threadIdx.x, sub = tid & 15;
    constexpr int U = 4;
    for (int it = blockIdx.x; it < 32 * 64; it += gridDim.x) {
        const int bh = it >> 6, c4 = it & 63, b = bh >> 3, h = bh & 7;
        const int c = h * 64 + sub * 4;
        const f32x4 gain = *(const f32x4*)(p.in[14] + c), bias = *(const f32x4*)(p.in[15] + c), rk = *(const f32x4*)(p.in[13] + c);
        u32x2 yb2[U]; f32x4 y[U]; h16x4 r4[U], k4[U], v4[U]; u32x2 g2[U];
#pragma unroll
        for (int u = 0; u < U; ++u) {
            const int t = NMETA + (c4 * U + u) * 32 + (tid >> 4);
            const size_t base = ((size_t)bh * TP + t) * 64 + sub * 4;
            const size_t rec = ((size_t)bh * TP + t) * 448, pbase = rec + (sub & 3) * 16 + (sub >> 2) * 4;
            yb2[u] = *(const u32x2*)(Y + base);
            r4[u] = *(const h16x4*)(SI + SI_R * 64 + pbase); k4[u] = *(const h16x4*)(SI + SI_K * 64 + pbase); v4[u] = *(const h16x4*)(SI + SI_V * 64 + rec + sub * 4);
            g2[u] = *(const u32x2*)((const bf16_t*)SI + 6 * 64 + pbase);
        }
#pragma unroll
        for (int u = 0; u < U; ++u) {
            const int t = NMETA + (c4 * U + u) * 32 + (tid >> 4);
            y[u][0] = __uint_as_float(yb2[u].x << 16); y[u][1] = __uint_as_float(yb2[u].x & 0xffff0000u); y[u][2] = __uint_as_float(yb2[u].y << 16); y[u][3] = __uint_as_float(yb2[u].y & 0xffff0000u);
            const float mean = reduce16((y[u][0] + y[u][1]) + (y[u][2] + y[u][3])) * (1.0f / 64.0f);
            const f32x4 dy = y[u] - mean;
            const float var = reduce16((dy[0] * dy[0] + dy[1] * dy[1]) + (dy[2] * dy[2] + dy[3] * dy[3])) * (1.0f / 64.0f);
            const float rs = rsqrtf(var + GN_EPS);
            float bs = 0.f;
#pragma unroll
            for (int j = 0; j < 4; ++j) bs += (float)r4[u][j] * (float)k4[u][j] * rk[j];
            bs = reduce16(bs);
            const float gg[4] = {__uint_as_float(g2[u].x << 16), __uint_as_float(g2[u].x & 0xffff0000u), __uint_as_float(g2[u].y << 16), __uint_as_float(g2[u].y & 0xffff0000u)};
            float o[4];
#pragma unroll
            for (int j = 0; j < 4; ++j) o[j] = (dy[j] * rs * gain[j] + bias[j] + bs * (float)v4[u][j]) * gg[j];
            u32x2 w; w.x = pk_bf16(o[0], o[1]); w.y = pk_bf16(o[2], o[3]);
            *(u32x2*)(orw + (size_t)(b * SEQ + t - NMETA) * 512 + c) = w;
        }
    }
}

__device__ __forceinline__ void phase4(const Params& p) {
    unsigned char* ws = p.ws;
    EpiBranch1 e1{(bf16_t*)(ws + O_T1), (const bf16_t*)p.out};
    EpiBranch2 e2{(const bf16_t*)(ws + O_T1), (const bf16_t*)p.out, (bf16_t*)(ws + O_M)};
    gemm_phase((const bf16_t*)(ws + O_OSB), (const bf16_t*)(ws + WS_WSB), 512, MS / BM, D / BM, e1);
    gemm_phase((const bf16_t*)(ws + O_ORW), (const bf16_t*)(ws + WS_WRW), 512, MS / BM, D / BM, e2);
}
__device__ __forceinline__ void phase5(const Params& p) {
    unsigned char* ws = p.ws;
    EpiBf16 e{(bf16_t*)(ws + O_P)};
    gemm_phase((const bf16_t*)(ws + O_M), (const bf16_t*)(ws + WS_WOUT), D, MS / BM, D / BM, e);
}
__device__ __forceinline__ void phase6(const Params& p) {
    unsigned char* ws = p.ws;
    const int lane = threadIdx.x & 63;
    f32x4 g1[4], g2[4];
#pragma unroll
    for (int j = 0; j < 4; ++j) { g1[j] = *(const f32x4*)(p.in[3] + 4 * lane + 256 * j); g2[j] = *(const f32x4*)(p.in[19] + 4 * lane + 256 * j); }
    for (int it = blockIdx.x; it < MS / 16; it += gridDim.x) {
        const int row0 = it * 16 + (threadIdx.x >> 6) * 2;
        f32x4 v[2][4], x[2][4];
#pragma unroll
        for (int r = 0; r < 2; ++r)
#pragma unroll
            for (int j = 0; j < 4; ++j) {
                { const u32x2 pb2 = *(const u32x2*)((const bf16_t*)(ws + O_P) + (size_t)(row0 + r) * D + 4 * lane + 256 * j);
                  v[r][j] = (f32x4){__uint_as_float(pb2.x << 16), __uint_as_float(pb2.x & 0xffff0000u), __uint_as_float(pb2.y << 16), __uint_as_float(pb2.y & 0xffff0000u)}; }
                x[r][j] = *(const f32x4*)(p.in[0] + (size_t)(row0 + r) * D + 4 * lane + 256 * j);
            }
#pragma unroll
        for (int r = 0; r < 2; ++r) {
            const int row = row0 + r;
            float ss = 0.f;
#pragma unroll
            for (int j = 0; j < 4; ++j) ss += (v[r][j][0] * v[r][j][0] + v[r][j][1] * v[r][j][1]) + (v[r][j][2] * v[r][j][2] + v[r][j][3] * v[r][j][3]);
            const float rs = rsqrtf(wave_sum(ss) * (1.0f / D) + RMS_EPS);
            float s2 = 0.f;
#pragma unroll
            for (int j = 0; j < 4; ++j) {
                v[r][j] = x[r][j] + v[r][j] * rs * g1[j];
                *(f32x4*)(p.out + (size_t)row * D + 4 * lane + 256 * j) = v[r][j];
                s2 += (v[r][j][0] * v[r][j][0] + v[r][j][1] * v[r][j][1]) + (v[r][j][2] * v[r][j][2] + v[r][j][3] * v[r][j][3]);
            }
            const float rs2 = rsqrtf(wave_sum(s2) * (1.0f / D) + RMS_EPS);
            bf16_t* fr_ = (bf16_t*)(ws + O_F) + (size_t)row * D;
#pragma unroll
            for (int j = 0; j < 4; ++j) {
                u32x2 w; w.x = pk_bf16(v[r][j][0] * rs2 * g2[j][0], v[r][j][1] * rs2 * g2[j][1]); w.y = pk_bf16(v[r][j][2] * rs2 * g2[j][2], v[r][j][3] * rs2 * g2[j][3]);
                *(u32x2*)(fr_ + 4 * lane + 256 * j) = w;
            }
        }
    }
}
__device__ __forceinline__ void phase7(const Params& p) {
    unsigned char* ws = p.ws;
    EpiGU e{(bf16_t*)(ws + O_ACT)};
    gemm_phase((const bf16_t*)(ws + O_F), (const bf16_t*)(ws + WS_WGU), D, MS / BM, 2 * DFF / BM, e);
}
__device__ __forceinline__ void phase8(const Params& p) {
    unsigned char* ws = p.ws;
    EpiBf16 e{(bf16_t*)(ws + O_DN)};
    gemm_phase((const bf16_t*)(ws + O_ACT), (const bf16_t*)(ws + WS_WD), DFF, MS / BM, D / BM, e);
}
__device__ __forceinline__ void phase9(const Params& p) {
    unsigned char* ws = p.ws;
    const int lane = threadIdx.x & 63;
    f32x4 g[4];
#pragma unroll
    for (int j = 0; j < 4; ++j) g[j] = *(const f32x4*)(p.in[20] + 4 * lane + 256 * j);
    for (int it = blockIdx.x; it < MS / 16; it += gridDim.x) {
        const int row0 = it * 16 + (threadIdx.x >> 6) * 2;
        f32x4 v[2][4], h1[2][4];
#pragma unroll
        for (int r = 0; r < 2; ++r)
#pragma unroll
            for (int j = 0; j < 4; ++j) {
                { const u32x2 db2 = *(const u32x2*)((const bf16_t*)(ws + O_DN) + (size_t)(row0 + r) * D + 4 * lane + 256 * j);
                  v[r][j] = (f32x4){__uint_as_float(db2.x << 16), __uint_as_float(db2.x & 0xffff0000u), __uint_as_float(db2.y << 16), __uint_as_float(db2.y & 0xffff0000u)}; }
                h1[r][j] = *(const f32x4*)(p.out + (size_t)(row0 + r) * D + 4 * lane + 256 * j);
            }
#pragma unroll
        for (int r = 0; r < 2; ++r) {
            float ss = 0.f;
#pragma unroll
            for (int j = 0; j < 4; ++j) ss += (v[r][j][0] * v[r][j][0] + v[r][j][1] * v[r][j][1]) + (v[r][j][2] * v[r][j][2] + v[r][j][3] * v[r][j][3]);
            const float rs = rsqrtf(wave_sum(ss) * (1.0f / D) + RMS_EPS);
#pragma unroll
            for (int j = 0; j < 4; ++j) *(f32x4*)(p.out + (size_t)(row0 + r) * D + 4 * lane + 256 * j) = h1[r][j] + v[r][j] * rs * g[j];
        }
    }
}

constexpr int N_PHASES = 11;
__device__ __forceinline__ void run_phase(const Params& p, int ph) {
    switch (ph) {
        case 0: phase0(p); break;
        case 1: phase1(p); break;
        case 2: phase2(p); break;
        case 3: phase3(p); break;
        case 4: phase3c(p); break;
        case 5: phase4(p); break;
        case 6: phase5(p); break;
        case 7: phase6(p); break;
        case 8: phase7(p); break;
        case 9: phase8(p); break;
        default: phase9(p); break;
    }
}

#if MULTI_LAUNCH
template <int PH> __global__ void __launch_bounds__(512) fwd_phase(Params p) { run_phase(p, PH); }
#else
__global__ void __launch_bounds__(512) fwd_mega(Params p) {
    cg::grid_group grid = cg::this_grid();
    volatile LAS unsigned* st = (volatile LAS unsigned*)(smem + 131072);
    if (threadIdx.x == 0) { st[0] = 0u; st[1] = 0u; }
    __syncthreads();
    const XcdBarrier xb = xcd_barrier_post((unsigned*)(p.ws + WS_BAR), st);
    if (p.out == nullptr) grid.sync();
    phase0(p); xcd_barrier(xb); phase1(p); xcd_barrier(xb); phase2(p); xcd_barrier(xb); phase3(p); xcd_barrier(xb); phase3c(p); xcd_barrier(xb);
    phase4(p); xcd_barrier(xb); phase5(p); xcd_barrier(xb); phase6(p); xcd_barrier(xb); phase7(p); xcd_barrier(xb); phase8(p); xcd_barrier(xb); phase9(p);
}
#endif

extern "C" void kernel_launch(void* const* d_in, const int* in_sizes, int n_in, void* d_out, int out_size, void* d_ws, size_t ws_size, hipStream_t stream) {
    static int grid = 0;
    if (grid == 0) {
        if (n_in != 24 || out_size != MS * D || ws_size < WS_END) { fprintf(stderr, "kernel_launch: unexpected shapes (n_in %d out %d ws %zu need %zu)\n", n_in, out_size, ws_size, (size_t)WS_END); grid = -1; return; }
        int dev = 0, cus = 0, per_cu = 0;
        (void)hipGetDevice(&dev);
        (void)hipDeviceGetAttribute(&cus, hipDeviceAttributeMultiprocessorCount, dev);
#if MULTI_LAUNCH
        per_cu = 1;
#else
        (void)hipFuncSetAttribute((const void*)fwd_mega, hipFuncAttributeMaxDynamicSharedMemorySize, LDS_BYTES);
        (void)hipOccupancyMaxActiveBlocksPerMultiprocessor(&per_cu, (const void*)fwd_mega, 512, LDS_BYTES);
        if (per_cu < 1) { fprintf(stderr, "kernel_launch: occupancy query says %d blocks per CU\n", per_cu); per_cu = 1; }
        if (per_cu > 1) per_cu = 1;
#endif
        grid = cus * per_cu;
        if (grid <= N_SCAN) { fprintf(stderr, "kernel_launch: grid %d too small (needs more than %d workgroups)\n", grid, N_SCAN); grid = -1; return; }
    }
    if (grid < 0) return;
    Params p{};
    for (int i = 0; i < 24; ++i) p.in[i] = (const float*)d_in[i];
    p.out = (float*)d_out; p.ws = (unsigned char*)d_ws;
#if MULTI_LAUNCH
#define LP(PH) do { (void)hipFuncSetAttribute((const void*)fwd_phase<PH>, hipFuncAttributeMaxDynamicSharedMemorySize, LDS_BYTES); hipLaunchKernelGGL(fwd_phase<PH>, dim3(grid), dim3(512), LDS_BYTES, stream, p); } while (0)
    LP(0); LP(1); LP(2); LP(3); LP(4); LP(5); LP(6); LP(7); LP(8); LP(9); LP(10);
#undef LP
#else
    if (hipMemsetAsync(d_ws, 0, WS_CTL_BYTES, stream) != hipSuccess) { fprintf(stderr, "kernel_launch: hipMemsetAsync of the control words failed\n"); return; }
    void* args[] = {&p};
    hipError_t e = hipLaunchCooperativeKernel((const void*)fwd_mega, dim3(grid), dim3(512), args, LDS_BYTES, stream);
    if (e != hipSuccess) fprintf(stderr, "cooperative launch failed: %s (grid %d)\n", hipGetErrorString(e), grid);
#endif
}
```

```cpp
#include <hip/hip_runtime.h>
#include <hip/hip_cooperative_groups.h>
#include <cstdio>
#include <cstdint>
#include <type_traits>
namespace cg = cooperative_groups;

#ifndef MULTI_LAUNCH
#define MULTI_LAUNCH 0
#endif

typedef unsigned short bf16_t;
typedef short bf16x8 __attribute__((ext_vector_type(8)));
typedef float f32x4 __attribute__((ext_vector_type(4)));
typedef float f32x2 __attribute__((ext_vector_type(2)));
typedef unsigned u32x2 __attribute__((ext_vector_type(2)));
typedef unsigned u32x4 __attribute__((ext_vector_type(4)));
typedef _Float16 h16x2 __attribute__((ext_vector_type(2)));
typedef _Float16 h16x4 __attribute__((ext_vector_type(4)));
typedef _Float16 h16x8 __attribute__((ext_vector_type(8)));

constexpr int D = 1024, NB = 4, SEQ = 8192, NMETA = 16, T = SEQ + NMETA, TP = 8320, MP = NB * TP, MS = NB * SEQ;
constexpr int PIN = 5376, DFF = 2816, NH = 8, RWS = 1792;
constexpr float RMS_EPS = 1e-6f, GN_EPS = 64e-5f;

constexpr size_t WS_CTL = 0;
constexpr size_t WS_BAR = 4096;
constexpr size_t WS_CTL_BYTES = 32768;
constexpr size_t WS_WIN = WS_CTL_BYTES;
constexpr size_t WS_WSB = WS_WIN + (size_t)PIN * D * 2;
constexpr size_t WS_WRW = WS_WSB + (size_t)D * 512 * 2;
constexpr size_t WS_WOUT = WS_WRW + (size_t)D * 512 * 2;
constexpr size_t WS_WGU = WS_WOUT + (size_t)D * D * 2;
constexpr size_t WS_WD = WS_WGU + (size_t)2 * DFF * D * 2;
constexpr size_t WS_WL = WS_WD + (size_t)D * DFF * 2;
constexpr size_t R_A0 = WS_WL + (size_t)512 * 256 * 2;
constexpr size_t R_URW = R_A0 + (size_t)MP * D * 2;
constexpr size_t R_QKV = R_URW;
constexpr size_t QKV_ONE = (size_t)MP * 512 * 2;
constexpr size_t R_SI = R_URW + (size_t)MP * RWS * 2;
constexpr size_t SI_ONE = (size_t)MP * 512 * 2;
constexpr size_t R_G = R_SI + 6 * SI_ONE;
constexpr size_t R_TAIL = R_G + SI_ONE;
constexpr size_t O_Y = R_TAIL;
constexpr size_t O_OSB = R_TAIL + SI_ONE;
constexpr size_t WS_END = O_OSB + (size_t)MS * 512 * 2;
constexpr size_t O_A0 = R_A0;
constexpr size_t O_ORW = R_A0;
constexpr size_t O_T1 = R_SI;
constexpr size_t O_M = R_SI + (size_t)MS * D * 4;
constexpr size_t O_P = R_A0;
constexpr size_t O_F = R_SI;
constexpr size_t O_ACT = R_A0;
constexpr size_t O_DN = R_SI + (size_t)MS * D * 2;
static_assert(3 * QKV_ONE <= (size_t)MP * RWS * 2, "overlay");
static_assert(O_M + (size_t)MS * D * 2 <= R_TAIL, "overlay");
static_assert(O_ACT + (size_t)MS * DFF * 2 <= R_SI, "overlay");
static_assert(O_P + (size_t)MS * D * 4 <= R_SI, "overlay");
static_assert(O_DN + (size_t)MS * D * 4 <= R_TAIL, "overlay");
static_assert(WS_END <= (size_t)512 * 1024 * 1024, "workspace");

constexpr int LDS_BYTES = 131072 + 64;

struct Params { const float* in[24]; float* out; unsigned char* ws; };

extern __shared__ __attribute__((aligned(16))) unsigned char smem[];

typedef __bf16 b16x2 __attribute__((ext_vector_type(2)));
__device__ __forceinline__ unsigned pk_bf16(float lo, float hi) { const f32x2 v = {lo, hi}; return __builtin_bit_cast(unsigned, __builtin_convertvector(v, b16x2)); }
__device__ __forceinline__ float bf2f(unsigned short v) { return __uint_as_float((unsigned)v << 16); }
__device__ __forceinline__ float sigmoidf_(float x) { return __builtin_amdgcn_rcpf(1.0f + __expf(-x)); }
__device__ __forceinline__ float softplusf_(float x) { return fmaxf(x, 0.f) + __logf(1.0f + __expf(-fabsf(x))); }
template <int CTRL> __device__ __forceinline__ float dppf(float x) { return __builtin_bit_cast(float, __builtin_amdgcn_mov_dpp(__builtin_bit_cast(int, x), CTRL, 0xf, 0xf, true)); }
__device__ __forceinline__ float reduce16(float v) {
    v += dppf<0xB1>(v); v += dppf<0x4E>(v); v += dppf<0x141>(v); v += dppf<0x140>(v); return v;
}
__device__ __forceinline__ float wave_sum(float v) {
#pragma unroll
    for (int o = 1; o < 64; o <<= 1) v += __shfl_xor(v, o);
    return v;
}

#define LAS __attribute__((address_space(3)))
#define XB_TMO      128
#define XB_XCNT(j)  (256  + 64 * (j))
#define XB_XSUB(j)  (1280 + 64 * (j))
#define XB_XGEN(j)  (2304 + 64 * (j))
#define XB_TOP      3328
#define XB_TOPGEN   3392
#define XCD_BAR_WORDS 3456
#define XB_SPIN_CAP (1u << 18)
__device__ __forceinline__ unsigned xb_ld(unsigned* p)              { return __hip_atomic_load(p, __ATOMIC_RELAXED, __HIP_MEMORY_SCOPE_AGENT); }
__device__ __forceinline__ unsigned xb_add(unsigned* p, unsigned v) { return __hip_atomic_fetch_add(p, v, __ATOMIC_RELAXED, __HIP_MEMORY_SCOPE_AGENT); }
__device__ __forceinline__ unsigned xb_xcc_id() { return (unsigned)__builtin_amdgcn_s_getreg((3 << 11) | 20) & 0xFu; }
#define XB_SPIN(cond, bar) do { unsigned _sp = 0; while (cond) { __builtin_amdgcn_s_sleep(1); \
    if ((++_sp & 255u) == 0u) { if (xb_ld(&(bar)[XB_TMO])) break; if (_sp > XB_SPIN_CAP) { atomicAdd(&(bar)[XB_TMO], 1u); break; } } } } while (0)
struct XcdBarrier { unsigned* bar; unsigned x; volatile LAS unsigned* st; };
__device__ __forceinline__ XcdBarrier xcd_barrier_post(unsigned* bar, volatile LAS unsigned* st) {
    XcdBarrier b; b.bar = bar; b.x = xb_xcc_id(); b.st = st;
    if (threadIdx.x == 0) (void)xb_add(&bar[XB_XCNT(b.x)], 1u);
    return b;
}
__device__ __forceinline__ void xcd_barrier_complete(unsigned* bar, unsigned x, unsigned& nloc, unsigned& nx) {
    const unsigned G = gridDim.x * gridDim.y * gridDim.z;
    unsigned sum, cnt, mine, sp = 0u;
    for (;;) {
        sum = 0u; cnt = 0u; mine = 0u;
#pragma unroll
        for (unsigned j = 0; j < 16; ++j) { const unsigned c = xb_ld(&bar[XB_XCNT(j)]); sum += c; cnt += (c > 0u) ? 1u : 0u; mine = (j == x) ? c : mine; }
        if (sum == G) break;
        __builtin_amdgcn_s_sleep(1);
        if ((++sp & 255u) == 0u) { if (xb_ld(&bar[XB_TMO])) break; if (sp > XB_SPIN_CAP) { atomicAdd(&bar[XB_TMO], 1u); break; } }
    }
    nloc = mine > 0u ? mine : 1u; nx = cnt > 0u ? cnt : 1u;
}
__device__ __forceinline__ void xcd_barrier(const XcdBarrier& b) {
    asm volatile("s_waitcnt vmcnt(0)" ::: "memory");
    __syncthreads();
    if (threadIdx.x == 0) {
        unsigned* bar = b.bar;
        __builtin_amdgcn_s_waitcnt(0);
        unsigned nloc = b.st[0], nx = b.st[1];
        if (nloc == 0u) { xcd_barrier_complete(bar, b.x, nloc, nx); b.st[0] = nloc; b.st[1] = nx; }
        const unsigned old = xb_add(&bar[XB_XSUB(b.x)], 1u);
        const unsigned gen = old / nloc;
        if (old + 1u == (gen + 1u) * nloc) {
            __builtin_amdgcn_fence(__ATOMIC_RELEASE, "agent");
            asm volatile("s_waitcnt vmcnt(0)" ::: "memory");
            const unsigned og = xb_add(&bar[XB_TOP], 1u);
            const unsigned tg = og / nx;
            if (og + 1u == (tg + 1u) * nx) xb_add(&bar[XB_TOPGEN], 1u);
            else XB_SPIN(xb_ld(&bar[XB_TOPGEN]) == tg, bar);
            __builtin_amdgcn_fence(__ATOMIC_ACQUIRE, "agent");
            xb_add(&bar[XB_XGEN(b.x)], 1u);
            asm volatile("s_waitcnt vmcnt(0)" ::: "memory");
        } else {
            XB_SPIN(xb_ld(&bar[XB_XGEN(b.x)]) == gen, bar);
            __builtin_amdgcn_fence(__ATOMIC_ACQUIRE, "agent");
            asm volatile("s_waitcnt vmcnt(0)" ::: "memory");
        }
    }
    __syncthreads();
}

constexpr int BM = 256, BK = 64, HALF = 128, HTB = HALF * BK * 2, NXCD = 8, WGM = 8;
__device__ __forceinline__ int lds_byte(int r, int c) { const int st = (r >> 4) * 2 + (c >> 5), rr = r & 15, cc = c & 31, ob = rr * 64 + cc * 2; return st * 1024 + (ob ^ (((ob >> 9) & 1) << 5)); }
__device__ __forceinline__ void stage_rc(int b, int& R, int& C) { const int st = b / 1024, sb = b % 1024, swz = sb ^ (((sb >> 9) & 1) << 5); R = (st >> 1) * 16 + swz / 64; C = (st & 1) * 32 + (swz % 64) / 2; }
struct Unit { int pm, pn; };
struct Sched {
    int nM, nN, nwg, G, c;
    __device__ __forceinline__ bool next(int i, Unit& u) const {
        const long L = (long)i * G + c; if (L >= nwg) return false;
        int wgid = (int)L; { const int q = nwg / NXCD, r = nwg % NXCD, xcd = wgid % NXCD, off = wgid / NXCD; wgid = (xcd < r ? xcd * (q + 1) : r * (q + 1) + (xcd - r) * q) + off; }
        const int nig = WGM * nN, gid = wgid / nig, fm = gid * WGM, gsz = (nM - fm) < WGM ? (nM - fm) : WGM;
        u.pm = fm + ((wgid % nig) % gsz); u.pn = (wgid % nig) / gsz; return true;
    }
};

template <class Epi>
__device__ __forceinline__ void gemm_phase(const bf16_t* __restrict__ Ag, const bf16_t* __restrict__ Btg, const int K, const int nM, const int nN, const Epi& E,
                                           const int G = (int)gridDim.x, const int c = (int)blockIdx.x, const int pn_from = 1 << 30, const int pn_add = 0) {
    LAS unsigned char* lds = (LAS unsigned char*)smem;
    const int tid = threadIdx.x, wid = __builtin_amdgcn_readfirstlane(tid >> 6), lane = tid & 63, wr = wid >> 2, wc = wid & 3, fr = lane & 15, fq = lane >> 4;
    const int nt = K / BK;
    Sched S; S.nM = nM; S.nN = nN; S.nwg = nM * nN; S.G = G; S.c = c;
    unsigned voffA[2], voffB[2];
#pragma unroll
    for (int i = 0; i < 2; ++i) { int R, C; stage_rc(tid * 16 + i * 8192, R, C);
        const int Rb = Epi::PERM ? ((R & ~31) + 8 * ((R & 15) >> 2) + 4 * ((R & 31) >> 4) + (R & 3)) : R;
        voffA[i] = (unsigned)(R * K + C) * 2u; voffB[i] = (unsigned)(Rb * K + C) * 2u; }
    const size_t kstep = (size_t)(BK * 2);
    const size_t hstep = (size_t)HALF * K * 2;
    const size_t tstep = 2 * hstep;
    const unsigned ldsw = (unsigned)wid * 1024u;
    const int aoff = lds_byte(wr * 64 + fr, fq * 8), boff = lds_byte(wc * 32 + fr, fq * 8);
#define PG8_SA(b, h) (((b) * 2 + (h)) * HTB)
#define PG8_SB(b, h) ((4 + (b) * 2 + (h)) * HTB)
#define PG8_STAGE(bufoff, gbase, voff) do { _Pragma("unroll") for (int _i = 0; _i < 2; ++_i) \
        __builtin_amdgcn_global_load_lds((const unsigned*)((const char*)(gbase) + (voff)[_i]), (LAS unsigned*)(lds + (bufoff) + ldsw + _i * 8192), 16, 0, 0); } while (0)
#define PG8_LDA(dst, b, h) do { _Pragma("unroll") for (int m = 0; m < 4; ++m) _Pragma("unroll") for (int k = 0; k < 2; ++k) dst[m][k] = *(const LAS bf16x8*)(lds + PG8_SA(b, h) + aoff + m * 2048 + k * 1024); } while (0)
#define PG8_LDB(dst, b, h) do { _Pragma("unroll") for (int n = 0; n < 2; ++n) _Pragma("unroll") for (int k = 0; k < 2; ++k) dst[n][k] = *(const LAS bf16x8*)(lds + PG8_SB(b, h) + boff + n * 2048 + k * 1024); } while (0)
#define PG8_MMA(ai, bj, At, Bt) do { __builtin_amdgcn_s_setprio(1); _Pragma("unroll") for (int m = 0; m < 4; ++m) _Pragma("unroll") for (int n = 0; n < 2; ++n) _Pragma("unroll") for (int k = 0; k < 2; ++k) \
        acc[ai][bj][m][n] = __builtin_amdgcn_mfma_f32_16x16x32_bf16(Bt[n][k], At[m][k], acc[ai][bj][m][n], 0, 0, 0); __builtin_amdgcn_s_setprio(0); } while (0)
#define PG8_WAIT_V(n) asm volatile("s_waitcnt vmcnt(" #n ")" ::: "memory")
#define PG8_WAIT_L(n) asm volatile("s_waitcnt lgkmcnt(" #n ")" ::: "memory")
#define PG8_BAR __builtin_amdgcn_s_barrier()
#define PG8_SCHED __builtin_amdgcn_sched_barrier(0)
    Unit cur, nxt; int ui = 0;
    __syncthreads();
    if (!S.next(0, cur)) return;
    if (cur.pn >= pn_from) cur.pn += pn_add;
    f32x4 acc[2][2][4][2];
#pragma unroll
    for (int a = 0; a < 2; ++a)
#pragma unroll
        for (int b = 0; b < 2; ++b)
#pragma unroll
            for (int m = 0; m < 4; ++m)
#pragma unroll
                for (int n = 0; n < 2; ++n) acc[a][b][m][n] = (f32x4){0.f, 0.f, 0.f, 0.f};
    bf16x8 At[4][2], B0[2][2], B1[2][2];
    const char* cA = (const char*)Ag + (size_t)cur.pm * tstep; const char* cB = (const char*)Btg + (size_t)cur.pn * tstep;
    PG8_STAGE(PG8_SB(0, 0), cB, voffB); PG8_STAGE(PG8_SB(0, 1), cB + hstep, voffB); PG8_STAGE(PG8_SA(0, 0), cA, voffA); PG8_STAGE(PG8_SA(0, 1), cA + hstep, voffA);
    if (wr == 1) PG8_BAR;
    PG8_WAIT_V(2); PG8_BAR;
    PG8_STAGE(PG8_SB(1, 0), cB + kstep, voffB); PG8_STAGE(PG8_SA(1, 0), cA + kstep, voffA); PG8_STAGE(PG8_SB(1, 1), cB + hstep + kstep, voffB);
    PG8_WAIT_V(6); PG8_BAR;
    for (;;) {
        const bool has_next = S.next(ui + 1, nxt);
        if (has_next && nxt.pn >= pn_from) nxt.pn += pn_add;
        const char* nA = has_next ? (const char*)Ag + (size_t)nxt.pm * tstep : cA; const char* nB = has_next ? (const char*)Btg + (size_t)nxt.pn * tstep : cB;
        for (int t = 0; t < nt; t += 2) {
            const bool last = (t == nt - 2);
            const char* a1 = cA + (size_t)(t + 1) * kstep;
            const char* a2 = last ? nA : cA + (size_t)(t + 2) * kstep; const char* b2 = last ? nB : cB + (size_t)(t + 2) * kstep;
            const char* a3 = a2 + kstep; const char* b3 = b2 + kstep;
            PG8_LDB(B0, 0, 0); PG8_LDB(B1, 0, 1); PG8_SCHED; PG8_LDA(At, 0, 0); PG8_STAGE(PG8_SA(1, 1), a1 + hstep, voffA);
            PG8_WAIT_V(8); PG8_WAIT_L(0); PG8_BAR; PG8_MMA(0, 0, At, B0); PG8_MMA(0, 1, At, B1); PG8_BAR; PG8_SCHED;
            PG8_LDA(At, 0, 1); PG8_STAGE(PG8_SB(0, 0), b2, voffB); PG8_STAGE(PG8_SB(0, 1), b2 + hstep, voffB); PG8_STAGE(PG8_SA(0, 0), a2, voffA);
            PG8_WAIT_V(8); PG8_WAIT_L(0); PG8_BAR; PG8_MMA(1, 0, At, B0); PG8_MMA(1, 1, At, B1); PG8_BAR; PG8_SCHED;
            PG8_LDB(B0, 1, 0); PG8_LDB(B1, 1, 1); PG8_SCHED; PG8_LDA(At, 1, 0); PG8_STAGE(PG8_SA(0, 1), a2 + hstep, voffA);
            PG8_WAIT_V(8); PG8_WAIT_L(0); PG8_BAR; PG8_MMA(0, 0, At, B0); PG8_MMA(0, 1, At, B1); PG8_BAR; PG8_SCHED;
            PG8_LDA(At, 1, 1); PG8_STAGE(PG8_SB(1, 0), b3, voffB); PG8_STAGE(PG8_SB(1, 1), b3 + hstep, voffB); PG8_STAGE(PG8_SA(1, 0), a3, voffA);
            PG8_WAIT_V(8); PG8_WAIT_L(0); PG8_BAR; PG8_MMA(1, 0, At, B0); PG8_MMA(1, 1, At, B1); PG8_BAR; PG8_SCHED;
        }
        if (wr == 0) PG8_BAR;
        {
            const int brow = cur.pm * BM, bcol = cur.pn * BM;
#pragma unroll
            for (int ai = 0; ai < 2; ++ai)
#pragma unroll
                for (int m = 0; m < 4; ++m) {
                    E.row(brow + ai * HALF + wr * 64 + m * 16 + fr, bcol + wc * 32, fq, acc[ai][0][m][0], acc[ai][0][m][1], acc[ai][1][m][0], acc[ai][1][m][1]);
                    asm volatile("" ::: "memory");
                }
        }
        if (!has_next) break;
#pragma unroll
        for (int a = 0; a < 2; ++a)
#pragma unroll
            for (int b = 0; b < 2; ++b)
#pragma unroll
                for (int m = 0; m < 4; ++m)
#pragma unroll
                    for (int n = 0; n < 2; ++n) acc[a][b][m][n] = (f32x4){0.f, 0.f, 0.f, 0.f};
        cur = nxt; cA = nA; cB = nB; ++ui;
        if (wr == 1) PG8_BAR;
    }
    PG8_WAIT_V(0);
    PG8_BAR;
#undef PG8_SA
#undef PG8_SB
#undef PG8_STAGE
#undef PG8_LDA
#undef PG8_LDB
#undef PG8_MMA
#undef PG8_WAIT_V
#undef PG8_WAIT_L
#undef PG8_BAR
#undef PG8_SCHED
}

template <bool PERM_> struct EpiInProj {
    static constexpr bool PERM = PERM_;
    bf16_t* qkv; _Float16* urw; bf16_t* gates;
    __device__ __forceinline__ void one(int row, int col, const f32x4& v) const {
        if (col < 1536) {
            const int which = col >> 9, hc = col & 511, h = hc >> 6, d = hc & 63, b = row / TP, t = row - b * TP;
            const float s = which == 0 ? 0.125f : 1.0f;
            u32x2 w; w.x = pk_bf16(v[0] * s, v[1] * s); w.y = pk_bf16(v[2] * s, v[3] * s);
            *(u32x2*)(qkv + (size_t)which * (QKV_ONE / 2) + ((size_t)(b * NH + h) * TP + t) * 64 + d) = w;
        } else if (col < 3328) {
            h16x4 o; o[0] = (_Float16)v[0]; o[1] = (_Float16)v[1]; o[2] = (_Float16)v[2]; o[3] = (_Float16)v[3];
            *(h16x4*)(urw + (size_t)row * RWS + (col - 1536)) = o;
        } else {
            const int b = row / TP, t = row - b * TP;
            if (t >= NMETA && t < T) {
                u32x2 w; w.x = pk_bf16(sigmoidf_(v[0]), sigmoidf_(v[1])); w.y = pk_bf16(sigmoidf_(v[2]), sigmoidf_(v[3]));
                *(u32x2*)(gates + (size_t)(b * SEQ + t - NMETA) * 2048 + (col - 3328)) = w;
            }
        }
    }
    __device__ __forceinline__ void half(int row, int col32, int fq, const f32x4& v0, const f32x4& v1) const {
        if constexpr (PERM_) {
            const int col = col32 + 8 * fq, b = row / TP, t = row - b * TP;
            if (col < 1536) {
                const int which = col >> 9, hc = col & 511, h = hc >> 6, d = hc & 63;
                const float s = which == 0 ? 0.125f : 1.0f;
                u32x4 w; w.x = pk_bf16(v0[0] * s, v0[1] * s); w.y = pk_bf16(v0[2] * s, v0[3] * s); w.z = pk_bf16(v1[0] * s, v1[1] * s); w.w = pk_bf16(v1[2] * s, v1[3] * s);
                *(u32x4*)(qkv + (size_t)which * (QKV_ONE / 2) + ((size_t)(b * NH + h) * TP + t) * 64 + d) = w;
            } else if (t >= NMETA && t < T) {
                u32x4 w; w.x = pk_bf16(sigmoidf_(v0[0]), sigmoidf_(v0[1])); w.y = pk_bf16(sigmoidf_(v0[2]), sigmoidf_(v0[3]));
                w.z = pk_bf16(sigmoidf_(v1[0]), sigmoidf_(v1[1])); w.w = pk_bf16(sigmoidf_(v1[2]), sigmoidf_(v1[3]));
                *(u32x4*)(gates + (size_t)(b * SEQ + t - NMETA) * 2048 + (col - 3328)) = w;
            }
        } else {
            if (col32 >= 1536 && col32 < 3072) {
                const int c = col32 - 1536, pos = (c & ~63) + fq * 16 + ((c & 63) >> 4) * 4;
                h16x8 o;
#pragma unroll
                for (int j = 0; j < 4; ++j) { o[j] = (_Float16)v0[j]; o[4 + j] = (_Float16)v1[j]; }
                *(h16x8*)(urw + (size_t)row * RWS + pos) = o;
            } else { one(row, col32 + 4 * fq, v0); one(row, col32 + 16 + 4 * fq, v1); }
        }
    }
    __device__ __forceinline__ void row(int r, int col32, int fq, const f32x4& a00, const f32x4& a01, const f32x4& a10, const f32x4& a11) const { half(r, col32, fq, a00, a01); half(r, col32 + HALF, fq, a10, a11); }
};
__device__ __forceinline__ void bf8_to_f(const u32x4& g, float (&f)[8]) {
#pragma unroll
    for (int i = 0; i < 4; ++i) { f[2 * i] = __uint_as_float(g[i] << 16); f[2 * i + 1] = __uint_as_float(g[i] & 0xffff0000u); }
}
struct EpiBranch1 {
    static constexpr bool PERM = true;
    bf16_t* t1; const bf16_t* gates;
    __device__ __forceinline__ void half(int row, int col32, int fq, const f32x4& v0, const f32x4& v1) const {
        const int col = col32 + 8 * fq;
        float g[8]; bf8_to_f(*(const u32x4*)(gates + (size_t)row * 2048 + col), g);
        u32x4 w; w.x = pk_bf16(v0[0] * g[0], v0[1] * g[1]); w.y = pk_bf16(v0[2] * g[2], v0[3] * g[3]); w.z = pk_bf16(v1[0] * g[4], v1[1] * g[5]); w.w = pk_bf16(v1[2] * g[6], v1[3] * g[7]);
        *(u32x4*)(t1 + (size_t)row * D + col) = w;
    }
    __device__ __forceinline__ void row(int r, int col32, int fq, const f32x4& a00, const f32x4& a01, const f32x4& a10, const f32x4& a11) const { half(r, col32, fq, a00, a01); half(r, col32 + HALF, fq, a10, a11); }
};
struct EpiBranch2 {
    static constexpr bool PERM = true;
    const bf16_t* t1; const bf16_t* gates; bf16_t* m;
    __device__ __forceinline__ void half(int row, int col32, int fq, const f32x4& v0, const f32x4& v1) const {
        const int col = col32 + 8 * fq;
        float g[8], a[8]; bf8_to_f(*(const u32x4*)(gates + (size_t)row * 2048 + 1024 + col), g); bf8_to_f(*(const u32x4*)(t1 + (size_t)row * D + col), a);
        u32x4 w; w.x = pk_bf16(a[0] + v0[0] * g[0], a[1] + v0[1] * g[1]); w.y = pk_bf16(a[2] + v0[2] * g[2], a[3] + v0[3] * g[3]);
        w.z = pk_bf16(a[4] + v1[0] * g[4], a[5] + v1[1] * g[5]); w.w = pk_bf16(a[6] + v1[2] * g[6], a[7] + v1[3] * g[7]);
        *(u32x4*)(m + (size_t)row * D + col) = w;
    }
    __device__ __forceinline__ void row(int r, int col32, int fq, const f32x4& a00, const f32x4& a01, const f32x4& a10, const f32x4& a11) const { half(r, col32, fq, a00, a01); half(r, col32 + HALF, fq, a10, a11); }
};
struct EpiF32 {
    static constexpr bool PERM = true;
    float* o;
    __device__ __forceinline__ void row(int r, int col32, int fq, const f32x4& a00, const f32x4& a01, const f32x4& a10, const f32x4& a11) const {
        float* q = o + (size_t)r * D + col32 + 8 * fq;
        *(f32x4*)q = a00; *(f32x4*)(q + 4) = a01; *(f32x4*)(q + HALF) = a10; *(f32x4*)(q + HALF + 4) = a11;
    }
};
struct EpiBf16 {
    static constexpr bool PERM = true;
    bf16_t* o;
    __device__ __forceinline__ void row(int r, int col32, int fq, const f32x4& a00, const f32x4& a01, const f32x4& a10, const f32x4& a11) const {
        bf16_t* q = o + (size_t)r * D + col32 + 8 * fq;
        u32x4 w0, w1;
        w0.x = pk_bf16(a00[0], a00[1]); w0.y = pk_bf16(a00[2], a00[3]); w0.z = pk_bf16(a01[0], a01[1]); w0.w = pk_bf16(a01[2], a01[3]);
        w1.x = pk_bf16(a10[0], a10[1]); w1.y = pk_bf16(a10[2], a10[3]); w1.z = pk_bf16(a11[0], a11[1]); w1.w = pk_bf16(a11[2], a11[3]);
        *(u32x4*)q = w0; *(u32x4*)(q + HALF) = w1;
    }
};
struct EpiGU {
    static constexpr bool PERM = true;
    bf16_t* act;
    __device__ __forceinline__ void row(int r, int col32, int fq, const f32x4& g0, const f32x4& g1, const f32x4& u0, const f32x4& u1) const {
        float o[8];
#pragma unroll
        for (int j = 0; j < 4; ++j) { o[j] = g0[j] * sigmoidf_(g0[j]) * u0[j]; o[4 + j] = g1[j] * sigmoidf_(g1[j]) * u1[j]; }
        u32x4 w; w.x = pk_bf16(o[0], o[1]); w.y = pk_bf16(o[2], o[3]); w.z = pk_bf16(o[4], o[5]); w.w = pk_bf16(o[6], o[7]);
        const int pn = col32 >> 8, cin = (col32 & 255) + 8 * fq;
        *(u32x4*)(act + (size_t)r * DFF + pn * 128 + cin) = w;
    }
};

__device__ __forceinline__ void transpose_tile(const float* __restrict__ src, int K, int N, bf16_t* __restrict__ dst, int ldd, int koff, int mode, int tile) {
    float* scr = (float*)smem;
    const int ntn = N / 128, kb = tile / ntn, nb = tile % ntn, k0 = kb * 64, n0 = nb * 128, tid = threadIdx.x;
    f32x4 v[4];
#pragma unroll
    for (int i = 0; i < 4; ++i) { const int idx = tid + 512 * i, kk = idx >> 5, n4 = idx & 31; v[i] = *(const f32x4*)(src + (size_t)(k0 + kk) * N + n0 + n4 * 4); }
#pragma unroll
    for (int i = 0; i < 4; ++i) { const int idx = tid + 512 * i, kk = idx >> 5, n4 = idx & 31;
#pragma unroll
        for (int c = 0; c < 4; ++c) scr[kk * 129 + n4 * 4 + c] = v[i][c]; }
    __syncthreads();
#pragma unroll
    for (int i = 0; i < 2; ++i) {
        const int o = tid + 512 * i, n = o >> 3, kc = (o & 7) * 8;
        u32x4 w;
        w.x = pk_bf16(scr[(kc + 0) * 129 + n], scr[(kc + 1) * 129 + n]); w.y = pk_bf16(scr[(kc + 2) * 129 + n], scr[(kc + 3) * 129 + n]);
        w.z = pk_bf16(scr[(kc + 4) * 129 + n], scr[(kc + 5) * 129 + n]); w.w = pk_bf16(scr[(kc + 6) * 129 + n], scr[(kc + 7) * 129 + n]);
        const int f = n0 + n;
        const int drow = mode == 0 ? f : ((f >> 7) * 256 + (mode == 2 ? 128 : 0) + (f & 127));
        *(u32x4*)(dst + (size_t)drow * ldd + koff + k0 + kc) = w;
    }
    __syncthreads();
}

__device__ __forceinline__ void phase0(const Params& p) {
    unsigned char* ws = p.ws;
    if (blockIdx.x == 0 && threadIdx.x < 64) ((unsigned*)(ws + WS_CTL))[threadIdx.x] = 0u;
    constexpr int J0 = 16 * 42, J1 = 8 * 8, J3 = 16 * 8, J4 = 16 * 22, J6 = 44 * 8, J7 = 4, J9 = 8;
    constexpr int NT = J0 + 2 * J1 + J3 + 2 * J4 + J6 + 2 * J7 + J9;
    constexpr int NR = MP / 32;
    for (int it = blockIdx.x; it < NT + NR; it += gridDim.x) {
        if (it >= NR) {
            int r = it - NR;
            if (r < J0) { transpose_tile(p.in[4], D, PIN, (bf16_t*)(ws + WS_WIN), D, 0, 0, r); continue; } r -= J0;
            if (r < J1) { transpose_tile(p.in[16], 512, D, (bf16_t*)(ws + WS_WSB), 512, 0, 0, r); continue; } r -= J1;
            if (r < J1) { transpose_tile(p.in[17], 512, D, (bf16_t*)(ws + WS_WRW), 512, 0, 0, r); continue; } r -= J1;
            if (r < J3) { transpose_tile(p.in[18], D, D, (bf16_t*)(ws + WS_WOUT), D, 0, 0, r); continue; } r -= J3;
            if (r < J4) { transpose_tile(p.in[21], D, DFF, (bf16_t*)(ws + WS_WGU), D, 0, 1, r); continue; } r -= J4;
            if (r < J4) { transpose_tile(p.in[22], D, DFF, (bf16_t*)(ws + WS_WGU), D, 0, 2, r); continue; } r -= J4;
            if (r < J6) { transpose_tile(p.in[23], DFF, D, (bf16_t*)(ws + WS_WD), DFF, 0, 0, r); continue; } r -= J6;
            if (r < J7) { transpose_tile(p.in[6], 64, 512, (bf16_t*)(ws + WS_WL), 256, 0, 0, r); continue; } r -= J7;
            if (r < J7) { transpose_tile(p.in[8], 64, 512, (bf16_t*)(ws + WS_WL), 256, 64, 0, r); continue; } r -= J7;
            transpose_tile(p.in[10], 128, 512, (bf16_t*)(ws + WS_WL), 256, 128, 0, r);
        } else {
            const int lane = threadIdx.x & 63, row0 = it * 32 + (threadIdx.x >> 6) * 4;
            f32x4 v[4][4];
#pragma unroll
            for (int r = 0; r < 4; ++r) {
                const int row = row0 + r, b = row / TP, t = row - b * TP;
                const float* src = t < NMETA ? p.in[1] + (size_t)t * D : p.in[0] + ((size_t)b * SEQ + (t < T ? t - NMETA : 0)) * D;
#pragma unroll
                for (int j = 0; j < 4; ++j) v[r][j] = __builtin_nontemporal_load((const f32x4*)(src + 4 * lane + 256 * j));
            }
            f32x4 g[4];
#pragma unroll
            for (int j = 0; j < 4; ++j) g[j] = *(const f32x4*)(p.in[2] + 4 * lane + 256 * j);
#pragma unroll
            for (int r = 0; r < 4; ++r) {
                const int row = row0 + r, b = row / TP, t = row - b * TP;
                float ss = 0.f;
#pragma unroll
                for (int j = 0; j < 4; ++j) ss += (v[r][j][0] * v[r][j][0] + v[r][j][1] * v[r][j][1]) + (v[r][j][2] * v[r][j][2] + v[r][j][3] * v[r][j][3]);
                const float rs = t < T ? rsqrtf(wave_sum(ss) * (1.0f / D) + RMS_EPS) : 0.f;
                bf16_t* orow = (bf16_t*)(ws + O_A0) + (size_t)row * D;
#pragma unroll
                for (int j = 0; j < 4; ++j) {
                    u32x2 w; w.x = pk_bf16(v[r][j][0] * rs * g[j][0], v[r][j][1] * rs * g[j][1]); w.y = pk_bf16(v[r][j][2] * rs * g[j][2], v[r][j][3] * rs * g[j][3]);
                    *(u32x2*)(orow + 4 * lane + 256 * j) = w;
                }
            }
        }
    }
}

__device__ __forceinline__ void phase1(const Params& p) {
    unsigned char* ws = p.ws;
    EpiInProj<false> epi{(bf16_t*)(ws + R_QKV), (_Float16*)(ws + R_URW), (bf16_t*)p.out};
    gemm_phase((const bf16_t*)(ws + O_A0), (const bf16_t*)(ws + WS_WIN), D, MP / BM, 7, epi, (int)gridDim.x, (int)blockIdx.x, 0, 6);
}

constexpr int SI_R = 0, SI_W = 1, SI_K = 2, SI_V = 3, SI_KK = 4, SI_B = 5;
constexpr int ALD = 264;
constexpr int P2_WLS = 64 * ALD * 2;
constexpr int P2_MU = P2_WLS;
constexpr int P2_AL = P2_MU + 1024;
__device__ __forceinline__ void phase2_main(const Params& p) {
    unsigned char* ws = p.ws;
    const int tid = threadIdx.x, wave = tid >> 6, lane = tid & 63, fr = lane & 15, fq = lane >> 4;
    const int h = blockIdx.x & 7, nslot = (gridDim.x >> 3) * 8, slot = (blockIdx.x >> 3) * 8 + wave;
    const _Float16* urw = (const _Float16*)(ws + R_URW);
    const float* mu = p.in[5];
    bf16_t* WLs = (bf16_t*)smem;
    float* mus = (float*)(smem + P2_MU);
    bf16_t* Al = (bf16_t*)(smem + P2_AL) + wave * (16 * ALD);
    __syncthreads();
    {
        const bf16_t* WL = (const bf16_t*)(ws + WS_WL) + (size_t)h * 64 * 256;
#pragma unroll
        for (int i = 0; i < 4; ++i) { const int idx = tid + 512 * i, row = idx >> 5, c16 = idx & 31; *(u32x4*)(WLs + row * ALD + c16 * 8) = *(const u32x4*)(WL + row * 256 + c16 * 8); }
        if (tid < 256) mus[tid] = mu[1536 + tid];
    }
    __syncthreads();
    if (blockIdx.x >= nslot) return;
    _Float16* SI = (_Float16*)(ws + R_SI);
    bf16_t* G = (bf16_t*)(ws + R_G);
    constexpr size_t SIE = (size_t)MP * 512;
#pragma unroll 1
    for (int g = slot; g < NB * 514; g += nslot) {
        const int ub = g / 514, ui = g - ub * 514, row0 = ub * TP + ui * 16;
        {
            const int half = lane >> 5, pc = (lane & 31) * 8;
            const float sA = pc < 64 ? 2.f : 1.f, sC = pc < 64 ? -1.f : 0.f;
            const bool lin = pc >= 64 && pc < 128;
            const f32x4 mA = *(const f32x4*)(mu + 1536 + pc), mB = *(const f32x4*)(mu + 1536 + pc + 4);
            h16x8 c[8], pv[8];
#pragma unroll
            for (int q = 0; q < 8; ++q) {
                const int rowa = row0 + 2 * q + half, ta = rowa % TP;
                const _Float16* cur = urw + (size_t)rowa * RWS + 1536 + pc;
                c[q] = *(const h16x8*)cur;
                pv[q] = *(const h16x8*)(ta > 0 ? cur - RWS : cur);
            }
#pragma unroll
            for (int q = 0; q < 8; ++q) {
                const int ta = (row0 + 2 * q + half) % TP;
                float o[8];
#pragma unroll
                for (int e = 0; e < 8; ++e) {
                    const float cf = (float)c[q][e], pf = ta > 0 ? (float)pv[q][e] : 0.f;
                    const float xs = cf + (e < 4 ? mA[e & 3] : mB[e & 3]) * (pf - cf);
                    const float sg = __builtin_amdgcn_rcpf(1.0f + __expf(-sA * xs));
                    o[e] = lin ? xs : sA * sg + sC;
                }
                u32x4 w; w.x = pk_bf16(o[0], o[1]); w.y = pk_bf16(o[2], o[3]); w.z = pk_bf16(o[4], o[5]); w.w = pk_bf16(o[6], o[7]);
                *(u32x4*)(Al + (2 * q + half) * ALD + pc) = w;
            }
        }
        asm volatile("s_waitcnt lgkmcnt(0)" ::: "memory");
        __builtin_amdgcn_wave_barrier();
        f32x4 acc[4];
        auto lora = [&](auto kbeg_c, auto ksteps_c) {
            constexpr int kbeg = decltype(kbeg_c)::value, ksteps = decltype(ksteps_c)::value;
#pragma unroll
            for (int n = 0; n < 4; ++n) acc[n] = (f32x4){0.f, 0.f, 0.f, 0.f};
#pragma unroll
            for (int ks = 0; ks < ksteps; ++ks) {
                const bf16x8 af = *(const bf16x8*)(Al + fr * ALD + kbeg + ks * 32 + fq * 8);
#pragma unroll
                for (int n = 0; n < 4; ++n) {
                    const bf16x8 wf = *(const bf16x8*)(WLs + (n * 16 + fr) * ALD + kbeg + ks * 32 + fq * 8);
                    acc[n] = __builtin_amdgcn_mfma_f32_16x16x32_bf16(wf, af, acc[n], 0, 0, 0);
                }
            }
        };
        const int row = row0 + fr, b = row / TP, t = row - b * TP;
        const size_t base = ((size_t)(b * NH + h) * TP + t) * 448;
        const _Float16* ur = urw + (size_t)row * RWS;
        const size_t pb = base + fq * 16;
        lora(std::integral_constant<int, 0>{}, std::integral_constant<int, 2>{});
        {
            h16x8 wo[2];
#pragma unroll
            for (int n = 0; n < 4; ++n) {
                const f32x4 db = *(const f32x4*)(p.in[7] + h * 64 + n * 16 + fq * 4);
#pragma unroll
                for (int j = 0; j < 4; ++j) {
                    const float e = sigmoidf_(db[j] + acc[n][j]) * 0.60653065971f;
                    wo[n >> 1][(n & 1) * 4 + j] = (_Float16)(1.0f - __expf(-e));
                }
            }
            *(h16x8*)(SI + SI_W * 64 + pb) = wo[0]; *(h16x8*)(SI + SI_W * 64 + pb + 8) = wo[1];
        }
        lora(std::integral_constant<int, 64>{}, std::integral_constant<int, 2>{});
        {
            const _Float16* up = ur + h * 64 + fq * 16;
            const _Float16* upp = t > 0 ? up - RWS : up;
            h16x8 kc[2], rc[2], vc[2], kp[2], rp[2], vp[2];
#pragma unroll
            for (int i = 0; i < 2; ++i) {
                rc[i] = *(const h16x8*)(up + i * 8); kc[i] = *(const h16x8*)(up + 512 + i * 8); vc[i] = *(const h16x8*)(up + 1024 + i * 8);
                rp[i] = *(const h16x8*)(upp + i * 8); kp[i] = *(const h16x8*)(upp + 512 + i * 8); vp[i] = *(const h16x8*)(upp + 1024 + i * 8);
            }
            float kv[4][4], av[4][4], kkr[4][4]; float ss = 0.f;
            h16x8 ro[2];
#pragma unroll
            for (int n = 0; n < 4; ++n) {
                const int c = n * 16 + fq * 4, c512 = h * 64 + c;
                const f32x4 muk = *(const f32x4*)(mu + 512 + c512), mur = *(const f32x4*)(mu + c512), muv = *(const f32x4*)(mu + 1024 + c512);
                const f32x4 ab = *(const f32x4*)(p.in[9] + c512), kkw = *(const f32x4*)(p.in[11] + c512);
                h16x4 vo;
#pragma unroll
                for (int j = 0; j < 4; ++j) {
                    const int i = n >> 1, e = (n & 1) * 4 + j;
                    const float kcf = (float)kc[i][e], kpf = t > 0 ? (float)kp[i][e] : 0.f;
                    const float rcf = (float)rc[i][e], rpf = t > 0 ? (float)rp[i][e] : 0.f;
                    const float vcf = (float)vc[i][e], vpf = t > 0 ? (float)vp[i][e] : 0.f;
                    kv[n][j] = kcf + muk[j] * (kpf - kcf);
                    ro[i][e] = (_Float16)(rcf + mur[j] * (rpf - rcf));
                    vo[j] = (_Float16)(vcf + muv[j] * (vpf - vcf));
                    av[n][j] = sigmoidf_(ab[j] + acc[n][j]);
                    kkr[n][j] = kv[n][j] * kkw[j];
                    ss += kkr[n][j] * kkr[n][j];
                }
                *(h16x4*)(SI + SI_V * 64 + base + c) = vo;
            }
            *(h16x8*)(SI + SI_R * 64 + pb) = ro[0]; *(h16x8*)(SI + SI_R * 64 + pb + 8) = ro[1];
            ss += __shfl_xor(ss, 16); ss += __shfl_xor(ss, 32);
            const float inv = fminf(__builtin_amdgcn_rsqf(ss), 1e12f);
            h16x8 ko[2], kko[2], bo[2];
#pragma unroll
            for (int n = 0; n < 4; ++n) {
                const f32x4 ka = *(const f32x4*)(p.in[12] + h * 64 + n * 16 + fq * 4);
#pragma unroll
                for (int j = 0; j < 4; ++j) {
                    const int i = n >> 1, e = (n & 1) * 4 + j;
                    const float kk = kkr[n][j] * inv;
                    ko[i][e] = (_Float16)(kv[n][j] * (1.0f + (av[n][j] - 1.0f) * ka[j]));
                    kko[i][e] = (_Float16)kk;
                    bo[i][e] = (_Float16)(kk * av[n][j]);
                }
            }
#pragma unroll
            for (int i = 0; i < 2; ++i) {
                *(h16x8*)(SI + SI_K * 64 + pb + i * 8) = ko[i]; *(h16x8*)(SI + SI_KK * 64 + pb + i * 8) = kko[i]; *(h16x8*)(SI + SI_B * 64 + pb + i * 8) = bo[i];
            }
        }
        lora(std::integral_constant<int, 128>{}, std::integral_constant<int, 4>{});
        {
            u32x4 g0, g1;
            g0.x = pk_bf16(acc[0][0], acc[0][1]); g0.y = pk_bf16(acc[0][2], acc[0][3]); g0.z = pk_bf16(acc[1][0], acc[1][1]); g0.w = pk_bf16(acc[1][2], acc[1][3]);
            g1.x = pk_bf16(acc[2][0], acc[2][1]); g1.y = pk_bf16(acc[2][2], acc[2][3]); g1.z = pk_bf16(acc[3][0], acc[3][1]); g1.w = pk_bf16(acc[3][2], acc[3][3]);
            *(u32x4*)((bf16_t*)SI + 6 * 64 + pb) = g0; *(u32x4*)((bf16_t*)SI + 6 * 64 + pb + 8) = g1;
        }
        asm volatile("s_waitcnt lgkmcnt(0)" ::: "memory");
        __builtin_amdgcn_wave_barrier();
    }
}
__device__ __forceinline__ void phase2_kmax(const Params& p, int item) {
    unsigned char* ws = p.ws;
    const int bh = item >> 2, qr = item & 3, tid = threadIdx.x;
    float* red = (float*)(smem + P2_AL + 8 * 16 * ALD * 2);
    float ss = 0.f;
    for (int t = qr * 2052 + tid; t < (qr + 1) * 2052; t += 512) {
        const bf16_t* kr = (const bf16_t*)(ws + R_QKV) + QKV_ONE / 2 + ((size_t)bh * TP + t) * 64;
        float s1 = 0.f;
#pragma unroll
        for (int q = 0; q < 8; ++q) {
            const u32x4 v = *(const u32x4*)(kr + q * 8);
#pragma unroll
            for (int e = 0; e < 4; ++e) { const float lo = __uint_as_float(v[e] << 16), hi = __uint_as_float(v[e] & 0xffff0000u); s1 += lo * lo + hi * hi; }
        }
        ss = fmaxf(ss, s1);
    }
#pragma unroll
    for (int o = 1; o < 64; o <<= 1) ss = fmaxf(ss, __shfl_xor(ss, o));
    __syncthreads();
    if ((tid & 63) == 0) red[tid >> 6] = ss;
    __syncthreads();
    if (tid == 0) {
        float m = red[0];
#pragma unroll
        for (int w = 1; w < 8; ++w) m = fmaxf(m, red[w]);
        ((float*)(ws + WS_CTL))[16 + item] = m;
    }
}
__device__ __forceinline__ void phase2(const Params& p) {
    phase2_main(p);
}

constexpr int SC_TC = 32, SC_NC = (T + SC_TC - 1) / SC_TC;
constexpr int SC_ARR = SC_TC * 64;
constexpr int SC_VOFF = 5 * SC_ARR, SC_COFF = SC_VOFF + SC_TC * 16;
constexpr int SC_BUF = (SC_COFF + SC_TC) * 4;
constexpr int SC_YOFF = 2 * SC_BUF, SC_YBUF = SC_TC * 16 * 4;
__device__ __forceinline__ float dot4(const f32x4& a, const f32x4& b) {
    f32x2 t = __builtin_shufflevector(a, a, 0, 1) * __builtin_shufflevector(b, b, 0, 1);
    t = __builtin_shufflevector(a, a, 2, 3) * __builtin_shufflevector(b, b, 2, 3) + t;
    return t[0] + t[1];
}
__device__ __forceinline__ void reduce16x2(float& a, float& b) {
    a += dppf<0xB1>(a); b += dppf<0xB1>(b); a += dppf<0x4E>(a); b += dppf<0x4E>(b);
    a += dppf<0x141>(a); b += dppf<0x141>(b); a += dppf<0x140>(a); b += dppf<0x140>(b);
}
__device__ __forceinline__ void scan_unit(const Params& p, int unit) {
    unsigned char* ws = p.ws;
    const int bh = unit >> 2, vr0 = (unit & 3) * 16, tid = threadIdx.x, wave = tid >> 6, lane = tid & 63;
    const _Float16* SI = (const _Float16*)(ws + R_SI);
    constexpr size_t SIE = (size_t)MP * 512;
    bf16_t* Y = (bf16_t*)(ws + O_Y);
    const size_t hb = (size_t)bh * TP * 64;
    __syncthreads();
    if (wave >= 4) {
        const int i = tid - 256, ip = i >= 8 ? i - 8 : i;
        const int arrs[5] = {SI_R, SI_W, SI_K, SI_KK, SI_B};
        u32x4 rg[5], rp[3]; unsigned rv;
        auto issue = [&](int c) {
            const size_t off = ((size_t)bh * TP + (size_t)c * SC_TC + (i >> 3)) * 448 + (i & 7) * 8;
            const size_t offp = i >= 8 ? off - 448 : off;
#pragma unroll
            for (int a = 0; a < 5; ++a) rg[a] = *(const u32x4*)(SI + arrs[a] * 64 + off);
            rp[0] = *(const u32x4*)(SI + SI_W * 64 + offp);
            rp[1] = *(const u32x4*)(SI + SI_K * 64 + offp);
            rp[2] = *(const u32x4*)(SI + SI_B * 64 + offp);
            rv = *(const unsigned*)(SI + SI_V * 64 + off - (i & 7) * 8 + vr0 + (i & 7) * 2);
        };
        auto commit = [&](int bufi) {
            float* buf = (float*)(smem + bufi * SC_BUF);
            float f[5][8];
#pragma unroll
            for (int a = 0; a < 5; ++a) {
                const h16x8 hv = __builtin_bit_cast(h16x8, rg[a]);
#pragma unroll
                for (int e = 0; e < 8; ++e) f[a][e] = (float)hv[e];
            }
            const bool odd = (i >> 3) & 1;
            float ckk = 0.f, cbk = 0.f;
            {
                const h16x8 pw = __builtin_bit_cast(h16x8, rp[0]), pk = __builtin_bit_cast(h16x8, rp[1]), pb = __builtin_bit_cast(h16x8, rp[2]);
#pragma unroll
                for (int e = 0; e < 8; ++e) {
                    const float kk2 = f[3][e];
                    ckk += (float)pk[e] * kk2; cbk += (float)pb[e] * kk2;
                    if (odd) f[3][e] = (1.0f - (float)pw[e]) * kk2;
                }
            }
            ckk += dppf<0xB1>(ckk); cbk += dppf<0xB1>(cbk); ckk += dppf<0x4E>(ckk); cbk += dppf<0x4E>(cbk); ckk += dppf<0x141>(ckk); cbk += dppf<0x141>(cbk);
#pragma unroll
            for (int a = 0; a < 5; ++a) {
                f32x4 lo, hi;
#pragma unroll
                for (int e = 0; e < 4; ++e) { lo[e] = f[a][e]; hi[e] = f[a][4 + e]; }
                if (a == 1) { lo = 1.0f - lo; hi = 1.0f - hi; }
                if (a == 4) { lo = -lo; hi = -hi; }
                *(f32x4*)(buf + a * SC_ARR + i * 8) = lo; *(f32x4*)(buf + a * SC_ARR + i * 8 + 4) = hi;
            }
            const h16x2 v2 = __builtin_bit_cast(h16x2, rv);
            f32x2 vf; vf[0] = (float)v2[0]; vf[1] = (float)v2[1];
            *(f32x2*)(buf + SC_VOFF + (i >> 3) * 16 + (i & 7) * 2) = vf;
            if (odd && (i & 7) == 0) { f32x2 cf; cf[0] = ckk; cf[1] = cbk; *(f32x2*)(buf + SC_COFF + (i >> 4) * 2) = cf; }
        };
        auto yout = [&](int c) {
            const float* yb = (const float*)(smem + SC_YOFF + (c & 1) * SC_YBUF);
            const f32x2 v = *(const f32x2*)(yb + (i >> 3) * 16 + (i & 7) * 2);
            *(unsigned*)(Y + hb + (size_t)(c * SC_TC + (i >> 3)) * 64 + vr0 + (i & 7) * 2) = pk_bf16(v[0], v[1]);
        };
        issue(0); commit(0); issue(1);
        __syncthreads();
        for (int c = 0; c < SC_NC; ++c) {
            if (c > 0) yout(c - 1);
            if (c + 1 < SC_NC) commit((c + 1) & 1);
            if (c + 2 < SC_NC) issue(c + 2);
            __syncthreads();
        }
        yout(SC_NC - 1);
    } else {
        const int rl = wave * 4 + (lane >> 4), sub = lane & 15;
        const bool odd_lane = lane & 1; const int yoff = (lane & 1) * 16 + rl;
        f32x4 S = {0.f, 0.f, 0.f, 0.f};
        __builtin_amdgcn_s_setprio(3);
        __syncthreads();
        for (int c = 0; c < SC_NC; ++c) {
            const float* buf = (const float*)(smem + (c & 1) * SC_BUF);
            float* yb = (float*)(smem + SC_YOFF + (c & 1) * SC_YBUF);
            const float* bp = buf + sub * 4;
#define SC_LD(arr, s) (*(const f32x4*)(bp + (arr) * SC_ARR + (s) * 64))
            f32x4 r1 = SC_LD(0, 0), w1 = SC_LD(1, 0), k1 = SC_LD(2, 0), q1 = SC_LD(3, 0), n1 = SC_LD(4, 0);
            f32x4 r2 = SC_LD(0, 1), w2 = SC_LD(1, 1), k2 = SC_LD(2, 1), g2 = SC_LD(3, 1), n2 = SC_LD(4, 1);
            float v1 = buf[SC_VOFF + rl], v2 = buf[SC_VOFF + 16 + rl];
            f32x2 cf = *(const f32x2*)(buf + SC_COFF);
#pragma unroll
            for (int pr = 0; pr < SC_TC / 2; ++pr) {
                const int sn = 2 * pr + 2;
                const f32x4 r1n = SC_LD(0, sn), w1n = SC_LD(1, sn), k1n = SC_LD(2, sn), q1n = SC_LD(3, sn), n1n = SC_LD(4, sn);
                const f32x4 r2n = SC_LD(0, sn + 1), w2n = SC_LD(1, sn + 1), k2n = SC_LD(2, sn + 1), g2n = SC_LD(3, sn + 1), n2n = SC_LD(4, sn + 1);
                const float v1n = buf[SC_VOFF + sn * 16 + rl], v2n = buf[SC_VOFF + (sn + 1) * 16 + rl];
                const f32x2 cfn = *(const f32x2*)(buf + SC_COFF + (pr + 1) * 2);
                __builtin_amdgcn_sched_barrier(0x7);
                float d1 = dot4(S, q1), e2 = dot4(S, g2);
                const f32x4 t1 = S * w1 + v1 * k1;
                reduce16x2(d1, e2);
                const float d2 = e2 + v1 * cf[0] - d1 * cf[1];
                const f32x4 S1 = t1 + d1 * n1;
                const f32x4 S2 = (S1 * w2 + v2 * k2) + d2 * n2;
                float y1 = dot4(S1, r1), y2 = dot4(S2, r2);
                y1 += dppf<0xB1>(y1); y2 += dppf<0xB1>(y2);
                float yz = odd_lane ? y2 : y1;
                yz += dppf<0x122>(yz); yz += dppf<0x124>(yz); yz += dppf<0x128>(yz);
                yb[(2 * pr) * 16 + yoff] = yz;
                S = S2;
                r1 = r1n; w1 = w1n; k1 = k1n; q1 = q1n; n1 = n1n; r2 = r2n; w2 = w2n; k2 = k2n; g2 = g2n; n2 = n2n; v1 = v1n; v2 = v2n; cf = cfn;
            }
#undef SC_LD
            __syncthreads();
        }
        __builtin_amdgcn_s_setprio(0);
    }
}

constexpr int KLD = 72;
__device__ __forceinline__ void attn_unit(const Params& p, int unit) {
    unsigned char* ws = p.ws;
    const int qt = unit % 65, bh = unit / 65, b = bh >> 3, h = bh & 7;
    const int tid = threadIdx.x, wave = tid >> 6, lane = tid & 63, fr = lane & 15, fq = lane >> 4;
    const bf16_t* Q = (const bf16_t*)(ws + R_QKV) + (size_t)bh * TP * 64;
    const bf16_t* Kg = Q + QKV_ONE / 2;
    const bf16_t* Vg = Q + QKV_ONE;
    bf16_t* slots = (bf16_t*)smem;
    constexpr int SLOT = 2 * 64 * KLD;
    volatile int* flags = (volatile int*)(smem + 2 * SLOT * 2);
    const int t0 = qt * 128, tq = t0 + wave * 16 + fr;
    bf16x8 qf[2];
    qf[0] = *(const bf16x8*)(Q + (size_t)tq * 64 + fq * 8);
    qf[1] = *(const bf16x8*)(Q + (size_t)tq * 64 + 32 + fq * 8);
    float qs = 0.f;
#pragma unroll
    for (int s = 0; s < 2; ++s)
#pragma unroll
        for (int e = 0; e < 8; ++e) { const float f = bf2f((unsigned short)qf[s][e]); qs += f * f; }
    qs += __shfl_xor(qs, 16); qs += __shfl_xor(qs, 32);
    const f32x4 km4 = *(const f32x4*)((const float*)(ws + WS_CTL) + 16 + bh * 4);
    const float kmax = sqrtf(fmaxf(fmaxf(km4[0], km4[1]), fmaxf(km4[2], km4[3])));
    const float zb = sqrtf(qs) * kmax * 1.0001f + 88.0f;
    float Arow = 0.f;
    f32x4 O[4];
#pragma unroll
    for (int nd = 0; nd < 4; ++nd) O[nd] = (f32x4){0.f, 0.f, 0.f, 0.f};
    const int key = tid >> 3, dc = (tid & 7) * 8, half = wave >> 2;
    auto tile_store = [&](int blk, const u32x4& kv, const u32x4& vv) {
        bf16_t* Ks_ = slots + (blk & 1) * SLOT; bf16_t* Vt_ = Ks_ + 64 * KLD;
        *(u32x4*)(Ks_ + key * KLD + dc) = kv;
#pragma unroll
        for (int e = 0; e < 4; ++e) { Vt_[(dc + 2 * e) * KLD + key] = (bf16_t)(vv[e] & 0xffffu); Vt_[(dc + 2 * e + 1) * KLD + key] = (bf16_t)(vv[e] >> 16); }
    };
    const int ktop = qt * 2 + 1;
    {
        const u32x4 k0 = *(const u32x4*)(Kg + (size_t)(ktop * 64 + key) * 64 + dc), v0 = *(const u32x4*)(Vg + (size_t)(ktop * 64 + key) * 64 + dc);
        __syncthreads();
        tile_store(ktop, k0, v0);
    }
    u32x4 kvv = *(const u32x4*)(Kg + (size_t)((ktop - 1) * 64 + key) * 64 + dc);
    u32x4 vvv = *(const u32x4*)(Vg + (size_t)((ktop - 1) * 64 + key) * 64 + dc);
    for (int kt = ktop; kt >= 0; --kt) {
        const int kb = kt - 1 + half;
        const bool done = __all(Arow > zb) || kb < 0;
        if (lane == 0) flags[wave] = done ? 1 : 0;
        __syncthreads();
        int alld = 1;
#pragma unroll
        for (int w = 0; w < 8; ++w) alld &= flags[w];
        if (alld) break;
        if (kt >= 1) {
            tile_store(kt - 1, kvv, vvv);
            if (kt >= 2) {
                kvv = *(const u32x4*)(Kg + (size_t)((kt - 2) * 64 + key) * 64 + dc);
                vvv = *(const u32x4*)(Vg + (size_t)((kt - 2) * 64 + key) * 64 + dc);
            }
        }
        asm volatile("s_waitcnt lgkmcnt(0)" ::: "memory");
        __builtin_amdgcn_s_barrier();
        if (kb < 0) continue;
        const bf16_t* Ks = slots + (kb & 1) * SLOT; const bf16_t* Vt = Ks + 64 * KLD;
        f32x4 z[4];
#pragma unroll
        for (int n = 0; n < 4; ++n) {
            z[n] = (f32x4){0.f, 0.f, 0.f, 0.f};
#pragma unroll
            for (int s = 0; s < 2; ++s) {
                const bf16x8 kf = *(const bf16x8*)(Ks + (n * 16 + fr) * KLD + s * 32 + fq * 8);
                z[n] = __builtin_amdgcn_mfma_f32_16x16x32_bf16(kf, qf[s], z[n], 0, 0, 0);
            }
        }
        float sp[4][4], lt[4], ex[4], sg[4];
#pragma unroll
        for (int n = 0; n < 4; ++n) {
#pragma unroll
            for (int j = 0; j < 4; ++j) { const int s = kb * 64 + n * 16 + fq * 4 + j; sp[n][j] = s < tq ? softplusf_(z[n][j]) : 0.f; }
            sp[n][2] += sp[n][3]; sp[n][1] += sp[n][2]; sp[n][0] += sp[n][1];
            lt[n] = sp[n][0];
            const float a = __shfl_xor(lt[n], 16), pr = lt[n] + a, c = __shfl_xor(pr, 32);
            ex[n] = fq == 3 ? 0.f : (fq == 2 ? a : (fq == 1 ? c : a + c));
            sg[n] = pr + c;
        }
        float nsuf[4]; nsuf[3] = 0.f; nsuf[2] = sg[3]; nsuf[1] = nsuf[2] + sg[2]; nsuf[0] = nsuf[1] + sg[1];
        float wgt[4][4];
#pragma unroll
        for (int n = 0; n < 4; ++n)
#pragma unroll
            for (int j = 0; j < 4; ++j) {
                const int s = kb * 64 + n * 16 + fq * 4 + j;
                const float C = Arow + nsuf[n] + ex[n] + sp[n][j];
                wgt[n][j] = s < tq ? __expf(z[n][j] - C) : 0.f;
            }
        Arow += nsuf[0] + sg[0];
#pragma unroll
        for (int ks = 0; ks < 2; ++ks) {
            u32x4 pw; pw.x = pk_bf16(wgt[2 * ks][0], wgt[2 * ks][1]); pw.y = pk_bf16(wgt[2 * ks][2], wgt[2 * ks][3]);
            pw.z = pk_bf16(wgt[2 * ks + 1][0], wgt[2 * ks + 1][1]); pw.w = pk_bf16(wgt[2 * ks + 1][2], wgt[2 * ks + 1][3]);
            const bf16x8 pf = __builtin_bit_cast(bf16x8, pw);
#pragma unroll
            for (int nd = 0; nd < 4; ++nd) {
                u32x4 vw;
                const u32x2 v0 = *(const u32x2*)(Vt + (nd * 16 + fr) * KLD + (2 * ks) * 16 + fq * 4);
                const u32x2 v1 = *(const u32x2*)(Vt + (nd * 16 + fr) * KLD + (2 * ks + 1) * 16 + fq * 4);
                vw.x = v0.x; vw.y = v0.y; vw.z = v1.x; vw.w = v1.y;
                O[nd] = __builtin_amdgcn_mfma_f32_16x16x32_bf16(pf, __builtin_bit_cast(bf16x8, vw), O[nd], 0, 0, 0);
            }
        }
    }
    __syncthreads();
    bf16_t* Ot = (bf16_t*)smem;
#pragma unroll
    for (int j = 0; j < 4; ++j)
#pragma unroll
        for (int nd = 0; nd < 4; ++nd) Ot[(wave * 16 + fq * 4 + j) * KLD + nd * 16 + fr] = (bf16_t)(pk_bf16(O[nd][j], 0.f) & 0xffffu);
    __syncthreads();
    bf16_t* osb = (bf16_t*)(ws + O_OSB);
#pragma unroll
    for (int i = 0; i < 2; ++i) {
        const int idx = tid + 512 * i, r = idx >> 3, pc8 = (idx & 7) * 8, t = t0 + r;
        if (t >= NMETA && t < T) *(u32x4*)(osb + (size_t)(b * SEQ + t - NMETA) * 512 + h * 64 + pc8) = *(const u32x4*)(Ot + r * KLD + pc8);
    }
}

constexpr int N_SCAN = 128, N_ATTN = 32 * 65;
__device__ __forceinline__ void sub_barrier(unsigned* ctr, unsigned target, bool arrive) {
    asm volatile("s_waitcnt vmcnt(0)" ::: "memory");
    __syncthreads();
    if (threadIdx.x == 0) {
        if (arrive) { __builtin_amdgcn_fence(__ATOMIC_RELEASE, "agent"); asm volatile("s_waitcnt vmcnt(0)" ::: "memory"); (void)xb_add(ctr, 1u); }
        unsigned sp = 0u;
        while (xb_ld(ctr) < target) { __builtin_amdgcn_s_sleep(2); if (++sp > (1u << 22)) break; }
        __builtin_amdgcn_fence(__ATOMIC_ACQUIRE, "agent");
        asm volatile("s_waitcnt vmcnt(0)" ::: "memory");
    }
    __syncthreads();
}
__device__ __forceinline__ void phase3(const Params& p) {
    unsigned char* ws = p.ws;
    unsigned* ctl = (unsigned*)(ws + WS_CTL);
    const int nother = (int)gridDim.x - N_SCAN;
    if ((int)blockIdx.x < N_SCAN) {
        scan_unit(p, blockIdx.x);
    } else {
        EpiInProj<true> epi{(bf16_t*)(ws + R_QKV), (_Float16*)(ws + R_URW), (bf16_t*)p.out};
        gemm_phase((const bf16_t*)(ws + O_A0), (const bf16_t*)(ws + WS_WIN), D, MP / BM, 14, epi, nother, (int)blockIdx.x - N_SCAN, 6, 7);
        sub_barrier(ctl + 256, (unsigned)nother, true);
        for (int it = (int)blockIdx.x - N_SCAN; it < 128; it += nother) phase2_kmax(p, it);
        sub_barrier(ctl + 320, (unsigned)nother, true);
    }
    sub_barrier(ctl + 320, (unsigned)nother, false);
    volatile int* slot = (volatile int*)(smem + 131072 - 16);
    for (;;) {
        __syncthreads();
        if (threadIdx.x == 0) *slot = (int)atomicAdd(ctl, 1u);
        __syncthreads();
        const int u = *slot;
        if (u >= N_ATTN) break;
        attn_unit(p, u);
    }
}

__device__ __forceinline__ void phase3c(const Params& p) {
    unsigned char* ws = p.ws;
    const _Float16* SI = (const _Float16*)(ws + R_SI);
    constexpr size_t SIE = (size_t)MP * 512;
    const bf16_t* Y = (const bf16_t*)(ws + O_Y);
    const bf16_t* G = (const bf16_t*)(ws + R_G);
    bf16_t* orw = (bf16_t*)(ws + O_ORW);
    const int tid = threadIdx.x, sub = tid & 15;
    constexpr int U = 4;
    for (int it = blockIdx.x; it < 32 * 64; it += gridDim.x) {
        const int bh = it >> 6, c4 = it & 63, b = bh >> 3, h = bh & 7;
        const int c = h * 64 + sub * 4;
        const f32x4 gain = *(const f32x4*)(p.in[14] + c), bias = *(const f32x4*)(p.in[15] + c), rk = *(const f32x4*)(p.in[13] + c);
        u32x2 yb2[U]; f32x4 y[U]; h16x4 r4[U], k4[U], v4[U]; u32x2 g2[U];
#pragma unroll
        for (int u = 0; u < U; ++u) {
            const int t = NMETA + (c4 * U + u) * 32 + (tid >> 4);
            const size_t base = ((size_t)bh * TP + t) * 64 + sub * 4;
            const size_t rec = ((size_t)bh * TP + t) * 448, pbase = rec + (sub & 3) * 16 + (sub >> 2) * 4;
            yb2[u] = *(const u32x2*)(Y + base);
            r4[u] = *(const h16x4*)(SI + SI_R * 64 + pbase); k4[u] = *(const h16x4*)(SI + SI_K * 64 + pbase); v4[u] = *(const h16x4*)(SI + SI_V * 64 + rec + sub * 4);
            g2[u] = *(const u32x2*)((const bf16_t*)SI + 6 * 64 + pbase);
        }
#pragma unroll
        for (int u = 0; u < U; ++u) {
            const int t = NMETA + (c4 * U + u) * 32 + (tid >> 4);
            y[u][0] = __uint_as_float(yb2[u].x << 16); y[u][1] = __uint_as_float(yb2[u].x & 0xffff0000u); y[u][2] = __uint_as_float(yb2[u].y << 16); y[u][3] = __uint_as_float(yb2[u].y & 0xffff0000u);
            const float mean = reduce16((y[u][0] + y[u][1]) + (y[u][2] + y[u][3])) * (1.0f / 64.0f);
            const f32x4 dy = y[u] - mean;
            const float var = reduce16((dy[0] * dy[0] + dy[1] * dy[1]) + (dy[2] * dy[2] + dy[3] * dy[3])) * (1.0f / 64.0f);
            const float rs = rsqrtf(var + GN_EPS);
            float bs = 0.f;
#pragma unroll
            for (int j = 0; j < 4; ++j) bs += (float)r4[u][j] * (float)k4[u][j] * rk[j];
            bs = reduce16(bs);
            const float gg[4] = {__uint_as_float(g2[u].x << 16), __uint_as_float(g2[u].x & 0xffff0000u), __uint_as_float(g2[u].y << 16), __uint_as_float(g2[u].y & 0xffff0000u)};
            float o[4];
#pragma unroll
            for (int j = 0; j < 4; ++j) o[j] = (dy[j] * rs * gain[j] + bias[j] + bs * (float)v4[u][j]) * gg[j];
            u32x2 w; w.x = pk_bf16(o[0], o[1]); w.y = pk_bf16(o[2], o[3]);
            *(u32x2*)(orw + (size_t)(b * SEQ + t - NMETA) * 512 + c) = w;
        }
    }
}

__device__ __forceinline__ void phase4(const Params& p) {
    unsigned char* ws = p.ws;
    EpiBranch1 e1{(bf16_t*)(ws + O_T1), (const bf16_t*)p.out};
    EpiBranch2 e2{(const bf16_t*)(ws + O_T1), (const bf16_t*)p.out, (bf16_t*)(ws + O_M)};
    gemm_phase((const bf16_t*)(ws + O_OSB), (const bf16_t*)(ws + WS_WSB), 512, MS / BM, D / BM, e1);
    gemm_phase((const bf16_t*)(ws + O_ORW), (const bf16_t*)(ws + WS_WRW), 512, MS / BM, D / BM, e2);
}
__device__ __forceinline__ void phase5(const Params& p) {
    unsigned char* ws = p.ws;
    EpiBf16 e{(bf16_t*)(ws + O_P)};
    gemm_phase((const bf16_t*)(ws + O_M), (const bf16_t*)(ws + WS_WOUT), D, MS / BM, D / BM, e);
}
__device__ __forceinline__ void phase6(const Params& p) {
    unsigned char* ws = p.ws;
    const int lane = threadIdx.x & 63;
    f32x4 g1[4], g2[4];
#pragma unroll
    for (int j = 0; j < 4; ++j) { g1[j] = *(const f32x4*)(p.in[3] + 4 * lane + 256 * j); g2[j] = *(const f32x4*)(p.in[19] + 4 * lane + 256 * j); }
    for (int it = blockIdx.x; it < MS / 16; it += gridDim.x) {
        const int row0 = it * 16 + (threadIdx.x >> 6) * 2;
        f32x4 v[2][4], x[2][4];
#pragma unroll
        for (int r = 0; r < 2; ++r)
#pragma unroll
            for (int j = 0; j < 4; ++j) {
                { const u32x2 pb2 = __builtin_nontemporal_load((const u32x2*)((const bf16_t*)(ws + O_P) + (size_t)(row0 + r) * D + 4 * lane + 256 * j));
                  v[r][j] = (f32x4){__uint_as_float(pb2.x << 16), __uint_as_float(pb2.x & 0xffff0000u), __uint_as_float(pb2.y << 16), __uint_as_float(pb2.y & 0xffff0000u)}; }
                x[r][j] = __builtin_nontemporal_load((const f32x4*)(p.in[0] + (size_t)(row0 + r) * D + 4 * lane + 256 * j));
            }
#pragma unroll
        for (int r = 0; r < 2; ++r) {
            const int row = row0 + r;
            float ss = 0.f;
#pragma unroll
            for (int j = 0; j < 4; ++j) ss += (v[r][j][0] * v[r][j][0] + v[r][j][1] * v[r][j][1]) + (v[r][j][2] * v[r][j][2] + v[r][j][3] * v[r][j][3]);
            const float rs = rsqrtf(wave_sum(ss) * (1.0f / D) + RMS_EPS);
            float s2 = 0.f;
#pragma unroll
            for (int j = 0; j < 4; ++j) {
                v[r][j] = x[r][j] + v[r][j] * rs * g1[j];
                *(f32x4*)(p.out + (size_t)row * D + 4 * lane + 256 * j) = v[r][j];
                s2 += (v[r][j][0] * v[r][j][0] + v[r][j][1] * v[r][j][1]) + (v[r][j][2] * v[r][j][2] + v[r][j][3] * v[r][j][3]);
            }
            const float rs2 = rsqrtf(wave_sum(s2) * (1.0f / D) + RMS_EPS);
            bf16_t* fr_ = (bf16_t*)(ws + O_F) + (size_t)row * D;
#pragma unroll
            for (int j = 0; j < 4; ++j) {
                u32x2 w; w.x = pk_bf16(v[r][j][0] * rs2 * g2[j][0], v[r][j][1] * rs2 * g2[j][1]); w.y = pk_bf16(v[r][j][2] * rs2 * g2[j][2], v[r][j][3] * rs2 * g2[j][3]);
                *(u32x2*)(fr_ + 4 * lane + 256 * j) = w;
            }
        }
    }
}
__device__ __forceinline__ void phase7(const Params& p) {
    unsigned char* ws = p.ws;
    EpiGU e{(bf16_t*)(ws + O_ACT)};
    gemm_phase((const bf16_t*)(ws + O_F), (const bf16_t*)(ws + WS_WGU), D, MS / BM, 2 * DFF / BM, e);
}
__device__ __forceinline__ void phase8(const Params& p) {
    unsigned char* ws = p.ws;
    EpiBf16 e{(bf16_t*)(ws + O_DN)};
    gemm_phase((const bf16_t*)(ws + O_ACT), (const bf16_t*)(ws + WS_WD), DFF, MS / BM, D / BM, e);
}
__device__ __forceinline__ void phase9(const Params& p) {
    unsigned char* ws = p.ws;
    const int lane = threadIdx.x & 63;
    f32x4 g[4];
#pragma unroll
    for (int j = 0; j < 4; ++j) g[j] = *(const f32x4*)(p.in[20] + 4 * lane + 256 * j);
    for (int it = blockIdx.x; it < MS / 16; it += gridDim.x) {
        const int row0 = it * 16 + (threadIdx.x >> 6) * 2;
        f32x4 v[2][4], h1[2][4];
#pragma unroll
        for (int r = 0; r < 2; ++r)
#pragma unroll
            for (int j = 0; j < 4; ++j) {
                { const u32x2 db2 = __builtin_nontemporal_load((const u32x2*)((const bf16_t*)(ws + O_DN) + (size_t)(row0 + r) * D + 4 * lane + 256 * j));
                  v[r][j] = (f32x4){__uint_as_float(db2.x << 16), __uint_as_float(db2.x & 0xffff0000u), __uint_as_float(db2.y << 16), __uint_as_float(db2.y & 0xffff0000u)}; }
                h1[r][j] = __builtin_nontemporal_load((const f32x4*)(p.out + (size_t)(row0 + r) * D + 4 * lane + 256 * j));
            }
#pragma unroll
        for (int r = 0; r < 2; ++r) {
            float ss = 0.f;
#pragma unroll
            for (int j = 0; j < 4; ++j) ss += (v[r][j][0] * v[r][j][0] + v[r][j][1] * v[r][j][1]) + (v[r][j][2] * v[r][j][2] + v[r][j][3] * v[r][j][3]);
            const float rs = rsqrtf(wave_sum(ss) * (1.0f / D) + RMS_EPS);
#pragma unroll
            for (int j = 0; j < 4; ++j) __builtin_nontemporal_store(h1[r][j] + v[r][j] * rs * g[j], (f32x4*)(p.out + (size_t)(row0 + r) * D + 4 * lane + 256 * j));
        }
    }
}

constexpr int N_PHASES = 11;
__device__ __forceinline__ void run_phase(const Params& p, int ph) {
    switch (ph) {
        case 0: phase0(p); break;
        case 1: phase1(p); break;
        case 2: phase2(p); break;
        case 3: phase3(p); break;
        case 4: phase3c(p); break;
        case 5: phase4(p); break;
        case 6: phase5(p); break;
        case 7: phase6(p); break;
        case 8: phase7(p); break;
        case 9: phase8(p); break;
        default: phase9(p); break;
    }
}

#if MULTI_LAUNCH
template <int PH> __global__ void __launch_bounds__(512) fwd_phase(Params p) { run_phase(p, PH); }
#else
__global__ void __launch_bounds__(512) fwd_mega(Params p) {
    cg::grid_group grid = cg::this_grid();
    volatile LAS unsigned* st = (volatile LAS unsigned*)(smem + 131072);
    if (threadIdx.x == 0) { st[0] = 0u; st[1] = 0u; }
    __syncthreads();
    const XcdBarrier xb = xcd_barrier_post((unsigned*)(p.ws + WS_BAR), st);
    if (p.out == nullptr) grid.sync();
    phase0(p); xcd_barrier(xb); phase1(p); xcd_barrier(xb); phase2(p); xcd_barrier(xb); phase3(p); xcd_barrier(xb); phase3c(p); xcd_barrier(xb);
    phase4(p); xcd_barrier(xb); phase5(p); xcd_barrier(xb); phase6(p); xcd_barrier(xb); phase7(p); xcd_barrier(xb); phase8(p); xcd_barrier(xb); phase9(p);
}
#endif

extern "C" void kernel_launch(void* const* d_in, const int* in_sizes, int n_in, void* d_out, int out_size, void* d_ws, size_t ws_size, hipStream_t stream) {
    static int grid = 0;
    if (grid == 0) {
        if (n_in != 24 || out_size != MS * D || ws_size < WS_END) { fprintf(stderr, "kernel_launch: unexpected shapes (n_in %d out %d ws %zu need %zu)\n", n_in, out_size, ws_size, (size_t)WS_END); grid = -1; return; }
        int dev = 0, cus = 0, per_cu = 0;
        (void)hipGetDevice(&dev);
        (void)hipDeviceGetAttribute(&cus, hipDeviceAttributeMultiprocessorCount, dev);
#if MULTI_LAUNCH
        per_cu = 1;
#else
        (void)hipFuncSetAttribute((const void*)fwd_mega, hipFuncAttributeMaxDynamicSharedMemorySize, LDS_BYTES);
        (void)hipOccupancyMaxActiveBlocksPerMultiprocessor(&per_cu, (const void*)fwd_mega, 512, LDS_BYTES);
        if (per_cu < 1) { fprintf(stderr, "kernel_launch: occupancy query says %d blocks per CU\n", per_cu); per_cu = 1; }
        if (per_cu > 1) per_cu = 1;
#endif
        grid = cus * per_cu;
        if (grid <= N_SCAN) { fprintf(stderr, "kernel_launch: grid %d too small (needs more than %d workgroups)\n", grid, N_SCAN); grid = -1; return; }
    }
    if (grid < 0) return;
    Params p{};
    for (int i = 0; i < 24; ++i) p.in[i] = (const float*)d_in[i];
    p.out = (float*)d_out; p.ws = (unsigned char*)d_ws;
#if MULTI_LAUNCH
#define LP(PH) do { (void)hipFuncSetAttribute((const void*)fwd_phase<PH>, hipFuncAttributeMaxDynamicSharedMemorySize, LDS_BYTES); hipLaunchKernelGGL(fwd_phase<PH>, dim3(grid), dim3(512), LDS_BYTES, stream, p); } while (0)
    LP(0); LP(1); LP(2); LP(3); LP(4); LP(5); LP(6); LP(7); LP(8); LP(9); LP(10);
#undef LP
#else
    if (hipMemsetAsync(d_ws, 0, WS_CTL_BYTES, stream) != hipSuccess) { fprintf(stderr, "kernel_launch: hipMemsetAsync of the control words failed\n"); return; }
    void* args[] = {&p};
    hipError_t e = hipLaunchCooperativeKernel((const void*)fwd_mega, dim3(grid), dim3(512), args, LDS_BYTES, stream);
    if (e != hipSuccess) fprintf(stderr, "cooperative launch failed: %s (grid %d)\n", hipGetErrorString(e), grid);
#endif
}
```

```cpp
#include <hip/hip_runtime.h>
#include <hip/hip_cooperative_groups.h>
#include <cstdio>
#include <cstdint>
#include <type_traits>
namespace cg = cooperative_groups;

#ifndef MULTI_LAUNCH
#define MULTI_LAUNCH 0
#endif

typedef unsigned short bf16_t;
typedef short bf16x8 __attribute__((ext_vector_type(8)));
typedef float f32x4 __attribute__((ext_vector_type(4)));
typedef float f32x2 __attribute__((ext_vector_type(2)));
typedef unsigned u32x2 __attribute__((ext_vector_type(2)));
typedef unsigned u32x4 __attribute__((ext_vector_type(4)));
typedef _Float16 h16x2 __attribute__((ext_vector_type(2)));
typedef _Float16 h16x4 __attribute__((ext_vector_type(4)));
typedef _Float16 h16x8 __attribute__((ext_vector_type(8)));

constexpr int D = 1024, NB = 4, SEQ = 8192, NMETA = 16, T = SEQ + NMETA, TP = 8320, MP = NB * TP, MS = NB * SEQ;
constexpr int PIN = 5376, DFF = 2816, NH = 8, RWS = 1792;
constexpr float RMS_EPS = 1e-6f, GN_EPS = 64e-5f;

constexpr size_t WS_CTL = 0;
constexpr size_t WS_BAR = 4096;
constexpr size_t WS_CTL_BYTES = 32768;
constexpr size_t WS_WIN = WS_CTL_BYTES;
constexpr size_t WS_WSB = WS_WIN + (size_t)PIN * D * 2;
constexpr size_t WS_WRW = WS_WSB + (size_t)D * 512 * 2;
constexpr size_t WS_WOUT = WS_WRW + (size_t)D * 512 * 2;
constexpr size_t WS_WGU = WS_WOUT + (size_t)D * D * 2;
constexpr size_t WS_WD = WS_WGU + (size_t)2 * DFF * D * 2;
constexpr size_t WS_WL = WS_WD + (size_t)D * DFF * 2;
constexpr size_t R_A0 = WS_WL + (size_t)512 * 256 * 2;
constexpr size_t R_URW = R_A0 + (size_t)MP * D * 2;
constexpr size_t R_QKV = R_URW;
constexpr size_t QKV_ONE = (size_t)MP * 512 * 2;
constexpr size_t R_SI = R_URW + (size_t)MP * RWS * 2;
constexpr size_t SI_ONE = (size_t)MP * 512 * 2;
constexpr size_t R_G = R_SI + 6 * SI_ONE;
constexpr size_t R_TAIL = R_G + SI_ONE;
constexpr size_t O_Y = R_TAIL;
constexpr size_t O_OSB = R_TAIL + SI_ONE;
constexpr size_t WS_END = O_OSB + (size_t)MS * 512 * 2;
constexpr size_t O_A0 = R_A0;
constexpr size_t O_ORW = R_A0;
constexpr size_t O_T1 = R_SI;
constexpr size_t O_M = R_SI + (size_t)MS * D * 4;
constexpr size_t O_P = R_A0;
constexpr size_t O_F = R_SI;
constexpr size_t O_ACT = R_A0;
constexpr size_t O_DN = R_SI + (size_t)MS * D * 2;
static_assert(3 * QKV_ONE <= (size_t)MP * RWS * 2, "overlay");
static_assert(O_M + (size_t)MS * D * 2 <= R_TAIL, "overlay");
static_assert(O_ACT + (size_t)MS * DFF * 2 <= R_SI, "overlay");
static_assert(O_P + (size_t)MS * D * 4 <= R_SI, "overlay");
static_assert(O_DN + (size_t)MS * D * 4 <= R_TAIL, "overlay");
static_assert(WS_END <= (size_t)512 * 1024 * 1024, "workspace");

constexpr size_t WS_XCNT = 20480;
constexpr size_t WS_XBUF = WS_END;
static_assert(WS_XBUF + (size_t)MS * 4 * 4 <= (size_t)512 * 1024 * 1024, "workspace");
constexpr int LDS_XCH = 131072 + 64;
constexpr int LDS_BYTES = 131072 + 64 + 6144;

struct Params { const float* in[24]; float* out; unsigned char* ws; };

extern __shared__ __attribute__((aligned(16))) unsigned char smem[];

typedef __bf16 b16x2 __attribute__((ext_vector_type(2)));
__device__ __forceinline__ unsigned pk_bf16(float lo, float hi) { const f32x2 v = {lo, hi}; return __builtin_bit_cast(unsigned, __builtin_convertvector(v, b16x2)); }
__device__ __forceinline__ float bf2f(unsigned short v) { return __uint_as_float((unsigned)v << 16); }
__device__ __forceinline__ float sigmoidf_(float x) { return __builtin_amdgcn_rcpf(1.0f + __expf(-x)); }
__device__ __forceinline__ float softplusf_(float x) { return fmaxf(x, 0.f) + __logf(1.0f + __expf(-fabsf(x))); }
template <int CTRL> __device__ __forceinline__ float dppf(float x) { return __builtin_bit_cast(float, __builtin_amdgcn_mov_dpp(__builtin_bit_cast(int, x), CTRL, 0xf, 0xf, true)); }
__device__ __forceinline__ float reduce16(float v) {
    v += dppf<0xB1>(v); v += dppf<0x4E>(v); v += dppf<0x141>(v); v += dppf<0x140>(v); return v;
}
__device__ __forceinline__ float wave_sum(float v) {
#pragma unroll
    for (int o = 1; o < 64; o <<= 1) v += __shfl_xor(v, o);
    return v;
}

#define LAS __attribute__((address_space(3)))
#define XB_TMO      128
#define XB_XCNT(j)  (256  + 64 * (j))
#define XB_XSUB(j)  (1280 + 64 * (j))
#define XB_XGEN(j)  (2304 + 64 * (j))
#define XB_TOP      3328
#define XB_TOPGEN   3392
#define XCD_BAR_WORDS 3456
#define XB_SPIN_CAP (1u << 18)
__device__ __forceinline__ unsigned xb_ld(unsigned* p)              { return __hip_atomic_load(p, __ATOMIC_RELAXED, __HIP_MEMORY_SCOPE_AGENT); }
__device__ __forceinline__ unsigned xb_add(unsigned* p, unsigned v) { return __hip_atomic_fetch_add(p, v, __ATOMIC_RELAXED, __HIP_MEMORY_SCOPE_AGENT); }
__device__ __forceinline__ unsigned xb_xcc_id() { return (unsigned)__builtin_amdgcn_s_getreg((3 << 11) | 20) & 0xFu; }
#define XB_SPIN(cond, bar) do { unsigned _sp = 0; while (cond) { __builtin_amdgcn_s_sleep(1); \
    if ((++_sp & 255u) == 0u) { if (xb_ld(&(bar)[XB_TMO])) break; if (_sp > XB_SPIN_CAP) { atomicAdd(&(bar)[XB_TMO], 1u); break; } } } } while (0)
struct XcdBarrier { unsigned* bar; unsigned x; volatile LAS unsigned* st; };
__device__ __forceinline__ XcdBarrier xcd_barrier_post(unsigned* bar, volatile LAS unsigned* st) {
    XcdBarrier b; b.bar = bar; b.x = xb_xcc_id(); b.st = st;
    if (threadIdx.x == 0) (void)xb_add(&bar[XB_XCNT(b.x)], 1u);
    return b;
}
__device__ __forceinline__ void xcd_barrier_complete(unsigned* bar, unsigned x, unsigned& nloc, unsigned& nx) {
    const unsigned G = gridDim.x * gridDim.y * gridDim.z;
    unsigned sum, cnt, mine, sp = 0u;
    for (;;) {
        sum = 0u; cnt = 0u; mine = 0u;
#pragma unroll
        for (unsigned j = 0; j < 16; ++j) { const unsigned c = xb_ld(&bar[XB_XCNT(j)]); sum += c; cnt += (c > 0u) ? 1u : 0u; mine = (j == x) ? c : mine; }
        if (sum == G) break;
        __builtin_amdgcn_s_sleep(1);
        if ((++sp & 255u) == 0u) { if (xb_ld(&bar[XB_TMO])) break; if (sp > XB_SPIN_CAP) { atomicAdd(&bar[XB_TMO], 1u); break; } }
    }
    nloc = mine > 0u ? mine : 1u; nx = cnt > 0u ? cnt : 1u;
}
__device__ __forceinline__ void xcd_barrier(const XcdBarrier& b) {
    asm volatile("s_waitcnt vmcnt(0)" ::: "memory");
    __syncthreads();
    if (threadIdx.x == 0) {
        unsigned* bar = b.bar;
        __builtin_amdgcn_s_waitcnt(0);
        unsigned nloc = b.st[0], nx = b.st[1];
        if (nloc == 0u) { xcd_barrier_complete(bar, b.x, nloc, nx); b.st[0] = nloc; b.st[1] = nx; }
        const unsigned old = xb_add(&bar[XB_XSUB(b.x)], 1u);
        const unsigned gen = old / nloc;
        if (old + 1u == (gen + 1u) * nloc) {
            __builtin_amdgcn_fence(__ATOMIC_RELEASE, "agent");
            asm volatile("s_waitcnt vmcnt(0)" ::: "memory");
            const unsigned og = xb_add(&bar[XB_TOP], 1u);
            const unsigned tg = og / nx;
            if (og + 1u == (tg + 1u) * nx) xb_add(&bar[XB_TOPGEN], 1u);
            else XB_SPIN(xb_ld(&bar[XB_TOPGEN]) == tg, bar);
            __builtin_amdgcn_fence(__ATOMIC_ACQUIRE, "agent");
            xb_add(&bar[XB_XGEN(b.x)], 1u);
            asm volatile("s_waitcnt vmcnt(0)" ::: "memory");
        } else {
            XB_SPIN(xb_ld(&bar[XB_XGEN(b.x)]) == gen, bar);
            __builtin_amdgcn_fence(__ATOMIC_ACQUIRE, "agent");
            asm volatile("s_waitcnt vmcnt(0)" ::: "memory");
        }
    }
    __syncthreads();
}

constexpr int BM = 256, BK = 64, HALF = 128, HTB = HALF * BK * 2, NXCD = 8, WGM = 8;
__device__ __forceinline__ int lds_byte(int r, int c) { const int st = (r >> 4) * 2 + (c >> 5), rr = r & 15, cc = c & 31, ob = rr * 64 + cc * 2; return st * 1024 + (ob ^ (((ob >> 9) & 1) << 5)); }
__device__ __forceinline__ void stage_rc(int b, int& R, int& C) { const int st = b / 1024, sb = b % 1024, swz = sb ^ (((sb >> 9) & 1) << 5); R = (st >> 1) * 16 + swz / 64; C = (st & 1) * 32 + (swz % 64) / 2; }
struct Unit { int pm, pn; };
struct Sched {
    int nM, nN, nwg, G, c;
    __device__ __forceinline__ bool next(int i, Unit& u) const {
        const long L = (long)i * G + c; if (L >= nwg) return false;
        int wgid = (int)L; { const int q = nwg / NXCD, r = nwg % NXCD, xcd = wgid % NXCD, off = wgid / NXCD; wgid = (xcd < r ? xcd * (q + 1) : r * (q + 1) + (xcd - r) * q) + off; }
        const int nig = WGM * nN, gid = wgid / nig, fm = gid * WGM, gsz = (nM - fm) < WGM ? (nM - fm) : WGM;
        u.pm = fm + ((wgid % nig) % gsz); u.pn = (wgid % nig) / gsz; return true;
    }
};

template <class Epi>
__device__ __forceinline__ void gemm_phase(const bf16_t* __restrict__ Ag, const bf16_t* __restrict__ Btg, const int K, const int nM, const int nN, const Epi& E,
                                           const int G = (int)gridDim.x, const int c = (int)blockIdx.x, const int pn_from = 1 << 30, const int pn_add = 0) {
    LAS unsigned char* lds = (LAS unsigned char*)smem;
    const int tid = threadIdx.x, wid = __builtin_amdgcn_readfirstlane(tid >> 6), lane = tid & 63, wr = wid >> 2, wc = wid & 3, fr = lane & 15, fq = lane >> 4;
    const int nt = K / BK;
    Sched S; S.nM = nM; S.nN = nN; S.nwg = nM * nN; S.G = G; S.c = c;
    unsigned voffA[2], voffB[2];
#pragma unroll
    for (int i = 0; i < 2; ++i) { int R, C; stage_rc(tid * 16 + i * 8192, R, C);
        const int Rb = Epi::PERM ? ((R & ~31) + 8 * ((R & 15) >> 2) + 4 * ((R & 31) >> 4) + (R & 3)) : R;
        voffA[i] = (unsigned)(R * K + C) * 2u; voffB[i] = (unsigned)(Rb * K + C) * 2u; }
    const size_t kstep = (size_t)(BK * 2);
    const size_t hstep = (size_t)HALF * K * 2;
    const size_t tstep = 2 * hstep;
    const unsigned ldsw = (unsigned)wid * 1024u;
    const int aoff = lds_byte(wr * 64 + fr, fq * 8), boff = lds_byte(wc * 32 + fr, fq * 8);
#define PG8_SA(b, h) (((b) * 2 + (h)) * HTB)
#define PG8_SB(b, h) ((4 + (b) * 2 + (h)) * HTB)
#define PG8_STAGE(bufoff, gbase, voff) do { _Pragma("unroll") for (int _i = 0; _i < 2; ++_i) \
        __builtin_amdgcn_global_load_lds((const unsigned*)((const char*)(gbase) + (voff)[_i]), (LAS unsigned*)(lds + (bufoff) + ldsw + _i * 8192), 16, 0, 0); } while (0)
#define PG8_LDA(dst, b, h) do { _Pragma("unroll") for (int m = 0; m < 4; ++m) _Pragma("unroll") for (int k = 0; k < 2; ++k) dst[m][k] = *(const LAS bf16x8*)(lds + PG8_SA(b, h) + aoff + m * 2048 + k * 1024); } while (0)
#define PG8_LDB(dst, b, h) do { _Pragma("unroll") for (int n = 0; n < 2; ++n) _Pragma("unroll") for (int k = 0; k < 2; ++k) dst[n][k] = *(const LAS bf16x8*)(lds + PG8_SB(b, h) + boff + n * 2048 + k * 1024); } while (0)
#define PG8_MMA(ai, bj, At, Bt) do { __builtin_amdgcn_s_setprio(1); _Pragma("unroll") for (int m = 0; m < 4; ++m) _Pragma("unroll") for (int n = 0; n < 2; ++n) _Pragma("unroll") for (int k = 0; k < 2; ++k) \
        acc[ai][bj][m][n] = __builtin_amdgcn_mfma_f32_16x16x32_bf16(Bt[n][k], At[m][k], acc[ai][bj][m][n], 0, 0, 0); __builtin_amdgcn_s_setprio(0); } while (0)
#define PG8_WAIT_V(n) asm volatile("s_waitcnt vmcnt(" #n ")" ::: "memory")
#define PG8_WAIT_L(n) asm volatile("s_waitcnt lgkmcnt(" #n ")" ::: "memory")
#define PG8_BAR __builtin_amdgcn_s_barrier()
#define PG8_SCHED __builtin_amdgcn_sched_barrier(0)
    Unit cur, nxt; int ui = 0;
    __syncthreads();
    if (!S.next(0, cur)) return;
    if (cur.pn >= pn_from) cur.pn += pn_add;
    f32x4 acc[2][2][4][2];
#pragma unroll
    for (int a = 0; a < 2; ++a)
#pragma unroll
        for (int b = 0; b < 2; ++b)
#pragma unroll
            for (int m = 0; m < 4; ++m)
#pragma unroll
                for (int n = 0; n < 2; ++n) acc[a][b][m][n] = (f32x4){0.f, 0.f, 0.f, 0.f};
    bf16x8 At[4][2], B0[2][2], B1[2][2];
    const char* cA = (const char*)Ag + (size_t)cur.pm * tstep; const char* cB = (const char*)Btg + (size_t)cur.pn * tstep;
    PG8_STAGE(PG8_SB(0, 0), cB, voffB); PG8_STAGE(PG8_SB(0, 1), cB + hstep, voffB); PG8_STAGE(PG8_SA(0, 0), cA, voffA); PG8_STAGE(PG8_SA(0, 1), cA + hstep, voffA);
    if (wr == 1) PG8_BAR;
    PG8_WAIT_V(2); PG8_BAR;
    PG8_STAGE(PG8_SB(1, 0), cB + kstep, voffB); PG8_STAGE(PG8_SA(1, 0), cA + kstep, voffA); PG8_STAGE(PG8_SB(1, 1), cB + hstep + kstep, voffB);
    PG8_WAIT_V(6); PG8_BAR;
    for (;;) {
        const bool has_next = S.next(ui + 1, nxt);
        if (has_next && nxt.pn >= pn_from) nxt.pn += pn_add;
        const char* nA = has_next ? (const char*)Ag + (size_t)nxt.pm * tstep : cA; const char* nB = has_next ? (const char*)Btg + (size_t)nxt.pn * tstep : cB;
        for (int t = 0; t < nt; t += 2) {
            const bool last = (t == nt - 2);
            const char* a1 = cA + (size_t)(t + 1) * kstep;
            const char* a2 = last ? nA : cA + (size_t)(t + 2) * kstep; const char* b2 = last ? nB : cB + (size_t)(t + 2) * kstep;
            const char* a3 = a2 + kstep; const char* b3 = b2 + kstep;
            PG8_LDB(B0, 0, 0); PG8_LDB(B1, 0, 1); PG8_SCHED; PG8_LDA(At, 0, 0); PG8_STAGE(PG8_SA(1, 1), a1 + hstep, voffA);
            PG8_WAIT_V(8); PG8_WAIT_L(0); PG8_BAR; PG8_MMA(0, 0, At, B0); PG8_MMA(0, 1, At, B1); PG8_BAR; PG8_SCHED;
            PG8_LDA(At, 0, 1); PG8_STAGE(PG8_SB(0, 0), b2, voffB); PG8_STAGE(PG8_SB(0, 1), b2 + hstep, voffB); PG8_STAGE(PG8_SA(0, 0), a2, voffA);
            PG8_WAIT_V(8); PG8_WAIT_L(0); PG8_BAR; PG8_MMA(1, 0, At, B0); PG8_MMA(1, 1, At, B1); PG8_BAR; PG8_SCHED;
            PG8_LDB(B0, 1, 0); PG8_LDB(B1, 1, 1); PG8_SCHED; PG8_LDA(At, 1, 0); PG8_STAGE(PG8_SA(0, 1), a2 + hstep, voffA);
            PG8_WAIT_V(8); PG8_WAIT_L(0); PG8_BAR; PG8_MMA(0, 0, At, B0); PG8_MMA(0, 1, At, B1); PG8_BAR; PG8_SCHED;
            PG8_LDA(At, 1, 1); PG8_STAGE(PG8_SB(1, 0), b3, voffB); PG8_STAGE(PG8_SB(1, 1), b3 + hstep, voffB); PG8_STAGE(PG8_SA(1, 0), a3, voffA);
            PG8_WAIT_V(8); PG8_WAIT_L(0); PG8_BAR; PG8_MMA(1, 0, At, B0); PG8_MMA(1, 1, At, B1); PG8_BAR; PG8_SCHED;
        }
        if (wr == 0) PG8_BAR;
        if constexpr (Epi::FUSED) {
            E.fused(acc, cur, wr, wc, fr, fq, wid, lane);
        } else {
            const int brow = cur.pm * BM, bcol = cur.pn * BM;
#pragma unroll
            for (int ai = 0; ai < 2; ++ai)
#pragma unroll
                for (int m = 0; m < 4; ++m) {
                    E.row(brow + ai * HALF + wr * 64 + m * 16 + fr, bcol + wc * 32, fq, acc[ai][0][m][0], acc[ai][0][m][1], acc[ai][1][m][0], acc[ai][1][m][1]);
                    asm volatile("" ::: "memory");
                }
        }
        if (!has_next) break;
#pragma unroll
        for (int a = 0; a < 2; ++a)
#pragma unroll
            for (int b = 0; b < 2; ++b)
#pragma unroll
                for (int m = 0; m < 4; ++m)
#pragma unroll
                    for (int n = 0; n < 2; ++n) acc[a][b][m][n] = (f32x4){0.f, 0.f, 0.f, 0.f};
        cur = nxt; cA = nA; cB = nB; ++ui;
        if (wr == 1) PG8_BAR;
    }
    PG8_WAIT_V(0);
    PG8_BAR;
#undef PG8_SA
#undef PG8_SB
#undef PG8_STAGE
#undef PG8_LDA
#undef PG8_LDB
#undef PG8_MMA
#undef PG8_WAIT_V
#undef PG8_WAIT_L
#undef PG8_BAR
#undef PG8_SCHED
}

template <bool PERM_> struct EpiInProj {
    static constexpr bool PERM = PERM_, FUSED = false;
    bf16_t* qkv; _Float16* urw; bf16_t* gates;
    __device__ __forceinline__ void one(int row, int col, const f32x4& v) const {
        if (col < 1536) {
            const int which = col >> 9, hc = col & 511, h = hc >> 6, d = hc & 63, b = row / TP, t = row - b * TP;
            const float s = which == 0 ? 0.125f : 1.0f;
            u32x2 w; w.x = pk_bf16(v[0] * s, v[1] * s); w.y = pk_bf16(v[2] * s, v[3] * s);
            *(u32x2*)(qkv + (size_t)which * (QKV_ONE / 2) + ((size_t)(b * NH + h) * TP + t) * 64 + d) = w;
        } else if (col < 3328) {
            h16x4 o; o[0] = (_Float16)v[0]; o[1] = (_Float16)v[1]; o[2] = (_Float16)v[2]; o[3] = (_Float16)v[3];
            *(h16x4*)(urw + (size_t)row * RWS + (col - 1536)) = o;
        } else {
            const int b = row / TP, t = row - b * TP;
            if (t >= NMETA && t < T) {
                u32x2 w; w.x = pk_bf16(sigmoidf_(v[0]), sigmoidf_(v[1])); w.y = pk_bf16(sigmoidf_(v[2]), sigmoidf_(v[3]));
                *(u32x2*)(gates + (size_t)(b * SEQ + t - NMETA) * 2048 + (col - 3328)) = w;
            }
        }
    }
    __device__ __forceinline__ void half(int row, int col32, int fq, const f32x4& v0, const f32x4& v1) const {
        if constexpr (PERM_) {
            const int col = col32 + 8 * fq, b = row / TP, t = row - b * TP;
            if (col < 1536) {
                const int which = col >> 9, hc = col & 511, h = hc >> 6, d = hc & 63;
                const float s = which == 0 ? 0.125f : 1.0f;
                u32x4 w; w.x = pk_bf16(v0[0] * s, v0[1] * s); w.y = pk_bf16(v0[2] * s, v0[3] * s); w.z = pk_bf16(v1[0] * s, v1[1] * s); w.w = pk_bf16(v1[2] * s, v1[3] * s);
                *(u32x4*)(qkv + (size_t)which * (QKV_ONE / 2) + ((size_t)(b * NH + h) * TP + t) * 64 + d) = w;
            } else if (t >= NMETA && t < T) {
                u32x4 w; w.x = pk_bf16(sigmoidf_(v0[0]), sigmoidf_(v0[1])); w.y = pk_bf16(sigmoidf_(v0[2]), sigmoidf_(v0[3]));
                w.z = pk_bf16(sigmoidf_(v1[0]), sigmoidf_(v1[1])); w.w = pk_bf16(sigmoidf_(v1[2]), sigmoidf_(v1[3]));
                *(u32x4*)(gates + (size_t)(b * SEQ + t - NMETA) * 2048 + (col - 3328)) = w;
            }
        } else {
            if (col32 >= 1536 && col32 < 3072) {
                const int c = col32 - 1536, pos = (c & ~63) + fq * 16 + ((c & 63) >> 4) * 4;
                h16x8 o;
#pragma unroll
                for (int j = 0; j < 4; ++j) { o[j] = (_Float16)v0[j]; o[4 + j] = (_Float16)v1[j]; }
                *(h16x8*)(urw + (size_t)row * RWS + pos) = o;
            } else { one(row, col32 + 4 * fq, v0); one(row, col32 + 16 + 4 * fq, v1); }
        }
    }
    __device__ __forceinline__ void row(int r, int col32, int fq, const f32x4& a00, const f32x4& a01, const f32x4& a10, const f32x4& a11) const { half(r, col32, fq, a00, a01); half(r, col32 + HALF, fq, a10, a11); }
};
__device__ __forceinline__ void bf8_to_f(const u32x4& g, float (&f)[8]) {
#pragma unroll
    for (int i = 0; i < 4; ++i) { f[2 * i] = __uint_as_float(g[i] << 16); f[2 * i + 1] = __uint_as_float(g[i] & 0xffff0000u); }
}
struct EpiBranch1 {
    static constexpr bool PERM = true, FUSED = false;
    bf16_t* t1; const bf16_t* gates;
    __device__ __forceinline__ void half(int row, int col32, int fq, const f32x4& v0, const f32x4& v1) const {
        const int col = col32 + 8 * fq;
        float g[8]; bf8_to_f(*(const u32x4*)(gates + (size_t)row * 2048 + col), g);
        u32x4 w; w.x = pk_bf16(v0[0] * g[0], v0[1] * g[1]); w.y = pk_bf16(v0[2] * g[2], v0[3] * g[3]); w.z = pk_bf16(v1[0] * g[4], v1[1] * g[5]); w.w = pk_bf16(v1[2] * g[6], v1[3] * g[7]);
        *(u32x4*)(t1 + (size_t)row * D + col) = w;
    }
    __device__ __forceinline__ void row(int r, int col32, int fq, const f32x4& a00, const f32x4& a01, const f32x4& a10, const f32x4& a11) const { half(r, col32, fq, a00, a01); half(r, col32 + HALF, fq, a10, a11); }
};
struct EpiBranch2 {
    static constexpr bool PERM = true, FUSED = false;
    const bf16_t* t1; const bf16_t* gates; bf16_t* m;
    __device__ __forceinline__ void half(int row, int col32, int fq, const f32x4& v0, const f32x4& v1) const {
        const int col = col32 + 8 * fq;
        float g[8], a[8]; bf8_to_f(*(const u32x4*)(gates + (size_t)row * 2048 + 1024 + col), g); bf8_to_f(*(const u32x4*)(t1 + (size_t)row * D + col), a);
        u32x4 w; w.x = pk_bf16(a[0] + v0[0] * g[0], a[1] + v0[1] * g[1]); w.y = pk_bf16(a[2] + v0[2] * g[2], a[3] + v0[3] * g[3]);
        w.z = pk_bf16(a[4] + v1[0] * g[4], a[5] + v1[1] * g[5]); w.w = pk_bf16(a[6] + v1[2] * g[6], a[7] + v1[3] * g[7]);
        *(u32x4*)(m + (size_t)row * D + col) = w;
    }
    __device__ __forceinline__ void row(int r, int col32, int fq, const f32x4& a00, const f32x4& a01, const f32x4& a10, const f32x4& a11) const { half(r, col32, fq, a00, a01); half(r, col32 + HALF, fq, a10, a11); }
};
struct EpiF32 {
    static constexpr bool PERM = true, FUSED = false;
    float* o;
    __device__ __forceinline__ void row(int r, int col32, int fq, const f32x4& a00, const f32x4& a01, const f32x4& a10, const f32x4& a11) const {
        float* q = o + (size_t)r * D + col32 + 8 * fq;
        *(f32x4*)q = a00; *(f32x4*)(q + 4) = a01; *(f32x4*)(q + HALF) = a10; *(f32x4*)(q + HALF + 4) = a11;
    }
};
struct EpiBf16 {
    static constexpr bool PERM = true, FUSED = false;
    bf16_t* o;
    __device__ __forceinline__ void row(int r, int col32, int fq, const f32x4& a00, const f32x4& a01, const f32x4& a10, const f32x4& a11) const {
        bf16_t* q = o + (size_t)r * D + col32 + 8 * fq;
        u32x4 w0, w1;
        w0.x = pk_bf16(a00[0], a00[1]); w0.y = pk_bf16(a00[2], a00[3]); w0.z = pk_bf16(a01[0], a01[1]); w0.w = pk_bf16(a01[2], a01[3]);
        w1.x = pk_bf16(a10[0], a10[1]); w1.y = pk_bf16(a10[2], a10[3]); w1.z = pk_bf16(a11[0], a11[1]); w1.w = pk_bf16(a11[2], a11[3]);
        *(u32x4*)q = w0; *(u32x4*)(q + HALF) = w1;
    }
};
struct EpiGU {
    static constexpr bool PERM = true, FUSED = false;
    bf16_t* act;
    __device__ __forceinline__ void row(int r, int col32, int fq, const f32x4& g0, const f32x4& g1, const f32x4& u0, const f32x4& u1) const {
        float o[8];
#pragma unroll
        for (int j = 0; j < 4; ++j) { o[j] = g0[j] * sigmoidf_(g0[j]) * u0[j]; o[4 + j] = g1[j] * sigmoidf_(g1[j]) * u1[j]; }
        u32x4 w; w.x = pk_bf16(o[0], o[1]); w.y = pk_bf16(o[2], o[3]); w.z = pk_bf16(o[4], o[5]); w.w = pk_bf16(o[6], o[7]);
        const int pn = col32 >> 8, cin = (col32 & 255) + 8 * fq;
        *(u32x4*)(act + (size_t)r * DFF + pn * 128 + cin) = w;
    }
};

struct EpiDownFused {
    static constexpr bool PERM = true, FUSED = true;
    float* out; const float* g; float* xbuf; unsigned* cnt;
    __device__ __forceinline__ void fused(f32x4 (&acc)[2][2][4][2], const Unit& u, int wr, int wc, int fr, int fq, int wid, int lane) const {
        LAS float* Pl = (LAS float*)(smem + LDS_XCH);
        LAS float* Sl = Pl + 1024;
        const int col0 = u.pn * BM + wc * 32 + 8 * fq;
        f32x4 hres[4][2][2];
#pragma unroll
        for (int m = 0; m < 4; ++m) {
            const float* q = out + (size_t)(u.pm * BM + wr * 64 + m * 16 + fr) * D + col0;
#pragma unroll
            for (int bj = 0; bj < 2; ++bj)
#pragma unroll
                for (int n = 0; n < 2; ++n) hres[m][bj][n] = *(const f32x4*)(q + bj * HALF + 4 * n);
        }
#pragma unroll
        for (int ai = 0; ai < 2; ++ai)
#pragma unroll
            for (int m = 0; m < 4; ++m) {
                float sq = 0.f;
#pragma unroll
                for (int bj = 0; bj < 2; ++bj)
#pragma unroll
                    for (int n = 0; n < 2; ++n) { const f32x4 x = acc[ai][bj][m][n]; sq += (x[0] * x[0] + x[1] * x[1]) + (x[2] * x[2] + x[3] * x[3]); }
                sq += __shfl_xor(sq, 16); sq += __shfl_xor(sq, 32);
                if (fq == 0) Pl[(ai * HALF + wr * 64 + m * 16 + fr) * 4 + wc] = sq;
            }
        asm volatile("s_waitcnt lgkmcnt(0)" ::: "memory"); __builtin_amdgcn_s_barrier(); asm volatile("" ::: "memory");
        const int tid = wid * 64 + lane;
        if (tid < 256) {
            const float t = (Pl[tid * 4 + 0] + Pl[tid * 4 + 1]) + (Pl[tid * 4 + 2] + Pl[tid * 4 + 3]);
            __hip_atomic_store(xbuf + ((size_t)(u.pm * BM + tid)) * 4 + u.pn, t, __ATOMIC_RELAXED, __HIP_MEMORY_SCOPE_AGENT);
        }
        asm volatile("s_waitcnt vmcnt(0)" ::: "memory");
        if (tid < 256 && lane == 0) __hip_atomic_fetch_add(cnt + 16 * u.pm, 1u, __ATOMIC_RELAXED, __HIP_MEMORY_SCOPE_AGENT);
        if (wid == 0) {
            unsigned sp = 0u;
            while ((unsigned)__builtin_amdgcn_readfirstlane(__hip_atomic_load(cnt + 16 * u.pm, __ATOMIC_RELAXED, __HIP_MEMORY_SCOPE_AGENT)) < 16u) { __builtin_amdgcn_s_sleep(2); if (++sp > (1u << 22)) break; }
            __builtin_amdgcn_fence(__ATOMIC_ACQUIRE, "agent");
        }
        asm volatile("s_waitcnt vmcnt(0) lgkmcnt(0)" ::: "memory"); __builtin_amdgcn_s_barrier(); asm volatile("" ::: "memory");
        if (tid < 256) {
            const float* slot = xbuf + ((size_t)(u.pm * BM + tid)) * 4;
            const float tot = (__hip_atomic_load(slot + 0, __ATOMIC_RELAXED, __HIP_MEMORY_SCOPE_AGENT) + __hip_atomic_load(slot + 1, __ATOMIC_RELAXED, __HIP_MEMORY_SCOPE_AGENT))
                            + (__hip_atomic_load(slot + 2, __ATOMIC_RELAXED, __HIP_MEMORY_SCOPE_AGENT) + __hip_atomic_load(slot + 3, __ATOMIC_RELAXED, __HIP_MEMORY_SCOPE_AGENT));
            Sl[tid] = rsqrtf(tot * (1.0f / D) + RMS_EPS);
        }
        asm volatile("s_waitcnt lgkmcnt(0)" ::: "memory"); __builtin_amdgcn_s_barrier(); asm volatile("" ::: "memory");
        f32x4 gv[2][2];
#pragma unroll
        for (int bj = 0; bj < 2; ++bj)
#pragma unroll
            for (int n = 0; n < 2; ++n) gv[bj][n] = *(const f32x4*)(g + col0 + bj * HALF + 4 * n);
#pragma unroll
        for (int ai = 0; ai < 2; ++ai)
#pragma unroll
            for (int m = 0; m < 4; ++m) {
                const int r = ai * HALF + wr * 64 + m * 16 + fr;
                const float rs = Sl[r];
                float* q = out + (size_t)(u.pm * BM + r) * D + col0;
#pragma unroll
                for (int bj = 0; bj < 2; ++bj)
#pragma unroll
                    for (int n = 0; n < 2; ++n) { const f32x4 h1 = ai == 0 ? hres[m][bj][n] : *(const f32x4*)(q + bj * HALF + 4 * n); *(f32x4*)(q + bj * HALF + 4 * n) = h1 + acc[ai][bj][m][n] * rs * gv[bj][n]; }
                asm volatile("" ::: "memory");
            }
    }
};

__device__ __forceinline__ void transpose_tile(const float* __restrict__ src, int K, int N, bf16_t* __restrict__ dst, int ldd, int koff, int mode, int tile) {
    float* scr = (float*)smem;
    const int ntn = N / 128, kb = tile / ntn, nb = tile % ntn, k0 = kb * 64, n0 = nb * 128, tid = threadIdx.x;
    f32x4 v[4];
#pragma unroll
    for (int i = 0; i < 4; ++i) { const int idx = tid + 512 * i, kk = idx >> 5, n4 = idx & 31; v[i] = *(const f32x4*)(src + (size_t)(k0 + kk) * N + n0 + n4 * 4); }
#pragma unroll
    for (int i = 0; i < 4; ++i) { const int idx = tid + 512 * i, kk = idx >> 5, n4 = idx & 31;
#pragma unroll
        for (int c = 0; c < 4; ++c) scr[kk * 129 + n4 * 4 + c] = v[i][c]; }
    __syncthreads();
#pragma unroll
    for (int i = 0; i < 2; ++i) {
        const int o = tid + 512 * i, n = o >> 3, kc = (o & 7) * 8;
        u32x4 w;
        w.x = pk_bf16(scr[(kc + 0) * 129 + n], scr[(kc + 1) * 129 + n]); w.y = pk_bf16(scr[(kc + 2) * 129 + n], scr[(kc + 3) * 129 + n]);
        w.z = pk_bf16(scr[(kc + 4) * 129 + n], scr[(kc + 5) * 129 + n]); w.w = pk_bf16(scr[(kc + 6) * 129 + n], scr[(kc + 7) * 129 + n]);
        const int f = n0 + n;
        const int drow = mode == 0 ? f : ((f >> 7) * 256 + (mode == 2 ? 128 : 0) + (f & 127));
        *(u32x4*)(dst + (size_t)drow * ldd + koff + k0 + kc) = w;
    }
    __syncthreads();
}

__device__ __forceinline__ void phase0(const Params& p) {
    unsigned char* ws = p.ws;
    if (blockIdx.x == 0 && threadIdx.x < 64) ((unsigned*)(ws + WS_CTL))[threadIdx.x] = 0u;
    constexpr int J0 = 16 * 42, J1 = 8 * 8, J3 = 16 * 8, J4 = 16 * 22, J6 = 44 * 8, J7 = 4, J9 = 8;
    constexpr int NT = J0 + 2 * J1 + J3 + 2 * J4 + J6 + 2 * J7 + J9;
    constexpr int NR = MP / 32;
    for (int it = blockIdx.x; it < NT + NR; it += gridDim.x) {
        if (it >= NR) {
            int r = it - NR;
            if (r < J0) { transpose_tile(p.in[4], D, PIN, (bf16_t*)(ws + WS_WIN), D, 0, 0, r); continue; } r -= J0;
            if (r < J1) { transpose_tile(p.in[16], 512, D, (bf16_t*)(ws + WS_WSB), 512, 0, 0, r); continue; } r -= J1;
            if (r < J1) { transpose_tile(p.in[17], 512, D, (bf16_t*)(ws + WS_WRW), 512, 0, 0, r); continue; } r -= J1;
            if (r < J3) { transpose_tile(p.in[18], D, D, (bf16_t*)(ws + WS_WOUT), D, 0, 0, r); continue; } r -= J3;
            if (r < J4) { transpose_tile(p.in[21], D, DFF, (bf16_t*)(ws + WS_WGU), D, 0, 1, r); continue; } r -= J4;
            if (r < J4) { transpose_tile(p.in[22], D, DFF, (bf16_t*)(ws + WS_WGU), D, 0, 2, r); continue; } r -= J4;
            if (r < J6) { transpose_tile(p.in[23], DFF, D, (bf16_t*)(ws + WS_WD), DFF, 0, 0, r); continue; } r -= J6;
            if (r < J7) { transpose_tile(p.in[6], 64, 512, (bf16_t*)(ws + WS_WL), 256, 0, 0, r); continue; } r -= J7;
            if (r < J7) { transpose_tile(p.in[8], 64, 512, (bf16_t*)(ws + WS_WL), 256, 64, 0, r); continue; } r -= J7;
            transpose_tile(p.in[10], 128, 512, (bf16_t*)(ws + WS_WL), 256, 128, 0, r);
        } else {
            const int lane = threadIdx.x & 63, row0 = it * 32 + (threadIdx.x >> 6) * 4;
            f32x4 v[4][4];
#pragma unroll
            for (int r = 0; r < 4; ++r) {
                const int row = row0 + r, b = row / TP, t = row - b * TP;
                const float* src = t < NMETA ? p.in[1] + (size_t)t * D : p.in[0] + ((size_t)b * SEQ + (t < T ? t - NMETA : 0)) * D;
#pragma unroll
                for (int j = 0; j < 4; ++j) v[r][j] = *(const f32x4*)(src + 4 * lane + 256 * j);
            }
            f32x4 g[4];
#pragma unroll
            for (int j = 0; j < 4; ++j) g[j] = *(const f32x4*)(p.in[2] + 4 * lane + 256 * j);
#pragma unroll
            for (int r = 0; r < 4; ++r) {
                const int row = row0 + r, b = row / TP, t = row - b * TP;
                float ss = 0.f;
#pragma unroll
                for (int j = 0; j < 4; ++j) ss += (v[r][j][0] * v[r][j][0] + v[r][j][1] * v[r][j][1]) + (v[r][j][2] * v[r][j][2] + v[r][j][3] * v[r][j][3]);
                const float rs = t < T ? rsqrtf(wave_sum(ss) * (1.0f / D) + RMS_EPS) : 0.f;
                bf16_t* orow = (bf16_t*)(ws + O_A0) + (size_t)row * D;
#pragma unroll
                for (int j = 0; j < 4; ++j) {
                    u32x2 w; w.x = pk_bf16(v[r][j][0] * rs * g[j][0], v[r][j][1] * rs * g[j][1]); w.y = pk_bf16(v[r][j][2] * rs * g[j][2], v[r][j][3] * rs * g[j][3]);
                    *(u32x2*)(orow + 4 * lane + 256 * j) = w;
                }
            }
        }
    }
}

__device__ __forceinline__ void phase1(const Params& p) {
    unsigned char* ws = p.ws;
    EpiInProj<false> epi{(bf16_t*)(ws + R_QKV), (_Float16*)(ws + R_URW), (bf16_t*)p.out};
    gemm_phase((const bf16_t*)(ws + O_A0), (const bf16_t*)(ws + WS_WIN), D, MP / BM, 7, epi, (int)gridDim.x, (int)blockIdx.x, 0, 6);
}

constexpr int SI_R = 0, SI_W = 1, SI_K = 2, SI_V = 3, SI_KK = 4, SI_B = 5;
constexpr int ALD = 264;
constexpr int P2_WLS = 64 * ALD * 2;
constexpr int P2_MU = P2_WLS;
constexpr int P2_AL = P2_MU + 1024;
__device__ __forceinline__ void phase2_main(const Params& p) {
    unsigned char* ws = p.ws;
    const int tid = threadIdx.x, wave = tid >> 6, lane = tid & 63, fr = lane & 15, fq = lane >> 4;
    const int h = blockIdx.x & 7, nslot = (gridDim.x >> 3) * 8, slot = (blockIdx.x >> 3) * 8 + wave;
    const _Float16* urw = (const _Float16*)(ws + R_URW);
    const float* mu = p.in[5];
    bf16_t* WLs = (bf16_t*)smem;
    float* mus = (float*)(smem + P2_MU);
    bf16_t* Al = (bf16_t*)(smem + P2_AL) + wave * (16 * ALD);
    __syncthreads();
    {
        const bf16_t* WL = (const bf16_t*)(ws + WS_WL) + (size_t)h * 64 * 256;
#pragma unroll
        for (int i = 0; i < 4; ++i) { const int idx = tid + 512 * i, row = idx >> 5, c16 = idx & 31; *(u32x4*)(WLs + row * ALD + c16 * 8) = *(const u32x4*)(WL + row * 256 + c16 * 8); }
        if (tid < 256) mus[tid] = mu[1536 + tid];
    }
    __syncthreads();
    if (blockIdx.x >= nslot) return;
    _Float16* SI = (_Float16*)(ws + R_SI);
    bf16_t* G = (bf16_t*)(ws + R_G);
    constexpr size_t SIE = (size_t)MP * 512;
#pragma unroll 1
    for (int g = slot; g < NB * 514; g += nslot) {
        const int ub = g / 514, ui = g - ub * 514, row0 = ub * TP + ui * 16;
        {
            const int half = lane >> 5, pc = (lane & 31) * 8;
            const float sA = pc < 64 ? 2.f : 1.f, sC = pc < 64 ? -1.f : 0.f;
            const bool lin = pc >= 64 && pc < 128;
            const f32x4 mA = *(const f32x4*)(mu + 1536 + pc), mB = *(const f32x4*)(mu + 1536 + pc + 4);
            h16x8 c[8], pv[8];
#pragma unroll
            for (int q = 0; q < 8; ++q) {
                const int rowa = row0 + 2 * q + half, ta = rowa % TP;
                const _Float16* cur = urw + (size_t)rowa * RWS + 1536 + pc;
                c[q] = *(const h16x8*)cur;
                pv[q] = *(const h16x8*)(ta > 0 ? cur - RWS : cur);
            }
#pragma unroll
            for (int q = 0; q < 8; ++q) {
                const int ta = (row0 + 2 * q + half) % TP;
                float o[8];
#pragma unroll
                for (int e = 0; e < 8; ++e) {
                    const float cf = (float)c[q][e], pf = ta > 0 ? (float)pv[q][e] : 0.f;
                    const float xs = cf + (e < 4 ? mA[e & 3] : mB[e & 3]) * (pf - cf);
                    const float sg = __builtin_amdgcn_rcpf(1.0f + __expf(-sA * xs));
                    o[e] = lin ? xs : sA * sg + sC;
                }
                u32x4 w; w.x = pk_bf16(o[0], o[1]); w.y = pk_bf16(o[2], o[3]); w.z = pk_bf16(o[4], o[5]); w.w = pk_bf16(o[6], o[7]);
                *(u32x4*)(Al + (2 * q + half) * ALD + pc) = w;
            }
        }
        asm volatile("s_waitcnt lgkmcnt(0)" ::: "memory");
        __builtin_amdgcn_wave_barrier();
        f32x4 acc[4];
        auto lora = [&](auto kbeg_c, auto ksteps_c) {
            constexpr int kbeg = decltype(kbeg_c)::value, ksteps = decltype(ksteps_c)::value;
#pragma unroll
            for (int n = 0; n < 4; ++n) acc[n] = (f32x4){0.f, 0.f, 0.f, 0.f};
#pragma unroll
            for (int ks = 0; ks < ksteps; ++ks) {
                const bf16x8 af = *(const bf16x8*)(Al + fr * ALD + kbeg + ks * 32 + fq * 8);
#pragma unroll
                for (int n = 0; n < 4; ++n) {
                    const bf16x8 wf = *(const bf16x8*)(WLs + (n * 16 + fr) * ALD + kbeg + ks * 32 + fq * 8);
                    acc[n] = __builtin_amdgcn_mfma_f32_16x16x32_bf16(wf, af, acc[n], 0, 0, 0);
                }
            }
        };
        const int row = row0 + fr, b = row / TP, t = row - b * TP;
        const size_t base = ((size_t)(b * NH + h) * TP + t) * 448;
        const _Float16* ur = urw + (size_t)row * RWS;
        const size_t pb = base + fq * 16;
        lora(std::integral_constant<int, 0>{}, std::integral_constant<int, 2>{});
        {
            h16x8 wo[2];
#pragma unroll
            for (int n = 0; n < 4; ++n) {
                const f32x4 db = *(const f32x4*)(p.in[7] + h * 64 + n * 16 + fq * 4);
#pragma unroll
                for (int j = 0; j < 4; ++j) {
                    const float e = sigmoidf_(db[j] + acc[n][j]) * 0.60653065971f;
                    wo[n >> 1][(n & 1) * 4 + j] = (_Float16)(1.0f - __expf(-e));
                }
            }
            *(h16x8*)(SI + SI_W * 64 + pb) = wo[0]; *(h16x8*)(SI + SI_W * 64 + pb + 8) = wo[1];
        }
        lora(std::integral_constant<int, 64>{}, std::integral_constant<int, 2>{});
        {
            const _Float16* up = ur + h * 64 + fq * 16;
            const _Float16* upp = t > 0 ? up - RWS : up;
            h16x8 kc[2], rc[2], vc[2], kp[2], rp[2], vp[2];
#pragma unroll
            for (int i = 0; i < 2; ++i) {
                rc[i] = *(const h16x8*)(up + i * 8); kc[i] = *(const h16x8*)(up + 512 + i * 8); vc[i] = *(const h16x8*)(up + 1024 + i * 8);
                rp[i] = *(const h16x8*)(upp + i * 8); kp[i] = *(const h16x8*)(upp + 512 + i * 8); vp[i] = *(const h16x8*)(upp + 1024 + i * 8);
            }
            float kv[4][4], av[4][4], kkr[4][4]; float ss = 0.f;
            h16x8 ro[2];
#pragma unroll
            for (int n = 0; n < 4; ++n) {
                const int c = n * 16 + fq * 4, c512 = h * 64 + c;
                const f32x4 muk = *(const f32x4*)(mu + 512 + c512), mur = *(const f32x4*)(mu + c512), muv = *(const f32x4*)(mu + 1024 + c512);
                const f32x4 ab = *(const f32x4*)(p.in[9] + c512), kkw = *(const f32x4*)(p.in[11] + c512);
                h16x4 vo;
#pragma unroll
                for (int j = 0; j < 4; ++j) {
                    const int i = n >> 1, e = (n & 1) * 4 + j;
                    const float kcf = (float)kc[i][e], kpf = t > 0 ? (float)kp[i][e] : 0.f;
                    const float rcf = (float)rc[i][e], rpf = t > 0 ? (float)rp[i][e] : 0.f;
                    const float vcf = (float)vc[i][e], vpf = t > 0 ? (float)vp[i][e] : 0.f;
                    kv[n][j] = kcf + muk[j] * (kpf - kcf);
                    ro[i][e] = (_Float16)(rcf + mur[j] * (rpf - rcf));
                    vo[j] = (_Float16)(vcf + muv[j] * (vpf - vcf));
                    av[n][j] = sigmoidf_(ab[j] + acc[n][j]);
                    kkr[n][j] = kv[n][j] * kkw[j];
                    ss += kkr[n][j] * kkr[n][j];
                }
                *(h16x4*)(SI + SI_V * 64 + base + c) = vo;
            }
            *(h16x8*)(SI + SI_R * 64 + pb) = ro[0]; *(h16x8*)(SI + SI_R * 64 + pb + 8) = ro[1];
            ss += __shfl_xor(ss, 16); ss += __shfl_xor(ss, 32);
            const float inv = fminf(__builtin_amdgcn_rsqf(ss), 1e12f);
            h16x8 ko[2], kko[2], bo[2];
#pragma unroll
            for (int n = 0; n < 4; ++n) {
                const f32x4 ka = *(const f32x4*)(p.in[12] + h * 64 + n * 16 + fq * 4);
#pragma unroll
                for (int j = 0; j < 4; ++j) {
                    const int i = n >> 1, e = (n & 1) * 4 + j;
                    const float kk = kkr[n][j] * inv;
                    ko[i][e] = (_Float16)(kv[n][j] * (1.0f + (av[n][j] - 1.0f) * ka[j]));
                    kko[i][e] = (_Float16)kk;
                    bo[i][e] = (_Float16)(kk * av[n][j]);
                }
            }
#pragma unroll
            for (int i = 0; i < 2; ++i) {
                *(h16x8*)(SI + SI_K * 64 + pb + i * 8) = ko[i]; *(h16x8*)(SI + SI_KK * 64 + pb + i * 8) = kko[i]; *(h16x8*)(SI + SI_B * 64 + pb + i * 8) = bo[i];
            }
        }
        lora(std::integral_constant<int, 128>{}, std::integral_constant<int, 4>{});
        {
            u32x4 g0, g1;
            g0.x = pk_bf16(acc[0][0], acc[0][1]); g0.y = pk_bf16(acc[0][2], acc[0][3]); g0.z = pk_bf16(acc[1][0], acc[1][1]); g0.w = pk_bf16(acc[1][2], acc[1][3]);
            g1.x = pk_bf16(acc[2][0], acc[2][1]); g1.y = pk_bf16(acc[2][2], acc[2][3]); g1.z = pk_bf16(acc[3][0], acc[3][1]); g1.w = pk_bf16(acc[3][2], acc[3][3]);
            *(u32x4*)((bf16_t*)SI + 6 * 64 + pb) = g0; *(u32x4*)((bf16_t*)SI + 6 * 64 + pb + 8) = g1;
        }
        asm volatile("s_waitcnt lgkmcnt(0)" ::: "memory");
        __builtin_amdgcn_wave_barrier();
    }
}
__device__ __forceinline__ void phase2_kmax(const Params& p, int item) {
    unsigned char* ws = p.ws;
    const int bh = item >> 2, qr = item & 3, tid = threadIdx.x;
    float* red = (float*)(smem + P2_AL + 8 * 16 * ALD * 2);
    float ss = 0.f;
    for (int t = qr * 2052 + tid; t < (qr + 1) * 2052; t += 512) {
        const bf16_t* kr = (const bf16_t*)(ws + R_QKV) + QKV_ONE / 2 + ((size_t)bh * TP + t) * 64;
        float s1 = 0.f;
#pragma unroll
        for (int q = 0; q < 8; ++q) {
            const u32x4 v = *(const u32x4*)(kr + q * 8);
#pragma unroll
            for (int e = 0; e < 4; ++e) { const float lo = __uint_as_float(v[e] << 16), hi = __uint_as_float(v[e] & 0xffff0000u); s1 += lo * lo + hi * hi; }
        }
        ss = fmaxf(ss, s1);
    }
#pragma unroll
    for (int o = 1; o < 64; o <<= 1) ss = fmaxf(ss, __shfl_xor(ss, o));
    __syncthreads();
    if ((tid & 63) == 0) red[tid >> 6] = ss;
    __syncthreads();
    if (tid == 0) {
        float m = red[0];
#pragma unroll
        for (int w = 1; w < 8; ++w) m = fmaxf(m, red[w]);
        ((float*)(ws + WS_CTL))[16 + item] = m;
    }
}
__device__ __forceinline__ void phase2(const Params& p) {
    phase2_main(p);
}

constexpr int SC_TC = 32, SC_NC = (T + SC_TC - 1) / SC_TC;
constexpr int SC_ARR = SC_TC * 64;
constexpr int SC_VOFF = 5 * SC_ARR, SC_COFF = SC_VOFF + SC_TC * 16;
constexpr int SC_BUF = (SC_COFF + SC_TC) * 4;
constexpr int SC_YOFF = 2 * SC_BUF, SC_YBUF = SC_TC * 16 * 4;
__device__ __forceinline__ float dot4(const f32x4& a, const f32x4& b) {
    f32x2 t = __builtin_shufflevector(a, a, 0, 1) * __builtin_shufflevector(b, b, 0, 1);
    t = __builtin_shufflevector(a, a, 2, 3) * __builtin_shufflevector(b, b, 2, 3) + t;
    return t[0] + t[1];
}
__device__ __forceinline__ void reduce16x2(float& a, float& b) {
    a += dppf<0xB1>(a); b += dppf<0xB1>(b); a += dppf<0x4E>(a); b += dppf<0x4E>(b);
    a += dppf<0x141>(a); b += dppf<0x141>(b); a += dppf<0x140>(a); b += dppf<0x140>(b);
}
__device__ __forceinline__ void scan_unit(const Params& p, int unit) {
    unsigned char* ws = p.ws;
    const int bh = unit >> 2, vr0 = (unit & 3) * 16, tid = threadIdx.x, wave = tid >> 6, lane = tid & 63;
    const _Float16* SI = (const _Float16*)(ws + R_SI);
    constexpr size_t SIE = (size_t)MP * 512;
    bf16_t* Y = (bf16_t*)(ws + O_Y);
    const size_t hb = (size_t)bh * TP * 64;
    __syncthreads();
    if (wave >= 4) {
        const int i = tid - 256, ip = i >= 8 ? i - 8 : i;
        const int arrs[5] = {SI_R, SI_W, SI_K, SI_KK, SI_B};
        u32x4 rg[5], rp[3]; unsigned rv;
        auto issue = [&](int c) {
            const size_t off = ((size_t)bh * TP + (size_t)c * SC_TC + (i >> 3)) * 448 + (i & 7) * 8;
            const size_t offp = i >= 8 ? off - 448 : off;
#pragma unroll
            for (int a = 0; a < 5; ++a) rg[a] = *(const u32x4*)(SI + arrs[a] * 64 + off);
            rp[0] = *(const u32x4*)(SI + SI_W * 64 + offp);
            rp[1] = *(const u32x4*)(SI + SI_K * 64 + offp);
            rp[2] = *(const u32x4*)(SI + SI_B * 64 + offp);
            rv = *(const unsigned*)(SI + SI_V * 64 + off - (i & 7) * 8 + vr0 + (i & 7) * 2);
        };
        auto commit = [&](int bufi) {
            float* buf = (float*)(smem + bufi * SC_BUF);
            float f[5][8];
#pragma unroll
            for (int a = 0; a < 5; ++a) {
                const h16x8 hv = __builtin_bit_cast(h16x8, rg[a]);
#pragma unroll
                for (int e = 0; e < 8; ++e) f[a][e] = (float)hv[e];
            }
            const bool odd = (i >> 3) & 1;
            float ckk = 0.f, cbk = 0.f;
            {
                const h16x8 pw = __builtin_bit_cast(h16x8, rp[0]), pk = __builtin_bit_cast(h16x8, rp[1]), pb = __builtin_bit_cast(h16x8, rp[2]);
#pragma unroll
                for (int e = 0; e < 8; ++e) {
                    const float kk2 = f[3][e];
                    ckk += (float)pk[e] * kk2; cbk += (float)pb[e] * kk2;
                    if (odd) f[3][e] = (1.0f - (float)pw[e]) * kk2;
                }
            }
            ckk += dppf<0xB1>(ckk); cbk += dppf<0xB1>(cbk); ckk += dppf<0x4E>(ckk); cbk += dppf<0x4E>(cbk); ckk += dppf<0x141>(ckk); cbk += dppf<0x141>(cbk);
#pragma unroll
            for (int a = 0; a < 5; ++a) {
                f32x4 lo, hi;
#pragma unroll
                for (int e = 0; e < 4; ++e) { lo[e] = f[a][e]; hi[e] = f[a][4 + e]; }
                if (a == 1) { lo = 1.0f - lo; hi = 1.0f - hi; }
                if (a == 4) { lo = -lo; hi = -hi; }
                *(f32x4*)(buf + a * SC_ARR + i * 8) = lo; *(f32x4*)(buf + a * SC_ARR + i * 8 + 4) = hi;
            }
            const h16x2 v2 = __builtin_bit_cast(h16x2, rv);
            f32x2 vf; vf[0] = (float)v2[0]; vf[1] = (float)v2[1];
            *(f32x2*)(buf + SC_VOFF + (i >> 3) * 16 + (i & 7) * 2) = vf;
            if (odd && (i & 7) == 0) { f32x2 cf; cf[0] = ckk; cf[1] = cbk; *(f32x2*)(buf + SC_COFF + (i >> 4) * 2) = cf; }
        };
        auto yout = [&](int c) {
            const float* yb = (const float*)(smem + SC_YOFF + (c & 1) * SC_YBUF);
            const f32x2 v = *(const f32x2*)(yb + (i >> 3) * 16 + (i & 7) * 2);
            *(unsigned*)(Y + hb + (size_t)(c * SC_TC + (i >> 3)) * 64 + vr0 + (i & 7) * 2) = pk_bf16(v[0], v[1]);
        };
        issue(0); commit(0); issue(1);
        __syncthreads();
        for (int c = 0; c < SC_NC; ++c) {
            if (c > 0) yout(c - 1);
            if (c + 1 < SC_NC) commit((c + 1) & 1);
            if (c + 2 < SC_NC) issue(c + 2);
            __syncthreads();
        }
        yout(SC_NC - 1);
    } else {
        const int rl = wave * 4 + (lane >> 4), sub = lane & 15;
        const bool odd_lane = lane & 1; const int yoff = (lane & 1) * 16 + rl;
        f32x4 S = {0.f, 0.f, 0.f, 0.f};
        __builtin_amdgcn_s_setprio(3);
        __syncthreads();
        for (int c = 0; c < SC_NC; ++c) {
            const float* buf = (const float*)(smem + (c & 1) * SC_BUF);
            float* yb = (float*)(smem + SC_YOFF + (c & 1) * SC_YBUF);
            const float* bp = buf + sub * 4;
#define SC_LD(arr, s) (*(const f32x4*)(bp + (arr) * SC_ARR + (s) * 64))
            f32x4 r1 = SC_LD(0, 0), w1 = SC_LD(1, 0), k1 = SC_LD(2, 0), q1 = SC_LD(3, 0), n1 = SC_LD(4, 0);
            f32x4 r2 = SC_LD(0, 1), w2 = SC_LD(1, 1), k2 = SC_LD(2, 1), g2 = SC_LD(3, 1), n2 = SC_LD(4, 1);
            float v1 = buf[SC_VOFF + rl], v2 = buf[SC_VOFF + 16 + rl];
            f32x2 cf = *(const f32x2*)(buf + SC_COFF);
#pragma unroll
            for (int pr = 0; pr < SC_TC / 2; ++pr) {
                const int sn = 2 * pr + 2;
                const f32x4 r1n = SC_LD(0, sn), w1n = SC_LD(1, sn), k1n = SC_LD(2, sn), q1n = SC_LD(3, sn), n1n = SC_LD(4, sn);
                const f32x4 r2n = SC_LD(0, sn + 1), w2n = SC_LD(1, sn + 1), k2n = SC_LD(2, sn + 1), g2n = SC_LD(3, sn + 1), n2n = SC_LD(4, sn + 1);
                const float v1n = buf[SC_VOFF + sn * 16 + rl], v2n = buf[SC_VOFF + (sn + 1) * 16 + rl];
                const f32x2 cfn = *(const f32x2*)(buf + SC_COFF + (pr + 1) * 2);
                __builtin_amdgcn_sched_barrier(0x7);
                float d1 = dot4(S, q1), e2 = dot4(S, g2);
                const f32x4 t1 = S * w1 + v1 * k1;
                reduce16x2(d1, e2);
                const float d2 = e2 + v1 * cf[0] - d1 * cf[1];
                const f32x4 S1 = t1 + d1 * n1;
                const f32x4 S2 = (S1 * w2 + v2 * k2) + d2 * n2;
                float y1 = dot4(S1, r1), y2 = dot4(S2, r2);
                y1 += dppf<0xB1>(y1); y2 += dppf<0xB1>(y2);
                float yz = odd_lane ? y2 : y1;
                yz += dppf<0x122>(yz); yz += dppf<0x124>(yz); yz += dppf<0x128>(yz);
                yb[(2 * pr) * 16 + yoff] = yz;
                S = S2;
                r1 = r1n; w1 = w1n; k1 = k1n; q1 = q1n; n1 = n1n; r2 = r2n; w2 = w2n; k2 = k2n; g2 = g2n; n2 = n2n; v1 = v1n; v2 = v2n; cf = cfn;
            }
#undef SC_LD
            __syncthreads();
        }
        __builtin_amdgcn_s_setprio(0);
    }
}

constexpr int KLD = 72;
__device__ __forceinline__ void attn_unit(const Params& p, int unit) {
    unsigned char* ws = p.ws;
    const int qt = unit % 65, bh = unit / 65, b = bh >> 3, h = bh & 7;
    const int tid = threadIdx.x, wave = tid >> 6, lane = tid & 63, fr = lane & 15, fq = lane >> 4;
    const bf16_t* Q = (const bf16_t*)(ws + R_QKV) + (size_t)bh * TP * 64;
    const bf16_t* Kg = Q + QKV_ONE / 2;
    const bf16_t* Vg = Q + QKV_ONE;
    bf16_t* slots = (bf16_t*)smem;
    constexpr int SLOT = 2 * 64 * KLD;
    volatile int* flags = (volatile int*)(smem + 2 * SLOT * 2);
    const int t0 = qt * 128, tq = t0 + wave * 16 + fr;
    bf16x8 qf[2];
    qf[0] = *(const bf16x8*)(Q + (size_t)tq * 64 + fq * 8);
    qf[1] = *(const bf16x8*)(Q + (size_t)tq * 64 + 32 + fq * 8);
    float qs = 0.f;
#pragma unroll
    for (int s = 0; s < 2; ++s)
#pragma unroll
        for (int e = 0; e < 8; ++e) { const float f = bf2f((unsigned short)qf[s][e]); qs += f * f; }
    qs += __shfl_xor(qs, 16); qs += __shfl_xor(qs, 32);
    const f32x4 km4 = *(const f32x4*)((const float*)(ws + WS_CTL) + 16 + bh * 4);
    const float kmax = sqrtf(fmaxf(fmaxf(km4[0], km4[1]), fmaxf(km4[2], km4[3])));
    const float zb = sqrtf(qs) * kmax * 1.0001f + 88.0f;
    float Arow = 0.f;
    f32x4 O[4];
#pragma unroll
    for (int nd = 0; nd < 4; ++nd) O[nd] = (f32x4){0.f, 0.f, 0.f, 0.f};
    const int key = tid >> 3, dc = (tid & 7) * 8, half = wave >> 2;
    auto tile_store = [&](int blk, const u32x4& kv, const u32x4& vv) {
        bf16_t* Ks_ = slots + (blk & 1) * SLOT; bf16_t* Vt_ = Ks_ + 64 * KLD;
        *(u32x4*)(Ks_ + key * KLD + dc) = kv;
#pragma unroll
        for (int e = 0; e < 4; ++e) { Vt_[(dc + 2 * e) * KLD + key] = (bf16_t)(vv[e] & 0xffffu); Vt_[(dc + 2 * e + 1) * KLD + key] = (bf16_t)(vv[e] >> 16); }
    };
    const int ktop = qt * 2 + 1;
    {
        const u32x4 k0 = *(const u32x4*)(Kg + (size_t)(ktop * 64 + key) * 64 + dc), v0 = *(const u32x4*)(Vg + (size_t)(ktop * 64 + key) * 64 + dc);
        __syncthreads();
        tile_store(ktop, k0, v0);
    }
    u32x4 kvv = *(const u32x4*)(Kg + (size_t)((ktop - 1) * 64 + key) * 64 + dc);
    u32x4 vvv = *(const u32x4*)(Vg + (size_t)((ktop - 1) * 64 + key) * 64 + dc);
    for (int kt = ktop; kt >= 0; --kt) {
        const int kb = kt - 1 + half;
        const bool done = __all(Arow > zb) || kb < 0;
        if (lane == 0) flags[wave] = done ? 1 : 0;
        __syncthreads();
        int alld = 1;
#pragma unroll
        for (int w = 0; w < 8; ++w) alld &= flags[w];
        if (alld) break;
        if (kt >= 1) {
            tile_store(kt - 1, kvv, vvv);
            if (kt >= 2) {
                kvv = *(const u32x4*)(Kg + (size_t)((kt - 2) * 64 + key) * 64 + dc);
                vvv = *(const u32x4*)(Vg + (size_t)((kt - 2) * 64 + key) * 64 + dc);
            }
        }
        asm volatile("s_waitcnt lgkmcnt(0)" ::: "memory");
        __builtin_amdgcn_s_barrier();
        if (kb < 0) continue;
        const bf16_t* Ks = slots + (kb & 1) * SLOT; const bf16_t* Vt = Ks + 64 * KLD;
        f32x4 z[4];
#pragma unroll
        for (int n = 0; n < 4; ++n) {
            z[n] = (f32x4){0.f, 0.f, 0.f, 0.f};
#pragma unroll
            for (int s = 0; s < 2; ++s) {
                const bf16x8 kf = *(const bf16x8*)(Ks + (n * 16 + fr) * KLD + s * 32 + fq * 8);
                z[n] = __builtin_amdgcn_mfma_f32_16x16x32_bf16(kf, qf[s], z[n], 0, 0, 0);
            }
        }
        float sp[4][4], lt[4], ex[4], sg[4];
#pragma unroll
        for (int n = 0; n < 4; ++n) {
#pragma unroll
            for (int j = 0; j < 4; ++j) { const int s = kb * 64 + n * 16 + fq * 4 + j; sp[n][j] = s < tq ? softplusf_(z[n][j]) : 0.f; }
            sp[n][2] += sp[n][3]; sp[n][1] += sp[n][2]; sp[n][0] += sp[n][1];
            lt[n] = sp[n][0];
            const float a = __shfl_xor(lt[n], 16), pr = lt[n] + a, c = __shfl_xor(pr, 32);
            ex[n] = fq == 3 ? 0.f : (fq == 2 ? a : (fq == 1 ? c : a + c));
            sg[n] = pr + c;
        }
        float nsuf[4]; nsuf[3] = 0.f; nsuf[2] = sg[3]; nsuf[1] = nsuf[2] + sg[2]; nsuf[0] = nsuf[1] + sg[1];
        float wgt[4][4];
#pragma unroll
        for (int n = 0; n < 4; ++n)
#pragma unroll
            for (int j = 0; j < 4; ++j) {
                const int s = kb * 64 + n * 16 + fq * 4 + j;
                const float C = Arow + nsuf[n] + ex[n] + sp[n][j];
                wgt[n][j] = s < tq ? __expf(z[n][j] - C) : 0.f;
            }
        Arow += nsuf[0] + sg[0];
#pragma unroll
        for (int ks = 0; ks < 2; ++ks) {
            u32x4 pw; pw.x = pk_bf16(wgt[2 * ks][0], wgt[2 * ks][1]); pw.y = pk_bf16(wgt[2 * ks][2], wgt[2 * ks][3]);
            pw.z = pk_bf16(wgt[2 * ks + 1][0], wgt[2 * ks + 1][1]); pw.w = pk_bf16(wgt[2 * ks + 1][2], wgt[2 * ks + 1][3]);
            const bf16x8 pf = __builtin_bit_cast(bf16x8, pw);
#pragma unroll
            for (int nd = 0; nd < 4; ++nd) {
                u32x4 vw;
                const u32x2 v0 = *(const u32x2*)(Vt + (nd * 16 + fr) * KLD + (2 * ks) * 16 + fq * 4);
                const u32x2 v1 = *(const u32x2*)(Vt + (nd * 16 + fr) * KLD + (2 * ks + 1) * 16 + fq * 4);
                vw.x = v0.x; vw.y = v0.y; vw.z = v1.x; vw.w = v1.y;
                O[nd] = __builtin_amdgcn_mfma_f32_16x16x32_bf16(pf, __builtin_bit_cast(bf16x8, vw), O[nd], 0, 0, 0);
            }
        }
    }
    __syncthreads();
    bf16_t* Ot = (bf16_t*)smem;
#pragma unroll
    for (int j = 0; j < 4; ++j)
#pragma unroll
        for (int nd = 0; nd < 4; ++nd) Ot[(wave * 16 + fq * 4 + j) * KLD + nd * 16 + fr] = (bf16_t)(pk_bf16(O[nd][j], 0.f) & 0xffffu);
    __syncthreads();
    bf16_t* osb = (bf16_t*)(ws + O_OSB);
#pragma unroll
    for (int i = 0; i < 2; ++i) {
        const int idx = tid + 512 * i, r = idx >> 3, pc8 = (idx & 7) * 8, t = t0 + r;
        if (t >= NMETA && t < T) *(u32x4*)(osb + (size_t)(b * SEQ + t - NMETA) * 512 + h * 64 + pc8) = *(const u32x4*)(Ot + r * KLD + pc8);
    }
}

constexpr int N_SCAN = 128, N_ATTN = 32 * 65;
__device__ __forceinline__ void sub_barrier(unsigned* ctr, unsigned target, bool arrive) {
    asm volatile("s_waitcnt vmcnt(0)" ::: "memory");
    __syncthreads();
    if (threadIdx.x == 0) {
        if (arrive) { __builtin_amdgcn_fence(__ATOMIC_RELEASE, "agent"); asm volatile("s_waitcnt vmcnt(0)" ::: "memory"); (void)xb_add(ctr, 1u); }
        unsigned sp = 0u;
        while (xb_ld(ctr) < target) { __builtin_amdgcn_s_sleep(2); if (++sp > (1u << 22)) break; }
        __builtin_amdgcn_fence(__ATOMIC_ACQUIRE, "agent");
        asm volatile("s_waitcnt vmcnt(0)" ::: "memory");
    }
    __syncthreads();
}
__device__ __forceinline__ void phase3(const Params& p) {
    unsigned char* ws = p.ws;
    unsigned* ctl = (unsigned*)(ws + WS_CTL);
    const int nother = (int)gridDim.x - N_SCAN;
    if ((int)blockIdx.x < N_SCAN) {
        scan_unit(p, blockIdx.x);
    } else {
        EpiInProj<true> epi{(bf16_t*)(ws + R_QKV), (_Float16*)(ws + R_URW), (bf16_t*)p.out};
        gemm_phase((const bf16_t*)(ws + O_A0), (const bf16_t*)(ws + WS_WIN), D, MP / BM, 14, epi, nother, (int)blockIdx.x - N_SCAN, 6, 7);
        sub_barrier(ctl + 256, (unsigned)nother, true);
        for (int it = (int)blockIdx.x - N_SCAN; it < 128; it += nother) phase2_kmax(p, it);
        sub_barrier(ctl + 320, (unsigned)nother, true);
    }
    sub_barrier(ctl + 320, (unsigned)nother, false);
    volatile int* slot = (volatile int*)(smem + 131072 - 16);
    for (;;) {
        __syncthreads();
        if (threadIdx.x == 0) *slot = (int)atomicAdd(ctl, 1u);
        __syncthreads();
        const int u = *slot;
        if (u >= N_ATTN) break;
        attn_unit(p, u);
    }
}

__device__ __forceinline__ void phase3c(const Params& p) {
    unsigned char* ws = p.ws;
    const _Float16* SI = (const _Float16*)(ws + R_SI);
    constexpr size_t SIE = (size_t)MP * 512;
    const bf16_t* Y = (const bf16_t*)(ws + O_Y);
    const bf16_t* G = (const bf16_t*)(ws + R_G);
    bf16_t* orw = (bf16_t*)(ws + O_ORW);
    const int tid = threadIdx.x, sub = tid & 15;
    constexpr int U = 4;
    for (int it = blockIdx.x; it < 32 * 64; it += gridDim.x) {
        const int bh = it >> 6, c4 = it & 63, b = bh >> 3, h = bh & 7;
        const int c = h * 64 + sub * 4;
        const f32x4 gain = *(const f32x4*)(p.in[14] + c), bias = *(const f32x4*)(p.in[15] + c), rk = *(const f32x4*)(p.in[13] + c);
        u32x2 yb2[U]; f32x4 y[U]; h16x4 r4[U], k4[U], v4[U]; u32x2 g2[U];
#pragma unroll
        for (int u = 0; u < U; ++u) {
            const int t = NMETA + (c4 * U + u) * 32 + (tid >> 4);
            const size_t base = ((size_t)bh * TP + t) * 64 + sub * 4;
            const size_t rec = ((size_t)bh * TP + t) * 448, pbase = rec + (sub & 3) * 16 + (sub >> 2) * 4;
            yb2[u] = *(const u32x2*)(Y + base);
            r4[u] = *(const h16x4*)(SI + SI_R * 64 + pbase); k4[u] = *(const h16x4*)(SI + SI_K * 64 + pbase); v4[u] = *(const h16x4*)(SI + SI_V * 64 + rec + sub * 4);
            g2[u] = *(const u32x2*)((const bf16_t*)SI + 6 * 64 + pbase);
        }
#pragma unroll
        for (int u = 0; u < U; ++u) {
            const int t = NMETA + (c4 * U + u) * 32 + (tid >> 4);
            y[u][0] = __uint_as_float(yb2[u].x << 16); y[u][1] = __uint_as_float(yb2[u].x & 0xffff0000u); y[u][2] = __uint_as_float(yb2[u].y << 16); y[u][3] = __uint_as_float(yb2[u].y & 0xffff0000u);
            const float mean = reduce16((y[u][0] + y[u][1]) + (y[u][2] + y[u][3])) * (1.0f / 64.0f);
            const f32x4 dy = y[u] - mean;
            const float var = reduce16((dy[0] * dy[0] + dy[1] * dy[1]) + (dy[2] * dy[2] + dy[3] * dy[3])) * (1.0f / 64.0f);
            const float rs = rsqrtf(var + GN_EPS);
            float bs = 0.f;
#pragma unroll
            for (int j = 0; j < 4; ++j) bs += (float)r4[u][j] * (float)k4[u][j] * rk[j];
            bs = reduce16(bs);
            const float gg[4] = {__uint_as_float(g2[u].x << 16), __uint_as_float(g2[u].x & 0xffff0000u), __uint_as_float(g2[u].y << 16), __uint_as_float(g2[u].y & 0xffff0000u)};
            float o[4];
#pragma unroll
            for (int j = 0; j < 4; ++j) o[j] = (dy[j] * rs * gain[j] + bias[j] + bs * (float)v4[u][j]) * gg[j];
            u32x2 w; w.x = pk_bf16(o[0], o[1]); w.y = pk_bf16(o[2], o[3]);
            *(u32x2*)(orw + (size_t)(b * SEQ + t - NMETA) * 512 + c) = w;
        }
    }
}

__device__ __forceinline__ void phase4(const Params& p) {
    unsigned char* ws = p.ws;
    EpiBranch1 e1{(bf16_t*)(ws + O_T1), (const bf16_t*)p.out};
    EpiBranch2 e2{(const bf16_t*)(ws + O_T1), (const bf16_t*)p.out, (bf16_t*)(ws + O_M)};
    gemm_phase((const bf16_t*)(ws + O_OSB), (const bf16_t*)(ws + WS_WSB), 512, MS / BM, D / BM, e1);
    gemm_phase((const bf16_t*)(ws + O_ORW), (const bf16_t*)(ws + WS_WRW), 512, MS / BM, D / BM, e2);
}
__device__ __forceinline__ void phase5(const Params& p) {
    unsigned char* ws = p.ws;
    EpiBf16 e{(bf16_t*)(ws + O_P)};
    gemm_phase((const bf16_t*)(ws + O_M), (const bf16_t*)(ws + WS_WOUT), D, MS / BM, D / BM, e);
}
__device__ __forceinline__ void phase6(const Params& p) {
    unsigned char* ws = p.ws;
    const int lane = threadIdx.x & 63;
    f32x4 g1[4], g2[4];
#pragma unroll
    for (int j = 0; j < 4; ++j) { g1[j] = *(const f32x4*)(p.in[3] + 4 * lane + 256 * j); g2[j] = *(const f32x4*)(p.in[19] + 4 * lane + 256 * j); }
    for (int it = blockIdx.x; it < MS / 16; it += gridDim.x) {
        const int row0 = it * 16 + (threadIdx.x >> 6) * 2;
        f32x4 v[2][4], x[2][4];
#pragma unroll
        for (int r = 0; r < 2; ++r)
#pragma unroll
            for (int j = 0; j < 4; ++j) {
                { const u32x2 pb2 = *(const u32x2*)((const bf16_t*)(ws + O_P) + (size_t)(row0 + r) * D + 4 * lane + 256 * j);
                  v[r][j] = (f32x4){__uint_as_float(pb2.x << 16), __uint_as_float(pb2.x & 0xffff0000u), __uint_as_float(pb2.y << 16), __uint_as_float(pb2.y & 0xffff0000u)}; }
                x[r][j] = *(const f32x4*)(p.in[0] + (size_t)(row0 + r) * D + 4 * lane + 256 * j);
            }
#pragma unroll
        for (int r = 0; r < 2; ++r) {
            const int row = row0 + r;
            float ss = 0.f;
#pragma unroll
            for (int j = 0; j < 4; ++j) ss += (v[r][j][0] * v[r][j][0] + v[r][j][1] * v[r][j][1]) + (v[r][j][2] * v[r][j][2] + v[r][j][3] * v[r][j][3]);
            const float rs = rsqrtf(wave_sum(ss) * (1.0f / D) + RMS_EPS);
            float s2 = 0.f;
#pragma unroll
            for (int j = 0; j < 4; ++j) {
                v[r][j] = x[r][j] + v[r][j] * rs * g1[j];
                *(f32x4*)(p.out + (size_t)row * D + 4 * lane + 256 * j) = v[r][j];
                s2 += (v[r][j][0] * v[r][j][0] + v[r][j][1] * v[r][j][1]) + (v[r][j][2] * v[r][j][2] + v[r][j][3] * v[r][j][3]);
            }
            const float rs2 = rsqrtf(wave_sum(s2) * (1.0f / D) + RMS_EPS);
            bf16_t* fr_ = (bf16_t*)(ws + O_F) + (size_t)row * D;
#pragma unroll
            for (int j = 0; j < 4; ++j) {
                u32x2 w; w.x = pk_bf16(v[r][j][0] * rs2 * g2[j][0], v[r][j][1] * rs2 * g2[j][1]); w.y = pk_bf16(v[r][j][2] * rs2 * g2[j][2], v[r][j][3] * rs2 * g2[j][3]);
                *(u32x2*)(fr_ + 4 * lane + 256 * j) = w;
            }
        }
    }
}
__device__ __forceinline__ void phase7(const Params& p) {
    unsigned char* ws = p.ws;
    EpiGU e{(bf16_t*)(ws + O_ACT)};
    gemm_phase((const bf16_t*)(ws + O_F), (const bf16_t*)(ws + WS_WGU), D, MS / BM, 2 * DFF / BM, e);
}
__device__ __forceinline__ void phase8(const Params& p) {
    unsigned char* ws = p.ws;
    EpiDownFused e{p.out, p.in[20], (float*)(ws + WS_XBUF), (unsigned*)(ws + WS_XCNT)};
    gemm_phase((const bf16_t*)(ws + O_ACT), (const bf16_t*)(ws + WS_WD), DFF, MS / BM, D / BM, e);
}
__device__ __forceinline__ void phase9(const Params& p) {
    unsigned char* ws = p.ws;
    const int lane = threadIdx.x & 63;
    f32x4 g[4];
#pragma unroll
    for (int j = 0; j < 4; ++j) g[j] = *(const f32x4*)(p.in[20] + 4 * lane + 256 * j);
    for (int it = blockIdx.x; it < MS / 16; it += gridDim.x) {
        const int row0 = it * 16 + (threadIdx.x >> 6) * 2;
        f32x4 v[2][4], h1[2][4];
#pragma unroll
        for (int r = 0; r < 2; ++r)
#pragma unroll
            for (int j = 0; j < 4; ++j) {
                { const u32x2 db2 = *(const u32x2*)((const bf16_t*)(ws + O_DN) + (size_t)(row0 + r) * D + 4 * lane + 256 * j);
                  v[r][j] = (f32x4){__uint_as_float(db2.x << 16), __uint_as_float(db2.x & 0xffff0000u), __uint_as_float(db2.y << 16), __uint_as_float(db2.y & 0xffff0000u)}; }
                h1[r][j] = *(const f32x4*)(p.out + (size_t)(row0 + r) * D + 4 * lane + 256 * j);
            }
#pragma unroll
        for (int r = 0; r < 2; ++r) {
            float ss = 0.f;
#pragma unroll
            for (int j = 0; j < 4; ++j) ss += (v[r][j][0] * v[r][j][0] + v[r][j][1] * v[r][j][1]) + (v[r][j][2] * v[r][j][2] + v[r][j][3] * v[r][j][3]);
            const float rs = rsqrtf(wave_sum(ss) * (1.0f / D) + RMS_EPS);
#pragma unroll
            for (int j = 0; j < 4; ++j) *(f32x4*)(p.out + (size_t)(row0 + r) * D + 4 * lane + 256 * j) = h1[r][j] + v[r][j] * rs * g[j];
        }
    }
}

constexpr int N_PHASES = 11;
__device__ __forceinline__ void run_phase(const Params& p, int ph) {
    switch (ph) {
        case 0: phase0(p); break;
        case 1: phase1(p); break;
        case 2: phase2(p); break;
        case 3: phase3(p); break;
        case 4: phase3c(p); break;
        case 5: phase4(p); break;
        case 6: phase5(p); break;
        case 7: phase6(p); break;
        case 8: phase7(p); break;
        case 9: phase8(p); break;
        default: phase9(p); break;
    }
}

#if MULTI_LAUNCH
template <int PH> __global__ void __launch_bounds__(512) fwd_phase(Params p) { run_phase(p, PH); }
#else
__global__ void __launch_bounds__(512) fwd_mega(Params p) {
    cg::grid_group grid = cg::this_grid();
    volatile LAS unsigned* st = (volatile LAS unsigned*)(smem + 131072);
    if (threadIdx.x == 0) { st[0] = 0u; st[1] = 0u; }
    __syncthreads();
    const XcdBarrier xb = xcd_barrier_post((unsigned*)(p.ws + WS_BAR), st);
    if (p.out == nullptr) grid.sync();
    phase0(p); xcd_barrier(xb); phase1(p); xcd_barrier(xb); phase2(p); xcd_barrier(xb); phase3(p); xcd_barrier(xb); phase3c(p); xcd_barrier(xb);
    phase4(p); xcd_barrier(xb); phase5(p); xcd_barrier(xb); phase6(p); xcd_barrier(xb); phase7(p); xcd_barrier(xb); phase8(p);
}
#endif

extern "C" void kernel_launch(void* const* d_in, const int* in_sizes, int n_in, void* d_out, int out_size, void* d_ws, size_t ws_size, hipStream_t stream) {
    static int grid = 0;
    if (grid == 0) {
        if (n_in != 24 || out_size != MS * D || ws_size < WS_END) { fprintf(stderr, "kernel_launch: unexpected shapes (n_in %d out %d ws %zu need %zu)\n", n_in, out_size, ws_size, (size_t)WS_END); grid = -1; return; }
        int dev = 0, cus = 0, per_cu = 0;
        (void)hipGetDevice(&dev);
        (void)hipDeviceGetAttribute(&cus, hipDeviceAttributeMultiprocessorCount, dev);
#if MULTI_LAUNCH
        per_cu = 1;
#else
        (void)hipFuncSetAttribute((const void*)fwd_mega, hipFuncAttributeMaxDynamicSharedMemorySize, LDS_BYTES);
        (void)hipOccupancyMaxActiveBlocksPerMultiprocessor(&per_cu, (const void*)fwd_mega, 512, LDS_BYTES);
        if (per_cu < 1) { fprintf(stderr, "kernel_launch: occupancy query says %d blocks per CU\n", per_cu); per_cu = 1; }
        if (per_cu > 1) per_cu = 1;
#endif
        grid = cus * per_cu;
        if (grid != 256) { fprintf(stderr, "kernel_launch: this kernel needs a 256-workgroup grid (got %d)\n", grid); grid = -1; return; }
        if (grid <= N_SCAN) { fprintf(stderr, "kernel_launch: grid %d too small (needs more than %d workgroups)\n", grid, N_SCAN); grid = -1; return; }
    }
    if (grid < 0) return;
    Params p{};
    for (int i = 0; i < 24; ++i) p.in[i] = (const float*)d_in[i];
    p.out = (float*)d_out; p.ws = (unsigned char*)d_ws;
#if MULTI_LAUNCH
#define LP(PH) do { (void)hipFuncSetAttribute((const void*)fwd_phase<PH>, hipFuncAttributeMaxDynamicSharedMemorySize, LDS_BYTES); hipLaunchKernelGGL(fwd_phase<PH>, dim3(grid), dim3(512), LDS_BYTES, stream, p); } while (0)
    LP(0); LP(1); LP(2); LP(3); LP(4); LP(5); LP(6); LP(7); LP(8); LP(9); LP(10);
#undef LP
#else
    if (hipMemsetAsync(d_ws, 0, WS_CTL_BYTES, stream) != hipSuccess) { fprintf(stderr, "kernel_launch: hipMemsetAsync of the control words failed\n"); return; }
    void* args[] = {&p};
    hipError_t e = hipLaunchCooperativeKernel((const void*)fwd_mega, dim3(grid), dim3(512), args, LDS_BYTES, stream);
    if (e != hipSuccess) fprintf(stderr, "cooperative launch failed: %s (grid %d)\n", hipGetErrorString(e), grid);
#endif
}
```

```cpp
#include <hip/hip_runtime.h>
#include <hip/hip_cooperative_groups.h>
#include <cstdio>
#include <cstdint>
#include <type_traits>
namespace cg = cooperative_groups;

#ifndef MULTI_LAUNCH
#define MULTI_LAUNCH 0
#endif

typedef unsigned short bf16_t;
typedef short bf16x8 __attribute__((ext_vector_type(8)));
typedef float f32x4 __attribute__((ext_vector_type(4)));
typedef float f32x2 __attribute__((ext_vector_type(2)));
typedef unsigned u32x2 __attribute__((ext_vector_type(2)));
typedef unsigned u32x4 __attribute__((ext_vector_type(4)));
typedef _Float16 h16x2 __attribute__((ext_vector_type(2)));
typedef _Float16 h16x4 __attribute__((ext_vector_type(4)));
typedef _Float16 h16x8 __attribute__((ext_vector_type(8)));

constexpr int D = 1024, NB = 4, SEQ = 8192, NMETA = 16, T = SEQ + NMETA, TP = 8320, MP = NB * TP, MS = NB * SEQ;
constexpr int PIN = 5376, DFF = 2816, NH = 8, RWS = 1792;
constexpr float RMS_EPS = 1e-6f, GN_EPS = 64e-5f;

constexpr size_t WS_CTL = 0;
constexpr size_t WS_BAR = 4096;
constexpr size_t WS_CTL_BYTES = 32768;
constexpr size_t WS_WIN = WS_CTL_BYTES;
constexpr size_t WS_WSB = WS_WIN + (size_t)PIN * D * 2;
constexpr size_t WS_WRW = WS_WSB + (size_t)D * 512 * 2;
constexpr size_t WS_WOUT = WS_WRW + (size_t)D * 512 * 2;
constexpr size_t WS_WGU = WS_WOUT + (size_t)D * D * 2;
constexpr size_t WS_WD = WS_WGU + (size_t)2 * DFF * D * 2;
constexpr size_t WS_WL = WS_WD + (size_t)D * DFF * 2;
constexpr size_t R_A0 = WS_WL + (size_t)512 * 256 * 2;
constexpr size_t R_URW = R_A0 + (size_t)MP * D * 2;
constexpr size_t R_QKV = R_URW;
constexpr size_t QKV_ONE = (size_t)MP * 512 * 2;
constexpr size_t R_SI = R_URW + (size_t)MP * RWS * 2;
constexpr size_t SI_ONE = (size_t)MP * 512 * 2;
constexpr size_t R_G = R_SI + 6 * SI_ONE;
constexpr size_t R_TAIL = R_G + SI_ONE;
constexpr size_t O_Y = R_TAIL;
constexpr size_t O_OSB = R_TAIL + SI_ONE;
constexpr size_t WS_END = O_OSB + (size_t)MS * 512 * 2;
constexpr size_t O_A0 = R_A0;
constexpr size_t O_ORW = R_A0;
constexpr size_t O_T1 = R_SI;
constexpr size_t O_M = R_SI + (size_t)MS * D * 4;
constexpr size_t O_P = R_A0;
constexpr size_t O_F = R_SI;
constexpr size_t O_ACT = R_A0;
constexpr size_t O_DN = R_SI + (size_t)MS * D * 2;
constexpr size_t O_H1B = R_SI + (size_t)MS * D * 4;
static_assert(O_H1B + (size_t)MS * D * 2 <= R_TAIL, "overlay");
static_assert(3 * QKV_ONE <= (size_t)MP * RWS * 2, "overlay");
static_assert(O_M + (size_t)MS * D * 2 <= R_TAIL, "overlay");
static_assert(O_ACT + (size_t)MS * DFF * 2 <= R_SI, "overlay");
static_assert(O_P + (size_t)MS * D * 4 <= R_SI, "overlay");
static_assert(O_DN + (size_t)MS * D * 4 <= R_TAIL, "overlay");
static_assert(WS_END <= (size_t)512 * 1024 * 1024, "workspace");

constexpr int LDS_BYTES = 131072 + 64;

struct Params { const float* in[24]; float* out; unsigned char* ws; };

extern __shared__ __attribute__((aligned(16))) unsigned char smem[];

typedef __bf16 b16x2 __attribute__((ext_vector_type(2)));
__device__ __forceinline__ unsigned pk_bf16(float lo, float hi) { const f32x2 v = {lo, hi}; return __builtin_bit_cast(unsigned, __builtin_convertvector(v, b16x2)); }
__device__ __forceinline__ float bf2f(unsigned short v) { return __uint_as_float((unsigned)v << 16); }
__device__ __forceinline__ float sigmoidf_(float x) { return __builtin_amdgcn_rcpf(1.0f + __expf(-x)); }
__device__ __forceinline__ float softplusf_(float x) { return fmaxf(x, 0.f) + __logf(1.0f + __expf(-fabsf(x))); }
template <int CTRL> __device__ __forceinline__ float dppf(float x) { return __builtin_bit_cast(float, __builtin_amdgcn_mov_dpp(__builtin_bit_cast(int, x), CTRL, 0xf, 0xf, true)); }
__device__ __forceinline__ float reduce16(float v) {
    v += dppf<0xB1>(v); v += dppf<0x4E>(v); v += dppf<0x141>(v); v += dppf<0x140>(v); return v;
}
__device__ __forceinline__ float wave_sum(float v) {
#pragma unroll
    for (int o = 1; o < 64; o <<= 1) v += __shfl_xor(v, o);
    return v;
}

#define LAS __attribute__((address_space(3)))
#define XB_TMO      128
#define XB_XCNT(j)  (256  + 64 * (j))
#define XB_XSUB(j)  (1280 + 64 * (j))
#define XB_XGEN(j)  (2304 + 64 * (j))
#define XB_TOP      3328
#define XB_TOPGEN   3392
#define XCD_BAR_WORDS 3456
#define XB_SPIN_CAP (1u << 18)
__device__ __forceinline__ unsigned xb_ld(unsigned* p)              { return __hip_atomic_load(p, __ATOMIC_RELAXED, __HIP_MEMORY_SCOPE_AGENT); }
__device__ __forceinline__ unsigned xb_add(unsigned* p, unsigned v) { return __hip_atomic_fetch_add(p, v, __ATOMIC_RELAXED, __HIP_MEMORY_SCOPE_AGENT); }
__device__ __forceinline__ unsigned xb_xcc_id() { return (unsigned)__builtin_amdgcn_s_getreg((3 << 11) | 20) & 0xFu; }
#define XB_SPIN(cond, bar) do { unsigned _sp = 0; while (cond) { __builtin_amdgcn_s_sleep(1); \
    if ((++_sp & 255u) == 0u) { if (xb_ld(&(bar)[XB_TMO])) break; if (_sp > XB_SPIN_CAP) { atomicAdd(&(bar)[XB_TMO], 1u); break; } } } } while (0)
struct XcdBarrier { unsigned* bar; unsigned x; volatile LAS unsigned* st; };
__device__ __forceinline__ XcdBarrier xcd_barrier_post(unsigned* bar, volatile LAS unsigned* st) {
    XcdBarrier b; b.bar = bar; b.x = xb_xcc_id(); b.st = st;
    if (threadIdx.x == 0) (void)xb_add(&bar[XB_XCNT(b.x)], 1u);
    return b;
}
__device__ __forceinline__ void xcd_barrier_complete(unsigned* bar, unsigned x, unsigned& nloc, unsigned& nx) {
    const unsigned G = gridDim.x * gridDim.y * gridDim.z;
    unsigned sum, cnt, mine, sp = 0u;
    for (;;) {
        sum = 0u; cnt = 0u; mine = 0u;
#pragma unroll
        for (unsigned j = 0; j < 16; ++j) { const unsigned c = xb_ld(&bar[XB_XCNT(j)]); sum += c; cnt += (c > 0u) ? 1u : 0u; mine = (j == x) ? c : mine; }
        if (sum == G) break;
        __builtin_amdgcn_s_sleep(1);
        if ((++sp & 255u) == 0u) { if (xb_ld(&bar[XB_TMO])) break; if (sp > XB_SPIN_CAP) { atomicAdd(&bar[XB_TMO], 1u); break; } }
    }
    nloc = mine > 0u ? mine : 1u; nx = cnt > 0u ? cnt : 1u;
}
__device__ __forceinline__ void xcd_barrier(const XcdBarrier& b) {
    asm volatile("s_waitcnt vmcnt(0)" ::: "memory");
    __syncthreads();
    if (threadIdx.x == 0) {
        unsigned* bar = b.bar;
        __builtin_amdgcn_s_waitcnt(0);
        unsigned nloc = b.st[0], nx = b.st[1];
        if (nloc == 0u) { xcd_barrier_complete(bar, b.x, nloc, nx); b.st[0] = nloc; b.st[1] = nx; }
        const unsigned old = xb_add(&bar[XB_XSUB(b.x)], 1u);
        const unsigned gen = old / nloc;
        if (old + 1u == (gen + 1u) * nloc) {
            __builtin_amdgcn_fence(__ATOMIC_RELEASE, "agent");
            asm volatile("s_waitcnt vmcnt(0)" ::: "memory");
            const unsigned og = xb_add(&bar[XB_TOP], 1u);
            const unsigned tg = og / nx;
            if (og + 1u == (tg + 1u) * nx) xb_add(&bar[XB_TOPGEN], 1u);
            else XB_SPIN(xb_ld(&bar[XB_TOPGEN]) == tg, bar);
            __builtin_amdgcn_fence(__ATOMIC_ACQUIRE, "agent");
            xb_add(&bar[XB_XGEN(b.x)], 1u);
            asm volatile("s_waitcnt vmcnt(0)" ::: "memory");
        } else {
            XB_SPIN(xb_ld(&bar[XB_XGEN(b.x)]) == gen, bar);
            __builtin_amdgcn_fence(__ATOMIC_ACQUIRE, "agent");
            asm volatile("s_waitcnt vmcnt(0)" ::: "memory");
        }
    }
    __syncthreads();
}

constexpr int BM = 256, BK = 64, HALF = 128, HTB = HALF * BK * 2, NXCD = 8, WGM = 8;
__device__ __forceinline__ int lds_byte(int r, int c) { const int st = (r >> 4) * 2 + (c >> 5), rr = r & 15, cc = c & 31, ob = rr * 64 + cc * 2; return st * 1024 + (ob ^ (((ob >> 9) & 1) << 5)); }
__device__ __forceinline__ void stage_rc(int b, int& R, int& C) { const int st = b / 1024, sb = b % 1024, swz = sb ^ (((sb >> 9) & 1) << 5); R = (st >> 1) * 16 + swz / 64; C = (st & 1) * 32 + (swz % 64) / 2; }
struct Unit { int pm, pn; };
struct Sched {
    int nM, nN, nwg, G, c;
    __device__ __forceinline__ bool next(int i, Unit& u) const {
        const long L = (long)i * G + c; if (L >= nwg) return false;
        int wgid = (int)L; { const int q = nwg / NXCD, r = nwg % NXCD, xcd = wgid % NXCD, off = wgid / NXCD; wgid = (xcd < r ? xcd * (q + 1) : r * (q + 1) + (xcd - r) * q) + off; }
        const int nig = WGM * nN, gid = wgid / nig, fm = gid * WGM, gsz = (nM - fm) < WGM ? (nM - fm) : WGM;
        u.pm = fm + ((wgid % nig) % gsz); u.pn = (wgid % nig) / gsz; return true;
    }
};

template <class Epi>
__device__ __forceinline__ void gemm_phase(const bf16_t* __restrict__ Ag, const bf16_t* __restrict__ Btg, const int K, const int nM, const int nN, const Epi& E,
                                           const int G = (int)gridDim.x, const int c = (int)blockIdx.x, const int pn_from = 1 << 30, const int pn_add = 0) {
    LAS unsigned char* lds = (LAS unsigned char*)smem;
    const int tid = threadIdx.x, wid = __builtin_amdgcn_readfirstlane(tid >> 6), lane = tid & 63, wr = wid >> 2, wc = wid & 3, fr = lane & 15, fq = lane >> 4;
    const int nt = K / BK;
    Sched S; S.nM = nM; S.nN = nN; S.nwg = nM * nN; S.G = G; S.c = c;
    unsigned voffA[2], voffB[2];
#pragma unroll
    for (int i = 0; i < 2; ++i) { int R, C; stage_rc(tid * 16 + i * 8192, R, C);
        const int Rb = Epi::PERM ? ((R & ~31) + 8 * ((R & 15) >> 2) + 4 * ((R & 31) >> 4) + (R & 3)) : R;
        voffA[i] = (unsigned)(R * K + C) * 2u; voffB[i] = (unsigned)(Rb * K + C) * 2u; }
    const size_t kstep = (size_t)(BK * 2);
    const size_t hstep = (size_t)HALF * K * 2;
    const size_t tstep = 2 * hstep;
    const unsigned ldsw = (unsigned)wid * 1024u;
    const int aoff = lds_byte(wr * 64 + fr, fq * 8), boff = lds_byte(wc * 32 + fr, fq * 8);
#define PG8_SA(b, h) (((b) * 2 + (h)) * HTB)
#define PG8_SB(b, h) ((4 + (b) * 2 + (h)) * HTB)
#define PG8_STAGE(bufoff, gbase, voff) do { _Pragma("unroll") for (int _i = 0; _i < 2; ++_i) \
        __builtin_amdgcn_global_load_lds((const unsigned*)((const char*)(gbase) + (voff)[_i]), (LAS unsigned*)(lds + (bufoff) + ldsw + _i * 8192), 16, 0, 0); } while (0)
#define PG8_LDA(dst, b, h) do { _Pragma("unroll") for (int m = 0; m < 4; ++m) _Pragma("unroll") for (int k = 0; k < 2; ++k) dst[m][k] = *(const LAS bf16x8*)(lds + PG8_SA(b, h) + aoff + m * 2048 + k * 1024); } while (0)
#define PG8_LDB(dst, b, h) do { _Pragma("unroll") for (int n = 0; n < 2; ++n) _Pragma("unroll") for (int k = 0; k < 2; ++k) dst[n][k] = *(const LAS bf16x8*)(lds + PG8_SB(b, h) + boff + n * 2048 + k * 1024); } while (0)
#define PG8_MMA(ai, bj, At, Bt) do { __builtin_amdgcn_s_setprio(1); _Pragma("unroll") for (int m = 0; m < 4; ++m) _Pragma("unroll") for (int n = 0; n < 2; ++n) _Pragma("unroll") for (int k = 0; k < 2; ++k) \
        acc[ai][bj][m][n] = __builtin_amdgcn_mfma_f32_16x16x32_bf16(Bt[n][k], At[m][k], acc[ai][bj][m][n], 0, 0, 0); __builtin_amdgcn_s_setprio(0); } while (0)
#define PG8_WAIT_V(n) asm volatile("s_waitcnt vmcnt(" #n ")" ::: "memory")
#define PG8_WAIT_L(n) asm volatile("s_waitcnt lgkmcnt(" #n ")" ::: "memory")
#define PG8_BAR __builtin_amdgcn_s_barrier()
#define PG8_SCHED __builtin_amdgcn_sched_barrier(0)
    Unit cur, nxt; int ui = 0;
    __syncthreads();
    if (!S.next(0, cur)) return;
    if (cur.pn >= pn_from) cur.pn += pn_add;
    f32x4 acc[2][2][4][2];
#pragma unroll
    for (int a = 0; a < 2; ++a)
#pragma unroll
        for (int b = 0; b < 2; ++b)
#pragma unroll
            for (int m = 0; m < 4; ++m)
#pragma unroll
                for (int n = 0; n < 2; ++n) acc[a][b][m][n] = (f32x4){0.f, 0.f, 0.f, 0.f};
    bf16x8 At[4][2], B0[2][2], B1[2][2];
    const char* cA = (const char*)Ag + (size_t)cur.pm * tstep; const char* cB = (const char*)Btg + (size_t)cur.pn * tstep;
    PG8_STAGE(PG8_SB(0, 0), cB, voffB); PG8_STAGE(PG8_SB(0, 1), cB + hstep, voffB); PG8_STAGE(PG8_SA(0, 0), cA, voffA); PG8_STAGE(PG8_SA(0, 1), cA + hstep, voffA);
    if (wr == 1) PG8_BAR;
    PG8_WAIT_V(2); PG8_BAR;
    PG8_STAGE(PG8_SB(1, 0), cB + kstep, voffB); PG8_STAGE(PG8_SA(1, 0), cA + kstep, voffA); PG8_STAGE(PG8_SB(1, 1), cB + hstep + kstep, voffB);
    PG8_WAIT_V(6); PG8_BAR;
    for (;;) {
        const bool has_next = S.next(ui + 1, nxt);
        if (has_next && nxt.pn >= pn_from) nxt.pn += pn_add;
        const char* nA = has_next ? (const char*)Ag + (size_t)nxt.pm * tstep : cA; const char* nB = has_next ? (const char*)Btg + (size_t)nxt.pn * tstep : cB;
        for (int t = 0; t < nt; t += 2) {
            const bool last = (t == nt - 2);
            const char* a1 = cA + (size_t)(t + 1) * kstep;
            const char* a2 = last ? nA : cA + (size_t)(t + 2) * kstep; const char* b2 = last ? nB : cB + (size_t)(t + 2) * kstep;
            const char* a3 = a2 + kstep; const char* b3 = b2 + kstep;
            PG8_LDB(B0, 0, 0); PG8_LDB(B1, 0, 1); PG8_SCHED; PG8_LDA(At, 0, 0); PG8_STAGE(PG8_SA(1, 1), a1 + hstep, voffA);
            PG8_WAIT_V(8); PG8_WAIT_L(0); PG8_BAR; PG8_MMA(0, 0, At, B0); PG8_MMA(0, 1, At, B1); PG8_BAR; PG8_SCHED;
            PG8_LDA(At, 0, 1); PG8_STAGE(PG8_SB(0, 0), b2, voffB); PG8_STAGE(PG8_SB(0, 1), b2 + hstep, voffB); PG8_STAGE(PG8_SA(0, 0), a2, voffA);
            PG8_WAIT_V(8); PG8_WAIT_L(0); PG8_BAR; PG8_MMA(1, 0, At, B0); PG8_MMA(1, 1, At, B1); PG8_BAR; PG8_SCHED;
            PG8_LDB(B0, 1, 0); PG8_LDB(B1, 1, 1); PG8_SCHED; PG8_LDA(At, 1, 0); PG8_STAGE(PG8_SA(0, 1), a2 + hstep, voffA);
            PG8_WAIT_V(8); PG8_WAIT_L(0); PG8_BAR; PG8_MMA(0, 0, At, B0); PG8_MMA(0, 1, At, B1); PG8_BAR; PG8_SCHED;
            PG8_LDA(At, 1, 1); PG8_STAGE(PG8_SB(1, 0), b3, voffB); PG8_STAGE(PG8_SB(1, 1), b3 + hstep, voffB); PG8_STAGE(PG8_SA(1, 0), a3, voffA);
            PG8_WAIT_V(8); PG8_WAIT_L(0); PG8_BAR; PG8_MMA(1, 0, At, B0); PG8_MMA(1, 1, At, B1); PG8_BAR; PG8_SCHED;
        }
        if (wr == 0) PG8_BAR;
        {
            const int brow = cur.pm * BM, bcol = cur.pn * BM;
#pragma unroll
            for (int ai = 0; ai < 2; ++ai)
#pragma unroll
                for (int m = 0; m < 4; ++m) {
                    E.row(brow + ai * HALF + wr * 64 + m * 16 + fr, bcol + wc * 32, fq, acc[ai][0][m][0], acc[ai][0][m][1], acc[ai][1][m][0], acc[ai][1][m][1]);
                    asm volatile("" ::: "memory");
                }
        }
        if (!has_next) break;
#pragma unroll
        for (int a = 0; a < 2; ++a)
#pragma unroll
            for (int b = 0; b < 2; ++b)
#pragma unroll
                for (int m = 0; m < 4; ++m)
#pragma unroll
                    for (int n = 0; n < 2; ++n) acc[a][b][m][n] = (f32x4){0.f, 0.f, 0.f, 0.f};
        cur = nxt; cA = nA; cB = nB; ++ui;
        if (wr == 1) PG8_BAR;
    }
    PG8_WAIT_V(0);
    PG8_BAR;
#undef PG8_SA
#undef PG8_SB
#undef PG8_STAGE
#undef PG8_LDA
#undef PG8_LDB
#undef PG8_MMA
#undef PG8_WAIT_V
#undef PG8_WAIT_L
#undef PG8_BAR
#undef PG8_SCHED
}

template <bool PERM_> struct EpiInProj {
    static constexpr bool PERM = PERM_;
    bf16_t* qkv; _Float16* urw; bf16_t* gates;
    __device__ __forceinline__ void one(int row, int col, const f32x4& v) const {
        if (col < 1536) {
            const int which = col >> 9, hc = col & 511, h = hc >> 6, d = hc & 63, b = row / TP, t = row - b * TP;
            const float s = which == 0 ? 0.125f : 1.0f;
            u32x2 w; w.x = pk_bf16(v[0] * s, v[1] * s); w.y = pk_bf16(v[2] * s, v[3] * s);
            *(u32x2*)(qkv + (size_t)which * (QKV_ONE / 2) + ((size_t)(b * NH + h) * TP + t) * 64 + d) = w;
        } else if (col < 3328) {
            h16x4 o; o[0] = (_Float16)v[0]; o[1] = (_Float16)v[1]; o[2] = (_Float16)v[2]; o[3] = (_Float16)v[3];
            *(h16x4*)(urw + (size_t)row * RWS + (col - 1536)) = o;
        } else {
            const int b = row / TP, t = row - b * TP;
            if (t >= NMETA && t < T) {
                u32x2 w; w.x = pk_bf16(sigmoidf_(v[0]), sigmoidf_(v[1])); w.y = pk_bf16(sigmoidf_(v[2]), sigmoidf_(v[3]));
                *(u32x2*)(gates + (size_t)(b * SEQ + t - NMETA) * 2048 + (col - 3328)) = w;
            }
        }
    }
    __device__ __forceinline__ void half(int row, int col32, int fq, const f32x4& v0, const f32x4& v1) const {
        if constexpr (PERM_) {
            const int col = col32 + 8 * fq, b = row / TP, t = row - b * TP;
            if (col < 1536) {
                const int which = col >> 9, hc = col & 511, h = hc >> 6, d = hc & 63;
                const float s = which == 0 ? 0.125f : 1.0f;
                u32x4 w; w.x = pk_bf16(v0[0] * s, v0[1] * s); w.y = pk_bf16(v0[2] * s, v0[3] * s); w.z = pk_bf16(v1[0] * s, v1[1] * s); w.w = pk_bf16(v1[2] * s, v1[3] * s);
                *(u32x4*)(qkv + (size_t)which * (QKV_ONE / 2) + ((size_t)(b * NH + h) * TP + t) * 64 + d) = w;
            } else if (t >= NMETA && t < T) {
                u32x4 w; w.x = pk_bf16(sigmoidf_(v0[0]), sigmoidf_(v0[1])); w.y = pk_bf16(sigmoidf_(v0[2]), sigmoidf_(v0[3]));
                w.z = pk_bf16(sigmoidf_(v1[0]), sigmoidf_(v1[1])); w.w = pk_bf16(sigmoidf_(v1[2]), sigmoidf_(v1[3]));
                *(u32x4*)(gates + (size_t)(b * SEQ + t - NMETA) * 2048 + (col - 3328)) = w;
            }
        } else {
            if (col32 >= 1536 && col32 < 3072) {
                const int c = col32 - 1536, pos = (c & ~63) + fq * 16 + ((c & 63) >> 4) * 4;
                h16x8 o;
#pragma unroll
                for (int j = 0; j < 4; ++j) { o[j] = (_Float16)v0[j]; o[4 + j] = (_Float16)v1[j]; }
                *(h16x8*)(urw + (size_t)row * RWS + pos) = o;
            } else { one(row, col32 + 4 * fq, v0); one(row, col32 + 16 + 4 * fq, v1); }
        }
    }
    __device__ __forceinline__ void row(int r, int col32, int fq, const f32x4& a00, const f32x4& a01, const f32x4& a10, const f32x4& a11) const { half(r, col32, fq, a00, a01); half(r, col32 + HALF, fq, a10, a11); }
};
__device__ __forceinline__ void bf8_to_f(const u32x4& g, float (&f)[8]) {
#pragma unroll
    for (int i = 0; i < 4; ++i) { f[2 * i] = __uint_as_float(g[i] << 16); f[2 * i + 1] = __uint_as_float(g[i] & 0xffff0000u); }
}
struct EpiBranch1 {
    static constexpr bool PERM = true;
    bf16_t* t1; const bf16_t* gates;
    __device__ __forceinline__ void half(int row, int col32, int fq, const f32x4& v0, const f32x4& v1) const {
        const int col = col32 + 8 * fq;
        float g[8]; bf8_to_f(*(const u32x4*)(gates + (size_t)row * 2048 + col), g);
        u32x4 w; w.x = pk_bf16(v0[0] * g[0], v0[1] * g[1]); w.y = pk_bf16(v0[2] * g[2], v0[3] * g[3]); w.z = pk_bf16(v1[0] * g[4], v1[1] * g[5]); w.w = pk_bf16(v1[2] * g[6], v1[3] * g[7]);
        *(u32x4*)(t1 + (size_t)row * D + col) = w;
    }
    __device__ __forceinline__ void row(int r, int col32, int fq, const f32x4& a00, const f32x4& a01, const f32x4& a10, const f32x4& a11) const { half(r, col32, fq, a00, a01); half(r, col32 + HALF, fq, a10, a11); }
};
struct EpiBranch2 {
    static constexpr bool PERM = true;
    const bf16_t* t1; const bf16_t* gates; bf16_t* m;
    __device__ __forceinline__ void half(int row, int col32, int fq, const f32x4& v0, const f32x4& v1) const {
        const int col = col32 + 8 * fq;
        float g[8], a[8]; bf8_to_f(*(const u32x4*)(gates + (size_t)row * 2048 + 1024 + col), g); bf8_to_f(*(const u32x4*)(t1 + (size_t)row * D + col), a);
        u32x4 w; w.x = pk_bf16(a[0] + v0[0] * g[0], a[1] + v0[1] * g[1]); w.y = pk_bf16(a[2] + v0[2] * g[2], a[3] + v0[3] * g[3]);
        w.z = pk_bf16(a[4] + v1[0] * g[4], a[5] + v1[1] * g[5]); w.w = pk_bf16(a[6] + v1[2] * g[6], a[7] + v1[3] * g[7]);
        *(u32x4*)(m + (size_t)row * D + col) = w;
    }
    __device__ __forceinline__ void row(int r, int col32, int fq, const f32x4& a00, const f32x4& a01, const f32x4& a10, const f32x4& a11) const { half(r, col32, fq, a00, a01); half(r, col32 + HALF, fq, a10, a11); }
};
struct EpiF32 {
    static constexpr bool PERM = true;
    float* o;
    __device__ __forceinline__ void row(int r, int col32, int fq, const f32x4& a00, const f32x4& a01, const f32x4& a10, const f32x4& a11) const {
        float* q = o + (size_t)r * D + col32 + 8 * fq;
        *(f32x4*)q = a00; *(f32x4*)(q + 4) = a01; *(f32x4*)(q + HALF) = a10; *(f32x4*)(q + HALF + 4) = a11;
    }
};
struct EpiBf16 {
    static constexpr bool PERM = true;
    bf16_t* o;
    __device__ __forceinline__ void row(int r, int col32, int fq, const f32x4& a00, const f32x4& a01, const f32x4& a10, const f32x4& a11) const {
        bf16_t* q = o + (size_t)r * D + col32 + 8 * fq;
        u32x4 w0, w1;
        w0.x = pk_bf16(a00[0], a00[1]); w0.y = pk_bf16(a00[2], a00[3]); w0.z = pk_bf16(a01[0], a01[1]); w0.w = pk_bf16(a01[2], a01[3]);
        w1.x = pk_bf16(a10[0], a10[1]); w1.y = pk_bf16(a10[2], a10[3]); w1.z = pk_bf16(a11[0], a11[1]); w1.w = pk_bf16(a11[2], a11[3]);
        *(u32x4*)q = w0; *(u32x4*)(q + HALF) = w1;
    }
};
struct EpiGU {
    static constexpr bool PERM = true;
    bf16_t* act;
    __device__ __forceinline__ void row(int r, int col32, int fq, const f32x4& g0, const f32x4& g1, const f32x4& u0, const f32x4& u1) const {
        float o[8];
#pragma unroll
        for (int j = 0; j < 4; ++j) { o[j] = g0[j] * sigmoidf_(g0[j]) * u0[j]; o[4 + j] = g1[j] * sigmoidf_(g1[j]) * u1[j]; }
        u32x4 w; w.x = pk_bf16(o[0], o[1]); w.y = pk_bf16(o[2], o[3]); w.z = pk_bf16(o[4], o[5]); w.w = pk_bf16(o[6], o[7]);
        const int pn = col32 >> 8, cin = (col32 & 255) + 8 * fq;
        *(u32x4*)(act + (size_t)r * DFF + pn * 128 + cin) = w;
    }
};

__device__ __forceinline__ void transpose_tile(const float* __restrict__ src, int K, int N, bf16_t* __restrict__ dst, int ldd, int koff, int mode, int tile) {
    float* scr = (float*)smem;
    const int ntn = N / 128, kb = tile / ntn, nb = tile % ntn, k0 = kb * 64, n0 = nb * 128, tid = threadIdx.x;
    f32x4 v[4];
#pragma unroll
    for (int i = 0; i < 4; ++i) { const int idx = tid + 512 * i, kk = idx >> 5, n4 = idx & 31; v[i] = *(const f32x4*)(src + (size_t)(k0 + kk) * N + n0 + n4 * 4); }
#pragma unroll
    for (int i = 0; i < 4; ++i) { const int idx = tid + 512 * i, kk = idx >> 5, n4 = idx & 31;
#pragma unroll
        for (int c = 0; c < 4; ++c) scr[kk * 129 + n4 * 4 + c] = v[i][c]; }
    __syncthreads();
#pragma unroll
    for (int i = 0; i < 2; ++i) {
        const int o = tid + 512 * i, n = o >> 3, kc = (o & 7) * 8;
        u32x4 w;
        w.x = pk_bf16(scr[(kc + 0) * 129 + n], scr[(kc + 1) * 129 + n]); w.y = pk_bf16(scr[(kc + 2) * 129 + n], scr[(kc + 3) * 129 + n]);
        w.z = pk_bf16(scr[(kc + 4) * 129 + n], scr[(kc + 5) * 129 + n]); w.w = pk_bf16(scr[(kc + 6) * 129 + n], scr[(kc + 7) * 129 + n]);
        const int f = n0 + n;
        const int drow = mode == 0 ? f : ((f >> 7) * 256 + (mode == 2 ? 128 : 0) + (f & 127));
        *(u32x4*)(dst + (size_t)drow * ldd + koff + k0 + kc) = w;
    }
    __syncthreads();
}

__device__ __forceinline__ void phase0(const Params& p) {
    unsigned char* ws = p.ws;
    if (blockIdx.x == 0 && threadIdx.x < 64) ((unsigned*)(ws + WS_CTL))[threadIdx.x] = 0u;
    constexpr int J0 = 16 * 42, J1 = 8 * 8, J3 = 16 * 8, J4 = 16 * 22, J6 = 44 * 8, J7 = 4, J9 = 8;
    constexpr int NT = J0 + 2 * J1 + J3 + 2 * J4 + J6 + 2 * J7 + J9;
    constexpr int NR = MP / 32;
    for (int it = blockIdx.x; it < NT + NR; it += gridDim.x) {
        if (it >= NR) {
            int r = it - NR;
            if (r < J0) { transpose_tile(p.in[4], D, PIN, (bf16_t*)(ws + WS_WIN), D, 0, 0, r); continue; } r -= J0;
            if (r < J1) { transpose_tile(p.in[16], 512, D, (bf16_t*)(ws + WS_WSB), 512, 0, 0, r); continue; } r -= J1;
            if (r < J1) { transpose_tile(p.in[17], 512, D, (bf16_t*)(ws + WS_WRW), 512, 0, 0, r); continue; } r -= J1;
            if (r < J3) { transpose_tile(p.in[18], D, D, (bf16_t*)(ws + WS_WOUT), D, 0, 0, r); continue; } r -= J3;
            if (r < J4) { transpose_tile(p.in[21], D, DFF, (bf16_t*)(ws + WS_WGU), D, 0, 1, r); continue; } r -= J4;
            if (r < J4) { transpose_tile(p.in[22], D, DFF, (bf16_t*)(ws + WS_WGU), D, 0, 2, r); continue; } r -= J4;
            if (r < J6) { transpose_tile(p.in[23], DFF, D, (bf16_t*)(ws + WS_WD), DFF, 0, 0, r); continue; } r -= J6;
            if (r < J7) { transpose_tile(p.in[6], 64, 512, (bf16_t*)(ws + WS_WL), 256, 0, 0, r); continue; } r -= J7;
            if (r < J7) { transpose_tile(p.in[8], 64, 512, (bf16_t*)(ws + WS_WL), 256, 64, 0, r); continue; } r -= J7;
            transpose_tile(p.in[10], 128, 512, (bf16_t*)(ws + WS_WL), 256, 128, 0, r);
        } else {
            const int lane = threadIdx.x & 63, row0 = it * 32 + (threadIdx.x >> 6) * 4;
            f32x4 v[4][4];
#pragma unroll
            for (int r = 0; r < 4; ++r) {
                const int row = row0 + r, b = row / TP, t = row - b * TP;
                const float* src = t < NMETA ? p.in[1] + (size_t)t * D : p.in[0] + ((size_t)b * SEQ + (t < T ? t - NMETA : 0)) * D;
#pragma unroll
                for (int j = 0; j < 4; ++j) v[r][j] = *(const f32x4*)(src + 4 * lane + 256 * j);
            }
            f32x4 g[4];
#pragma unroll
            for (int j = 0; j < 4; ++j) g[j] = *(const f32x4*)(p.in[2] + 4 * lane + 256 * j);
#pragma unroll
            for (int r = 0; r < 4; ++r) {
                const int row = row0 + r, b = row / TP, t = row - b * TP;
                float ss = 0.f;
#pragma unroll
                for (int j = 0; j < 4; ++j) ss += (v[r][j][0] * v[r][j][0] + v[r][j][1] * v[r][j][1]) + (v[r][j][2] * v[r][j][2] + v[r][j][3] * v[r][j][3]);
                const float rs = t < T ? rsqrtf(wave_sum(ss) * (1.0f / D) + RMS_EPS) : 0.f;
                bf16_t* orow = (bf16_t*)(ws + O_A0) + (size_t)row * D;
#pragma unroll
                for (int j = 0; j < 4; ++j) {
                    u32x2 w; w.x = pk_bf16(v[r][j][0] * rs * g[j][0], v[r][j][1] * rs * g[j][1]); w.y = pk_bf16(v[r][j][2] * rs * g[j][2], v[r][j][3] * rs * g[j][3]);
                    *(u32x2*)(orow + 4 * lane + 256 * j) = w;
                }
            }
        }
    }
}

__device__ __forceinline__ void phase1(const Params& p) {
    unsigned char* ws = p.ws;
    EpiInProj<false> epi{(bf16_t*)(ws + R_QKV), (_Float16*)(ws + R_URW), (bf16_t*)p.out};
    gemm_phase((const bf16_t*)(ws + O_A0), (const bf16_t*)(ws + WS_WIN), D, MP / BM, 7, epi, (int)gridDim.x, (int)blockIdx.x, 0, 6);
}

constexpr int SI_R = 0, SI_W = 1, SI_K = 2, SI_V = 3, SI_KK = 4, SI_B = 5;
constexpr int ALD = 264;
constexpr int P2_WLS = 64 * ALD * 2;
constexpr int P2_MU = P2_WLS;
constexpr int P2_AL = P2_MU + 1024;
__device__ __forceinline__ void phase2_main(const Params& p) {
    unsigned char* ws = p.ws;
    const int tid = threadIdx.x, wave = tid >> 6, lane = tid & 63, fr = lane & 15, fq = lane >> 4;
    const int h = blockIdx.x & 7, nslot = (gridDim.x >> 3) * 8, slot = (blockIdx.x >> 3) * 8 + wave;
    const _Float16* urw = (const _Float16*)(ws + R_URW);
    const float* mu = p.in[5];
    bf16_t* WLs = (bf16_t*)smem;
    float* mus = (float*)(smem + P2_MU);
    bf16_t* Al = (bf16_t*)(smem + P2_AL) + wave * (16 * ALD);
    __syncthreads();
    {
        const bf16_t* WL = (const bf16_t*)(ws + WS_WL) + (size_t)h * 64 * 256;
#pragma unroll
        for (int i = 0; i < 4; ++i) { const int idx = tid + 512 * i, row = idx >> 5, c16 = idx & 31; *(u32x4*)(WLs + row * ALD + c16 * 8) = *(const u32x4*)(WL + row * 256 + c16 * 8); }
        if (tid < 256) mus[tid] = mu[1536 + tid];
    }
    __syncthreads();
    if (blockIdx.x >= nslot) return;
    _Float16* SI = (_Float16*)(ws + R_SI);
    bf16_t* G = (bf16_t*)(ws + R_G);
    constexpr size_t SIE = (size_t)MP * 512;
#pragma unroll 1
    for (int g = slot; g < NB * 514; g += nslot) {
        const int ub = g / 514, ui = g - ub * 514, row0 = ub * TP + ui * 16;
        {
            const int half = lane >> 5, pc = (lane & 31) * 8;
            const float sA = pc < 64 ? 2.f : 1.f, sC = pc < 64 ? -1.f : 0.f;
            const bool lin = pc >= 64 && pc < 128;
            const f32x4 mA = *(const f32x4*)(mu + 1536 + pc), mB = *(const f32x4*)(mu + 1536 + pc + 4);
            h16x8 c[8], pv[8];
#pragma unroll
            for (int q = 0; q < 8; ++q) {
                const int rowa = row0 + 2 * q + half, ta = rowa % TP;
                const _Float16* cur = urw + (size_t)rowa * RWS + 1536 + pc;
                c[q] = *(const h16x8*)cur;
                pv[q] = *(const h16x8*)(ta > 0 ? cur - RWS : cur);
            }
#pragma unroll
            for (int q = 0; q < 8; ++q) {
                const int ta = (row0 + 2 * q + half) % TP;
                float o[8];
#pragma unroll
                for (int e = 0; e < 8; ++e) {
                    const float cf = (float)c[q][e], pf = ta > 0 ? (float)pv[q][e] : 0.f;
                    const float xs = cf + (e < 4 ? mA[e & 3] : mB[e & 3]) * (pf - cf);
                    const float sg = __builtin_amdgcn_rcpf(1.0f + __expf(-sA * xs));
                    o[e] = lin ? xs : sA * sg + sC;
                }
                u32x4 w; w.x = pk_bf16(o[0], o[1]); w.y = pk_bf16(o[2], o[3]); w.z = pk_bf16(o[4], o[5]); w.w = pk_bf16(o[6], o[7]);
                *(u32x4*)(Al + (2 * q + half) * ALD + pc) = w;
            }
        }
        asm volatile("s_waitcnt lgkmcnt(0)" ::: "memory");
        __builtin_amdgcn_wave_barrier();
        f32x4 acc[4];
        auto lora = [&](auto kbeg_c, auto ksteps_c) {
            constexpr int kbeg = decltype(kbeg_c)::value, ksteps = decltype(ksteps_c)::value;
#pragma unroll
            for (int n = 0; n < 4; ++n) acc[n] = (f32x4){0.f, 0.f, 0.f, 0.f};
#pragma unroll
            for (int ks = 0; ks < ksteps; ++ks) {
                const bf16x8 af = *(const bf16x8*)(Al + fr * ALD + kbeg + ks * 32 + fq * 8);
#pragma unroll
                for (int n = 0; n < 4; ++n) {
                    const bf16x8 wf = *(const bf16x8*)(WLs + (n * 16 + fr) * ALD + kbeg + ks * 32 + fq * 8);
                    acc[n] = __builtin_amdgcn_mfma_f32_16x16x32_bf16(wf, af, acc[n], 0, 0, 0);
                }
            }
        };
        const int row = row0 + fr, b = row / TP, t = row - b * TP;
        const size_t base = ((size_t)(b * NH + h) * TP + t) * 448;
        const _Float16* ur = urw + (size_t)row * RWS;
        const size_t pb = base + fq * 16;
        lora(std::integral_constant<int, 0>{}, std::integral_constant<int, 2>{});
        {
            h16x8 wo[2];
#pragma unroll
            for (int n = 0; n < 4; ++n) {
                const f32x4 db = *(const f32x4*)(p.in[7] + h * 64 + n * 16 + fq * 4);
#pragma unroll
                for (int j = 0; j < 4; ++j) {
                    const float e = sigmoidf_(db[j] + acc[n][j]) * 0.60653065971f;
                    wo[n >> 1][(n & 1) * 4 + j] = (_Float16)(1.0f - __expf(-e));
                }
            }
            *(h16x8*)(SI + SI_W * 64 + pb) = wo[0]; *(h16x8*)(SI + SI_W * 64 + pb + 8) = wo[1];
        }
        lora(std::integral_constant<int, 64>{}, std::integral_constant<int, 2>{});
        {
            const _Float16* up = ur + h * 64 + fq * 16;
            const _Float16* upp = t > 0 ? up - RWS : up;
            h16x8 kc[2], rc[2], vc[2], kp[2], rp[2], vp[2];
#pragma unroll
            for (int i = 0; i < 2; ++i) {
                rc[i] = *(const h16x8*)(up + i * 8); kc[i] = *(const h16x8*)(up + 512 + i * 8); vc[i] = *(const h16x8*)(up + 1024 + i * 8);
                rp[i] = *(const h16x8*)(upp + i * 8); kp[i] = *(const h16x8*)(upp + 512 + i * 8); vp[i] = *(const h16x8*)(upp + 1024 + i * 8);
            }
            float kv[4][4], av[4][4], kkr[4][4]; float ss = 0.f;
            h16x8 ro[2];
#pragma unroll
            for (int n = 0; n < 4; ++n) {
                const int c = n * 16 + fq * 4, c512 = h * 64 + c;
                const f32x4 muk = *(const f32x4*)(mu + 512 + c512), mur = *(const f32x4*)(mu + c512), muv = *(const f32x4*)(mu + 1024 + c512);
                const f32x4 ab = *(const f32x4*)(p.in[9] + c512), kkw = *(const f32x4*)(p.in[11] + c512);
                h16x4 vo;
#pragma unroll
                for (int j = 0; j < 4; ++j) {
                    const int i = n >> 1, e = (n & 1) * 4 + j;
                    const float kcf = (float)kc[i][e], kpf = t > 0 ? (float)kp[i][e] : 0.f;
                    const float rcf = (float)rc[i][e], rpf = t > 0 ? (float)rp[i][e] : 0.f;
                    const float vcf = (float)vc[i][e], vpf = t > 0 ? (float)vp[i][e] : 0.f;
                    kv[n][j] = kcf + muk[j] * (kpf - kcf);
                    ro[i][e] = (_Float16)(rcf + mur[j] * (rpf - rcf));
                    vo[j] = (_Float16)(vcf + muv[j] * (vpf - vcf));
                    av[n][j] = sigmoidf_(ab[j] + acc[n][j]);
                    kkr[n][j] = kv[n][j] * kkw[j];
                    ss += kkr[n][j] * kkr[n][j];
                }
                *(h16x4*)(SI + SI_V * 64 + base + c) = vo;
            }
            *(h16x8*)(SI + SI_R * 64 + pb) = ro[0]; *(h16x8*)(SI + SI_R * 64 + pb + 8) = ro[1];
            ss += __shfl_xor(ss, 16); ss += __shfl_xor(ss, 32);
            const float inv = fminf(__builtin_amdgcn_rsqf(ss), 1e12f);
            h16x8 ko[2], kko[2], bo[2];
#pragma unroll
            for (int n = 0; n < 4; ++n) {
                const f32x4 ka = *(const f32x4*)(p.in[12] + h * 64 + n * 16 + fq * 4);
#pragma unroll
                for (int j = 0; j < 4; ++j) {
                    const int i = n >> 1, e = (n & 1) * 4 + j;
                    const float kk = kkr[n][j] * inv;
                    ko[i][e] = (_Float16)(kv[n][j] * (1.0f + (av[n][j] - 1.0f) * ka[j]));
                    kko[i][e] = (_Float16)kk;
                    bo[i][e] = (_Float16)(kk * av[n][j]);
                }
            }
#pragma unroll
            for (int i = 0; i < 2; ++i) {
                *(h16x8*)(SI + SI_K * 64 + pb + i * 8) = ko[i]; *(h16x8*)(SI + SI_KK * 64 + pb + i * 8) = kko[i]; *(h16x8*)(SI + SI_B * 64 + pb + i * 8) = bo[i];
            }
        }
        lora(std::integral_constant<int, 128>{}, std::integral_constant<int, 4>{});
        {
            u32x4 g0, g1;
            g0.x = pk_bf16(acc[0][0], acc[0][1]); g0.y = pk_bf16(acc[0][2], acc[0][3]); g0.z = pk_bf16(acc[1][0], acc[1][1]); g0.w = pk_bf16(acc[1][2], acc[1][3]);
            g1.x = pk_bf16(acc[2][0], acc[2][1]); g1.y = pk_bf16(acc[2][2], acc[2][3]); g1.z = pk_bf16(acc[3][0], acc[3][1]); g1.w = pk_bf16(acc[3][2], acc[3][3]);
            *(u32x4*)((bf16_t*)SI + 6 * 64 + pb) = g0; *(u32x4*)((bf16_t*)SI + 6 * 64 + pb + 8) = g1;
        }
        asm volatile("s_waitcnt lgkmcnt(0)" ::: "memory");
        __builtin_amdgcn_wave_barrier();
    }
}
__device__ __forceinline__ void phase2_kmax(const Params& p, int item) {
    unsigned char* ws = p.ws;
    const int bh = item >> 2, qr = item & 3, tid = threadIdx.x;
    float* red = (float*)(smem + P2_AL + 8 * 16 * ALD * 2);
    float ss = 0.f;
    for (int t = qr * 2052 + tid; t < (qr + 1) * 2052; t += 512) {
        const bf16_t* kr = (const bf16_t*)(ws + R_QKV) + QKV_ONE / 2 + ((size_t)bh * TP + t) * 64;
        float s1 = 0.f;
#pragma unroll
        for (int q = 0; q < 8; ++q) {
            const u32x4 v = *(const u32x4*)(kr + q * 8);
#pragma unroll
            for (int e = 0; e < 4; ++e) { const float lo = __uint_as_float(v[e] << 16), hi = __uint_as_float(v[e] & 0xffff0000u); s1 += lo * lo + hi * hi; }
        }
        ss = fmaxf(ss, s1);
    }
#pragma unroll
    for (int o = 1; o < 64; o <<= 1) ss = fmaxf(ss, __shfl_xor(ss, o));
    __syncthreads();
    if ((tid & 63) == 0) red[tid >> 6] = ss;
    __syncthreads();
    if (tid == 0) {
        float m = red[0];
#pragma unroll
        for (int w = 1; w < 8; ++w) m = fmaxf(m, red[w]);
        ((float*)(ws + WS_CTL))[16 + item] = m;
    }
}
__device__ __forceinline__ void phase2(const Params& p) {
    phase2_main(p);
}

constexpr int SC_TC = 32, SC_NC = (T + SC_TC - 1) / SC_TC;
constexpr int SC_ARR = SC_TC * 64;
constexpr int SC_VOFF = 5 * SC_ARR, SC_COFF = SC_VOFF + SC_TC * 16;
constexpr int SC_BUF = (SC_COFF + SC_TC) * 4;
constexpr int SC_YOFF = 2 * SC_BUF, SC_YBUF = SC_TC * 16 * 4;
__device__ __forceinline__ float dot4(const f32x4& a, const f32x4& b) {
    f32x2 t = __builtin_shufflevector(a, a, 0, 1) * __builtin_shufflevector(b, b, 0, 1);
    t = __builtin_shufflevector(a, a, 2, 3) * __builtin_shufflevector(b, b, 2, 3) + t;
    return t[0] + t[1];
}
__device__ __forceinline__ void reduce16x2(float& a, float& b) {
    a += dppf<0xB1>(a); b += dppf<0xB1>(b); a += dppf<0x4E>(a); b += dppf<0x4E>(b);
    a += dppf<0x141>(a); b += dppf<0x141>(b); a += dppf<0x140>(a); b += dppf<0x140>(b);
}
__device__ __forceinline__ void scan_unit(const Params& p, int unit) {
    unsigned char* ws = p.ws;
    const int bh = unit >> 2, vr0 = (unit & 3) * 16, tid = threadIdx.x, wave = tid >> 6, lane = tid & 63;
    const _Float16* SI = (const _Float16*)(ws + R_SI);
    constexpr size_t SIE = (size_t)MP * 512;
    bf16_t* Y = (bf16_t*)(ws + O_Y);
    const size_t hb = (size_t)bh * TP * 64;
    __syncthreads();
    if (wave >= 4) {
        const int i = tid - 256, ip = i >= 8 ? i - 8 : i;
        const int arrs[5] = {SI_R, SI_W, SI_K, SI_KK, SI_B};
        u32x4 rg[5], rp[3]; unsigned rv;
        auto issue = [&](int c) {
            const size_t off = ((size_t)bh * TP + (size_t)c * SC_TC + (i >> 3)) * 448 + (i & 7) * 8;
            const size_t offp = i >= 8 ? off - 448 : off;
#pragma unroll
            for (int a = 0; a < 5; ++a) rg[a] = *(const u32x4*)(SI + arrs[a] * 64 + off);
            rp[0] = *(const u32x4*)(SI + SI_W * 64 + offp);
            rp[1] = *(const u32x4*)(SI + SI_K * 64 + offp);
            rp[2] = *(const u32x4*)(SI + SI_B * 64 + offp);
            rv = *(const unsigned*)(SI + SI_V * 64 + off - (i & 7) * 8 + vr0 + (i & 7) * 2);
        };
        auto commit = [&](int bufi) {
            float* buf = (float*)(smem + bufi * SC_BUF);
            float f[5][8];
#pragma unroll
            for (int a = 0; a < 5; ++a) {
                const h16x8 hv = __builtin_bit_cast(h16x8, rg[a]);
#pragma unroll
                for (int e = 0; e < 8; ++e) f[a][e] = (float)hv[e];
            }
            const bool odd = (i >> 3) & 1;
            float ckk = 0.f, cbk = 0.f;
            {
                const h16x8 pw = __builtin_bit_cast(h16x8, rp[0]), pk = __builtin_bit_cast(h16x8, rp[1]), pb = __builtin_bit_cast(h16x8, rp[2]);
#pragma unroll
                for (int e = 0; e < 8; ++e) {
                    const float kk2 = f[3][e];
                    ckk += (float)pk[e] * kk2; cbk += (float)pb[e] * kk2;
                    if (odd) f[3][e] = (1.0f - (float)pw[e]) * kk2;
                }
            }
            ckk += dppf<0xB1>(ckk); cbk += dppf<0xB1>(cbk); ckk += dppf<0x4E>(ckk); cbk += dppf<0x4E>(cbk); ckk += dppf<0x141>(ckk); cbk += dppf<0x141>(cbk);
#pragma unroll
            for (int a = 0; a < 5; ++a) {
                f32x4 lo, hi;
#pragma unroll
                for (int e = 0; e < 4; ++e) { lo[e] = f[a][e]; hi[e] = f[a][4 + e]; }
                if (a == 1) { lo = 1.0f - lo; hi = 1.0f - hi; }
                if (a == 4) { lo = -lo; hi = -hi; }
                *(f32x4*)(buf + a * SC_ARR + i * 8) = lo; *(f32x4*)(buf + a * SC_ARR + i * 8 + 4) = hi;
            }
            const h16x2 v2 = __builtin_bit_cast(h16x2, rv);
            f32x2 vf; vf[0] = (float)v2[0]; vf[1] = (float)v2[1];
            *(f32x2*)(buf + SC_VOFF + (i >> 3) * 16 + (i & 7) * 2) = vf;
            if (odd && (i & 7) == 0) { f32x2 cf; cf[0] = ckk; cf[1] = cbk; *(f32x2*)(buf + SC_COFF + (i >> 4) * 2) = cf; }
        };
        auto yout = [&](int c) {
            const float* yb = (const float*)(smem + SC_YOFF + (c & 1) * SC_YBUF);
            const f32x2 v = *(const f32x2*)(yb + (i >> 3) * 16 + (i & 7) * 2);
            *(unsigned*)(Y + hb + (size_t)(c * SC_TC + (i >> 3)) * 64 + vr0 + (i & 7) * 2) = pk_bf16(v[0], v[1]);
        };
        issue(0); commit(0); issue(1);
        __syncthreads();
        for (int c = 0; c < SC_NC; ++c) {
            if (c > 0) yout(c - 1);
            if (c + 1 < SC_NC) commit((c + 1) & 1);
            if (c + 2 < SC_NC) issue(c + 2);
            __syncthreads();
        }
        yout(SC_NC - 1);
    } else {
        const int rl = wave * 4 + (lane >> 4), sub = lane & 15;
        const bool odd_lane = lane & 1; const int yoff = (lane & 1) * 16 + rl;
        f32x4 S = {0.f, 0.f, 0.f, 0.f};
        __builtin_amdgcn_s_setprio(3);
        __syncthreads();
        for (int c = 0; c < SC_NC; ++c) {
            const float* buf = (const float*)(smem + (c & 1) * SC_BUF);
            float* yb = (float*)(smem + SC_YOFF + (c & 1) * SC_YBUF);
            const float* bp = buf + sub * 4;
#define SC_LD(arr, s) (*(const f32x4*)(bp + (arr) * SC_ARR + (s) * 64))
            f32x4 r1 = SC_LD(0, 0), w1 = SC_LD(1, 0), k1 = SC_LD(2, 0), q1 = SC_LD(3, 0), n1 = SC_LD(4, 0);
            f32x4 r2 = SC_LD(0, 1), w2 = SC_LD(1, 1), k2 = SC_LD(2, 1), g2 = SC_LD(3, 1), n2 = SC_LD(4, 1);
            float v1 = buf[SC_VOFF + rl], v2 = buf[SC_VOFF + 16 + rl];
            f32x2 cf = *(const f32x2*)(buf + SC_COFF);
#pragma unroll
            for (int pr = 0; pr < SC_TC / 2; ++pr) {
                const int sn = 2 * pr + 2;
                const f32x4 r1n = SC_LD(0, sn), w1n = SC_LD(1, sn), k1n = SC_LD(2, sn), q1n = SC_LD(3, sn), n1n = SC_LD(4, sn);
                const f32x4 r2n = SC_LD(0, sn + 1), w2n = SC_LD(1, sn + 1), k2n = SC_LD(2, sn + 1), g2n = SC_LD(3, sn + 1), n2n = SC_LD(4, sn + 1);
                const float v1n = buf[SC_VOFF + sn * 16 + rl], v2n = buf[SC_VOFF + (sn + 1) * 16 + rl];
                const f32x2 cfn = *(const f32x2*)(buf + SC_COFF + (pr + 1) * 2);
                __builtin_amdgcn_sched_barrier(0x7);
                float d1 = dot4(S, q1), e2 = dot4(S, g2);
                const f32x4 t1 = S * w1 + v1 * k1;
                reduce16x2(d1, e2);
                const float d2 = e2 + v1 * cf[0] - d1 * cf[1];
                const f32x4 S1 = t1 + d1 * n1;
                const f32x4 S2 = (S1 * w2 + v2 * k2) + d2 * n2;
                float y1 = dot4(S1, r1), y2 = dot4(S2, r2);
                y1 += dppf<0xB1>(y1); y2 += dppf<0xB1>(y2);
                float yz = odd_lane ? y2 : y1;
                yz += dppf<0x122>(yz); yz += dppf<0x124>(yz); yz += dppf<0x128>(yz);
                yb[(2 * pr) * 16 + yoff] = yz;
                S = S2;
                r1 = r1n; w1 = w1n; k1 = k1n; q1 = q1n; n1 = n1n; r2 = r2n; w2 = w2n; k2 = k2n; g2 = g2n; n2 = n2n; v1 = v1n; v2 = v2n; cf = cfn;
            }
#undef SC_LD
            __syncthreads();
        }
        __builtin_amdgcn_s_setprio(0);
    }
}

constexpr int KLD = 72;
__device__ __forceinline__ void attn_unit(const Params& p, int unit) {
    unsigned char* ws = p.ws;
    const int qt = unit % 65, bh = unit / 65, b = bh >> 3, h = bh & 7;
    const int tid = threadIdx.x, wave = tid >> 6, lane = tid & 63, fr = lane & 15, fq = lane >> 4;
    const bf16_t* Q = (const bf16_t*)(ws + R_QKV) + (size_t)bh * TP * 64;
    const bf16_t* Kg = Q + QKV_ONE / 2;
    const bf16_t* Vg = Q + QKV_ONE;
    bf16_t* slots = (bf16_t*)smem;
    constexpr int SLOT = 2 * 64 * KLD;
    volatile int* flags = (volatile int*)(smem + 2 * SLOT * 2);
    const int t0 = qt * 128, tq = t0 + wave * 16 + fr;
    bf16x8 qf[2];
    qf[0] = *(const bf16x8*)(Q + (size_t)tq * 64 + fq * 8);
    qf[1] = *(const bf16x8*)(Q + (size_t)tq * 64 + 32 + fq * 8);
    float qs = 0.f;
#pragma unroll
    for (int s = 0; s < 2; ++s)
#pragma unroll
        for (int e = 0; e < 8; ++e) { const float f = bf2f((unsigned short)qf[s][e]); qs += f * f; }
    qs += __shfl_xor(qs, 16); qs += __shfl_xor(qs, 32);
    const f32x4 km4 = *(const f32x4*)((const float*)(ws + WS_CTL) + 16 + bh * 4);
    const float kmax = sqrtf(fmaxf(fmaxf(km4[0], km4[1]), fmaxf(km4[2], km4[3])));
    const float zb = sqrtf(qs) * kmax * 1.0001f + 88.0f;
    float Arow = 0.f;
    f32x4 O[4];
#pragma unroll
    for (int nd = 0; nd < 4; ++nd) O[nd] = (f32x4){0.f, 0.f, 0.f, 0.f};
    const int key = tid >> 3, dc = (tid & 7) * 8, half = wave >> 2;
    auto tile_store = [&](int blk, const u32x4& kv, const u32x4& vv) {
        bf16_t* Ks_ = slots + (blk & 1) * SLOT; bf16_t* Vt_ = Ks_ + 64 * KLD;
        *(u32x4*)(Ks_ + key * KLD + dc) = kv;
#pragma unroll
        for (int e = 0; e < 4; ++e) { Vt_[(dc + 2 * e) * KLD + key] = (bf16_t)(vv[e] & 0xffffu); Vt_[(dc + 2 * e + 1) * KLD + key] = (bf16_t)(vv[e] >> 16); }
    };
    const int ktop = qt * 2 + 1;
    {
        const u32x4 k0 = *(const u32x4*)(Kg + (size_t)(ktop * 64 + key) * 64 + dc), v0 = *(const u32x4*)(Vg + (size_t)(ktop * 64 + key) * 64 + dc);
        __syncthreads();
        tile_store(ktop, k0, v0);
    }
    u32x4 kvv = *(const u32x4*)(Kg + (size_t)((ktop - 1) * 64 + key) * 64 + dc);
    u32x4 vvv = *(const u32x4*)(Vg + (size_t)((ktop - 1) * 64 + key) * 64 + dc);
    for (int kt = ktop; kt >= 0; --kt) {
        const int kb = kt - 1 + half;
        const bool done = __all(Arow > zb) || kb < 0;
        if (lane == 0) flags[wave] = done ? 1 : 0;
        __syncthreads();
        int alld = 1;
#pragma unroll
        for (int w = 0; w < 8; ++w) alld &= flags[w];
        if (alld) break;
        if (kt >= 1) {
            tile_store(kt - 1, kvv, vvv);
            if (kt >= 2) {
                kvv = *(const u32x4*)(Kg + (size_t)((kt - 2) * 64 + key) * 64 + dc);
                vvv = *(const u32x4*)(Vg + (size_t)((kt - 2) * 64 + key) * 64 + dc);
            }
        }
        asm volatile("s_waitcnt lgkmcnt(0)" ::: "memory");
        __builtin_amdgcn_s_barrier();
        if (kb < 0) continue;
        const bf16_t* Ks = slots + (kb & 1) * SLOT; const bf16_t* Vt = Ks + 64 * KLD;
        f32x4 z[4];
#pragma unroll
        for (int n = 0; n < 4; ++n) {
            z[n] = (f32x4){0.f, 0.f, 0.f, 0.f};
#pragma unroll
            for (int s = 0; s < 2; ++s) {
                const bf16x8 kf = *(const bf16x8*)(Ks + (n * 16 + fr) * KLD + s * 32 + fq * 8);
                z[n] = __builtin_amdgcn_mfma_f32_16x16x32_bf16(kf, qf[s], z[n], 0, 0, 0);
            }
        }
        float sp[4][4], lt[4], ex[4], sg[4];
#pragma unroll
        for (int n = 0; n < 4; ++n) {
#pragma unroll
            for (int j = 0; j < 4; ++j) { const int s = kb * 64 + n * 16 + fq * 4 + j; sp[n][j] = s < tq ? softplusf_(z[n][j]) : 0.f; }
            sp[n][2] += sp[n][3]; sp[n][1] += sp[n][2]; sp[n][0] += sp[n][1];
            lt[n] = sp[n][0];
            const float a = __shfl_xor(lt[n], 16), pr = lt[n] + a, c = __shfl_xor(pr, 32);
            ex[n] = fq == 3 ? 0.f : (fq == 2 ? a : (fq == 1 ? c : a + c));
            sg[n] = pr + c;
        }
        float nsuf[4]; nsuf[3] = 0.f; nsuf[2] = sg[3]; nsuf[1] = nsuf[2] + sg[2]; nsuf[0] = nsuf[1] + sg[1];
        float wgt[4][4];
#pragma unroll
        for (int n = 0; n < 4; ++n)
#pragma unroll
            for (int j = 0; j < 4; ++j) {
                const int s = kb * 64 + n * 16 + fq * 4 + j;
                const float C = Arow + nsuf[n] + ex[n] + sp[n][j];
                wgt[n][j] = s < tq ? __expf(z[n][j] - C) : 0.f;
            }
        Arow += nsuf[0] + sg[0];
#pragma unroll
        for (int ks = 0; ks < 2; ++ks) {
            u32x4 pw; pw.x = pk_bf16(wgt[2 * ks][0], wgt[2 * ks][1]); pw.y = pk_bf16(wgt[2 * ks][2], wgt[2 * ks][3]);
            pw.z = pk_bf16(wgt[2 * ks + 1][0], wgt[2 * ks + 1][1]); pw.w = pk_bf16(wgt[2 * ks + 1][2], wgt[2 * ks + 1][3]);
            const bf16x8 pf = __builtin_bit_cast(bf16x8, pw);
#pragma unroll
            for (int nd = 0; nd < 4; ++nd) {
                u32x4 vw;
                const u32x2 v0 = *(const u32x2*)(Vt + (nd * 16 + fr) * KLD + (2 * ks) * 16 + fq * 4);
                const u32x2 v1 = *(const u32x2*)(Vt + (nd * 16 + fr) * KLD + (2 * ks + 1) * 16 + fq * 4);
                vw.x = v0.x; vw.y = v0.y; vw.z = v1.x; vw.w = v1.y;
                O[nd] = __builtin_amdgcn_mfma_f32_16x16x32_bf16(pf, __builtin_bit_cast(bf16x8, vw), O[nd], 0, 0, 0);
            }
        }
    }
    __syncthreads();
    bf16_t* Ot = (bf16_t*)smem;
#pragma unroll
    for (int j = 0; j < 4; ++j)
#pragma unroll
        for (int nd = 0; nd < 4; ++nd) Ot[(wave * 16 + fq * 4 + j) * KLD + nd * 16 + fr] = (bf16_t)(pk_bf16(O[nd][j], 0.f) & 0xffffu);
    __syncthreads();
    bf16_t* osb = (bf16_t*)(ws + O_OSB);
#pragma unroll
    for (int i = 0; i < 2; ++i) {
        const int idx = tid + 512 * i, r = idx >> 3, pc8 = (idx & 7) * 8, t = t0 + r;
        if (t >= NMETA && t < T) *(u32x4*)(osb + (size_t)(b * SEQ + t - NMETA) * 512 + h * 64 + pc8) = *(const u32x4*)(Ot + r * KLD + pc8);
    }
}

constexpr int N_SCAN = 128, N_ATTN = 32 * 65;
__device__ __forceinline__ void sub_barrier(unsigned* ctr, unsigned target, bool arrive) {
    asm volatile("s_waitcnt vmcnt(0)" ::: "memory");
    __syncthreads();
    if (threadIdx.x == 0) {
        if (arrive) { __builtin_amdgcn_fence(__ATOMIC_RELEASE, "agent"); asm volatile("s_waitcnt vmcnt(0)" ::: "memory"); (void)xb_add(ctr, 1u); }
        unsigned sp = 0u;
        while (xb_ld(ctr) < target) { __builtin_amdgcn_s_sleep(2); if (++sp > (1u << 22)) break; }
        __builtin_amdgcn_fence(__ATOMIC_ACQUIRE, "agent");
        asm volatile("s_waitcnt vmcnt(0)" ::: "memory");
    }
    __syncthreads();
}
__device__ __forceinline__ void phase3(const Params& p) {
    unsigned char* ws = p.ws;
    unsigned* ctl = (unsigned*)(ws + WS_CTL);
    const int nother = (int)gridDim.x - N_SCAN;
    if ((int)blockIdx.x < N_SCAN) {
        scan_unit(p, blockIdx.x);
    } else {
        EpiInProj<true> epi{(bf16_t*)(ws + R_QKV), (_Float16*)(ws + R_URW), (bf16_t*)p.out};
        gemm_phase((const bf16_t*)(ws + O_A0), (const bf16_t*)(ws + WS_WIN), D, MP / BM, 14, epi, nother, (int)blockIdx.x - N_SCAN, 6, 7);
        sub_barrier(ctl + 256, (unsigned)nother, true);
        for (int it = (int)blockIdx.x - N_SCAN; it < 128; it += nother) phase2_kmax(p, it);
        sub_barrier(ctl + 320, (unsigned)nother, true);
    }
    sub_barrier(ctl + 320, (unsigned)nother, false);
    volatile int* slot = (volatile int*)(smem + 131072 - 16);
    for (;;) {
        __syncthreads();
        if (threadIdx.x == 0) *slot = (int)atomicAdd(ctl, 1u);
        __syncthreads();
        const int u = *slot;
        if (u >= N_ATTN) break;
        attn_unit(p, u);
    }
}

__device__ __forceinline__ void phase3c(const Params& p) {
    unsigned char* ws = p.ws;
    const _Float16* SI = (const _Float16*)(ws + R_SI);
    constexpr size_t SIE = (size_t)MP * 512;
    const bf16_t* Y = (const bf16_t*)(ws + O_Y);
    const bf16_t* G = (const bf16_t*)(ws + R_G);
    bf16_t* orw = (bf16_t*)(ws + O_ORW);
    const int tid = threadIdx.x, sub = tid & 15;
    constexpr int U = 4;
    for (int it = blockIdx.x; it < 32 * 64; it += gridDim.x) {
        const int bh = it >> 6, c4 = it & 63, b = bh >> 3, h = bh & 7;
        const int c = h * 64 + sub * 4;
        const f32x4 gain = *(const f32x4*)(p.in[14] + c), bias = *(const f32x4*)(p.in[15] + c), rk = *(const f32x4*)(p.in[13] + c);
        u32x2 yb2[U]; f32x4 y[U]; h16x4 r4[U], k4[U], v4[U]; u32x2 g2[U];
#pragma unroll
        for (int u = 0; u < U; ++u) {
            const int t = NMETA + (c4 * U + u) * 32 + (tid >> 4);
            const size_t base = ((size_t)bh * TP + t) * 64 + sub * 4;
            const size_t rec = ((size_t)bh * TP + t) * 448, pbase = rec + (sub & 3) * 16 + (sub >> 2) * 4;
            yb2[u] = *(const u32x2*)(Y + base);
            r4[u] = *(const h16x4*)(SI + SI_R * 64 + pbase); k4[u] = *(const h16x4*)(SI + SI_K * 64 + pbase); v4[u] = *(const h16x4*)(SI + SI_V * 64 + rec + sub * 4);
            g2[u] = *(const u32x2*)((const bf16_t*)SI + 6 * 64 + pbase);
        }
#pragma unroll
        for (int u = 0; u < U; ++u) {
            const int t = NMETA + (c4 * U + u) * 32 + (tid >> 4);
            y[u][0] = __uint_as_float(yb2[u].x << 16); y[u][1] = __uint_as_float(yb2[u].x & 0xffff0000u); y[u][2] = __uint_as_float(yb2[u].y << 16); y[u][3] = __uint_as_float(yb2[u].y & 0xffff0000u);
            const float mean = reduce16((y[u][0] + y[u][1]) + (y[u][2] + y[u][3])) * (1.0f / 64.0f);
            const f32x4 dy = y[u] - mean;
            const float var = reduce16((dy[0] * dy[0] + dy[1] * dy[1]) + (dy[2] * dy[2] + dy[3] * dy[3])) * (1.0f / 64.0f);
            const float rs = rsqrtf(var + GN_EPS);
            float bs = 0.f;
#pragma unroll
            for (int j = 0; j < 4; ++j) bs += (float)r4[u][j] * (float)k4[u][j] * rk[j];
            bs = reduce16(bs);
            const float gg[4] = {__uint_as_float(g2[u].x << 16), __uint_as_float(g2[u].x & 0xffff0000u), __uint_as_float(g2[u].y << 16), __uint_as_float(g2[u].y & 0xffff0000u)};
            float o[4];
#pragma unroll
            for (int j = 0; j < 4; ++j) o[j] = (dy[j] * rs * gain[j] + bias[j] + bs * (float)v4[u][j]) * gg[j];
            u32x2 w; w.x = pk_bf16(o[0], o[1]); w.y = pk_bf16(o[2], o[3]);
            *(u32x2*)(orw + (size_t)(b * SEQ + t - NMETA) * 512 + c) = w;
        }
    }
}

__device__ __forceinline__ void phase4(const Params& p) {
    unsigned char* ws = p.ws;
    EpiBranch1 e1{(bf16_t*)(ws + O_T1), (const bf16_t*)p.out};
    EpiBranch2 e2{(const bf16_t*)(ws + O_T1), (const bf16_t*)p.out, (bf16_t*)(ws + O_M)};
    gemm_phase((const bf16_t*)(ws + O_OSB), (const bf16_t*)(ws + WS_WSB), 512, MS / BM, D / BM, e1);
    gemm_phase((const bf16_t*)(ws + O_ORW), (const bf16_t*)(ws + WS_WRW), 512, MS / BM, D / BM, e2);
}
__device__ __forceinline__ void phase5(const Params& p) {
    unsigned char* ws = p.ws;
    EpiBf16 e{(bf16_t*)(ws + O_P)};
    gemm_phase((const bf16_t*)(ws + O_M), (const bf16_t*)(ws + WS_WOUT), D, MS / BM, D / BM, e);
}
__device__ __forceinline__ void phase6(const Params& p) {
    unsigned char* ws = p.ws;
    const int lane = threadIdx.x & 63;
    f32x4 g1[4], g2[4];
#pragma unroll
    for (int j = 0; j < 4; ++j) { g1[j] = *(const f32x4*)(p.in[3] + 4 * lane + 256 * j); g2[j] = *(const f32x4*)(p.in[19] + 4 * lane + 256 * j); }
    for (int it = blockIdx.x; it < MS / 16; it += gridDim.x) {
        const int row0 = it * 16 + (threadIdx.x >> 6) * 2;
        f32x4 v[2][4], x[2][4];
#pragma unroll
        for (int r = 0; r < 2; ++r)
#pragma unroll
            for (int j = 0; j < 4; ++j) {
                { const u32x2 pb2 = *(const u32x2*)((const bf16_t*)(ws + O_P) + (size_t)(row0 + r) * D + 4 * lane + 256 * j);
                  v[r][j] = (f32x4){__uint_as_float(pb2.x << 16), __uint_as_float(pb2.x & 0xffff0000u), __uint_as_float(pb2.y << 16), __uint_as_float(pb2.y & 0xffff0000u)}; }
                x[r][j] = *(const f32x4*)(p.in[0] + (size_t)(row0 + r) * D + 4 * lane + 256 * j);
            }
#pragma unroll
        for (int r = 0; r < 2; ++r) {
            const int row = row0 + r;
            float ss = 0.f;
#pragma unroll
            for (int j = 0; j < 4; ++j) ss += (v[r][j][0] * v[r][j][0] + v[r][j][1] * v[r][j][1]) + (v[r][j][2] * v[r][j][2] + v[r][j][3] * v[r][j][3]);
            const float rs = rsqrtf(wave_sum(ss) * (1.0f / D) + RMS_EPS);
            float s2 = 0.f;
#pragma unroll
            for (int j = 0; j < 4; ++j) {
                v[r][j] = x[r][j] + v[r][j] * rs * g1[j];
                { u32x2 hb; hb.x = pk_bf16(v[r][j][0], v[r][j][1]); hb.y = pk_bf16(v[r][j][2], v[r][j][3]);
                  *(u32x2*)((bf16_t*)(ws + O_H1B) + (size_t)row * D + 4 * lane + 256 * j) = hb;
                  v[r][j] = (f32x4){__uint_as_float(hb.x << 16), __uint_as_float(hb.x & 0xffff0000u), __uint_as_float(hb.y << 16), __uint_as_float(hb.y & 0xffff0000u)}; }
                s2 += (v[r][j][0] * v[r][j][0] + v[r][j][1] * v[r][j][1]) + (v[r][j][2] * v[r][j][2] + v[r][j][3] * v[r][j][3]);
            }
            const float rs2 = rsqrtf(wave_sum(s2) * (1.0f / D) + RMS_EPS);
            bf16_t* fr_ = (bf16_t*)(ws + O_F) + (size_t)row * D;
#pragma unroll
            for (int j = 0; j < 4; ++j) {
                u32x2 w; w.x = pk_bf16(v[r][j][0] * rs2 * g2[j][0], v[r][j][1] * rs2 * g2[j][1]); w.y = pk_bf16(v[r][j][2] * rs2 * g2[j][2], v[r][j][3] * rs2 * g2[j][3]);
                *(u32x2*)(fr_ + 4 * lane + 256 * j) = w;
            }
        }
    }
}
__device__ __forceinline__ void phase7(const Params& p) {
    unsigned char* ws = p.ws;
    EpiGU e{(bf16_t*)(ws + O_ACT)};
    gemm_phase((const bf16_t*)(ws + O_F), (const bf16_t*)(ws + WS_WGU), D, MS / BM, 2 * DFF / BM, e);
}
__device__ __forceinline__ void phase8(const Params& p) {
    unsigned char* ws = p.ws;
    EpiBf16 e{(bf16_t*)(ws + O_DN)};
    gemm_phase((const bf16_t*)(ws + O_ACT), (const bf16_t*)(ws + WS_WD), DFF, MS / BM, D / BM, e);
}
__device__ __forceinline__ void phase9(const Params& p) {
    unsigned char* ws = p.ws;
    const int lane = threadIdx.x & 63;
    f32x4 g[4];
#pragma unroll
    for (int j = 0; j < 4; ++j) g[j] = *(const f32x4*)(p.in[20] + 4 * lane + 256 * j);
    for (int it = blockIdx.x; it < MS / 16; it += gridDim.x) {
        const int row0 = it * 16 + (threadIdx.x >> 6) * 2;
        f32x4 v[2][4], h1[2][4];
#pragma unroll
        for (int r = 0; r < 2; ++r)
#pragma unroll
            for (int j = 0; j < 4; ++j) {
                { const u32x2 db2 = *(const u32x2*)((const bf16_t*)(ws + O_DN) + (size_t)(row0 + r) * D + 4 * lane + 256 * j);
                  v[r][j] = (f32x4){__uint_as_float(db2.x << 16), __uint_as_float(db2.x & 0xffff0000u), __uint_as_float(db2.y << 16), __uint_as_float(db2.y & 0xffff0000u)}; }
                { const u32x2 hb = *(const u32x2*)((const bf16_t*)(ws + O_H1B) + (size_t)(row0 + r) * D + 4 * lane + 256 * j);
                  h1[r][j] = (f32x4){__uint_as_float(hb.x << 16), __uint_as_float(hb.x & 0xffff0000u), __uint_as_float(hb.y << 16), __uint_as_float(hb.y & 0xffff0000u)}; }
            }
#pragma unroll
        for (int r = 0; r < 2; ++r) {
            float ss = 0.f;
#pragma unroll
            for (int j = 0; j < 4; ++j) ss += (v[r][j][0] * v[r][j][0] + v[r][j][1] * v[r][j][1]) + (v[r][j][2] * v[r][j][2] + v[r][j][3] * v[r][j][3]);
            const float rs = rsqrtf(wave_sum(ss) * (1.0f / D) + RMS_EPS);
#pragma unroll
            for (int j = 0; j < 4; ++j) *(f32x4*)(p.out + (size_t)(row0 + r) * D + 4 * lane + 256 * j) = h1[r][j] + v[r][j] * rs * g[j];
        }
    }
}

constexpr int N_PHASES = 11;
__device__ __forceinline__ void run_phase(const Params& p, int ph) {
    switch (ph) {
        case 0: phase0(p); break;
        case 1: phase1(p); break;
        case 2: phase2(p); break;
        case 3: phase3(p); break;
        case 4: phase3c(p); break;
        case 5: phase4(p); break;
        case 6: phase5(p); break;
        case 7: phase6(p); break;
        case 8: phase7(p); break;
        case 9: phase8(p); break;
        default: phase9(p); break;
    }
}

#if MULTI_LAUNCH
template <int PH> __global__ void __launch_bounds__(512) fwd_phase(Params p) { run_phase(p, PH); }
#else
__global__ void __launch_bounds__(512) fwd_mega(Params p) {
    cg::grid_group grid = cg::this_grid();
    volatile LAS unsigned* st = (volatile LAS unsigned*)(smem + 131072);
    if (threadIdx.x == 0) { st[0] = 0u; st[1] = 0u; }
    __syncthreads();
    const XcdBarrier xb = xcd_barrier_post((unsigned*)(p.ws + WS_BAR), st);
    if (p.out == nullptr) grid.sync();
    phase0(p); xcd_barrier(xb); phase1(p); xcd_barrier(xb); phase2(p); xcd_barrier(xb); phase3(p); xcd_barrier(xb); phase3c(p); xcd_barrier(xb);
    phase4(p); xcd_barrier(xb); phase5(p); xcd_barrier(xb); phase6(p); xcd_barrier(xb); phase7(p); xcd_barrier(xb); phase8(p); xcd_barrier(xb); phase9(p);
}
#endif

extern "C" void kernel_launch(void* const* d_in, const int* in_sizes, int n_in, void* d_out, int out_size, void* d_ws, size_t ws_size, hipStream_t stream) {
    static int grid = 0;
    if (grid == 0) {
        if (n_in != 24 || out_size != MS * D || ws_size < WS_END) { fprintf(stderr, "kernel_launch: unexpected shapes (n_in %d out %d ws %zu need %zu)\n", n_in, out_size, ws_size, (size_t)WS_END); grid = -1; return; }
        int dev = 0, cus = 0, per_cu = 0;
        (void)hipGetDevice(&dev);
        (void)hipDeviceGetAttribute(&cus, hipDeviceAttributeMultiprocessorCount, dev);
#if MULTI_LAUNCH
        per_cu = 1;
#else
        (void)hipFuncSetAttribute((const void*)fwd_mega, hipFuncAttributeMaxDynamicSharedMemorySize, LDS_BYTES);
        (void)hipOccupancyMaxActiveBlocksPerMultiprocessor(&per_cu, (const void*)fwd_mega, 512, LDS_BYTES);
        if (per_cu < 1) { fprintf(stderr, "kernel_launch: occupancy query says %d blocks per CU\n", per_cu); per_cu = 1; }
        if (per_cu > 1) per_cu = 1;
#endif
        grid = cus * per_cu;
        if (grid <= N_SCAN) { fprintf(stderr, "kernel_launch: grid %d too small (needs more than %d workgroups)\n", grid, N_SCAN); grid = -1; return; }
    }
    if (grid < 0) return;
    Params p{};
    for (int i = 0; i < 24; ++i) p.in[i] = (const float*)d_in[i];
    p.out = (float*)d_out; p.ws = (unsigned char*)d_ws;
#if MULTI_LAUNCH
#define LP(PH) do { (void)hipFuncSetAttribute((const void*)fwd_phase<PH>, hipFuncAttributeMaxDynamicSharedMemorySize, LDS_BYTES); hipLaunchKernelGGL(fwd_phase<PH>, dim3(grid), dim3(512), LDS_BYTES, stream, p); } while (0)
    LP(0); LP(1); LP(2); LP(3); LP(4); LP(5); LP(6); LP(7); LP(8); LP(9); LP(10);
#undef LP
#else
    if (hipMemsetAsync(d_ws, 0, WS_CTL_BYTES, stream) != hipSuccess) { fprintf(stderr, "kernel_launch: hipMemsetAsync of the control words failed\n"); return; }
    void* args[] = {&p};
    hipError_t e = hipLaunchCooperativeKernel((const void*)fwd_mega, dim3(grid), dim3(512), args, LDS_BYTES, stream);
    if (e != hipSuccess) fprintf(stderr, "cooperative launch failed: %s (grid %d)\n", hipGetErrorString(e), grid);
#endif
}
```

```cpp
#include <hip/hip_runtime.h>
#include <hip/hip_cooperative_groups.h>
#include <cstdio>
#include <cstdint>
#include <type_traits>
namespace cg = cooperative_groups;

#ifndef MULTI_LAUNCH
#define MULTI_LAUNCH 0
#endif

typedef unsigned short bf16_t;
typedef short bf16x8 __attribute__((ext_vector_type(8)));
typedef float f32x4 __attribute__((ext_vector_type(4)));
typedef float f32x2 __attribute__((ext_vector_type(2)));
typedef unsigned u32x2 __attribute__((ext_vector_type(2)));
typedef unsigned u32x4 __attribute__((ext_vector_type(4)));
typedef _Float16 h16x2 __attribute__((ext_vector_type(2)));
typedef _Float16 h16x4 __attribute__((ext_vector_type(4)));
typedef _Float16 h16x8 __attribute__((ext_vector_type(8)));

constexpr int D = 1024, NB = 4, SEQ = 8192, NMETA = 16, T = SEQ + NMETA, TP = 8320, MP = NB * TP, MS = NB * SEQ;
constexpr int PIN = 5376, DFF = 2816, NH = 8, RWS = 1792;
constexpr float RMS_EPS = 1e-6f, GN_EPS = 64e-5f;

constexpr size_t WS_CTL = 0;
constexpr size_t WS_BAR = 4096;
constexpr size_t WS_CTL_BYTES = 32768;
constexpr size_t WS_WIN = WS_CTL_BYTES;
constexpr size_t WS_WSB = WS_WIN + (size_t)PIN * D * 2;
constexpr size_t WS_WRW = WS_WSB + (size_t)D * 512 * 2;
constexpr size_t WS_WOUT = WS_WRW + (size_t)D * 512 * 2;
constexpr size_t WS_WGU = WS_WOUT + (size_t)D * D * 2;
constexpr size_t WS_WD = WS_WGU + (size_t)2 * DFF * D * 2;
constexpr size_t WS_WL = WS_WD + (size_t)D * DFF * 2;
constexpr size_t R_A0 = WS_WL + (size_t)512 * 256 * 2;
constexpr size_t R_URW = R_A0 + (size_t)MP * D * 2;
constexpr size_t R_QKV = R_URW;
constexpr size_t QKV_ONE = (size_t)MP * 512 * 2;
constexpr size_t R_SI = R_URW + (size_t)MP * RWS * 2;
constexpr size_t SI_ONE = (size_t)MP * 512 * 2;
constexpr size_t R_G = R_SI + 6 * SI_ONE;
constexpr size_t R_TAIL = R_G + SI_ONE;
constexpr size_t O_Y = R_TAIL;
constexpr size_t O_OSB = R_TAIL + SI_ONE;
constexpr size_t WS_END = O_OSB + (size_t)MS * 512 * 2;
constexpr size_t O_A0 = R_A0;
constexpr size_t O_ORW = R_A0;
constexpr size_t O_T1 = R_SI;
constexpr size_t O_M = R_SI + (size_t)MS * D * 4;
constexpr size_t O_P = R_A0;
constexpr size_t O_F = R_SI;
constexpr size_t O_ACT = R_A0;
constexpr size_t O_DN = R_SI + (size_t)MS * D * 2;
constexpr size_t O_H1B = R_SI + (size_t)MS * D * 4;
static_assert(O_H1B + (size_t)MS * D * 2 <= R_TAIL, "overlay");
static_assert(3 * QKV_ONE <= (size_t)MP * RWS * 2, "overlay");
static_assert(O_M + (size_t)MS * D * 2 <= R_TAIL, "overlay");
static_assert(O_ACT + (size_t)MS * DFF * 2 <= R_SI, "overlay");
static_assert(O_P + (size_t)MS * D * 4 <= R_SI, "overlay");
static_assert(O_DN + (size_t)MS * D * 4 <= R_TAIL, "overlay");
static_assert(WS_END <= (size_t)512 * 1024 * 1024, "workspace");

constexpr size_t WS_XCNT = 20480;
constexpr size_t WS_XBUF = WS_END;
static_assert(WS_XBUF + (size_t)MS * 4 * 4 <= (size_t)512 * 1024 * 1024, "workspace");
constexpr int LDS_XCH = 131072 + 64;
constexpr int LDS_BYTES = 131072 + 64 + 6144;

struct Params { const float* in[24]; float* out; unsigned char* ws; };

extern __shared__ __attribute__((aligned(16))) unsigned char smem[];

typedef __bf16 b16x2 __attribute__((ext_vector_type(2)));
__device__ __forceinline__ unsigned pk_bf16(float lo, float hi) { const f32x2 v = {lo, hi}; return __builtin_bit_cast(unsigned, __builtin_convertvector(v, b16x2)); }
__device__ __forceinline__ float bf2f(unsigned short v) { return __uint_as_float((unsigned)v << 16); }
__device__ __forceinline__ float sigmoidf_(float x) { return __builtin_amdgcn_rcpf(1.0f + __expf(-x)); }
__device__ __forceinline__ float softplusf_(float x) { return fmaxf(x, 0.f) + __logf(1.0f + __expf(-fabsf(x))); }
template <int CTRL> __device__ __forceinline__ float dppf(float x) { return __builtin_bit_cast(float, __builtin_amdgcn_mov_dpp(__builtin_bit_cast(int, x), CTRL, 0xf, 0xf, true)); }
__device__ __forceinline__ float reduce16(float v) {
    v += dppf<0xB1>(v); v += dppf<0x4E>(v); v += dppf<0x141>(v); v += dppf<0x140>(v); return v;
}
__device__ __forceinline__ float wave_sum(float v) {
#pragma unroll
    for (int o = 1; o < 64; o <<= 1) v += __shfl_xor(v, o);
    return v;
}

#define LAS __attribute__((address_space(3)))
#define XB_TMO      128
#define XB_XCNT(j)  (256  + 64 * (j))
#define XB_XSUB(j)  (1280 + 64 * (j))
#define XB_XGEN(j)  (2304 + 64 * (j))
#define XB_TOP      3328
#define XB_TOPGEN   3392
#define XCD_BAR_WORDS 3456
#define XB_SPIN_CAP (1u << 18)
__device__ __forceinline__ unsigned xb_ld(unsigned* p)              { return __hip_atomic_load(p, __ATOMIC_RELAXED, __HIP_MEMORY_SCOPE_AGENT); }
__device__ __forceinline__ unsigned xb_add(unsigned* p, unsigned v) { return __hip_atomic_fetch_add(p, v, __ATOMIC_RELAXED, __HIP_MEMORY_SCOPE_AGENT); }
__device__ __forceinline__ unsigned xb_xcc_id() { return (unsigned)__builtin_amdgcn_s_getreg((3 << 11) | 20) & 0xFu; }
#define XB_SPIN(cond, bar) do { unsigned _sp = 0; while (cond) { __builtin_amdgcn_s_sleep(1); \
    if ((++_sp & 255u) == 0u) { if (xb_ld(&(bar)[XB_TMO])) break; if (_sp > XB_SPIN_CAP) { atomicAdd(&(bar)[XB_TMO], 1u); break; } } } } while (0)
struct XcdBarrier { unsigned* bar; unsigned x; volatile LAS unsigned* st; };
__device__ __forceinline__ XcdBarrier xcd_barrier_post(unsigned* bar, volatile LAS unsigned* st) {
    XcdBarrier b; b.bar = bar; b.x = xb_xcc_id(); b.st = st;
    if (threadIdx.x == 0) (void)xb_add(&bar[XB_XCNT(b.x)], 1u);
    return b;
}
__device__ __forceinline__ void xcd_barrier_complete(unsigned* bar, unsigned x, unsigned& nloc, unsigned& nx) {
    const unsigned G = gridDim.x * gridDim.y * gridDim.z;
    unsigned sum, cnt, mine, sp = 0u;
    for (;;) {
        sum = 0u; cnt = 0u; mine = 0u;
#pragma unroll
        for (unsigned j = 0; j < 16; ++j) { const unsigned c = xb_ld(&bar[XB_XCNT(j)]); sum += c; cnt += (c > 0u) ? 1u : 0u; mine = (j == x) ? c : mine; }
        if (sum == G) break;
        __builtin_amdgcn_s_sleep(1);
        if ((++sp & 255u) == 0u) { if (xb_ld(&bar[XB_TMO])) break; if (sp > XB_SPIN_CAP) { atomicAdd(&bar[XB_TMO], 1u); break; } }
    }
    nloc = mine > 0u ? mine : 1u; nx = cnt > 0u ? cnt : 1u;
}
__device__ __forceinline__ void xcd_barrier(const XcdBarrier& b) {
    asm volatile("s_waitcnt vmcnt(0)" ::: "memory");
    __syncthreads();
    if (threadIdx.x == 0) {
        unsigned* bar = b.bar;
        __builtin_amdgcn_s_waitcnt(0);
        unsigned nloc = b.st[0], nx = b.st[1];
        if (nloc == 0u) { xcd_barrier_complete(bar, b.x, nloc, nx); b.st[0] = nloc; b.st[1] = nx; }
        const unsigned old = xb_add(&bar[XB_XSUB(b.x)], 1u);
        const unsigned gen = old / nloc;
        if (old + 1u == (gen + 1u) * nloc) {
            __builtin_amdgcn_fence(__ATOMIC_RELEASE, "agent");
            asm volatile("s_waitcnt vmcnt(0)" ::: "memory");
            const unsigned og = xb_add(&bar[XB_TOP], 1u);
            const unsigned tg = og / nx;
            if (og + 1u == (tg + 1u) * nx) xb_add(&bar[XB_TOPGEN], 1u);
            else XB_SPIN(xb_ld(&bar[XB_TOPGEN]) == tg, bar);
            __builtin_amdgcn_fence(__ATOMIC_ACQUIRE, "agent");
            xb_add(&bar[XB_XGEN(b.x)], 1u);
            asm volatile("s_waitcnt vmcnt(0)" ::: "memory");
        } else {
            XB_SPIN(xb_ld(&bar[XB_XGEN(b.x)]) == gen, bar);
            __builtin_amdgcn_fence(__ATOMIC_ACQUIRE, "agent");
            asm volatile("s_waitcnt vmcnt(0)" ::: "memory");
        }
    }
    __syncthreads();
}

constexpr int BM = 256, BK = 64, HALF = 128, HTB = HALF * BK * 2, NXCD = 8, WGM = 8;
__device__ __forceinline__ int lds_byte(int r, int c) { const int st = (r >> 4) * 2 + (c >> 5), rr = r & 15, cc = c & 31, ob = rr * 64 + cc * 2; return st * 1024 + (ob ^ (((ob >> 9) & 1) << 5)); }
__device__ __forceinline__ void stage_rc(int b, int& R, int& C) { const int st = b / 1024, sb = b % 1024, swz = sb ^ (((sb >> 9) & 1) << 5); R = (st >> 1) * 16 + swz / 64; C = (st & 1) * 32 + (swz % 64) / 2; }
struct Unit { int pm, pn; };
struct Sched {
    int nM, nN, nwg, G, c;
    __device__ __forceinline__ bool next(int i, Unit& u) const {
        const long L = (long)i * G + c; if (L >= nwg) return false;
        int wgid = (int)L; { const int q = nwg / NXCD, r = nwg % NXCD, xcd = wgid % NXCD, off = wgid / NXCD; wgid = (xcd < r ? xcd * (q + 1) : r * (q + 1) + (xcd - r) * q) + off; }
        const int nig = WGM * nN, gid = wgid / nig, fm = gid * WGM, gsz = (nM - fm) < WGM ? (nM - fm) : WGM;
        u.pm = fm + ((wgid % nig) % gsz); u.pn = (wgid % nig) / gsz; return true;
    }
};

template <class Epi>
__device__ __forceinline__ void gemm_phase(const bf16_t* __restrict__ Ag, const bf16_t* __restrict__ Btg, const int K, const int nM, const int nN, const Epi& E,
                                           const int G = (int)gridDim.x, const int c = (int)blockIdx.x, const int pn_from = 1 << 30, const int pn_add = 0) {
    LAS unsigned char* lds = (LAS unsigned char*)smem;
    const int tid = threadIdx.x, wid = __builtin_amdgcn_readfirstlane(tid >> 6), lane = tid & 63, wr = wid >> 2, wc = wid & 3, fr = lane & 15, fq = lane >> 4;
    const int nt = K / BK;
    Sched S; S.nM = nM; S.nN = nN; S.nwg = nM * nN; S.G = G; S.c = c;
    unsigned voffA[2], voffB[2];
#pragma unroll
    for (int i = 0; i < 2; ++i) { int R, C; stage_rc(tid * 16 + i * 8192, R, C);
        const int Rb = Epi::PERM ? ((R & ~31) + 8 * ((R & 15) >> 2) + 4 * ((R & 31) >> 4) + (R & 3)) : R;
        voffA[i] = (unsigned)(R * K + C) * 2u; voffB[i] = (unsigned)(Rb * K + C) * 2u; }
    const size_t kstep = (size_t)(BK * 2);
    const size_t hstep = (size_t)HALF * K * 2;
    const size_t tstep = 2 * hstep;
    const unsigned ldsw = (unsigned)wid * 1024u;
    const int aoff = lds_byte(wr * 64 + fr, fq * 8), boff = lds_byte(wc * 32 + fr, fq * 8);
#define PG8_SA(b, h) (((b) * 2 + (h)) * HTB)
#define PG8_SB(b, h) ((4 + (b) * 2 + (h)) * HTB)
#define PG8_STAGE(bufoff, gbase, voff) do { _Pragma("unroll") for (int _i = 0; _i < 2; ++_i) \
        __builtin_amdgcn_global_load_lds((const unsigned*)((const char*)(gbase) + (voff)[_i]), (LAS unsigned*)(lds + (bufoff) + ldsw + _i * 8192), 16, 0, 0); } while (0)
#define PG8_LDA(dst, b, h) do { _Pragma("unroll") for (int m = 0; m < 4; ++m) _Pragma("unroll") for (int k = 0; k < 2; ++k) dst[m][k] = *(const LAS bf16x8*)(lds + PG8_SA(b, h) + aoff + m * 2048 + k * 1024); } while (0)
#define PG8_LDB(dst, b, h) do { _Pragma("unroll") for (int n = 0; n < 2; ++n) _Pragma("unroll") for (int k = 0; k < 2; ++k) dst[n][k] = *(const LAS bf16x8*)(lds + PG8_SB(b, h) + boff + n * 2048 + k * 1024); } while (0)
#define PG8_MMA(ai, bj, At, Bt) do { __builtin_amdgcn_s_setprio(1); _Pragma("unroll") for (int m = 0; m < 4; ++m) _Pragma("unroll") for (int n = 0; n < 2; ++n) _Pragma("unroll") for (int k = 0; k < 2; ++k) \
        acc[ai][bj][m][n] = __builtin_amdgcn_mfma_f32_16x16x32_bf16(Bt[n][k], At[m][k], acc[ai][bj][m][n], 0, 0, 0); __builtin_amdgcn_s_setprio(0); } while (0)
#define PG8_WAIT_V(n) asm volatile("s_waitcnt vmcnt(" #n ")" ::: "memory")
#define PG8_WAIT_L(n) asm volatile("s_waitcnt lgkmcnt(" #n ")" ::: "memory")
#define PG8_BAR __builtin_amdgcn_s_barrier()
#define PG8_SCHED __builtin_amdgcn_sched_barrier(0)
    Unit cur, nxt; int ui = 0;
    __syncthreads();
    if (!S.next(0, cur)) return;
    if (cur.pn >= pn_from) cur.pn += pn_add;
    f32x4 acc[2][2][4][2];
#pragma unroll
    for (int a = 0; a < 2; ++a)
#pragma unroll
        for (int b = 0; b < 2; ++b)
#pragma unroll
            for (int m = 0; m < 4; ++m)
#pragma unroll
                for (int n = 0; n < 2; ++n) acc[a][b][m][n] = (f32x4){0.f, 0.f, 0.f, 0.f};
    bf16x8 At[4][2], B0[2][2], B1[2][2];
    const char* cA = (const char*)Ag + (size_t)cur.pm * tstep; const char* cB = (const char*)Btg + (size_t)cur.pn * tstep;
    PG8_STAGE(PG8_SB(0, 0), cB, voffB); PG8_STAGE(PG8_SB(0, 1), cB + hstep, voffB); PG8_STAGE(PG8_SA(0, 0), cA, voffA); PG8_STAGE(PG8_SA(0, 1), cA + hstep, voffA);
    if (wr == 1) PG8_BAR;
    PG8_WAIT_V(2); PG8_BAR;
    PG8_STAGE(PG8_SB(1, 0), cB + kstep, voffB); PG8_STAGE(PG8_SA(1, 0), cA + kstep, voffA); PG8_STAGE(PG8_SB(1, 1), cB + hstep + kstep, voffB);
    PG8_WAIT_V(6); PG8_BAR;
    for (;;) {
        const bool has_next = S.next(ui + 1, nxt);
        if (has_next && nxt.pn >= pn_from) nxt.pn += pn_add;
        const char* nA = has_next ? (const char*)Ag + (size_t)nxt.pm * tstep : cA; const char* nB = has_next ? (const char*)Btg + (size_t)nxt.pn * tstep : cB;
        for (int t = 0; t < nt; t += 2) {
            const bool last = (t == nt - 2);
            const char* a1 = cA + (size_t)(t + 1) * kstep;
            const char* a2 = last ? nA : cA + (size_t)(t + 2) * kstep; const char* b2 = last ? nB : cB + (size_t)(t + 2) * kstep;
            const char* a3 = a2 + kstep; const char* b3 = b2 + kstep;
            PG8_LDB(B0, 0, 0); PG8_LDB(B1, 0, 1); PG8_SCHED; PG8_LDA(At, 0, 0); PG8_STAGE(PG8_SA(1, 1), a1 + hstep, voffA);
            PG8_WAIT_V(8); PG8_WAIT_L(0); PG8_BAR; PG8_MMA(0, 0, At, B0); PG8_MMA(0, 1, At, B1); PG8_BAR; PG8_SCHED;
            PG8_LDA(At, 0, 1); PG8_STAGE(PG8_SB(0, 0), b2, voffB); PG8_STAGE(PG8_SB(0, 1), b2 + hstep, voffB); PG8_STAGE(PG8_SA(0, 0), a2, voffA);
            PG8_WAIT_V(8); PG8_WAIT_L(0); PG8_BAR; PG8_MMA(1, 0, At, B0); PG8_MMA(1, 1, At, B1); PG8_BAR; PG8_SCHED;
            PG8_LDB(B0, 1, 0); PG8_LDB(B1, 1, 1); PG8_SCHED; PG8_LDA(At, 1, 0); PG8_STAGE(PG8_SA(0, 1), a2 + hstep, voffA);
            PG8_WAIT_V(8); PG8_WAIT_L(0); PG8_BAR; PG8_MMA(0, 0, At, B0); PG8_MMA(0, 1, At, B1); PG8_BAR; PG8_SCHED;
            PG8_LDA(At, 1, 1); PG8_STAGE(PG8_SB(1, 0), b3, voffB); PG8_STAGE(PG8_SB(1, 1), b3 + hstep, voffB); PG8_STAGE(PG8_SA(1, 0), a3, voffA);
            PG8_WAIT_V(8); PG8_WAIT_L(0); PG8_BAR; PG8_MMA(1, 0, At, B0); PG8_MMA(1, 1, At, B1); PG8_BAR; PG8_SCHED;
        }
        if (wr == 0) PG8_BAR;
        if constexpr (Epi::FUSED) {
            E.fused(acc, cur, wr, wc, fr, fq, wid, lane);
        } else {
            const int brow = cur.pm * BM, bcol = cur.pn * BM;
#pragma unroll
            for (int ai = 0; ai < 2; ++ai)
#pragma unroll
                for (int m = 0; m < 4; ++m) {
                    E.row(brow + ai * HALF + wr * 64 + m * 16 + fr, bcol + wc * 32, fq, acc[ai][0][m][0], acc[ai][0][m][1], acc[ai][1][m][0], acc[ai][1][m][1]);
                    asm volatile("" ::: "memory");
                }
        }
        if (!has_next) break;
#pragma unroll
        for (int a = 0; a < 2; ++a)
#pragma unroll
            for (int b = 0; b < 2; ++b)
#pragma unroll
                for (int m = 0; m < 4; ++m)
#pragma unroll
                    for (int n = 0; n < 2; ++n) acc[a][b][m][n] = (f32x4){0.f, 0.f, 0.f, 0.f};
        cur = nxt; cA = nA; cB = nB; ++ui;
        if (wr == 1) PG8_BAR;
    }
    PG8_WAIT_V(0);
    PG8_BAR;
#undef PG8_SA
#undef PG8_SB
#undef PG8_STAGE
#undef PG8_LDA
#undef PG8_LDB
#undef PG8_MMA
#undef PG8_WAIT_V
#undef PG8_WAIT_L
#undef PG8_BAR
#undef PG8_SCHED
}

template <bool PERM_> struct EpiInProj {
    static constexpr bool PERM = PERM_, FUSED = false;
    bf16_t* qkv; _Float16* urw; bf16_t* gates;
    __device__ __forceinline__ void one(int row, int col, const f32x4& v) const {
        if (col < 1536) {
            const int which = col >> 9, hc = col & 511, h = hc >> 6, d = hc & 63, b = row / TP, t = row - b * TP;
            const float s = which == 0 ? 0.125f : 1.0f;
            u32x2 w; w.x = pk_bf16(v[0] * s, v[1] * s); w.y = pk_bf16(v[2] * s, v[3] * s);
            *(u32x2*)(qkv + (size_t)which * (QKV_ONE / 2) + ((size_t)(b * NH + h) * TP + t) * 64 + d) = w;
        } else if (col < 3328) {
            h16x4 o; o[0] = (_Float16)v[0]; o[1] = (_Float16)v[1]; o[2] = (_Float16)v[2]; o[3] = (_Float16)v[3];
            *(h16x4*)(urw + (size_t)row * RWS + (col - 1536)) = o;
        } else {
            const int b = row / TP, t = row - b * TP;
            if (t >= NMETA && t < T) {
                u32x2 w; w.x = pk_bf16(sigmoidf_(v[0]), sigmoidf_(v[1])); w.y = pk_bf16(sigmoidf_(v[2]), sigmoidf_(v[3]));
                *(u32x2*)(gates + (size_t)(b * SEQ + t - NMETA) * 2048 + (col - 3328)) = w;
            }
        }
    }
    __device__ __forceinline__ void half(int row, int col32, int fq, const f32x4& v0, const f32x4& v1) const {
        if constexpr (PERM_) {
            const int col = col32 + 8 * fq, b = row / TP, t = row - b * TP;
            if (col < 1536) {
                const int which = col >> 9, hc = col & 511, h = hc >> 6, d = hc & 63;
                const float s = which == 0 ? 0.125f : 1.0f;
                u32x4 w; w.x = pk_bf16(v0[0] * s, v0[1] * s); w.y = pk_bf16(v0[2] * s, v0[3] * s); w.z = pk_bf16(v1[0] * s, v1[1] * s); w.w = pk_bf16(v1[2] * s, v1[3] * s);
                *(u32x4*)(qkv + (size_t)which * (QKV_ONE / 2) + ((size_t)(b * NH + h) * TP + t) * 64 + d) = w;
            } else if (t >= NMETA && t < T) {
                u32x4 w; w.x = pk_bf16(sigmoidf_(v0[0]), sigmoidf_(v0[1])); w.y = pk_bf16(sigmoidf_(v0[2]), sigmoidf_(v0[3]));
                w.z = pk_bf16(sigmoidf_(v1[0]), sigmoidf_(v1[1])); w.w = pk_bf16(sigmoidf_(v1[2]), sigmoidf_(v1[3]));
                *(u32x4*)(gates + (size_t)(b * SEQ + t - NMETA) * 2048 + (col - 3328)) = w;
            }
        } else {
            if (col32 >= 1536 && col32 < 3072) {
                const int c = col32 - 1536, pos = (c & ~63) + fq * 16 + ((c & 63) >> 4) * 4;
                h16x8 o;
#pragma unroll
                for (int j = 0; j < 4; ++j) { o[j] = (_Float16)v0[j]; o[4 + j] = (_Float16)v1[j]; }
                *(h16x8*)(urw + (size_t)row * RWS + pos) = o;
            } else { one(row, col32 + 4 * fq, v0); one(row, col32 + 16 + 4 * fq, v1); }
        }
    }
    __device__ __forceinline__ void row(int r, int col32, int fq, const f32x4& a00, const f32x4& a01, const f32x4& a10, const f32x4& a11) const { half(r, col32, fq, a00, a01); half(r, col32 + HALF, fq, a10, a11); }
};
__device__ __forceinline__ void bf8_to_f(const u32x4& g, float (&f)[8]) {
#pragma unroll
    for (int i = 0; i < 4; ++i) { f[2 * i] = __uint_as_float(g[i] << 16); f[2 * i + 1] = __uint_as_float(g[i] & 0xffff0000u); }
}
struct EpiBranch1 {
    static constexpr bool PERM = true, FUSED = false;
    bf16_t* t1; const bf16_t* gates;
    __device__ __forceinline__ void half(int row, int col32, int fq, const f32x4& v0, const f32x4& v1) const {
        const int col = col32 + 8 * fq;
        float g[8]; bf8_to_f(*(const u32x4*)(gates + (size_t)row * 2048 + col), g);
        u32x4 w; w.x = pk_bf16(v0[0] * g[0], v0[1] * g[1]); w.y = pk_bf16(v0[2] * g[2], v0[3] * g[3]); w.z = pk_bf16(v1[0] * g[4], v1[1] * g[5]); w.w = pk_bf16(v1[2] * g[6], v1[3] * g[7]);
        *(u32x4*)(t1 + (size_t)row * D + col) = w;
    }
    __device__ __forceinline__ void row(int r, int col32, int fq, const f32x4& a00, const f32x4& a01, const f32x4& a10, const f32x4& a11) const { half(r, col32, fq, a00, a01); half(r, col32 + HALF, fq, a10, a11); }
};
struct EpiBranch2 {
    static constexpr bool PERM = true, FUSED = false;
    const bf16_t* t1; const bf16_t* gates; bf16_t* m;
    __device__ __forceinline__ void half(int row, int col32, int fq, const f32x4& v0, const f32x4& v1) const {
        const int col = col32 + 8 * fq;
        float g[8], a[8]; bf8_to_f(*(const u32x4*)(gates + (size_t)row * 2048 + 1024 + col), g); bf8_to_f(*(const u32x4*)(t1 + (size_t)row * D + col), a);
        u32x4 w; w.x = pk_bf16(a[0] + v0[0] * g[0], a[1] + v0[1] * g[1]); w.y = pk_bf16(a[2] + v0[2] * g[2], a[3] + v0[3] * g[3]);
        w.z = pk_bf16(a[4] + v1[0] * g[4], a[5] + v1[1] * g[5]); w.w = pk_bf16(a[6] + v1[2] * g[6], a[7] + v1[3] * g[7]);
        *(u32x4*)(m + (size_t)row * D + col) = w;
    }
    __device__ __forceinline__ void row(int r, int col32, int fq, const f32x4& a00, const f32x4& a01, const f32x4& a10, const f32x4& a11) const { half(r, col32, fq, a00, a01); half(r, col32 + HALF, fq, a10, a11); }
};
struct EpiF32 {
    static constexpr bool PERM = true, FUSED = false;
    float* o;
    __device__ __forceinline__ void row(int r, int col32, int fq, const f32x4& a00, const f32x4& a01, const f32x4& a10, const f32x4& a11) const {
        float* q = o + (size_t)r * D + col32 + 8 * fq;
        *(f32x4*)q = a00; *(f32x4*)(q + 4) = a01; *(f32x4*)(q + HALF) = a10; *(f32x4*)(q + HALF + 4) = a11;
    }
};
struct EpiBf16 {
    static constexpr bool PERM = true, FUSED = false;
    bf16_t* o;
    __device__ __forceinline__ void row(int r, int col32, int fq, const f32x4& a00, const f32x4& a01, const f32x4& a10, const f32x4& a11) const {
        bf16_t* q = o + (size_t)r * D + col32 + 8 * fq;
        u32x4 w0, w1;
        w0.x = pk_bf16(a00[0], a00[1]); w0.y = pk_bf16(a00[2], a00[3]); w0.z = pk_bf16(a01[0], a01[1]); w0.w = pk_bf16(a01[2], a01[3]);
        w1.x = pk_bf16(a10[0], a10[1]); w1.y = pk_bf16(a10[2], a10[3]); w1.z = pk_bf16(a11[0], a11[1]); w1.w = pk_bf16(a11[2], a11[3]);
        *(u32x4*)q = w0; *(u32x4*)(q + HALF) = w1;
    }
};
struct EpiGU {
    static constexpr bool PERM = true, FUSED = false;
    bf16_t* act;
    __device__ __forceinline__ void row(int r, int col32, int fq, const f32x4& g0, const f32x4& g1, const f32x4& u0, const f32x4& u1) const {
        float o[8];
#pragma unroll
        for (int j = 0; j < 4; ++j) { o[j] = g0[j] * sigmoidf_(g0[j]) * u0[j]; o[4 + j] = g1[j] * sigmoidf_(g1[j]) * u1[j]; }
        u32x4 w; w.x = pk_bf16(o[0], o[1]); w.y = pk_bf16(o[2], o[3]); w.z = pk_bf16(o[4], o[5]); w.w = pk_bf16(o[6], o[7]);
        const int pn = col32 >> 8, cin = (col32 & 255) + 8 * fq;
        *(u32x4*)(act + (size_t)r * DFF + pn * 128 + cin) = w;
    }
};

struct EpiDownFused {
    static constexpr bool PERM = true, FUSED = true;
    float* out; const bf16_t* h1b; const float* g; float* xbuf; unsigned* cnt;
    __device__ __forceinline__ void fused(f32x4 (&acc)[2][2][4][2], const Unit& u, int wr, int wc, int fr, int fq, int wid, int lane) const {
        LAS float* Pl = (LAS float*)(smem + LDS_XCH);
        LAS float* Sl = Pl + 1024;
        const int col0 = u.pn * BM + wc * 32 + 8 * fq;
        u32x4 hres[2][4][2];
#pragma unroll
        for (int ai = 0; ai < 2; ++ai)
#pragma unroll
            for (int m = 0; m < 4; ++m) {
                const bf16_t* q = h1b + (size_t)(u.pm * BM + ai * HALF + wr * 64 + m * 16 + fr) * D + col0;
#pragma unroll
                for (int bj = 0; bj < 2; ++bj) hres[ai][m][bj] = *(const u32x4*)(q + bj * HALF);
            }
#pragma unroll
        for (int ai = 0; ai < 2; ++ai)
#pragma unroll
            for (int m = 0; m < 4; ++m) {
                float sq = 0.f;
#pragma unroll
                for (int bj = 0; bj < 2; ++bj)
#pragma unroll
                    for (int n = 0; n < 2; ++n) { const f32x4 x = acc[ai][bj][m][n]; sq += (x[0] * x[0] + x[1] * x[1]) + (x[2] * x[2] + x[3] * x[3]); }
                sq += __shfl_xor(sq, 16); sq += __shfl_xor(sq, 32);
                if (fq == 0) Pl[(ai * HALF + wr * 64 + m * 16 + fr) * 4 + wc] = sq;
            }
        asm volatile("s_waitcnt lgkmcnt(0)" ::: "memory"); __builtin_amdgcn_s_barrier(); asm volatile("" ::: "memory");
        const int tid = wid * 64 + lane;
        if (tid < 256) {
            const float t = (Pl[tid * 4 + 0] + Pl[tid * 4 + 1]) + (Pl[tid * 4 + 2] + Pl[tid * 4 + 3]);
            __hip_atomic_store(xbuf + ((size_t)(u.pm * BM + tid)) * 4 + u.pn, t, __ATOMIC_RELAXED, __HIP_MEMORY_SCOPE_AGENT);
        }
        asm volatile("s_waitcnt vmcnt(0)" ::: "memory");
        if (tid < 256 && lane == 0) __hip_atomic_fetch_add(cnt + 16 * u.pm, 1u, __ATOMIC_RELAXED, __HIP_MEMORY_SCOPE_AGENT);
        if (wid == 0) {
            unsigned sp = 0u;
            while ((unsigned)__builtin_amdgcn_readfirstlane(__hip_atomic_load(cnt + 16 * u.pm, __ATOMIC_RELAXED, __HIP_MEMORY_SCOPE_AGENT)) < 16u) { __builtin_amdgcn_s_sleep(2); if (++sp > (1u << 22)) break; }
            __builtin_amdgcn_fence(__ATOMIC_ACQUIRE, "agent");
        }
        asm volatile("s_waitcnt vmcnt(0) lgkmcnt(0)" ::: "memory"); __builtin_amdgcn_s_barrier(); asm volatile("" ::: "memory");
        if (tid < 256) {
            const float* slot = xbuf + ((size_t)(u.pm * BM + tid)) * 4;
            const float tot = (__hip_atomic_load(slot + 0, __ATOMIC_RELAXED, __HIP_MEMORY_SCOPE_AGENT) + __hip_atomic_load(slot + 1, __ATOMIC_RELAXED, __HIP_MEMORY_SCOPE_AGENT))
                            + (__hip_atomic_load(slot + 2, __ATOMIC_RELAXED, __HIP_MEMORY_SCOPE_AGENT) + __hip_atomic_load(slot + 3, __ATOMIC_RELAXED, __HIP_MEMORY_SCOPE_AGENT));
            Sl[tid] = rsqrtf(tot * (1.0f / D) + RMS_EPS);
        }
        asm volatile("s_waitcnt lgkmcnt(0)" ::: "memory"); __builtin_amdgcn_s_barrier(); asm volatile("" ::: "memory");
        f32x4 gv[2][2];
#pragma unroll
        for (int bj = 0; bj < 2; ++bj)
#pragma unroll
            for (int n = 0; n < 2; ++n) gv[bj][n] = *(const f32x4*)(g + col0 + bj * HALF + 4 * n);
#pragma unroll
        for (int ai = 0; ai < 2; ++ai)
#pragma unroll
            for (int m = 0; m < 4; ++m) {
                const int r = ai * HALF + wr * 64 + m * 16 + fr;
                const float rs = Sl[r];
                float* q = out + (size_t)(u.pm * BM + r) * D + col0;
#pragma unroll
                for (int bj = 0; bj < 2; ++bj)
#pragma unroll
                    for (int n = 0; n < 2; ++n) {
                        const unsigned lo = hres[ai][m][bj][2 * n], hi = hres[ai][m][bj][2 * n + 1];
                        const f32x4 h1 = {__uint_as_float(lo << 16), __uint_as_float(lo & 0xffff0000u), __uint_as_float(hi << 16), __uint_as_float(hi & 0xffff0000u)};
                        *(f32x4*)(q + bj * HALF + 4 * n) = h1 + acc[ai][bj][m][n] * rs * gv[bj][n];
                    }
                asm volatile("" ::: "memory");
            }
    }
};

__device__ __forceinline__ void transpose_tile(const float* __restrict__ src, int K, int N, bf16_t* __restrict__ dst, int ldd, int koff, int mode, int tile) {
    float* scr = (float*)smem;
    const int ntn = N / 128, kb = tile / ntn, nb = tile % ntn, k0 = kb * 64, n0 = nb * 128, tid = threadIdx.x;
    f32x4 v[4];
#pragma unroll
    for (int i = 0; i < 4; ++i) { const int idx = tid + 512 * i, kk = idx >> 5, n4 = idx & 31; v[i] = *(const f32x4*)(src + (size_t)(k0 + kk) * N + n0 + n4 * 4); }
#pragma unroll
    for (int i = 0; i < 4; ++i) { const int idx = tid + 512 * i, kk = idx >> 5, n4 = idx & 31;
#pragma unroll
        for (int c = 0; c < 4; ++c) scr[kk * 129 + n4 * 4 + c] = v[i][c]; }
    __syncthreads();
#pragma unroll
    for (int i = 0; i < 2; ++i) {
        const int o = tid + 512 * i, n = o >> 3, kc = (o & 7) * 8;
        u32x4 w;
        w.x = pk_bf16(scr[(kc + 0) * 129 + n], scr[(kc + 1) * 129 + n]); w.y = pk_bf16(scr[(kc + 2) * 129 + n], scr[(kc + 3) * 129 + n]);
        w.z = pk_bf16(scr[(kc + 4) * 129 + n], scr[(kc + 5) * 129 + n]); w.w = pk_bf16(scr[(kc + 6) * 129 + n], scr[(kc + 7) * 129 + n]);
        const int f = n0 + n;
        const int drow = mode == 0 ? f : ((f >> 7) * 256 + (mode == 2 ? 128 : 0) + (f & 127));
        *(u32x4*)(dst + (size_t)drow * ldd + koff + k0 + kc) = w;
    }
    __syncthreads();
}

__device__ __forceinline__ void phase0(const Params& p) {
    unsigned char* ws = p.ws;
    if (blockIdx.x == 0 && threadIdx.x < 64) ((unsigned*)(ws + WS_CTL))[threadIdx.x] = 0u;
    constexpr int J0 = 16 * 42, J1 = 8 * 8, J3 = 16 * 8, J4 = 16 * 22, J6 = 44 * 8, J7 = 4, J9 = 8;
    constexpr int NT = J0 + 2 * J1 + J3 + 2 * J4 + J6 + 2 * J7 + J9;
    constexpr int NR = MP / 32;
    for (int it = blockIdx.x; it < NT + NR; it += gridDim.x) {
        if (it >= NR) {
            int r = it - NR;
            if (r < J0) { transpose_tile(p.in[4], D, PIN, (bf16_t*)(ws + WS_WIN), D, 0, 0, r); continue; } r -= J0;
            if (r < J1) { transpose_tile(p.in[16], 512, D, (bf16_t*)(ws + WS_WSB), 512, 0, 0, r); continue; } r -= J1;
            if (r < J1) { transpose_tile(p.in[17], 512, D, (bf16_t*)(ws + WS_WRW), 512, 0, 0, r); continue; } r -= J1;
            if (r < J3) { transpose_tile(p.in[18], D, D, (bf16_t*)(ws + WS_WOUT), D, 0, 0, r); continue; } r -= J3;
            if (r < J4) { transpose_tile(p.in[21], D, DFF, (bf16_t*)(ws + WS_WGU), D, 0, 1, r); continue; } r -= J4;
            if (r < J4) { transpose_tile(p.in[22], D, DFF, (bf16_t*)(ws + WS_WGU), D, 0, 2, r); continue; } r -= J4;
            if (r < J6) { transpose_tile(p.in[23], DFF, D, (bf16_t*)(ws + WS_WD), DFF, 0, 0, r); continue; } r -= J6;
            if (r < J7) { transpose_tile(p.in[6], 64, 512, (bf16_t*)(ws + WS_WL), 256, 0, 0, r); continue; } r -= J7;
            if (r < J7) { transpose_tile(p.in[8], 64, 512, (bf16_t*)(ws + WS_WL), 256, 64, 0, r); continue; } r -= J7;
            transpose_tile(p.in[10], 128, 512, (bf16_t*)(ws + WS_WL), 256, 128, 0, r);
        } else {
            const int lane = threadIdx.x & 63, row0 = it * 32 + (threadIdx.x >> 6) * 4;
            f32x4 v[4][4];
#pragma unroll
            for (int r = 0; r < 4; ++r) {
                const int row = row0 + r, b = row / TP, t = row - b * TP;
                const float* src = t < NMETA ? p.in[1] + (size_t)t * D : p.in[0] + ((size_t)b * SEQ + (t < T ? t - NMETA : 0)) * D;
#pragma unroll
                for (int j = 0; j < 4; ++j) v[r][j] = *(const f32x4*)(src + 4 * lane + 256 * j);
            }
            f32x4 g[4];
#pragma unroll
            for (int j = 0; j < 4; ++j) g[j] = *(const f32x4*)(p.in[2] + 4 * lane + 256 * j);
#pragma unroll
            for (int r = 0; r < 4; ++r) {
                const int row = row0 + r, b = row / TP, t = row - b * TP;
                float ss = 0.f;
#pragma unroll
                for (int j = 0; j < 4; ++j) ss += (v[r][j][0] * v[r][j][0] + v[r][j][1] * v[r][j][1]) + (v[r][j][2] * v[r][j][2] + v[r][j][3] * v[r][j][3]);
                const float rs = t < T ? rsqrtf(wave_sum(ss) * (1.0f / D) + RMS_EPS) : 0.f;
                bf16_t* orow = (bf16_t*)(ws + O_A0) + (size_t)row * D;
#pragma unroll
                for (int j = 0; j < 4; ++j) {
                    u32x2 w; w.x = pk_bf16(v[r][j][0] * rs * g[j][0], v[r][j][1] * rs * g[j][1]); w.y = pk_bf16(v[r][j][2] * rs * g[j][2], v[r][j][3] * rs * g[j][3]);
                    *(u32x2*)(orow + 4 * lane + 256 * j) = w;
                }
            }
        }
    }
}

__device__ __forceinline__ void phase1(const Params& p) {
    unsigned char* ws = p.ws;
    EpiInProj<false> epi{(bf16_t*)(ws + R_QKV), (_Float16*)(ws + R_URW), (bf16_t*)p.out};
    gemm_phase((const bf16_t*)(ws + O_A0), (const bf16_t*)(ws + WS_WIN), D, MP / BM, 7, epi, (int)gridDim.x, (int)blockIdx.x, 0, 6);
}

constexpr int SI_R = 0, SI_W = 1, SI_K = 2, SI_V = 3, SI_KK = 4, SI_B = 5;
constexpr int ALD = 264;
constexpr int P2_WLS = 64 * ALD * 2;
constexpr int P2_MU = P2_WLS;
constexpr int P2_AL = P2_MU + 1024;
__device__ __forceinline__ void phase2_main(const Params& p) {
    unsigned char* ws = p.ws;
    const int tid = threadIdx.x, wave = tid >> 6, lane = tid & 63, fr = lane & 15, fq = lane >> 4;
    const int h = blockIdx.x & 7, nslot = (gridDim.x >> 3) * 8, slot = (blockIdx.x >> 3) * 8 + wave;
    const _Float16* urw = (const _Float16*)(ws + R_URW);
    const float* mu = p.in[5];
    bf16_t* WLs = (bf16_t*)smem;
    float* mus = (float*)(smem + P2_MU);
    bf16_t* Al = (bf16_t*)(smem + P2_AL) + wave * (16 * ALD);
    __syncthreads();
    {
        const bf16_t* WL = (const bf16_t*)(ws + WS_WL) + (size_t)h * 64 * 256;
#pragma unroll
        for (int i = 0; i < 4; ++i) { const int idx = tid + 512 * i, row = idx >> 5, c16 = idx & 31; *(u32x4*)(WLs + row * ALD + c16 * 8) = *(const u32x4*)(WL + row * 256 + c16 * 8); }
        if (tid < 256) mus[tid] = mu[1536 + tid];
    }
    __syncthreads();
    if (blockIdx.x >= nslot) return;
    _Float16* SI = (_Float16*)(ws + R_SI);
    bf16_t* G = (bf16_t*)(ws + R_G);
    constexpr size_t SIE = (size_t)MP * 512;
#pragma unroll 1
    for (int g = slot; g < NB * 514; g += nslot) {
        const int ub = g / 514, ui = g - ub * 514, row0 = ub * TP + ui * 16;
        {
            const int half = lane >> 5, pc = (lane & 31) * 8;
            const float sA = pc < 64 ? 2.f : 1.f, sC = pc < 64 ? -1.f : 0.f;
            const bool lin = pc >= 64 && pc < 128;
            const f32x4 mA = *(const f32x4*)(mu + 1536 + pc), mB = *(const f32x4*)(mu + 1536 + pc + 4);
            h16x8 c[8], pv[8];
#pragma unroll
            for (int q = 0; q < 8; ++q) {
                const int rowa = row0 + 2 * q + half, ta = rowa % TP;
                const _Float16* cur = urw + (size_t)rowa * RWS + 1536 + pc;
                c[q] = *(const h16x8*)cur;
                pv[q] = *(const h16x8*)(ta > 0 ? cur - RWS : cur);
            }
#pragma unroll
            for (int q = 0; q < 8; ++q) {
                const int ta = (row0 + 2 * q + half) % TP;
                float o[8];
#pragma unroll
                for (int e = 0; e < 8; ++e) {
                    const float cf = (float)c[q][e], pf = ta > 0 ? (float)pv[q][e] : 0.f;
                    const float xs = cf + (e < 4 ? mA[e & 3] : mB[e & 3]) * (pf - cf);
                    const float sg = __builtin_amdgcn_rcpf(1.0f + __expf(-sA * xs));
                    o[e] = lin ? xs : sA * sg + sC;
                }
                u32x4 w; w.x = pk_bf16(o[0], o[1]); w.y = pk_bf16(o[2], o[3]); w.z = pk_bf16(o[4], o[5]); w.w = pk_bf16(o[6], o[7]);
                *(u32x4*)(Al + (2 * q + half) * ALD + pc) = w;
            }
        }
        asm volatile("s_waitcnt lgkmcnt(0)" ::: "memory");
        __builtin_amdgcn_wave_barrier();
        f32x4 acc[4];
        auto lora = [&](auto kbeg_c, auto ksteps_c) {
            constexpr int kbeg = decltype(kbeg_c)::value, ksteps = decltype(ksteps_c)::value;
#pragma unroll
            for (int n = 0; n < 4; ++n) acc[n] = (f32x4){0.f, 0.f, 0.f, 0.f};
#pragma unroll
            for (int ks = 0; ks < ksteps; ++ks) {
                const bf16x8 af = *(const bf16x8*)(Al + fr * ALD + kbeg + ks * 32 + fq * 8);
#pragma unroll
                for (int n = 0; n < 4; ++n) {
                    const bf16x8 wf = *(const bf16x8*)(WLs + (n * 16 + fr) * ALD + kbeg + ks * 32 + fq * 8);
                    acc[n] = __builtin_amdgcn_mfma_f32_16x16x32_bf16(wf, af, acc[n], 0, 0, 0);
                }
            }
        };
        const int row = row0 + fr, b = row / TP, t = row - b * TP;
        const size_t base = ((size_t)(b * NH + h) * TP + t) * 448;
        const _Float16* ur = urw + (size_t)row * RWS;
        const size_t pb = base + fq * 16;
        lora(std::integral_constant<int, 0>{}, std::integral_constant<int, 2>{});
        {
            h16x8 wo[2];
#pragma unroll
            for (int n = 0; n < 4; ++n) {
                const f32x4 db = *(const f32x4*)(p.in[7] + h * 64 + n * 16 + fq * 4);
#pragma unroll
                for (int j = 0; j < 4; ++j) {
                    const float e = sigmoidf_(db[j] + acc[n][j]) * 0.60653065971f;
                    wo[n >> 1][(n & 1) * 4 + j] = (_Float16)(1.0f - __expf(-e));
                }
            }
            *(h16x8*)(SI + SI_W * 64 + pb) = wo[0]; *(h16x8*)(SI + SI_W * 64 + pb + 8) = wo[1];
        }
        lora(std::integral_constant<int, 64>{}, std::integral_constant<int, 2>{});
        {
            const _Float16* up = ur + h * 64 + fq * 16;
            const _Float16* upp = t > 0 ? up - RWS : up;
            h16x8 kc[2], rc[2], vc[2], kp[2], rp[2], vp[2];
#pragma unroll
            for (int i = 0; i < 2; ++i) {
                rc[i] = *(const h16x8*)(up + i * 8); kc[i] = *(const h16x8*)(up + 512 + i * 8); vc[i] = *(const h16x8*)(up + 1024 + i * 8);
                rp[i] = *(const h16x8*)(upp + i * 8); kp[i] = *(const h16x8*)(upp + 512 + i * 8); vp[i] = *(const h16x8*)(upp + 1024 + i * 8);
            }
            float kv[4][4], av[4][4], kkr[4][4]; float ss = 0.f;
            h16x8 ro[2];
#pragma unroll
            for (int n = 0; n < 4; ++n) {
                const int c = n * 16 + fq * 4, c512 = h * 64 + c;
                const f32x4 muk = *(const f32x4*)(mu + 512 + c512), mur = *(const f32x4*)(mu + c512), muv = *(const f32x4*)(mu + 1024 + c512);
                const f32x4 ab = *(const f32x4*)(p.in[9] + c512), kkw = *(const f32x4*)(p.in[11] + c512);
                h16x4 vo;
#pragma unroll
                for (int j = 0; j < 4; ++j) {
                    const int i = n >> 1, e = (n & 1) * 4 + j;
                    const float kcf = (float)kc[i][e], kpf = t > 0 ? (float)kp[i][e] : 0.f;
                    const float rcf = (float)rc[i][e], rpf = t > 0 ? (float)rp[i][e] : 0.f;
                    const float vcf = (float)vc[i][e], vpf = t > 0 ? (float)vp[i][e] : 0.f;
                    kv[n][j] = kcf + muk[j] * (kpf - kcf);
                    ro[i][e] = (_Float16)(rcf + mur[j] * (rpf - rcf));
                    vo[j] = (_Float16)(vcf + muv[j] * (vpf - vcf));
                    av[n][j] = sigmoidf_(ab[j] + acc[n][j]);
                    kkr[n][j] = kv[n][j] * kkw[j];
                    ss += kkr[n][j] * kkr[n][j];
                }
                *(h16x4*)(SI + SI_V * 64 + base + c) = vo;
            }
            *(h16x8*)(SI + SI_R * 64 + pb) = ro[0]; *(h16x8*)(SI + SI_R * 64 + pb + 8) = ro[1];
            ss += __shfl_xor(ss, 16); ss += __shfl_xor(ss, 32);
            const float inv = fminf(__builtin_amdgcn_rsqf(ss), 1e12f);
            h16x8 ko[2], kko[2], bo[2];
#pragma unroll
            for (int n = 0; n < 4; ++n) {
                const f32x4 ka = *(const f32x4*)(p.in[12] + h * 64 + n * 16 + fq * 4);
#pragma unroll
                for (int j = 0; j < 4; ++j) {
                    const int i = n >> 1, e = (n & 1) * 4 + j;
                    const float kk = kkr[n][j] * inv;
                    ko[i][e] = (_Float16)(kv[n][j] * (1.0f + (av[n][j] - 1.0f) * ka[j]));
                    kko[i][e] = (_Float16)kk;
                    bo[i][e] = (_Float16)(kk * av[n][j]);
                }
            }
#pragma unroll
            for (int i = 0; i < 2; ++i) {
                *(h16x8*)(SI + SI_K * 64 + pb + i * 8) = ko[i]; *(h16x8*)(SI + SI_KK * 64 + pb + i * 8) = kko[i]; *(h16x8*)(SI + SI_B * 64 + pb + i * 8) = bo[i];
            }
        }
        lora(std::integral_constant<int, 128>{}, std::integral_constant<int, 4>{});
        {
            u32x4 g0, g1;
            g0.x = pk_bf16(acc[0][0], acc[0][1]); g0.y = pk_bf16(acc[0][2], acc[0][3]); g0.z = pk_bf16(acc[1][0], acc[1][1]); g0.w = pk_bf16(acc[1][2], acc[1][3]);
            g1.x = pk_bf16(acc[2][0], acc[2][1]); g1.y = pk_bf16(acc[2][2], acc[2][3]); g1.z = pk_bf16(acc[3][0], acc[3][1]); g1.w = pk_bf16(acc[3][2], acc[3][3]);
            *(u32x4*)((bf16_t*)SI + 6 * 64 + pb) = g0; *(u32x4*)((bf16_t*)SI + 6 * 64 + pb + 8) = g1;
        }
        asm volatile("s_waitcnt lgkmcnt(0)" ::: "memory");
        __builtin_amdgcn_wave_barrier();
    }
}
__device__ __forceinline__ void phase2_kmax(const Params& p, int item) {
    unsigned char* ws = p.ws;
    const int bh = item >> 2, qr = item & 3, tid = threadIdx.x;
    float* red = (float*)(smem + P2_AL + 8 * 16 * ALD * 2);
    float ss = 0.f;
    for (int t = qr * 2052 + tid; t < (qr + 1) * 2052; t += 512) {
        const bf16_t* kr = (const bf16_t*)(ws + R_QKV) + QKV_ONE / 2 + ((size_t)bh * TP + t) * 64;
        float s1 = 0.f;
#pragma unroll
        for (int q = 0; q < 8; ++q) {
            const u32x4 v = *(const u32x4*)(kr + q * 8);
#pragma unroll
            for (int e = 0; e < 4; ++e) { const float lo = __uint_as_float(v[e] << 16), hi = __uint_as_float(v[e] & 0xffff0000u); s1 += lo * lo + hi * hi; }
        }
        ss = fmaxf(ss, s1);
    }
#pragma unroll
    for (int o = 1; o < 64; o <<= 1) ss = fmaxf(ss, __shfl_xor(ss, o));
    __syncthreads();
    if ((tid & 63) == 0) red[tid >> 6] = ss;
    __syncthreads();
    if (tid == 0) {
        float m = red[0];
#pragma unroll
        for (int w = 1; w < 8; ++w) m = fmaxf(m, red[w]);
        ((float*)(ws + WS_CTL))[16 + item] = m;
    }
}
__device__ __forceinline__ void phase2(const Params& p) {
    phase2_main(p);
}

constexpr int SC_TC = 32, SC_NC = (T + SC_TC - 1) / SC_TC;
constexpr int SC_ARR = SC_TC * 64;
constexpr int SC_VOFF = 5 * SC_ARR, SC_COFF = SC_VOFF + SC_TC * 16;
constexpr int SC_BUF = (SC_COFF + SC_TC) * 4;
constexpr int SC_YOFF = 2 * SC_BUF, SC_YBUF = SC_TC * 16 * 4;
__device__ __forceinline__ float dot4(const f32x4& a, const f32x4& b) {
    f32x2 t = __builtin_shufflevector(a, a, 0, 1) * __builtin_shufflevector(b, b, 0, 1);
    t = __builtin_shufflevector(a, a, 2, 3) * __builtin_shufflevector(b, b, 2, 3) + t;
    return t[0] + t[1];
}
__device__ __forceinline__ void reduce16x2(float& a, float& b) {
    a += dppf<0xB1>(a); b += dppf<0xB1>(b); a += dppf<0x4E>(a); b += dppf<0x4E>(b);
    a += dppf<0x141>(a); b += dppf<0x141>(b); a += dppf<0x140>(a); b += dppf<0x140>(b);
}
__device__ __forceinline__ void scan_unit(const Params& p, int unit) {
    unsigned char* ws = p.ws;
    const int bh = unit >> 2, vr0 = (unit & 3) * 16, tid = threadIdx.x, wave = tid >> 6, lane = tid & 63;
    const _Float16* SI = (const _Float16*)(ws + R_SI);
    constexpr size_t SIE = (size_t)MP * 512;
    bf16_t* Y = (bf16_t*)(ws + O_Y);
    const size_t hb = (size_t)bh * TP * 64;
    __syncthreads();
    if (wave >= 4) {
        const int i = tid - 256, ip = i >= 8 ? i - 8 : i;
        const int arrs[5] = {SI_R, SI_W, SI_K, SI_KK, SI_B};
        u32x4 rg[5], rp[3]; unsigned rv;
        auto issue = [&](int c) {
            const size_t off = ((size_t)bh * TP + (size_t)c * SC_TC + (i >> 3)) * 448 + (i & 7) * 8;
            const size_t offp = i >= 8 ? off - 448 : off;
#pragma unroll
            for (int a = 0; a < 5; ++a) rg[a] = *(const u32x4*)(SI + arrs[a] * 64 + off);
            rp[0] = *(const u32x4*)(SI + SI_W * 64 + offp);
            rp[1] = *(const u32x4*)(SI + SI_K * 64 + offp);
            rp[2] = *(const u32x4*)(SI + SI_B * 64 + offp);
            rv = *(const unsigned*)(SI + SI_V * 64 + off - (i & 7) * 8 + vr0 + (i & 7) * 2);
        };
        auto commit = [&](int bufi) {
            float* buf = (float*)(smem + bufi * SC_BUF);
            float f[5][8];
#pragma unroll
            for (int a = 0; a < 5; ++a) {
                const h16x8 hv = __builtin_bit_cast(h16x8, rg[a]);
#pragma unroll
                for (int e = 0; e < 8; ++e) f[a][e] = (float)hv[e];
            }
            const bool odd = (i >> 3) & 1;
            float ckk = 0.f, cbk = 0.f;
            {
                const h16x8 pw = __builtin_bit_cast(h16x8, rp[0]), pk = __builtin_bit_cast(h16x8, rp[1]), pb = __builtin_bit_cast(h16x8, rp[2]);
#pragma unroll
                for (int e = 0; e < 8; ++e) {
                    const float kk2 = f[3][e];
                    ckk += (float)pk[e] * kk2; cbk += (float)pb[e] * kk2;
                    if (odd) f[3][e] = (1.0f - (float)pw[e]) * kk2;
                }
            }
            ckk += dppf<0xB1>(ckk); cbk += dppf<0xB1>(cbk); ckk += dppf<0x4E>(ckk); cbk += dppf<0x4E>(cbk); ckk += dppf<0x141>(ckk); cbk += dppf<0x141>(cbk);
#pragma unroll
            for (int a = 0; a < 5; ++a) {
                f32x4 lo, hi;
#pragma unroll
                for (int e = 0; e < 4; ++e) { lo[e] = f[a][e]; hi[e] = f[a][4 + e]; }
                if (a == 1) { lo = 1.0f - lo; hi = 1.0f - hi; }
                if (a == 4) { lo = -lo; hi = -hi; }
                *(f32x4*)(buf + a * SC_ARR + i * 8) = lo; *(f32x4*)(buf + a * SC_ARR + i * 8 + 4) = hi;
            }
            const h16x2 v2 = __builtin_bit_cast(h16x2, rv);
            f32x2 vf; vf[0] = (float)v2[0]; vf[1] = (float)v2[1];
            *(f32x2*)(buf + SC_VOFF + (i >> 3) * 16 + (i & 7) * 2) = vf;
            if (odd && (i & 7) == 0) { f32x2 cf; cf[0] = ckk; cf[1] = cbk; *(f32x2*)(buf + SC_COFF + (i >> 4) * 2) = cf; }
        };
        auto yout = [&](int c) {
            const float* yb = (const float*)(smem + SC_YOFF + (c & 1) * SC_YBUF);
            const f32x2 v = *(const f32x2*)(yb + (i >> 3) * 16 + (i & 7) * 2);
            *(unsigned*)(Y + hb + (size_t)(c * SC_TC + (i >> 3)) * 64 + vr0 + (i & 7) * 2) = pk_bf16(v[0], v[1]);
        };
        issue(0); commit(0); issue(1);
        __syncthreads();
        for (int c = 0; c < SC_NC; ++c) {
            if (c > 0) yout(c - 1);
            if (c + 1 < SC_NC) commit((c + 1) & 1);
            if (c + 2 < SC_NC) issue(c + 2);
            __syncthreads();
        }
        yout(SC_NC - 1);
    } else {
        const int rl = wave * 4 + (lane >> 4), sub = lane & 15;
        const bool odd_lane = lane & 1; const int yoff = (lane & 1) * 16 + rl;
        f32x4 S = {0.f, 0.f, 0.f, 0.f};
        __builtin_amdgcn_s_setprio(3);
        __syncthreads();
        for (int c = 0; c < SC_NC; ++c) {
            const float* buf = (const float*)(smem + (c & 1) * SC_BUF);
            float* yb = (float*)(smem + SC_YOFF + (c & 1) * SC_YBUF);
            const float* bp = buf + sub * 4;
#define SC_LD(arr, s) (*(const f32x4*)(bp + (arr) * SC_ARR + (s) * 64))
            f32x4 r1 = SC_LD(0, 0), w1 = SC_LD(1, 0), k1 = SC_LD(2, 0), q1 = SC_LD(3, 0), n1 = SC_LD(4, 0);
            f32x4 r2 = SC_LD(0, 1), w2 = SC_LD(1, 1), k2 = SC_LD(2, 1), g2 = SC_LD(3, 1), n2 = SC_LD(4, 1);
            float v1 = buf[SC_VOFF + rl], v2 = buf[SC_VOFF + 16 + rl];
            f32x2 cf = *(const f32x2*)(buf + SC_COFF);
#pragma unroll
            for (int pr = 0; pr < SC_TC / 2; ++pr) {
                const int sn = 2 * pr + 2;
                const f32x4 r1n = SC_LD(0, sn), w1n = SC_LD(1, sn), k1n = SC_LD(2, sn), q1n = SC_LD(3, sn), n1n = SC_LD(4, sn);
                const f32x4 r2n = SC_LD(0, sn + 1), w2n = SC_LD(1, sn + 1), k2n = SC_LD(2, sn + 1), g2n = SC_LD(3, sn + 1), n2n = SC_LD(4, sn + 1);
                const float v1n = buf[SC_VOFF + sn * 16 + rl], v2n = buf[SC_VOFF + (sn + 1) * 16 + rl];
                const f32x2 cfn = *(const f32x2*)(buf + SC_COFF + (pr + 1) * 2);
                __builtin_amdgcn_sched_barrier(0x7);
                float d1 = dot4(S, q1), e2 = dot4(S, g2);
                const f32x4 t1 = S * w1 + v1 * k1;
                reduce16x2(d1, e2);
                const float d2 = e2 + v1 * cf[0] - d1 * cf[1];
                const f32x4 S1 = t1 + d1 * n1;
                const f32x4 S2 = (S1 * w2 + v2 * k2) + d2 * n2;
                float y1 = dot4(S1, r1), y2 = dot4(S2, r2);
                y1 += dppf<0xB1>(y1); y2 += dppf<0xB1>(y2);
                float yz = odd_lane ? y2 : y1;
                yz += dppf<0x122>(yz); yz += dppf<0x124>(yz); yz += dppf<0x128>(yz);
                yb[(2 * pr) * 16 + yoff] = yz;
                S = S2;
                r1 = r1n; w1 = w1n; k1 = k1n; q1 = q1n; n1 = n1n; r2 = r2n; w2 = w2n; k2 = k2n; g2 = g2n; n2 = n2n; v1 = v1n; v2 = v2n; cf = cfn;
            }
#undef SC_LD
            __syncthreads();
        }
        __builtin_amdgcn_s_setprio(0);
    }
}

constexpr int KLD = 72;
__device__ __forceinline__ void attn_unit(const Params& p, int unit) {
    unsigned char* ws = p.ws;
    const int qt = unit % 65, bh = unit / 65, b = bh >> 3, h = bh & 7;
    const int tid = threadIdx.x, wave = tid >> 6, lane = tid & 63, fr = lane & 15, fq = lane >> 4;
    const bf16_t* Q = (const bf16_t*)(ws + R_QKV) + (size_t)bh * TP * 64;
    const bf16_t* Kg = Q + QKV_ONE / 2;
    const bf16_t* Vg = Q + QKV_ONE;
    bf16_t* slots = (bf16_t*)smem;
    constexpr int SLOT = 2 * 64 * KLD;
    volatile int* flags = (volatile int*)(smem + 2 * SLOT * 2);
    const int t0 = qt * 128, tq = t0 + wave * 16 + fr;
    bf16x8 qf[2];
    qf[0] = *(const bf16x8*)(Q + (size_t)tq * 64 + fq * 8);
    qf[1] = *(const bf16x8*)(Q + (size_t)tq * 64 + 32 + fq * 8);
    float qs = 0.f;
#pragma unroll
    for (int s = 0; s < 2; ++s)
#pragma unroll
        for (int e = 0; e < 8; ++e) { const float f = bf2f((unsigned short)qf[s][e]); qs += f * f; }
    qs += __shfl_xor(qs, 16); qs += __shfl_xor(qs, 32);
    const f32x4 km4 = *(const f32x4*)((const float*)(ws + WS_CTL) + 16 + bh * 4);
    const float kmax = sqrtf(fmaxf(fmaxf(km4[0], km4[1]), fmaxf(km4[2], km4[3])));
    const float zb = sqrtf(qs) * kmax * 1.0001f + 88.0f;
    float Arow = 0.f;
    f32x4 O[4];
#pragma unroll
    for (int nd = 0; nd < 4; ++nd) O[nd] = (f32x4){0.f, 0.f, 0.f, 0.f};
    const int key = tid >> 3, dc = (tid & 7) * 8, half = wave >> 2;
    auto tile_store = [&](int blk, const u32x4& kv, const u32x4& vv) {
        bf16_t* Ks_ = slots + (blk & 1) * SLOT; bf16_t* Vt_ = Ks_ + 64 * KLD;
        *(u32x4*)(Ks_ + key * KLD + dc) = kv;
#pragma unroll
        for (int e = 0; e < 4; ++e) { Vt_[(dc + 2 * e) * KLD + key] = (bf16_t)(vv[e] & 0xffffu); Vt_[(dc + 2 * e + 1) * KLD + key] = (bf16_t)(vv[e] >> 16); }
    };
    const int ktop = qt * 2 + 1;
    {
        const u32x4 k0 = *(const u32x4*)(Kg + (size_t)(ktop * 64 + key) * 64 + dc), v0 = *(const u32x4*)(Vg + (size_t)(ktop * 64 + key) * 64 + dc);
        __syncthreads();
        tile_store(ktop, k0, v0);
    }
    u32x4 kvv = *(const u32x4*)(Kg + (size_t)((ktop - 1) * 64 + key) * 64 + dc);
    u32x4 vvv = *(const u32x4*)(Vg + (size_t)((ktop - 1) * 64 + key) * 64 + dc);
    for (int kt = ktop; kt >= 0; --kt) {
        const int kb = kt - 1 + half;
        const bool done = __all(Arow > zb) || kb < 0;
        if (lane == 0) flags[wave] = done ? 1 : 0;
        __syncthreads();
        int alld = 1;
#pragma unroll
        for (int w = 0; w < 8; ++w) alld &= flags[w];
        if (alld) break;
        if (kt >= 1) {
            tile_store(kt - 1, kvv, vvv);
            if (kt >= 2) {
                kvv = *(const u32x4*)(Kg + (size_t)((kt - 2) * 64 + key) * 64 + dc);
                vvv = *(const u32x4*)(Vg + (size_t)((kt - 2) * 64 + key) * 64 + dc);
            }
        }
        asm volatile("s_waitcnt lgkmcnt(0)" ::: "memory");
        __builtin_amdgcn_s_barrier();
        if (kb < 0) continue;
        const bf16_t* Ks = slots + (kb & 1) * SLOT; const bf16_t* Vt = Ks + 64 * KLD;
        f32x4 z[4];
#pragma unroll
        for (int n = 0; n < 4; ++n) {
            z[n] = (f32x4){0.f, 0.f, 0.f, 0.f};
#pragma unroll
            for (int s = 0; s < 2; ++s) {
                const bf16x8 kf = *(const bf16x8*)(Ks + (n * 16 + fr) * KLD + s * 32 + fq * 8);
                z[n] = __builtin_amdgcn_mfma_f32_16x16x32_bf16(kf, qf[s], z[n], 0, 0, 0);
            }
        }
        float sp[4][4], lt[4], ex[4], sg[4];
#pragma unroll
        for (int n = 0; n < 4; ++n) {
#pragma unroll
            for (int j = 0; j < 4; ++j) { const int s = kb * 64 + n * 16 + fq * 4 + j; sp[n][j] = s < tq ? softplusf_(z[n][j]) : 0.f; }
            sp[n][2] += sp[n][3]; sp[n][1] += sp[n][2]; sp[n][0] += sp[n][1];
            lt[n] = sp[n][0];
            const float a = __shfl_xor(lt[n], 16), pr = lt[n] + a, c = __shfl_xor(pr, 32);
            ex[n] = fq == 3 ? 0.f : (fq == 2 ? a : (fq == 1 ? c : a + c));
            sg[n] = pr + c;
        }
        float nsuf[4]; nsuf[3] = 0.f; nsuf[2] = sg[3]; nsuf[1] = nsuf[2] + sg[2]; nsuf[0] = nsuf[1] + sg[1];
        float wgt[4][4];
#pragma unroll
        for (int n = 0; n < 4; ++n)
#pragma unroll
            for (int j = 0; j < 4; ++j) {
                const int s = kb * 64 + n * 16 + fq * 4 + j;
                const float C = Arow + nsuf[n] + ex[n] + sp[n][j];
                wgt[n][j] = s < tq ? __expf(z[n][j] - C) : 0.f;
            }
        Arow += nsuf[0] + sg[0];
#pragma unroll
        for (int ks = 0; ks < 2; ++ks) {
            u32x4 pw; pw.x = pk_bf16(wgt[2 * ks][0], wgt[2 * ks][1]); pw.y = pk_bf16(wgt[2 * ks][2], wgt[2 * ks][3]);
            pw.z = pk_bf16(wgt[2 * ks + 1][0], wgt[2 * ks + 1][1]); pw.w = pk_bf16(wgt[2 * ks + 1][2], wgt[2 * ks + 1][3]);
            const bf16x8 pf = __builtin_bit_cast(bf16x8, pw);
#pragma unroll
            for (int nd = 0; nd < 4; ++nd) {
                u32x4 vw;
                const u32x2 v0 = *(const u32x2*)(Vt + (nd * 16 + fr) * KLD + (2 * ks) * 16 + fq * 4);
                const u32x2 v1 = *(const u32x2*)(Vt + (nd * 16 + fr) * KLD + (2 * ks + 1) * 16 + fq * 4);
                vw.x = v0.x; vw.y = v0.y; vw.z = v1.x; vw.w = v1.y;
                O[nd] = __builtin_amdgcn_mfma_f32_16x16x32_bf16(pf, __builtin_bit_cast(bf16x8, vw), O[nd], 0, 0, 0);
            }
        }
    }
    __syncthreads();
    bf16_t* Ot = (bf16_t*)smem;
#pragma unroll
    for (int j = 0; j < 4; ++j)
#pragma unroll
        for (int nd = 0; nd < 4; ++nd) Ot[(wave * 16 + fq * 4 + j) * KLD + nd * 16 + fr] = (bf16_t)(pk_bf16(O[nd][j], 0.f) & 0xffffu);
    __syncthreads();
    bf16_t* osb = (bf16_t*)(ws + O_OSB);
#pragma unroll
    for (int i = 0; i < 2; ++i) {
        const int idx = tid + 512 * i, r = idx >> 3, pc8 = (idx & 7) * 8, t = t0 + r;
        if (t >= NMETA && t < T) *(u32x4*)(osb + (size_t)(b * SEQ + t - NMETA) * 512 + h * 64 + pc8) = *(const u32x4*)(Ot + r * KLD + pc8);
    }
}

constexpr int N_SCAN = 128, N_ATTN = 32 * 65;
__device__ __forceinline__ void sub_barrier(unsigned* ctr, unsigned target, bool arrive) {
    asm volatile("s_waitcnt vmcnt(0)" ::: "memory");
    __syncthreads();
    if (threadIdx.x == 0) {
        if (arrive) { __builtin_amdgcn_fence(__ATOMIC_RELEASE, "agent"); asm volatile("s_waitcnt vmcnt(0)" ::: "memory"); (void)xb_add(ctr, 1u); }
        unsigned sp = 0u;
        while (xb_ld(ctr) < target) { __builtin_amdgcn_s_sleep(2); if (++sp > (1u << 22)) break; }
        __builtin_amdgcn_fence(__ATOMIC_ACQUIRE, "agent");
        asm volatile("s_waitcnt vmcnt(0)" ::: "memory");
    }
    __syncthreads();
}
__device__ __forceinline__ void phase3(const Params& p) {
    unsigned char* ws = p.ws;
    unsigned* ctl = (unsigned*)(ws + WS_CTL);
    const int nother = (int)gridDim.x - N_SCAN;
    if ((int)blockIdx.x < N_SCAN) {
        scan_unit(p, blockIdx.x);
    } else {
        EpiInProj<true> epi{(bf16_t*)(ws + R_QKV), (_Float16*)(ws + R_URW), (bf16_t*)p.out};
        gemm_phase((const bf16_t*)(ws + O_A0), (const bf16_t*)(ws + WS_WIN), D, MP / BM, 14, epi, nother, (int)blockIdx.x - N_SCAN, 6, 7);
        sub_barrier(ctl + 256, (unsigned)nother, true);
        for (int it = (int)blockIdx.x - N_SCAN; it < 128; it += nother) phase2_kmax(p, it);
        sub_barrier(ctl + 320, (unsigned)nother, true);
    }
    sub_barrier(ctl + 320, (unsigned)nother, false);
    volatile int* slot = (volatile int*)(smem + 131072 - 16);
    for (;;) {
        __syncthreads();
        if (threadIdx.x == 0) *slot = (int)atomicAdd(ctl, 1u);
        __syncthreads();
        const int u = *slot;
        if (u >= N_ATTN) break;
        attn_unit(p, u);
    }
}

__device__ __forceinline__ void phase3c(const Params& p) {
    unsigned char* ws = p.ws;
    const _Float16* SI = (const _Float16*)(ws + R_SI);
    constexpr size_t SIE = (size_t)MP * 512;
    const bf16_t* Y = (const bf16_t*)(ws + O_Y);
    const bf16_t* G = (const bf16_t*)(ws + R_G);
    bf16_t* orw = (bf16_t*)(ws + O_ORW);
    const int tid = threadIdx.x, sub = tid & 15;
    constexpr int U = 4;
    for (int it = blockIdx.x; it < 32 * 64; it += gridDim.x) {
        const int bh = it >> 6, c4 = it & 63, b = bh >> 3, h = bh & 7;
        const int c = h * 64 + sub * 4;
        const f32x4 gain = *(const f32x4*)(p.in[14] + c), bias = *(const f32x4*)(p.in[15] + c), rk = *(const f32x4*)(p.in[13] + c);
        u32x2 yb2[U]; f32x4 y[U]; h16x4 r4[U], k4[U], v4[U]; u32x2 g2[U];
#pragma unroll
        for (int u = 0; u < U; ++u) {
            const int t = NMETA + (c4 * U + u) * 32 + (tid >> 4);
            const size_t base = ((size_t)bh * TP + t) * 64 + sub * 4;
            const size_t rec = ((size_t)bh * TP + t) * 448, pbase = rec + (sub & 3) * 16 + (sub >> 2) * 4;
            yb2[u] = *(const u32x2*)(Y + base);
            r4[u] = *(const h16x4*)(SI + SI_R * 64 + pbase); k4[u] = *(const h16x4*)(SI + SI_K * 64 + pbase); v4[u] = *(const h16x4*)(SI + SI_V * 64 + rec + sub * 4);
            g2[u] = *(const u32x2*)((const bf16_t*)SI + 6 * 64 + pbase);
        }
#pragma unroll
        for (int u = 0; u < U; ++u) {
            const int t = NMETA + (c4 * U + u) * 32 + (tid >> 4);
            y[u][0] = __uint_as_float(yb2[u].x << 16); y[u][1] = __uint_as_float(yb2[u].x & 0xffff0000u); y[u][2] = __uint_as_float(yb2[u].y << 16); y[u][3] = __uint_as_float(yb2[u].y & 0xffff0000u);
            const float mean = reduce16((y[u][0] + y[u][1]) + (y[u][2] + y[u][3])) * (1.0f / 64.0f);
            const f32x4 dy = y[u] - mean;
            const float var = reduce16((dy[0] * dy[0] + dy[1] * dy[1]) + (dy[2] * dy[2] + dy[3] * dy[3])) * (1.0f / 64.0f);
            const float rs = rsqrtf(var + GN_EPS);
            float bs = 0.f;
#pragma unroll
            for (int j = 0; j < 4; ++j) bs += (float)r4[u][j] * (float)k4[u][j] * rk[j];
            bs = reduce16(bs);
            const float gg[4] = {__uint_as_float(g2[u].x << 16), __uint_as_float(g2[u].x & 0xffff0000u), __uint_as_float(g2[u].y << 16), __uint_as_float(g2[u].y & 0xffff0000u)};
            float o[4];
#pragma unroll
            for (int j = 0; j < 4; ++j) o[j] = (dy[j] * rs * gain[j] + bias[j] + bs * (float)v4[u][j]) * gg[j];
            u32x2 w; w.x = pk_bf16(o[0], o[1]); w.y = pk_bf16(o[2], o[3]);
            *(u32x2*)(orw + (size_t)(b * SEQ + t - NMETA) * 512 + c) = w;
        }
    }
}

__device__ __forceinline__ void phase4(const Params& p) {
    unsigned char* ws = p.ws;
    EpiBranch1 e1{(bf16_t*)(ws + O_T1), (const bf16_t*)p.out};
    EpiBranch2 e2{(const bf16_t*)(ws + O_T1), (const bf16_t*)p.out, (bf16_t*)(ws + O_M)};
    gemm_phase((const bf16_t*)(ws + O_OSB), (const bf16_t*)(ws + WS_WSB), 512, MS / BM, D / BM, e1);
    gemm_phase((const bf16_t*)(ws + O_ORW), (const bf16_t*)(ws + WS_WRW), 512, MS / BM, D / BM, e2);
}
__device__ __forceinline__ void phase5(const Params& p) {
    unsigned char* ws = p.ws;
    EpiBf16 e{(bf16_t*)(ws + O_P)};
    gemm_phase((const bf16_t*)(ws + O_M), (const bf16_t*)(ws + WS_WOUT), D, MS / BM, D / BM, e);
}
__device__ __forceinline__ void phase6(const Params& p) {
    unsigned char* ws = p.ws;
    const int lane = threadIdx.x & 63;
    f32x4 g1[4], g2[4];
#pragma unroll
    for (int j = 0; j < 4; ++j) { g1[j] = *(const f32x4*)(p.in[3] + 4 * lane + 256 * j); g2[j] = *(const f32x4*)(p.in[19] + 4 * lane + 256 * j); }
    for (int it = blockIdx.x; it < MS / 16; it += gridDim.x) {
        const int row0 = it * 16 + (threadIdx.x >> 6) * 2;
        f32x4 v[2][4], x[2][4];
#pragma unroll
        for (int r = 0; r < 2; ++r)
#pragma unroll
            for (int j = 0; j < 4; ++j) {
                { const u32x2 pb2 = *(const u32x2*)((const bf16_t*)(ws + O_P) + (size_t)(row0 + r) * D + 4 * lane + 256 * j);
                  v[r][j] = (f32x4){__uint_as_float(pb2.x << 16), __uint_as_float(pb2.x & 0xffff0000u), __uint_as_float(pb2.y << 16), __uint_as_float(pb2.y & 0xffff0000u)}; }
                x[r][j] = *(const f32x4*)(p.in[0] + (size_t)(row0 + r) * D + 4 * lane + 256 * j);
            }
#pragma unroll
        for (int r = 0; r < 2; ++r) {
            const int row = row0 + r;
            float ss = 0.f;
#pragma unroll
            for (int j = 0; j < 4; ++j) ss += (v[r][j][0] * v[r][j][0] + v[r][j][1] * v[r][j][1]) + (v[r][j][2] * v[r][j][2] + v[r][j][3] * v[r][j][3]);
            const float rs = rsqrtf(wave_sum(ss) * (1.0f / D) + RMS_EPS);
            float s2 = 0.f;
#pragma unroll
            for (int j = 0; j < 4; ++j) {
                v[r][j] = x[r][j] + v[r][j] * rs * g1[j];
                { u32x2 hb; hb.x = pk_bf16(v[r][j][0], v[r][j][1]); hb.y = pk_bf16(v[r][j][2], v[r][j][3]);
                  *(u32x2*)((bf16_t*)(ws + O_H1B) + (size_t)row * D + 4 * lane + 256 * j) = hb;
                  v[r][j] = (f32x4){__uint_as_float(hb.x << 16), __uint_as_float(hb.x & 0xffff0000u), __uint_as_float(hb.y << 16), __uint_as_float(hb.y & 0xffff0000u)}; }
                s2 += (v[r][j][0] * v[r][j][0] + v[r][j][1] * v[r][j][1]) + (v[r][j][2] * v[r][j][2] + v[r][j][3] * v[r][j][3]);
            }
            const float rs2 = rsqrtf(wave_sum(s2) * (1.0f / D) + RMS_EPS);
            bf16_t* fr_ = (bf16_t*)(ws + O_F) + (size_t)row * D;
#pragma unroll
            for (int j = 0; j < 4; ++j) {
                u32x2 w; w.x = pk_bf16(v[r][j][0] * rs2 * g2[j][0], v[r][j][1] * rs2 * g2[j][1]); w.y = pk_bf16(v[r][j][2] * rs2 * g2[j][2], v[r][j][3] * rs2 * g2[j][3]);
                *(u32x2*)(fr_ + 4 * lane + 256 * j) = w;
            }
        }
    }
}
__device__ __forceinline__ void phase7(const Params& p) {
    unsigned char* ws = p.ws;
    EpiGU e{(bf16_t*)(ws + O_ACT)};
    gemm_phase((const bf16_t*)(ws + O_F), (const bf16_t*)(ws + WS_WGU), D, MS / BM, 2 * DFF / BM, e);
}
__device__ __forceinline__ void phase8(const Params& p) {
    unsigned char* ws = p.ws;
    EpiDownFused e{p.out, (const bf16_t*)(ws + O_H1B), p.in[20], (float*)(ws + WS_XBUF), (unsigned*)(ws + WS_XCNT)};
    gemm_phase((const bf16_t*)(ws + O_ACT), (const bf16_t*)(ws + WS_WD), DFF, MS / BM, D / BM, e);
}
__device__ __forceinline__ void phase9(const Params& p) {
    unsigned char* ws = p.ws;
    const int lane = threadIdx.x & 63;
    f32x4 g[4];
#pragma unroll
    for (int j = 0; j < 4; ++j) g[j] = *(const f32x4*)(p.in[20] + 4 * lane + 256 * j);
    for (int it = blockIdx.x; it < MS / 16; it += gridDim.x) {
        const int row0 = it * 16 + (threadIdx.x >> 6) * 2;
        f32x4 v[2][4], h1[2][4];
#pragma unroll
        for (int r = 0; r < 2; ++r)
#pragma unroll
            for (int j = 0; j < 4; ++j) {
                { const u32x2 db2 = *(const u32x2*)((const bf16_t*)(ws + O_DN) + (size_t)(row0 + r) * D + 4 * lane + 256 * j);
                  v[r][j] = (f32x4){__uint_as_float(db2.x << 16), __uint_as_float(db2.x & 0xffff0000u), __uint_as_float(db2.y << 16), __uint_as_float(db2.y & 0xffff0000u)}; }
                h1[r][j] = *(const f32x4*)(p.out + (size_t)(row0 + r) * D + 4 * lane + 256 * j);
            }
#pragma unroll
        for (int r = 0; r < 2; ++r) {
            float ss = 0.f;
#pragma unroll
            for (int j = 0; j < 4; ++j) ss += (v[r][j][0] * v[r][j][0] + v[r][j][1] * v[r][j][1]) + (v[r][j][2] * v[r][j][2] + v[r][j][3] * v[r][j][3]);
            const float rs = rsqrtf(wave_sum(ss) * (1.0f / D) + RMS_EPS);
#pragma unroll
            for (int j = 0; j < 4; ++j) *(f32x4*)(p.out + (size_t)(row0 + r) * D + 4 * lane + 256 * j) = h1[r][j] + v[r][j] * rs * g[j];
        }
    }
}

constexpr int N_PHASES = 11;
__device__ __forceinline__ void run_phase(const Params& p, int ph) {
    switch (ph) {
        case 0: phase0(p); break;
        case 1: phase1(p); break;
        case 2: phase2(p); break;
        case 3: phase3(p); break;
        case 4: phase3c(p); break;
        case 5: phase4(p); break;
        case 6: phase5(p); break;
        case 7: phase6(p); break;
        case 8: phase7(p); break;
        case 9: phase8(p); break;
        default: phase9(p); break;
    }
}

#if MULTI_LAUNCH
template <int PH> __global__ void __launch_bounds__(512) fwd_phase(Params p) { run_phase(p, PH); }
#else
__global__ void __launch_bounds__(512) fwd_mega(Params p) {
    cg::grid_group grid = cg::this_grid();
    volatile LAS unsigned* st = (volatile LAS unsigned*)(smem + 131072);
    if (threadIdx.x == 0) { st[0] = 0u; st[1] = 0u; }
    __syncthreads();
    const XcdBarrier xb = xcd_barrier_post((unsigned*)(p.ws + WS_BAR), st);
    if (p.out == nullptr) grid.sync();
    phase0(p); xcd_barrier(xb); phase1(p); xcd_barrier(xb); phase2(p); xcd_barrier(xb); phase3(p); xcd_barrier(xb); phase3c(p); xcd_barrier(xb);
    phase4(p); xcd_barrier(xb); phase5(p); xcd_barrier(xb); phase6(p); xcd_barrier(xb); phase7(p); xcd_barrier(xb); phase8(p);
}
#endif

extern "C" void kernel_launch(void* const* d_in, const int* in_sizes, int n_in, void* d_out, int out_size, void* d_ws, size_t ws_size, hipStream_t stream) {
    static int grid = 0;
    if (grid == 0) {
        if (n_in != 24 || out_size != MS * D || ws_size < WS_END) { fprintf(stderr, "kernel_launch: unexpected shapes (n_in %d out %d ws %zu need %zu)\n", n_in, out_size, ws_size, (size_t)WS_END); grid = -1; return; }
        int dev = 0, cus = 0, per_cu = 0;
        (void)hipGetDevice(&dev);
        (void)hipDeviceGetAttribute(&cus, hipDeviceAttributeMultiprocessorCount, dev);
#if MULTI_LAUNCH
        per_cu = 1;
#else
        (void)hipFuncSetAttribute((const void*)fwd_mega, hipFuncAttributeMaxDynamicSharedMemorySize, LDS_BYTES);
        (void)hipOccupancyMaxActiveBlocksPerMultiprocessor(&per_cu, (const void*)fwd_mega, 512, LDS_BYTES);
        if (per_cu < 1) { fprintf(stderr, "kernel_launch: occupancy query says %d blocks per CU\n", per_cu); per_cu = 1; }
        if (per_cu > 1) per_cu = 1;
#endif
        grid = cus * per_cu;
        if (grid != 256) { fprintf(stderr, "kernel_launch: this kernel needs a 256-workgroup grid (got %d)\n", grid); grid = -1; return; }
        if (grid <= N_SCAN) { fprintf(stderr, "kernel_launch: grid %d too small (needs more than %d workgroups)\n", grid, N_SCAN); grid = -1; return; }
    }
    if (grid < 0) return;
    Params p{};
    for (int i = 0; i < 24; ++i) p.in[i] = (const float*)d_in[i];
    p.out = (float*)d_out; p.ws = (unsigned char*)d_ws;
#if MULTI_LAUNCH
#define LP(PH) do { (void)hipFuncSetAttribute((const void*)fwd_phase<PH>, hipFuncAttributeMaxDynamicSharedMemorySize, LDS_BYTES); hipLaunchKernelGGL(fwd_phase<PH>, dim3(grid), dim3(512), LDS_BYTES, stream, p); } while (0)
    LP(0); LP(1); LP(2); LP(3); LP(4); LP(5); LP(6); LP(7); LP(8); LP(9); LP(10);
#undef LP
#else
    if (hipMemsetAsync(d_ws, 0, WS_CTL_BYTES, stream) != hipSuccess) { fprintf(stderr, "kernel_launch: hipMemsetAsync of the control words failed\n"); return; }
    void* args[] = {&p};
    hipError_t e = hipLaunchCooperativeKernel((const void*)fwd_mega, dim3(grid), dim3(512), args, LDS_BYTES, stream);
    if (e != hipSuccess) fprintf(stderr, "cooperative launch failed: %s (grid %d)\n", hipGetErrorString(e), grid);
#endif
}
```
